# Optimizing an MI355X kernel written in HIP

```python
import math
import jax
import jax.numpy as jnp
from jax import lax
import numpy as np

D_MODEL = 2048
BATCH = 4
SEQ = 4096
DEPTH = 4

MEM_LEN = 256
N_EVEN = (DEPTH + 1) // 2
N_ODD = DEPTH // 2
CONV_K = 4
LRU_WIDTH = D_MODEL // 2
LRU_BLOCKS = 8
LRU_BLOCK = LRU_WIDTH // LRU_BLOCKS
LRU_C = 8.0
HGRN_WIDTH = D_MODEL // 2
HGRN_HEADS = 8
HGRN_DK = HGRN_WIDTH // HGRN_HEADS
HGRN_DV = HGRN_DK
HGRN_CHUNK = 64
AB_IN = 2 * LRU_WIDTH + 4 * HGRN_WIDTH
AB_SPLITS = [LRU_WIDTH, 2 * LRU_WIDTH, 2 * LRU_WIDTH + HGRN_WIDTH,
             2 * LRU_WIDTH + 2 * HGRN_WIDTH, 2 * LRU_WIDTH + 3 * HGRN_WIDTH]
AB_OUT = LRU_WIDTH + HGRN_WIDTH
SSD_INNER = 2 * D_MODEL
SSD_HEADDIM = 64
SSD_HEADS = SSD_INNER // SSD_HEADDIM
SSD_GROUPS = 8
SSD_HPG = SSD_HEADS // SSD_GROUPS
SSD_STATE = 128
SSD_CHUNK = 128
SSD_CONV_DIM = SSD_INNER + 2 * SSD_GROUPS * SSD_STATE
SSD_IN = SSD_INNER + SSD_CONV_DIM + SSD_HEADS
XA_HEADS = 4
XA_HEADDIM = D_MODEL // XA_HEADS
FFN_HIDDEN = ((8 * D_MODEL // 3 + 255) // 256) * 256

kernel_name = 'hybrid_rglru_hgrn2_ssd_trunk'


def rmsnorm(x, g, eps=1e-6):
    xf = x.astype(jnp.float32)
    y = xf * lax.rsqrt(jnp.mean(xf * xf, axis=-1, keepdims=True) + eps)
    return (y * g.astype(jnp.float32)).astype(x.dtype)


def causal_dwconv(u, w, b):
    k_width = w.shape[0]
    s = u.shape[1]
    up = jnp.pad(u, ((0, 0), (k_width - 1, 0), (0, 0)))
    out = b
    for k in range(k_width):
        out = out + up[:, k:k + s] * w[k]
    return out


def linear_recurrence(a, b):
    def combine(l, r):
        return (l[0] * r[0], r[0] * l[1] + r[1])
    _, h = lax.associative_scan(combine, (a, b), axis=1)
    return h


def hgrn2_chunked(q, k, log_f, v):
    bsz, s, h, dk = q.shape
    dv = v.shape[-1]
    n_chunks = s // HGRN_CHUNK

    def to_chunks(t):
        return t.reshape(bsz, n_chunks, HGRN_CHUNK, h, t.shape[-1]).transpose(1, 0, 3, 2, 4)

    causal = jnp.tril(jnp.ones((HGRN_CHUNK, HGRN_CHUNK), dtype=bool))[:, :, None]

    def step(state, inp):
        qc, kc, gc, vc = inp
        cum = jnp.cumsum(gc, axis=2)
        diff = cum[:, :, :, None, :] - cum[:, :, None, :, :]
        decay = jnp.exp(jnp.where(causal, diff, -jnp.inf))
        scores = jnp.einsum('bhtk,bhsk,bhtsk->bhts', qc, kc, decay)
        o = jnp.einsum('bhts,bhsv->bhtv', scores, vc)
        o = o + jnp.einsum('bhtk,bhkv->bhtv', qc * jnp.exp(cum), state)
        last = cum[:, :, -1:, :]
        state = (jnp.exp(last[:, :, 0, :, None]) * state
                 + jnp.einsum('bhsk,bhsv->bhkv', kc * jnp.exp(last - cum), vc))
        return state, o

    state0 = jnp.zeros((bsz, h, dk, dv), jnp.float32)
    xs = (to_chunks(q), to_chunks(k), to_chunks(log_f), to_chunks(v))
    _, o = lax.scan(step, state0, xs)
    return o.transpose(1, 0, 3, 2, 4).reshape(bsz, s, h, dv)


def ssd_chunked(xh, dt, a_neg, bm, cm):
    bsz, s, g, r, p = xh.shape
    n = bm.shape[-1]
    n_chunks = s // SSD_CHUNK

    def to_chunks(t):
        return jnp.moveaxis(t.reshape(bsz, n_chunks, SSD_CHUNK, *t.shape[2:]), 1, 0)

    causal = jnp.tril(jnp.ones((SSD_CHUNK, SSD_CHUNK), dtype=bool))

    def step(state, inp):
        xc, dtc, bc, cc = inp
        cum = jnp.cumsum(dtc * a_neg, axis=1)
        cum_h = jnp.moveaxis(cum, 1, -1)
        seg = cum_h[..., :, None] - cum_h[..., None, :]
        decay = jnp.exp(jnp.where(causal, seg, -jnp.inf))
        cb = jnp.einsum('btgn,bsgn->bgts', cc, bc)
        xdt = xc * dtc[..., None]
        y = jnp.einsum('bgrts,bsgrp->btgrp', cb[:, :, None] * decay, xdt)
        y = y + jnp.einsum('btgn,bgrpn->btgrp', cc, state) * jnp.exp(cum)[..., None]
        last = cum[:, -1]
        w_s = jnp.exp(last[:, None] - cum)[..., None]
        state = (jnp.exp(last)[..., None, None] * state
                 + jnp.einsum('bsgn,bsgrp->bgrpn', bc, xdt * w_s))
        return state, y

    state0 = jnp.zeros((bsz, g, r, p, n), jnp.float32)
    xs = (to_chunks(xh), to_chunks(dt), to_chunks(bm), to_chunks(cm))
    _, y = lax.scan(step, state0, xs)
    return jnp.moveaxis(y, 0, 1).reshape(bsz, s, g, r, p)


def rglru_hgrn2_mixer(h, w_in, w_out, conv_w, conv_b, w_r, b_r, w_i, b_i, lam,
                      lower_bound, head_norm):
    bsz, s, _ = h.shape
    f32 = jnp.float32
    proj = h @ w_in
    xa, ga, q, f, iv, gb = jnp.split(proj, AB_SPLITS, axis=-1)
    xa = causal_dwconv(xa, conv_w, conv_b)
    xb = xa.reshape(bsz, s, LRU_BLOCKS, LRU_BLOCK)
    r_gate = jax.nn.sigmoid(jnp.einsum('bshi,hij->bshj', xb, w_r).reshape(bsz, s, LRU_WIDTH) + b_r).astype(f32)
    i_gate = jax.nn.sigmoid(jnp.einsum('bshi,hij->bshj', xb, w_i).reshape(bsz, s, LRU_WIDTH) + b_i).astype(f32)
    log_a = -LRU_C * r_gate * jax.nn.softplus(-lam.astype(f32))
    a = jnp.exp(log_a)
    mult = jnp.sqrt(-jnp.expm1(2.0 * log_a))
    h_lru = linear_recurrence(a, mult * i_gate * xa.astype(f32))
    y_a = jax.nn.gelu(ga) * h_lru.astype(h.dtype)
    qh = jax.nn.silu(q).astype(f32).reshape(bsz, s, HGRN_HEADS, HGRN_DK)
    fg = lower_bound + (1.0 - lower_bound) * jax.nn.sigmoid(f.astype(f32))
    kh = (1.0 - fg).reshape(bsz, s, HGRN_HEADS, HGRN_DK)
    log_fg = jnp.log(fg).reshape(bsz, s, HGRN_HEADS, HGRN_DK)
    vh = iv.astype(f32).reshape(bsz, s, HGRN_HEADS, HGRN_DV)
    o = hgrn2_chunked(qh, kh, log_fg, vh)
    o = rmsnorm(o, head_norm.reshape(HGRN_HEADS, HGRN_DV)).reshape(bsz, s, HGRN_WIDTH)
    y_b = o.astype(h.dtype) * jax.nn.silu(gb)
    return jnp.concatenate([y_a, y_b], axis=-1) @ w_out


def ssd_mixer(h, w_in, w_out, conv_w, conv_b, dt_bias, a_log, d_skip, norm_w):
    bsz, s, _ = h.shape
    f32 = jnp.float32
    proj = h @ w_in
    z, xbc, dt_raw = jnp.split(proj, [SSD_INNER, SSD_INNER + SSD_CONV_DIM], axis=-1)
    xbc = jax.nn.silu(causal_dwconv(xbc, conv_w, conv_b))
    xs, bm, cm = jnp.split(xbc, [SSD_INNER, SSD_INNER + SSD_GROUPS * SSD_STATE], axis=-1)
    dt = jax.nn.softplus(dt_raw.astype(f32) + dt_bias.astype(f32))
    a_neg = -jnp.exp(a_log.astype(f32))
    xh = xs.astype(f32).reshape(bsz, s, SSD_GROUPS, SSD_HPG, SSD_HEADDIM)
    y = ssd_chunked(xh,
                    dt.reshape(bsz, s, SSD_GROUPS, SSD_HPG),
                    a_neg.reshape(SSD_GROUPS, SSD_HPG),
                    bm.astype(f32).reshape(bsz, s, SSD_GROUPS, SSD_STATE),
                    cm.astype(f32).reshape(bsz, s, SSD_GROUPS, SSD_STATE))
    y = y + d_skip.astype(f32).reshape(SSD_GROUPS, SSD_HPG)[:, :, None] * xh
    y = y.reshape(bsz, s, SSD_INNER).astype(h.dtype) * jax.nn.silu(z)
    y = rmsnorm(y.reshape(bsz, s, SSD_GROUPS, SSD_INNER // SSD_GROUPS),
                norm_w.reshape(SSD_GROUPS, SSD_INNER // SSD_GROUPS)).reshape(bsz, s, SSD_INNER)
    return y @ w_out


def memory_cross_attention(h, mem_n, w_q, w_kv, w_o):
    bsz, s, _ = h.shape
    q = (h @ w_q).reshape(bsz, s, XA_HEADS, XA_HEADDIM)
    k, v = jnp.split(mem_n @ w_kv, 2, axis=-1)
    k = k.reshape(bsz, -1, XA_HEADS, XA_HEADDIM)
    v = v.reshape(bsz, -1, XA_HEADS, XA_HEADDIM)
    scores = jnp.einsum('bshd,bmhd->bhsm', q, k).astype(jnp.float32) * (XA_HEADDIM ** -0.5)
    p = jax.nn.softmax(scores, axis=-1).astype(v.dtype)
    o = jnp.einsum('bhsm,bmhd->bshd', p, v).reshape(bsz, s, D_MODEL)
    return o @ w_o


def swiglu(h, w_gate, w_up, w_down):
    return (jax.nn.silu(h @ w_gate) * (h @ w_up)) @ w_down


def setup_inputs(seed: int = 0) -> dict:
    key = jax.random.key(seed)
    k = jax.random.split(key, 32)
    f32 = jnp.float32

    def nrm(i, shape, scale):
        return jax.random.normal(k[i], shape, f32) * scale

    def gain(i, shape):
        return 1.0 + nrm(i, shape, 0.02)

    lam_u = jax.random.uniform(k[16], (N_EVEN, LRU_WIDTH), f32, 0.9, 0.999)
    lam_s = lam_u ** (1.0 / LRU_C)
    lam = jnp.log(lam_s) - jnp.log1p(-lam_s)
    dt0 = jnp.exp(jax.random.uniform(k[22], (N_ODD, SSD_HEADS), f32, math.log(1e-3), math.log(1e-1)))
    dt_bias = dt0 + jnp.log(-jnp.expm1(-dt0))
    a_log = jnp.log(jax.random.uniform(k[23], (N_ODD, SSD_HEADS), f32, 1.0, 16.0))
    return {
        'x': nrm(0, (BATCH, SEQ, D_MODEL), 1.0),
        'mem': nrm(1, (BATCH, MEM_LEN, D_MODEL), 1.0),
        'norm_mix': gain(2, (DEPTH, D_MODEL)),
        'norm_xattn': gain(3, (DEPTH, D_MODEL)),
        'norm_ffn': gain(4, (DEPTH, D_MODEL)),
        'norm_mem': gain(5, (D_MODEL,)),
        'norm_final': gain(6, (D_MODEL,)),
        'ab_w_in': nrm(7, (N_EVEN, D_MODEL, AB_IN), D_MODEL ** -0.5),
        'ab_w_out': nrm(8, (N_EVEN, AB_OUT, D_MODEL), AB_OUT ** -0.5),
        'lru_conv_w': nrm(9, (N_EVEN, CONV_K, LRU_WIDTH), CONV_K ** -0.5),
        'lru_conv_b': nrm(10, (N_EVEN, LRU_WIDTH), 0.01),
        'lru_w_r': nrm(11, (N_EVEN, LRU_BLOCKS, LRU_BLOCK, LRU_BLOCK), LRU_BLOCK ** -0.5),
        'lru_b_r': nrm(12, (N_EVEN, LRU_WIDTH), 0.01),
        'lru_w_i': nrm(13, (N_EVEN, LRU_BLOCKS, LRU_BLOCK, LRU_BLOCK), LRU_BLOCK ** -0.5),
        'lru_b_i': nrm(14, (N_EVEN, LRU_WIDTH), 0.01),
        'lru_lambda': lam,
        'hgrn_lower_bounds': nrm(15, (N_EVEN, HGRN_WIDTH), 0.1),
        'hgrn_norm': gain(17, (N_EVEN, HGRN_WIDTH)),
        'ssd_w_in': nrm(18, (N_ODD, D_MODEL, SSD_IN), D_MODEL ** -0.5),
        'ssd_w_out': nrm(19, (N_ODD, SSD_INNER, D_MODEL), SSD_INNER ** -0.5),
        'ssd_conv_w': nrm(20, (N_ODD, CONV_K, SSD_CONV_DIM), CONV_K ** -0.5),
        'ssd_conv_b': nrm(21, (N_ODD, SSD_CONV_DIM), 0.01),
        'ssd_dt_bias': dt_bias,
        'ssd_a_log': a_log,
        'ssd_d': gain(24, (N_ODD, SSD_HEADS)),
        'ssd_norm': gain(25, (N_ODD, SSD_INNER)),
        'xa_w_q': nrm(26, (DEPTH, D_MODEL, D_MODEL), D_MODEL ** -0.5),
        'xa_w_kv': nrm(27, (DEPTH, D_MODEL, 2 * D_MODEL), D_MODEL ** -0.5),
        'xa_w_o': nrm(28, (DEPTH, D_MODEL, D_MODEL), D_MODEL ** -0.5),
        'ffn_w_gate': nrm(29, (DEPTH, D_MODEL, FFN_HIDDEN), D_MODEL ** -0.5),
        'ffn_w_up': nrm(30, (DEPTH, D_MODEL, FFN_HIDDEN), D_MODEL ** -0.5),
        'ffn_w_down': nrm(31, (DEPTH, FFN_HIDDEN, D_MODEL), FFN_HIDDEN ** -0.5),
    }


def reference(x, mem, norm_mix, norm_xattn, norm_ffn, norm_mem, norm_final,
              ab_w_in, ab_w_out, lru_conv_w, lru_conv_b, lru_w_r, lru_b_r, lru_w_i, lru_b_i,
              lru_lambda, hgrn_lower_bounds, hgrn_norm,
              ssd_w_in, ssd_w_out, ssd_conv_w, ssd_conv_b, ssd_dt_bias, ssd_a_log, ssd_d, ssd_norm,
              xa_w_q, xa_w_kv, xa_w_o, ffn_w_gate, ffn_w_up, ffn_w_down):
    sm = jax.nn.softmax(hgrn_lower_bounds.astype(jnp.float32), axis=0)
    lower_bounds = jnp.cumsum(sm, axis=0) - sm[0]
    mem_n = rmsnorm(mem, norm_mem)
    for layer in range(DEPTH):
        h = rmsnorm(x, norm_mix[layer])
        if layer % 2 == 0:
            e = layer // 2
            y = rglru_hgrn2_mixer(h, ab_w_in[e], ab_w_out[e], lru_conv_w[e], lru_conv_b[e],
                                  lru_w_r[e], lru_b_r[e], lru_w_i[e], lru_b_i[e], lru_lambda[e],
                                  lower_bounds[e], hgrn_norm[e])
        else:
            o = layer // 2
            y = ssd_mixer(h, ssd_w_in[o], ssd_w_out[o], ssd_conv_w[o], ssd_conv_b[o],
                          ssd_dt_bias[o], ssd_a_log[o], ssd_d[o], ssd_norm[o])
        x = x + y
        x = x + memory_cross_attention(rmsnorm(x, norm_xattn[layer]), mem_n,
                                       xa_w_q[layer], xa_w_kv[layer], xa_w_o[layer])
        x = x + swiglu(rmsnorm(x, norm_ffn[layer]), ffn_w_gate[layer], ffn_w_up[layer], ffn_w_down[layer])
    return rmsnorm(x, norm_final)
```

```cpp
#include <hip/hip_runtime.h>
#include <cstdio>
#include <cstdint>

#ifndef MK_SPLIT
#define MK_SPLIT 1
#endif

#define GAS __attribute__((address_space(1)))
#define LAS __attribute__((address_space(3)))
typedef unsigned short bf16;
typedef short bf16x8 __attribute__((ext_vector_type(8)));
typedef float f32x4 __attribute__((ext_vector_type(4)));
typedef float f32x2 __attribute__((ext_vector_type(2)));
typedef unsigned u32x4 __attribute__((ext_vector_type(4)));
typedef unsigned u32x2 __attribute__((ext_vector_type(2)));

constexpr int D = 2048, NB = 4, SEQ = 4096, M = NB * SEQ, DEPTH = 4, MEMLEN = 256, MEMROWS = NB * MEMLEN;
constexpr int LRUW = 1024, ABIN = 6144;
constexpr int SSDIN = 4096, SSDCONV = 6144, SSDPROJ = 10304, SSDN1 = 10240, NHEADS = 64;
constexpr int XAD = 512, FF = 5632;
constexpr float EPS = 1e-6f;
constexpr int NWAVES = 8, NTHR = 512;

constexpr size_t MiB = 1u << 20;
constexpr size_t WS_CTL = 0, CTL_ZERO_BYTES = 1 * MiB;
constexpr size_t WS_WKV = 2 * MiB;
constexpr size_t WS_KMAT = 66 * MiB;
constexpr size_t WS_VT = 82 * MiB;
constexpr size_t WS_MEMN = 98 * MiB;
constexpr size_t WS_TAB = 102 * MiB;
constexpr size_t WS_XB = 106 * MiB;
constexpr size_t WS_WL = 170 * MiB;
constexpr size_t WS_ACT = 310 * MiB;
constexpr size_t WS_SS = (310 + 680) * MiB;
constexpr size_t WS_END = (310 + 680 + 8) * MiB;
constexpr size_t TAB_LB = 0;
constexpr size_t TAB_WRT = 64 * 1024;
constexpr size_t WL_IN = 0;
constexpr size_t WL_DT = (size_t)SSDN1 * D;
constexpr size_t WL_OUT = (size_t)(SSDN1 + 256) * D;
constexpr size_t WL_Q = WL_OUT + (size_t)D * SSDIN;
constexpr size_t WL_O = WL_Q + (size_t)D * D;
constexpr size_t WL_GU = WL_O + (size_t)D * D;
constexpr size_t WL_DN = WL_GU + (size_t)2 * FF * D;
constexpr size_t WL_ELEMS = WL_DN + (size_t)D * FF;
static_assert(WL_ELEMS * 2 <= 140 * MiB, "per-layer weights");
constexpr size_t A_Z = 0;
constexpr size_t A_XBC = 128 * MiB;
constexpr size_t A_Y = 128 * MiB;
constexpr size_t A_XBT = 320 * MiB;
constexpr size_t A_BCN = 480 * MiB;
constexpr size_t A_ST = 544 * MiB;
constexpr size_t A_DT = 672 * MiB;
constexpr size_t A_DEC = 676 * MiB;
constexpr size_t A_PROJ = 0;
constexpr size_t A_LOGF = 192 * MiB;
constexpr size_t A_HST = 256 * MiB;
constexpr size_t A_YAB = 320 * MiB;
constexpr size_t A_SEG = 384 * MiB;
constexpr size_t A_HDEC = 386 * MiB;
constexpr size_t A_Q = 0;
constexpr size_t A_P = 64 * MiB;
constexpr size_t A_O = 96 * MiB;
constexpr size_t A_H = 160 * MiB;

constexpr int LDS_BYTES = 155648;
constexpr int EPI_OFF = 131072;
constexpr int MISC_OFF = LDS_BYTES - 256;

#define LDS_WAIT() asm volatile("s_waitcnt lgkmcnt(0)" ::: "memory")
#define VM_WAIT() asm volatile("s_waitcnt vmcnt(0)" ::: "memory")
__device__ __forceinline__ unsigned f2bf(float f) { unsigned u = __builtin_bit_cast(unsigned, f); return (u + 0x7fffu + ((u >> 16) & 1u)) >> 16; }
__device__ __forceinline__ unsigned pk2(float lo, float hi) { return f2bf(lo) | (f2bf(hi) << 16); }
typedef __bf16 bf16x2v __attribute__((ext_vector_type(2)));
__device__ __forceinline__ unsigned cvt_pk_bf16(float lo, float hi) { const f32x2 v = {lo, hi}; return __builtin_bit_cast(unsigned, __builtin_convertvector(v, bf16x2v)); }
__device__ __forceinline__ float bflo(unsigned w) { return __uint_as_float(w << 16); }
__device__ __forceinline__ float bfhi(unsigned w) { return __uint_as_float(w & 0xffff0000u); }
__device__ __forceinline__ float bf2f(bf16 b) { return __uint_as_float((unsigned)b << 16); }
__device__ __forceinline__ float sigm(float x) { return 1.f / (1.f + __expf(-x)); }
__device__ __forceinline__ float siluf(float x) { return x * sigm(x); }
__device__ __forceinline__ float gelu_tanh(float x) { return x * sigm(1.5957691216f * (x + 0.044715f * x * x * x)); }
__device__ __forceinline__ float softplusf(float x) { const float e = __expf(-fabsf(x)); const float l = (e < 0.03f) ? e * (1.f - e * (0.5f - e * 0.33333333f)) : __logf(1.f + e); return fmaxf(x, 0.f) + l; }
__device__ __forceinline__ float wave_sum(float v) {
#pragma unroll
    for (int o = 1; o < 64; o <<= 1) v += __shfl_xor(v, o);
    return v;
}

#define XB_TMO      128
#define XB_XCNT(j)  (256  + 64 * (j))
#define XB_XSUB(j)  (1280 + 64 * (j))
#define XB_XGEN(j)  (2304 + 64 * (j))
#define XB_TOP      3328
#define XB_TOPGEN   3392
#define XCD_BAR_WORDS 3456
#define XB_SPIN_CAP (1u << 18)

__device__ __forceinline__ unsigned xb_ld(unsigned* p)              { return __hip_atomic_load(p, __ATOMIC_RELAXED, __HIP_MEMORY_SCOPE_AGENT); }
__device__ __forceinline__ unsigned xb_add(unsigned* p, unsigned v) { return __hip_atomic_fetch_add(p, v, __ATOMIC_RELAXED, __HIP_MEMORY_SCOPE_AGENT); }
__device__ __forceinline__ unsigned xb_xcc_id() { return (unsigned)__builtin_amdgcn_s_getreg((3 << 11) | 20) & 0xFu; }
#define XB_SPIN(cond, bar) do { unsigned _sp = 0; while (cond) { __builtin_amdgcn_s_sleep(1); \
    if ((++_sp & 255u) == 0u) { if (xb_ld(&(bar)[XB_TMO])) break; if (_sp > XB_SPIN_CAP) { atomicAdd(&(bar)[XB_TMO], 1u); break; } } } } while (0)

struct XcdBarrier {
    unsigned* bar; unsigned x;
    volatile LAS unsigned* st;
};
__device__ __forceinline__ XcdBarrier xcd_barrier_post(unsigned* bar, volatile LAS unsigned* st) {
    XcdBarrier b; b.bar = bar; b.x = xb_xcc_id(); b.st = st;
    if (threadIdx.x == 0) (void)xb_add(&bar[XB_XCNT(b.x)], 1u);
    return b;
}
__device__ __forceinline__ void xcd_barrier_complete(unsigned* bar, unsigned x, unsigned& nloc, unsigned& nx) {
    const unsigned G = gridDim.x * gridDim.y * gridDim.z;
    unsigned sum, cnt, mine, sp = 0u;
    for (;;) {
        sum = 0u; cnt = 0u; mine = 0u;
#pragma unroll
        for (unsigned j = 0; j < 16; ++j) { const unsigned c = xb_ld(&bar[XB_XCNT(j)]); sum += c; cnt += (c > 0u) ? 1u : 0u; mine = (j == x) ? c : mine; }
        if (sum == G) break;
        __builtin_amdgcn_s_sleep(1);
        if ((++sp & 255u) == 0u) { if (xb_ld(&bar[XB_TMO])) break; if (sp > XB_SPIN_CAP) { atomicAdd(&bar[XB_TMO], 1u); break; } }
    }
    nloc = mine > 0u ? mine : 1u; nx = cnt > 0u ? cnt : 1u;
}
__device__ __forceinline__ void xcd_barrier(const XcdBarrier& b) {
    asm volatile("s_waitcnt vmcnt(0)" ::: "memory");
    __syncthreads();
    if (threadIdx.x == 0) {
        unsigned* bar = b.bar;
        __builtin_amdgcn_s_waitcnt(0);
        unsigned nloc = b.st[0], nx = b.st[1];
        if (nloc == 0u) { xcd_barrier_complete(bar, b.x, nloc, nx); b.st[0] = nloc; b.st[1] = nx; }
        const unsigned old = xb_add(&bar[XB_XSUB(b.x)], 1u);
        const unsigned gen = old / nloc;
        if (old + 1u == (gen + 1u) * nloc) {
            __builtin_amdgcn_fence(__ATOMIC_RELEASE, "agent");
            asm volatile("s_waitcnt vmcnt(0)" ::: "memory");
            const unsigned og = xb_add(&bar[XB_TOP], 1u);
            const unsigned tg = og / nx;
            if (og + 1u == (tg + 1u) * nx) xb_add(&bar[XB_TOPGEN], 1u);
            else XB_SPIN(xb_ld(&bar[XB_TOPGEN]) == tg, bar);
            __builtin_amdgcn_fence(__ATOMIC_ACQUIRE, "agent");
            xb_add(&bar[XB_XGEN(b.x)], 1u);
            asm volatile("s_waitcnt vmcnt(0)" ::: "memory");
        } else {
            XB_SPIN(xb_ld(&bar[XB_XGEN(b.x)]) == gen, bar);
            __builtin_amdgcn_fence(__ATOMIC_ACQUIRE, "agent");
            asm volatile("s_waitcnt vmcnt(0)" ::: "memory");
        }
    }
    __syncthreads();
}

namespace pg8 {
constexpr int BM = 256, BK = 64, HALF = 128, HTB = HALF * BK * 2, STAGE_BYTES = 8 * HTB, NXCD = 8, WGM = 8;
__host__ __device__ __forceinline__ int lds_byte(int r, int c) { const int st = (r >> 4) * 2 + (c >> 5), rr = r & 15, cc = c & 31, ob = rr * 64 + cc * 2; return st * 1024 + (ob ^ (((ob >> 9) & 1) << 5)); }
__host__ __device__ __forceinline__ void stage_rc(int b, int& R, int& C) { const int st = b / 1024, sb = b % 1024, swz = sb ^ (((sb >> 9) & 1) << 5); R = (st >> 1) * 16 + swz / 64; C = (st & 1) * 32 + (swz % 64) / 2; }
__host__ __device__ __forceinline__ int perm32(int rho) { const int n = rho >> 4, i = rho & 15; return 8 * (i >> 2) + 4 * n + (i & 3); }

struct Unit { const char* a; const char* b; int orow, ocol, aux; };

template <class Epi, class Sched>
__device__ __forceinline__ void gemm_phase(const int tid, LAS unsigned char* lds, const int K, const int lda, const int ldb, const Sched& S, const Epi& E) {
    const int wid = __builtin_amdgcn_readfirstlane(tid >> 6), lane = tid & 63, wr = wid >> 2, wc = wid & 3, fr = lane & 15, fq = lane >> 4;
    const int nt = K / BK;
    unsigned voffA[2], voffB[2];
#pragma unroll
    for (int i = 0; i < 2; ++i) { int R, C; stage_rc(tid * 16 + i * 8192, R, C); const int Rb = (R & ~31) + perm32(R & 31);
        voffA[i] = (unsigned)(R * lda + C) * 2u; voffB[i] = (unsigned)(Rb * ldb + C) * 2u; }
    const size_t kstep = (size_t)(BK * 2);
    const size_t hstepA = (size_t)HALF * lda * 2, hstepB = (size_t)HALF * ldb * 2;
    const unsigned ldsw = (unsigned)wid * 1024u;
    const int aoff = lds_byte(wr * 64 + fr, fq * 8), boff = lds_byte(wc * 32 + fr, fq * 8);
#define PG8_SA(b, h) (((b) * 2 + (h)) * HTB)
#define PG8_SB(b, h) ((4 + (b) * 2 + (h)) * HTB)
#define PG8_STAGE(bufoff, gbase, voff) do { _Pragma("unroll") for (int _i = 0; _i < 2; ++_i) \
        __builtin_amdgcn_global_load_lds((const unsigned*)((const char*)(gbase) + (voff)[_i]), (LAS unsigned*)(lds + (bufoff) + ldsw + _i * 8192), 16, 0, 0); } while (0)
#define PG8_LDA(dst, b, h) do { _Pragma("unroll") for (int m = 0; m < 4; ++m) _Pragma("unroll") for (int k = 0; k < 2; ++k) dst[m][k] = *(const LAS bf16x8*)(lds + PG8_SA(b, h) + aoff + m * 2048 + k * 1024); } while (0)
#define PG8_LDB(dst, b, h) do { _Pragma("unroll") for (int n = 0; n < 2; ++n) _Pragma("unroll") for (int k = 0; k < 2; ++k) dst[n][k] = *(const LAS bf16x8*)(lds + PG8_SB(b, h) + boff + n * 2048 + k * 1024); } while (0)
#define PG8_MMA(ai, bj, At, Bt) do { __builtin_amdgcn_s_setprio(1); _Pragma("unroll") for (int m = 0; m < 4; ++m) _Pragma("unroll") for (int n = 0; n < 2; ++n) _Pragma("unroll") for (int k = 0; k < 2; ++k) \
        acc[ai][bj][m][n] = __builtin_amdgcn_mfma_f32_16x16x32_bf16(Bt[n][k], At[m][k], acc[ai][bj][m][n], 0, 0, 0); __builtin_amdgcn_s_setprio(0); } while (0)
#define PG8_WAIT_V(n) asm volatile("s_waitcnt vmcnt(" #n ")" ::: "memory")
#define PG8_WAIT_L(n) asm volatile("s_waitcnt lgkmcnt(" #n ")" ::: "memory")
#define PG8_BAR __builtin_amdgcn_s_barrier()
#define PG8_SCHED __builtin_amdgcn_sched_barrier(0)
    Unit cur, nxt; int ui = 0;
    if (!S.next(0, cur)) return;
    f32x4 acc[2][2][4][2];
#pragma unroll
    for (int a = 0; a < 2; ++a)
#pragma unroll
        for (int b = 0; b < 2; ++b)
#pragma unroll
            for (int m = 0; m < 4; ++m)
#pragma unroll
                for (int n = 0; n < 2; ++n) acc[a][b][m][n] = (f32x4){0.f, 0.f, 0.f, 0.f};
    bf16x8 At[4][2], B0[2][2], B1[2][2];
    const char* cA = cur.a; const char* cB = cur.b;
    PG8_STAGE(PG8_SB(0, 0), cB, voffB); PG8_STAGE(PG8_SB(0, 1), cB + hstepB, voffB); PG8_STAGE(PG8_SA(0, 0), cA, voffA); PG8_STAGE(PG8_SA(0, 1), cA + hstepA, voffA);
    if (wr == 1) PG8_BAR;
    PG8_WAIT_V(2); PG8_BAR;
    PG8_STAGE(PG8_SB(1, 0), cB + kstep, voffB); PG8_STAGE(PG8_SA(1, 0), cA + kstep, voffA); PG8_STAGE(PG8_SB(1, 1), cB + hstepB + kstep, voffB);
    PG8_WAIT_V(6); PG8_BAR;
    for (;;) {
        const bool has_next = S.next(ui + 1, nxt);
        const char* nA = has_next ? nxt.a : cA; const char* nB = has_next ? nxt.b : cB;
        for (int t = 0; t < nt; t += 2) {
            const bool last = (t == nt - 2);
            const char* a1 = cA + (size_t)(t + 1) * kstep;
            const char* a2 = last ? nA : cA + (size_t)(t + 2) * kstep; const char* b2 = last ? nB : cB + (size_t)(t + 2) * kstep;
            const char* a3 = a2 + kstep; const char* b3 = b2 + kstep;
            PG8_LDB(B0, 0, 0); PG8_LDB(B1, 0, 1); PG8_SCHED; PG8_LDA(At, 0, 0); PG8_STAGE(PG8_SA(1, 1), a1 + hstepA, voffA);
            PG8_WAIT_V(8); PG8_WAIT_L(0); PG8_BAR; PG8_MMA(0, 0, At, B0); PG8_MMA(0, 1, At, B1); PG8_BAR; PG8_SCHED;
            PG8_LDA(At, 0, 1); PG8_STAGE(PG8_SB(0, 0), b2, voffB); PG8_STAGE(PG8_SB(0, 1), b2 + hstepB, voffB); PG8_STAGE(PG8_SA(0, 0), a2, voffA);
            PG8_WAIT_V(8); PG8_WAIT_L(0); PG8_BAR; PG8_MMA(1, 0, At, B0); PG8_MMA(1, 1, At, B1); PG8_BAR; PG8_SCHED;
            PG8_LDB(B0, 1, 0); PG8_LDB(B1, 1, 1); PG8_SCHED; PG8_LDA(At, 1, 0); PG8_STAGE(PG8_SA(0, 1), a2 + hstepA, voffA);
            PG8_WAIT_V(8); PG8_WAIT_L(0); PG8_BAR; PG8_MMA(0, 0, At, B0); PG8_MMA(0, 1, At, B1); PG8_BAR; PG8_SCHED;
            PG8_LDA(At, 1, 1); PG8_STAGE(PG8_SB(1, 0), b3, voffB); PG8_STAGE(PG8_SB(1, 1), b3 + hstepB, voffB); PG8_STAGE(PG8_SA(1, 0), a3, voffA);
            PG8_WAIT_V(8); PG8_WAIT_L(0); PG8_BAR; PG8_MMA(1, 0, At, B0); PG8_MMA(1, 1, At, B1); PG8_BAR; PG8_SCHED;
        }
        if (wr == 0) PG8_BAR;
        E(acc, cur, wr, wc, fr, fq);
        if (!has_next) break;
#pragma unroll
        for (int a = 0; a < 2; ++a)
#pragma unroll
            for (int b = 0; b < 2; ++b)
#pragma unroll
                for (int m = 0; m < 4; ++m)
#pragma unroll
                    for (int n = 0; n < 2; ++n) acc[a][b][m][n] = (f32x4){0.f, 0.f, 0.f, 0.f};
        cur = nxt; cA = nA; cB = nB; ++ui;
        if (wr == 1) PG8_BAR;
    }
    PG8_WAIT_V(0);
    PG8_BAR;
#undef PG8_SA
#undef PG8_SB
#undef PG8_STAGE
#undef PG8_LDA
#undef PG8_LDB
#undef PG8_MMA
#undef PG8_WAIT_V
#undef PG8_WAIT_L
#undef PG8_SCHED
}
}
namespace pg8 {
struct SchedMN {
    const char* A; const char* Bt; int lda, ldb; int nM, nN, nwg, G, c;
    __device__ __forceinline__ void init(const bf16* A_, int lda_, const bf16* Bt_, int ldb_, int Mrows, int Ncols, int G_, int c_) {
        A = (const char*)A_; Bt = (const char*)Bt_; lda = lda_; ldb = ldb_; nM = Mrows / BM; nN = Ncols / BM; nwg = nM * nN; G = G_; c = c_; }
    __device__ __forceinline__ bool next(int i, Unit& u) const {
        const long L = (long)i * G + c; if (L >= nwg) return false;
        int wgid = (int)L; { const int q = nwg / NXCD, r = nwg % NXCD, xcd = wgid % NXCD, off = wgid / NXCD; wgid = (xcd < r ? xcd * (q + 1) : r * (q + 1) + (xcd - r) * q) + off; }
        const int nig = WGM * nN, gid = wgid / nig, fm = gid * WGM, gsz = (nM - fm) < WGM ? (nM - fm) : WGM;
        const int pm = fm + ((wgid % nig) % gsz), pn = (wgid % nig) / gsz;
        u.a = A + (size_t)pm * BM * lda * 2; u.b = Bt + (size_t)pn * BM * ldb * 2; u.orow = pm * BM; u.ocol = pn * BM; u.aux = pn; return true;
    }
};
struct SchedKV {
    const char* memn; const char* wkv; int G, c;
    __device__ __forceinline__ bool next(int i, Unit& u) const {
        const int L = i * G + c; if (L >= 256) return false;
        const int l = L >> 6, r = L & 63; const char* w = wkv + (size_t)l * 4096 * D * 2;
        if (r < 32) { const int pm = r >> 3, pn = r & 7; u.a = memn + (size_t)pm * 256 * D * 2; u.b = w + (size_t)pn * 256 * D * 2; u.orow = pm * 256; u.ocol = pn * 256; u.aux = l * 2; }
        else { const int q = r - 32, pm = q >> 2, pn = q & 3; u.a = w + (size_t)(2048 + pm * 256) * D * 2; u.b = memn + (size_t)pn * 256 * D * 2; u.orow = pm * 256; u.ocol = pn * 256; u.aux = l * 2 + 1; }
        return true;
    }
};
struct SchedS {
    const char* Q; const char* Km; int G, c;
    __device__ __forceinline__ bool next(int i, Unit& u) const {
        const int L = i * G + c; if (L >= 256) return false;
        const int bh = 2 * (L & 7) + ((L >> 3) >> 4), it = (L >> 3) & 15, b = bh >> 2, h = bh & 3;
        u.a = Q + ((size_t)(b * SEQ + it * 256) * D + h * XAD) * 2; u.b = Km + ((size_t)(b * MEMLEN) * D + h * XAD) * 2; u.orow = b * SEQ + it * 256; u.ocol = h * 256; u.aux = 0; return true;
    }
};
struct SchedPV {
    const char* P; const char* Vt; int G, c;
    __device__ __forceinline__ bool next(int i, Unit& u) const {
        const int L = i * G + c; if (L >= 512) return false;
        const int x = L & 7, r = L >> 3;
        const int bh = 2 * x + (r >> 5), q = r & 31, it = q >> 1, nh = q & 1, b = bh >> 2, h = bh & 3;
        u.a = P + ((size_t)(b * SEQ + it * 256) * 1024 + h * 256) * 2; u.b = Vt + ((size_t)(h * XAD + nh * 256) * 1024 + b * MEMLEN) * 2; u.orow = b * SEQ + it * 256; u.ocol = h * XAD + nh * 256; u.aux = 0; return true;
    }
};
struct SchedDt {
    const char* A; const char* Bt; int c;
    __device__ __forceinline__ bool next(int i, Unit& u) const {
        if (i != 0 || c >= 64) return false;
        u.a = A + (size_t)c * 256 * D * 2; u.b = Bt; u.orow = c * 256; u.ocol = 0; u.aux = 0; return true;
    }
};

#define EPI_ARGS f32x4 (&acc)[2][2][4][2], const Unit& u, int wr, int wc, int fr, int fq
#define EPI_ROW(ai, m) (u.orow + (ai) * HALF + wr * 64 + (m) * 16 + fr)
#define EPI_COL(bj) (u.ocol + (bj) * HALF + wc * 32 + 8 * fq)
__device__ __forceinline__ float rstd_of(const float* ss, int row) { const f32x4 a = *(const f32x4*)(ss + (size_t)row * 8), b = *(const f32x4*)(ss + (size_t)row * 8 + 4);
    return rsqrtf((((a[0] + a[1]) + (a[2] + a[3])) + ((b[0] + b[1]) + (b[2] + b[3]))) * (1.0f / D) + EPS); }
__device__ __forceinline__ u32x4 pack8(const f32x4 a, const f32x4 b) { u32x4 w; w.x = cvt_pk_bf16(a[0], a[1]); w.y = cvt_pk_bf16(a[2], a[3]); w.z = cvt_pk_bf16(b[0], b[1]); w.w = cvt_pk_bf16(b[2], b[3]); return w; }

struct EpiProjEven {
    const float* ss; bf16* proj; float* logf; const float* lb;
    __device__ __forceinline__ void operator()(EPI_ARGS) const {
        const int range = u.aux >> 2;
#pragma unroll
        for (int ai = 0; ai < 2; ++ai)
#pragma unroll
            for (int m = 0; m < 4; ++m) { const int row = EPI_ROW(ai, m); const float rs = rstd_of(ss, row);
#pragma unroll
                for (int bj = 0; bj < 2; ++bj) { const int col = EPI_COL(bj); f32x4 v0 = acc[ai][bj][m][0] * rs, v1 = acc[ai][bj][m][1] * rs;
                    if (range == 3) { const int c = col - 3072; const f32x4 l0 = *(const f32x4*)(lb + c), l1 = *(const f32x4*)(lb + c + 4);
#pragma unroll
                        for (int j = 0; j < 4; ++j) { v0[j] = __logf(l0[j] + (1.f - l0[j]) * sigm(v0[j])); v1[j] = __logf(l1[j] + (1.f - l1[j]) * sigm(v1[j])); }
                        float* p = logf + (size_t)row * 1024 + c; *(f32x4*)p = v0; *(f32x4*)(p + 4) = v1;
                    } else {
                        if (range == 1) {
#pragma unroll
                            for (int j = 0; j < 4; ++j) { v0[j] = gelu_tanh(v0[j]); v1[j] = gelu_tanh(v1[j]); } }
                        else if (range == 2 || range == 5) {
#pragma unroll
                            for (int j = 0; j < 4; ++j) { v0[j] = siluf(v0[j]); v1[j] = siluf(v1[j]); } }
                        *(u32x4*)(proj + (size_t)row * ABIN + col) = pack8(v0, v1);
                    } } }
    }
};
struct EpiProjOdd {
    const float* ss; bf16* Z; bf16* XBC;
    __device__ __forceinline__ void operator()(EPI_ARGS) const {
        const bool isz = u.ocol < SSDIN;
#pragma unroll
        for (int ai = 0; ai < 2; ++ai)
#pragma unroll
            for (int m = 0; m < 4; ++m) { const int row = EPI_ROW(ai, m); const float rs = rstd_of(ss, row);
#pragma unroll
                for (int bj = 0; bj < 2; ++bj) { const int col = EPI_COL(bj); f32x4 v0 = acc[ai][bj][m][0] * rs, v1 = acc[ai][bj][m][1] * rs;
                    if (isz) {
#pragma unroll
                        for (int j = 0; j < 4; ++j) { v0[j] = siluf(v0[j]); v1[j] = siluf(v1[j]); }
                        *(u32x4*)(Z + (size_t)row * SSDIN + col) = pack8(v0, v1);
                    } else *(u32x4*)(XBC + (size_t)row * SSDCONV + (col - SSDIN)) = pack8(v0, v1); } }
    }
};
struct EpiDt {
    const float* ss; const float* bias; float* DT;
    __device__ __forceinline__ void operator()(EPI_ARGS) const {
        if (wc >= 2) return;
        const int col = wc * 32 + 8 * fq; const f32x4 b0 = *(const f32x4*)(bias + col), b1 = *(const f32x4*)(bias + col + 4);
#pragma unroll
        for (int ai = 0; ai < 2; ++ai)
#pragma unroll
            for (int m = 0; m < 4; ++m) { const int row = EPI_ROW(ai, m); const float rs = rstd_of(ss, row);
                f32x4 v0 = acc[ai][0][m][0] * rs + b0, v1 = acc[ai][0][m][1] * rs + b1;
#pragma unroll
                for (int j = 0; j < 4; ++j) { v0[j] = softplusf(v0[j]); v1[j] = softplusf(v1[j]); }
                float* p = DT + (size_t)row * 64 + col; *(f32x4*)p = v0; *(f32x4*)(p + 4) = v1; }
    }
};
struct EpiResid {
    float* x; bf16* xb; float* ssnew; LAS float* tab;
    __device__ __forceinline__ void operator()(EPI_ARGS) const {
#pragma unroll
        for (int ai = 0; ai < 2; ++ai)
#pragma unroll
            for (int m = 0; m < 4; ++m) { const int row = EPI_ROW(ai, m); float sq = 0.f;
#pragma unroll
                for (int bj = 0; bj < 2; ++bj) { const int col = EPI_COL(bj); float* p = x + (size_t)row * D + col;
                    const f32x4 o0 = *(const f32x4*)p + acc[ai][bj][m][0], o1 = *(const f32x4*)(p + 4) + acc[ai][bj][m][1];
                    *(f32x4*)p = o0; *(f32x4*)(p + 4) = o1; *(u32x4*)(xb + (size_t)row * D + col) = pack8(o0, o1);
                    sq += ((o0[0] * o0[0] + o0[1] * o0[1]) + (o0[2] * o0[2] + o0[3] * o0[3])) + ((o1[0] * o1[0] + o1[1] * o1[1]) + (o1[2] * o1[2] + o1[3] * o1[3])); }
                sq += __shfl_xor(sq, 16); sq += __shfl_xor(sq, 32);
                if (fq == 0) tab[(ai * HALF + wr * 64 + m * 16 + fr) * 4 + wc] = sq; }
        LDS_WAIT(); PG8_BAR; asm volatile("" ::: "memory");
        const int lane = fq * 16 + fr, r = (wr * 4 + wc) * 32 + (lane & 31);
        if (lane < 32) { const f32x4 t = *(const LAS f32x4*)(tab + r * 4); ssnew[(size_t)(u.orow + r) * 8 + (u.ocol >> 8)] = (t[0] + t[1]) + (t[2] + t[3]); }
    }
};
struct EpiQ {
    const float* ss; bf16* Q; float scale;
    __device__ __forceinline__ void operator()(EPI_ARGS) const {
#pragma unroll
        for (int ai = 0; ai < 2; ++ai)
#pragma unroll
            for (int m = 0; m < 4; ++m) { const int row = EPI_ROW(ai, m); const float rs = rstd_of(ss, row) * scale;
#pragma unroll
                for (int bj = 0; bj < 2; ++bj) *(u32x4*)(Q + (size_t)row * D + EPI_COL(bj)) = pack8(acc[ai][bj][m][0] * rs, acc[ai][bj][m][1] * rs); }
    }
};
struct EpiPlain {
    bf16* O; int ldc;
    __device__ __forceinline__ void operator()(EPI_ARGS) const {
#pragma unroll
        for (int ai = 0; ai < 2; ++ai)
#pragma unroll
            for (int m = 0; m < 4; ++m) { const int row = EPI_ROW(ai, m);
#pragma unroll
                for (int bj = 0; bj < 2; ++bj) *(u32x4*)(O + (size_t)row * ldc + EPI_COL(bj)) = pack8(acc[ai][bj][m][0], acc[ai][bj][m][1]); }
    }
};
struct EpiKV {
    bf16* Km; bf16* Vt;
    __device__ __forceinline__ void operator()(EPI_ARGS) const {
        const int l = u.aux >> 1; const bool isv = u.aux & 1;
        bf16* O = isv ? Vt + (size_t)l * D * MEMROWS : Km + (size_t)l * MEMROWS * D; const int ldc = isv ? MEMROWS : D;
#pragma unroll
        for (int ai = 0; ai < 2; ++ai)
#pragma unroll
            for (int m = 0; m < 4; ++m) { const int row = EPI_ROW(ai, m);
#pragma unroll
                for (int bj = 0; bj < 2; ++bj) *(u32x4*)(O + (size_t)row * ldc + EPI_COL(bj)) = pack8(acc[ai][bj][m][0], acc[ai][bj][m][1]); }
    }
};
struct EpiSoftmax {
    bf16* P; LAS float* tab;
    __device__ __forceinline__ void operator()(EPI_ARGS) const {
        float mx[2][4];
#pragma unroll
        for (int ai = 0; ai < 2; ++ai)
#pragma unroll
            for (int m = 0; m < 4; ++m) { float v = -3.0e38f;
#pragma unroll
                for (int bj = 0; bj < 2; ++bj)
#pragma unroll
                    for (int n = 0; n < 2; ++n) { const f32x4 a = acc[ai][bj][m][n]; v = fmaxf(v, fmaxf(fmaxf(a[0], a[1]), fmaxf(a[2], a[3]))); }
                v = fmaxf(v, __shfl_xor(v, 16)); v = fmaxf(v, __shfl_xor(v, 32));
                if (fq == 0) tab[(ai * HALF + wr * 64 + m * 16 + fr) * 4 + wc] = v; }
        LDS_WAIT(); PG8_BAR; asm volatile("" ::: "memory");
#pragma unroll
        for (int ai = 0; ai < 2; ++ai)
#pragma unroll
            for (int m = 0; m < 4; ++m) { const int r = ai * HALF + wr * 64 + m * 16 + fr; const f32x4 t = *(const LAS f32x4*)(tab + r * 4);
                const float rm = fmaxf(fmaxf(t[0], t[1]), fmaxf(t[2], t[3])); float s = 0.f;
#pragma unroll
                for (int bj = 0; bj < 2; ++bj)
#pragma unroll
                    for (int n = 0; n < 2; ++n) { f32x4 a = acc[ai][bj][m][n];
#pragma unroll
                        for (int j = 0; j < 4; ++j) { a[j] = __expf(a[j] - rm); s += a[j]; }
                        acc[ai][bj][m][n] = a; }
                s += __shfl_xor(s, 16); s += __shfl_xor(s, 32);
                if (fq == 0) tab[1024 + r * 4 + wc] = s; }
        LDS_WAIT(); PG8_BAR; asm volatile("" ::: "memory");
#pragma unroll
        for (int ai = 0; ai < 2; ++ai)
#pragma unroll
            for (int m = 0; m < 4; ++m) { const int r = ai * HALF + wr * 64 + m * 16 + fr; const f32x4 t = *(const LAS f32x4*)(tab + 1024 + r * 4);
                const float inv = 1.0f / ((t[0] + t[1]) + (t[2] + t[3])); const int row = u.orow + r;
#pragma unroll
                for (int bj = 0; bj < 2; ++bj) *(u32x4*)(P + (size_t)row * 1024 + EPI_COL(bj)) = pack8(acc[ai][bj][m][0] * inv, acc[ai][bj][m][1] * inv); }
    }
};
struct EpiGateUp {
    const float* ss; bf16* H;
    __device__ __forceinline__ void operator()(EPI_ARGS) const {
#pragma unroll
        for (int ai = 0; ai < 2; ++ai)
#pragma unroll
            for (int m = 0; m < 4; ++m) { const int row = EPI_ROW(ai, m); const float rs = rstd_of(ss, row);
#pragma unroll
                for (int bj = 0; bj < 2; ++bj) { const int hc = EPI_COL(bj) >> 1; const f32x4 g = acc[ai][bj][m][0] * rs, up = acc[ai][bj][m][1] * rs; f32x4 h;
#pragma unroll
                    for (int j = 0; j < 4; ++j) h[j] = siluf(g[j]) * up[j];
                    u32x2 w; w.x = cvt_pk_bf16(h[0], h[1]); w.y = cvt_pk_bf16(h[2], h[3]); *(u32x2*)(H + (size_t)row * FF + hc) = w; } }
    }
};
#undef EPI_ARGS
}
#define MFMA16(X, Y, ACC) __builtin_amdgcn_mfma_f32_16x16x32_bf16((X), (Y), (ACC), 0, 0, 0)
#define WG_SYNC() do { asm volatile("s_waitcnt vmcnt(0) lgkmcnt(0)" ::: "memory"); __builtin_amdgcn_s_barrier(); asm volatile("" ::: "memory"); } while (0)
constexpr int LP = 136;
constexpr int LP64 = 72;
__device__ __forceinline__ bf16x8 lds_frag(const LAS bf16* base, int row, int pitch, int kofs) { return *(const LAS bf16x8*)(base + row * pitch + kofs); }
__device__ __forceinline__ u32x2 pack4(const f32x4 a) { u32x2 w; w.x = cvt_pk_bf16(a[0], a[1]); w.y = cvt_pk_bf16(a[2], a[3]); return w; }

template <int MAP>
__device__ __forceinline__ void conv_item(const float* W, int ldw, int K, int n0, const float* gain, bf16* WT, int row_off, LAS float* scr, int item, int nblk, int lane) {
    const int kb = item / nblk, nb = item % nblk, k0 = 64 * kb, nn0 = 32 * nb;
#pragma unroll 8
    for (int i = 0; i < 32; ++i) { const int kk = 2 * i + (lane >> 5); float v = W[(size_t)(k0 + kk) * ldw + n0 + nn0 + (lane & 31)]; if (gain) v *= gain[k0 + kk]; scr[kk * 33 + (lane & 31)] = v; }
    LDS_WAIT(); asm volatile("" ::: "memory");
    const int c = lane & 7;
#pragma unroll
    for (int j = 0; j < 4; ++j) { const int n = (lane >> 3) + 8 * j; const LAS float* s = scr + (8 * c) * 33 + n;
        u32x4 o; o.x = pk2(s[0 * 33], s[1 * 33]); o.y = pk2(s[2 * 33], s[3 * 33]); o.z = pk2(s[4 * 33], s[5 * 33]); o.w = pk2(s[6 * 33], s[7 * 33]);
        const int nn = nn0 + n; const int dr = MAP == 0 ? nn : ((nn >> 2) * 8 + (nn & 3) + (MAP == 2 ? 4 : 0));
        *(u32x4*)(WT + (size_t)(row_off + dr) * K + k0 + 8 * c) = o; }
    LDS_WAIT(); asm volatile("" ::: "memory");
}
template <int MAP>
__device__ __forceinline__ void conv_matrix(const float* W, int ldw, int K, int n0, int ncols, const float* gain, bf16* WT, int row_off, LAS float* scr, int gw, int NGW, int lane) {
    const int nblk = ncols / 32, nitems = (K / 64) * nblk;
    for (int it = gw; it < nitems; it += NGW) conv_item<MAP>(W, ldw, K, n0, gain, WT, row_off, scr, it, nblk, lane);
}

struct In {
    const float *x, *mem, *norm_mix, *norm_xattn, *norm_ffn, *norm_mem, *norm_final, *ab_w_in, *ab_w_out, *lru_conv_w, *lru_conv_b, *lru_w_r, *lru_b_r, *lru_w_i, *lru_b_i, *lru_lambda,
        *hgrn_lb, *hgrn_norm, *ssd_w_in, *ssd_w_out, *ssd_conv_w, *ssd_conv_b, *ssd_dt_bias, *ssd_a_log, *ssd_d, *ssd_norm, *xa_w_q, *xa_w_kv, *xa_w_o, *ffn_w_gate, *ffn_w_up, *ffn_w_down;
};

typedef const In __attribute__((address_space(4))) CIn;
__device__ __forceinline__ void convert_layer(CIn& I, int l, bf16* WL, LAS float* scr, int gw, int NGW, int lane) {
    const int e = l >> 1;
    if ((l & 1) == 0) {
        conv_matrix<0>(I.ab_w_in + (size_t)e * D * ABIN, ABIN, D, 0, ABIN, I.norm_mix + l * D, WL + WL_IN, 0, scr, gw, NGW, lane);
        conv_matrix<0>(I.ab_w_out + (size_t)e * D * D, D, D, 0, D, nullptr, WL + WL_OUT, 0, scr, gw, NGW, lane);
    } else {
        conv_matrix<0>(I.ssd_w_in + (size_t)e * D * SSDPROJ, SSDPROJ, D, 0, SSDN1, I.norm_mix + l * D, WL + WL_IN, 0, scr, gw, NGW, lane);
        conv_matrix<0>(I.ssd_w_in + (size_t)e * D * SSDPROJ, SSDPROJ, D, SSDN1, 64, I.norm_mix + l * D, WL + WL_DT, 0, scr, gw, NGW, lane);
        for (int i = gw * 64 + lane; i < 192 * D / 8; i += NGW * 64) *(u32x4*)(WL + WL_DT + (size_t)64 * D + (size_t)i * 8) = (u32x4){0u, 0u, 0u, 0u};
        conv_matrix<0>(I.ssd_w_out + (size_t)e * SSDIN * D, D, SSDIN, 0, D, nullptr, WL + WL_OUT, 0, scr, gw, NGW, lane);
    }
    conv_matrix<0>(I.xa_w_q + (size_t)l * D * D, D, D, 0, D, I.norm_xattn + l * D, WL + WL_Q, 0, scr, gw, NGW, lane);
    conv_matrix<0>(I.xa_w_o + (size_t)l * D * D, D, D, 0, D, nullptr, WL + WL_O, 0, scr, gw, NGW, lane);
    conv_matrix<1>(I.ffn_w_gate + (size_t)l * D * FF, FF, D, 0, FF, I.norm_ffn + l * D, WL + WL_GU, 0, scr, gw, NGW, lane);
    conv_matrix<2>(I.ffn_w_up + (size_t)l * D * FF, FF, D, 0, FF, I.norm_ffn + l * D, WL + WL_GU, 0, scr, gw, NGW, lane);
    conv_matrix<0>(I.ffn_w_down + (size_t)l * FF * D, D, FF, 0, D, nullptr, WL + WL_DN, 0, scr, gw, NGW, lane);
}

template <bool PASSB>
__device__ __forceinline__ void lru_units(const int tid, LAS unsigned char* lds, int G, int cu, const bf16* PROJ, const bf16* WRT, const float* cw, const float* cb, const float* br, const float* bi,
                                          const float* lam, float* SEG, bf16* YAB) {
    const int wid = __builtin_amdgcn_readfirstlane(tid >> 6), lane = tid & 63, q = lane >> 4, c16 = lane & 15;
    LAS bf16* XA = (LAS bf16*)(lds);
    LAS bf16* XC = (LAS bf16*)(lds + 35840);
    LAS bf16* WR = (LAS bf16*)(lds + 70656);
    LAS bf16* WI = (LAS bf16*)(lds + 105472);
    LAS float* PAR = (LAS float*)(lds + 140288);
    LAS float* WT = (LAS float*)(lds + 144384);
    LAS float* HIN = (LAS float*)(lds + 152576);
    int loadedj = -1;
    for (int u = cu; u < 1024; u += G) {
        const int j = u & 7, rest = u >> 3, b = rest >> 5, seg = rest & 31; const int t0 = b * SEQ + seg * 128;
        if (j != loadedj) {
            loadedj = j;
            for (int p = tid; p < 2 * 2048; p += NTHR) { const int g = p >> 11, pp = p & 2047, r = pp >> 4, pc = pp & 15;
                const u32x4 v = *(const u32x4*)(WRT + ((size_t)(g * 8 + j) * 128 + r) * 128 + pc * 8);
                *(LAS u32x4*)((g ? WI : WR) + r * LP + pc * 8) = v; }
            if (tid < 128) { const int ch = j * 128 + tid;
                PAR[0 * 128 + tid] = 8.0f * softplusf(-lam[ch]); PAR[1 * 128 + tid] = br[ch]; PAR[2 * 128 + tid] = bi[ch]; PAR[3 * 128 + tid] = cb[ch];
#pragma unroll
                for (int k = 0; k < 4; ++k) PAR[(4 + k) * 128 + tid] = cw[k * LRUW + ch]; }
        }
        for (int p = tid; p < 131 * 16; p += NTHR) { const int r = p >> 4, pc = p & 15; u32x4 v = (u32x4){0u, 0u, 0u, 0u};
            if (seg > 0 || r >= 3) v = *(const u32x4*)(PROJ + (size_t)(t0 + r - 3) * ABIN + j * 128 + pc * 8);
            *(LAS u32x4*)(XA + r * LP + pc * 8) = v; }
        if (PASSB) { if (tid < 128) { float h = 0.f; const float* sg = SEG + ((size_t)(b * 8 + j) * 32) * 256 + tid * 2;
                for (int s = 0; s < seg; ++s) { const f32x2 ab = *(const f32x2*)(sg + (size_t)s * 256); h = ab.x * h + ab.y; }
                HIN[tid] = h; } }
        WG_SYNC();
        {
            const int ch8 = tid & 15, tr = tid >> 4; u32x4 rows[7];
#pragma unroll
            for (int i = 0; i < 7; ++i) rows[i] = *(const LAS u32x4*)(XA + (4 * tr + i) * LP + ch8 * 8);
            float w[4][8], bb[8];
#pragma unroll
            for (int e = 0; e < 8; ++e) { bb[e] = PAR[3 * 128 + ch8 * 8 + e];
#pragma unroll
                for (int k = 0; k < 4; ++k) w[k][e] = PAR[(4 + k) * 128 + ch8 * 8 + e]; }
#pragma unroll
            for (int i = 0; i < 4; ++i) { float o[8];
#pragma unroll
                for (int e = 0; e < 8; ++e) { float a = bb[e];
#pragma unroll
                    for (int k = 0; k < 4; ++k) { const unsigned wd = rows[i + k][e >> 1]; a += w[k][e] * ((e & 1) ? bfhi(wd) : bflo(wd)); }
                    o[e] = a; }
                u32x4 pk; pk.x = cvt_pk_bf16(o[0], o[1]); pk.y = cvt_pk_bf16(o[2], o[3]); pk.z = cvt_pk_bf16(o[4], o[5]); pk.w = cvt_pk_bf16(o[6], o[7]);
                *(LAS u32x4*)(XC + (4 * tr + i) * LP + ch8 * 8) = pk; }
        }
        WG_SYNC();
        float PP[8][4], HH[8][4];
        {
            bf16x8 xf[4];
#pragma unroll
            for (int ks = 0; ks < 4; ++ks) xf[ks] = lds_frag(XC, 16 * wid + c16, LP, 32 * ks + 8 * q);
#pragma unroll
            for (int jb = 0; jb < 8; ++jb) {
                f32x4 aR = (f32x4){0.f, 0.f, 0.f, 0.f}, aI = aR;
#pragma unroll
                for (int ks = 0; ks < 4; ++ks) { aR = MFMA16(xf[ks], lds_frag(WR, 16 * jb + c16, LP, 32 * ks + 8 * q), aR); aI = MFMA16(xf[ks], lds_frag(WI, 16 * jb + c16, LP, 32 * ks + 8 * q), aI); }
                const int ch = 16 * jb + c16;
                const float sp8 = PAR[ch], pbr = PAR[128 + ch], pbi = PAR[256 + ch], pcb = PAR[384 + ch], w0 = PAR[512 + ch], w1 = PAR[640 + ch], w2 = PAR[768 + ch], w3 = PAR[896 + ch];
                float xr[7];
#pragma unroll
                for (int i = 0; i < 7; ++i) xr[i] = bf2f(XA[(16 * wid + 4 * q + i) * LP + ch]);
                float a[4], bt[4];
#pragma unroll
                for (int r = 0; r < 4; ++r) { const float xc = pcb + w0 * xr[r] + w1 * xr[r + 1] + w2 * xr[r + 2] + w3 * xr[r + 3];
                    const float rg = sigm(aR[r] + pbr), ig = sigm(aI[r] + pbi); const float la = -sp8 * rg;
                    a[r] = __expf(la); bt[r] = sqrtf(fmaxf(-expm1f(2.0f * la), 0.f)) * ig * xc; }
                float P[4], H[4]; P[0] = a[0]; H[0] = bt[0];
#pragma unroll
                for (int r = 1; r < 4; ++r) { P[r] = a[r] * P[r - 1]; H[r] = a[r] * H[r - 1] + bt[r]; }
                float Ae = 1.f, Be = 0.f, Aw = 1.f, Bw = 0.f;
#pragma unroll
                for (int qq = 0; qq < 4; ++qq) { const float Aq = __shfl(P[3], c16 + 16 * qq), Bq = __shfl(H[3], c16 + 16 * qq);
                    if (qq < q) { Be = Aq * Be + Bq; Ae = Aq * Ae; }
                    Bw = Aq * Bw + Bq; Aw = Aq * Aw; }
#pragma unroll
                for (int r = 0; r < 4; ++r) { PP[jb][r] = P[r] * Ae; HH[jb][r] = P[r] * Be + H[r]; }
                if (q == 0) *(LAS f32x2*)(WT + (wid * 128 + ch) * 2) = (f32x2){Aw, Bw};
            }
        }
        WG_SYNC();
        if (!PASSB) {
            if (tid < 128) { float A = 1.f, B = 0.f;
#pragma unroll
                for (int w = 0; w < 8; ++w) { const f32x2 ab = *(const LAS f32x2*)(WT + (w * 128 + tid) * 2); B = ab.x * B + ab.y; A = ab.x * A; }
                *(f32x2*)(SEG + ((size_t)(b * 8 + j) * 32 + seg) * 256 + tid * 2) = (f32x2){A, B}; }
        } else {
#pragma unroll
            for (int jb = 0; jb < 8; ++jb) { const int ch = 16 * jb + c16; float h0 = HIN[ch];
                for (int w = 0; w < wid; ++w) { const f32x2 ab = *(const LAS f32x2*)(WT + (w * 128 + ch) * 2); h0 = ab.x * h0 + ab.y; }
#pragma unroll
                for (int r = 0; r < 4; ++r) { const int t = t0 + 16 * wid + 4 * q + r; const float h = PP[jb][r] * h0 + HH[jb][r];
                    const float ga = bf2f(PROJ[(size_t)t * ABIN + 1024 + j * 128 + ch]);
                    YAB[(size_t)t * D + j * 128 + ch] = (bf16)f2bf(ga * h); } }
        }
        WG_SYNC();
    }
}

__device__ __forceinline__ void hgrn1_units(const int tid, LAS unsigned char* lds, int G, int cu, const float* LOGF, const bf16* PROJ, bf16* HST, float* HDEC) {
    const int wid = __builtin_amdgcn_readfirstlane(tid >> 6), lane = tid & 63, q = lane >> 4, c16 = lane & 15;
    LAS bf16* KT = (LAS bf16*)(lds);
    LAS bf16* VT = (LAS bf16*)(lds + 18432);
    LAS float* TOT = (LAS float*)(lds + 36864);
    const int k = tid & 127, qt = tid >> 7;
    for (int u = cu; u < 2048; u += G) {
        const int bh = u >> 6, c = u & 63, b = bh >> 3, h = bh & 7; const int t0 = b * SEQ + c * 64 + 16 * qt;
        float cs[16], lf[16]; unsigned vv[16];
#pragma unroll
        for (int i = 0; i < 16; ++i) { lf[i] = LOGF[(size_t)(t0 + i) * 1024 + h * 128 + k]; vv[i] = PROJ[(size_t)(t0 + i) * ABIN + 4096 + h * 128 + k]; }
        cs[0] = lf[0];
#pragma unroll
        for (int i = 1; i < 16; ++i) cs[i] = cs[i - 1] + lf[i];
        TOT[qt * 128 + k] = cs[15];
        WG_SYNC();
        float pre = 0.f, last = 0.f;
#pragma unroll
        for (int qq = 0; qq < 4; ++qq) { const float t = TOT[qq * 128 + k]; if (qq < qt) pre += t; last += t; }
        unsigned kw[8], vw[8];
#pragma unroll
        for (int i = 0; i < 8; ++i) { const float k0 = (1.f - __expf(lf[2 * i])) * __expf(last - (pre + cs[2 * i])), k1 = (1.f - __expf(lf[2 * i + 1])) * __expf(last - (pre + cs[2 * i + 1]));
            kw[i] = cvt_pk_bf16(k0, k1); vw[i] = vv[2 * i] | (vv[2 * i + 1] << 16); }
        *(LAS u32x4*)(KT + k * LP64 + 16 * qt) = (u32x4){kw[0], kw[1], kw[2], kw[3]}; *(LAS u32x4*)(KT + k * LP64 + 16 * qt + 8) = (u32x4){kw[4], kw[5], kw[6], kw[7]};
        *(LAS u32x4*)(VT + k * LP64 + 16 * qt) = (u32x4){vw[0], vw[1], vw[2], vw[3]}; *(LAS u32x4*)(VT + k * LP64 + 16 * qt + 8) = (u32x4){vw[4], vw[5], vw[6], vw[7]};
        if (qt == 0) HDEC[(size_t)u * 128 + k] = __expf(last);
        WG_SYNC();
        bf16x8 kf[2];
#pragma unroll
        for (int ks = 0; ks < 2; ++ks) kf[ks] = lds_frag(KT, 16 * wid + c16, LP64, 32 * ks + 8 * q);
#pragma unroll
        for (int vb = 0; vb < 8; ++vb) { f32x4 acc = (f32x4){0.f, 0.f, 0.f, 0.f};
#pragma unroll
            for (int ks = 0; ks < 2; ++ks) acc = MFMA16(kf[ks], lds_frag(VT, 16 * vb + c16, LP64, 32 * ks + 8 * q), acc);
            *(u32x2*)(HST + ((size_t)u * 128 + 16 * vb + c16) * 128 + 16 * wid + 4 * q) = pack4(acc); }
        WG_SYNC();
    }
}
__device__ __forceinline__ void hgrn2_scan(const int tid, int G, int cu, bf16* HST, const float* HDEC) {
    for (int task = cu * NTHR + tid; task < 32 * 4096; task += G * NTHR) {
        const int bh = task >> 12, e = (task & 4095) * 4; f32x4 S = (f32x4){0.f, 0.f, 0.f, 0.f};
#pragma unroll 8
        for (int c = 0; c < 64; ++c) { const size_t u = (size_t)bh * 64 + c; bf16* p = HST + u * 16384 + e; const u32x2 L = *(const u32x2*)p; const f32x4 d = *(const f32x4*)(HDEC + u * 128 + (e & 127));
            *(u32x2*)p = pack4(S);
            S[0] = d[0] * S[0] + bflo(L.x); S[1] = d[1] * S[1] + bfhi(L.x); S[2] = d[2] * S[2] + bflo(L.y); S[3] = d[3] * S[3] + bfhi(L.y); }
    }
}
__device__ __forceinline__ void hgrn3_units(const int tid, LAS unsigned char* lds, int G, int cu, const float* LOGF, const bf16* PROJ, const bf16* HST, const float* hnorm, bf16* YAB) {
    const int wid = __builtin_amdgcn_readfirstlane(tid >> 6), lane = tid & 63, q = lane >> 4, c16 = lane & 15;
    LAS bf16* QH = (LAS bf16*)(lds);
    LAS bf16* QT = (LAS bf16*)(lds + 17408);
    LAS bf16* KH = (LAS bf16*)(lds + 34816);
    LAS bf16* VT = (LAS bf16*)(lds + 52224);
    LAS bf16* STL = (LAS bf16*)(lds + 70656);
    LAS bf16* PM = (LAS bf16*)(lds + 105472);
    LAS float* TOT = (LAS float*)(lds + 114688);
    LAS float* SQ = (LAS float*)(lds + 116736);
    const int k = tid & 127, qt = tid >> 7;
    for (int u = cu; u < 2048; u += G) {
        const int bh = u >> 6, c = u & 63, b = bh >> 3, h = bh & 7; const int tc = b * SEQ + c * 64, t0 = tc + 16 * qt;
        float cs[16], lf[16], qv[16]; unsigned vv[16];
#pragma unroll
        for (int i = 0; i < 16; ++i) { lf[i] = LOGF[(size_t)(t0 + i) * 1024 + h * 128 + k]; const bf16* pr = PROJ + (size_t)(t0 + i) * ABIN + h * 128 + k; qv[i] = bf2f(pr[2048]); vv[i] = pr[4096]; }
        cs[0] = lf[0];
#pragma unroll
        for (int i = 1; i < 16; ++i) cs[i] = cs[i - 1] + lf[i];
        TOT[qt * 128 + k] = cs[15];
#pragma unroll
        for (int i = 0; i < 4; ++i) { const int p = tid + NTHR * i, r = p >> 4, pc = p & 15; *(LAS u32x4*)(STL + r * LP + pc * 8) = *(const u32x4*)(HST + (size_t)u * 16384 + r * 128 + pc * 8); }
        WG_SYNC();
        float pre = 0.f;
#pragma unroll
        for (int qq = 0; qq < 4; ++qq) { const float t = TOT[qq * 128 + k]; if (qq < qt) pre += t; }
        const float ref = TOT[k] + TOT[128 + k];
        unsigned vw[8];
#pragma unroll
        for (int i = 0; i < 16; ++i) { const float cum = pre + cs[i], kk = 1.f - __expf(lf[i]);
            QT[(16 * qt + i) * LP + k] = (bf16)f2bf(qv[i] * __expf(cum));
            QH[(16 * qt + i) * LP + k] = (bf16)f2bf(qv[i] * __expf(fminf(cum - ref, 80.f)));
            KH[(16 * qt + i) * LP + k] = (bf16)f2bf(kk * __expf(fminf(ref - cum, 80.f))); }
#pragma unroll
        for (int i = 0; i < 8; ++i) vw[i] = vv[2 * i] | (vv[2 * i + 1] << 16);
        *(LAS u32x4*)(VT + k * LP64 + 16 * qt) = (u32x4){vw[0], vw[1], vw[2], vw[3]}; *(LAS u32x4*)(VT + k * LP64 + 16 * qt + 8) = (u32x4){vw[4], vw[5], vw[6], vw[7]};
        WG_SYNC();
        {
            const int tb = wid & 3;
            bf16x8 qf[4];
#pragma unroll
            for (int ks = 0; ks < 4; ++ks) qf[ks] = lds_frag(QH, 16 * tb + c16, LP, 32 * ks + 8 * q);
#pragma unroll
            for (int sbi = 0; sbi < 2; ++sbi) { const int sb = 2 * (wid >> 2) + sbi; f32x4 acc = (f32x4){0.f, 0.f, 0.f, 0.f};
#pragma unroll
                for (int ks = 0; ks < 4; ++ks) acc = MFMA16(lds_frag(KH, 16 * sb + c16, LP, 32 * ks + 8 * q), qf[ks], acc);
                const int t = 16 * tb + c16, s0 = 16 * sb + 4 * q;
#pragma unroll
                for (int r = 0; r < 4; ++r) acc[r] = (s0 + r <= t) ? acc[r] : 0.f;
                *(LAS u32x2*)(PM + t * LP64 + s0) = pack4(acc); }
        }
        WG_SYNC();
        {
            const int tb = wid & 3, vh = wid >> 2, t = 16 * tb + c16;
            bf16x8 qf[4], pf[2];
#pragma unroll
            for (int ks = 0; ks < 4; ++ks) qf[ks] = lds_frag(QT, t, LP, 32 * ks + 8 * q);
#pragma unroll
            for (int ks = 0; ks < 2; ++ks) pf[ks] = lds_frag(PM, t, LP64, 32 * ks + 8 * q);
            f32x4 acc[4]; float sq = 0.f;
#pragma unroll
            for (int vb = 0; vb < 4; ++vb) { const int vr = 64 * vh + 16 * vb + c16; acc[vb] = (f32x4){0.f, 0.f, 0.f, 0.f};
#pragma unroll
                for (int ks = 0; ks < 4; ++ks) acc[vb] = MFMA16(lds_frag(STL, vr, LP, 32 * ks + 8 * q), qf[ks], acc[vb]);
#pragma unroll
                for (int ks = 0; ks < 2; ++ks) acc[vb] = MFMA16(lds_frag(VT, vr, LP64, 32 * ks + 8 * q), pf[ks], acc[vb]);
                sq += (acc[vb][0] * acc[vb][0] + acc[vb][1] * acc[vb][1]) + (acc[vb][2] * acc[vb][2] + acc[vb][3] * acc[vb][3]); }
            sq += __shfl_xor(sq, 16); sq += __shfl_xor(sq, 32);
            if (q == 0) SQ[vh * 64 + t] = sq;
            WG_SYNC();
            const float rstd = rsqrtf((SQ[t] + SQ[64 + t]) * (1.0f / 128.f) + EPS);
#pragma unroll
            for (int vb = 0; vb < 4; ++vb) { const int v0 = 64 * vh + 16 * vb + 4 * q; const f32x4 hn = *(const f32x4*)(hnorm + h * 128 + v0);
                const u32x2 gw = *(const u32x2*)(PROJ + (size_t)(tc + t) * ABIN + 5120 + h * 128 + v0);
                f32x4 y; y[0] = acc[vb][0] * rstd * hn[0] * bflo(gw.x); y[1] = acc[vb][1] * rstd * hn[1] * bfhi(gw.x); y[2] = acc[vb][2] * rstd * hn[2] * bflo(gw.y); y[3] = acc[vb][3] * rstd * hn[3] * bfhi(gw.y);
                *(u32x2*)(YAB + (size_t)(tc + t) * D + 1024 + h * 128 + v0) = pack4(y); }
        }
        WG_SYNC();
    }
}
__device__ __forceinline__ void ssd_prep_units(const int tid, LAS unsigned char* lds, int ufirst, int ustride, int uend, const bf16* XBC, const float* cw, const float* cb, bf16* XBT, bf16* BCN) {
    LAS bf16* T = (LAS bf16*)(lds);
    const int ch8 = tid & 15, tr = tid >> 4;
    for (int u = ufirst; u < uend; u += ustride) {
        const int bc = u / 48, cblk = u % 48, c = bc & 31; const int t0 = bc * 128; const int ch0 = cblk * 128 + ch8 * 8;
        u32x4 rows[7];
#pragma unroll
        for (int i = 0; i < 7; ++i) { const int s = 4 * tr + i - 3; rows[i] = (u32x4){0u, 0u, 0u, 0u}; if (c > 0 || s >= 0) rows[i] = *(const u32x4*)(XBC + (size_t)(t0 + s) * SSDCONV + ch0); }
        float w[4][8], bb[8];
        { const f32x4 b0 = *(const f32x4*)(cb + ch0), b1 = *(const f32x4*)(cb + ch0 + 4);
#pragma unroll
          for (int e = 0; e < 4; ++e) { bb[e] = b0[e]; bb[4 + e] = b1[e]; }
#pragma unroll
          for (int k = 0; k < 4; ++k) { const f32x4 w0 = *(const f32x4*)(cw + (size_t)k * SSDCONV + ch0), w1 = *(const f32x4*)(cw + (size_t)k * SSDCONV + ch0 + 4);
#pragma unroll
              for (int e = 0; e < 4; ++e) { w[k][e] = w0[e]; w[k][4 + e] = w1[e]; } } }
#pragma unroll
        for (int i = 0; i < 4; ++i) { float o[8];
#pragma unroll
            for (int e = 0; e < 8; ++e) { float a = bb[e];
#pragma unroll
                for (int k = 0; k < 4; ++k) { const unsigned wd = rows[i + k][e >> 1]; a += w[k][e] * ((e & 1) ? bfhi(wd) : bflo(wd)); }
                o[e] = siluf(a); }
            u32x4 pk; pk.x = cvt_pk_bf16(o[0], o[1]); pk.y = cvt_pk_bf16(o[2], o[3]); pk.z = cvt_pk_bf16(o[4], o[5]); pk.w = cvt_pk_bf16(o[6], o[7]);
            if (cblk >= 32) *(u32x4*)(BCN + (size_t)(t0 + 4 * tr + i) * 2048 + (ch0 - 4096)) = pk;
            if (cblk < 40) {
#pragma unroll
                for (int e = 0; e < 8; ++e) T[(ch8 * 8 + e) * LP + 4 * tr + i] = (bf16)(((e & 1) ? (pk[e >> 1] >> 16) : pk[e >> 1]) & 0xffffu); } }
        if (cblk < 40) {
            WG_SYNC();
#pragma unroll
            for (int i = 0; i < 4; ++i) { const int p = tid + NTHR * i, r = p >> 4, pc = p & 15;
                *(u32x4*)(XBT + ((size_t)bc * 5120 + cblk * 128 + r) * 128 + pc * 8) = *(const LAS u32x4*)(T + r * LP + pc * 8); }
            WG_SYNC();
        }
    }
}
__device__ __forceinline__ float ssd_tables(const float* DT, const float* a_log, int t0, int hd, int wid, int lane, LAS float* CUM, LAS float* DTS) {
    const float an = -__expf(a_log[hd]);
    const float d0 = DT[(size_t)(t0 + 2 * lane) * 64 + hd], d1 = DT[(size_t)(t0 + 2 * lane + 1) * 64 + hd];
    const float a0 = d0 * an, a1 = d1 * an; float v = a0 + a1;
#pragma unroll
    for (int o = 1; o < 64; o <<= 1) { const float t = __shfl_up(v, o); if (lane >= o) v += t; }
    CUM[wid * 128 + 2 * lane] = v - a1; CUM[wid * 128 + 2 * lane + 1] = v; DTS[wid * 128 + 2 * lane] = d0; DTS[wid * 128 + 2 * lane + 1] = d1;
    return __shfl(v, 63);
}
__device__ __forceinline__ void ssd1_units(const int tid, LAS unsigned char* lds, int G, int cu, const bf16* XBT, const float* DT, const float* a_log, bf16* ST, float* DEC) {
    const int wid = __builtin_amdgcn_readfirstlane(tid >> 6), lane = tid & 63, q = lane >> 4, c16 = lane & 15;
    LAS bf16* BT = (LAS bf16*)(lds);
    LAS float* CUM = (LAS float*)(lds + 34816);
    LAS float* DTS = (LAS float*)(lds + 38912);
    for (int u = cu; u < 1024; u += G) {
        const int bc = u >> 3, g = u & 7, t0 = bc * 128, hd = g * 8 + wid;
#pragma unroll
        for (int i = 0; i < 4; ++i) { const int p = tid + NTHR * i, r = p >> 4, pc = p & 15;
            *(LAS u32x4*)(BT + r * LP + pc * 8) = *(const u32x4*)(XBT + ((size_t)bc * 5120 + 4096 + g * 128 + r) * 128 + pc * 8); }
        const float last = ssd_tables(DT, a_log, t0, hd, wid, lane, CUM, DTS);
        if (lane == 0) DEC[bc * 64 + hd] = __expf(last);
        u32x4 xr[4][4];
#pragma unroll
        for (int pb = 0; pb < 4; ++pb)
#pragma unroll
            for (int ks = 0; ks < 4; ++ks) xr[pb][ks] = *(const u32x4*)(XBT + ((size_t)bc * 5120 + hd * 64 + 16 * pb + c16) * 128 + 32 * ks + 8 * q);
        WG_SYNC();
        bf16x8 xf[4][4];
#pragma unroll
        for (int ks = 0; ks < 4; ++ks) { float sc[8];
#pragma unroll
            for (int j = 0; j < 8; ++j) { const int s = 32 * ks + 8 * q + j; sc[j] = DTS[wid * 128 + s] * __expf(last - CUM[wid * 128 + s]); }
#pragma unroll
            for (int pb = 0; pb < 4; ++pb) { u32x4 o;
#pragma unroll
                for (int e = 0; e < 4; ++e) o[e] = cvt_pk_bf16(bflo(xr[pb][ks][e]) * sc[2 * e], bfhi(xr[pb][ks][e]) * sc[2 * e + 1]);
                xf[pb][ks] = __builtin_bit_cast(bf16x8, o); } }
#pragma unroll
        for (int nb = 0; nb < 8; ++nb) { bf16x8 bf[4];
#pragma unroll
            for (int ks = 0; ks < 4; ++ks) bf[ks] = lds_frag(BT, 16 * nb + c16, LP, 32 * ks + 8 * q);
#pragma unroll
            for (int pb = 0; pb < 4; ++pb) { f32x4 acc = (f32x4){0.f, 0.f, 0.f, 0.f};
#pragma unroll
                for (int ks = 0; ks < 4; ++ks) acc = MFMA16(bf[ks], xf[pb][ks], acc);
                *(u32x2*)(ST + (((size_t)bc * 64 + hd) * 64 + 16 * pb + c16) * 128 + 16 * nb + 4 * q) = pack4(acc); } }
        WG_SYNC();
    }
}
__device__ __forceinline__ void ssd2_scan(const int tid, int G, int cu, bf16* ST, const float* DEC) {
    for (int task = cu * NTHR + tid; task < NB * 4096 * 32; task += G * NTHR) {
        const int b = task >> 17, r = task & 131071, hp = r >> 5, n4 = (r & 31) * 4, hd = hp >> 6; f32x4 S = (f32x4){0.f, 0.f, 0.f, 0.f};
#pragma unroll 8
        for (int c = 0; c < 32; ++c) { const int bc = b * 32 + c; bf16* p = ST + ((size_t)bc * 4096 + hp) * 128 + n4; const u32x2 L = *(const u32x2*)p; const float d = DEC[bc * 64 + hd];
            *(u32x2*)p = pack4(S);
            S[0] = d * S[0] + bflo(L.x); S[1] = d * S[1] + bfhi(L.x); S[2] = d * S[2] + bflo(L.y); S[3] = d * S[3] + bfhi(L.y); }
    }
}
__device__ __forceinline__ void ssd3_units(const int tid, LAS unsigned char* lds, int G, int cu, const bf16* XBT, const bf16* BCN, const bf16* ST, const float* DT, const float* a_log, const float* dskip,
                                           const bf16* Z, const float* normw, bf16* Y) {
    const int wid = __builtin_amdgcn_readfirstlane(tid >> 6), lane = tid & 63, q = lane >> 4, c16 = lane & 15;
    LAS bf16* CN = (LAS bf16*)(lds);
    LAS bf16* BN = (LAS bf16*)(lds + 34816);
    LAS bf16* CB = (LAS bf16*)(lds + 69632);
    LAS bf16* XTh = (LAS bf16*)(lds + 104448);
    LAS bf16* STh = (LAS bf16*)(lds + 121856);
    LAS float* CUM = (LAS float*)(lds + 139264);
    LAS float* DTS = (LAS float*)(lds + 143360);
    for (int u = cu; u < 1024; u += G) {
        const int bc = u >> 3, g = u & 7, t0 = bc * 128;
#pragma unroll
        for (int i = 0; i < 4; ++i) { const int p = tid + NTHR * i, r = p >> 4, pc = p & 15; const bf16* src = BCN + (size_t)(t0 + r) * 2048 + g * 128 + pc * 8;
            *(LAS u32x4*)(BN + r * LP + pc * 8) = *(const u32x4*)src; *(LAS u32x4*)(CN + r * LP + pc * 8) = *(const u32x4*)(src + 1024); }
        (void)ssd_tables(DT, a_log, t0, g * 8 + wid, wid, lane, CUM, DTS);
        WG_SYNC();
        {
            bf16x8 cf[4];
#pragma unroll
            for (int ks = 0; ks < 4; ++ks) cf[ks] = lds_frag(CN, 16 * wid + c16, LP, 32 * ks + 8 * q);
#pragma unroll
            for (int sb = 0; sb < 8; ++sb) { if (sb > wid + 1) continue; f32x4 acc = (f32x4){0.f, 0.f, 0.f, 0.f};
#pragma unroll
                for (int ks = 0; ks < 4; ++ks) acc = MFMA16(lds_frag(BN, 16 * sb + c16, LP, 32 * ks + 8 * q), cf[ks], acc);
                *(LAS u32x2*)(CB + (16 * wid + c16) * LP + 16 * sb + 4 * q) = pack4(acc); }
        }
        const int tl = 16 * wid + c16;
        float sq = 0.f;
        bf16* yrow = Y + (size_t)(t0 + tl) * SSDIN + g * 512 + 4 * q;
        const int nks = (16 * wid + 15) / 32 + 1;
#pragma unroll 1
        for (int h = 0; h < 8; ++h) {
            const int hd = g * 8 + h;
            WG_SYNC();
#pragma unroll
            for (int i = 0; i < 2; ++i) { const int p = tid + NTHR * i, r = p >> 4, pc = p & 15;
                *(LAS u32x4*)(XTh + r * LP + pc * 8) = *(const u32x4*)(XBT + ((size_t)bc * 5120 + hd * 64 + r) * 128 + pc * 8);
                *(LAS u32x4*)(STh + r * LP + pc * 8) = *(const u32x4*)(ST + (((size_t)bc * 64 + hd) * 64 + r) * 128 + pc * 8); }
            WG_SYNC();
            const float cumt = CUM[h * 128 + tl], ect = __expf(cumt), dsk = dskip[hd];
            f32x4 acc[4];
            {
                bf16x8 cf[4];
#pragma unroll
                for (int ks = 0; ks < 4; ++ks) cf[ks] = lds_frag(CN, tl, LP, 32 * ks + 8 * q);
#pragma unroll
                for (int pb = 0; pb < 4; ++pb) { acc[pb] = (f32x4){0.f, 0.f, 0.f, 0.f};
#pragma unroll
                    for (int ks = 0; ks < 4; ++ks) acc[pb] = MFMA16(lds_frag(STh, 16 * pb + c16, LP, 32 * ks + 8 * q), cf[ks], acc[pb]);
                    acc[pb] = acc[pb] * ect; }
            }
            for (int ks = 0; ks < nks; ++ks) {
                const int s0 = 32 * ks + 8 * q; const u32x4 cbw = *(const LAS u32x4*)(CB + tl * LP + s0);
                const f32x4 c0 = *(const LAS f32x4*)(CUM + h * 128 + s0), c1 = *(const LAS f32x4*)(CUM + h * 128 + s0 + 4), d0 = *(const LAS f32x4*)(DTS + h * 128 + s0), d1 = *(const LAS f32x4*)(DTS + h * 128 + s0 + 4);
                float gv[8];
#pragma unroll
                for (int j = 0; j < 8; ++j) { const int s = s0 + j; const float cb = (j & 1) ? bfhi(cbw[j >> 1]) : bflo(cbw[j >> 1]); const float cs = j < 4 ? c0[j & 3] : c1[j & 3], ds = j < 4 ? d0[j & 3] : d1[j & 3];
                    float v = cb * __expf(fminf(cumt - cs, 0.f)) * ds; v = (s <= tl) ? v : 0.f; gv[j] = (s == tl) ? v + dsk : v; }
                u32x4 gw; gw.x = cvt_pk_bf16(gv[0], gv[1]); gw.y = cvt_pk_bf16(gv[2], gv[3]); gw.z = cvt_pk_bf16(gv[4], gv[5]); gw.w = cvt_pk_bf16(gv[6], gv[7]);
                const bf16x8 gf = __builtin_bit_cast(bf16x8, gw);
#pragma unroll
                for (int pb = 0; pb < 4; ++pb) acc[pb] = MFMA16(lds_frag(XTh, 16 * pb + c16, LP, s0), gf, acc[pb]);
            }
#pragma unroll
            for (int pb = 0; pb < 4; ++pb) { const u32x2 zw = *(const u32x2*)(Z + (size_t)(t0 + tl) * SSDIN + hd * 64 + 16 * pb + 4 * q);
                f32x4 y; y[0] = acc[pb][0] * bflo(zw.x); y[1] = acc[pb][1] * bfhi(zw.x); y[2] = acc[pb][2] * bflo(zw.y); y[3] = acc[pb][3] * bfhi(zw.y);
                sq += (y[0] * y[0] + y[1] * y[1]) + (y[2] * y[2] + y[3] * y[3]); *(u32x2*)(yrow + h * 64 + 16 * pb) = pack4(y); }
        }
        sq += __shfl_xor(sq, 16); sq += __shfl_xor(sq, 32);
        const float rstd = rsqrtf(sq * (1.0f / 512.f) + EPS);
        VM_WAIT();
#pragma unroll 1
        for (int h = 0; h < 8; ++h)
#pragma unroll
            for (int pb = 0; pb < 4; ++pb) { const int ch = (g * 8 + h) * 64 + 16 * pb + 4 * q; const f32x4 nw = *(const f32x4*)(normw + ch); bf16* yp = yrow + h * 64 + 16 * pb;
                const u32x2 w = *(const volatile u32x2*)yp;
                f32x4 y; y[0] = bflo(w.x) * rstd * nw[0]; y[1] = bfhi(w.x) * rstd * nw[1]; y[2] = bflo(w.y) * rstd * nw[2]; y[3] = bfhi(w.y) * rstd * nw[3];
                *(u32x2*)yp = pack4(y); }
        WG_SYNC();
    }
}
struct Args { In in; float* out; unsigned char* ws; int ph_lo, ph_hi; };
static_assert(sizeof(Args) == 32 * 8 + 8 + 8 + 8, "Args has no padding");
typedef const Args __attribute__((address_space(4))) CArgs;

#define PHASE_BEGIN if (pc >= lo && pc < hi) { int tid = wave0 * 64 + (int)__builtin_amdgcn_mbcnt_hi(~0u, __builtin_amdgcn_mbcnt_lo(~0u, 0u)); asm volatile("" : "+v"(tid)); int cu = blockIdx.x; asm volatile("" : "+s"(cu)); int G = gridDim.x; asm volatile("" : "+s"(G)); \
        const int lane = tid & 63, wave = __builtin_amdgcn_readfirstlane(tid >> 6), gw = cu * NWAVES + wave, NGW = G * NWAVES; (void)lane; (void)gw; (void)NGW; \
        CArgs* ap = (CArgs*)__builtin_amdgcn_kernarg_segment_ptr(); asm volatile("" : "+s"(ap)); CIn& I = ap->in; unsigned char* const ws = ap->ws; float* const xres = ap->out; \
        unsigned char* const act = ws + WS_ACT; float* const SS = (float*)(ws + WS_SS); bf16* const XB = (bf16*)(ws + WS_XB); bf16* const WL = (bf16*)(ws + WS_WL); (void)I; (void)xres; (void)act; (void)SS; (void)XB; (void)WL;
#if MK_SPLIT
#define PHASE_END } ++pc;
#else
#define PHASE_END if (pc + 1 < hi) xcd_barrier(bar); } ++pc;
#endif
#define D_WKV ((bf16*)(ws + WS_WKV))
#define D_KMAT ((bf16*)(ws + WS_KMAT))
#define D_VT ((bf16*)(ws + WS_VT))
#define D_MEMN ((bf16*)(ws + WS_MEMN))
#define D_LB ((float*)(ws + WS_TAB + TAB_LB))
#define D_WRT ((bf16*)(ws + WS_TAB + TAB_WRT))


template <int l>
__device__ __forceinline__ void layer_body(LAS unsigned char* lds, const int wave0, const int lo, const int hi, int& pc, const XcdBarrier& bar) {
    int ssi = 3 * l;

        if (l > 0) {
            PHASE_BEGIN
                convert_layer(I, l, WL, (LAS float*)(lds + wave * 16384), gw, NGW, lane);
            PHASE_END
        }
        const int e = l >> 1;
        int mixK;
        if ((l & 1) == 0) {
#define PROJ ((bf16*)(act + A_PROJ))
#define LOGF ((float*)(act + A_LOGF))
#define HST ((bf16*)(act + A_HST))
#define YAB ((bf16*)(act + A_YAB))
#define SEG ((float*)(act + A_SEG))
#define HDEC ((float*)(act + A_HDEC))
            PHASE_BEGIN
                pg8::SchedMN S; S.init(XB, D, WL + WL_IN, D, M, ABIN, G, cu); pg8::EpiProjEven E{SS + (size_t)ssi * M * 8, PROJ, LOGF, D_LB + e * 1024};
                pg8::gemm_phase(tid, lds, D, D, D, S, E);
            PHASE_END
            PHASE_BEGIN
                lru_units<false>(tid, lds, G, cu, PROJ, D_WRT + (size_t)e * 2 * 8 * 16384, I.lru_conv_w + e * 4 * LRUW, I.lru_conv_b + e * LRUW, I.lru_b_r + e * LRUW, I.lru_b_i + e * LRUW, I.lru_lambda + e * LRUW, SEG, YAB);
                hgrn1_units(tid, lds, G, cu, LOGF, PROJ, HST, HDEC);
            PHASE_END
            PHASE_BEGIN
                lru_units<true>(tid, lds, G, cu, PROJ, D_WRT + (size_t)e * 2 * 8 * 16384, I.lru_conv_w + e * 4 * LRUW, I.lru_conv_b + e * LRUW, I.lru_b_r + e * LRUW, I.lru_b_i + e * LRUW, I.lru_lambda + e * LRUW, SEG, YAB);
                hgrn2_scan(tid, G, cu, HST, HDEC);
            PHASE_END
            PHASE_BEGIN
                hgrn3_units(tid, lds, G, cu, LOGF, PROJ, HST, I.hgrn_norm + e * 1024, YAB);
            PHASE_END
            mixK = D;
        } else {
#define Zb ((bf16*)(act + A_Z))
#define XBC ((bf16*)(act + A_XBC))
#define XBT ((bf16*)(act + A_XBT))
#define BCN ((bf16*)(act + A_BCN))
#define STb ((bf16*)(act + A_ST))
#define DTb ((float*)(act + A_DT))
#define DEC ((float*)(act + A_DEC))
#define Yb ((bf16*)(act + A_Y))
            PHASE_BEGIN
                pg8::SchedMN S; S.init(XB, D, WL + WL_IN, D, M, SSDN1, G, cu); pg8::EpiProjOdd E{SS + (size_t)ssi * M * 8, Zb, XBC};
                pg8::gemm_phase(tid, lds, D, D, D, S, E);
            PHASE_END
            PHASE_BEGIN
                { pg8::SchedDt S{(const char*)XB, (const char*)(WL + WL_DT), cu}; pg8::EpiDt E{SS + (size_t)ssi * M * 8, I.ssd_dt_bias + e * 64, DTb};
                  pg8::gemm_phase(tid, lds, D, D, D, S, E); }
                { int uf = cu, us = G, ue = 6144; if (G == 256) { if (cu < 64) { us = 64; ue = 1152; } else { uf = 1152 + (cu - 64); us = 192; } }
                  ssd_prep_units(tid, lds, uf, us, ue, XBC, I.ssd_conv_w + (size_t)e * 4 * SSDCONV, I.ssd_conv_b + e * SSDCONV, XBT, BCN); }
            PHASE_END
            PHASE_BEGIN
                ssd1_units(tid, lds, G, cu, XBT, DTb, I.ssd_a_log + e * 64, STb, DEC);
            PHASE_END
            PHASE_BEGIN
                ssd2_scan(tid, G, cu, STb, DEC);
            PHASE_END
            PHASE_BEGIN
                ssd3_units(tid, lds, G, cu, XBT, BCN, STb, DTb, I.ssd_a_log + e * 64, I.ssd_d + e * 64, Zb, I.ssd_norm + e * SSDIN, Yb);
            PHASE_END
            mixK = SSDIN;
        }
        PHASE_BEGIN
            pg8::SchedMN S; S.init(mixK == D ? (const bf16*)YAB : (const bf16*)Yb, mixK, WL + WL_OUT, mixK, M, D, G, cu); pg8::EpiResid E{xres, XB, SS + (size_t)(ssi + 1) * M * 8, (LAS float*)(lds + EPI_OFF)};
            pg8::gemm_phase(tid, lds, mixK, mixK, mixK, S, E);
        PHASE_END
        ++ssi;
#define Qb ((bf16*)(act + A_Q))
#define Pb ((bf16*)(act + A_P))
#define Ob ((bf16*)(act + A_O))
#define Hb ((bf16*)(act + A_H))
        PHASE_BEGIN
            pg8::SchedMN S; S.init(XB, D, WL + WL_Q, D, M, D, G, cu); pg8::EpiQ E{SS + (size_t)ssi * M * 8, Qb, 0.044194173824159216f};
            pg8::gemm_phase(tid, lds, D, D, D, S, E);
        PHASE_END
        PHASE_BEGIN
            pg8::SchedS S{(const char*)Qb, (const char*)(D_KMAT + (size_t)l * MEMROWS * D), G, cu}; pg8::EpiSoftmax E{Pb, (LAS float*)(lds + EPI_OFF)};
            pg8::gemm_phase(tid, lds, XAD, D, D, S, E);
        PHASE_END
        PHASE_BEGIN
            pg8::SchedPV S{(const char*)Pb, (const char*)(D_VT + (size_t)l * D * MEMROWS), G, cu}; pg8::EpiPlain E{Ob, D};
            pg8::gemm_phase(tid, lds, MEMLEN, 1024, MEMROWS, S, E);
        PHASE_END
        PHASE_BEGIN
            pg8::SchedMN S; S.init(Ob, D, WL + WL_O, D, M, D, G, cu); pg8::EpiResid E{xres, XB, SS + (size_t)(ssi + 1) * M * 8, (LAS float*)(lds + EPI_OFF)};
            pg8::gemm_phase(tid, lds, D, D, D, S, E);
        PHASE_END
        ++ssi;
        PHASE_BEGIN
            pg8::SchedMN S; S.init(XB, D, WL + WL_GU, D, M, 2 * FF, G, cu); pg8::EpiGateUp E{SS + (size_t)ssi * M * 8, Hb};
            pg8::gemm_phase(tid, lds, D, D, D, S, E);
        PHASE_END
        PHASE_BEGIN
            pg8::SchedMN S; S.init(Hb, FF, WL + WL_DN, FF, M, D, G, cu); pg8::EpiResid E{xres, XB, SS + (size_t)(ssi + 1) * M * 8, (LAS float*)(lds + EPI_OFF)};
            pg8::gemm_phase(tid, lds, FF, FF, FF, S, E);
        PHASE_END
        ++ssi;
    }

__global__ void __launch_bounds__(NTHR, 2) fwd(Args args) {
    extern __shared__ __attribute__((aligned(16))) unsigned char lds_raw[];
    LAS unsigned char* lds = (LAS unsigned char*)lds_raw;
    volatile LAS unsigned* MISC = (volatile LAS unsigned*)(lds + MISC_OFF);
    const int wave0 = __builtin_amdgcn_readfirstlane((int)threadIdx.x >> 6);
    if (threadIdx.x < 64) MISC[threadIdx.x] = 0u;
    __syncthreads();
#if !MK_SPLIT
    XcdBarrier bar = xcd_barrier_post((unsigned*)(args.ws + WS_CTL), MISC + 8);
#else
    XcdBarrier bar; bar.bar = nullptr; bar.x = 0; bar.st = nullptr;
#endif
    const int lo = args.ph_lo, hi = args.ph_hi; int pc = 0;
    PHASE_BEGIN
        LAS float* scr = (LAS float*)(lds + wave * 16384);
        for (int l = 0; l < DEPTH; ++l) conv_matrix<0>(I.xa_w_kv + (size_t)l * D * 4096, 4096, D, 0, 4096, nullptr, D_WKV + (size_t)l * 4096 * D, 0, scr, gw, NGW, lane);
        convert_layer(I, 0, WL, scr, gw, NGW, lane);
        for (int m = gw; m < MEMROWS; m += NGW) {
            const f32x4* xr = (const f32x4*)(I.mem + (size_t)m * D); f32x4 v[8]; float s = 0.f;
#pragma unroll
            for (int j = 0; j < 8; ++j) { v[j] = xr[64 * j + lane]; s += (v[j][0] * v[j][0] + v[j][1] * v[j][1]) + (v[j][2] * v[j][2] + v[j][3] * v[j][3]); }
            const float rs = rsqrtf(wave_sum(s) * (1.0f / D) + EPS);
#pragma unroll
            for (int j = 0; j < 8; ++j) { const f32x4 g = *(const f32x4*)(I.norm_mem + (64 * j + lane) * 4); *(u32x2*)(D_MEMN + (size_t)m * D + (64 * j + lane) * 4) = pack4(v[j] * rs * g); }
        }
        for (int m = gw; m < M; m += NGW) {
            const f32x4* xr = (const f32x4*)(I.x + (size_t)m * D); f32x4* orow = (f32x4*)(xres + (size_t)m * D); float s = 0.f;
#pragma unroll
            for (int j = 0; j < 8; ++j) { const f32x4 v = xr[64 * j + lane]; s += (v[0] * v[0] + v[1] * v[1]) + (v[2] * v[2] + v[3] * v[3]); orow[64 * j + lane] = v; *(u32x2*)(XB + (size_t)m * D + (64 * j + lane) * 4) = pack4(v); }
            s = wave_sum(s); if (lane < 8) SS[(size_t)m * 8 + lane] = lane == 0 ? s : 0.f;
        }
        for (int i = cu * NTHR + tid; i < 1024; i += G * NTHR) {
            const float a = I.hgrn_lb[i], b = I.hgrn_lb[1024 + i], mx = fmaxf(a, b), e0 = __expf(a - mx), e1 = __expf(b - mx); D_LB[i] = 0.f; D_LB[1024 + i] = e1 / (e0 + e1); }
        for (int i = cu * NTHR + tid; i < 2 * 2 * 8 * 16384; i += G * NTHR) {
            const int ii = i & 127, jj = (i >> 7) & 127, blk = (i >> 14) & 7, gt = (i >> 17) & 1, e = i >> 18;
            const float* src = gt ? I.lru_w_i : I.lru_w_r; D_WRT[i] = (bf16)f2bf(src[((size_t)(e * 8 + blk) * 128 + ii) * 128 + jj]); }
    PHASE_END

    PHASE_BEGIN
        pg8::SchedKV S{(const char*)D_MEMN, (const char*)D_WKV, G, cu}; pg8::EpiKV E{D_KMAT, D_VT};
        pg8::gemm_phase(tid, lds, D, D, D, S, E);
    PHASE_END

    layer_body<0>(lds, wave0, lo, hi, pc, bar); layer_body<1>(lds, wave0, lo, hi, pc, bar); layer_body<2>(lds, wave0, lo, hi, pc, bar); layer_body<3>(lds, wave0, lo, hi, pc, bar);
    const int ssi = 12;
    PHASE_BEGIN
        const float* ssf = SS + (size_t)ssi * M * 8;
        for (int m = gw; m < M; m += NGW) { f32x4* row = (f32x4*)(xres + (size_t)m * D); const float rs = pg8::rstd_of(ssf, m);
#pragma unroll
            for (int j = 0; j < 8; ++j) { const f32x4 g = *(const f32x4*)(I.norm_final + (64 * j + lane) * 4); row[64 * j + lane] = row[64 * j + lane] * rs * g; } }
    PHASE_END
#undef PHASE_BEGIN
#undef PHASE_END
}

constexpr int NPHASES = 2 + (5 + 6) + (1 + 6 + 6) + (1 + 5 + 6) + (1 + 6 + 6) + 1;

extern "C" void kernel_launch(void* const* d_in, const int* in_sizes, int n_in, void* d_out, int out_size, void* d_ws, size_t ws_size, hipStream_t stream) {
    static int grid = 0;
    if (grid == 0) {
        if (n_in != 32 || out_size != M * D || ws_size < WS_END) { fprintf(stderr, "kernel_launch: unexpected problem (n_in %d, out %d, ws %zu)\n", n_in, out_size, ws_size); grid = -1; return; }
        int dev = 0, cus = 0;
        if (hipGetDevice(&dev) != hipSuccess || hipDeviceGetAttribute(&cus, hipDeviceAttributeMultiprocessorCount, dev) != hipSuccess) { grid = -1; return; }
        if (hipFuncSetAttribute((const void*)fwd, hipFuncAttributeMaxDynamicSharedMemorySize, LDS_BYTES) != hipSuccess) { fprintf(stderr, "kernel_launch: hipFuncSetAttribute failed\n"); grid = -1; return; }
        int per_cu = 0;
        if (hipOccupancyMaxActiveBlocksPerMultiprocessor(&per_cu, (const void*)fwd, NTHR, LDS_BYTES) != hipSuccess || per_cu < 1) fprintf(stderr, "kernel_launch: occupancy query says %d\n", per_cu);
        (void)hipGetLastError();
        grid = cus;
    }
    if (grid < 0) return;
    (void)hipMemsetAsync((char*)d_ws + WS_CTL, 0, CTL_ZERO_BYTES, stream);
    Args a{};
    const float** ip = (const float**)&a.in;
    for (int i = 0; i < 32; ++i) ip[i] = (const float*)d_in[i];
    a.out = (float*)d_out; a.ws = (unsigned char*)d_ws;
#if MK_SPLIT
    for (int li = 0; li < NPHASES; ++li) { a.ph_lo = li; a.ph_hi = li + 1; hipLaunchKernelGGL(fwd, dim3(grid), dim3(NTHR), LDS_BYTES, stream, a); }
#else
    a.ph_lo = 0; a.ph_hi = NPHASES;
    hipLaunchKernelGGL(fwd, dim3(grid), dim3(NTHR), LDS_BYTES, stream, a);
#endif
}
```

```cpp
#include <hip/hip_runtime.h>
#include <cstdio>
#include <cstdint>

#ifndef MK_SPLIT
#define MK_SPLIT 0
#endif

#define GAS __attribute__((address_space(1)))
#define LAS __attribute__((address_space(3)))
typedef unsigned short bf16;
typedef short bf16x8 __attribute__((ext_vector_type(8)));
typedef float f32x4 __attribute__((ext_vector_type(4)));
typedef float f32x2 __attribute__((ext_vector_type(2)));
typedef unsigned u32x4 __attribute__((ext_vector_type(4)));
typedef unsigned u32x2 __attribute__((ext_vector_type(2)));

constexpr int D = 2048, NB = 4, SEQ = 4096, M = NB * SEQ, DEPTH = 4, MEMLEN = 256, MEMROWS = NB * MEMLEN;
constexpr int LRUW = 1024, ABIN = 6144;
constexpr int SSDIN = 4096, SSDCONV = 6144, SSDPROJ = 10304, SSDN1 = 10240, NHEADS = 64;
constexpr int XAD = 512, FF = 5632;
constexpr float EPS = 1e-6f;
constexpr int NWAVES = 8, NTHR = 512;

constexpr size_t MiB = 1u << 20;
constexpr size_t WS_CTL = 0, CTL_ZERO_BYTES = 1 * MiB;
constexpr size_t WS_WKV = 2 * MiB;
constexpr size_t WS_KMAT = 66 * MiB;
constexpr size_t WS_VT = 82 * MiB;
constexpr size_t WS_MEMN = 98 * MiB;
constexpr size_t WS_TAB = 102 * MiB;
constexpr size_t WS_XB = 106 * MiB;
constexpr size_t WS_WL = 170 * MiB;
constexpr size_t WS_ACT = 310 * MiB;
constexpr size_t WS_SS = (310 + 680) * MiB;
constexpr size_t WS_END = (310 + 680 + 8) * MiB;
constexpr size_t TAB_LB = 0;
constexpr size_t TAB_WRT = 64 * 1024;
constexpr size_t WL_IN = 0;
constexpr size_t WL_DT = (size_t)SSDN1 * D;
constexpr size_t WL_OUT = (size_t)(SSDN1 + 256) * D;
constexpr size_t WL_Q = WL_OUT + (size_t)D * SSDIN;
constexpr size_t WL_O = WL_Q + (size_t)D * D;
constexpr size_t WL_GU = WL_O + (size_t)D * D;
constexpr size_t WL_DN = WL_GU + (size_t)2 * FF * D;
constexpr size_t WL_ELEMS = WL_DN + (size_t)D * FF;
static_assert(WL_ELEMS * 2 <= 140 * MiB, "per-layer weights");
constexpr size_t A_Z = 0;
constexpr size_t A_XBC = 128 * MiB;
constexpr size_t A_Y = 128 * MiB;
constexpr size_t A_XBT = 320 * MiB;
constexpr size_t A_BCN = 480 * MiB;
constexpr size_t A_ST = 544 * MiB;
constexpr size_t A_DT = 672 * MiB;
constexpr size_t A_DEC = 676 * MiB;
constexpr size_t A_PROJ = 0;
constexpr size_t A_LOGF = 192 * MiB;
constexpr size_t A_HST = 256 * MiB;
constexpr size_t A_YAB = 320 * MiB;
constexpr size_t A_SEG = 384 * MiB;
constexpr size_t A_HDEC = 386 * MiB;
constexpr size_t A_Q = 0;
constexpr size_t A_P = 64 * MiB;
constexpr size_t A_O = 96 * MiB;
constexpr size_t A_H = 160 * MiB;

constexpr int LDS_BYTES = 155648;
constexpr int EPI_OFF = 131072;
constexpr int MISC_OFF = LDS_BYTES - 256;

#define LDS_WAIT() asm volatile("s_waitcnt lgkmcnt(0)" ::: "memory")
#define VM_WAIT() asm volatile("s_waitcnt vmcnt(0)" ::: "memory")
__device__ __forceinline__ unsigned f2bf(float f) { unsigned u = __builtin_bit_cast(unsigned, f); return (u + 0x7fffu + ((u >> 16) & 1u)) >> 16; }
__device__ __forceinline__ unsigned pk2(float lo, float hi) { return f2bf(lo) | (f2bf(hi) << 16); }
typedef __bf16 bf16x2v __attribute__((ext_vector_type(2)));
__device__ __forceinline__ unsigned cvt_pk_bf16(float lo, float hi) { const f32x2 v = {lo, hi}; return __builtin_bit_cast(unsigned, __builtin_convertvector(v, bf16x2v)); }
__device__ __forceinline__ float bflo(unsigned w) { return __uint_as_float(w << 16); }
__device__ __forceinline__ float bfhi(unsigned w) { return __uint_as_float(w & 0xffff0000u); }
__device__ __forceinline__ float bf2f(bf16 b) { return __uint_as_float((unsigned)b << 16); }
__device__ __forceinline__ float sigm(float x) { return 1.f / (1.f + __expf(-x)); }
__device__ __forceinline__ float siluf(float x) { return x * sigm(x); }
__device__ __forceinline__ float gelu_tanh(float x) { return x * sigm(1.5957691216f * (x + 0.044715f * x * x * x)); }
__device__ __forceinline__ float softplusf(float x) { const float e = __expf(-fabsf(x)); const float l = (e < 0.03f) ? e * (1.f - e * (0.5f - e * 0.33333333f)) : __logf(1.f + e); return fmaxf(x, 0.f) + l; }
__device__ __forceinline__ float wave_sum(float v) {
#pragma unroll
    for (int o = 1; o < 64; o <<= 1) v += __shfl_xor(v, o);
    return v;
}

#define XB_TMO      128
#define XB_XCNT(j)  (256  + 64 * (j))
#define XB_XSUB(j)  (1280 + 64 * (j))
#define XB_XGEN(j)  (2304 + 64 * (j))
#define XB_TOP      3328
#define XB_TOPGEN   3392
#define XCD_BAR_WORDS 3456
#define XB_SPIN_CAP (1u << 18)

__device__ __forceinline__ unsigned xb_ld(unsigned* p)              { return __hip_atomic_load(p, __ATOMIC_RELAXED, __HIP_MEMORY_SCOPE_AGENT); }
__device__ __forceinline__ unsigned xb_add(unsigned* p, unsigned v) { return __hip_atomic_fetch_add(p, v, __ATOMIC_RELAXED, __HIP_MEMORY_SCOPE_AGENT); }
__device__ __forceinline__ unsigned xb_xcc_id() { return (unsigned)__builtin_amdgcn_s_getreg((3 << 11) | 20) & 0xFu; }
#define XB_SPIN(cond, bar) do { unsigned _sp = 0; while (cond) { __builtin_amdgcn_s_sleep(1); \
    if ((++_sp & 255u) == 0u) { if (xb_ld(&(bar)[XB_TMO])) break; if (_sp > XB_SPIN_CAP) { atomicAdd(&(bar)[XB_TMO], 1u); break; } } } } while (0)

struct XcdBarrier {
    unsigned* bar; unsigned x;
    volatile LAS unsigned* st;
};
__device__ __forceinline__ XcdBarrier xcd_barrier_post(unsigned* bar, volatile LAS unsigned* st) {
    XcdBarrier b; b.bar = bar; b.x = xb_xcc_id(); b.st = st;
    if (threadIdx.x == 0) (void)xb_add(&bar[XB_XCNT(b.x)], 1u);
    return b;
}
__device__ __forceinline__ void xcd_barrier_complete(unsigned* bar, unsigned x, unsigned& nloc, unsigned& nx) {
    const unsigned G = gridDim.x * gridDim.y * gridDim.z;
    unsigned sum, cnt, mine, sp = 0u;
    for (;;) {
        sum = 0u; cnt = 0u; mine = 0u;
#pragma unroll
        for (unsigned j = 0; j < 16; ++j) { const unsigned c = xb_ld(&bar[XB_XCNT(j)]); sum += c; cnt += (c > 0u) ? 1u : 0u; mine = (j == x) ? c : mine; }
        if (sum == G) break;
        __builtin_amdgcn_s_sleep(1);
        if ((++sp & 255u) == 0u) { if (xb_ld(&bar[XB_TMO])) break; if (sp > XB_SPIN_CAP) { atomicAdd(&bar[XB_TMO], 1u); break; } }
    }
    nloc = mine > 0u ? mine : 1u; nx = cnt > 0u ? cnt : 1u;
}
__device__ __forceinline__ void xcd_barrier(const XcdBarrier& b) {
    asm volatile("s_waitcnt vmcnt(0)" ::: "memory");
    __syncthreads();
    if (threadIdx.x == 0) {
        unsigned* bar = b.bar;
        __builtin_amdgcn_s_waitcnt(0);
        unsigned nloc = b.st[0], nx = b.st[1];
        if (nloc == 0u) { xcd_barrier_complete(bar, b.x, nloc, nx); b.st[0] = nloc; b.st[1] = nx; }
        const unsigned old = xb_add(&bar[XB_XSUB(b.x)], 1u);
        const unsigned gen = old / nloc;
        if (old + 1u == (gen + 1u) * nloc) {
            __builtin_amdgcn_fence(__ATOMIC_RELEASE, "agent");
            asm volatile("s_waitcnt vmcnt(0)" ::: "memory");
            const unsigned og = xb_add(&bar[XB_TOP], 1u);
            const unsigned tg = og / nx;
            if (og + 1u == (tg + 1u) * nx) xb_add(&bar[XB_TOPGEN], 1u);
            else XB_SPIN(xb_ld(&bar[XB_TOPGEN]) == tg, bar);
            __builtin_amdgcn_fence(__ATOMIC_ACQUIRE, "agent");
            xb_add(&bar[XB_XGEN(b.x)], 1u);
            asm volatile("s_waitcnt vmcnt(0)" ::: "memory");
        } else {
            XB_SPIN(xb_ld(&bar[XB_XGEN(b.x)]) == gen, bar);
            __builtin_amdgcn_fence(__ATOMIC_ACQUIRE, "agent");
            asm volatile("s_waitcnt vmcnt(0)" ::: "memory");
        }
    }
    __syncthreads();
}

namespace pg8 {
constexpr int BM = 256, BK = 64, HALF = 128, HTB = HALF * BK * 2, STAGE_BYTES = 8 * HTB, NXCD = 8, WGM = 8;
__host__ __device__ __forceinline__ int lds_byte(int r, int c) { const int st = (r >> 4) * 2 + (c >> 5), rr = r & 15, cc = c & 31, ob = rr * 64 + cc * 2; return st * 1024 + (ob ^ (((ob >> 9) & 1) << 5)); }
__host__ __device__ __forceinline__ void stage_rc(int b, int& R, int& C) { const int st = b / 1024, sb = b % 1024, swz = sb ^ (((sb >> 9) & 1) << 5); R = (st >> 1) * 16 + swz / 64; C = (st & 1) * 32 + (swz % 64) / 2; }
__host__ __device__ __forceinline__ int perm32(int rho) { const int n = rho >> 4, i = rho & 15; return 8 * (i >> 2) + 4 * n + (i & 3); }

struct Unit { const char* a; const char* b; int orow, ocol, aux; };

template <class Epi, class Sched>
__device__ __forceinline__ void gemm_phase(const int tid, LAS unsigned char* lds, const int K, const int lda, const int ldb, const Sched& S, const Epi& E) {
    const int wid = __builtin_amdgcn_readfirstlane(tid >> 6), lane = tid & 63, wr = wid >> 2, wc = wid & 3, fr = lane & 15, fq = lane >> 4;
    const int nt = K / BK;
    unsigned voffA[2], voffB[2];
#pragma unroll
    for (int i = 0; i < 2; ++i) { int R, C; stage_rc(tid * 16 + i * 8192, R, C); const int Rb = (R & ~31) + perm32(R & 31);
        voffA[i] = (unsigned)(R * lda + C) * 2u; voffB[i] = (unsigned)(Rb * ldb + C) * 2u; }
    const size_t kstep = (size_t)(BK * 2);
    const size_t hstepA = (size_t)HALF * lda * 2, hstepB = (size_t)HALF * ldb * 2;
    const unsigned ldsw = (unsigned)wid * 1024u;
    const int aoff = lds_byte(wr * 64 + fr, fq * 8), boff = lds_byte(wc * 32 + fr, fq * 8);
#define PG8_SA(b, h) (((b) * 2 + (h)) * HTB)
#define PG8_SB(b, h) ((4 + (b) * 2 + (h)) * HTB)
#define PG8_STAGE(bufoff, gbase, voff) do { _Pragma("unroll") for (int _i = 0; _i < 2; ++_i) \
        __builtin_amdgcn_global_load_lds((const unsigned*)((const char*)(gbase) + (voff)[_i]), (LAS unsigned*)(lds + (bufoff) + ldsw + _i * 8192), 16, 0, 0); } while (0)
#define PG8_LDA(dst, b, h) do { _Pragma("unroll") for (int m = 0; m < 4; ++m) _Pragma("unroll") for (int k = 0; k < 2; ++k) dst[m][k] = *(const LAS bf16x8*)(lds + PG8_SA(b, h) + aoff + m * 2048 + k * 1024); } while (0)
#define PG8_LDB(dst, b, h) do { _Pragma("unroll") for (int n = 0; n < 2; ++n) _Pragma("unroll") for (int k = 0; k < 2; ++k) dst[n][k] = *(const LAS bf16x8*)(lds + PG8_SB(b, h) + boff + n * 2048 + k * 1024); } while (0)
#define PG8_MMA(ai, bj, At, Bt) do { __builtin_amdgcn_s_setprio(1); _Pragma("unroll") for (int m = 0; m < 4; ++m) _Pragma("unroll") for (int n = 0; n < 2; ++n) _Pragma("unroll") for (int k = 0; k < 2; ++k) \
        acc[ai][bj][m][n] = __builtin_amdgcn_mfma_f32_16x16x32_bf16(Bt[n][k], At[m][k], acc[ai][bj][m][n], 0, 0, 0); __builtin_amdgcn_s_setprio(0); } while (0)
#define PG8_WAIT_V(n) asm volatile("s_waitcnt vmcnt(" #n ")" ::: "memory")
#define PG8_WAIT_L(n) asm volatile("s_waitcnt lgkmcnt(" #n ")" ::: "memory")
#define PG8_BAR __builtin_amdgcn_s_barrier()
#define PG8_SCHED __builtin_amdgcn_sched_barrier(0)
    Unit cur, nxt; int ui = 0;
    if (!S.next(0, cur)) return;
    f32x4 acc[2][2][4][2];
#pragma unroll
    for (int a = 0; a < 2; ++a)
#pragma unroll
        for (int b = 0; b < 2; ++b)
#pragma unroll
            for (int m = 0; m < 4; ++m)
#pragma unroll
                for (int n = 0; n < 2; ++n) acc[a][b][m][n] = (f32x4){0.f, 0.f, 0.f, 0.f};
    bf16x8 At[4][2], B0[2][2], B1[2][2];
    const char* cA = cur.a; const char* cB = cur.b;
    PG8_STAGE(PG8_SB(0, 0), cB, voffB); PG8_STAGE(PG8_SB(0, 1), cB + hstepB, voffB); PG8_STAGE(PG8_SA(0, 0), cA, voffA); PG8_STAGE(PG8_SA(0, 1), cA + hstepA, voffA);
    if (wr == 1) PG8_BAR;
    PG8_WAIT_V(2); PG8_BAR;
    PG8_STAGE(PG8_SB(1, 0), cB + kstep, voffB); PG8_STAGE(PG8_SA(1, 0), cA + kstep, voffA); PG8_STAGE(PG8_SB(1, 1), cB + hstepB + kstep, voffB);
    PG8_WAIT_V(6); PG8_BAR;
    for (;;) {
        const bool has_next = S.next(ui + 1, nxt);
        const char* nA = has_next ? nxt.a : cA; const char* nB = has_next ? nxt.b : cB;
        for (int t = 0; t < nt; t += 2) {
            const bool last = (t == nt - 2);
            const char* a1 = cA + (size_t)(t + 1) * kstep;
            const char* a2 = last ? nA : cA + (size_t)(t + 2) * kstep; const char* b2 = last ? nB : cB + (size_t)(t + 2) * kstep;
            const char* a3 = a2 + kstep; const char* b3 = b2 + kstep;
            PG8_LDB(B0, 0, 0); PG8_LDB(B1, 0, 1); PG8_SCHED; PG8_LDA(At, 0, 0); PG8_STAGE(PG8_SA(1, 1), a1 + hstepA, voffA);
            PG8_WAIT_V(8); PG8_WAIT_L(0); PG8_BAR; PG8_MMA(0, 0, At, B0); PG8_MMA(0, 1, At, B1); PG8_BAR; PG8_SCHED;
            PG8_LDA(At, 0, 1); PG8_STAGE(PG8_SB(0, 0), b2, voffB); PG8_STAGE(PG8_SB(0, 1), b2 + hstepB, voffB); PG8_STAGE(PG8_SA(0, 0), a2, voffA);
            PG8_WAIT_V(8); PG8_WAIT_L(0); PG8_BAR; PG8_MMA(1, 0, At, B0); PG8_MMA(1, 1, At, B1); PG8_BAR; PG8_SCHED;
            PG8_LDB(B0, 1, 0); PG8_LDB(B1, 1, 1); PG8_SCHED; PG8_LDA(At, 1, 0); PG8_STAGE(PG8_SA(0, 1), a2 + hstepA, voffA);
            PG8_WAIT_V(8); PG8_WAIT_L(0); PG8_BAR; PG8_MMA(0, 0, At, B0); PG8_MMA(0, 1, At, B1); PG8_BAR; PG8_SCHED;
            PG8_LDA(At, 1, 1); PG8_STAGE(PG8_SB(1, 0), b3, voffB); PG8_STAGE(PG8_SB(1, 1), b3 + hstepB, voffB); PG8_STAGE(PG8_SA(1, 0), a3, voffA);
            PG8_WAIT_V(8); PG8_WAIT_L(0); PG8_BAR; PG8_MMA(1, 0, At, B0); PG8_MMA(1, 1, At, B1); PG8_BAR; PG8_SCHED;
        }
        if (wr == 0) PG8_BAR;
        E(acc, cur, wr, wc, fr, fq);
        if (!has_next) break;
#pragma unroll
        for (int a = 0; a < 2; ++a)
#pragma unroll
            for (int b = 0; b < 2; ++b)
#pragma unroll
                for (int m = 0; m < 4; ++m)
#pragma unroll
                    for (int n = 0; n < 2; ++n) acc[a][b][m][n] = (f32x4){0.f, 0.f, 0.f, 0.f};
        cur = nxt; cA = nA; cB = nB; ++ui;
        if (wr == 1) PG8_BAR;
    }
    PG8_WAIT_V(0);
    PG8_BAR;
#undef PG8_SA
#undef PG8_SB
#undef PG8_STAGE
#undef PG8_LDA
#undef PG8_LDB
#undef PG8_MMA
#undef PG8_WAIT_V
#undef PG8_WAIT_L
#undef PG8_SCHED
}
}
namespace pg8 {
struct SchedMN {
    const char* A; const char* Bt; int lda, ldb; int nM, nN, nwg, G, c;
    __device__ __forceinline__ void init(const bf16* A_, int lda_, const bf16* Bt_, int ldb_, int Mrows, int Ncols, int G_, int c_) {
        A = (const char*)A_; Bt = (const char*)Bt_; lda = lda_; ldb = ldb_; nM = Mrows / BM; nN = Ncols / BM; nwg = nM * nN; G = G_; c = c_; }
    __device__ __forceinline__ bool next(int i, Unit& u) const {
        const long L = (long)i * G + c; if (L >= nwg) return false;
        int wgid = (int)L; { const int q = nwg / NXCD, r = nwg % NXCD, xcd = wgid % NXCD, off = wgid / NXCD; wgid = (xcd < r ? xcd * (q + 1) : r * (q + 1) + (xcd - r) * q) + off; }
        const int nig = WGM * nN, gid = wgid / nig, fm = gid * WGM, gsz = (nM - fm) < WGM ? (nM - fm) : WGM;
        const int pm = fm + ((wgid % nig) % gsz), pn = (wgid % nig) / gsz;
        u.a = A + (size_t)pm * BM * lda * 2; u.b = Bt + (size_t)pn * BM * ldb * 2; u.orow = pm * BM; u.ocol = pn * BM; u.aux = pn; return true;
    }
};
struct SchedKV {
    const char* memn; const char* wkv; int G, c;
    __device__ __forceinline__ bool next(int i, Unit& u) const {
        const int L = i * G + c; if (L >= 256) return false;
        const int l = L >> 6, r = L & 63; const char* w = wkv + (size_t)l * 4096 * D * 2;
        if (r < 32) { const int pm = r >> 3, pn = r & 7; u.a = memn + (size_t)pm * 256 * D * 2; u.b = w + (size_t)pn * 256 * D * 2; u.orow = pm * 256; u.ocol = pn * 256; u.aux = l * 2; }
        else { const int q = r - 32, pm = q >> 2, pn = q & 3; u.a = w + (size_t)(2048 + pm * 256) * D * 2; u.b = memn + (size_t)pn * 256 * D * 2; u.orow = pm * 256; u.ocol = pn * 256; u.aux = l * 2 + 1; }
        return true;
    }
};
struct SchedS {
    const char* Q; const char* Km; int G, c;
    __device__ __forceinline__ bool next(int i, Unit& u) const {
        const int L = i * G + c; if (L >= 256) return false;
        const int bh = 2 * (L & 7) + ((L >> 3) >> 4), it = (L >> 3) & 15, b = bh >> 2, h = bh & 3;
        u.a = Q + ((size_t)(b * SEQ + it * 256) * D + h * XAD) * 2; u.b = Km + ((size_t)(b * MEMLEN) * D + h * XAD) * 2; u.orow = b * SEQ + it * 256; u.ocol = h * 256; u.aux = 0; return true;
    }
};
struct SchedPV {
    const char* P; const char* Vt; int G, c;
    __device__ __forceinline__ bool next(int i, Unit& u) const {
        const int L = i * G + c; if (L >= 512) return false;
        const int x = L & 7, r = L >> 3;
        const int bh = 2 * x + (r >> 5), q = r & 31, it = q >> 1, nh = q & 1, b = bh >> 2, h = bh & 3;
        u.a = P + ((size_t)(b * SEQ + it * 256) * 1024 + h * 256) * 2; u.b = Vt + ((size_t)(h * XAD + nh * 256) * 1024 + b * MEMLEN) * 2; u.orow = b * SEQ + it * 256; u.ocol = h * XAD + nh * 256; u.aux = 0; return true;
    }
};
struct SchedDt {
    const char* A; const char* Bt; int c;
    __device__ __forceinline__ bool next(int i, Unit& u) const {
        if (i != 0 || c >= 64) return false;
        u.a = A + (size_t)c * 256 * D * 2; u.b = Bt; u.orow = c * 256; u.ocol = 0; u.aux = 0; return true;
    }
};

#define EPI_ARGS f32x4 (&acc)[2][2][4][2], const Unit& u, int wr, int wc, int fr, int fq
#define EPI_ROW(ai, m) (u.orow + (ai) * HALF + wr * 64 + (m) * 16 + fr)
#define EPI_COL(bj) (u.ocol + (bj) * HALF + wc * 32 + 8 * fq)
__device__ __forceinline__ float rstd_of(const float* ss, int row) { const f32x4 a = *(const f32x4*)(ss + (size_t)row * 8), b = *(const f32x4*)(ss + (size_t)row * 8 + 4);
    return rsqrtf((((a[0] + a[1]) + (a[2] + a[3])) + ((b[0] + b[1]) + (b[2] + b[3]))) * (1.0f / D) + EPS); }
__device__ __forceinline__ u32x4 pack8(const f32x4 a, const f32x4 b) { u32x4 w; w.x = cvt_pk_bf16(a[0], a[1]); w.y = cvt_pk_bf16(a[2], a[3]); w.z = cvt_pk_bf16(b[0], b[1]); w.w = cvt_pk_bf16(b[2], b[3]); return w; }

struct EpiProjEven {
    const float* ss; bf16* proj; float* logf; const float* lb;
    __device__ __forceinline__ void operator()(EPI_ARGS) const {
        const int range = u.aux >> 2;
#pragma unroll
        for (int ai = 0; ai < 2; ++ai)
#pragma unroll
            for (int m = 0; m < 4; ++m) { const int row = EPI_ROW(ai, m); const float rs = rstd_of(ss, row);
#pragma unroll
                for (int bj = 0; bj < 2; ++bj) { const int col = EPI_COL(bj); f32x4 v0 = acc[ai][bj][m][0] * rs, v1 = acc[ai][bj][m][1] * rs;
                    if (range == 3) { const int c = col - 3072; const f32x4 l0 = *(const f32x4*)(lb + c), l1 = *(const f32x4*)(lb + c + 4);
#pragma unroll
                        for (int j = 0; j < 4; ++j) { v0[j] = __logf(l0[j] + (1.f - l0[j]) * sigm(v0[j])); v1[j] = __logf(l1[j] + (1.f - l1[j]) * sigm(v1[j])); }
                        float* p = logf + (size_t)row * 1024 + c; *(f32x4*)p = v0; *(f32x4*)(p + 4) = v1;
                    } else {
                        if (range == 1) {
#pragma unroll
                            for (int j = 0; j < 4; ++j) { v0[j] = gelu_tanh(v0[j]); v1[j] = gelu_tanh(v1[j]); } }
                        else if (range == 2 || range == 5) {
#pragma unroll
                            for (int j = 0; j < 4; ++j) { v0[j] = siluf(v0[j]); v1[j] = siluf(v1[j]); } }
                        *(u32x4*)(proj + (size_t)row * ABIN + col) = pack8(v0, v1);
                    } } }
    }
};
struct EpiProjOdd {
    const float* ss; bf16* Z; bf16* XBC;
    __device__ __forceinline__ void operator()(EPI_ARGS) const {
        const bool isz = u.ocol < SSDIN;
#pragma unroll
        for (int ai = 0; ai < 2; ++ai)
#pragma unroll
            for (int m = 0; m < 4; ++m) { const int row = EPI_ROW(ai, m); const float rs = rstd_of(ss, row);
#pragma unroll
                for (int bj = 0; bj < 2; ++bj) { const int col = EPI_COL(bj); f32x4 v0 = acc[ai][bj][m][0] * rs, v1 = acc[ai][bj][m][1] * rs;
                    if (isz) {
#pragma unroll
                        for (int j = 0; j < 4; ++j) { v0[j] = siluf(v0[j]); v1[j] = siluf(v1[j]); }
                        *(u32x4*)(Z + (size_t)row * SSDIN + col) = pack8(v0, v1);
                    } else *(u32x4*)(XBC + (size_t)row * SSDCONV + (col - SSDIN)) = pack8(v0, v1); } }
    }
};
struct EpiDt {
    const float* ss; const float* bias; float* DT;
    __device__ __forceinline__ void operator()(EPI_ARGS) const {
        if (wc >= 2) return;
        const int col = wc * 32 + 8 * fq; const f32x4 b0 = *(const f32x4*)(bias + col), b1 = *(const f32x4*)(bias + col + 4);
#pragma unroll
        for (int ai = 0; ai < 2; ++ai)
#pragma unroll
            for (int m = 0; m < 4; ++m) { const int row = EPI_ROW(ai, m); const float rs = rstd_of(ss, row);
                f32x4 v0 = acc[ai][0][m][0] * rs + b0, v1 = acc[ai][0][m][1] * rs + b1;
#pragma unroll
                for (int j = 0; j < 4; ++j) { v0[j] = softplusf(v0[j]); v1[j] = softplusf(v1[j]); }
                float* p = DT + (size_t)row * 64 + col; *(f32x4*)p = v0; *(f32x4*)(p + 4) = v1; }
    }
};
struct EpiResid {
    float* x; bf16* xb; float* ssnew; LAS float* tab;
    __device__ __forceinline__ void operator()(EPI_ARGS) const {
#pragma unroll
        for (int ai = 0; ai < 2; ++ai)
#pragma unroll
            for (int m = 0; m < 4; ++m) { const int row = EPI_ROW(ai, m); float sq = 0.f;
#pragma unroll
                for (int bj = 0; bj < 2; ++bj) { const int col = EPI_COL(bj); float* p = x + (size_t)row * D + col;
                    const f32x4 o0 = *(const f32x4*)p + acc[ai][bj][m][0], o1 = *(const f32x4*)(p + 4) + acc[ai][bj][m][1];
                    *(f32x4*)p = o0; *(f32x4*)(p + 4) = o1; *(u32x4*)(xb + (size_t)row * D + col) = pack8(o0, o1);
                    sq += ((o0[0] * o0[0] + o0[1] * o0[1]) + (o0[2] * o0[2] + o0[3] * o0[3])) + ((o1[0] * o1[0] + o1[1] * o1[1]) + (o1[2] * o1[2] + o1[3] * o1[3])); }
                sq += __shfl_xor(sq, 16); sq += __shfl_xor(sq, 32);
                if (fq == 0) tab[(ai * HALF + wr * 64 + m * 16 + fr) * 4 + wc] = sq; }
        LDS_WAIT(); PG8_BAR; asm volatile("" ::: "memory");
        const int lane = fq * 16 + fr, r = (wr * 4 + wc) * 32 + (lane & 31);
        if (lane < 32) { const f32x4 t = *(const LAS f32x4*)(tab + r * 4); ssnew[(size_t)(u.orow + r) * 8 + (u.ocol >> 8)] = (t[0] + t[1]) + (t[2] + t[3]); }
    }
};
struct EpiQ {
    const float* ss; bf16* Q; float scale;
    __device__ __forceinline__ void operator()(EPI_ARGS) const {
#pragma unroll
        for (int ai = 0; ai < 2; ++ai)
#pragma unroll
            for (int m = 0; m < 4; ++m) { const int row = EPI_ROW(ai, m); const float rs = rstd_of(ss, row) * scale;
#pragma unroll
                for (int bj = 0; bj < 2; ++bj) *(u32x4*)(Q + (size_t)row * D + EPI_COL(bj)) = pack8(acc[ai][bj][m][0] * rs, acc[ai][bj][m][1] * rs); }
    }
};
struct EpiPlain {
    bf16* O; int ldc;
    __device__ __forceinline__ void operator()(EPI_ARGS) const {
#pragma unroll
        for (int ai = 0; ai < 2; ++ai)
#pragma unroll
            for (int m = 0; m < 4; ++m) { const int row = EPI_ROW(ai, m);
#pragma unroll
                for (int bj = 0; bj < 2; ++bj) *(u32x4*)(O + (size_t)row * ldc + EPI_COL(bj)) = pack8(acc[ai][bj][m][0], acc[ai][bj][m][1]); }
    }
};
struct EpiKV {
    bf16* Km; bf16* Vt;
    __device__ __forceinline__ void operator()(EPI_ARGS) const {
        const int l = u.aux >> 1; const bool isv = u.aux & 1;
        bf16* O = isv ? Vt + (size_t)l * D * MEMROWS : Km + (size_t)l * MEMROWS * D; const int ldc = isv ? MEMROWS : D;
#pragma unroll
        for (int ai = 0; ai < 2; ++ai)
#pragma unroll
            for (int m = 0; m < 4; ++m) { const int row = EPI_ROW(ai, m);
#pragma unroll
                for (int bj = 0; bj < 2; ++bj) *(u32x4*)(O + (size_t)row * ldc + EPI_COL(bj)) = pack8(acc[ai][bj][m][0], acc[ai][bj][m][1]); }
    }
};
struct EpiSoftmax {
    bf16* P; LAS float* tab;
    __device__ __forceinline__ void operator()(EPI_ARGS) const {
        float mx[2][4];
#pragma unroll
        for (int ai = 0; ai < 2; ++ai)
#pragma unroll
            for (int m = 0; m < 4; ++m) { float v = -3.0e38f;
#pragma unroll
                for (int bj = 0; bj < 2; ++bj)
#pragma unroll
                    for (int n = 0; n < 2; ++n) { const f32x4 a = acc[ai][bj][m][n]; v = fmaxf(v, fmaxf(fmaxf(a[0], a[1]), fmaxf(a[2], a[3]))); }
                v = fmaxf(v, __shfl_xor(v, 16)); v = fmaxf(v, __shfl_xor(v, 32));
                if (fq == 0) tab[(ai * HALF + wr * 64 + m * 16 + fr) * 4 + wc] = v; }
        LDS_WAIT(); PG8_BAR; asm volatile("" ::: "memory");
#pragma unroll
        for (int ai = 0; ai < 2; ++ai)
#pragma unroll
            for (int m = 0; m < 4; ++m) { const int r = ai * HALF + wr * 64 + m * 16 + fr; const f32x4 t = *(const LAS f32x4*)(tab + r * 4);
                const float rm = fmaxf(fmaxf(t[0], t[1]), fmaxf(t[2], t[3])); float s = 0.f;
#pragma unroll
                for (int bj = 0; bj < 2; ++bj)
#pragma unroll
                    for (int n = 0; n < 2; ++n) { f32x4 a = acc[ai][bj][m][n];
#pragma unroll
                        for (int j = 0; j < 4; ++j) { a[j] = __expf(a[j] - rm); s += a[j]; }
                        acc[ai][bj][m][n] = a; }
                s += __shfl_xor(s, 16); s += __shfl_xor(s, 32);
                if (fq == 0) tab[1024 + r * 4 + wc] = s; }
        LDS_WAIT(); PG8_BAR; asm volatile("" ::: "memory");
#pragma unroll
        for (int ai = 0; ai < 2; ++ai)
#pragma unroll
            for (int m = 0; m < 4; ++m) { const int r = ai * HALF + wr * 64 + m * 16 + fr; const f32x4 t = *(const LAS f32x4*)(tab + 1024 + r * 4);
                const float inv = 1.0f / ((t[0] + t[1]) + (t[2] + t[3])); const int row = u.orow + r;
#pragma unroll
                for (int bj = 0; bj < 2; ++bj) *(u32x4*)(P + (size_t)row * 1024 + EPI_COL(bj)) = pack8(acc[ai][bj][m][0] * inv, acc[ai][bj][m][1] * inv); }
    }
};
struct EpiGateUp {
    const float* ss; bf16* H;
    __device__ __forceinline__ void operator()(EPI_ARGS) const {
#pragma unroll
        for (int ai = 0; ai < 2; ++ai)
#pragma unroll
            for (int m = 0; m < 4; ++m) { const int row = EPI_ROW(ai, m); const float rs = rstd_of(ss, row);
#pragma unroll
                for (int bj = 0; bj < 2; ++bj) { const int hc = EPI_COL(bj) >> 1; const f32x4 g = acc[ai][bj][m][0] * rs, up = acc[ai][bj][m][1] * rs; f32x4 h;
#pragma unroll
                    for (int j = 0; j < 4; ++j) h[j] = siluf(g[j]) * up[j];
                    u32x2 w; w.x = cvt_pk_bf16(h[0], h[1]); w.y = cvt_pk_bf16(h[2], h[3]); *(u32x2*)(H + (size_t)row * FF + hc) = w; } }
    }
};
#undef EPI_ARGS
}
#define MFMA16(X, Y, ACC) __builtin_amdgcn_mfma_f32_16x16x32_bf16((X), (Y), (ACC), 0, 0, 0)
#define WG_SYNC() do { asm volatile("s_waitcnt vmcnt(0) lgkmcnt(0)" ::: "memory"); __builtin_amdgcn_s_barrier(); asm volatile("" ::: "memory"); } while (0)
constexpr int LP = 136;
constexpr int LP64 = 72;
__device__ __forceinline__ bf16x8 lds_frag(const LAS bf16* base, int row, int pitch, int kofs) { return *(const LAS bf16x8*)(base + row * pitch + kofs); }
__device__ __forceinline__ u32x2 pack4(const f32x4 a) { u32x2 w; w.x = cvt_pk_bf16(a[0], a[1]); w.y = cvt_pk_bf16(a[2], a[3]); return w; }

template <int MAP>
__device__ __forceinline__ void conv_item(const float* W, int ldw, int K, int n0, const float* gain, bf16* WT, int row_off, LAS float* scr, int item, int nblk, int lane) {
    const int kb = item / nblk, nb = item % nblk, k0 = 64 * kb, nn0 = 32 * nb;
#pragma unroll 8
    for (int i = 0; i < 32; ++i) { const int kk = 2 * i + (lane >> 5); float v = W[(size_t)(k0 + kk) * ldw + n0 + nn0 + (lane & 31)]; if (gain) v *= gain[k0 + kk]; scr[kk * 33 + (lane & 31)] = v; }
    LDS_WAIT(); asm volatile("" ::: "memory");
    const int c = lane & 7;
#pragma unroll
    for (int j = 0; j < 4; ++j) { const int n = (lane >> 3) + 8 * j; const LAS float* s = scr + (8 * c) * 33 + n;
        u32x4 o; o.x = pk2(s[0 * 33], s[1 * 33]); o.y = pk2(s[2 * 33], s[3 * 33]); o.z = pk2(s[4 * 33], s[5 * 33]); o.w = pk2(s[6 * 33], s[7 * 33]);
        const int nn = nn0 + n; const int dr = MAP == 0 ? nn : ((nn >> 2) * 8 + (nn & 3) + (MAP == 2 ? 4 : 0));
        *(u32x4*)(WT + (size_t)(row_off + dr) * K + k0 + 8 * c) = o; }
    LDS_WAIT(); asm volatile("" ::: "memory");
}
template <int MAP>
__device__ __forceinline__ void conv_matrix(const float* W, int ldw, int K, int n0, int ncols, const float* gain, bf16* WT, int row_off, LAS float* scr, int gw, int NGW, int lane) {
    const int nblk = ncols / 32, nitems = (K / 64) * nblk;
    for (int it = gw; it < nitems; it += NGW) conv_item<MAP>(W, ldw, K, n0, gain, WT, row_off, scr, it, nblk, lane);
}

struct In {
    const float *x, *mem, *norm_mix, *norm_xattn, *norm_ffn, *norm_mem, *norm_final, *ab_w_in, *ab_w_out, *lru_conv_w, *lru_conv_b, *lru_w_r, *lru_b_r, *lru_w_i, *lru_b_i, *lru_lambda,
        *hgrn_lb, *hgrn_norm, *ssd_w_in, *ssd_w_out, *ssd_conv_w, *ssd_conv_b, *ssd_dt_bias, *ssd_a_log, *ssd_d, *ssd_norm, *xa_w_q, *xa_w_kv, *xa_w_o, *ffn_w_gate, *ffn_w_up, *ffn_w_down;
};

typedef const In __attribute__((address_space(4))) CIn;
__device__ __forceinline__ void convert_layer(CIn& I, int l, bf16* WL, LAS float* scr, int gw, int NGW, int lane) {
    const int e = l >> 1;
    if ((l & 1) == 0) {
        conv_matrix<0>(I.ab_w_in + (size_t)e * D * ABIN, ABIN, D, 0, ABIN, I.norm_mix + l * D, WL + WL_IN, 0, scr, gw, NGW, lane);
        conv_matrix<0>(I.ab_w_out + (size_t)e * D * D, D, D, 0, D, nullptr, WL + WL_OUT, 0, scr, gw, NGW, lane);
    } else {
        conv_matrix<0>(I.ssd_w_in + (size_t)e * D * SSDPROJ, SSDPROJ, D, 0, SSDN1, I.norm_mix + l * D, WL + WL_IN, 0, scr, gw, NGW, lane);
        conv_matrix<0>(I.ssd_w_in + (size_t)e * D * SSDPROJ, SSDPROJ, D, SSDN1, 64, I.norm_mix + l * D, WL + WL_DT, 0, scr, gw, NGW, lane);
        for (int i = gw * 64 + lane; i < 192 * D / 8; i += NGW * 64) *(u32x4*)(WL + WL_DT + (size_t)64 * D + (size_t)i * 8) = (u32x4){0u, 0u, 0u, 0u};
        conv_matrix<0>(I.ssd_w_out + (size_t)e * SSDIN * D, D, SSDIN, 0, D, nullptr, WL + WL_OUT, 0, scr, gw, NGW, lane);
    }
    conv_matrix<0>(I.xa_w_q + (size_t)l * D * D, D, D, 0, D, I.norm_xattn + l * D, WL + WL_Q, 0, scr, gw, NGW, lane);
    conv_matrix<0>(I.xa_w_o + (size_t)l * D * D, D, D, 0, D, nullptr, WL + WL_O, 0, scr, gw, NGW, lane);
    conv_matrix<1>(I.ffn_w_gate + (size_t)l * D * FF, FF, D, 0, FF, I.norm_ffn + l * D, WL + WL_GU, 0, scr, gw, NGW, lane);
    conv_matrix<2>(I.ffn_w_up + (size_t)l * D * FF, FF, D, 0, FF, I.norm_ffn + l * D, WL + WL_GU, 0, scr, gw, NGW, lane);
    conv_matrix<0>(I.ffn_w_down + (size_t)l * FF * D, D, FF, 0, D, nullptr, WL + WL_DN, 0, scr, gw, NGW, lane);
}

template <bool PASSB>
__device__ __forceinline__ void lru_units(const int tid, LAS unsigned char* lds, int G, int cu, const bf16* PROJ, const bf16* WRT, const float* cw, const float* cb, const float* br, const float* bi,
                                          const float* lam, float* SEG, bf16* YAB) {
    const int wid = __builtin_amdgcn_readfirstlane(tid >> 6), lane = tid & 63, q = lane >> 4, c16 = lane & 15;
    LAS bf16* XA = (LAS bf16*)(lds);
    LAS bf16* XC = (LAS bf16*)(lds + 35840);
    LAS bf16* WR = (LAS bf16*)(lds + 70656);
    LAS bf16* WI = (LAS bf16*)(lds + 105472);
    LAS float* PAR = (LAS float*)(lds + 140288);
    LAS float* WT = (LAS float*)(lds + 144384);
    LAS float* HIN = (LAS float*)(lds + 152576);
    int loadedj = -1;
    for (int u = cu; u < 1024; u += G) {
        const int j = u & 7, rest = u >> 3, b = rest >> 5, seg = rest & 31; const int t0 = b * SEQ + seg * 128;
        if (j != loadedj) {
            loadedj = j;
            for (int p = tid; p < 2 * 2048; p += NTHR) { const int g = p >> 11, pp = p & 2047, r = pp >> 4, pc = pp & 15;
                const u32x4 v = *(const u32x4*)(WRT + ((size_t)(g * 8 + j) * 128 + r) * 128 + pc * 8);
                *(LAS u32x4*)((g ? WI : WR) + r * LP + pc * 8) = v; }
            if (tid < 128) { const int ch = j * 128 + tid;
                PAR[0 * 128 + tid] = 8.0f * softplusf(-lam[ch]); PAR[1 * 128 + tid] = br[ch]; PAR[2 * 128 + tid] = bi[ch]; PAR[3 * 128 + tid] = cb[ch];
#pragma unroll
                for (int k = 0; k < 4; ++k) PAR[(4 + k) * 128 + tid] = cw[k * LRUW + ch]; }
        }
        for (int p = tid; p < 131 * 16; p += NTHR) { const int r = p >> 4, pc = p & 15; u32x4 v = (u32x4){0u, 0u, 0u, 0u};
            if (seg > 0 || r >= 3) v = *(const u32x4*)(PROJ + (size_t)(t0 + r - 3) * ABIN + j * 128 + pc * 8);
            *(LAS u32x4*)(XA + r * LP + pc * 8) = v; }
        if (PASSB) { if (tid < 128) { float h = 0.f; const float* sg = SEG + ((size_t)(b * 8 + j) * 32) * 256 + tid * 2;
                for (int s = 0; s < seg; ++s) { const f32x2 ab = *(const f32x2*)(sg + (size_t)s * 256); h = ab.x * h + ab.y; }
                HIN[tid] = h; } }
        WG_SYNC();
        {
            const int ch8 = tid & 15, tr = tid >> 4; u32x4 rows[7];
#pragma unroll
            for (int i = 0; i < 7; ++i) rows[i] = *(const LAS u32x4*)(XA + (4 * tr + i) * LP + ch8 * 8);
            float w[4][8], bb[8];
#pragma unroll
            for (int e = 0; e < 8; ++e) { bb[e] = PAR[3 * 128 + ch8 * 8 + e];
#pragma unroll
                for (int k = 0; k < 4; ++k) w[k][e] = PAR[(4 + k) * 128 + ch8 * 8 + e]; }
#pragma unroll
            for (int i = 0; i < 4; ++i) { float o[8];
#pragma unroll
                for (int e = 0; e < 8; ++e) { float a = bb[e];
#pragma unroll
                    for (int k = 0; k < 4; ++k) { const unsigned wd = rows[i + k][e >> 1]; a += w[k][e] * ((e & 1) ? bfhi(wd) : bflo(wd)); }
                    o[e] = a; }
                u32x4 pk; pk.x = cvt_pk_bf16(o[0], o[1]); pk.y = cvt_pk_bf16(o[2], o[3]); pk.z = cvt_pk_bf16(o[4], o[5]); pk.w = cvt_pk_bf16(o[6], o[7]);
                *(LAS u32x4*)(XC + (4 * tr + i) * LP + ch8 * 8) = pk; }
        }
        WG_SYNC();
        float PP[8][4], HH[8][4];
        {
            bf16x8 xf[4];
#pragma unroll
            for (int ks = 0; ks < 4; ++ks) xf[ks] = lds_frag(XC, 16 * wid + c16, LP, 32 * ks + 8 * q);
#pragma unroll
            for (int jb = 0; jb < 8; ++jb) {
                f32x4 aR = (f32x4){0.f, 0.f, 0.f, 0.f}, aI = aR;
#pragma unroll
                for (int ks = 0; ks < 4; ++ks) { aR = MFMA16(xf[ks], lds_frag(WR, 16 * jb + c16, LP, 32 * ks + 8 * q), aR); aI = MFMA16(xf[ks], lds_frag(WI, 16 * jb + c16, LP, 32 * ks + 8 * q), aI); }
                const int ch = 16 * jb + c16;
                const float sp8 = PAR[ch], pbr = PAR[128 + ch], pbi = PAR[256 + ch], pcb = PAR[384 + ch], w0 = PAR[512 + ch], w1 = PAR[640 + ch], w2 = PAR[768 + ch], w3 = PAR[896 + ch];
                float xr[7];
#pragma unroll
                for (int i = 0; i < 7; ++i) xr[i] = bf2f(XA[(16 * wid + 4 * q + i) * LP + ch]);
                float a[4], bt[4];
#pragma unroll
                for (int r = 0; r < 4; ++r) { const float xc = pcb + w0 * xr[r] + w1 * xr[r + 1] + w2 * xr[r + 2] + w3 * xr[r + 3];
                    const float rg = sigm(aR[r] + pbr), ig = sigm(aI[r] + pbi); const float la = -sp8 * rg;
                    a[r] = __expf(la); bt[r] = sqrtf(fmaxf(-expm1f(2.0f * la), 0.f)) * ig * xc; }
                float P[4], H[4]; P[0] = a[0]; H[0] = bt[0];
#pragma unroll
                for (int r = 1; r < 4; ++r) { P[r] = a[r] * P[r - 1]; H[r] = a[r] * H[r - 1] + bt[r]; }
                float Ae = 1.f, Be = 0.f, Aw = 1.f, Bw = 0.f;
#pragma unroll
                for (int qq = 0; qq < 4; ++qq) { const float Aq = __shfl(P[3], c16 + 16 * qq), Bq = __shfl(H[3], c16 + 16 * qq);
                    if (qq < q) { Be = Aq * Be + Bq; Ae = Aq * Ae; }
                    Bw = Aq * Bw + Bq; Aw = Aq * Aw; }
#pragma unroll
                for (int r = 0; r < 4; ++r) { PP[jb][r] = P[r] * Ae; HH[jb][r] = P[r] * Be + H[r]; }
                if (q == 0) *(LAS f32x2*)(WT + (wid * 128 + ch) * 2) = (f32x2){Aw, Bw};
            }
        }
        WG_SYNC();
        if (!PASSB) {
            if (tid < 128) { float A = 1.f, B = 0.f;
#pragma unroll
                for (int w = 0; w < 8; ++w) { const f32x2 ab = *(const LAS f32x2*)(WT + (w * 128 + tid) * 2); B = ab.x * B + ab.y; A = ab.x * A; }
                *(f32x2*)(SEG + ((size_t)(b * 8 + j) * 32 + seg) * 256 + tid * 2) = (f32x2){A, B}; }
        } else {
#pragma unroll
            for (int jb = 0; jb < 8; ++jb) { const int ch = 16 * jb + c16; float h0 = HIN[ch];
                for (int w = 0; w < wid; ++w) { const f32x2 ab = *(const LAS f32x2*)(WT + (w * 128 + ch) * 2); h0 = ab.x * h0 + ab.y; }
#pragma unroll
                for (int r = 0; r < 4; ++r) { const int t = t0 + 16 * wid + 4 * q + r; const float h = PP[jb][r] * h0 + HH[jb][r];
                    const float ga = bf2f(PROJ[(size_t)t * ABIN + 1024 + j * 128 + ch]);
                    YAB[(size_t)t * D + j * 128 + ch] = (bf16)f2bf(ga * h); } }
        }
        WG_SYNC();
    }
}

__device__ __forceinline__ void hgrn1_units(const int tid, LAS unsigned char* lds, int G, int cu, const float* LOGF, const bf16* PROJ, bf16* HST, float* HDEC) {
    const int wid = __builtin_amdgcn_readfirstlane(tid >> 6), lane = tid & 63, q = lane >> 4, c16 = lane & 15;
    LAS bf16* KT = (LAS bf16*)(lds);
    LAS bf16* VT = (LAS bf16*)(lds + 18432);
    LAS float* TOT = (LAS float*)(lds + 36864);
    const int k = tid & 127, qt = tid >> 7;
    for (int u = cu; u < 2048; u += G) {
        const int bh = u >> 6, c = u & 63, b = bh >> 3, h = bh & 7; const int t0 = b * SEQ + c * 64 + 16 * qt;
        float cs[16], lf[16]; unsigned vv[16];
#pragma unroll
        for (int i = 0; i < 16; ++i) { lf[i] = LOGF[(size_t)(t0 + i) * 1024 + h * 128 + k]; vv[i] = PROJ[(size_t)(t0 + i) * ABIN + 4096 + h * 128 + k]; }
        cs[0] = lf[0];
#pragma unroll
        for (int i = 1; i < 16; ++i) cs[i] = cs[i - 1] + lf[i];
        TOT[qt * 128 + k] = cs[15];
        WG_SYNC();
        float pre = 0.f, last = 0.f;
#pragma unroll
        for (int qq = 0; qq < 4; ++qq) { const float t = TOT[qq * 128 + k]; if (qq < qt) pre += t; last += t; }
        unsigned kw[8], vw[8];
#pragma unroll
        for (int i = 0; i < 8; ++i) { const float k0 = (1.f - __expf(lf[2 * i])) * __expf(last - (pre + cs[2 * i])), k1 = (1.f - __expf(lf[2 * i + 1])) * __expf(last - (pre + cs[2 * i + 1]));
            kw[i] = cvt_pk_bf16(k0, k1); vw[i] = vv[2 * i] | (vv[2 * i + 1] << 16); }
        *(LAS u32x4*)(KT + k * LP64 + 16 * qt) = (u32x4){kw[0], kw[1], kw[2], kw[3]}; *(LAS u32x4*)(KT + k * LP64 + 16 * qt + 8) = (u32x4){kw[4], kw[5], kw[6], kw[7]};
        *(LAS u32x4*)(VT + k * LP64 + 16 * qt) = (u32x4){vw[0], vw[1], vw[2], vw[3]}; *(LAS u32x4*)(VT + k * LP64 + 16 * qt + 8) = (u32x4){vw[4], vw[5], vw[6], vw[7]};
        if (qt == 0) HDEC[(size_t)u * 128 + k] = __expf(last);
        WG_SYNC();
        bf16x8 kf[2];
#pragma unroll
        for (int ks = 0; ks < 2; ++ks) kf[ks] = lds_frag(KT, 16 * wid + c16, LP64, 32 * ks + 8 * q);
#pragma unroll
        for (int vb = 0; vb < 8; ++vb) { f32x4 acc = (f32x4){0.f, 0.f, 0.f, 0.f};
#pragma unroll
            for (int ks = 0; ks < 2; ++ks) acc = MFMA16(kf[ks], lds_frag(VT, 16 * vb + c16, LP64, 32 * ks + 8 * q), acc);
            *(u32x2*)(HST + ((size_t)u * 128 + 16 * vb + c16) * 128 + 16 * wid + 4 * q) = pack4(acc); }
        WG_SYNC();
    }
}
__device__ __forceinline__ void hgrn2_scan(const int tid, int G, int cu, bf16* HST, const float* HDEC) {
    for (int task = cu * NTHR + tid; task < 32 * 4096; task += G * NTHR) {
        const int bh = task >> 12, e = (task & 4095) * 4; f32x4 S = (f32x4){0.f, 0.f, 0.f, 0.f};
#pragma unroll 8
        for (int c = 0; c < 64; ++c) { const size_t u = (size_t)bh * 64 + c; bf16* p = HST + u * 16384 + e; const u32x2 L = *(const u32x2*)p; const f32x4 d = *(const f32x4*)(HDEC + u * 128 + (e & 127));
            *(u32x2*)p = pack4(S);
            S[0] = d[0] * S[0] + bflo(L.x); S[1] = d[1] * S[1] + bfhi(L.x); S[2] = d[2] * S[2] + bflo(L.y); S[3] = d[3] * S[3] + bfhi(L.y); }
    }
}
__device__ __forceinline__ void hgrn3_units(const int tid, LAS unsigned char* lds, int G, int cu, const float* LOGF, const bf16* PROJ, const bf16* HST, const float* hnorm, bf16* YAB) {
    const int wid = __builtin_amdgcn_readfirstlane(tid >> 6), lane = tid & 63, q = lane >> 4, c16 = lane & 15;
    LAS bf16* QH = (LAS bf16*)(lds);
    LAS bf16* QT = (LAS bf16*)(lds + 17408);
    LAS bf16* KH = (LAS bf16*)(lds + 34816);
    LAS bf16* VT = (LAS bf16*)(lds + 52224);
    LAS bf16* STL = (LAS bf16*)(lds + 70656);
    LAS bf16* PM = (LAS bf16*)(lds + 105472);
    LAS float* TOT = (LAS float*)(lds + 114688);
    LAS float* SQ = (LAS float*)(lds + 116736);
    const int k = tid & 127, qt = tid >> 7;
    for (int u = cu; u < 2048; u += G) {
        const int bh = u >> 6, c = u & 63, b = bh >> 3, h = bh & 7; const int tc = b * SEQ + c * 64, t0 = tc + 16 * qt;
        float cs[16], lf[16], qv[16]; unsigned vv[16];
#pragma unroll
        for (int i = 0; i < 16; ++i) { lf[i] = LOGF[(size_t)(t0 + i) * 1024 + h * 128 + k]; const bf16* pr = PROJ + (size_t)(t0 + i) * ABIN + h * 128 + k; qv[i] = bf2f(pr[2048]); vv[i] = pr[4096]; }
        cs[0] = lf[0];
#pragma unroll
        for (int i = 1; i < 16; ++i) cs[i] = cs[i - 1] + lf[i];
        TOT[qt * 128 + k] = cs[15];
#pragma unroll
        for (int i = 0; i < 4; ++i) { const int p = tid + NTHR * i, r = p >> 4, pc = p & 15; *(LAS u32x4*)(STL + r * LP + pc * 8) = *(const u32x4*)(HST + (size_t)u * 16384 + r * 128 + pc * 8); }
        WG_SYNC();
        float pre = 0.f;
#pragma unroll
        for (int qq = 0; qq < 4; ++qq) { const float t = TOT[qq * 128 + k]; if (qq < qt) pre += t; }
        const float ref = TOT[k] + TOT[128 + k];
        unsigned vw[8];
#pragma unroll
        for (int i = 0; i < 16; ++i) { const float cum = pre + cs[i], kk = 1.f - __expf(lf[i]);
            QT[(16 * qt + i) * LP + k] = (bf16)f2bf(qv[i] * __expf(cum));
            QH[(16 * qt + i) * LP + k] = (bf16)f2bf(qv[i] * __expf(fminf(cum - ref, 80.f)));
            KH[(16 * qt + i) * LP + k] = (bf16)f2bf(kk * __expf(fminf(ref - cum, 80.f))); }
#pragma unroll
        for (int i = 0; i < 8; ++i) vw[i] = vv[2 * i] | (vv[2 * i + 1] << 16);
        *(LAS u32x4*)(VT + k * LP64 + 16 * qt) = (u32x4){vw[0], vw[1], vw[2], vw[3]}; *(LAS u32x4*)(VT + k * LP64 + 16 * qt + 8) = (u32x4){vw[4], vw[5], vw[6], vw[7]};
        WG_SYNC();
        {
            const int tb = wid & 3;
            bf16x8 qf[4];
#pragma unroll
            for (int ks = 0; ks < 4; ++ks) qf[ks] = lds_frag(QH, 16 * tb + c16, LP, 32 * ks + 8 * q);
#pragma unroll
            for (int sbi = 0; sbi < 2; ++sbi) { const int sb = 2 * (wid >> 2) + sbi; f32x4 acc = (f32x4){0.f, 0.f, 0.f, 0.f};
#pragma unroll
                for (int ks = 0; ks < 4; ++ks) acc = MFMA16(lds_frag(KH, 16 * sb + c16, LP, 32 * ks + 8 * q), qf[ks], acc);
                const int t = 16 * tb + c16, s0 = 16 * sb + 4 * q;
#pragma unroll
                for (int r = 0; r < 4; ++r) acc[r] = (s0 + r <= t) ? acc[r] : 0.f;
                *(LAS u32x2*)(PM + t * LP64 + s0) = pack4(acc); }
        }
        WG_SYNC();
        {
            const int tb = wid & 3, vh = wid >> 2, t = 16 * tb + c16;
            bf16x8 qf[4], pf[2];
#pragma unroll
            for (int ks = 0; ks < 4; ++ks) qf[ks] = lds_frag(QT, t, LP, 32 * ks + 8 * q);
#pragma unroll
            for (int ks = 0; ks < 2; ++ks) pf[ks] = lds_frag(PM, t, LP64, 32 * ks + 8 * q);
            f32x4 acc[4]; float sq = 0.f;
#pragma unroll
            for (int vb = 0; vb < 4; ++vb) { const int vr = 64 * vh + 16 * vb + c16; acc[vb] = (f32x4){0.f, 0.f, 0.f, 0.f};
#pragma unroll
                for (int ks = 0; ks < 4; ++ks) acc[vb] = MFMA16(lds_frag(STL, vr, LP, 32 * ks + 8 * q), qf[ks], acc[vb]);
#pragma unroll
                for (int ks = 0; ks < 2; ++ks) acc[vb] = MFMA16(lds_frag(VT, vr, LP64, 32 * ks + 8 * q), pf[ks], acc[vb]);
                sq += (acc[vb][0] * acc[vb][0] + acc[vb][1] * acc[vb][1]) + (acc[vb][2] * acc[vb][2] + acc[vb][3] * acc[vb][3]); }
            sq += __shfl_xor(sq, 16); sq += __shfl_xor(sq, 32);
            if (q == 0) SQ[vh * 64 + t] = sq;
            WG_SYNC();
            const float rstd = rsqrtf((SQ[t] + SQ[64 + t]) * (1.0f / 128.f) + EPS);
#pragma unroll
            for (int vb = 0; vb < 4; ++vb) { const int v0 = 64 * vh + 16 * vb + 4 * q; const f32x4 hn = *(const f32x4*)(hnorm + h * 128 + v0);
                const u32x2 gw = *(const u32x2*)(PROJ + (size_t)(tc + t) * ABIN + 5120 + h * 128 + v0);
                f32x4 y; y[0] = acc[vb][0] * rstd * hn[0] * bflo(gw.x); y[1] = acc[vb][1] * rstd * hn[1] * bfhi(gw.x); y[2] = acc[vb][2] * rstd * hn[2] * bflo(gw.y); y[3] = acc[vb][3] * rstd * hn[3] * bfhi(gw.y);
                *(u32x2*)(YAB + (size_t)(tc + t) * D + 1024 + h * 128 + v0) = pack4(y); }
        }
        WG_SYNC();
    }
}
__device__ __forceinline__ void ssd_prep_units(const int tid, LAS unsigned char* lds, int ufirst, int ustride, int uend, const bf16* XBC, const float* cw, const float* cb, bf16* XBT, bf16* BCN) {
    LAS bf16* T = (LAS bf16*)(lds);
    const int ch8 = tid & 15, tr = tid >> 4;
    for (int u = ufirst; u < uend; u += ustride) {
        const int bc = u / 48, cblk = u % 48, c = bc & 31; const int t0 = bc * 128; const int ch0 = cblk * 128 + ch8 * 8;
        u32x4 rows[7];
#pragma unroll
        for (int i = 0; i < 7; ++i) { const int s = 4 * tr + i - 3; rows[i] = (u32x4){0u, 0u, 0u, 0u}; if (c > 0 || s >= 0) rows[i] = *(const u32x4*)(XBC + (size_t)(t0 + s) * SSDCONV + ch0); }
        float w[4][8], bb[8];
        { const f32x4 b0 = *(const f32x4*)(cb + ch0), b1 = *(const f32x4*)(cb + ch0 + 4);
#pragma unroll
          for (int e = 0; e < 4; ++e) { bb[e] = b0[e]; bb[4 + e] = b1[e]; }
#pragma unroll
          for (int k = 0; k < 4; ++k) { const f32x4 w0 = *(const f32x4*)(cw + (size_t)k * SSDCONV + ch0), w1 = *(const f32x4*)(cw + (size_t)k * SSDCONV + ch0 + 4);
#pragma unroll
              for (int e = 0; e < 4; ++e) { w[k][e] = w0[e]; w[k][4 + e] = w1[e]; } } }
#pragma unroll
        for (int i = 0; i < 4; ++i) { float o[8];
#pragma unroll
            for (int e = 0; e < 8; ++e) { float a = bb[e];
#pragma unroll
                for (int k = 0; k < 4; ++k) { const unsigned wd = rows[i + k][e >> 1]; a += w[k][e] * ((e & 1) ? bfhi(wd) : bflo(wd)); }
                o[e] = siluf(a); }
            u32x4 pk; pk.x = cvt_pk_bf16(o[0], o[1]); pk.y = cvt_pk_bf16(o[2], o[3]); pk.z = cvt_pk_bf16(o[4], o[5]); pk.w = cvt_pk_bf16(o[6], o[7]);
            if (cblk >= 32) *(u32x4*)(BCN + (size_t)(t0 + 4 * tr + i) * 2048 + (ch0 - 4096)) = pk;
            if (cblk < 40) {
#pragma unroll
                for (int e = 0; e < 8; ++e) T[(ch8 * 8 + e) * LP + 4 * tr + i] = (bf16)(((e & 1) ? (pk[e >> 1] >> 16) : pk[e >> 1]) & 0xffffu); } }
        if (cblk < 40) {
            WG_SYNC();
#pragma unroll
            for (int i = 0; i < 4; ++i) { const int p = tid + NTHR * i, r = p >> 4, pc = p & 15;
                *(u32x4*)(XBT + ((size_t)bc * 5120 + cblk * 128 + r) * 128 + pc * 8) = *(const LAS u32x4*)(T + r * LP + pc * 8); }
            WG_SYNC();
        }
    }
}
__device__ __forceinline__ float ssd_tables(const float* DT, const float* a_log, int t0, int hd, int wid, int lane, LAS float* CUM, LAS float* DTS) {
    const float an = -__expf(a_log[hd]);
    const float d0 = DT[(size_t)(t0 + 2 * lane) * 64 + hd], d1 = DT[(size_t)(t0 + 2 * lane + 1) * 64 + hd];
    const float a0 = d0 * an, a1 = d1 * an; float v = a0 + a1;
#pragma unroll
    for (int o = 1; o < 64; o <<= 1) { const float t = __shfl_up(v, o); if (lane >= o) v += t; }
    CUM[wid * 128 + 2 * lane] = v - a1; CUM[wid * 128 + 2 * lane + 1] = v; DTS[wid * 128 + 2 * lane] = d0; DTS[wid * 128 + 2 * lane + 1] = d1;
    return __shfl(v, 63);
}
__device__ __forceinline__ void ssd1_units(const int tid, LAS unsigned char* lds, int G, int cu, const bf16* XBT, const float* DT, const float* a_log, bf16* ST, float* DEC) {
    const int wid = __builtin_amdgcn_readfirstlane(tid >> 6), lane = tid & 63, q = lane >> 4, c16 = lane & 15;
    LAS bf16* BT = (LAS bf16*)(lds);
    LAS float* CUM = (LAS float*)(lds + 34816);
    LAS float* DTS = (LAS float*)(lds + 38912);
    for (int u = cu; u < 1024; u += G) {
        const int bc = u >> 3, g = u & 7, t0 = bc * 128, hd = g * 8 + wid;
#pragma unroll
        for (int i = 0; i < 4; ++i) { const int p = tid + NTHR * i, r = p >> 4, pc = p & 15;
            *(LAS u32x4*)(BT + r * LP + pc * 8) = *(const u32x4*)(XBT + ((size_t)bc * 5120 + 4096 + g * 128 + r) * 128 + pc * 8); }
        const float last = ssd_tables(DT, a_log, t0, hd, wid, lane, CUM, DTS);
        if (lane == 0) DEC[bc * 64 + hd] = __expf(last);
        u32x4 xr[4][4];
#pragma unroll
        for (int pb = 0; pb < 4; ++pb)
#pragma unroll
            for (int ks = 0; ks < 4; ++ks) xr[pb][ks] = *(const u32x4*)(XBT + ((size_t)bc * 5120 + hd * 64 + 16 * pb + c16) * 128 + 32 * ks + 8 * q);
        WG_SYNC();
        bf16x8 xf[4][4];
#pragma unroll
        for (int ks = 0; ks < 4; ++ks) { float sc[8];
#pragma unroll
            for (int j = 0; j < 8; ++j) { const int s = 32 * ks + 8 * q + j; sc[j] = DTS[wid * 128 + s] * __expf(last - CUM[wid * 128 + s]); }
#pragma unroll
            for (int pb = 0; pb < 4; ++pb) { u32x4 o;
#pragma unroll
                for (int e = 0; e < 4; ++e) o[e] = cvt_pk_bf16(bflo(xr[pb][ks][e]) * sc[2 * e], bfhi(xr[pb][ks][e]) * sc[2 * e + 1]);
                xf[pb][ks] = __builtin_bit_cast(bf16x8, o); } }
#pragma unroll
        for (int nb = 0; nb < 8; ++nb) { bf16x8 bf[4];
#pragma unroll
            for (int ks = 0; ks < 4; ++ks) bf[ks] = lds_frag(BT, 16 * nb + c16, LP, 32 * ks + 8 * q);
#pragma unroll
            for (int pb = 0; pb < 4; ++pb) { f32x4 acc = (f32x4){0.f, 0.f, 0.f, 0.f};
#pragma unroll
                for (int ks = 0; ks < 4; ++ks) acc = MFMA16(bf[ks], xf[pb][ks], acc);
                *(u32x2*)(ST + (((size_t)bc * 64 + hd) * 64 + 16 * pb + c16) * 128 + 16 * nb + 4 * q) = pack4(acc); } }
        WG_SYNC();
    }
}
__device__ __forceinline__ void ssd2_scan(const int tid, int G, int cu, bf16* ST, const float* DEC) {
    for (int task = cu * NTHR + tid; task < NB * 4096 * 32; task += G * NTHR) {
        const int b = task >> 17, r = task & 131071, hp = r >> 5, n4 = (r & 31) * 4, hd = hp >> 6; f32x4 S = (f32x4){0.f, 0.f, 0.f, 0.f};
#pragma unroll 8
        for (int c = 0; c < 32; ++c) { const int bc = b * 32 + c; bf16* p = ST + ((size_t)bc * 4096 + hp) * 128 + n4; const u32x2 L = *(const u32x2*)p; const float d = DEC[bc * 64 + hd];
            *(u32x2*)p = pack4(S);
            S[0] = d * S[0] + bflo(L.x); S[1] = d * S[1] + bfhi(L.x); S[2] = d * S[2] + bflo(L.y); S[3] = d * S[3] + bfhi(L.y); }
    }
}
__device__ __forceinline__ void ssd3_units(const int tid, LAS unsigned char* lds, int G, int cu, const bf16* XBT, const bf16* BCN, const bf16* ST, const float* DT, const float* a_log, const float* dskip,
                                           const bf16* Z, const float* normw, bf16* Y) {
    const int wid = __builtin_amdgcn_readfirstlane(tid >> 6), lane = tid & 63, q = lane >> 4, c16 = lane & 15;
    LAS bf16* CN = (LAS bf16*)(lds);
    LAS bf16* BN = (LAS bf16*)(lds + 34816);
    LAS bf16* CB = (LAS bf16*)(lds + 69632);
    LAS bf16* XTh = (LAS bf16*)(lds + 104448);
    LAS bf16* STh = (LAS bf16*)(lds + 121856);
    LAS float* CUM = (LAS float*)(lds + 139264);
    LAS float* DTS = (LAS float*)(lds + 143360);
    for (int u = cu; u < 1024; u += G) {
        const int bc = u >> 3, g = u & 7, t0 = bc * 128;
#pragma unroll
        for (int i = 0; i < 4; ++i) { const int p = tid + NTHR * i, r = p >> 4, pc = p & 15; const bf16* src = BCN + (size_t)(t0 + r) * 2048 + g * 128 + pc * 8;
            *(LAS u32x4*)(BN + r * LP + pc * 8) = *(const u32x4*)src; *(LAS u32x4*)(CN + r * LP + pc * 8) = *(const u32x4*)(src + 1024); }
        (void)ssd_tables(DT, a_log, t0, g * 8 + wid, wid, lane, CUM, DTS);
        WG_SYNC();
        {
            bf16x8 cf[4];
#pragma unroll
            for (int ks = 0; ks < 4; ++ks) cf[ks] = lds_frag(CN, 16 * wid + c16, LP, 32 * ks + 8 * q);
#pragma unroll
            for (int sb = 0; sb < 8; ++sb) { if (sb > wid + 1) continue; f32x4 acc = (f32x4){0.f, 0.f, 0.f, 0.f};
#pragma unroll
                for (int ks = 0; ks < 4; ++ks) acc = MFMA16(lds_frag(BN, 16 * sb + c16, LP, 32 * ks + 8 * q), cf[ks], acc);
                *(LAS u32x2*)(CB + (16 * wid + c16) * LP + 16 * sb + 4 * q) = pack4(acc); }
        }
        const int tl = 16 * wid + c16;
        float sq = 0.f;
        bf16* yrow = Y + (size_t)(t0 + tl) * SSDIN + g * 512 + 4 * q;
        const int nks = (16 * wid + 15) / 32 + 1;
#pragma unroll 1
        for (int h = 0; h < 8; ++h) {
            const int hd = g * 8 + h;
            WG_SYNC();
#pragma unroll
            for (int i = 0; i < 2; ++i) { const int p = tid + NTHR * i, r = p >> 4, pc = p & 15;
                *(LAS u32x4*)(XTh + r * LP + pc * 8) = *(const u32x4*)(XBT + ((size_t)bc * 5120 + hd * 64 + r) * 128 + pc * 8);
                *(LAS u32x4*)(STh + r * LP + pc * 8) = *(const u32x4*)(ST + (((size_t)bc * 64 + hd) * 64 + r) * 128 + pc * 8); }
            WG_SYNC();
            const float cumt = CUM[h * 128 + tl], ect = __expf(cumt), dsk = dskip[hd];
            f32x4 acc[4];
            {
                bf16x8 cf[4];
#pragma unroll
                for (int ks = 0; ks < 4; ++ks) cf[ks] = lds_frag(CN, tl, LP, 32 * ks + 8 * q);
#pragma unroll
                for (int pb = 0; pb < 4; ++pb) { acc[pb] = (f32x4){0.f, 0.f, 0.f, 0.f};
#pragma unroll
                    for (int ks = 0; ks < 4; ++ks) acc[pb] = MFMA16(lds_frag(STh, 16 * pb + c16, LP, 32 * ks + 8 * q), cf[ks], acc[pb]);
                    acc[pb] = acc[pb] * ect; }
            }
            for (int ks = 0; ks < nks; ++ks) {
                const int s0 = 32 * ks + 8 * q; const u32x4 cbw = *(const LAS u32x4*)(CB + tl * LP + s0);
                const f32x4 c0 = *(const LAS f32x4*)(CUM + h * 128 + s0), c1 = *(const LAS f32x4*)(CUM + h * 128 + s0 + 4), d0 = *(const LAS f32x4*)(DTS + h * 128 + s0), d1 = *(const LAS f32x4*)(DTS + h * 128 + s0 + 4);
                float gv[8];
#pragma unroll
                for (int j = 0; j < 8; ++j) { const int s = s0 + j; const float cb = (j & 1) ? bfhi(cbw[j >> 1]) : bflo(cbw[j >> 1]); const float cs = j < 4 ? c0[j & 3] : c1[j & 3], ds = j < 4 ? d0[j & 3] : d1[j & 3];
                    float v = cb * __expf(fminf(cumt - cs, 0.f)) * ds; v = (s <= tl) ? v : 0.f; gv[j] = (s == tl) ? v + dsk : v; }
                u32x4 gw; gw.x = cvt_pk_bf16(gv[0], gv[1]); gw.y = cvt_pk_bf16(gv[2], gv[3]); gw.z = cvt_pk_bf16(gv[4], gv[5]); gw.w = cvt_pk_bf16(gv[6], gv[7]);
                const bf16x8 gf = __builtin_bit_cast(bf16x8, gw);
#pragma unroll
                for (int pb = 0; pb < 4; ++pb) acc[pb] = MFMA16(lds_frag(XTh, 16 * pb + c16, LP, s0), gf, acc[pb]);
            }
#pragma unroll
            for (int pb = 0; pb < 4; ++pb) { const u32x2 zw = *(const u32x2*)(Z + (size_t)(t0 + tl) * SSDIN + hd * 64 + 16 * pb + 4 * q);
                f32x4 y; y[0] = acc[pb][0] * bflo(zw.x); y[1] = acc[pb][1] * bfhi(zw.x); y[2] = acc[pb][2] * bflo(zw.y); y[3] = acc[pb][3] * bfhi(zw.y);
                sq += (y[0] * y[0] + y[1] * y[1]) + (y[2] * y[2] + y[3] * y[3]); *(u32x2*)(yrow + h * 64 + 16 * pb) = pack4(y); }
        }
        sq += __shfl_xor(sq, 16); sq += __shfl_xor(sq, 32);
        const float rstd = rsqrtf(sq * (1.0f / 512.f) + EPS);
        VM_WAIT();
#pragma unroll 1
        for (int h = 0; h < 8; ++h)
#pragma unroll
            for (int pb = 0; pb < 4; ++pb) { const int ch = (g * 8 + h) * 64 + 16 * pb + 4 * q; const f32x4 nw = *(const f32x4*)(normw + ch); bf16* yp = yrow + h * 64 + 16 * pb;
                const u32x2 w = *(const volatile u32x2*)yp;
                f32x4 y; y[0] = bflo(w.x) * rstd * nw[0]; y[1] = bfhi(w.x) * rstd * nw[1]; y[2] = bflo(w.y) * rstd * nw[2]; y[3] = bfhi(w.y) * rstd * nw[3];
                *(u32x2*)yp = pack4(y); }
        WG_SYNC();
    }
}
struct Args { In in; float* out; unsigned char* ws; int ph_lo, ph_hi; };
static_assert(sizeof(Args) == 32 * 8 + 8 + 8 + 8, "Args has no padding");
typedef const Args __attribute__((address_space(4))) CArgs;

#define PHASE_BEGIN if (pc >= lo && pc < hi) { int tid = wave0 * 64 + (int)__builtin_amdgcn_mbcnt_hi(~0u, __builtin_amdgcn_mbcnt_lo(~0u, 0u)); asm volatile("" : "+v"(tid)); int cu = blockIdx.x; asm volatile("" : "+s"(cu)); int G = gridDim.x; asm volatile("" : "+s"(G)); \
        const int lane = tid & 63, wave = __builtin_amdgcn_readfirstlane(tid >> 6), gw = cu * NWAVES + wave, NGW = G * NWAVES; (void)lane; (void)gw; (void)NGW; \
        CArgs* ap = (CArgs*)__builtin_amdgcn_kernarg_segment_ptr(); asm volatile("" : "+s"(ap)); CIn& I = ap->in; unsigned char* const ws = ap->ws; float* const xres = ap->out; \
        unsigned char* const act = ws + WS_ACT; float* const SS = (float*)(ws + WS_SS); bf16* const XB = (bf16*)(ws + WS_XB); bf16* const WL = (bf16*)(ws + WS_WL); (void)I; (void)xres; (void)act; (void)SS; (void)XB; (void)WL;
#if MK_SPLIT
#define PHASE_END } ++pc;
#else
#define PHASE_END if (pc + 1 < hi) xcd_barrier(bar); } ++pc;
#endif
#define D_WKV ((bf16*)(ws + WS_WKV))
#define D_KMAT ((bf16*)(ws + WS_KMAT))
#define D_VT ((bf16*)(ws + WS_VT))
#define D_MEMN ((bf16*)(ws + WS_MEMN))
#define D_LB ((float*)(ws + WS_TAB + TAB_LB))
#define D_WRT ((bf16*)(ws + WS_TAB + TAB_WRT))


template <int l>
__device__ __forceinline__ void layer_body(LAS unsigned char* lds, const int wave0, const int lo, const int hi, int& pc, const XcdBarrier& bar) {
    int ssi = 3 * l;

        if (l > 0) {
            PHASE_BEGIN
                convert_layer(I, l, WL, (LAS float*)(lds + wave * 16384), gw, NGW, lane);
            PHASE_END
        }
        const int e = l >> 1;
        int mixK;
        if ((l & 1) == 0) {
#define PROJ ((bf16*)(act + A_PROJ))
#define LOGF ((float*)(act + A_LOGF))
#define HST ((bf16*)(act + A_HST))
#define YAB ((bf16*)(act + A_YAB))
#define SEG ((float*)(act + A_SEG))
#define HDEC ((float*)(act + A_HDEC))
            PHASE_BEGIN
                pg8::SchedMN S; S.init(XB, D, WL + WL_IN, D, M, ABIN, G, cu); pg8::EpiProjEven E{SS + (size_t)ssi * M * 8, PROJ, LOGF, D_LB + e * 1024};
                pg8::gemm_phase(tid, lds, D, D, D, S, E);
            PHASE_END
            PHASE_BEGIN
                lru_units<false>(tid, lds, G, cu, PROJ, D_WRT + (size_t)e * 2 * 8 * 16384, I.lru_conv_w + e * 4 * LRUW, I.lru_conv_b + e * LRUW, I.lru_b_r + e * LRUW, I.lru_b_i + e * LRUW, I.lru_lambda + e * LRUW, SEG, YAB);
                hgrn1_units(tid, lds, G, cu, LOGF, PROJ, HST, HDEC);
            PHASE_END
            PHASE_BEGIN
                lru_units<true>(tid, lds, G, cu, PROJ, D_WRT + (size_t)e * 2 * 8 * 16384, I.lru_conv_w + e * 4 * LRUW, I.lru_conv_b + e * LRUW, I.lru_b_r + e * LRUW, I.lru_b_i + e * LRUW, I.lru_lambda + e * LRUW, SEG, YAB);
                hgrn2_scan(tid, G, cu, HST, HDEC);
            PHASE_END
            PHASE_BEGIN
                hgrn3_units(tid, lds, G, cu, LOGF, PROJ, HST, I.hgrn_norm + e * 1024, YAB);
            PHASE_END
            mixK = D;
        } else {
#define Zb ((bf16*)(act + A_Z))
#define XBC ((bf16*)(act + A_XBC))
#define XBT ((bf16*)(act + A_XBT))
#define BCN ((bf16*)(act + A_BCN))
#define STb ((bf16*)(act + A_ST))
#define DTb ((float*)(act + A_DT))
#define DEC ((float*)(act + A_DEC))
#define Yb ((bf16*)(act + A_Y))
            PHASE_BEGIN
                pg8::SchedMN S; S.init(XB, D, WL + WL_IN, D, M, SSDN1, G, cu); pg8::EpiProjOdd E{SS + (size_t)ssi * M * 8, Zb, XBC};
                pg8::gemm_phase(tid, lds, D, D, D, S, E);
            PHASE_END
            PHASE_BEGIN
                { pg8::SchedDt S{(const char*)XB, (const char*)(WL + WL_DT), cu}; pg8::EpiDt E{SS + (size_t)ssi * M * 8, I.ssd_dt_bias + e * 64, DTb};
                  pg8::gemm_phase(tid, lds, D, D, D, S, E); }
                { int uf = cu, us = G, ue = 6144; if (G == 256) { if (cu < 64) { us = 64; ue = 1152; } else { uf = 1152 + (cu - 64); us = 192; } }
                  ssd_prep_units(tid, lds, uf, us, ue, XBC, I.ssd_conv_w + (size_t)e * 4 * SSDCONV, I.ssd_conv_b + e * SSDCONV, XBT, BCN); }
            PHASE_END
            PHASE_BEGIN
                ssd1_units(tid, lds, G, cu, XBT, DTb, I.ssd_a_log + e * 64, STb, DEC);
            PHASE_END
            PHASE_BEGIN
                ssd2_scan(tid, G, cu, STb, DEC);
            PHASE_END
            PHASE_BEGIN
                ssd3_units(tid, lds, G, cu, XBT, BCN, STb, DTb, I.ssd_a_log + e * 64, I.ssd_d + e * 64, Zb, I.ssd_norm + e * SSDIN, Yb);
            PHASE_END
            mixK = SSDIN;
        }
        PHASE_BEGIN
            pg8::SchedMN S; S.init(mixK == D ? (const bf16*)YAB : (const bf16*)Yb, mixK, WL + WL_OUT, mixK, M, D, G, cu); pg8::EpiResid E{xres, XB, SS + (size_t)(ssi + 1) * M * 8, (LAS float*)(lds + EPI_OFF)};
            pg8::gemm_phase(tid, lds, mixK, mixK, mixK, S, E);
        PHASE_END
        ++ssi;
#define Qb ((bf16*)(act + A_Q))
#define Pb ((bf16*)(act + A_P))
#define Ob ((bf16*)(act + A_O))
#define Hb ((bf16*)(act + A_H))
        PHASE_BEGIN
            pg8::SchedMN S; S.init(XB, D, WL + WL_Q, D, M, D, G, cu); pg8::EpiQ E{SS + (size_t)ssi * M * 8, Qb, 0.044194173824159216f};
            pg8::gemm_phase(tid, lds, D, D, D, S, E);
        PHASE_END
        PHASE_BEGIN
            pg8::SchedS S{(const char*)Qb, (const char*)(D_KMAT + (size_t)l * MEMROWS * D), G, cu}; pg8::EpiSoftmax E{Pb, (LAS float*)(lds + EPI_OFF)};
            pg8::gemm_phase(tid, lds, XAD, D, D, S, E);
        PHASE_END
        PHASE_BEGIN
            pg8::SchedPV S{(const char*)Pb, (const char*)(D_VT + (size_t)l * D * MEMROWS), G, cu}; pg8::EpiPlain E{Ob, D};
            pg8::gemm_phase(tid, lds, MEMLEN, 1024, MEMROWS, S, E);
        PHASE_END
        PHASE_BEGIN
            pg8::SchedMN S; S.init(Ob, D, WL + WL_O, D, M, D, G, cu); pg8::EpiResid E{xres, XB, SS + (size_t)(ssi + 1) * M * 8, (LAS float*)(lds + EPI_OFF)};
            pg8::gemm_phase(tid, lds, D, D, D, S, E);
        PHASE_END
        ++ssi;
        PHASE_BEGIN
            pg8::SchedMN S; S.init(XB, D, WL + WL_GU, D, M, 2 * FF, G, cu); pg8::EpiGateUp E{SS + (size_t)ssi * M * 8, Hb};
            pg8::gemm_phase(tid, lds, D, D, D, S, E);
        PHASE_END
        PHASE_BEGIN
            pg8::SchedMN S; S.init(Hb, FF, WL + WL_DN, FF, M, D, G, cu); pg8::EpiResid E{xres, XB, SS + (size_t)(ssi + 1) * M * 8, (LAS float*)(lds + EPI_OFF)};
            pg8::gemm_phase(tid, lds, FF, FF, FF, S, E);
        PHASE_END
        ++ssi;
    }

__global__ void __launch_bounds__(NTHR, 2) fwd(Args args) {
    extern __shared__ __attribute__((aligned(16))) unsigned char lds_raw[];
    LAS unsigned char* lds = (LAS unsigned char*)lds_raw;
    volatile LAS unsigned* MISC = (volatile LAS unsigned*)(lds + MISC_OFF);
    const int wave0 = __builtin_amdgcn_readfirstlane((int)threadIdx.x >> 6);
    if (threadIdx.x < 64) MISC[threadIdx.x] = 0u;
    __syncthreads();
#if !MK_SPLIT
    XcdBarrier bar = xcd_barrier_post((unsigned*)(args.ws + WS_CTL), MISC + 8);
#else
    XcdBarrier bar; bar.bar = nullptr; bar.x = 0; bar.st = nullptr;
#endif
    const int lo = args.ph_lo, hi = args.ph_hi; int pc = 0;
    PHASE_BEGIN
        LAS float* scr = (LAS float*)(lds + wave * 16384);
        for (int l = 0; l < DEPTH; ++l) conv_matrix<0>(I.xa_w_kv + (size_t)l * D * 4096, 4096, D, 0, 4096, nullptr, D_WKV + (size_t)l * 4096 * D, 0, scr, gw, NGW, lane);
        convert_layer(I, 0, WL, scr, gw, NGW, lane);
        for (int m = gw; m < MEMROWS; m += NGW) {
            const f32x4* xr = (const f32x4*)(I.mem + (size_t)m * D); f32x4 v[8]; float s = 0.f;
#pragma unroll
            for (int j = 0; j < 8; ++j) { v[j] = xr[64 * j + lane]; s += (v[j][0] * v[j][0] + v[j][1] * v[j][1]) + (v[j][2] * v[j][2] + v[j][3] * v[j][3]); }
            const float rs = rsqrtf(wave_sum(s) * (1.0f / D) + EPS);
#pragma unroll
            for (int j = 0; j < 8; ++j) { const f32x4 g = *(const f32x4*)(I.norm_mem + (64 * j + lane) * 4); *(u32x2*)(D_MEMN + (size_t)m * D + (64 * j + lane) * 4) = pack4(v[j] * rs * g); }
        }
        for (int m = gw; m < M; m += NGW) {
            const f32x4* xr = (const f32x4*)(I.x + (size_t)m * D); f32x4* orow = (f32x4*)(xres + (size_t)m * D); float s = 0.f;
#pragma unroll
            for (int j = 0; j < 8; ++j) { const f32x4 v = xr[64 * j + lane]; s += (v[0] * v[0] + v[1] * v[1]) + (v[2] * v[2] + v[3] * v[3]); orow[64 * j + lane] = v; *(u32x2*)(XB + (size_t)m * D + (64 * j + lane) * 4) = pack4(v); }
            s = wave_sum(s); if (lane < 8) SS[(size_t)m * 8 + lane] = lane == 0 ? s : 0.f;
        }
        for (int i = cu * NTHR + tid; i < 1024; i += G * NTHR) {
            const float a = I.hgrn_lb[i], b = I.hgrn_lb[1024 + i], mx = fmaxf(a, b), e0 = __expf(a - mx), e1 = __expf(b - mx); D_LB[i] = 0.f; D_LB[1024 + i] = e1 / (e0 + e1); }
        for (int i = cu * NTHR + tid; i < 2 * 2 * 8 * 16384; i += G * NTHR) {
            const int ii = i & 127, jj = (i >> 7) & 127, blk = (i >> 14) & 7, gt = (i >> 17) & 1, e = i >> 18;
            const float* src = gt ? I.lru_w_i : I.lru_w_r; D_WRT[i] = (bf16)f2bf(src[((size_t)(e * 8 + blk) * 128 + ii) * 128 + jj]); }
    PHASE_END

    PHASE_BEGIN
        pg8::SchedKV S{(const char*)D_MEMN, (const char*)D_WKV, G, cu}; pg8::EpiKV E{D_KMAT, D_VT};
        pg8::gemm_phase(tid, lds, D, D, D, S, E);
    PHASE_END

    layer_body<0>(lds, wave0, lo, hi, pc, bar); layer_body<1>(lds, wave0, lo, hi, pc, bar); layer_body<2>(lds, wave0, lo, hi, pc, bar); layer_body<3>(lds, wave0, lo, hi, pc, bar);
    const int ssi = 12;
    PHASE_BEGIN
        const float* ssf = SS + (size_t)ssi * M * 8;
        for (int m = gw; m < M; m += NGW) { f32x4* row = (f32x4*)(xres + (size_t)m * D); const float rs = pg8::rstd_of(ssf, m);
#pragma unroll
            for (int j = 0; j < 8; ++j) { const f32x4 g = *(const f32x4*)(I.norm_final + (64 * j + lane) * 4); row[64 * j + lane] = row[64 * j + lane] * rs * g; } }
    PHASE_END
#undef PHASE_BEGIN
#undef PHASE_END
}

constexpr int NPHASES = 2 + (5 + 6) + (1 + 6 + 6) + (1 + 5 + 6) + (1 + 6 + 6) + 1;

extern "C" void kernel_launch(void* const* d_in, const int* in_sizes, int n_in, void* d_out, int out_size, void* d_ws, size_t ws_size, hipStream_t stream) {
    static int grid = 0;
    if (grid == 0) {
        if (n_in != 32 || out_size != M * D || ws_size < WS_END) { fprintf(stderr, "kernel_launch: unexpected problem (n_in %d, out %d, ws %zu)\n", n_in, out_size, ws_size); grid = -1; return; }
        int dev = 0, cus = 0;
        if (hipGetDevice(&dev) != hipSuccess || hipDeviceGetAttribute(&cus, hipDeviceAttributeMultiprocessorCount, dev) != hipSuccess) { grid = -1; return; }
        if (hipFuncSetAttribute((const void*)fwd, hipFuncAttributeMaxDynamicSharedMemorySize, LDS_BYTES) != hipSuccess) { fprintf(stderr, "kernel_launch: hipFuncSetAttribute failed\n"); grid = -1; return; }
        int per_cu = 0;
        if (hipOccupancyMaxActiveBlocksPerMultiprocessor(&per_cu, (const void*)fwd, NTHR, LDS_BYTES) != hipSuccess || per_cu < 1) fprintf(stderr, "kernel_launch: occupancy query says %d\n", per_cu);
        (void)hipGetLastError();
        grid = cus;
    }
    if (grid < 0) return;
    (void)hipMemsetAsync((char*)d_ws + WS_CTL, 0, CTL_ZERO_BYTES, stream);
    Args a{};
    const float** ip = (const float**)&a.in;
    for (int i = 0; i < 32; ++i) ip[i] = (const float*)d_in[i];
    a.out = (float*)d_out; a.ws = (unsigned char*)d_ws;
#if MK_SPLIT
    for (int li = 0; li < NPHASES; ++li) { a.ph_lo = li; a.ph_hi = li + 1; hipLaunchKernelGGL(fwd, dim3(grid), dim3(NTHR), LDS_BYTES, stream, a); }
#else
    a.ph_lo = 0; a.ph_hi = NPHASES;
    hipLaunchKernelGGL(fwd, dim3(grid), dim3(NTHR), LDS_BYTES, stream, a);
#endif
}
```

```cpp
#include <hip/hip_runtime.h>
#include <cstdio>
#include <cstdint>

#ifndef MK_SPLIT
#define MK_SPLIT 0
#endif

#define GAS __attribute__((address_space(1)))
#define LAS __attribute__((address_space(3)))
typedef unsigned short bf16;
typedef short bf16x8 __attribute__((ext_vector_type(8)));
typedef float f32x4 __attribute__((ext_vector_type(4)));
typedef float f32x2 __attribute__((ext_vector_type(2)));
typedef unsigned u32x4 __attribute__((ext_vector_type(4)));
typedef unsigned u32x2 __attribute__((ext_vector_type(2)));

constexpr int D = 2048, NB = 4, SEQ = 4096, M = NB * SEQ, DEPTH = 4, MEMLEN = 256, MEMROWS = NB * MEMLEN;
constexpr int LRUW = 1024, ABIN = 6144;
constexpr int SSDIN = 4096, SSDCONV = 6144, SSDPROJ = 10304, SSDN1 = 10240, NHEADS = 64;
constexpr int XAD = 512, FF = 5632;
constexpr float EPS = 1e-6f;
constexpr int NWAVES = 8, NTHR = 512;

constexpr size_t MiB = 1u << 20;
constexpr size_t WS_CTL = 0, CTL_ZERO_BYTES = 1 * MiB;
constexpr size_t WS_WKV = 2 * MiB;
constexpr size_t WS_KMAT = 66 * MiB;
constexpr size_t WS_VT = 82 * MiB;
constexpr size_t WS_MEMN = 98 * MiB;
constexpr size_t WS_TAB = 102 * MiB;
constexpr size_t WS_XB = 106 * MiB;
constexpr size_t WS_WL = 170 * MiB;
constexpr size_t WS_ACT = 310 * MiB;
constexpr size_t WS_SS = (310 + 680) * MiB;
constexpr size_t WS_END = (310 + 680 + 8) * MiB;
constexpr size_t TAB_LB = 0;
constexpr size_t TAB_WRT = 64 * 1024;
constexpr size_t WL_IN = 0;
constexpr size_t WL_DT = (size_t)SSDN1 * D;
constexpr size_t WL_OUT = (size_t)(SSDN1 + 256) * D;
constexpr size_t WL_Q = WL_OUT + (size_t)D * SSDIN;
constexpr size_t WL_O = WL_Q + (size_t)D * D;
constexpr size_t WL_GU = WL_O + (size_t)D * D;
constexpr size_t WL_DN = WL_GU + (size_t)2 * FF * D;
constexpr size_t WL_ELEMS = WL_DN + (size_t)D * FF;
static_assert(WL_ELEMS * 2 <= 140 * MiB, "per-layer weights");
constexpr size_t A_Z = 0;
constexpr size_t A_XBC = 128 * MiB;
constexpr size_t A_Y = 128 * MiB;
constexpr size_t A_XBT = 320 * MiB;
constexpr size_t A_BCN = 480 * MiB;
constexpr size_t A_ST = 544 * MiB;
constexpr size_t A_DT = 672 * MiB;
constexpr size_t A_DEC = 676 * MiB;
constexpr size_t A_PROJ = 0;
constexpr size_t A_LOGF = 192 * MiB;
constexpr size_t A_HST = 256 * MiB;
constexpr size_t A_YAB = 320 * MiB;
constexpr size_t A_SEG = 384 * MiB;
constexpr size_t A_HDEC = 386 * MiB;
constexpr size_t A_Q = 0;
constexpr size_t A_P = 64 * MiB;
constexpr size_t A_O = 96 * MiB;
constexpr size_t A_H = 160 * MiB;

constexpr int LDS_BYTES = 155648;
constexpr int EPI_OFF = 131072;
constexpr int MISC_OFF = LDS_BYTES - 256;

#define LDS_WAIT() asm volatile("s_waitcnt lgkmcnt(0)" ::: "memory")
#define VM_WAIT() asm volatile("s_waitcnt vmcnt(0)" ::: "memory")
__device__ __forceinline__ unsigned f2bf(float f) { unsigned u = __builtin_bit_cast(unsigned, f); return (u + 0x7fffu + ((u >> 16) & 1u)) >> 16; }
__device__ __forceinline__ unsigned pk2(float lo, float hi) { return f2bf(lo) | (f2bf(hi) << 16); }
typedef __bf16 bf16x2v __attribute__((ext_vector_type(2)));
__device__ __forceinline__ unsigned cvt_pk_bf16(float lo, float hi) { const f32x2 v = {lo, hi}; return __builtin_bit_cast(unsigned, __builtin_convertvector(v, bf16x2v)); }
__device__ __forceinline__ float bflo(unsigned w) { return __uint_as_float(w << 16); }
__device__ __forceinline__ float bfhi(unsigned w) { return __uint_as_float(w & 0xffff0000u); }
__device__ __forceinline__ float bf2f(bf16 b) { return __uint_as_float((unsigned)b << 16); }
__device__ __forceinline__ float sigm(float x) { return 1.f / (1.f + __expf(-x)); }
__device__ __forceinline__ float siluf(float x) { return x * sigm(x); }
__device__ __forceinline__ float gelu_tanh(float x) { return x * sigm(1.5957691216f * (x + 0.044715f * x * x * x)); }
__device__ __forceinline__ float softplusf(float x) { const float e = __expf(-fabsf(x)); const float l = (e < 0.03f) ? e * (1.f - e * (0.5f - e * 0.33333333f)) : __logf(1.f + e); return fmaxf(x, 0.f) + l; }
__device__ __forceinline__ float wave_sum(float v) {
#pragma unroll
    for (int o = 1; o < 64; o <<= 1) v += __shfl_xor(v, o);
    return v;
}

#define XB_TMO      128
#define XB_XCNT(j)  (256  + 64 * (j))
#define XB_XSUB(j)  (1280 + 64 * (j))
#define XB_XGEN(j)  (2304 + 64 * (j))
#define XB_TOP      3328
#define XB_TOPGEN   3392
#define XCD_BAR_WORDS 3456
#define XB_SPIN_CAP (1u << 18)

__device__ __forceinline__ unsigned xb_ld(unsigned* p)              { return __hip_atomic_load(p, __ATOMIC_RELAXED, __HIP_MEMORY_SCOPE_AGENT); }
__device__ __forceinline__ unsigned xb_add(unsigned* p, unsigned v) { return __hip_atomic_fetch_add(p, v, __ATOMIC_RELAXED, __HIP_MEMORY_SCOPE_AGENT); }
__device__ __forceinline__ unsigned xb_xcc_id() { return (unsigned)__builtin_amdgcn_s_getreg((3 << 11) | 20) & 0xFu; }
#define XB_SPIN(cond, bar) do { unsigned _sp = 0; while (cond) { __builtin_amdgcn_s_sleep(1); \
    if ((++_sp & 255u) == 0u) { if (xb_ld(&(bar)[XB_TMO])) break; if (_sp > XB_SPIN_CAP) { atomicAdd(&(bar)[XB_TMO], 1u); break; } } } } while (0)

struct XcdBarrier {
    unsigned* bar; unsigned x;
    volatile LAS unsigned* st;
};
__device__ __forceinline__ XcdBarrier xcd_barrier_post(unsigned* bar, volatile LAS unsigned* st) {
    XcdBarrier b; b.bar = bar; b.x = xb_xcc_id(); b.st = st;
    if (threadIdx.x == 0) (void)xb_add(&bar[XB_XCNT(b.x)], 1u);
    return b;
}
__device__ __forceinline__ void xcd_barrier_complete(unsigned* bar, unsigned x, unsigned& nloc, unsigned& nx) {
    const unsigned G = gridDim.x * gridDim.y * gridDim.z;
    unsigned sum, cnt, mine, sp = 0u;
    for (;;) {
        sum = 0u; cnt = 0u; mine = 0u;
#pragma unroll
        for (unsigned j = 0; j < 16; ++j) { const unsigned c = xb_ld(&bar[XB_XCNT(j)]); sum += c; cnt += (c > 0u) ? 1u : 0u; mine = (j == x) ? c : mine; }
        if (sum == G) break;
        __builtin_amdgcn_s_sleep(1);
        if ((++sp & 255u) == 0u) { if (xb_ld(&bar[XB_TMO])) break; if (sp > XB_SPIN_CAP) { atomicAdd(&bar[XB_TMO], 1u); break; } }
    }
    nloc = mine > 0u ? mine : 1u; nx = cnt > 0u ? cnt : 1u;
}
__device__ __forceinline__ void xcd_barrier(const XcdBarrier& b) {
    asm volatile("s_waitcnt vmcnt(0)" ::: "memory");
    __syncthreads();
    if (threadIdx.x == 0) {
        unsigned* bar = b.bar;
        __builtin_amdgcn_s_waitcnt(0);
        unsigned nloc = b.st[0], nx = b.st[1];
        if (nloc == 0u) { xcd_barrier_complete(bar, b.x, nloc, nx); b.st[0] = nloc; b.st[1] = nx; }
        const unsigned old = xb_add(&bar[XB_XSUB(b.x)], 1u);
        const unsigned gen = old / nloc;
        if (old + 1u == (gen + 1u) * nloc) {
            __builtin_amdgcn_fence(__ATOMIC_RELEASE, "agent");
            asm volatile("s_waitcnt vmcnt(0)" ::: "memory");
            const unsigned og = xb_add(&bar[XB_TOP], 1u);
            const unsigned tg = og / nx;
            if (og + 1u == (tg + 1u) * nx) xb_add(&bar[XB_TOPGEN], 1u);
            else XB_SPIN(xb_ld(&bar[XB_TOPGEN]) == tg, bar);
            __builtin_amdgcn_fence(__ATOMIC_ACQUIRE, "agent");
            xb_add(&bar[XB_XGEN(b.x)], 1u);
            asm volatile("s_waitcnt vmcnt(0)" ::: "memory");
        } else {
            XB_SPIN(xb_ld(&bar[XB_XGEN(b.x)]) == gen, bar);
            __builtin_amdgcn_fence(__ATOMIC_ACQUIRE, "agent");
            asm volatile("s_waitcnt vmcnt(0)" ::: "memory");
        }
    }
    __syncthreads();
}

namespace pg8 {
constexpr int BM = 256, BK = 64, HALF = 128, HTB = HALF * BK * 2, STAGE_BYTES = 8 * HTB, NXCD = 8, WGM = 8;
__host__ __device__ __forceinline__ int lds_byte(int r, int c) { const int st = (r >> 4) * 2 + (c >> 5), rr = r & 15, cc = c & 31, ob = rr * 64 + cc * 2; return st * 1024 + (ob ^ (((ob >> 9) & 1) << 5)); }
__host__ __device__ __forceinline__ void stage_rc(int b, int& R, int& C) { const int st = b / 1024, sb = b % 1024, swz = sb ^ (((sb >> 9) & 1) << 5); R = (st >> 1) * 16 + swz / 64; C = (st & 1) * 32 + (swz % 64) / 2; }
__host__ __device__ __forceinline__ int perm32(int rho) { const int n = rho >> 4, i = rho & 15; return 8 * (i >> 2) + 4 * n + (i & 3); }

struct Unit { const char* a; const char* b; int orow, ocol, aux; };

template <class Epi, class Sched>
__device__ __forceinline__ void gemm_phase(const int tid, LAS unsigned char* lds, const int K, const int lda, const int ldb, const Sched& S, const Epi& E) {
    const int wid = __builtin_amdgcn_readfirstlane(tid >> 6), lane = tid & 63, wr = wid >> 2, wc = wid & 3, fr = lane & 15, fq = lane >> 4;
    const int nt = K / BK;
    unsigned voffA[2], voffB[2];
#pragma unroll
    for (int i = 0; i < 2; ++i) { int R, C; stage_rc(tid * 16 + i * 8192, R, C); const int Rb = (R & ~31) + perm32(R & 31);
        voffA[i] = (unsigned)(R * lda + C) * 2u; voffB[i] = (unsigned)(Rb * ldb + C) * 2u; }
    const size_t kstep = (size_t)(BK * 2);
    const size_t hstepA = (size_t)HALF * lda * 2, hstepB = (size_t)HALF * ldb * 2;
    const unsigned ldsw = (unsigned)wid * 1024u;
    const int aoff = lds_byte(wr * 64 + fr, fq * 8), boff = lds_byte(wc * 32 + fr, fq * 8);
#define PG8_SA(b, h) (((b) * 2 + (h)) * HTB)
#define PG8_SB(b, h) ((4 + (b) * 2 + (h)) * HTB)
#define PG8_STAGE(bufoff, gbase, voff) do { _Pragma("unroll") for (int _i = 0; _i < 2; ++_i) \
        __builtin_amdgcn_global_load_lds((const unsigned*)((const char*)(gbase) + (voff)[_i]), (LAS unsigned*)(lds + (bufoff) + ldsw + _i * 8192), 16, 0, 0); } while (0)
#define PG8_LDA(dst, b, h) do { _Pragma("unroll") for (int m = 0; m < 4; ++m) _Pragma("unroll") for (int k = 0; k < 2; ++k) dst[m][k] = *(const LAS bf16x8*)(lds + PG8_SA(b, h) + aoff + m * 2048 + k * 1024); } while (0)
#define PG8_LDB(dst, b, h) do { _Pragma("unroll") for (int n = 0; n < 2; ++n) _Pragma("unroll") for (int k = 0; k < 2; ++k) dst[n][k] = *(const LAS bf16x8*)(lds + PG8_SB(b, h) + boff + n * 2048 + k * 1024); } while (0)
#define PG8_MMA(ai, bj, At, Bt) do { __builtin_amdgcn_s_setprio(1); _Pragma("unroll") for (int m = 0; m < 4; ++m) _Pragma("unroll") for (int n = 0; n < 2; ++n) _Pragma("unroll") for (int k = 0; k < 2; ++k) \
        acc[ai][bj][m][n] = __builtin_amdgcn_mfma_f32_16x16x32_bf16(Bt[n][k], At[m][k], acc[ai][bj][m][n], 0, 0, 0); __builtin_amdgcn_s_setprio(0); } while (0)
#define PG8_WAIT_V(n) asm volatile("s_waitcnt vmcnt(" #n ")" ::: "memory")
#define PG8_WAIT_L(n) asm volatile("s_waitcnt lgkmcnt(" #n ")" ::: "memory")
#define PG8_BAR __builtin_amdgcn_s_barrier()
#define PG8_SCHED __builtin_amdgcn_sched_barrier(0)
    Unit cur, nxt; int ui = 0;
    if (!S.next(0, cur)) return;
    f32x4 acc[2][2][4][2];
#pragma unroll
    for (int a = 0; a < 2; ++a)
#pragma unroll
        for (int b = 0; b < 2; ++b)
#pragma unroll
            for (int m = 0; m < 4; ++m)
#pragma unroll
                for (int n = 0; n < 2; ++n) acc[a][b][m][n] = (f32x4){0.f, 0.f, 0.f, 0.f};
    bf16x8 At[4][2], B0[2][2], B1[2][2];
    const char* cA = cur.a; const char* cB = cur.b;
    PG8_STAGE(PG8_SB(0, 0), cB, voffB); PG8_STAGE(PG8_SB(0, 1), cB + hstepB, voffB); PG8_STAGE(PG8_SA(0, 0), cA, voffA); PG8_STAGE(PG8_SA(0, 1), cA + hstepA, voffA);
    if (wr == 1) PG8_BAR;
    PG8_WAIT_V(2); PG8_BAR;
    PG8_STAGE(PG8_SB(1, 0), cB + kstep, voffB); PG8_STAGE(PG8_SA(1, 0), cA + kstep, voffA); PG8_STAGE(PG8_SB(1, 1), cB + hstepB + kstep, voffB);
    PG8_WAIT_V(6); PG8_BAR;
    for (;;) {
        const bool has_next = S.next(ui + 1, nxt);
        const char* nA = has_next ? nxt.a : cA; const char* nB = has_next ? nxt.b : cB;
        for (int t = 0; t < nt; t += 2) {
            const bool last = (t == nt - 2);
            const char* a1 = cA + (size_t)(t + 1) * kstep;
            const char* a2 = last ? nA : cA + (size_t)(t + 2) * kstep; const char* b2 = last ? nB : cB + (size_t)(t + 2) * kstep;
            const char* a3 = a2 + kstep; const char* b3 = b2 + kstep;
            PG8_LDB(B0, 0, 0); PG8_LDB(B1, 0, 1); PG8_SCHED; PG8_LDA(At, 0, 0); PG8_STAGE(PG8_SA(1, 1), a1 + hstepA, voffA);
            PG8_WAIT_V(8); PG8_WAIT_L(0); PG8_BAR; PG8_MMA(0, 0, At, B0); PG8_MMA(0, 1, At, B1); PG8_BAR; PG8_SCHED;
            PG8_LDA(At, 0, 1); PG8_STAGE(PG8_SB(0, 0), b2, voffB); PG8_STAGE(PG8_SB(0, 1), b2 + hstepB, voffB); PG8_STAGE(PG8_SA(0, 0), a2, voffA);
            PG8_WAIT_V(8); PG8_WAIT_L(0); PG8_BAR; PG8_MMA(1, 0, At, B0); PG8_MMA(1, 1, At, B1); PG8_BAR; PG8_SCHED;
            PG8_LDB(B0, 1, 0); PG8_LDB(B1, 1, 1); PG8_SCHED; PG8_LDA(At, 1, 0); PG8_STAGE(PG8_SA(0, 1), a2 + hstepA, voffA);
            PG8_WAIT_V(8); PG8_WAIT_L(0); PG8_BAR; PG8_MMA(0, 0, At, B0); PG8_MMA(0, 1, At, B1); PG8_BAR; PG8_SCHED;
            PG8_LDA(At, 1, 1); PG8_STAGE(PG8_SB(1, 0), b3, voffB); PG8_STAGE(PG8_SB(1, 1), b3 + hstepB, voffB); PG8_STAGE(PG8_SA(1, 0), a3, voffA);
            PG8_WAIT_V(8); PG8_WAIT_L(0); PG8_BAR; PG8_MMA(1, 0, At, B0); PG8_MMA(1, 1, At, B1); PG8_BAR; PG8_SCHED;
        }
        if (wr == 0) PG8_BAR;
        E(acc, cur, wr, wc, fr, fq);
        if (!has_next) break;
#pragma unroll
        for (int a = 0; a < 2; ++a)
#pragma unroll
            for (int b = 0; b < 2; ++b)
#pragma unroll
                for (int m = 0; m < 4; ++m)
#pragma unroll
                    for (int n = 0; n < 2; ++n) acc[a][b][m][n] = (f32x4){0.f, 0.f, 0.f, 0.f};
        cur = nxt; cA = nA; cB = nB; ++ui;
        if (wr == 1) PG8_BAR;
    }
    PG8_WAIT_V(0);
    PG8_BAR;
#undef PG8_SA
#undef PG8_SB
#undef PG8_STAGE
#undef PG8_LDA
#undef PG8_LDB
#undef PG8_MMA
#undef PG8_WAIT_V
#undef PG8_WAIT_L
#undef PG8_SCHED
}
}
namespace pg8 {
struct SchedMN {
    const char* A; const char* Bt; int lda, ldb; int nM, nN, nwg, G, c;
    __device__ __forceinline__ void init(const bf16* A_, int lda_, const bf16* Bt_, int ldb_, int Mrows, int Ncols, int G_, int c_) {
        A = (const char*)A_; Bt = (const char*)Bt_; lda = lda_; ldb = ldb_; nM = Mrows / BM; nN = Ncols / BM; nwg = nM * nN; G = G_; c = c_; }
    __device__ __forceinline__ bool next(int i, Unit& u) const {
        const long L = (long)i * G + c; if (L >= nwg) return false;
        int wgid = (int)L; { const int q = nwg / NXCD, r = nwg % NXCD, xcd = wgid % NXCD, off = wgid / NXCD; wgid = (xcd < r ? xcd * (q + 1) : r * (q + 1) + (xcd - r) * q) + off; }
        const int nig = WGM * nN, gid = wgid / nig, fm = gid * WGM, gsz = (nM - fm) < WGM ? (nM - fm) : WGM;
        const int pm = fm + ((wgid % nig) % gsz), pn = (wgid % nig) / gsz;
        u.a = A + (size_t)pm * BM * lda * 2; u.b = Bt + (size_t)pn * BM * ldb * 2; u.orow = pm * BM; u.ocol = pn * BM; u.aux = pn; return true;
    }
};
struct SchedKV {
    const char* memn; const char* wkv; int G, c;
    __device__ __forceinline__ bool next(int i, Unit& u) const {
        const int L = i * G + c; if (L >= 256) return false;
        const int l = L >> 6, r = L & 63; const char* w = wkv + (size_t)l * 4096 * D * 2;
        if (r < 32) { const int pm = r >> 3, pn = r & 7; u.a = memn + (size_t)pm * 256 * D * 2; u.b = w + (size_t)pn * 256 * D * 2; u.orow = pm * 256; u.ocol = pn * 256; u.aux = l * 2; }
        else { const int q = r - 32, pm = q >> 2, pn = q & 3; u.a = w + (size_t)(2048 + pm * 256) * D * 2; u.b = memn + (size_t)pn * 256 * D * 2; u.orow = pm * 256; u.ocol = pn * 256; u.aux = l * 2 + 1; }
        return true;
    }
};
struct SchedS {
    const char* Q; const char* Km; int G, c;
    __device__ __forceinline__ bool next(int i, Unit& u) const {
        const int L = i * G + c; if (L >= 256) return false;
        const int bh = 2 * (L & 7) + ((L >> 3) >> 4), it = (L >> 3) & 15, b = bh >> 2, h = bh & 3;
        u.a = Q + ((size_t)(b * SEQ + it * 256) * D + h * XAD) * 2; u.b = Km + ((size_t)(b * MEMLEN) * D + h * XAD) * 2; u.orow = b * SEQ + it * 256; u.ocol = h * 256; u.aux = 0; return true;
    }
};
struct SchedPV {
    const char* P; const char* Vt; int G, c;
    __device__ __forceinline__ bool next(int i, Unit& u) const {
        const int L = i * G + c; if (L >= 512) return false;
        const int x = L & 7, r = L >> 3;
        const int bh = 2 * x + (r >> 5), q = r & 31, it = q >> 1, nh = q & 1, b = bh >> 2, h = bh & 3;
        u.a = P + ((size_t)(b * SEQ + it * 256) * 1024 + h * 256) * 2; u.b = Vt + ((size_t)(h * XAD + nh * 256) * 1024 + b * MEMLEN) * 2; u.orow = b * SEQ + it * 256; u.ocol = h * XAD + nh * 256; u.aux = 0; return true;
    }
};
struct SchedDt {
    const char* A; const char* Bt; int c;
    __device__ __forceinline__ bool next(int i, Unit& u) const {
        if (i != 0 || c >= 64) return false;
        u.a = A + (size_t)c * 256 * D * 2; u.b = Bt; u.orow = c * 256; u.ocol = 0; u.aux = 0; return true;
    }
};

#define EPI_ARGS f32x4 (&acc)[2][2][4][2], const Unit& u, int wr, int wc, int fr, int fq
#define EPI_ROW(ai, m) (u.orow + (ai) * HALF + wr * 64 + (m) * 16 + fr)
#define EPI_COL(bj) (u.ocol + (bj) * HALF + wc * 32 + 8 * fq)
__device__ __forceinline__ float rstd_of(const float* ss, int row) { const f32x4 a = *(const f32x4*)(ss + (size_t)row * 8), b = *(const f32x4*)(ss + (size_t)row * 8 + 4);
    return rsqrtf((((a[0] + a[1]) + (a[2] + a[3])) + ((b[0] + b[1]) + (b[2] + b[3]))) * (1.0f / D) + EPS); }
__device__ __forceinline__ u32x4 pack8(const f32x4 a, const f32x4 b) { u32x4 w; w.x = cvt_pk_bf16(a[0], a[1]); w.y = cvt_pk_bf16(a[2], a[3]); w.z = cvt_pk_bf16(b[0], b[1]); w.w = cvt_pk_bf16(b[2], b[3]); return w; }

struct EpiProjEven {
    const float* ss; bf16* proj; float* logf; const float* lb;
    __device__ __forceinline__ void operator()(EPI_ARGS) const {
        const int range = u.aux >> 2;
#pragma unroll
        for (int ai = 0; ai < 2; ++ai)
#pragma unroll
            for (int m = 0; m < 4; ++m) { const int row = EPI_ROW(ai, m); const float rs = rstd_of(ss, row);
#pragma unroll
                for (int bj = 0; bj < 2; ++bj) { const int col = EPI_COL(bj); f32x4 v0 = acc[ai][bj][m][0] * rs, v1 = acc[ai][bj][m][1] * rs;
                    if (range == 3) { const int c = col - 3072; const f32x4 l0 = *(const f32x4*)(lb + c), l1 = *(const f32x4*)(lb + c + 4);
#pragma unroll
                        for (int j = 0; j < 4; ++j) { v0[j] = __logf(l0[j] + (1.f - l0[j]) * sigm(v0[j])); v1[j] = __logf(l1[j] + (1.f - l1[j]) * sigm(v1[j])); }
                        float* p = logf + (size_t)row * 1024 + c; *(f32x4*)p = v0; *(f32x4*)(p + 4) = v1;
                    } else {
                        if (range == 1) {
#pragma unroll
                            for (int j = 0; j < 4; ++j) { v0[j] = gelu_tanh(v0[j]); v1[j] = gelu_tanh(v1[j]); } }
                        else if (range == 2 || range == 5) {
#pragma unroll
                            for (int j = 0; j < 4; ++j) { v0[j] = siluf(v0[j]); v1[j] = siluf(v1[j]); } }
                        *(u32x4*)(proj + (size_t)row * ABIN + col) = pack8(v0, v1);
                    } } }
    }
};
struct EpiProjOdd {
    const float* ss; bf16* Z; bf16* XBC;
    __device__ __forceinline__ void operator()(EPI_ARGS) const {
        const bool isz = u.ocol < SSDIN;
#pragma unroll
        for (int ai = 0; ai < 2; ++ai)
#pragma unroll
            for (int m = 0; m < 4; ++m) { const int row = EPI_ROW(ai, m); const float rs = rstd_of(ss, row);
#pragma unroll
                for (int bj = 0; bj < 2; ++bj) { const int col = EPI_COL(bj); f32x4 v0 = acc[ai][bj][m][0] * rs, v1 = acc[ai][bj][m][1] * rs;
                    if (isz) {
#pragma unroll
                        for (int j = 0; j < 4; ++j) { v0[j] = siluf(v0[j]); v1[j] = siluf(v1[j]); }
                        *(u32x4*)(Z + (size_t)row * SSDIN + col) = pack8(v0, v1);
                    } else *(u32x4*)(XBC + (size_t)row * SSDCONV + (col - SSDIN)) = pack8(v0, v1); } }
    }
};
struct EpiDt {
    const float* ss; const float* bias; float* DT;
    __device__ __forceinline__ void operator()(EPI_ARGS) const {
        if (wc >= 2) return;
        const int col = wc * 32 + 8 * fq; const f32x4 b0 = *(const f32x4*)(bias + col), b1 = *(const f32x4*)(bias + col + 4);
#pragma unroll
        for (int ai = 0; ai < 2; ++ai)
#pragma unroll
            for (int m = 0; m < 4; ++m) { const int row = EPI_ROW(ai, m); const float rs = rstd_of(ss, row);
                f32x4 v0 = acc[ai][0][m][0] * rs + b0, v1 = acc[ai][0][m][1] * rs + b1;
#pragma unroll
                for (int j = 0; j < 4; ++j) { v0[j] = softplusf(v0[j]); v1[j] = softplusf(v1[j]); }
                float* p = DT + (size_t)row * 64 + col; *(f32x4*)p = v0; *(f32x4*)(p + 4) = v1; }
    }
};
struct EpiResid {
    float* x; bf16* xb; float* ssnew; LAS float* tab;
    __device__ __forceinline__ void operator()(EPI_ARGS) const {
#pragma unroll
        for (int ai = 0; ai < 2; ++ai)
#pragma unroll
            for (int m = 0; m < 4; ++m) { const int row = EPI_ROW(ai, m); float sq = 0.f;
#pragma unroll
                for (int bj = 0; bj < 2; ++bj) { const int col = EPI_COL(bj); float* p = x + (size_t)row * D + col;
                    const f32x4 o0 = *(const f32x4*)p + acc[ai][bj][m][0], o1 = *(const f32x4*)(p + 4) + acc[ai][bj][m][1];
                    *(f32x4*)p = o0; *(f32x4*)(p + 4) = o1; *(u32x4*)(xb + (size_t)row * D + col) = pack8(o0, o1);
                    sq += ((o0[0] * o0[0] + o0[1] * o0[1]) + (o0[2] * o0[2] + o0[3] * o0[3])) + ((o1[0] * o1[0] + o1[1] * o1[1]) + (o1[2] * o1[2] + o1[3] * o1[3])); }
                sq += __shfl_xor(sq, 16); sq += __shfl_xor(sq, 32);
                if (fq == 0) tab[(ai * HALF + wr * 64 + m * 16 + fr) * 4 + wc] = sq; }
        LDS_WAIT(); PG8_BAR; asm volatile("" ::: "memory");
        const int lane = fq * 16 + fr, r = (wr * 4 + wc) * 32 + (lane & 31);
        if (lane < 32) { const f32x4 t = *(const LAS f32x4*)(tab + r * 4); ssnew[(size_t)(u.orow + r) * 8 + (u.ocol >> 8)] = (t[0] + t[1]) + (t[2] + t[3]); }
    }
};
struct EpiQ {
    const float* ss; bf16* Q; float scale;
    __device__ __forceinline__ void operator()(EPI_ARGS) const {
#pragma unroll
        for (int ai = 0; ai < 2; ++ai)
#pragma unroll
            for (int m = 0; m < 4; ++m) { const int row = EPI_ROW(ai, m); const float rs = rstd_of(ss, row) * scale;
#pragma unroll
                for (int bj = 0; bj < 2; ++bj) *(u32x4*)(Q + (size_t)row * D + EPI_COL(bj)) = pack8(acc[ai][bj][m][0] * rs, acc[ai][bj][m][1] * rs); }
    }
};
struct EpiPlain {
    bf16* O; int ldc;
    __device__ __forceinline__ void operator()(EPI_ARGS) const {
#pragma unroll
        for (int ai = 0; ai < 2; ++ai)
#pragma unroll
            for (int m = 0; m < 4; ++m) { const int row = EPI_ROW(ai, m);
#pragma unroll
                for (int bj = 0; bj < 2; ++bj) *(u32x4*)(O + (size_t)row * ldc + EPI_COL(bj)) = pack8(acc[ai][bj][m][0], acc[ai][bj][m][1]); }
    }
};
struct EpiKV {
    bf16* Km; bf16* Vt;
    __device__ __forceinline__ void operator()(EPI_ARGS) const {
        const int l = u.aux >> 1; const bool isv = u.aux & 1;
        bf16* O = isv ? Vt + (size_t)l * D * MEMROWS : Km + (size_t)l * MEMROWS * D; const int ldc = isv ? MEMROWS : D;
#pragma unroll
        for (int ai = 0; ai < 2; ++ai)
#pragma unroll
            for (int m = 0; m < 4; ++m) { const int row = EPI_ROW(ai, m);
#pragma unroll
                for (int bj = 0; bj < 2; ++bj) *(u32x4*)(O + (size_t)row * ldc + EPI_COL(bj)) = pack8(acc[ai][bj][m][0], acc[ai][bj][m][1]); }
    }
};
struct EpiSoftmax {
    bf16* P; LAS float* tab;
    __device__ __forceinline__ void operator()(EPI_ARGS) const {
        float mx[2][4];
#pragma unroll
        for (int ai = 0; ai < 2; ++ai)
#pragma unroll
            for (int m = 0; m < 4; ++m) { float v = -3.0e38f;
#pragma unroll
                for (int bj = 0; bj < 2; ++bj)
#pragma unroll
                    for (int n = 0; n < 2; ++n) { const f32x4 a = acc[ai][bj][m][n]; v = fmaxf(v, fmaxf(fmaxf(a[0], a[1]), fmaxf(a[2], a[3]))); }
                v = fmaxf(v, __shfl_xor(v, 16)); v = fmaxf(v, __shfl_xor(v, 32));
                if (fq == 0) tab[(ai * HALF + wr * 64 + m * 16 + fr) * 4 + wc] = v; }
        LDS_WAIT(); PG8_BAR; asm volatile("" ::: "memory");
#pragma unroll
        for (int ai = 0; ai < 2; ++ai)
#pragma unroll
            for (int m = 0; m < 4; ++m) { const int r = ai * HALF + wr * 64 + m * 16 + fr; const f32x4 t = *(const LAS f32x4*)(tab + r * 4);
                const float rm = fmaxf(fmaxf(t[0], t[1]), fmaxf(t[2], t[3])); float s = 0.f;
#pragma unroll
                for (int bj = 0; bj < 2; ++bj)
#pragma unroll
                    for (int n = 0; n < 2; ++n) { f32x4 a = acc[ai][bj][m][n];
#pragma unroll
                        for (int j = 0; j < 4; ++j) { a[j] = __expf(a[j] - rm); s += a[j]; }
                        acc[ai][bj][m][n] = a; }
                s += __shfl_xor(s, 16); s += __shfl_xor(s, 32);
                if (fq == 0) tab[1024 + r * 4 + wc] = s; }
        LDS_WAIT(); PG8_BAR; asm volatile("" ::: "memory");
#pragma unroll
        for (int ai = 0; ai < 2; ++ai)
#pragma unroll
            for (int m = 0; m < 4; ++m) { const int r = ai * HALF + wr * 64 + m * 16 + fr; const f32x4 t = *(const LAS f32x4*)(tab + 1024 + r * 4);
                const float inv = 1.0f / ((t[0] + t[1]) + (t[2] + t[3])); const int row = u.orow + r;
#pragma unroll
                for (int bj = 0; bj < 2; ++bj) *(u32x4*)(P + (size_t)row * 1024 + EPI_COL(bj)) = pack8(acc[ai][bj][m][0] * inv, acc[ai][bj][m][1] * inv); }
    }
};
struct EpiGateUp {
    const float* ss; bf16* H;
    __device__ __forceinline__ void operator()(EPI_ARGS) const {
#pragma unroll
        for (int ai = 0; ai < 2; ++ai)
#pragma unroll
            for (int m = 0; m < 4; ++m) { const int row = EPI_ROW(ai, m); const float rs = rstd_of(ss, row);
#pragma unroll
                for (int bj = 0; bj < 2; ++bj) { const int hc = EPI_COL(bj) >> 1; const f32x4 g = acc[ai][bj][m][0] * rs, up = acc[ai][bj][m][1] * rs; f32x4 h;
#pragma unroll
                    for (int j = 0; j < 4; ++j) h[j] = siluf(g[j]) * up[j];
                    u32x2 w; w.x = cvt_pk_bf16(h[0], h[1]); w.y = cvt_pk_bf16(h[2], h[3]); *(u32x2*)(H + (size_t)row * FF + hc) = w; } }
    }
};
#undef EPI_ARGS
}
#define MFMA16(X, Y, ACC) __builtin_amdgcn_mfma_f32_16x16x32_bf16((X), (Y), (ACC), 0, 0, 0)
#define WG_SYNC() do { asm volatile("s_waitcnt vmcnt(0) lgkmcnt(0)" ::: "memory"); __builtin_amdgcn_s_barrier(); asm volatile("" ::: "memory"); } while (0)
constexpr int LP = 136;
constexpr int LP64 = 72;
__device__ __forceinline__ bf16x8 lds_frag(const LAS bf16* base, int row, int pitch, int kofs) { return *(const LAS bf16x8*)(base + row * pitch + kofs); }
__device__ __forceinline__ u32x2 pack4(const f32x4 a) { u32x2 w; w.x = cvt_pk_bf16(a[0], a[1]); w.y = cvt_pk_bf16(a[2], a[3]); return w; }

template <int MAP>
__device__ __forceinline__ void conv_item(const float* W, int ldw, int K, int n0, const float* gain, bf16* WT, int row_off, LAS float* scr, int item, int nblk, int lane) {
    const int kb = item / nblk, nb = item % nblk, k0 = 64 * kb, nn0 = 64 * nb;
    const int kr = lane >> 4, n4 = (lane & 15) * 4;
    const float* src = W + (size_t)(k0 + kr) * ldw + n0 + nn0 + n4;
#pragma unroll 8
    for (int i = 0; i < 16; ++i) { f32x4 v = *(const f32x4*)(src + (size_t)(4 * i) * ldw); if (gain) v = v * gain[k0 + 4 * i + kr];
        LAS float* d = scr + (4 * i + kr) * 65 + n4; d[0] = v[0]; d[1] = v[1]; d[2] = v[2]; d[3] = v[3]; }
    LDS_WAIT(); asm volatile("" ::: "memory");
    const int c = lane & 7, nbase = lane >> 3;
#pragma unroll
    for (int j = 0; j < 8; ++j) { const int n = nbase + 8 * j; const LAS float* s = scr + (8 * c) * 65 + n;
        u32x4 o; o.x = cvt_pk_bf16(s[0 * 65], s[1 * 65]); o.y = cvt_pk_bf16(s[2 * 65], s[3 * 65]); o.z = cvt_pk_bf16(s[4 * 65], s[5 * 65]); o.w = cvt_pk_bf16(s[6 * 65], s[7 * 65]);
        const int nn = nn0 + n; const int dr = MAP == 0 ? nn : ((nn >> 2) * 8 + (nn & 3) + (MAP == 2 ? 4 : 0));
        *(u32x4*)(WT + (size_t)(row_off + dr) * K + k0 + 8 * c) = o; }
    LDS_WAIT(); asm volatile("" ::: "memory");
}
template <int MAP>
__device__ __forceinline__ void conv_matrix(const float* W, int ldw, int K, int n0, int ncols, const float* gain, bf16* WT, int row_off, LAS float* scr, int gw, int NGW, int lane) {
    const int nblk = ncols / 64, nitems = (K / 64) * nblk;
    for (int it = gw; it < nitems; it += NGW) conv_item<MAP>(W, ldw, K, n0, gain, WT, row_off, scr, it, nblk, lane);
}

struct In {
    const float *x, *mem, *norm_mix, *norm_xattn, *norm_ffn, *norm_mem, *norm_final, *ab_w_in, *ab_w_out, *lru_conv_w, *lru_conv_b, *lru_w_r, *lru_b_r, *lru_w_i, *lru_b_i, *lru_lambda,
        *hgrn_lb, *hgrn_norm, *ssd_w_in, *ssd_w_out, *ssd_conv_w, *ssd_conv_b, *ssd_dt_bias, *ssd_a_log, *ssd_d, *ssd_norm, *xa_w_q, *xa_w_kv, *xa_w_o, *ffn_w_gate, *ffn_w_up, *ffn_w_down;
};

typedef const In __attribute__((address_space(4))) CIn;
__device__ __forceinline__ void convert_layer(CIn& I, int l, bf16* WL, LAS float* scr, int gw, int NGW, int lane) {
    const int e = l >> 1;
    if ((l & 1) == 0) {
        conv_matrix<0>(I.ab_w_in + (size_t)e * D * ABIN, ABIN, D, 0, ABIN, I.norm_mix + l * D, WL + WL_IN, 0, scr, gw, NGW, lane);
        conv_matrix<0>(I.ab_w_out + (size_t)e * D * D, D, D, 0, D, nullptr, WL + WL_OUT, 0, scr, gw, NGW, lane);
    } else {
        conv_matrix<0>(I.ssd_w_in + (size_t)e * D * SSDPROJ, SSDPROJ, D, 0, SSDN1, I.norm_mix + l * D, WL + WL_IN, 0, scr, gw, NGW, lane);
        conv_matrix<0>(I.ssd_w_in + (size_t)e * D * SSDPROJ, SSDPROJ, D, SSDN1, 64, I.norm_mix + l * D, WL + WL_DT, 0, scr, gw, NGW, lane);
        for (int i = gw * 64 + lane; i < 192 * D / 8; i += NGW * 64) *(u32x4*)(WL + WL_DT + (size_t)64 * D + (size_t)i * 8) = (u32x4){0u, 0u, 0u, 0u};
        conv_matrix<0>(I.ssd_w_out + (size_t)e * SSDIN * D, D, SSDIN, 0, D, nullptr, WL + WL_OUT, 0, scr, gw, NGW, lane);
    }
    conv_matrix<0>(I.xa_w_q + (size_t)l * D * D, D, D, 0, D, I.norm_xattn + l * D, WL + WL_Q, 0, scr, gw, NGW, lane);
    conv_matrix<0>(I.xa_w_o + (size_t)l * D * D, D, D, 0, D, nullptr, WL + WL_O, 0, scr, gw, NGW, lane);
    conv_matrix<1>(I.ffn_w_gate + (size_t)l * D * FF, FF, D, 0, FF, I.norm_ffn + l * D, WL + WL_GU, 0, scr, gw, NGW, lane);
    conv_matrix<2>(I.ffn_w_up + (size_t)l * D * FF, FF, D, 0, FF, I.norm_ffn + l * D, WL + WL_GU, 0, scr, gw, NGW, lane);
    conv_matrix<0>(I.ffn_w_down + (size_t)l * FF * D, D, FF, 0, D, nullptr, WL + WL_DN, 0, scr, gw, NGW, lane);
}

template <bool PASSB>
__device__ __forceinline__ void lru_units(const int tid, LAS unsigned char* lds, int G, int cu, const bf16* PROJ, const bf16* WRT, const float* cw, const float* cb, const float* br, const float* bi,
                                          const float* lam, float* SEG, bf16* YAB) {
    const int wid = __builtin_amdgcn_readfirstlane(tid >> 6), lane = tid & 63, q = lane >> 4, c16 = lane & 15;
    LAS bf16* XA = (LAS bf16*)(lds);
    LAS bf16* XC = (LAS bf16*)(lds + 35840);
    LAS bf16* WR = (LAS bf16*)(lds + 70656);
    LAS bf16* WI = (LAS bf16*)(lds + 105472);
    LAS float* PAR = (LAS float*)(lds + 140288);
    LAS float* WT = (LAS float*)(lds + 144384);
    LAS float* HIN = (LAS float*)(lds + 152576);
    int loadedj = -1;
    for (int u = cu; u < 1024; u += G) {
        const int j = u & 7, rest = u >> 3, b = rest >> 5, seg = rest & 31; const int t0 = b * SEQ + seg * 128;
        if (j != loadedj) {
            loadedj = j;
            for (int p = tid; p < 2 * 2048; p += NTHR) { const int g = p >> 11, pp = p & 2047, r = pp >> 4, pc = pp & 15;
                const u32x4 v = *(const u32x4*)(WRT + ((size_t)(g * 8 + j) * 128 + r) * 128 + pc * 8);
                *(LAS u32x4*)((g ? WI : WR) + r * LP + pc * 8) = v; }
            if (tid < 128) { const int ch = j * 128 + tid;
                PAR[0 * 128 + tid] = 8.0f * softplusf(-lam[ch]); PAR[1 * 128 + tid] = br[ch]; PAR[2 * 128 + tid] = bi[ch]; PAR[3 * 128 + tid] = cb[ch];
#pragma unroll
                for (int k = 0; k < 4; ++k) PAR[(4 + k) * 128 + tid] = cw[k * LRUW + ch]; }
        }
        for (int p = tid; p < 131 * 16; p += NTHR) { const int r = p >> 4, pc = p & 15; u32x4 v = (u32x4){0u, 0u, 0u, 0u};
            if (seg > 0 || r >= 3) v = *(const u32x4*)(PROJ + (size_t)(t0 + r - 3) * ABIN + j * 128 + pc * 8);
            *(LAS u32x4*)(XA + r * LP + pc * 8) = v; }
        if (PASSB) { if (tid < 128) { float h = 0.f; const float* sg = SEG + ((size_t)(b * 8 + j) * 32) * 256 + tid * 2;
                for (int s = 0; s < seg; ++s) { const f32x2 ab = *(const f32x2*)(sg + (size_t)s * 256); h = ab.x * h + ab.y; }
                HIN[tid] = h; } }
        WG_SYNC();
        {
            const int ch8 = tid & 15, tr = tid >> 4; u32x4 rows[7];
#pragma unroll
            for (int i = 0; i < 7; ++i) rows[i] = *(const LAS u32x4*)(XA + (4 * tr + i) * LP + ch8 * 8);
            float w[4][8], bb[8];
#pragma unroll
            for (int e = 0; e < 8; ++e) { bb[e] = PAR[3 * 128 + ch8 * 8 + e];
#pragma unroll
                for (int k = 0; k < 4; ++k) w[k][e] = PAR[(4 + k) * 128 + ch8 * 8 + e]; }
#pragma unroll
            for (int i = 0; i < 4; ++i) { float o[8];
#pragma unroll
                for (int e = 0; e < 8; ++e) { float a = bb[e];
#pragma unroll
                    for (int k = 0; k < 4; ++k) { const unsigned wd = rows[i + k][e >> 1]; a += w[k][e] * ((e & 1) ? bfhi(wd) : bflo(wd)); }
                    o[e] = a; }
                u32x4 pk; pk.x = cvt_pk_bf16(o[0], o[1]); pk.y = cvt_pk_bf16(o[2], o[3]); pk.z = cvt_pk_bf16(o[4], o[5]); pk.w = cvt_pk_bf16(o[6], o[7]);
                *(LAS u32x4*)(XC + (4 * tr + i) * LP + ch8 * 8) = pk; }
        }
        WG_SYNC();
        float PP[8][4], HH[8][4];
        {
            bf16x8 xf[4];
#pragma unroll
            for (int ks = 0; ks < 4; ++ks) xf[ks] = lds_frag(XC, 16 * wid + c16, LP, 32 * ks + 8 * q);
#pragma unroll
            for (int jb = 0; jb < 8; ++jb) {
                f32x4 aR = (f32x4){0.f, 0.f, 0.f, 0.f}, aI = aR;
#pragma unroll
                for (int ks = 0; ks < 4; ++ks) { aR = MFMA16(xf[ks], lds_frag(WR, 16 * jb + c16, LP, 32 * ks + 8 * q), aR); aI = MFMA16(xf[ks], lds_frag(WI, 16 * jb + c16, LP, 32 * ks + 8 * q), aI); }
                const int ch = 16 * jb + c16;
                const float sp8 = PAR[ch], pbr = PAR[128 + ch], pbi = PAR[256 + ch], pcb = PAR[384 + ch], w0 = PAR[512 + ch], w1 = PAR[640 + ch], w2 = PAR[768 + ch], w3 = PAR[896 + ch];
                float xr[7];
#pragma unroll
                for (int i = 0; i < 7; ++i) xr[i] = bf2f(XA[(16 * wid + 4 * q + i) * LP + ch]);
                float a[4], bt[4];
#pragma unroll
                for (int r = 0; r < 4; ++r) { const float xc = pcb + w0 * xr[r] + w1 * xr[r + 1] + w2 * xr[r + 2] + w3 * xr[r + 3];
                    const float rg = sigm(aR[r] + pbr), ig = sigm(aI[r] + pbi); const float la = -sp8 * rg;
                    a[r] = __expf(la); bt[r] = sqrtf(fmaxf(-expm1f(2.0f * la), 0.f)) * ig * xc; }
                float P[4], H[4]; P[0] = a[0]; H[0] = bt[0];
#pragma unroll
                for (int r = 1; r < 4; ++r) { P[r] = a[r] * P[r - 1]; H[r] = a[r] * H[r - 1] + bt[r]; }
                float Ae = 1.f, Be = 0.f, Aw = 1.f, Bw = 0.f;
#pragma unroll
                for (int qq = 0; qq < 4; ++qq) { const float Aq = __shfl(P[3], c16 + 16 * qq), Bq = __shfl(H[3], c16 + 16 * qq);
                    if (qq < q) { Be = Aq * Be + Bq; Ae = Aq * Ae; }
                    Bw = Aq * Bw + Bq; Aw = Aq * Aw; }
#pragma unroll
                for (int r = 0; r < 4; ++r) { PP[jb][r] = P[r] * Ae; HH[jb][r] = P[r] * Be + H[r]; }
                if (q == 0) *(LAS f32x2*)(WT + (wid * 128 + ch) * 2) = (f32x2){Aw, Bw};
            }
        }
        WG_SYNC();
        if (!PASSB) {
            if (tid < 128) { float A = 1.f, B = 0.f;
#pragma unroll
                for (int w = 0; w < 8; ++w) { const f32x2 ab = *(const LAS f32x2*)(WT + (w * 128 + tid) * 2); B = ab.x * B + ab.y; A = ab.x * A; }
                *(f32x2*)(SEG + ((size_t)(b * 8 + j) * 32 + seg) * 256 + tid * 2) = (f32x2){A, B}; }
        } else {
#pragma unroll
            for (int jb = 0; jb < 8; ++jb) { const int ch = 16 * jb + c16; float h0 = HIN[ch];
                for (int w = 0; w < wid; ++w) { const f32x2 ab = *(const LAS f32x2*)(WT + (w * 128 + ch) * 2); h0 = ab.x * h0 + ab.y; }
#pragma unroll
                for (int r = 0; r < 4; ++r) { const int t = t0 + 16 * wid + 4 * q + r; const float h = PP[jb][r] * h0 + HH[jb][r];
                    const float ga = bf2f(PROJ[(size_t)t * ABIN + 1024 + j * 128 + ch]);
                    YAB[(size_t)t * D + j * 128 + ch] = (bf16)f2bf(ga * h); } }
        }
        WG_SYNC();
    }
}

__device__ __forceinline__ void hgrn1_units(const int tid, LAS unsigned char* lds, int G, int cu, const float* LOGF, const bf16* PROJ, bf16* HST, float* HDEC) {
    const int wid = __builtin_amdgcn_readfirstlane(tid >> 6), lane = tid & 63, q = lane >> 4, c16 = lane & 15;
    LAS bf16* KT = (LAS bf16*)(lds);
    LAS bf16* VT = (LAS bf16*)(lds + 18432);
    LAS float* TOT = (LAS float*)(lds + 36864);
    const int k = tid & 127, qt = tid >> 7;
    for (int u = cu; u < 2048; u += G) {
        const int bh = u >> 6, c = u & 63, b = bh >> 3, h = bh & 7; const int t0 = b * SEQ + c * 64 + 16 * qt;
        float cs[16], lf[16]; unsigned vv[16];
#pragma unroll
        for (int i = 0; i < 16; ++i) { lf[i] = LOGF[(size_t)(t0 + i) * 1024 + h * 128 + k]; vv[i] = PROJ[(size_t)(t0 + i) * ABIN + 4096 + h * 128 + k]; }
        cs[0] = lf[0];
#pragma unroll
        for (int i = 1; i < 16; ++i) cs[i] = cs[i - 1] + lf[i];
        TOT[qt * 128 + k] = cs[15];
        WG_SYNC();
        float pre = 0.f, last = 0.f;
#pragma unroll
        for (int qq = 0; qq < 4; ++qq) { const float t = TOT[qq * 128 + k]; if (qq < qt) pre += t; last += t; }
        unsigned kw[8], vw[8];
#pragma unroll
        for (int i = 0; i < 8; ++i) { const float k0 = (1.f - __expf(lf[2 * i])) * __expf(last - (pre + cs[2 * i])), k1 = (1.f - __expf(lf[2 * i + 1])) * __expf(last - (pre + cs[2 * i + 1]));
            kw[i] = cvt_pk_bf16(k0, k1); vw[i] = vv[2 * i] | (vv[2 * i + 1] << 16); }
        *(LAS u32x4*)(KT + k * LP64 + 16 * qt) = (u32x4){kw[0], kw[1], kw[2], kw[3]}; *(LAS u32x4*)(KT + k * LP64 + 16 * qt + 8) = (u32x4){kw[4], kw[5], kw[6], kw[7]};
        *(LAS u32x4*)(VT + k * LP64 + 16 * qt) = (u32x4){vw[0], vw[1], vw[2], vw[3]}; *(LAS u32x4*)(VT + k * LP64 + 16 * qt + 8) = (u32x4){vw[4], vw[5], vw[6], vw[7]};
        if (qt == 0) HDEC[(size_t)u * 128 + k] = __expf(last);
        WG_SYNC();
        bf16x8 kf[2];
#pragma unroll
        for (int ks = 0; ks < 2; ++ks) kf[ks] = lds_frag(KT, 16 * wid + c16, LP64, 32 * ks + 8 * q);
#pragma unroll
        for (int vb = 0; vb < 8; ++vb) { f32x4 acc = (f32x4){0.f, 0.f, 0.f, 0.f};
#pragma unroll
            for (int ks = 0; ks < 2; ++ks) acc = MFMA16(kf[ks], lds_frag(VT, 16 * vb + c16, LP64, 32 * ks + 8 * q), acc);
            *(u32x2*)(HST + ((size_t)u * 128 + 16 * vb + c16) * 128 + 16 * wid + 4 * q) = pack4(acc); }
        WG_SYNC();
    }
}
__device__ __forceinline__ void hgrn2_scan(const int tid, int G, int cu, bf16* HST, const float* HDEC) {
    for (int task = cu * NTHR + tid; task < 32 * 4096; task += G * NTHR) {
        const int bh = task >> 12, e = (task & 4095) * 4; f32x4 S = (f32x4){0.f, 0.f, 0.f, 0.f};
        bf16* p0 = HST + (size_t)bh * 64 * 16384 + e; const float* d0 = HDEC + (size_t)bh * 64 * 128 + (e & 127);
#pragma unroll 1
        for (int cb = 0; cb < 64; cb += 16) { u32x2 L[16]; f32x4 d[16];
#pragma unroll
            for (int c = 0; c < 16; ++c) { L[c] = *(const u32x2*)(p0 + (size_t)(cb + c) * 16384); d[c] = *(const f32x4*)(d0 + (size_t)(cb + c) * 128); }
#pragma unroll
            for (int c = 0; c < 16; ++c) { *(u32x2*)(p0 + (size_t)(cb + c) * 16384) = pack4(S);
                S[0] = d[c][0] * S[0] + bflo(L[c].x); S[1] = d[c][1] * S[1] + bfhi(L[c].x); S[2] = d[c][2] * S[2] + bflo(L[c].y); S[3] = d[c][3] * S[3] + bfhi(L[c].y); } }
    }
}
__device__ __forceinline__ void hgrn3_units(const int tid, LAS unsigned char* lds, int G, int cu, const float* LOGF, const bf16* PROJ, const bf16* HST, const float* hnorm, bf16* YAB) {
    const int wid = __builtin_amdgcn_readfirstlane(tid >> 6), lane = tid & 63, q = lane >> 4, c16 = lane & 15;
    LAS bf16* QH = (LAS bf16*)(lds);
    LAS bf16* QT = (LAS bf16*)(lds + 17408);
    LAS bf16* KH = (LAS bf16*)(lds + 34816);
    LAS bf16* VT = (LAS bf16*)(lds + 52224);
    LAS bf16* STL = (LAS bf16*)(lds + 70656);
    LAS bf16* PM = (LAS bf16*)(lds + 105472);
    LAS float* TOT = (LAS float*)(lds + 114688);
    LAS float* SQ = (LAS float*)(lds + 116736);
    const int k = tid & 127, qt = tid >> 7;
    for (int u = cu; u < 2048; u += G) {
        const int bh = u >> 6, c = u & 63, b = bh >> 3, h = bh & 7; const int tc = b * SEQ + c * 64, t0 = tc + 16 * qt;
        float cs[16], lf[16], qv[16]; unsigned vv[16];
#pragma unroll
        for (int i = 0; i < 16; ++i) { lf[i] = LOGF[(size_t)(t0 + i) * 1024 + h * 128 + k]; const bf16* pr = PROJ + (size_t)(t0 + i) * ABIN + h * 128 + k; qv[i] = bf2f(pr[2048]); vv[i] = pr[4096]; }
        cs[0] = lf[0];
#pragma unroll
        for (int i = 1; i < 16; ++i) cs[i] = cs[i - 1] + lf[i];
        TOT[qt * 128 + k] = cs[15];
#pragma unroll
        for (int i = 0; i < 4; ++i) { const int p = tid + NTHR * i, r = p >> 4, pc = p & 15; *(LAS u32x4*)(STL + r * LP + pc * 8) = *(const u32x4*)(HST + (size_t)u * 16384 + r * 128 + pc * 8); }
        WG_SYNC();
        float pre = 0.f;
#pragma unroll
        for (int qq = 0; qq < 4; ++qq) { const float t = TOT[qq * 128 + k]; if (qq < qt) pre += t; }
        const float ref = TOT[k] + TOT[128 + k];
        unsigned vw[8];
#pragma unroll
        for (int i = 0; i < 16; ++i) { const float cum = pre + cs[i], kk = 1.f - __expf(lf[i]);
            QT[(16 * qt + i) * LP + k] = (bf16)f2bf(qv[i] * __expf(cum));
            QH[(16 * qt + i) * LP + k] = (bf16)f2bf(qv[i] * __expf(fminf(cum - ref, 80.f)));
            KH[(16 * qt + i) * LP + k] = (bf16)f2bf(kk * __expf(fminf(ref - cum, 80.f))); }
#pragma unroll
        for (int i = 0; i < 8; ++i) vw[i] = vv[2 * i] | (vv[2 * i + 1] << 16);
        *(LAS u32x4*)(VT + k * LP64 + 16 * qt) = (u32x4){vw[0], vw[1], vw[2], vw[3]}; *(LAS u32x4*)(VT + k * LP64 + 16 * qt + 8) = (u32x4){vw[4], vw[5], vw[6], vw[7]};
        WG_SYNC();
        {
            const int tb = wid & 3;
            bf16x8 qf[4];
#pragma unroll
            for (int ks = 0; ks < 4; ++ks) qf[ks] = lds_frag(QH, 16 * tb + c16, LP, 32 * ks + 8 * q);
#pragma unroll
            for (int sbi = 0; sbi < 2; ++sbi) { const int sb = 2 * (wid >> 2) + sbi; f32x4 acc = (f32x4){0.f, 0.f, 0.f, 0.f};
#pragma unroll
                for (int ks = 0; ks < 4; ++ks) acc = MFMA16(lds_frag(KH, 16 * sb + c16, LP, 32 * ks + 8 * q), qf[ks], acc);
                const int t = 16 * tb + c16, s0 = 16 * sb + 4 * q;
#pragma unroll
                for (int r = 0; r < 4; ++r) acc[r] = (s0 + r <= t) ? acc[r] : 0.f;
                *(LAS u32x2*)(PM + t * LP64 + s0) = pack4(acc); }
        }
        WG_SYNC();
        {
            const int tb = wid & 3, vh = wid >> 2, t = 16 * tb + c16;
            bf16x8 qf[4], pf[2];
#pragma unroll
            for (int ks = 0; ks < 4; ++ks) qf[ks] = lds_frag(QT, t, LP, 32 * ks + 8 * q);
#pragma unroll
            for (int ks = 0; ks < 2; ++ks) pf[ks] = lds_frag(PM, t, LP64, 32 * ks + 8 * q);
            f32x4 acc[4]; float sq = 0.f;
#pragma unroll
            for (int vb = 0; vb < 4; ++vb) { const int vr = 64 * vh + 16 * vb + c16; acc[vb] = (f32x4){0.f, 0.f, 0.f, 0.f};
#pragma unroll
                for (int ks = 0; ks < 4; ++ks) acc[vb] = MFMA16(lds_frag(STL, vr, LP, 32 * ks + 8 * q), qf[ks], acc[vb]);
#pragma unroll
                for (int ks = 0; ks < 2; ++ks) acc[vb] = MFMA16(lds_frag(VT, vr, LP64, 32 * ks + 8 * q), pf[ks], acc[vb]);
                sq += (acc[vb][0] * acc[vb][0] + acc[vb][1] * acc[vb][1]) + (acc[vb][2] * acc[vb][2] + acc[vb][3] * acc[vb][3]); }
            sq += __shfl_xor(sq, 16); sq += __shfl_xor(sq, 32);
            if (q == 0) SQ[vh * 64 + t] = sq;
            WG_SYNC();
            const float rstd = rsqrtf((SQ[t] + SQ[64 + t]) * (1.0f / 128.f) + EPS);
#pragma unroll
            for (int vb = 0; vb < 4; ++vb) { const int v0 = 64 * vh + 16 * vb + 4 * q; const f32x4 hn = *(const f32x4*)(hnorm + h * 128 + v0);
                const u32x2 gw = *(const u32x2*)(PROJ + (size_t)(tc + t) * ABIN + 5120 + h * 128 + v0);
                f32x4 y; y[0] = acc[vb][0] * rstd * hn[0] * bflo(gw.x); y[1] = acc[vb][1] * rstd * hn[1] * bfhi(gw.x); y[2] = acc[vb][2] * rstd * hn[2] * bflo(gw.y); y[3] = acc[vb][3] * rstd * hn[3] * bfhi(gw.y);
                *(u32x2*)(YAB + (size_t)(tc + t) * D + 1024 + h * 128 + v0) = pack4(y); }
        }
        WG_SYNC();
    }
}
__device__ __forceinline__ void ssd_prep_units(const int tid, LAS unsigned char* lds, int ufirst, int ustride, int uend, const bf16* XBC, const float* cw, const float* cb, bf16* XBT, bf16* BCN) {
    LAS bf16* T = (LAS bf16*)(lds);
    const int ch8 = tid & 15, tr = tid >> 4;
    for (int u = ufirst; u < uend; u += ustride) {
        const int bc = u / 48, cblk = u % 48, c = bc & 31; const int t0 = bc * 128; const int ch0 = cblk * 128 + ch8 * 8;
        u32x4 rows[7];
#pragma unroll
        for (int i = 0; i < 7; ++i) { const int s = 4 * tr + i - 3; rows[i] = (u32x4){0u, 0u, 0u, 0u}; if (c > 0 || s >= 0) rows[i] = *(const u32x4*)(XBC + (size_t)(t0 + s) * SSDCONV + ch0); }
        float w[4][8], bb[8];
        { const f32x4 b0 = *(const f32x4*)(cb + ch0), b1 = *(const f32x4*)(cb + ch0 + 4);
#pragma unroll
          for (int e = 0; e < 4; ++e) { bb[e] = b0[e]; bb[4 + e] = b1[e]; }
#pragma unroll
          for (int k = 0; k < 4; ++k) { const f32x4 w0 = *(const f32x4*)(cw + (size_t)k * SSDCONV + ch0), w1 = *(const f32x4*)(cw + (size_t)k * SSDCONV + ch0 + 4);
#pragma unroll
              for (int e = 0; e < 4; ++e) { w[k][e] = w0[e]; w[k][4 + e] = w1[e]; } } }
#pragma unroll
        for (int i = 0; i < 4; ++i) { float o[8];
#pragma unroll
            for (int e = 0; e < 8; ++e) { float a = bb[e];
#pragma unroll
                for (int k = 0; k < 4; ++k) { const unsigned wd = rows[i + k][e >> 1]; a += w[k][e] * ((e & 1) ? bfhi(wd) : bflo(wd)); }
                o[e] = siluf(a); }
            u32x4 pk; pk.x = cvt_pk_bf16(o[0], o[1]); pk.y = cvt_pk_bf16(o[2], o[3]); pk.z = cvt_pk_bf16(o[4], o[5]); pk.w = cvt_pk_bf16(o[6], o[7]);
            if (cblk >= 32) *(u32x4*)(BCN + (size_t)(t0 + 4 * tr + i) * 2048 + (ch0 - 4096)) = pk;
            if (cblk < 40) {
#pragma unroll
                for (int e = 0; e < 8; ++e) T[(ch8 * 8 + e) * LP + 4 * tr + i] = (bf16)(((e & 1) ? (pk[e >> 1] >> 16) : pk[e >> 1]) & 0xffffu); } }
        if (cblk < 40) {
            WG_SYNC();
#pragma unroll
            for (int i = 0; i < 4; ++i) { const int p = tid + NTHR * i, r = p >> 4, pc = p & 15;
                *(u32x4*)(XBT + ((size_t)bc * 5120 + cblk * 128 + r) * 128 + pc * 8) = *(const LAS u32x4*)(T + r * LP + pc * 8); }
            WG_SYNC();
        }
    }
}
__device__ __forceinline__ float ssd_tables(const float* DT, const float* a_log, int t0, int hd, int wid, int lane, LAS float* CUM, LAS float* DTS) {
    const float an = -__expf(a_log[hd]);
    const float d0 = DT[(size_t)(t0 + 2 * lane) * 64 + hd], d1 = DT[(size_t)(t0 + 2 * lane + 1) * 64 + hd];
    const float a0 = d0 * an, a1 = d1 * an; float v = a0 + a1;
#pragma unroll
    for (int o = 1; o < 64; o <<= 1) { const float t = __shfl_up(v, o); if (lane >= o) v += t; }
    CUM[wid * 128 + 2 * lane] = v - a1; CUM[wid * 128 + 2 * lane + 1] = v; DTS[wid * 128 + 2 * lane] = d0; DTS[wid * 128 + 2 * lane + 1] = d1;
    return __shfl(v, 63);
}
__device__ __forceinline__ void ssd1_units(const int tid, LAS unsigned char* lds, int G, int cu, const bf16* XBT, const float* DT, const float* a_log, bf16* ST, float* DEC) {
    const int wid = __builtin_amdgcn_readfirstlane(tid >> 6), lane = tid & 63, q = lane >> 4, c16 = lane & 15;
    LAS bf16* BT = (LAS bf16*)(lds);
    LAS float* CUM = (LAS float*)(lds + 34816);
    LAS float* DTS = (LAS float*)(lds + 38912);
    for (int u = cu; u < 1024; u += G) {
        const int bc = u >> 3, g = u & 7, t0 = bc * 128, hd = g * 8 + wid;
#pragma unroll
        for (int i = 0; i < 4; ++i) { const int p = tid + NTHR * i, r = p >> 4, pc = p & 15;
            *(LAS u32x4*)(BT + r * LP + pc * 8) = *(const u32x4*)(XBT + ((size_t)bc * 5120 + 4096 + g * 128 + r) * 128 + pc * 8); }
        const float last = ssd_tables(DT, a_log, t0, hd, wid, lane, CUM, DTS);
        if (lane == 0) DEC[bc * 64 + hd] = __expf(last);
        u32x4 xr[4][4];
#pragma unroll
        for (int pb = 0; pb < 4; ++pb)
#pragma unroll
            for (int ks = 0; ks < 4; ++ks) xr[pb][ks] = *(const u32x4*)(XBT + ((size_t)bc * 5120 + hd * 64 + 16 * pb + c16) * 128 + 32 * ks + 8 * q);
        WG_SYNC();
        bf16x8 xf[4][4];
#pragma unroll
        for (int ks = 0; ks < 4; ++ks) { float sc[8];
#pragma unroll
            for (int j = 0; j < 8; ++j) { const int s = 32 * ks + 8 * q + j; sc[j] = DTS[wid * 128 + s] * __expf(last - CUM[wid * 128 + s]); }
#pragma unroll
            for (int pb = 0; pb < 4; ++pb) { u32x4 o;
#pragma unroll
                for (int e = 0; e < 4; ++e) o[e] = cvt_pk_bf16(bflo(xr[pb][ks][e]) * sc[2 * e], bfhi(xr[pb][ks][e]) * sc[2 * e + 1]);
                xf[pb][ks] = __builtin_bit_cast(bf16x8, o); } }
#pragma unroll
        for (int nb = 0; nb < 8; ++nb) { bf16x8 bf[4];
#pragma unroll
            for (int ks = 0; ks < 4; ++ks) bf[ks] = lds_frag(BT, 16 * nb + c16, LP, 32 * ks + 8 * q);
#pragma unroll
            for (int pb = 0; pb < 4; ++pb) { f32x4 acc = (f32x4){0.f, 0.f, 0.f, 0.f};
#pragma unroll
                for (int ks = 0; ks < 4; ++ks) acc = MFMA16(bf[ks], xf[pb][ks], acc);
                *(u32x2*)(ST + (((size_t)bc * 64 + hd) * 64 + 16 * pb + c16) * 128 + 16 * nb + 4 * q) = pack4(acc); } }
        WG_SYNC();
    }
}
__device__ __forceinline__ void ssd2_scan(const int tid, int G, int cu, bf16* ST, const float* DEC) {
    for (int task = cu * NTHR + tid; task < NB * 4096 * 32; task += G * NTHR) {
        const int b = task >> 17, r = task & 131071, hp = r >> 5, n4 = (r & 31) * 4, hd = hp >> 6; f32x4 S = (f32x4){0.f, 0.f, 0.f, 0.f};
        bf16* p0 = ST + ((size_t)(b * 32) * 4096 + hp) * 128 + n4; const float* d0 = DEC + (b * 32) * 64 + hd;
        u32x2 L[32]; float d[32];
#pragma unroll
        for (int c = 0; c < 32; ++c) { L[c] = *(const u32x2*)(p0 + (size_t)c * 4096 * 128); d[c] = d0[c * 64]; }
#pragma unroll
        for (int c = 0; c < 32; ++c) { *(u32x2*)(p0 + (size_t)c * 4096 * 128) = pack4(S);
            S[0] = d[c] * S[0] + bflo(L[c].x); S[1] = d[c] * S[1] + bfhi(L[c].x); S[2] = d[c] * S[2] + bflo(L[c].y); S[3] = d[c] * S[3] + bfhi(L[c].y); }
    }
}
__device__ __forceinline__ void ssd3_units(const int tid, LAS unsigned char* lds, int G, int cu, const bf16* XBT, const bf16* BCN, const bf16* ST, const float* DT, const float* a_log, const float* dskip,
                                           const bf16* Z, const float* normw, bf16* Y) {
    const int wid = __builtin_amdgcn_readfirstlane(tid >> 6), lane = tid & 63, q = lane >> 4, c16 = lane & 15;
    LAS bf16* CN = (LAS bf16*)(lds);
    LAS bf16* BN = (LAS bf16*)(lds + 34816);
    LAS bf16* CB = (LAS bf16*)(lds + 69632);
    LAS bf16* XTh = (LAS bf16*)(lds + 104448);
    LAS bf16* STh = (LAS bf16*)(lds + 121856);
    LAS float* CUM = (LAS float*)(lds + 139264);
    LAS float* DTS = (LAS float*)(lds + 143360);
    for (int u = cu; u < 1024; u += G) {
        const int bc = u >> 3, g = u & 7, t0 = bc * 128;
#pragma unroll
        for (int i = 0; i < 4; ++i) { const int p = tid + NTHR * i, r = p >> 4, pc = p & 15; const bf16* src = BCN + (size_t)(t0 + r) * 2048 + g * 128 + pc * 8;
            *(LAS u32x4*)(BN + r * LP + pc * 8) = *(const u32x4*)src; *(LAS u32x4*)(CN + r * LP + pc * 8) = *(const u32x4*)(src + 1024); }
        (void)ssd_tables(DT, a_log, t0, g * 8 + wid, wid, lane, CUM, DTS);
        WG_SYNC();
        {
            bf16x8 cf[4];
#pragma unroll
            for (int ks = 0; ks < 4; ++ks) cf[ks] = lds_frag(CN, 16 * wid + c16, LP, 32 * ks + 8 * q);
#pragma unroll
            for (int sb = 0; sb < 8; ++sb) { if (sb > wid + 1) continue; f32x4 acc = (f32x4){0.f, 0.f, 0.f, 0.f};
#pragma unroll
                for (int ks = 0; ks < 4; ++ks) acc = MFMA16(lds_frag(BN, 16 * sb + c16, LP, 32 * ks + 8 * q), cf[ks], acc);
                *(LAS u32x2*)(CB + (16 * wid + c16) * LP + 16 * sb + 4 * q) = pack4(acc); }
        }
        const int tl = 16 * wid + c16;
        float sq = 0.f;
        bf16* yrow = Y + (size_t)(t0 + tl) * SSDIN + g * 512 + 4 * q;
        const int nks = (16 * wid + 15) / 32 + 1;
#pragma unroll 1
        for (int h = 0; h < 8; ++h) {
            const int hd = g * 8 + h;
            WG_SYNC();
#pragma unroll
            for (int i = 0; i < 2; ++i) { const int p = tid + NTHR * i, r = p >> 4, pc = p & 15;
                *(LAS u32x4*)(XTh + r * LP + pc * 8) = *(const u32x4*)(XBT + ((size_t)bc * 5120 + hd * 64 + r) * 128 + pc * 8);
                *(LAS u32x4*)(STh + r * LP + pc * 8) = *(const u32x4*)(ST + (((size_t)bc * 64 + hd) * 64 + r) * 128 + pc * 8); }
            WG_SYNC();
            const float cumt = CUM[h * 128 + tl], ect = __expf(cumt), dsk = dskip[hd];
            f32x4 acc[4];
            {
                bf16x8 cf[4];
#pragma unroll
                for (int ks = 0; ks < 4; ++ks) cf[ks] = lds_frag(CN, tl, LP, 32 * ks + 8 * q);
#pragma unroll
                for (int pb = 0; pb < 4; ++pb) { acc[pb] = (f32x4){0.f, 0.f, 0.f, 0.f};
#pragma unroll
                    for (int ks = 0; ks < 4; ++ks) acc[pb] = MFMA16(lds_frag(STh, 16 * pb + c16, LP, 32 * ks + 8 * q), cf[ks], acc[pb]);
                    acc[pb] = acc[pb] * ect; }
            }
            for (int ks = 0; ks < nks; ++ks) {
                const int s0 = 32 * ks + 8 * q; const u32x4 cbw = *(const LAS u32x4*)(CB + tl * LP + s0);
                const f32x4 c0 = *(const LAS f32x4*)(CUM + h * 128 + s0), c1 = *(const LAS f32x4*)(CUM + h * 128 + s0 + 4), d0 = *(const LAS f32x4*)(DTS + h * 128 + s0), d1 = *(const LAS f32x4*)(DTS + h * 128 + s0 + 4);
                float gv[8];
#pragma unroll
                for (int j = 0; j < 8; ++j) { const int s = s0 + j; const float cb = (j & 1) ? bfhi(cbw[j >> 1]) : bflo(cbw[j >> 1]); const float cs = j < 4 ? c0[j & 3] : c1[j & 3], ds = j < 4 ? d0[j & 3] : d1[j & 3];
                    float v = cb * __expf(fminf(cumt - cs, 0.f)) * ds; v = (s <= tl) ? v : 0.f; gv[j] = (s == tl) ? v + dsk : v; }
                u32x4 gw; gw.x = cvt_pk_bf16(gv[0], gv[1]); gw.y = cvt_pk_bf16(gv[2], gv[3]); gw.z = cvt_pk_bf16(gv[4], gv[5]); gw.w = cvt_pk_bf16(gv[6], gv[7]);
                const bf16x8 gf = __builtin_bit_cast(bf16x8, gw);
#pragma unroll
                for (int pb = 0; pb < 4; ++pb) acc[pb] = MFMA16(lds_frag(XTh, 16 * pb + c16, LP, s0), gf, acc[pb]);
            }
#pragma unroll
            for (int pb = 0; pb < 4; ++pb) { const u32x2 zw = *(const u32x2*)(Z + (size_t)(t0 + tl) * SSDIN + hd * 64 + 16 * pb + 4 * q);
                f32x4 y; y[0] = acc[pb][0] * bflo(zw.x); y[1] = acc[pb][1] * bfhi(zw.x); y[2] = acc[pb][2] * bflo(zw.y); y[3] = acc[pb][3] * bfhi(zw.y);
                sq += (y[0] * y[0] + y[1] * y[1]) + (y[2] * y[2] + y[3] * y[3]); *(u32x2*)(yrow + h * 64 + 16 * pb) = pack4(y); }
        }
        sq += __shfl_xor(sq, 16); sq += __shfl_xor(sq, 32);
        const float rstd = rsqrtf(sq * (1.0f / 512.f) + EPS);
        VM_WAIT();
#pragma unroll 1
        for (int h = 0; h < 8; ++h)
#pragma unroll
            for (int pb = 0; pb < 4; ++pb) { const int ch = (g * 8 + h) * 64 + 16 * pb + 4 * q; const f32x4 nw = *(const f32x4*)(normw + ch); bf16* yp = yrow + h * 64 + 16 * pb;
                const u32x2 w = *(const volatile u32x2*)yp;
                f32x4 y; y[0] = bflo(w.x) * rstd * nw[0]; y[1] = bfhi(w.x) * rstd * nw[1]; y[2] = bflo(w.y) * rstd * nw[2]; y[3] = bfhi(w.y) * rstd * nw[3];
                *(u32x2*)yp = pack4(y); }
        WG_SYNC();
    }
}
#ifndef REP_GEMM
#define REP_GEMM 1
#endif
#if REP_GEMM == 2
#define GEMM_REP(...) { __VA_ARGS__ } { __VA_ARGS__ }
#else
#define GEMM_REP(...) { __VA_ARGS__ }
#endif
#ifndef REP_MIX
#define REP_MIX 1
#endif
#ifndef REP_CONV
#define REP_CONV 1
#endif
struct Args { In in; float* out; unsigned char* ws; int ph_lo, ph_hi; };
static_assert(sizeof(Args) == 32 * 8 + 8 + 8 + 8, "Args has no padding");
typedef const Args __attribute__((address_space(4))) CArgs;

#define PHASE_BEGIN if (pc >= lo && pc < hi) { int tid = wave0 * 64 + (int)__builtin_amdgcn_mbcnt_hi(~0u, __builtin_amdgcn_mbcnt_lo(~0u, 0u)); asm volatile("" : "+v"(tid)); int cu = blockIdx.x; asm volatile("" : "+s"(cu)); int G = gridDim.x; asm volatile("" : "+s"(G)); \
        const int lane = tid & 63, wave = __builtin_amdgcn_readfirstlane(tid >> 6), gw = cu * NWAVES + wave, NGW = G * NWAVES; (void)lane; (void)gw; (void)NGW; \
        CArgs* ap = (CArgs*)__builtin_amdgcn_kernarg_segment_ptr(); asm volatile("" : "+s"(ap)); CIn& I = ap->in; unsigned char* const ws = ap->ws; float* const xres = ap->out; \
        unsigned char* const act = ws + WS_ACT; float* const SS = (float*)(ws + WS_SS); bf16* const XB = (bf16*)(ws + WS_XB); bf16* const WL = (bf16*)(ws + WS_WL); (void)I; (void)xres; (void)act; (void)SS; (void)XB; (void)WL;
#if MK_SPLIT
#define PHASE_END } ++pc;
#else
#define PHASE_END if (pc + 1 < hi) xcd_barrier(bar); } ++pc;
#endif
#define D_WKV ((bf16*)(ws + WS_WKV))
#define D_KMAT ((bf16*)(ws + WS_KMAT))
#define D_VT ((bf16*)(ws + WS_VT))
#define D_MEMN ((bf16*)(ws + WS_MEMN))
#define D_LB ((float*)(ws + WS_TAB + TAB_LB))
#define D_WRT ((bf16*)(ws + WS_TAB + TAB_WRT))


template <int l>
__device__ __forceinline__ void layer_body(LAS unsigned char* lds, const int wave0, const int lo, const int hi, int& pc, const XcdBarrier& bar) {
    int ssi = 3 * l;

        if (l > 0) {
            PHASE_BEGIN
                for (int rep_ = 0; rep_ < REP_CONV; ++rep_) { convert_layer(I, l, WL, (LAS float*)(lds + wave * 16640), gw, NGW, lane); }
            PHASE_END
        }
        const int e = l >> 1;
        int mixK;
        if ((l & 1) == 0) {
#define PROJ ((bf16*)(act + A_PROJ))
#define LOGF ((float*)(act + A_LOGF))
#define HST ((bf16*)(act + A_HST))
#define YAB ((bf16*)(act + A_YAB))
#define SEG ((float*)(act + A_SEG))
#define HDEC ((float*)(act + A_HDEC))
            PHASE_BEGIN
                GEMM_REP(pg8::SchedMN S; S.init(XB, D, WL + WL_IN, D, M, ABIN, G, cu); pg8::EpiProjEven E{SS + (size_t)ssi * M * 8, PROJ, LOGF, D_LB + e * 1024};
                pg8::gemm_phase(tid, lds, D, D, D, S, E);)
            PHASE_END
            PHASE_BEGIN
                for (int rep_ = 0; rep_ < REP_MIX; ++rep_) { lru_units<false>(tid, lds, G, cu, PROJ, D_WRT + (size_t)e * 2 * 8 * 16384, I.lru_conv_w + e * 4 * LRUW, I.lru_conv_b + e * LRUW, I.lru_b_r + e * LRUW, I.lru_b_i + e * LRUW, I.lru_lambda + e * LRUW, SEG, YAB);
                hgrn1_units(tid, lds, G, cu, LOGF, PROJ, HST, HDEC); }
            PHASE_END
            PHASE_BEGIN
                for (int rep_ = 0; rep_ < REP_MIX; ++rep_) { lru_units<true>(tid, lds, G, cu, PROJ, D_WRT + (size_t)e * 2 * 8 * 16384, I.lru_conv_w + e * 4 * LRUW, I.lru_conv_b + e * LRUW, I.lru_b_r + e * LRUW, I.lru_b_i + e * LRUW, I.lru_lambda + e * LRUW, SEG, YAB); }
                hgrn2_scan(tid, G, cu, HST, HDEC);
            PHASE_END
            PHASE_BEGIN
                for (int rep_ = 0; rep_ < REP_MIX; ++rep_) { hgrn3_units(tid, lds, G, cu, LOGF, PROJ, HST, I.hgrn_norm + e * 1024, YAB); }
            PHASE_END
            mixK = D;
        } else {
#define Zb ((bf16*)(act + A_Z))
#define XBC ((bf16*)(act + A_XBC))
#define XBT ((bf16*)(act + A_XBT))
#define BCN ((bf16*)(act + A_BCN))
#define STb ((bf16*)(act + A_ST))
#define DTb ((float*)(act + A_DT))
#define DEC ((float*)(act + A_DEC))
#define Yb ((bf16*)(act + A_Y))
            PHASE_BEGIN
                GEMM_REP(pg8::SchedMN S; S.init(XB, D, WL + WL_IN, D, M, SSDN1, G, cu); pg8::EpiProjOdd E{SS + (size_t)ssi * M * 8, Zb, XBC};
                pg8::gemm_phase(tid, lds, D, D, D, S, E);)
            PHASE_END
            PHASE_BEGIN
                for (int rep_ = 0; rep_ < REP_MIX; ++rep_) {
                { pg8::SchedDt S{(const char*)XB, (const char*)(WL + WL_DT), cu}; pg8::EpiDt E{SS + (size_t)ssi * M * 8, I.ssd_dt_bias + e * 64, DTb};
                  pg8::gemm_phase(tid, lds, D, D, D, S, E); }
                { int uf = cu, us = G, ue = 6144; if (G == 256) { if (cu < 64) { us = 64; ue = 1152; } else { uf = 1152 + (cu - 64); us = 192; } }
                  ssd_prep_units(tid, lds, uf, us, ue, XBC, I.ssd_conv_w + (size_t)e * 4 * SSDCONV, I.ssd_conv_b + e * SSDCONV, XBT, BCN); }
                }
            PHASE_END
            PHASE_BEGIN
                for (int rep_ = 0; rep_ < REP_MIX; ++rep_) { ssd1_units(tid, lds, G, cu, XBT, DTb, I.ssd_a_log + e * 64, STb, DEC); }
            PHASE_END
            PHASE_BEGIN
                ssd2_scan(tid, G, cu, STb, DEC);
            PHASE_END
            PHASE_BEGIN
                for (int rep_ = 0; rep_ < REP_MIX; ++rep_) { ssd3_units(tid, lds, G, cu, XBT, BCN, STb, DTb, I.ssd_a_log + e * 64, I.ssd_d + e * 64, Zb, I.ssd_norm + e * SSDIN, Yb); }
            PHASE_END
            mixK = SSDIN;
        }
        PHASE_BEGIN
            pg8::SchedMN S; S.init(mixK == D ? (const bf16*)YAB : (const bf16*)Yb, mixK, WL + WL_OUT, mixK, M, D, G, cu); pg8::EpiResid E{xres, XB, SS + (size_t)(ssi + 1) * M * 8, (LAS float*)(lds + EPI_OFF)};
            pg8::gemm_phase(tid, lds, mixK, mixK, mixK, S, E);
        PHASE_END
        ++ssi;
#define Qb ((bf16*)(act + A_Q))
#define Pb ((bf16*)(act + A_P))
#define Ob ((bf16*)(act + A_O))
#define Hb ((bf16*)(act + A_H))
        PHASE_BEGIN
            GEMM_REP(pg8::SchedMN S; S.init(XB, D, WL + WL_Q, D, M, D, G, cu); pg8::EpiQ E{SS + (size_t)ssi * M * 8, Qb, 0.044194173824159216f};
            pg8::gemm_phase(tid, lds, D, D, D, S, E);)
        PHASE_END
        PHASE_BEGIN
            GEMM_REP(pg8::SchedS S{(const char*)Qb, (const char*)(D_KMAT + (size_t)l * MEMROWS * D), G, cu}; pg8::EpiSoftmax E{Pb, (LAS float*)(lds + EPI_OFF)};
            pg8::gemm_phase(tid, lds, XAD, D, D, S, E);)
        PHASE_END
        PHASE_BEGIN
            GEMM_REP(pg8::SchedPV S{(const char*)Pb, (const char*)(D_VT + (size_t)l * D * MEMROWS), G, cu}; pg8::EpiPlain E{Ob, D};
            pg8::gemm_phase(tid, lds, MEMLEN, 1024, MEMROWS, S, E);)
        PHASE_END
        PHASE_BEGIN
            pg8::SchedMN S; S.init(Ob, D, WL + WL_O, D, M, D, G, cu); pg8::EpiResid E{xres, XB, SS + (size_t)(ssi + 1) * M * 8, (LAS float*)(lds + EPI_OFF)};
            pg8::gemm_phase(tid, lds, D, D, D, S, E);
        PHASE_END
        ++ssi;
        PHASE_BEGIN
            GEMM_REP(pg8::SchedMN S; S.init(XB, D, WL + WL_GU, D, M, 2 * FF, G, cu); pg8::EpiGateUp E{SS + (size_t)ssi * M * 8, Hb};
            pg8::gemm_phase(tid, lds, D, D, D, S, E);)
        PHASE_END
        PHASE_BEGIN
            pg8::SchedMN S; S.init(Hb, FF, WL + WL_DN, FF, M, D, G, cu); pg8::EpiResid E{xres, XB, SS + (size_t)(ssi + 1) * M * 8, (LAS float*)(lds + EPI_OFF)};
            pg8::gemm_phase(tid, lds, FF, FF, FF, S, E);
        PHASE_END
        ++ssi;
    }

__global__ void __launch_bounds__(NTHR, 2) fwd(Args args) {
    extern __shared__ __attribute__((aligned(16))) unsigned char lds_raw[];
    LAS unsigned char* lds = (LAS unsigned char*)lds_raw;
    volatile LAS unsigned* MISC = (volatile LAS unsigned*)(lds + MISC_OFF);
    const int wave0 = __builtin_amdgcn_readfirstlane((int)threadIdx.x >> 6);
    if (threadIdx.x < 64) MISC[threadIdx.x] = 0u;
    __syncthreads();
#if !MK_SPLIT
    XcdBarrier bar = xcd_barrier_post((unsigned*)(args.ws + WS_CTL), MISC + 8);
#else
    XcdBarrier bar; bar.bar = nullptr; bar.x = 0; bar.st = nullptr;
#endif
    const int lo = args.ph_lo, hi = args.ph_hi; int pc = 0;
    PHASE_BEGIN
        LAS float* scr = (LAS float*)(lds + wave * 16640);
        for (int l = 0; l < DEPTH; ++l) conv_matrix<0>(I.xa_w_kv + (size_t)l * D * 4096, 4096, D, 0, 4096, nullptr, D_WKV + (size_t)l * 4096 * D, 0, scr, gw, NGW, lane);
        for (int rep_ = 0; rep_ < REP_CONV; ++rep_) convert_layer(I, 0, WL, scr, gw, NGW, lane);
        for (int m = gw; m < MEMROWS; m += NGW) {
            const f32x4* xr = (const f32x4*)(I.mem + (size_t)m * D); f32x4 v[8]; float s = 0.f;
#pragma unroll
            for (int j = 0; j < 8; ++j) { v[j] = xr[64 * j + lane]; s += (v[j][0] * v[j][0] + v[j][1] * v[j][1]) + (v[j][2] * v[j][2] + v[j][3] * v[j][3]); }
            const float rs = rsqrtf(wave_sum(s) * (1.0f / D) + EPS);
#pragma unroll
            for (int j = 0; j < 8; ++j) { const f32x4 g = *(const f32x4*)(I.norm_mem + (64 * j + lane) * 4); *(u32x2*)(D_MEMN + (size_t)m * D + (64 * j + lane) * 4) = pack4(v[j] * rs * g); }
        }
        for (int m = gw; m < M; m += NGW) {
            const f32x4* xr = (const f32x4*)(I.x + (size_t)m * D); f32x4* orow = (f32x4*)(xres + (size_t)m * D); float s = 0.f;
#pragma unroll
            for (int j = 0; j < 8; ++j) { const f32x4 v = xr[64 * j + lane]; s += (v[0] * v[0] + v[1] * v[1]) + (v[2] * v[2] + v[3] * v[3]); orow[64 * j + lane] = v; *(u32x2*)(XB + (size_t)m * D + (64 * j + lane) * 4) = pack4(v); }
            s = wave_sum(s); if (lane < 8) SS[(size_t)m * 8 + lane] = lane == 0 ? s : 0.f;
        }
        for (int i = cu * NTHR + tid; i < 1024; i += G * NTHR) {
            const float a = I.hgrn_lb[i], b = I.hgrn_lb[1024 + i], mx = fmaxf(a, b), e0 = __expf(a - mx), e1 = __expf(b - mx); D_LB[i] = 0.f; D_LB[1024 + i] = e1 / (e0 + e1); }
        for (int i = cu * NTHR + tid; i < 2 * 2 * 8 * 16384; i += G * NTHR) {
            const int ii = i & 127, jj = (i >> 7) & 127, blk = (i >> 14) & 7, gt = (i >> 17) & 1, e = i >> 18;
            const float* src = gt ? I.lru_w_i : I.lru_w_r; D_WRT[i] = (bf16)f2bf(src[((size_t)(e * 8 + blk) * 128 + ii) * 128 + jj]); }
    PHASE_END

    PHASE_BEGIN
        pg8::SchedKV S{(const char*)D_MEMN, (const char*)D_WKV, G, cu}; pg8::EpiKV E{D_KMAT, D_VT};
        pg8::gemm_phase(tid, lds, D, D, D, S, E);
    PHASE_END

    layer_body<0>(lds, wave0, lo, hi, pc, bar); layer_body<1>(lds, wave0, lo, hi, pc, bar); layer_body<2>(lds, wave0, lo, hi, pc, bar); layer_body<3>(lds, wave0, lo, hi, pc, bar);
    const int ssi = 12;
    PHASE_BEGIN
        const float* ssf = SS + (size_t)ssi * M * 8;
        for (int m = gw; m < M; m += NGW) { f32x4* row = (f32x4*)(xres + (size_t)m * D); const float rs = pg8::rstd_of(ssf, m);
#pragma unroll
            for (int j = 0; j < 8; ++j) { const f32x4 g = *(const f32x4*)(I.norm_final + (64 * j + lane) * 4); row[64 * j + lane] = row[64 * j + lane] * rs * g; } }
    PHASE_END
#undef PHASE_BEGIN
#undef PHASE_END
}

constexpr int NPHASES = 2 + (5 + 6) + (1 + 6 + 6) + (1 + 5 + 6) + (1 + 6 + 6) + 1;

extern "C" void kernel_launch(void* const* d_in, const int* in_sizes, int n_in, void* d_out, int out_size, void* d_ws, size_t ws_size, hipStream_t stream) {
    static int grid = 0;
    if (grid == 0) {
        if (n_in != 32 || out_size != M * D || ws_size < WS_END) { fprintf(stderr, "kernel_launch: unexpected problem (n_in %d, out %d, ws %zu)\n", n_in, out_size, ws_size); grid = -1; return; }
        int dev = 0, cus = 0;
        if (hipGetDevice(&dev) != hipSuccess || hipDeviceGetAttribute(&cus, hipDeviceAttributeMultiprocessorCount, dev) != hipSuccess) { grid = -1; return; }
        if (hipFuncSetAttribute((const void*)fwd, hipFuncAttributeMaxDynamicSharedMemorySize, LDS_BYTES) != hipSuccess) { fprintf(stderr, "kernel_launch: hipFuncSetAttribute failed\n"); grid = -1; return; }
        int per_cu = 0;
        if (hipOccupancyMaxActiveBlocksPerMultiprocessor(&per_cu, (const void*)fwd, NTHR, LDS_BYTES) != hipSuccess || per_cu < 1) fprintf(stderr, "kernel_launch: occupancy query says %d\n", per_cu);
        (void)hipGetLastError();
        grid = cus;
    }
    if (grid < 0) return;
    (void)hipMemsetAsync((char*)d_ws + WS_CTL, 0, CTL_ZERO_BYTES, stream);
    Args a{};
    const float** ip = (const float**)&a.in;
    for (int i = 0; i < 32; ++i) ip[i] = (const float*)d_in[i];
    a.out = (float*)d_out; a.ws = (unsigned char*)d_ws;
#if MK_SPLIT
#ifndef PROBE_MASK
#define PROBE_MASK 0ull
#endif
    for (int li = 0; li < NPHASES; ++li) { a.ph_lo = li; a.ph_hi = li + 1; hipLaunchKernelGGL(fwd, dim3(grid), dim3(NTHR), LDS_BYTES, stream, a);
        if ((PROBE_MASK >> li) & 1ull) hipLaunchKernelGGL(fwd, dim3(grid), dim3(NTHR), LDS_BYTES, stream, a); }
#else
    a.ph_lo = 0; a.ph_hi = NPHASES;
    hipLaunchKernelGGL(fwd, dim3(grid), dim3(NTHR), LDS_BYTES, stream, a);
#endif
}
```

```cpp
#include <hip/hip_runtime.h>
#include <cstdio>
#include <cstdint>

#ifndef MK_SPLIT
#define MK_SPLIT 0
#endif

#ifndef RESID_F16
#define RESID_F16 1
#endif
constexpr bool RF16 = RESID_F16 != 0;
#define GAS __attribute__((address_space(1)))
#define LAS __attribute__((address_space(3)))
typedef unsigned short bf16;
typedef short bf16x8 __attribute__((ext_vector_type(8)));
typedef float f32x4 __attribute__((ext_vector_type(4)));
typedef float f32x2 __attribute__((ext_vector_type(2)));
typedef unsigned u32x4 __attribute__((ext_vector_type(4)));
typedef unsigned u32x2 __attribute__((ext_vector_type(2)));

constexpr int D = 2048, NB = 4, SEQ = 4096, M = NB * SEQ, DEPTH = 4, MEMLEN = 256, MEMROWS = NB * MEMLEN;
constexpr int LRUW = 1024, ABIN = 6144;
constexpr int SSDIN = 4096, SSDCONV = 6144, SSDPROJ = 10304, SSDN1 = 10240, NHEADS = 64;
constexpr int XAD = 512, FF = 5632;
constexpr float EPS = 1e-6f;
constexpr int NWAVES = 8, NTHR = 512;

constexpr size_t MiB = 1u << 20;
constexpr size_t WS_CTL = 0, CTL_ZERO_BYTES = 1 * MiB;
constexpr size_t WS_WKV = 2 * MiB;
constexpr size_t WS_KMAT = 66 * MiB;
constexpr size_t WS_VT = 82 * MiB;
constexpr size_t WS_MEMN = 98 * MiB;
constexpr size_t WS_TAB = 102 * MiB;
constexpr size_t WS_XB = 106 * MiB;
constexpr size_t WS_WL = 170 * MiB;
constexpr size_t WS_ACT = 310 * MiB;
constexpr size_t WS_SS = (310 + 680) * MiB;
constexpr size_t WS_END = (310 + 680 + 8) * MiB;
constexpr size_t TAB_LB = 0;
constexpr size_t TAB_WRT = 64 * 1024;
constexpr size_t WL_IN = 0;
constexpr size_t WL_DT = (size_t)SSDN1 * D;
constexpr size_t WL_OUT = (size_t)(SSDN1 + 256) * D;
constexpr size_t WL_Q = WL_OUT + (size_t)D * SSDIN;
constexpr size_t WL_O = WL_Q + (size_t)D * D;
constexpr size_t WL_GU = WL_O + (size_t)D * D;
constexpr size_t WL_DN = WL_GU + (size_t)2 * FF * D;
constexpr size_t WL_ELEMS = WL_DN + (size_t)D * FF;
static_assert(WL_ELEMS * 2 <= 140 * MiB, "per-layer weights");
constexpr size_t A_Z = 0;
constexpr size_t A_XBC = 128 * MiB;
constexpr size_t A_Y = 128 * MiB;
constexpr size_t A_XBT = 320 * MiB;
constexpr size_t A_BCN = 480 * MiB;
constexpr size_t A_ST = 544 * MiB;
constexpr size_t A_DT = 672 * MiB;
constexpr size_t A_DEC = 676 * MiB;
constexpr size_t A_PROJ = 0;
constexpr size_t A_LOGF = 192 * MiB;
constexpr size_t A_HST = 256 * MiB;
constexpr size_t A_YAB = 320 * MiB;
constexpr size_t A_SEG = 384 * MiB;
constexpr size_t A_HDEC = 386 * MiB;
constexpr size_t A_Q = 0;
constexpr size_t A_P = 64 * MiB;
constexpr size_t A_O = 96 * MiB;
constexpr size_t A_H = 160 * MiB;

constexpr int LDS_BYTES = 155648;
constexpr int EPI_OFF = 131072;
constexpr int MISC_OFF = LDS_BYTES - 256;

#define LDS_WAIT() asm volatile("s_waitcnt lgkmcnt(0)" ::: "memory")
#define VM_WAIT() asm volatile("s_waitcnt vmcnt(0)" ::: "memory")
__device__ __forceinline__ unsigned f2bf(float f) { unsigned u = __builtin_bit_cast(unsigned, f); return (u + 0x7fffu + ((u >> 16) & 1u)) >> 16; }
__device__ __forceinline__ unsigned pk2(float lo, float hi) { return f2bf(lo) | (f2bf(hi) << 16); }
typedef __bf16 bf16x2v __attribute__((ext_vector_type(2)));
__device__ __forceinline__ unsigned cvt_pk_bf16(float lo, float hi) { const f32x2 v = {lo, hi}; return __builtin_bit_cast(unsigned, __builtin_convertvector(v, bf16x2v)); }
typedef _Float16 f16x2v __attribute__((ext_vector_type(2)));
typedef _Float16 f16x8 __attribute__((ext_vector_type(8)));
__device__ __forceinline__ unsigned cvt_pk_f16(float lo, float hi) { const f32x2 v = {lo, hi}; return __builtin_bit_cast(unsigned, __builtin_convertvector(v, f16x2v)); }
__device__ __forceinline__ float h16lo(unsigned w) { return (float)__builtin_bit_cast(f16x2v, w)[0]; }
__device__ __forceinline__ float h16hi(unsigned w) { return (float)__builtin_bit_cast(f16x2v, w)[1]; }
__device__ __forceinline__ float bflo(unsigned w) { return __uint_as_float(w << 16); }
__device__ __forceinline__ float bfhi(unsigned w) { return __uint_as_float(w & 0xffff0000u); }
__device__ __forceinline__ unsigned rs_pk(float lo, float hi) { return RF16 ? cvt_pk_f16(lo, hi) : cvt_pk_bf16(lo, hi); }
__device__ __forceinline__ float rs_lo(unsigned w) { return RF16 ? h16lo(w) : bflo(w); }
__device__ __forceinline__ float rs_hi(unsigned w) { return RF16 ? h16hi(w) : bfhi(w); }
__device__ __forceinline__ float bf2f(bf16 b) { return __uint_as_float((unsigned)b << 16); }
__device__ __forceinline__ float sigm(float x) { return __builtin_amdgcn_rcpf(1.f + __expf(-x)); }
__device__ __forceinline__ float siluf(float x) { return x * sigm(x); }
__device__ __forceinline__ float gelu_tanh(float x) { return x * sigm(1.5957691216f * (x + 0.044715f * x * x * x)); }
__device__ __forceinline__ float softplusf(float x) { const float e = __expf(-fabsf(x)); const float l = (e < 0.03f) ? e * (1.f - e * (0.5f - e * 0.33333333f)) : __logf(1.f + e); return fmaxf(x, 0.f) + l; }
__device__ __forceinline__ float wave_sum(float v) {
#pragma unroll
    for (int o = 1; o < 64; o <<= 1) v += __shfl_xor(v, o);
    return v;
}

#define XB_TMO      128
#define XB_XCNT(j)  (256  + 64 * (j))
#define XB_XSUB(j)  (1280 + 64 * (j))
#define XB_XGEN(j)  (2304 + 64 * (j))
#define XB_TOP      3328
#define XB_TOPGEN   3392
#define XCD_BAR_WORDS 3456
#define XB_SPIN_CAP (1u << 18)

__device__ __forceinline__ unsigned xb_ld(unsigned* p)              { return __hip_atomic_load(p, __ATOMIC_RELAXED, __HIP_MEMORY_SCOPE_AGENT); }
__device__ __forceinline__ unsigned xb_add(unsigned* p, unsigned v) { return __hip_atomic_fetch_add(p, v, __ATOMIC_RELAXED, __HIP_MEMORY_SCOPE_AGENT); }
__device__ __forceinline__ unsigned xb_xcc_id() { return (unsigned)__builtin_amdgcn_s_getreg((3 << 11) | 20) & 0xFu; }
#define XB_SPIN(cond, bar) do { unsigned _sp = 0; while (cond) { __builtin_amdgcn_s_sleep(1); \
    if ((++_sp & 255u) == 0u) { if (xb_ld(&(bar)[XB_TMO])) break; if (_sp > XB_SPIN_CAP) { atomicAdd(&(bar)[XB_TMO], 1u); break; } } } } while (0)

struct XcdBarrier {
    unsigned* bar; unsigned x;
    volatile LAS unsigned* st;
};
__device__ __forceinline__ XcdBarrier xcd_barrier_post(unsigned* bar, volatile LAS unsigned* st) {
    XcdBarrier b; b.bar = bar; b.x = xb_xcc_id(); b.st = st;
    if (threadIdx.x == 0) (void)xb_add(&bar[XB_XCNT(b.x)], 1u);
    return b;
}
__device__ __forceinline__ void xcd_barrier_complete(unsigned* bar, unsigned x, unsigned& nloc, unsigned& nx) {
    const unsigned G = gridDim.x * gridDim.y * gridDim.z;
    unsigned sum, cnt, mine, sp = 0u;
    for (;;) {
        sum = 0u; cnt = 0u; mine = 0u;
#pragma unroll
        for (unsigned j = 0; j < 16; ++j) { const unsigned c = xb_ld(&bar[XB_XCNT(j)]); sum += c; cnt += (c > 0u) ? 1u : 0u; mine = (j == x) ? c : mine; }
        if (sum == G) break;
        __builtin_amdgcn_s_sleep(1);
        if ((++sp & 255u) == 0u) { if (xb_ld(&bar[XB_TMO])) break; if (sp > XB_SPIN_CAP) { atomicAdd(&bar[XB_TMO], 1u); break; } }
    }
    nloc = mine > 0u ? mine : 1u; nx = cnt > 0u ? cnt : 1u;
}
__device__ __forceinline__ void xcd_barrier(const XcdBarrier& b) {
    asm volatile("s_waitcnt vmcnt(0)" ::: "memory");
    __syncthreads();
    if (threadIdx.x == 0) {
        unsigned* bar = b.bar;
        __builtin_amdgcn_s_waitcnt(0);
        unsigned nloc = b.st[0], nx = b.st[1];
        if (nloc == 0u) { xcd_barrier_complete(bar, b.x, nloc, nx); b.st[0] = nloc; b.st[1] = nx; }
        const unsigned old = xb_add(&bar[XB_XSUB(b.x)], 1u);
        const unsigned gen = old / nloc;
        if (old + 1u == (gen + 1u) * nloc) {
            __builtin_amdgcn_fence(__ATOMIC_RELEASE, "agent");
            asm volatile("s_waitcnt vmcnt(0)" ::: "memory");
            const unsigned og = xb_add(&bar[XB_TOP], 1u);
            const unsigned tg = og / nx;
            if (og + 1u == (tg + 1u) * nx) xb_add(&bar[XB_TOPGEN], 1u);
            else XB_SPIN(xb_ld(&bar[XB_TOPGEN]) == tg, bar);
            __builtin_amdgcn_fence(__ATOMIC_ACQUIRE, "agent");
            xb_add(&bar[XB_XGEN(b.x)], 1u);
            asm volatile("s_waitcnt vmcnt(0)" ::: "memory");
        } else {
            XB_SPIN(xb_ld(&bar[XB_XGEN(b.x)]) == gen, bar);
            __builtin_amdgcn_fence(__ATOMIC_ACQUIRE, "agent");
            asm volatile("s_waitcnt vmcnt(0)" ::: "memory");
        }
    }
    __syncthreads();
}

namespace pg8 {
constexpr int BM = 256, BK = 64, HALF = 128, HTB = HALF * BK * 2, STAGE_BYTES = 8 * HTB, NXCD = 8, WGM = 8;
__host__ __device__ __forceinline__ int lds_byte(int r, int c) { const int st = (r >> 4) * 2 + (c >> 5), rr = r & 15, cc = c & 31, ob = rr * 64 + cc * 2; return st * 1024 + (ob ^ (((ob >> 9) & 1) << 5)); }
__host__ __device__ __forceinline__ void stage_rc(int b, int& R, int& C) { const int st = b / 1024, sb = b % 1024, swz = sb ^ (((sb >> 9) & 1) << 5); R = (st >> 1) * 16 + swz / 64; C = (st & 1) * 32 + (swz % 64) / 2; }
__host__ __device__ __forceinline__ int perm32(int rho) { const int n = rho >> 4, i = rho & 15; return 8 * (i >> 2) + 4 * n + (i & 3); }

struct Unit { const char* a; const char* b; int orow, ocol, aux; };

template <bool F16 = false, bool ALIGN = true, class Epi, class Sched>
__device__ __forceinline__ void gemm_phase(const int tid, LAS unsigned char* lds, const int K, const int lda, const int ldb, const Sched& S, const Epi& E) {
    const int wid = __builtin_amdgcn_readfirstlane(tid >> 6), lane = tid & 63, wr = wid >> 2, wc = wid & 3, fr = lane & 15, fq = lane >> 4;
    const int nt = K / BK;
    unsigned voffA[2], voffB[2];
#pragma unroll
    for (int i = 0; i < 2; ++i) { int R, C; stage_rc(tid * 16 + i * 8192, R, C); const int Rb = (R & ~31) + perm32(R & 31);
        voffA[i] = (unsigned)(R * lda + C) * 2u; voffB[i] = (unsigned)(Rb * ldb + C) * 2u; }
    const size_t kstep = (size_t)(BK * 2);
    const size_t hstepA = (size_t)HALF * lda * 2, hstepB = (size_t)HALF * ldb * 2;
    const unsigned ldsw = (unsigned)wid * 1024u;
    const int aoff = lds_byte(wr * 64 + fr, fq * 8), boff = lds_byte(wc * 32 + fr, fq * 8);
#define PG8_SA(b, h) (((b) * 2 + (h)) * HTB)
#define PG8_SB(b, h) ((4 + (b) * 2 + (h)) * HTB)
#define PG8_STAGE(bufoff, gbase, voff) do { _Pragma("unroll") for (int _i = 0; _i < 2; ++_i) \
        __builtin_amdgcn_global_load_lds((const unsigned*)((const char*)(gbase) + (voff)[_i]), (LAS unsigned*)(lds + (bufoff) + ldsw + _i * 8192), 16, 0, 0); } while (0)
#define PG8_LDA(dst, b, h) do { _Pragma("unroll") for (int m = 0; m < 4; ++m) _Pragma("unroll") for (int k = 0; k < 2; ++k) dst[m][k] = *(const LAS bf16x8*)(lds + PG8_SA(b, h) + aoff + m * 2048 + k * 1024); } while (0)
#define PG8_LDB(dst, b, h) do { _Pragma("unroll") for (int n = 0; n < 2; ++n) _Pragma("unroll") for (int k = 0; k < 2; ++k) dst[n][k] = *(const LAS bf16x8*)(lds + PG8_SB(b, h) + boff + n * 2048 + k * 1024); } while (0)
#define PG8_MMA(ai, bj, At, Bt) do { __builtin_amdgcn_s_setprio(1); _Pragma("unroll") for (int m = 0; m < 4; ++m) _Pragma("unroll") for (int n = 0; n < 2; ++n) _Pragma("unroll") for (int k = 0; k < 2; ++k) \
        acc[ai][bj][m][n] = F16 ? __builtin_amdgcn_mfma_f32_16x16x32_f16(__builtin_bit_cast(f16x8, Bt[n][k]), __builtin_bit_cast(f16x8, At[m][k]), acc[ai][bj][m][n], 0, 0, 0) \
                                : __builtin_amdgcn_mfma_f32_16x16x32_bf16(Bt[n][k], At[m][k], acc[ai][bj][m][n], 0, 0, 0); __builtin_amdgcn_s_setprio(0); } while (0)
#define PG8_WAIT_V(n) asm volatile("s_waitcnt vmcnt(" #n ")" ::: "memory")
#define PG8_WAIT_L(n) asm volatile("s_waitcnt lgkmcnt(" #n ")" ::: "memory")
#define PG8_BAR __builtin_amdgcn_s_barrier()
#define PG8_SCHED __builtin_amdgcn_sched_barrier(0)
    Unit cur, nxt; int ui = 0;
    if (!S.next(0, cur)) return;
    f32x4 acc[2][2][4][2];
#pragma unroll
    for (int a = 0; a < 2; ++a)
#pragma unroll
        for (int b = 0; b < 2; ++b)
#pragma unroll
            for (int m = 0; m < 4; ++m)
#pragma unroll
                for (int n = 0; n < 2; ++n) acc[a][b][m][n] = (f32x4){0.f, 0.f, 0.f, 0.f};
    bf16x8 At[4][2], B0[2][2], B1[2][2];
    const char* cA = cur.a; const char* cB = cur.b;
    PG8_STAGE(PG8_SB(0, 0), cB, voffB); PG8_STAGE(PG8_SB(0, 1), cB + hstepB, voffB); PG8_STAGE(PG8_SA(0, 0), cA, voffA); PG8_STAGE(PG8_SA(0, 1), cA + hstepA, voffA);
    if (wr == 1) PG8_BAR;
    PG8_WAIT_V(2); PG8_BAR;
    PG8_STAGE(PG8_SB(1, 0), cB + kstep, voffB); PG8_STAGE(PG8_SA(1, 0), cA + kstep, voffA); PG8_STAGE(PG8_SB(1, 1), cB + hstepB + kstep, voffB);
    PG8_WAIT_V(6); PG8_BAR;
    for (;;) {
        const bool has_next = S.next(ui + 1, nxt);
        const char* nA = has_next ? nxt.a : cA; const char* nB = has_next ? nxt.b : cB;
        for (int t = 0; t < nt; t += 2) {
            const bool last = (t == nt - 2);
            const char* a1 = cA + (size_t)(t + 1) * kstep;
            const char* a2 = last ? nA : cA + (size_t)(t + 2) * kstep; const char* b2 = last ? nB : cB + (size_t)(t + 2) * kstep;
            const char* a3 = a2 + kstep; const char* b3 = b2 + kstep;
            PG8_LDB(B0, 0, 0); PG8_LDB(B1, 0, 1); PG8_SCHED; PG8_LDA(At, 0, 0); PG8_STAGE(PG8_SA(1, 1), a1 + hstepA, voffA);
            PG8_WAIT_V(8); PG8_WAIT_L(0); PG8_BAR; PG8_MMA(0, 0, At, B0); PG8_MMA(0, 1, At, B1); PG8_BAR; PG8_SCHED;
            PG8_LDA(At, 0, 1); PG8_STAGE(PG8_SB(0, 0), b2, voffB); PG8_STAGE(PG8_SB(0, 1), b2 + hstepB, voffB); PG8_STAGE(PG8_SA(0, 0), a2, voffA);
            PG8_WAIT_V(8); PG8_WAIT_L(0); PG8_BAR; PG8_MMA(1, 0, At, B0); PG8_MMA(1, 1, At, B1); PG8_BAR; PG8_SCHED;
            PG8_LDB(B0, 1, 0); PG8_LDB(B1, 1, 1); PG8_SCHED; PG8_LDA(At, 1, 0); PG8_STAGE(PG8_SA(0, 1), a2 + hstepA, voffA);
            PG8_WAIT_V(8); PG8_WAIT_L(0); PG8_BAR; PG8_MMA(0, 0, At, B0); PG8_MMA(0, 1, At, B1); PG8_BAR; PG8_SCHED;
            PG8_LDA(At, 1, 1); PG8_STAGE(PG8_SB(1, 0), b3, voffB); PG8_STAGE(PG8_SB(1, 1), b3 + hstepB, voffB); PG8_STAGE(PG8_SA(1, 0), a3, voffA);
            PG8_WAIT_V(8); PG8_WAIT_L(0); PG8_BAR; PG8_MMA(1, 0, At, B0); PG8_MMA(1, 1, At, B1); PG8_BAR; PG8_SCHED;
        }
        if (ALIGN) { if (wr == 0) PG8_BAR; }
        E(acc, cur, wr, wc, fr, fq);
        if (!has_next) break;
#pragma unroll
        for (int a = 0; a < 2; ++a)
#pragma unroll
            for (int b = 0; b < 2; ++b)
#pragma unroll
                for (int m = 0; m < 4; ++m)
#pragma unroll
                    for (int n = 0; n < 2; ++n) acc[a][b][m][n] = (f32x4){0.f, 0.f, 0.f, 0.f};
        cur = nxt; cA = nA; cB = nB; ++ui;
        if (ALIGN) { if (wr == 1) PG8_BAR; }
    }
    PG8_WAIT_V(0);
    if (!ALIGN) { if (wr == 0) PG8_BAR; }
    PG8_BAR;
#undef PG8_SA
#undef PG8_SB
#undef PG8_STAGE
#undef PG8_LDA
#undef PG8_LDB
#undef PG8_MMA
#undef PG8_WAIT_V
#undef PG8_WAIT_L
#undef PG8_SCHED
}
}
namespace pg8 {
struct SchedMN {
    const char* A; const char* Bt; int lda, ldb; int nM, nN, nwg, G, c;
    __device__ __forceinline__ void init(const bf16* A_, int lda_, const bf16* Bt_, int ldb_, int Mrows, int Ncols, int G_, int c_) {
        A = (const char*)A_; Bt = (const char*)Bt_; lda = lda_; ldb = ldb_; nM = Mrows / BM; nN = Ncols / BM; nwg = nM * nN; G = G_; c = c_; }
    __device__ __forceinline__ bool next(int i, Unit& u) const {
        const long L = (long)i * G + c; if (L >= nwg) return false;
        int wgid = (int)L; { const int q = nwg / NXCD, r = nwg % NXCD, xcd = wgid % NXCD, off = wgid / NXCD; wgid = (xcd < r ? xcd * (q + 1) : r * (q + 1) + (xcd - r) * q) + off; }
        const int nig = WGM * nN, gid = wgid / nig, fm = gid * WGM, gsz = (nM - fm) < WGM ? (nM - fm) : WGM;
        const int pm = fm + ((wgid % nig) % gsz), pn = (wgid % nig) / gsz;
        u.a = A + (size_t)pm * BM * lda * 2; u.b = Bt + (size_t)pn * BM * ldb * 2; u.orow = pm * BM; u.ocol = pn * BM; u.aux = pn; return true;
    }
};
struct SchedKV {
    const char* memn; const char* wkv; int G, c;
    __device__ __forceinline__ bool next(int i, Unit& u) const {
        const int L = i * G + c; if (L >= 256) return false;
        const int l = L >> 6, r = L & 63; const char* w = wkv + (size_t)l * 4096 * D * 2;
        if (r < 32) { const int pm = r >> 3, pn = r & 7; u.a = memn + (size_t)pm * 256 * D * 2; u.b = w + (size_t)pn * 256 * D * 2; u.orow = pm * 256; u.ocol = pn * 256; u.aux = l * 2; }
        else { const int q = r - 32, pm = q >> 2, pn = q & 3; u.a = w + (size_t)(2048 + pm * 256) * D * 2; u.b = memn + (size_t)pn * 256 * D * 2; u.orow = pm * 256; u.ocol = pn * 256; u.aux = l * 2 + 1; }
        return true;
    }
};
struct SchedS {
    const char* Q; const char* Km; int G, c;
    __device__ __forceinline__ bool next(int i, Unit& u) const {
        const int L = i * G + c; if (L >= 256) return false;
        const int bh = 2 * (L & 7) + ((L >> 3) >> 4), it = (L >> 3) & 15, b = bh >> 2, h = bh & 3;
        u.a = Q + ((size_t)(b * SEQ + it * 256) * D + h * XAD) * 2; u.b = Km + ((size_t)(b * MEMLEN) * D + h * XAD) * 2; u.orow = b * SEQ + it * 256; u.ocol = h * 256; u.aux = 0; return true;
    }
};
struct SchedPV {
    const char* P; const char* Vt; int G, c;
    __device__ __forceinline__ bool next(int i, Unit& u) const {
        const int L = i * G + c; if (L >= 512) return false;
        const int x = L & 7, r = L >> 3;
        const int bh = 2 * x + (r >> 5), q = r & 31, it = q >> 1, nh = q & 1, b = bh >> 2, h = bh & 3;
        u.a = P + ((size_t)(b * SEQ + it * 256) * 1024 + h * 256) * 2; u.b = Vt + ((size_t)(h * XAD + nh * 256) * 1024 + b * MEMLEN) * 2; u.orow = b * SEQ + it * 256; u.ocol = h * XAD + nh * 256; u.aux = 0; return true;
    }
};
struct SchedDt {
    const char* A; const char* Bt; int c;
    __device__ __forceinline__ bool next(int i, Unit& u) const {
        if (i != 0 || c >= 64) return false;
        u.a = A + (size_t)c * 256 * D * 2; u.b = Bt; u.orow = c * 256; u.ocol = 0; u.aux = 0; return true;
    }
};

struct SchedChainQ {
    const char* A; const char* Bt; int pm, h, n;
    __device__ __forceinline__ bool next(int i, Unit& u) const { if (i >= n) return false; const int pn = 2 * h + i;
        u.a = A + (size_t)pm * 256 * D * 2; u.b = Bt + (size_t)pn * 256 * D * 2; u.orow = pm * 256; u.ocol = pn * 256; u.aux = pn; return true; }
};
struct SchedChainS {
    const char* Q; const char* Km; int pm, h, n;
    __device__ __forceinline__ bool next(int i, Unit& u) const { if (i >= n) return false; const int b = pm >> 4;
        u.a = Q + ((size_t)pm * 256 * D + h * XAD) * 2; u.b = Km + ((size_t)(b * MEMLEN) * D + h * XAD) * 2; u.orow = pm * 256; u.ocol = h * 256; u.aux = 0; return true; }
};
struct SchedChainPV {
    const char* P; const char* Vt; int pm, h, n;
    __device__ __forceinline__ bool next(int i, Unit& u) const { if (i >= n) return false; const int b = pm >> 4;
        u.a = P + ((size_t)pm * 256 * 1024 + h * 256) * 2; u.b = Vt + ((size_t)(h * XAD + i * 256) * 1024 + b * MEMLEN) * 2; u.orow = pm * 256; u.ocol = h * XAD + i * 256; u.aux = 0; return true; }
};

#define EPI_ARGS f32x4 (&acc)[2][2][4][2], const Unit& u, int wr, int wc, int fr, int fq
#define EPI_ROW(ai, m) (u.orow + (ai) * HALF + wr * 64 + (m) * 16 + fr)
#define EPI_COL(bj) (u.ocol + (bj) * HALF + wc * 32 + 8 * fq)
__device__ __forceinline__ float rstd_of(const float* ss, int row) { const f32x4 a = *(const f32x4*)(ss + (size_t)row * 8), b = *(const f32x4*)(ss + (size_t)row * 8 + 4);
    return rsqrtf((((a[0] + a[1]) + (a[2] + a[3])) + ((b[0] + b[1]) + (b[2] + b[3]))) * (1.0f / D) + EPS); }
__device__ __forceinline__ u32x4 pack8(const f32x4 a, const f32x4 b) { u32x4 w; w.x = cvt_pk_bf16(a[0], a[1]); w.y = cvt_pk_bf16(a[2], a[3]); w.z = cvt_pk_bf16(b[0], b[1]); w.w = cvt_pk_bf16(b[2], b[3]); return w; }

struct EpiProjEven {
    const float* ss; bf16* proj; float* logf; const float* lb;
    __device__ __forceinline__ void operator()(EPI_ARGS) const {
        const int range = u.aux >> 2;
#pragma unroll
        for (int ai = 0; ai < 2; ++ai)
#pragma unroll
            for (int m = 0; m < 4; ++m) { const int row = EPI_ROW(ai, m); const float rs = rstd_of(ss, row);
#pragma unroll
                for (int bj = 0; bj < 2; ++bj) { const int col = EPI_COL(bj); f32x4 v0 = acc[ai][bj][m][0] * rs, v1 = acc[ai][bj][m][1] * rs;
                    if (range == 3) { const int c = col - 3072; const f32x4 l0 = *(const f32x4*)(lb + c), l1 = *(const f32x4*)(lb + c + 4);
#pragma unroll
                        for (int j = 0; j < 4; ++j) { v0[j] = __logf(l0[j] + (1.f - l0[j]) * sigm(v0[j])); v1[j] = __logf(l1[j] + (1.f - l1[j]) * sigm(v1[j])); }
                        float* p = logf + (size_t)row * 1024 + c; *(f32x4*)p = v0; *(f32x4*)(p + 4) = v1;
                    } else {
                        if (range == 1) {
#pragma unroll
                            for (int j = 0; j < 4; ++j) { v0[j] = gelu_tanh(v0[j]); v1[j] = gelu_tanh(v1[j]); } }
                        else if (range == 2 || range == 5) {
#pragma unroll
                            for (int j = 0; j < 4; ++j) { v0[j] = siluf(v0[j]); v1[j] = siluf(v1[j]); } }
                        *(u32x4*)(proj + (size_t)row * ABIN + col) = pack8(v0, v1);
                    } } }
    }
};
struct EpiProjOdd {
    const float* ss; bf16* Z; bf16* XBC;
    __device__ __forceinline__ void operator()(EPI_ARGS) const {
        const bool isz = u.ocol < SSDIN;
#pragma unroll
        for (int ai = 0; ai < 2; ++ai)
#pragma unroll
            for (int m = 0; m < 4; ++m) { const int row = EPI_ROW(ai, m); const float rs = rstd_of(ss, row);
#pragma unroll
                for (int bj = 0; bj < 2; ++bj) { const int col = EPI_COL(bj); f32x4 v0 = acc[ai][bj][m][0] * rs, v1 = acc[ai][bj][m][1] * rs;
                    if (isz) {
#pragma unroll
                        for (int j = 0; j < 4; ++j) { v0[j] = siluf(v0[j]); v1[j] = siluf(v1[j]); }
                        *(u32x4*)(Z + (size_t)row * SSDIN + col) = pack8(v0, v1);
                    } else *(u32x4*)(XBC + (size_t)row * SSDCONV + (col - SSDIN)) = pack8(v0, v1); } }
    }
};
struct EpiDt {
    const float* ss; const float* bias; float* DT;
    __device__ __forceinline__ void operator()(EPI_ARGS) const {
        if (wc >= 2) return;
        const int col = wc * 32 + 8 * fq; const f32x4 b0 = *(const f32x4*)(bias + col), b1 = *(const f32x4*)(bias + col + 4);
#pragma unroll
        for (int ai = 0; ai < 2; ++ai)
#pragma unroll
            for (int m = 0; m < 4; ++m) { const int row = EPI_ROW(ai, m); const float rs = rstd_of(ss, row);
                f32x4 v0 = acc[ai][0][m][0] * rs + b0, v1 = acc[ai][0][m][1] * rs + b1;
#pragma unroll
                for (int j = 0; j < 4; ++j) { v0[j] = softplusf(v0[j]); v1[j] = softplusf(v1[j]); }
                float* p = DT + (size_t)row * 64 + col; *(f32x4*)p = v0; *(f32x4*)(p + 4) = v1; }
    }
};
struct EpiResid {
    bf16* xb; float* ssnew; LAS float* tab;
    __device__ __forceinline__ void operator()(EPI_ARGS) const {
#pragma unroll
        for (int ai = 0; ai < 2; ++ai)
#pragma unroll
            for (int m = 0; m < 4; ++m) { const int row = EPI_ROW(ai, m); float sq = 0.f;
#pragma unroll
                for (int bj = 0; bj < 2; ++bj) { bf16* p = xb + (size_t)row * D + EPI_COL(bj); const u32x4 w = *(const u32x4*)p;
                    f32x4 o0 = acc[ai][bj][m][0], o1 = acc[ai][bj][m][1];
                    o0[0] += rs_lo(w.x); o0[1] += rs_hi(w.x); o0[2] += rs_lo(w.y); o0[3] += rs_hi(w.y); o1[0] += rs_lo(w.z); o1[1] += rs_hi(w.z); o1[2] += rs_lo(w.w); o1[3] += rs_hi(w.w);
                    { u32x4 pk; pk.x = rs_pk(o0[0], o0[1]); pk.y = rs_pk(o0[2], o0[3]); pk.z = rs_pk(o1[0], o1[1]); pk.w = rs_pk(o1[2], o1[3]); *(u32x4*)p = pk; }
                    sq += ((o0[0] * o0[0] + o0[1] * o0[1]) + (o0[2] * o0[2] + o0[3] * o0[3])) + ((o1[0] * o1[0] + o1[1] * o1[1]) + (o1[2] * o1[2] + o1[3] * o1[3])); }
                sq += __shfl_xor(sq, 16); sq += __shfl_xor(sq, 32);
                if (fq == 0) tab[(ai * HALF + wr * 64 + m * 16 + fr) * 4 + wc] = sq; }
        LDS_WAIT(); PG8_BAR; asm volatile("" ::: "memory");
        const int lane = fq * 16 + fr, r = (wr * 4 + wc) * 32 + (lane & 31);
        if (lane < 32) { const f32x4 t = *(const LAS f32x4*)(tab + r * 4); ssnew[(size_t)(u.orow + r) * 8 + (u.ocol >> 8)] = (t[0] + t[1]) + (t[2] + t[3]); }
    }
};
struct EpiQ {
    const float* ss; bf16* Q; float scale;
    __device__ __forceinline__ void operator()(EPI_ARGS) const {
#pragma unroll
        for (int ai = 0; ai < 2; ++ai)
#pragma unroll
            for (int m = 0; m < 4; ++m) { const int row = EPI_ROW(ai, m); const float rs = rstd_of(ss, row) * scale;
#pragma unroll
                for (int bj = 0; bj < 2; ++bj) *(u32x4*)(Q + (size_t)row * D + EPI_COL(bj)) = pack8(acc[ai][bj][m][0] * rs, acc[ai][bj][m][1] * rs); }
    }
};
struct EpiPlain {
    bf16* O; int ldc;
    __device__ __forceinline__ void operator()(EPI_ARGS) const {
#pragma unroll
        for (int ai = 0; ai < 2; ++ai)
#pragma unroll
            for (int m = 0; m < 4; ++m) { const int row = EPI_ROW(ai, m);
#pragma unroll
                for (int bj = 0; bj < 2; ++bj) *(u32x4*)(O + (size_t)row * ldc + EPI_COL(bj)) = pack8(acc[ai][bj][m][0], acc[ai][bj][m][1]); }
    }
};
struct EpiKV {
    bf16* Km; bf16* Vt;
    __device__ __forceinline__ void operator()(EPI_ARGS) const {
        const int l = u.aux >> 1; const bool isv = u.aux & 1;
        bf16* O = isv ? Vt + (size_t)l * D * MEMROWS : Km + (size_t)l * MEMROWS * D; const int ldc = isv ? MEMROWS : D;
#pragma unroll
        for (int ai = 0; ai < 2; ++ai)
#pragma unroll
            for (int m = 0; m < 4; ++m) { const int row = EPI_ROW(ai, m);
#pragma unroll
                for (int bj = 0; bj < 2; ++bj) *(u32x4*)(O + (size_t)row * ldc + EPI_COL(bj)) = pack8(acc[ai][bj][m][0], acc[ai][bj][m][1]); }
    }
};
struct EpiSoftmax {
    bf16* P; LAS float* tab;
    __device__ __forceinline__ void operator()(EPI_ARGS) const {
        float mx[2][4];
#pragma unroll
        for (int ai = 0; ai < 2; ++ai)
#pragma unroll
            for (int m = 0; m < 4; ++m) { float v = -3.0e38f;
#pragma unroll
                for (int bj = 0; bj < 2; ++bj)
#pragma unroll
                    for (int n = 0; n < 2; ++n) { const f32x4 a = acc[ai][bj][m][n]; v = fmaxf(v, fmaxf(fmaxf(a[0], a[1]), fmaxf(a[2], a[3]))); }
                v = fmaxf(v, __shfl_xor(v, 16)); v = fmaxf(v, __shfl_xor(v, 32));
                if (fq == 0) tab[(ai * HALF + wr * 64 + m * 16 + fr) * 4 + wc] = v; }
        LDS_WAIT(); PG8_BAR; asm volatile("" ::: "memory");
#pragma unroll
        for (int ai = 0; ai < 2; ++ai)
#pragma unroll
            for (int m = 0; m < 4; ++m) { const int r = ai * HALF + wr * 64 + m * 16 + fr; const f32x4 t = *(const LAS f32x4*)(tab + r * 4);
                const float rm = fmaxf(fmaxf(t[0], t[1]), fmaxf(t[2], t[3])); float s = 0.f;
#pragma unroll
                for (int bj = 0; bj < 2; ++bj)
#pragma unroll
                    for (int n = 0; n < 2; ++n) { f32x4 a = acc[ai][bj][m][n];
#pragma unroll
                        for (int j = 0; j < 4; ++j) { a[j] = __expf(a[j] - rm); s += a[j]; }
                        acc[ai][bj][m][n] = a; }
                s += __shfl_xor(s, 16); s += __shfl_xor(s, 32);
                if (fq == 0) tab[1024 + r * 4 + wc] = s; }
        LDS_WAIT(); PG8_BAR; asm volatile("" ::: "memory");
#pragma unroll
        for (int ai = 0; ai < 2; ++ai)
#pragma unroll
            for (int m = 0; m < 4; ++m) { const int r = ai * HALF + wr * 64 + m * 16 + fr; const f32x4 t = *(const LAS f32x4*)(tab + 1024 + r * 4);
                const float inv = __builtin_amdgcn_rcpf((t[0] + t[1]) + (t[2] + t[3])); const int row = u.orow + r;
#pragma unroll
                for (int bj = 0; bj < 2; ++bj) *(u32x4*)(P + (size_t)row * 1024 + EPI_COL(bj)) = pack8(acc[ai][bj][m][0] * inv, acc[ai][bj][m][1] * inv); }
    }
};
struct EpiGateUp {
    const float* ss; bf16* H;
    __device__ __forceinline__ void operator()(EPI_ARGS) const {
#pragma unroll
        for (int ai = 0; ai < 2; ++ai)
#pragma unroll
            for (int m = 0; m < 4; ++m) { const int row = EPI_ROW(ai, m); const float rs = rstd_of(ss, row);
#pragma unroll
                for (int bj = 0; bj < 2; ++bj) { const int hc = EPI_COL(bj) >> 1; const f32x4 g = acc[ai][bj][m][0] * rs, up = acc[ai][bj][m][1] * rs; f32x4 h;
#pragma unroll
                    for (int j = 0; j < 4; ++j) h[j] = siluf(g[j]) * up[j];
                    u32x2 w; w.x = cvt_pk_bf16(h[0], h[1]); w.y = cvt_pk_bf16(h[2], h[3]); *(u32x2*)(H + (size_t)row * FF + hc) = w; } }
    }
};
#undef EPI_ARGS
}
#define MFMA16(X, Y, ACC) __builtin_amdgcn_mfma_f32_16x16x32_bf16((X), (Y), (ACC), 0, 0, 0)
#define WG_SYNC() do { asm volatile("s_waitcnt vmcnt(0) lgkmcnt(0)" ::: "memory"); __builtin_amdgcn_s_barrier(); asm volatile("" ::: "memory"); } while (0)
#define LDS_SYNC() do { asm volatile("s_waitcnt lgkmcnt(0)" ::: "memory"); __builtin_amdgcn_s_barrier(); asm volatile("" ::: "memory"); } while (0)
constexpr int LP = 136;
constexpr int LP64 = 72;
__device__ __forceinline__ bf16x8 lds_frag(const LAS bf16* base, int row, int pitch, int kofs) { return *(const LAS bf16x8*)(base + row * pitch + kofs); }
__device__ __forceinline__ u32x2 pack4(const f32x4 a) { u32x2 w; w.x = cvt_pk_bf16(a[0], a[1]); w.y = cvt_pk_bf16(a[2], a[3]); return w; }

template <int MAP, bool F16>
__device__ __forceinline__ void conv_item(const float* W, int ldw, int K, int n0, const float* gain, bf16* WT, int row_off, LAS float* scr, int item, int nblk, int lane) {
    const int kb = item / nblk, nb = item % nblk, k0 = 64 * kb, nn0 = 64 * nb;
    const int kr = lane >> 4, n4 = (lane & 15) * 4;
    const float* src = W + (size_t)(k0 + kr) * ldw + n0 + nn0 + n4;
    f32x4 v[16];
#pragma unroll
    for (int i = 0; i < 16; ++i) v[i] = *(const f32x4*)(src + (size_t)(4 * i) * ldw);
#pragma unroll
    for (int i = 0; i < 16; ++i) { f32x4 w = v[i]; if (gain) w = w * gain[k0 + 4 * i + kr];
        LAS float* d = scr + (4 * i + kr) * 65 + n4; d[0] = w[0]; d[1] = w[1]; d[2] = w[2]; d[3] = w[3]; }
    LDS_WAIT(); asm volatile("" ::: "memory");
    const int c = lane & 7, nbase = lane >> 3;
#pragma unroll
    for (int j = 0; j < 8; ++j) { const int n = nbase + 8 * j; const LAS float* s = scr + (8 * c) * 65 + n;
        u32x4 o; if (F16) { o.x = cvt_pk_f16(s[0 * 65], s[1 * 65]); o.y = cvt_pk_f16(s[2 * 65], s[3 * 65]); o.z = cvt_pk_f16(s[4 * 65], s[5 * 65]); o.w = cvt_pk_f16(s[6 * 65], s[7 * 65]); }
        else { o.x = cvt_pk_bf16(s[0 * 65], s[1 * 65]); o.y = cvt_pk_bf16(s[2 * 65], s[3 * 65]); o.z = cvt_pk_bf16(s[4 * 65], s[5 * 65]); o.w = cvt_pk_bf16(s[6 * 65], s[7 * 65]); }
        const int nn = nn0 + n; const int dr = MAP == 0 ? nn : ((nn >> 2) * 8 + (nn & 3) + (MAP == 2 ? 4 : 0));
        *(u32x4*)(WT + (size_t)(row_off + dr) * K + k0 + 8 * c) = o; }
    LDS_WAIT(); asm volatile("" ::: "memory");
}
template <int MAP, bool F16 = false>
__device__ __forceinline__ void conv_matrix(const float* W, int ldw, int K, int n0, int ncols, const float* gain, bf16* WT, int row_off, LAS float* scr, int gw, int NGW, int lane, int& rot) {
    const int nblk = ncols / 64, nitems = (K / 64) * nblk; int first = gw - rot; if (first < 0) first += NGW;
    for (int it = first; it < nitems; it += NGW) conv_item<MAP, F16>(W, ldw, K, n0, gain, WT, row_off, scr, it, nblk, lane);
    rot = (rot + nitems) % NGW;
}

struct In {
    const float *x, *mem, *norm_mix, *norm_xattn, *norm_ffn, *norm_mem, *norm_final, *ab_w_in, *ab_w_out, *lru_conv_w, *lru_conv_b, *lru_w_r, *lru_b_r, *lru_w_i, *lru_b_i, *lru_lambda,
        *hgrn_lb, *hgrn_norm, *ssd_w_in, *ssd_w_out, *ssd_conv_w, *ssd_conv_b, *ssd_dt_bias, *ssd_a_log, *ssd_d, *ssd_norm, *xa_w_q, *xa_w_kv, *xa_w_o, *ffn_w_gate, *ffn_w_up, *ffn_w_down;
};

typedef const In __attribute__((address_space(4))) CIn;
__device__ __forceinline__ void convert_layer(CIn& I, int l, bf16* WL, LAS float* scr, int gw, int NGW, int lane, int& rot) {
    const int e = l >> 1;
    if ((l & 1) == 0) {
        conv_matrix<0, RF16>(I.ab_w_in + (size_t)e * D * ABIN, ABIN, D, 0, ABIN, I.norm_mix + l * D, WL + WL_IN, 0, scr, gw, NGW, lane, rot);
        conv_matrix<0>(I.ab_w_out + (size_t)e * D * D, D, D, 0, D, nullptr, WL + WL_OUT, 0, scr, gw, NGW, lane, rot);
    } else {
        conv_matrix<0, RF16>(I.ssd_w_in + (size_t)e * D * SSDPROJ, SSDPROJ, D, 0, SSDN1, I.norm_mix + l * D, WL + WL_IN, 0, scr, gw, NGW, lane, rot);
        conv_matrix<0, RF16>(I.ssd_w_in + (size_t)e * D * SSDPROJ, SSDPROJ, D, SSDN1, 64, I.norm_mix + l * D, WL + WL_DT, 0, scr, gw, NGW, lane, rot);
        for (int i = gw * 64 + lane; i < 192 * D / 8; i += NGW * 64) *(u32x4*)(WL + WL_DT + (size_t)64 * D + (size_t)i * 8) = (u32x4){0u, 0u, 0u, 0u};
        conv_matrix<0>(I.ssd_w_out + (size_t)e * SSDIN * D, D, SSDIN, 0, D, nullptr, WL + WL_OUT, 0, scr, gw, NGW, lane, rot);
    }
    conv_matrix<0, RF16>(I.xa_w_q + (size_t)l * D * D, D, D, 0, D, I.norm_xattn + l * D, WL + WL_Q, 0, scr, gw, NGW, lane, rot);
    conv_matrix<0>(I.xa_w_o + (size_t)l * D * D, D, D, 0, D, nullptr, WL + WL_O, 0, scr, gw, NGW, lane, rot);
    conv_matrix<1, RF16>(I.ffn_w_gate + (size_t)l * D * FF, FF, D, 0, FF, I.norm_ffn + l * D, WL + WL_GU, 0, scr, gw, NGW, lane, rot);
    conv_matrix<2, RF16>(I.ffn_w_up + (size_t)l * D * FF, FF, D, 0, FF, I.norm_ffn + l * D, WL + WL_GU, 0, scr, gw, NGW, lane, rot);
    conv_matrix<0>(I.ffn_w_down + (size_t)l * FF * D, D, FF, 0, D, nullptr, WL + WL_DN, 0, scr, gw, NGW, lane, rot);
}

template <bool PASSB>
__device__ __forceinline__ void lru_units(const int tid, LAS unsigned char* lds, int G, int cu, const bf16* PROJ, const bf16* WRT, const float* cw, const float* cb, const float* br, const float* bi,
                                          const float* lam, float* SEG, bf16* YAB) {
    const int wid = __builtin_amdgcn_readfirstlane(tid >> 6), lane = tid & 63, q = lane >> 4, c16 = lane & 15;
    LAS bf16* XA = (LAS bf16*)(lds);
    LAS bf16* XC = (LAS bf16*)(lds + 35840);
    LAS bf16* WR = (LAS bf16*)(lds + 70656);
    LAS bf16* WI = (LAS bf16*)(lds + 105472);
    LAS float* PAR = (LAS float*)(lds + 140288);
    LAS float* WT = (LAS float*)(lds + 144384);
    LAS float* HIN = (LAS float*)(lds + 152576);
    int loadedj = -1;
    for (int u = cu; u < 1024; u += G) {
        const int j = u & 7, rest = u >> 3, b = rest >> 5, seg = rest & 31; const int t0 = b * SEQ + seg * 128;
        if (j != loadedj) {
            loadedj = j;
            for (int p = tid; p < 2 * 2048; p += NTHR) { const int g = p >> 11, pp = p & 2047, r = pp >> 4, pc = pp & 15;
                const u32x4 v = *(const u32x4*)(WRT + ((size_t)(g * 8 + j) * 128 + r) * 128 + pc * 8);
                *(LAS u32x4*)((g ? WI : WR) + r * LP + pc * 8) = v; }
            if (tid < 128) { const int ch = j * 128 + tid;
                PAR[0 * 128 + tid] = 8.0f * softplusf(-lam[ch]); PAR[1 * 128 + tid] = br[ch]; PAR[2 * 128 + tid] = bi[ch]; PAR[3 * 128 + tid] = cb[ch];
#pragma unroll
                for (int k = 0; k < 4; ++k) PAR[(4 + k) * 128 + tid] = cw[k * LRUW + ch]; }
        }
        for (int p = tid; p < 131 * 16; p += NTHR) { const int r = p >> 4, pc = p & 15; u32x4 v = (u32x4){0u, 0u, 0u, 0u};
            if (seg > 0 || r >= 3) v = *(const u32x4*)(PROJ + (size_t)(t0 + r - 3) * ABIN + j * 128 + pc * 8);
            *(LAS u32x4*)(XA + r * LP + pc * 8) = v; }
        if (PASSB) { if (tid < 128) { float h = 0.f; const float* sg = SEG + ((size_t)(b * 8 + j) * 32) * 256 + tid * 2;
                for (int s = 0; s < seg; ++s) { const f32x2 ab = *(const f32x2*)(sg + (size_t)s * 256); h = ab.x * h + ab.y; }
                HIN[tid] = h; } }
        WG_SYNC();
        {
            const int ch8 = tid & 15, tr = tid >> 4; u32x4 rows[7];
#pragma unroll
            for (int i = 0; i < 7; ++i) rows[i] = *(const LAS u32x4*)(XA + (4 * tr + i) * LP + ch8 * 8);
            float w[4][8], bb[8];
#pragma unroll
            for (int e = 0; e < 8; ++e) { bb[e] = PAR[3 * 128 + ch8 * 8 + e];
#pragma unroll
                for (int k = 0; k < 4; ++k) w[k][e] = PAR[(4 + k) * 128 + ch8 * 8 + e]; }
#pragma unroll
            for (int i = 0; i < 4; ++i) { float o[8];
#pragma unroll
                for (int e = 0; e < 8; ++e) { float a = bb[e];
#pragma unroll
                    for (int k = 0; k < 4; ++k) { const unsigned wd = rows[i + k][e >> 1]; a += w[k][e] * ((e & 1) ? bfhi(wd) : bflo(wd)); }
                    o[e] = a; }
                u32x4 pk; pk.x = cvt_pk_bf16(o[0], o[1]); pk.y = cvt_pk_bf16(o[2], o[3]); pk.z = cvt_pk_bf16(o[4], o[5]); pk.w = cvt_pk_bf16(o[6], o[7]);
                *(LAS u32x4*)(XC + (4 * tr + i) * LP + ch8 * 8) = pk; }
        }
        WG_SYNC();
        float PP[8][4], HH[8][4];
        {
            bf16x8 xf[4];
#pragma unroll
            for (int ks = 0; ks < 4; ++ks) xf[ks] = lds_frag(XC, 16 * wid + c16, LP, 32 * ks + 8 * q);
#pragma unroll
            for (int jb = 0; jb < 8; ++jb) {
                f32x4 aR = (f32x4){0.f, 0.f, 0.f, 0.f}, aI = aR;
#pragma unroll
                for (int ks = 0; ks < 4; ++ks) { aR = MFMA16(xf[ks], lds_frag(WR, 16 * jb + c16, LP, 32 * ks + 8 * q), aR); aI = MFMA16(xf[ks], lds_frag(WI, 16 * jb + c16, LP, 32 * ks + 8 * q), aI); }
                const int ch = 16 * jb + c16;
                const float sp8 = PAR[ch], pbr = PAR[128 + ch], pbi = PAR[256 + ch], pcb = PAR[384 + ch], w0 = PAR[512 + ch], w1 = PAR[640 + ch], w2 = PAR[768 + ch], w3 = PAR[896 + ch];
                float xr[7];
#pragma unroll
                for (int i = 0; i < 7; ++i) xr[i] = bf2f(XA[(16 * wid + 4 * q + i) * LP + ch]);
                float a[4], bt[4];
#pragma unroll
                for (int r = 0; r < 4; ++r) { const float xc = pcb + w0 * xr[r] + w1 * xr[r + 1] + w2 * xr[r + 2] + w3 * xr[r + 3];
                    const float rg = sigm(aR[r] + pbr), ig = sigm(aI[r] + pbi); const float la = -sp8 * rg;
                    const float av = __expf(la), x2 = 2.0f * la; a[r] = av;
                    const float om = (x2 > -0.02f) ? -x2 * (1.0f + x2 * (0.5f + x2 * 0.16666667f)) : 1.0f - av * av;
                    bt[r] = __builtin_amdgcn_sqrtf(fmaxf(om, 0.f)) * ig * xc; }
                float P[4], H[4]; P[0] = a[0]; H[0] = bt[0];
#pragma unroll
                for (int r = 1; r < 4; ++r) { P[r] = a[r] * P[r - 1]; H[r] = a[r] * H[r - 1] + bt[r]; }
                float Ae = 1.f, Be = 0.f, Aw = 1.f, Bw = 0.f;
#pragma unroll
                for (int qq = 0; qq < 4; ++qq) { const float Aq = __shfl(P[3], c16 + 16 * qq), Bq = __shfl(H[3], c16 + 16 * qq);
                    if (qq < q) { Be = Aq * Be + Bq; Ae = Aq * Ae; }
                    Bw = Aq * Bw + Bq; Aw = Aq * Aw; }
#pragma unroll
                for (int r = 0; r < 4; ++r) { PP[jb][r] = P[r] * Ae; HH[jb][r] = P[r] * Be + H[r]; }
                if (q == 0) *(LAS f32x2*)(WT + (wid * 128 + ch) * 2) = (f32x2){Aw, Bw};
            }
        }
        WG_SYNC();
        if (!PASSB) {
            if (tid < 128) { float A = 1.f, B = 0.f;
#pragma unroll
                for (int w = 0; w < 8; ++w) { const f32x2 ab = *(const LAS f32x2*)(WT + (w * 128 + tid) * 2); B = ab.x * B + ab.y; A = ab.x * A; }
                *(f32x2*)(SEG + ((size_t)(b * 8 + j) * 32 + seg) * 256 + tid * 2) = (f32x2){A, B}; }
        } else {
#pragma unroll
            for (int jb = 0; jb < 8; ++jb) { const int ch = 16 * jb + c16; float h0 = HIN[ch];
                for (int w = 0; w < wid; ++w) { const f32x2 ab = *(const LAS f32x2*)(WT + (w * 128 + ch) * 2); h0 = ab.x * h0 + ab.y; }
#pragma unroll
                for (int r = 0; r < 4; ++r) { const int t = t0 + 16 * wid + 4 * q + r; const float h = PP[jb][r] * h0 + HH[jb][r];
                    const float ga = bf2f(PROJ[(size_t)t * ABIN + 1024 + j * 128 + ch]);
                    YAB[(size_t)t * D + j * 128 + ch] = (bf16)f2bf(ga * h); } }
        }
        WG_SYNC();
    }
}

__device__ __forceinline__ void hgrn1_load(float (&lf)[16], unsigned (&vv)[16], const float* LOGF, const bf16* PROJ, int u, int k, int qt) {
    const int bh = u >> 6, c = u & 63, b = bh >> 3, h = bh & 7; const int t0 = b * SEQ + c * 64 + 16 * qt;
#pragma unroll
    for (int i = 0; i < 16; ++i) { lf[i] = LOGF[(size_t)(t0 + i) * 1024 + h * 128 + k]; vv[i] = PROJ[(size_t)(t0 + i) * ABIN + 4096 + h * 128 + k]; }
}
__device__ __forceinline__ void hgrn1_units(const int tid, LAS unsigned char* lds, int G, int cu, const float* LOGF, const bf16* PROJ, bf16* HST, float* HDEC) {
    const int wid = __builtin_amdgcn_readfirstlane(tid >> 6), lane = tid & 63, q = lane >> 4, c16 = lane & 15;
    LAS bf16* KT = (LAS bf16*)(lds);
    LAS bf16* VT = (LAS bf16*)(lds + 18432);
    LAS float* TOT = (LAS float*)(lds + 36864);
    const int k = tid & 127, qt = tid >> 7;
    float lf[16], nlf[16]; unsigned vv[16], nvv[16];
    if (cu < 2048) hgrn1_load(lf, vv, LOGF, PROJ, cu, k, qt);
    for (int u = cu; u < 2048; u += G) {
        if (u + G < 2048) hgrn1_load(nlf, nvv, LOGF, PROJ, u + G, k, qt);
        float cs[16];
        cs[0] = lf[0];
#pragma unroll
        for (int i = 1; i < 16; ++i) cs[i] = cs[i - 1] + lf[i];
        TOT[qt * 128 + k] = cs[15];
        LDS_SYNC();
        float pre = 0.f, last = 0.f;
#pragma unroll
        for (int qq = 0; qq < 4; ++qq) { const float t = TOT[qq * 128 + k]; if (qq < qt) pre += t; last += t; }
        unsigned kw[8], vw[8];
#pragma unroll
        for (int i = 0; i < 8; ++i) { const float k0 = (1.f - __expf(lf[2 * i])) * __expf(last - (pre + cs[2 * i])), k1 = (1.f - __expf(lf[2 * i + 1])) * __expf(last - (pre + cs[2 * i + 1]));
            kw[i] = cvt_pk_bf16(k0, k1); vw[i] = vv[2 * i] | (vv[2 * i + 1] << 16); }
        *(LAS u32x4*)(KT + k * LP64 + 16 * qt) = (u32x4){kw[0], kw[1], kw[2], kw[3]}; *(LAS u32x4*)(KT + k * LP64 + 16 * qt + 8) = (u32x4){kw[4], kw[5], kw[6], kw[7]};
        *(LAS u32x4*)(VT + k * LP64 + 16 * qt) = (u32x4){vw[0], vw[1], vw[2], vw[3]}; *(LAS u32x4*)(VT + k * LP64 + 16 * qt + 8) = (u32x4){vw[4], vw[5], vw[6], vw[7]};
        if (qt == 0) HDEC[(size_t)u * 128 + k] = __expf(last);
        LDS_SYNC();
        bf16x8 kf[2];
#pragma unroll
        for (int ks = 0; ks < 2; ++ks) kf[ks] = lds_frag(KT, 16 * wid + c16, LP64, 32 * ks + 8 * q);
#pragma unroll
        for (int vb = 0; vb < 8; ++vb) { f32x4 acc = (f32x4){0.f, 0.f, 0.f, 0.f};
#pragma unroll
            for (int ks = 0; ks < 2; ++ks) acc = MFMA16(kf[ks], lds_frag(VT, 16 * vb + c16, LP64, 32 * ks + 8 * q), acc);
            *(u32x2*)(HST + ((size_t)u * 128 + 16 * vb + c16) * 128 + 16 * wid + 4 * q) = pack4(acc); }
        LDS_SYNC();
#pragma unroll
        for (int i = 0; i < 16; ++i) { lf[i] = nlf[i]; vv[i] = nvv[i]; }
    }
    WG_SYNC();
}
__device__ __forceinline__ void hgrn2_scan(const int tid, int G, int cu, bf16* HST, const float* HDEC) {
    for (int task = cu * NTHR + tid; task < 32 * 4096; task += G * NTHR) {
        const int bh = task >> 12, e = (task & 4095) * 4; f32x4 S = (f32x4){0.f, 0.f, 0.f, 0.f};
        bf16* p0 = HST + (size_t)bh * 64 * 16384 + e; const float* d0 = HDEC + (size_t)bh * 64 * 128 + (e & 127);
#pragma unroll 1
        for (int cb = 0; cb < 64; cb += 16) { u32x2 L[16]; f32x4 d[16];
#pragma unroll
            for (int c = 0; c < 16; ++c) { L[c] = *(const u32x2*)(p0 + (size_t)(cb + c) * 16384); d[c] = *(const f32x4*)(d0 + (size_t)(cb + c) * 128); }
#pragma unroll
            for (int c = 0; c < 16; ++c) { *(u32x2*)(p0 + (size_t)(cb + c) * 16384) = pack4(S);
                S[0] = d[c][0] * S[0] + bflo(L[c].x); S[1] = d[c][1] * S[1] + bfhi(L[c].x); S[2] = d[c][2] * S[2] + bflo(L[c].y); S[3] = d[c][3] * S[3] + bfhi(L[c].y); } }
    }
}
__device__ __forceinline__ void hgrn3_load(float (&lf)[16], unsigned (&qv)[16], unsigned (&vv)[16], u32x4 (&st)[4], const float* LOGF, const bf16* PROJ, const bf16* HST, int u, int k, int qt, int tid) {
    const int bh = u >> 6, c = u & 63, b = bh >> 3, h = bh & 7; const int t0 = b * SEQ + c * 64 + 16 * qt;
#pragma unroll
    for (int i = 0; i < 16; ++i) { lf[i] = LOGF[(size_t)(t0 + i) * 1024 + h * 128 + k]; const bf16* pr = PROJ + (size_t)(t0 + i) * ABIN + h * 128 + k; qv[i] = pr[2048]; vv[i] = pr[4096]; }
#pragma unroll
    for (int i = 0; i < 4; ++i) { const int p = tid + NTHR * i, r = p >> 4, pc = p & 15; st[i] = *(const u32x4*)(HST + (size_t)u * 16384 + r * 128 + pc * 8); }
}
__device__ __forceinline__ void hgrn3_units(const int tid, LAS unsigned char* lds, int G, int cu, const float* LOGF, const bf16* PROJ, const bf16* HST, const float* hnorm, bf16* YAB) {
    const int wid = __builtin_amdgcn_readfirstlane(tid >> 6), lane = tid & 63, q = lane >> 4, c16 = lane & 15;
    LAS bf16* QH = (LAS bf16*)(lds);
    LAS bf16* QT = (LAS bf16*)(lds + 17408);
    LAS bf16* KH = (LAS bf16*)(lds + 34816);
    LAS bf16* VT = (LAS bf16*)(lds + 52224);
    LAS bf16* STL = (LAS bf16*)(lds + 70656);
    LAS bf16* PM = (LAS bf16*)(lds + 105472);
    LAS float* TOT = (LAS float*)(lds + 114688);
    LAS float* SQ = (LAS float*)(lds + 116736);
    const int k = tid & 127, qt = tid >> 7;
    float lf[16], nlf[16]; unsigned qv[16], nqv[16], vv[16], nvv[16]; u32x4 st[4], nst[4];
    if (cu < 2048) hgrn3_load(lf, qv, vv, st, LOGF, PROJ, HST, cu, k, qt, tid);
    for (int u = cu; u < 2048; u += G) {
        const int bh = u >> 6, c = u & 63, b = bh >> 3, h = bh & 7; const int tc = b * SEQ + c * 64;
        float cs[16];
        cs[0] = lf[0];
#pragma unroll
        for (int i = 1; i < 16; ++i) cs[i] = cs[i - 1] + lf[i];
        TOT[qt * 128 + k] = cs[15];
#pragma unroll
        for (int i = 0; i < 4; ++i) { const int p = tid + NTHR * i, r = p >> 4, pc = p & 15; *(LAS u32x4*)(STL + r * LP + pc * 8) = st[i]; }
        if (u + G < 2048) hgrn3_load(nlf, nqv, nvv, nst, LOGF, PROJ, HST, u + G, k, qt, tid);
        LDS_SYNC();
        float pre = 0.f;
#pragma unroll
        for (int qq = 0; qq < 4; ++qq) { const float t = TOT[qq * 128 + k]; if (qq < qt) pre += t; }
        const float ref = TOT[k] + TOT[128 + k];
        unsigned vw[8];
#pragma unroll
        for (int i = 0; i < 16; ++i) { const float cum = pre + cs[i], kk = 1.f - __expf(lf[i]), qf = bf2f((bf16)qv[i]);
            QT[(16 * qt + i) * LP + k] = (bf16)f2bf(qf * __expf(cum));
            QH[(16 * qt + i) * LP + k] = (bf16)f2bf(qf * __expf(fminf(cum - ref, 80.f)));
            KH[(16 * qt + i) * LP + k] = (bf16)f2bf(kk * __expf(fminf(ref - cum, 80.f))); }
#pragma unroll
        for (int i = 0; i < 8; ++i) vw[i] = vv[2 * i] | (vv[2 * i + 1] << 16);
        *(LAS u32x4*)(VT + k * LP64 + 16 * qt) = (u32x4){vw[0], vw[1], vw[2], vw[3]}; *(LAS u32x4*)(VT + k * LP64 + 16 * qt + 8) = (u32x4){vw[4], vw[5], vw[6], vw[7]};
        LDS_SYNC();
        {
            const int tb = wid & 3;
            bf16x8 qf[4];
#pragma unroll
            for (int ks = 0; ks < 4; ++ks) qf[ks] = lds_frag(QH, 16 * tb + c16, LP, 32 * ks + 8 * q);
#pragma unroll
            for (int sbi = 0; sbi < 2; ++sbi) { const int sb = 2 * (wid >> 2) + sbi; f32x4 acc = (f32x4){0.f, 0.f, 0.f, 0.f};
#pragma unroll
                for (int ks = 0; ks < 4; ++ks) acc = MFMA16(lds_frag(KH, 16 * sb + c16, LP, 32 * ks + 8 * q), qf[ks], acc);
                const int t = 16 * tb + c16, s0 = 16 * sb + 4 * q;
#pragma unroll
                for (int r = 0; r < 4; ++r) acc[r] = (s0 + r <= t) ? acc[r] : 0.f;
                *(LAS u32x2*)(PM + t * LP64 + s0) = pack4(acc); }
        }
        LDS_SYNC();
        {
            const int tb = wid & 3, vh = wid >> 2, t = 16 * tb + c16;
            bf16x8 qf[4], pf[2];
#pragma unroll
            for (int ks = 0; ks < 4; ++ks) qf[ks] = lds_frag(QT, t, LP, 32 * ks + 8 * q);
#pragma unroll
            for (int ks = 0; ks < 2; ++ks) pf[ks] = lds_frag(PM, t, LP64, 32 * ks + 8 * q);
            f32x4 acc[4]; float sq = 0.f;
#pragma unroll
            for (int vb = 0; vb < 4; ++vb) { const int vr = 64 * vh + 16 * vb + c16; acc[vb] = (f32x4){0.f, 0.f, 0.f, 0.f};
#pragma unroll
                for (int ks = 0; ks < 4; ++ks) acc[vb] = MFMA16(lds_frag(STL, vr, LP, 32 * ks + 8 * q), qf[ks], acc[vb]);
#pragma unroll
                for (int ks = 0; ks < 2; ++ks) acc[vb] = MFMA16(lds_frag(VT, vr, LP64, 32 * ks + 8 * q), pf[ks], acc[vb]);
                sq += (acc[vb][0] * acc[vb][0] + acc[vb][1] * acc[vb][1]) + (acc[vb][2] * acc[vb][2] + acc[vb][3] * acc[vb][3]); }
            sq += __shfl_xor(sq, 16); sq += __shfl_xor(sq, 32);
            if (q == 0) SQ[vh * 64 + t] = sq;
            LDS_SYNC();
            const float rstd = rsqrtf((SQ[t] + SQ[64 + t]) * (1.0f / 128.f) + EPS);
#pragma unroll
            for (int vb = 0; vb < 4; ++vb) { const int v0 = 64 * vh + 16 * vb + 4 * q; const f32x4 hn = *(const f32x4*)(hnorm + h * 128 + v0);
                const u32x2 gw = *(const u32x2*)(PROJ + (size_t)(tc + t) * ABIN + 5120 + h * 128 + v0);
                f32x4 y; y[0] = acc[vb][0] * rstd * hn[0] * bflo(gw.x); y[1] = acc[vb][1] * rstd * hn[1] * bfhi(gw.x); y[2] = acc[vb][2] * rstd * hn[2] * bflo(gw.y); y[3] = acc[vb][3] * rstd * hn[3] * bfhi(gw.y);
                *(u32x2*)(YAB + (size_t)(tc + t) * D + 1024 + h * 128 + v0) = pack4(y); }
        }
        LDS_SYNC();
#pragma unroll
        for (int i = 0; i < 16; ++i) { lf[i] = nlf[i]; qv[i] = nqv[i]; vv[i] = nvv[i]; }
#pragma unroll
        for (int i = 0; i < 4; ++i) st[i] = nst[i];
    }
    WG_SYNC();
}
__device__ __forceinline__ void ssd_prep_load(u32x4 (&rows)[7], const bf16* XBC, int u, int ch8, int tr) {
    const int bc = u / 48, cblk = u % 48, c = bc & 31; const bf16* src = XBC + (size_t)(bc * 128 + 4 * tr - 3) * SSDCONV + cblk * 128 + ch8 * 8;
#pragma unroll
    for (int i = 0; i < 7; ++i) { rows[i] = (u32x4){0u, 0u, 0u, 0u}; if (c > 0 || 4 * tr + i >= 3) rows[i] = *(const u32x4*)(src + (size_t)i * SSDCONV); }
}
__device__ __forceinline__ void ssd_prep_units(const int tid, LAS unsigned char* lds, int ufirst, int ustride, int uend, const bf16* XBC, const float* cw, const float* cb, bf16* XBT, bf16* BCN) {
    LAS bf16* T = (LAS bf16*)(lds);
    const int ch8 = tid & 15, tr = tid >> 4;
    u32x4 rows[7], nrows[7];
    if (ufirst < uend) ssd_prep_load(rows, XBC, ufirst, ch8, tr);
    for (int u = ufirst; u < uend; u += ustride) {
        const int bc = u / 48, cblk = u % 48; const int t0 = bc * 128; const int ch0 = cblk * 128 + ch8 * 8;
        if (u + ustride < uend) ssd_prep_load(nrows, XBC, u + ustride, ch8, tr);
        float w[4][8], bb[8];
        { const f32x4 b0 = *(const f32x4*)(cb + ch0), b1 = *(const f32x4*)(cb + ch0 + 4);
#pragma unroll
          for (int e = 0; e < 4; ++e) { bb[e] = b0[e]; bb[4 + e] = b1[e]; }
#pragma unroll
          for (int k = 0; k < 4; ++k) { const f32x4 w0 = *(const f32x4*)(cw + (size_t)k * SSDCONV + ch0), w1 = *(const f32x4*)(cw + (size_t)k * SSDCONV + ch0 + 4);
#pragma unroll
              for (int e = 0; e < 4; ++e) { w[k][e] = w0[e]; w[k][4 + e] = w1[e]; } } }
        u32x4 ov[4];
#pragma unroll
        for (int i = 0; i < 4; ++i) { float o[8];
#pragma unroll
            for (int e = 0; e < 8; ++e) { float a = bb[e];
#pragma unroll
                for (int k = 0; k < 4; ++k) { const unsigned wd = rows[i + k][e >> 1]; a += w[k][e] * ((e & 1) ? bfhi(wd) : bflo(wd)); }
                o[e] = siluf(a); }
            u32x4 pk; pk.x = cvt_pk_bf16(o[0], o[1]); pk.y = cvt_pk_bf16(o[2], o[3]); pk.z = cvt_pk_bf16(o[4], o[5]); pk.w = cvt_pk_bf16(o[6], o[7]);
            if (cblk >= 32) *(u32x4*)(BCN + (size_t)(t0 + 4 * tr + i) * 2048 + (ch0 - 4096)) = pk;
            ov[i] = pk; }
        if (cblk < 40) {
#pragma unroll
            for (int e = 0; e < 8; ++e) { u32x2 w;
                const unsigned a0 = ov[0][e >> 1], a1 = ov[1][e >> 1], a2 = ov[2][e >> 1], a3 = ov[3][e >> 1];
                if (e & 1) { w.x = (a0 >> 16) | (a1 & 0xffff0000u); w.y = (a2 >> 16) | (a3 & 0xffff0000u); } else { w.x = (a0 & 0xffffu) | (a1 << 16); w.y = (a2 & 0xffffu) | (a3 << 16); }
                *(LAS u32x2*)(T + (ch8 * 8 + e) * LP + 8 * ((tr >> 1) ^ ch8) + 4 * (tr & 1)) = w; }
            LDS_SYNC();
#pragma unroll
            for (int i = 0; i < 4; ++i) { const int p = tid + NTHR * i, r = p >> 4, pc = p & 15;
                *(u32x4*)(XBT + ((size_t)bc * 5120 + cblk * 128 + r) * 128 + pc * 8) = *(const LAS u32x4*)(T + r * LP + 8 * (pc ^ (r >> 3))); }
            LDS_SYNC();
        }
#pragma unroll
        for (int i = 0; i < 7; ++i) rows[i] = nrows[i];
    }
    WG_SYNC();
}
__device__ __forceinline__ float ssd_tables(const float* DT, const float* a_log, int t0, int hd, int wid, int lane, LAS float* CUM, LAS float* DTS) {
    const float an = -__expf(a_log[hd]);
    const float d0 = DT[(size_t)(t0 + 2 * lane) * 64 + hd], d1 = DT[(size_t)(t0 + 2 * lane + 1) * 64 + hd];
    const float a0 = d0 * an, a1 = d1 * an; float v = a0 + a1;
#pragma unroll
    for (int o = 1; o < 64; o <<= 1) { const float t = __shfl_up(v, o); if (lane >= o) v += t; }
    CUM[wid * 128 + 2 * lane] = v - a1; CUM[wid * 128 + 2 * lane + 1] = v; DTS[wid * 128 + 2 * lane] = d0; DTS[wid * 128 + 2 * lane + 1] = d1;
    return __shfl(v, 63);
}
__device__ __forceinline__ void ssd1_units(const int tid, LAS unsigned char* lds, int G, int cu, const bf16* XBT, const float* DT, const float* a_log, bf16* ST, float* DEC) {
    const int wid = __builtin_amdgcn_readfirstlane(tid >> 6), lane = tid & 63, q = lane >> 4, c16 = lane & 15;
    LAS bf16* BT = (LAS bf16*)(lds);
    LAS float* CUM = (LAS float*)(lds + 34816);
    LAS float* DTS = (LAS float*)(lds + 38912);
    for (int u = cu; u < 1024; u += G) {
        const int bc = u >> 3, g = u & 7, t0 = bc * 128, hd = g * 8 + wid;
#pragma unroll
        for (int i = 0; i < 4; ++i) { const int p = tid + NTHR * i, r = p >> 4, pc = p & 15;
            *(LAS u32x4*)(BT + r * LP + pc * 8) = *(const u32x4*)(XBT + ((size_t)bc * 5120 + 4096 + g * 128 + r) * 128 + pc * 8); }
        const float last = ssd_tables(DT, a_log, t0, hd, wid, lane, CUM, DTS);
        if (lane == 0) DEC[bc * 64 + hd] = __expf(last);
        u32x4 xr[4][4];
#pragma unroll
        for (int pb = 0; pb < 4; ++pb)
#pragma unroll
            for (int ks = 0; ks < 4; ++ks) xr[pb][ks] = *(const u32x4*)(XBT + ((size_t)bc * 5120 + hd * 64 + 16 * pb + c16) * 128 + 32 * ks + 8 * q);
        WG_SYNC();
        bf16x8 xf[4][4];
#pragma unroll
        for (int ks = 0; ks < 4; ++ks) { float sc[8];
#pragma unroll
            for (int j = 0; j < 8; ++j) { const int s = 32 * ks + 8 * q + j; sc[j] = DTS[wid * 128 + s] * __expf(last - CUM[wid * 128 + s]); }
#pragma unroll
            for (int pb = 0; pb < 4; ++pb) { u32x4 o;
#pragma unroll
                for (int e = 0; e < 4; ++e) o[e] = cvt_pk_bf16(bflo(xr[pb][ks][e]) * sc[2 * e], bfhi(xr[pb][ks][e]) * sc[2 * e + 1]);
                xf[pb][ks] = __builtin_bit_cast(bf16x8, o); } }
#pragma unroll
        for (int nb = 0; nb < 8; ++nb) { bf16x8 bf[4];
#pragma unroll
            for (int ks = 0; ks < 4; ++ks) bf[ks] = lds_frag(BT, 16 * nb + c16, LP, 32 * ks + 8 * q);
#pragma unroll
            for (int pb = 0; pb < 4; ++pb) { f32x4 acc = (f32x4){0.f, 0.f, 0.f, 0.f};
#pragma unroll
                for (int ks = 0; ks < 4; ++ks) acc = MFMA16(bf[ks], xf[pb][ks], acc);
                *(u32x2*)(ST + (((size_t)bc * 64 + hd) * 64 + 16 * pb + c16) * 128 + 16 * nb + 4 * q) = pack4(acc); } }
        WG_SYNC();
    }
}
__device__ __forceinline__ void ssd2_scan(const int tid, int G, int cu, bf16* ST, const float* DEC) {
    for (int task = cu * NTHR + tid; task < NB * 4096 * 32; task += G * NTHR) {
        const int b = task >> 17, r = task & 131071, hp = r >> 5, n4 = (r & 31) * 4, hd = hp >> 6; f32x4 S = (f32x4){0.f, 0.f, 0.f, 0.f};
        bf16* p0 = ST + ((size_t)(b * 32) * 4096 + hp) * 128 + n4; const float* d0 = DEC + (b * 32) * 64 + hd;
        u32x2 L[32]; float d[32];
#pragma unroll
        for (int c = 0; c < 32; ++c) { L[c] = *(const u32x2*)(p0 + (size_t)c * 4096 * 128); d[c] = d0[c * 64]; }
#pragma unroll
        for (int c = 0; c < 32; ++c) { *(u32x2*)(p0 + (size_t)c * 4096 * 128) = pack4(S);
            S[0] = d[c] * S[0] + bflo(L[c].x); S[1] = d[c] * S[1] + bfhi(L[c].x); S[2] = d[c] * S[2] + bflo(L[c].y); S[3] = d[c] * S[3] + bfhi(L[c].y); }
    }
}
__device__ __forceinline__ void ssd3_units(const int tid, LAS unsigned char* lds, int G, int cu, const bf16* XBT, const bf16* BCN, const bf16* ST, const float* DT, const float* a_log, const float* dskip,
                                           const bf16* Z, const float* normw, bf16* Y) {
    const int wid = __builtin_amdgcn_readfirstlane(tid >> 6), lane = tid & 63, q = lane >> 4, c16 = lane & 15;
    LAS bf16* CN = (LAS bf16*)(lds);
    LAS bf16* BN = (LAS bf16*)(lds + 34816);
    LAS bf16* CB = (LAS bf16*)(lds + 69632);
    LAS float* CUM = (LAS float*)(lds + 104448);
    LAS float* DTS = (LAS float*)(lds + 108544);
    LAS float* SQP = (LAS float*)(lds + 112640);
    for (int u = cu; u < 1024; u += G) {
        const int bc = u >> 3, g = u & 7, t0 = bc * 128, hd = g * 8 + wid;
#pragma unroll
        for (int i = 0; i < 4; ++i) { const int p = tid + NTHR * i, r = p >> 4, pc = p & 15; const bf16* src = BCN + (size_t)(t0 + r) * 2048 + g * 128 + pc * 8;
            *(LAS u32x4*)(BN + r * LP + pc * 8) = *(const u32x4*)src; *(LAS u32x4*)(CN + r * LP + pc * 8) = *(const u32x4*)(src + 1024); }
        (void)ssd_tables(DT, a_log, t0, hd, wid, lane, CUM, DTS);
        bf16x8 sf[4][4];
        const bf16* xb = XBT + ((size_t)bc * 5120 + hd * 64 + c16) * 128 + 8 * q;
        { const bf16* sb = ST + (((size_t)bc * 64 + hd) * 64 + c16) * 128 + 8 * q;
#pragma unroll
          for (int pb = 0; pb < 4; ++pb)
#pragma unroll
              for (int ks = 0; ks < 4; ++ks) sf[pb][ks] = *(const bf16x8*)(sb + (size_t)(16 * pb) * 128 + 32 * ks); }
        WG_SYNC();
        {
            bf16x8 cf[4];
#pragma unroll
            for (int ks = 0; ks < 4; ++ks) cf[ks] = lds_frag(CN, 16 * wid + c16, LP, 32 * ks + 8 * q);
#pragma unroll
            for (int sb = 0; sb < 8; ++sb) { if (sb > wid + 1) continue; f32x4 acc = (f32x4){0.f, 0.f, 0.f, 0.f};
#pragma unroll
                for (int ks = 0; ks < 4; ++ks) acc = MFMA16(lds_frag(BN, 16 * sb + c16, LP, 32 * ks + 8 * q), cf[ks], acc);
                *(LAS u32x2*)(CB + (16 * wid + c16) * LP + 16 * sb + 4 * q) = pack4(acc); }
        }
        WG_SYNC();
        const float dsk = dskip[hd];
        bf16* ybase = Y + (size_t)t0 * SSDIN + hd * 64 + 4 * q; const bf16* zbase = Z + (size_t)t0 * SSDIN + hd * 64 + 4 * q;
        const f32x4 nw0 = *(const f32x4*)(normw + hd * 64 + 4 * q), nw1 = *(const f32x4*)(normw + hd * 64 + 16 + 4 * q), nw2 = *(const f32x4*)(normw + hd * 64 + 32 + 4 * q), nw3 = *(const f32x4*)(normw + hd * 64 + 48 + 4 * q);
#pragma unroll 1
        for (int tp = 0; tp < 8; ++tp) {
        u32x2 yk[1][4];
#pragma unroll
        for (int tt = 0; tt < 1; ++tt) { const int tb = tp;
            const int tl = 16 * tb + c16; const float cumt = CUM[wid * 128 + tl], ect = __expf(cumt);
            f32x4 acc[4];
            { bf16x8 cf[4];
#pragma unroll
              for (int ks = 0; ks < 4; ++ks) cf[ks] = lds_frag(CN, tl, LP, 32 * ks + 8 * q);
#pragma unroll
              for (int pb = 0; pb < 4; ++pb) { acc[pb] = (f32x4){0.f, 0.f, 0.f, 0.f};
#pragma unroll
                  for (int ks = 0; ks < 4; ++ks) acc[pb] = MFMA16(sf[pb][ks], cf[ks], acc[pb]);
                  acc[pb] = acc[pb] * ect; } }
#pragma unroll
            for (int ks = 0; ks < 4; ++ks) { if (32 * ks > 16 * tb + 15) continue;
                const int s0 = 32 * ks + 8 * q; const u32x4 cbw = *(const LAS u32x4*)(CB + tl * LP + s0);
                const f32x4 c0 = *(const LAS f32x4*)(CUM + wid * 128 + s0), c1 = *(const LAS f32x4*)(CUM + wid * 128 + s0 + 4), d0 = *(const LAS f32x4*)(DTS + wid * 128 + s0), d1 = *(const LAS f32x4*)(DTS + wid * 128 + s0 + 4);
                float gv[8];
#pragma unroll
                for (int j = 0; j < 8; ++j) { const int s = s0 + j; const float cb = (j & 1) ? bfhi(cbw[j >> 1]) : bflo(cbw[j >> 1]); const float cs = j < 4 ? c0[j & 3] : c1[j & 3], ds = j < 4 ? d0[j & 3] : d1[j & 3];
                    float v = cb * __expf(fminf(cumt - cs, 0.f)) * ds; v = (s <= tl) ? v : 0.f; gv[j] = (s == tl) ? v + dsk : v; }
                u32x4 gw; gw.x = cvt_pk_bf16(gv[0], gv[1]); gw.y = cvt_pk_bf16(gv[2], gv[3]); gw.z = cvt_pk_bf16(gv[4], gv[5]); gw.w = cvt_pk_bf16(gv[6], gv[7]);
                const bf16x8 gf = __builtin_bit_cast(bf16x8, gw);
#pragma unroll
                for (int pb = 0; pb < 4; ++pb) acc[pb] = MFMA16(*(const bf16x8*)(xb + (size_t)(16 * pb) * 128 + 32 * ks), gf, acc[pb]);
            }
            float sq = 0.f;
#pragma unroll
            for (int pb = 0; pb < 4; ++pb) { const u32x2 zw = *(const u32x2*)(zbase + (size_t)tl * SSDIN + 16 * pb);
                f32x4 y; y[0] = acc[pb][0] * bflo(zw.x); y[1] = acc[pb][1] * bfhi(zw.x); y[2] = acc[pb][2] * bflo(zw.y); y[3] = acc[pb][3] * bfhi(zw.y);
                sq += (y[0] * y[0] + y[1] * y[1]) + (y[2] * y[2] + y[3] * y[3]); yk[tt][pb] = pack4(y); }
            sq += __shfl_xor(sq, 16); sq += __shfl_xor(sq, 32);
            if (q == 0) SQP[tl * 8 + wid] = sq;
        }
        WG_SYNC();
#pragma unroll
        for (int tt = 0; tt < 1; ++tt) { const int tl = 16 * tp + c16; const f32x4 s0 = *(const LAS f32x4*)(SQP + tl * 8), s1 = *(const LAS f32x4*)(SQP + tl * 8 + 4);
            const float rstd = rsqrtf((((s0[0] + s0[1]) + (s0[2] + s0[3])) + ((s1[0] + s1[1]) + (s1[2] + s1[3]))) * (1.0f / 512.f) + EPS);
#pragma unroll
            for (int pb = 0; pb < 4; ++pb) { bf16* yp = ybase + (size_t)tl * SSDIN + 16 * pb; const u32x2 w = yk[tt][pb]; const f32x4 nw = pb == 0 ? nw0 : pb == 1 ? nw1 : pb == 2 ? nw2 : nw3;
                f32x4 y; y[0] = bflo(w.x) * rstd * nw[0]; y[1] = bfhi(w.x) * rstd * nw[1]; y[2] = bflo(w.y) * rstd * nw[2]; y[3] = bfhi(w.y) * rstd * nw[3];
                *(u32x2*)yp = pack4(y); } }
        }
        WG_SYNC();
    }
}
#ifndef REP_GEMM
#define REP_GEMM 1
#endif
#if REP_GEMM == 2
#define GEMM_REP(...) { __VA_ARGS__ } { __VA_ARGS__ }
#else
#define GEMM_REP(...) { __VA_ARGS__ }
#endif
#ifndef REP_MIX
#define REP_MIX 1
#endif
#ifndef REP_CONV
#define REP_CONV 1
#endif
struct Args { In in; float* out; unsigned char* ws; int ph_lo, ph_hi; };
static_assert(sizeof(Args) == 32 * 8 + 8 + 8 + 8, "Args has no padding");
typedef const Args __attribute__((address_space(4))) CArgs;

#ifndef SLEEP_MASK
#define SLEEP_MASK 0ull
#endif
#define SLEEP_AMP 4
#define PHASE_BEGIN if (pc >= lo && pc < hi) { const unsigned long long t0_ = SLEEP_MASK ? __builtin_amdgcn_s_memrealtime() : 0ull; (void)t0_; int tid = wave0 * 64 + (int)__builtin_amdgcn_mbcnt_hi(~0u, __builtin_amdgcn_mbcnt_lo(~0u, 0u)); asm volatile("" : "+v"(tid)); int cu = blockIdx.x; asm volatile("" : "+s"(cu)); int G = gridDim.x; asm volatile("" : "+s"(G)); \
        const int lane = tid & 63, wave = __builtin_amdgcn_readfirstlane(tid >> 6), gw = cu * NWAVES + wave, NGW = G * NWAVES; (void)lane; (void)gw; (void)NGW; \
        CArgs* ap = (CArgs*)__builtin_amdgcn_kernarg_segment_ptr(); asm volatile("" : "+s"(ap)); CIn& I = ap->in; unsigned char* const ws = ap->ws; float* const xres = ap->out; \
        unsigned char* const act = ws + WS_ACT; float* const SS = (float*)(ws + WS_SS); bf16* const XB = (bf16*)(ws + WS_XB); bf16* const WL = (bf16*)(ws + WS_WL); (void)I; (void)xres; (void)act; (void)SS; (void)XB; (void)WL;
#if MK_SPLIT
#define PHASE_END } ++pc;
#else
#define PHASE_END if (pc + 1 < hi) xcd_barrier(bar); if (SLEEP_MASK && ((SLEEP_MASK >> pc) & 1ull)) { const unsigned long long t1_ = __builtin_amdgcn_s_memrealtime(), until_ = t1_ + SLEEP_AMP * (t1_ - t0_); while (__builtin_amdgcn_s_memrealtime() < until_) __builtin_amdgcn_s_sleep(8); } } ++pc;
#endif
#define PHASE_END_LOCAL } ++pc;
#define D_WKV ((bf16*)(ws + WS_WKV))
#define D_KMAT ((bf16*)(ws + WS_KMAT))
#define D_VT ((bf16*)(ws + WS_VT))
#define D_MEMN ((bf16*)(ws + WS_MEMN))
#define D_LB ((float*)(ws + WS_TAB + TAB_LB))
#define D_WRT ((bf16*)(ws + WS_TAB + TAB_WRT))


template <int l>
__device__ __forceinline__ void layer_body(LAS unsigned char* lds, const int wave0, const int lo, const int hi, int& pc, const XcdBarrier& bar) {
    int ssi = 3 * l;

        if (l > 0) {
            PHASE_BEGIN
                int rot = 0; for (int rep_ = 0; rep_ < REP_CONV; ++rep_) { convert_layer(I, l, WL, (LAS float*)(lds + wave * 16640), gw, NGW, lane, rot); }
            PHASE_END
        }
        const int e = l >> 1;
        int mixK;
        if ((l & 1) == 0) {
#define PROJ ((bf16*)(act + A_PROJ))
#define LOGF ((float*)(act + A_LOGF))
#define HST ((bf16*)(act + A_HST))
#define YAB ((bf16*)(act + A_YAB))
#define SEG ((float*)(act + A_SEG))
#define HDEC ((float*)(act + A_HDEC))
            PHASE_BEGIN
                if (l == 0) { pg8::SchedKV S{(const char*)D_MEMN, (const char*)D_WKV, G, cu}; pg8::EpiKV E{D_KMAT, D_VT}; pg8::gemm_phase(tid, lds, D, D, D, S, E); asm volatile("" : "+v"(tid)); }
                GEMM_REP(pg8::SchedMN S; S.init(XB, D, WL + WL_IN, D, M, ABIN, G, cu); pg8::EpiProjEven E{SS + (size_t)ssi * M * 8, PROJ, LOGF, D_LB + e * 1024};
                pg8::gemm_phase<RF16>(tid, lds, D, D, D, S, E);)
            PHASE_END
            PHASE_BEGIN
                for (int rep_ = 0; rep_ < REP_MIX; ++rep_) { lru_units<false>(tid, lds, G, cu, PROJ, D_WRT + (size_t)e * 2 * 8 * 16384, I.lru_conv_w + e * 4 * LRUW, I.lru_conv_b + e * LRUW, I.lru_b_r + e * LRUW, I.lru_b_i + e * LRUW, I.lru_lambda + e * LRUW, SEG, YAB);
                hgrn1_units(tid, lds, G, cu, LOGF, PROJ, HST, HDEC); }
            PHASE_END
            PHASE_BEGIN
                for (int rep_ = 0; rep_ < REP_MIX; ++rep_) { lru_units<true>(tid, lds, G, cu, PROJ, D_WRT + (size_t)e * 2 * 8 * 16384, I.lru_conv_w + e * 4 * LRUW, I.lru_conv_b + e * LRUW, I.lru_b_r + e * LRUW, I.lru_b_i + e * LRUW, I.lru_lambda + e * LRUW, SEG, YAB); }
                hgrn2_scan(tid, G, cu, HST, HDEC);
            PHASE_END
            PHASE_BEGIN
                for (int rep_ = 0; rep_ < REP_MIX; ++rep_) { hgrn3_units(tid, lds, G, cu, LOGF, PROJ, HST, I.hgrn_norm + e * 1024, YAB); }
            PHASE_END
            mixK = D;
        } else {
#define Zb ((bf16*)(act + A_Z))
#define XBC ((bf16*)(act + A_XBC))
#define XBT ((bf16*)(act + A_XBT))
#define BCN ((bf16*)(act + A_BCN))
#define STb ((bf16*)(act + A_ST))
#define DTb ((float*)(act + A_DT))
#define DEC ((float*)(act + A_DEC))
#define Yb ((bf16*)(act + A_Y))
            PHASE_BEGIN
                GEMM_REP(pg8::SchedMN S; S.init(XB, D, WL + WL_IN, D, M, SSDN1, G, cu); pg8::EpiProjOdd E{SS + (size_t)ssi * M * 8, Zb, XBC};
                pg8::gemm_phase<RF16>(tid, lds, D, D, D, S, E);)
            PHASE_END
            PHASE_BEGIN
                for (int rep_ = 0; rep_ < REP_MIX; ++rep_) {
                { pg8::SchedDt S{(const char*)XB, (const char*)(WL + WL_DT), cu}; pg8::EpiDt E{SS + (size_t)ssi * M * 8, I.ssd_dt_bias + e * 64, DTb};
                  pg8::gemm_phase<RF16>(tid, lds, D, D, D, S, E); }
                { int uf = cu, us = G, ue = 6144; if (G == 256) { if (cu < 64) { us = 64; ue = 1152; } else { uf = 1152 + (cu - 64); us = 192; } }
                  ssd_prep_units(tid, lds, uf, us, ue, XBC, I.ssd_conv_w + (size_t)e * 4 * SSDCONV, I.ssd_conv_b + e * SSDCONV, XBT, BCN); }
                }
            PHASE_END
            PHASE_BEGIN
                for (int rep_ = 0; rep_ < REP_MIX; ++rep_) { ssd1_units(tid, lds, G, cu, XBT, DTb, I.ssd_a_log + e * 64, STb, DEC); }
            PHASE_END
            PHASE_BEGIN
                ssd2_scan(tid, G, cu, STb, DEC);
            PHASE_END
            PHASE_BEGIN
                for (int rep_ = 0; rep_ < REP_MIX; ++rep_) { ssd3_units(tid, lds, G, cu, XBT, BCN, STb, DTb, I.ssd_a_log + e * 64, I.ssd_d + e * 64, Zb, I.ssd_norm + e * SSDIN, Yb); }
            PHASE_END
            mixK = SSDIN;
        }
        PHASE_BEGIN
            pg8::SchedMN S; S.init(mixK == D ? (const bf16*)YAB : (const bf16*)Yb, mixK, WL + WL_OUT, mixK, M, D, G, cu); pg8::EpiResid E{XB, SS + (size_t)(ssi + 1) * M * 8, (LAS float*)(lds + EPI_OFF)};
            pg8::gemm_phase(tid, lds, mixK, mixK, mixK, S, E);
        PHASE_END
        ++ssi;
#define Qb ((bf16*)(act + A_Q))
#define Pb ((bf16*)(act + A_P))
#define Ob ((bf16*)(act + A_O))
#define Hb ((bf16*)(act + A_H))
        PHASE_BEGIN
            if (cu < 256) { const int pm = (cu & 7) * 8 + (cu >> 5), h = (cu >> 3) & 3;     int nu = 2; asm volatile("" : "+s"(nu));
                pg8::SchedChainQ S{(const char*)XB, (const char*)(WL + WL_Q), pm, h, nu}; pg8::EpiQ E{SS + (size_t)ssi * M * 8, Qb, 0.044194173824159216f}; pg8::gemm_phase<RF16>(tid, lds, D, D, D, S, E); }
        PHASE_END_LOCAL
        PHASE_BEGIN
            if (cu < 256) { const int pm = (cu & 7) * 8 + (cu >> 5), h = (cu >> 3) & 3;     int nu = 1, kk = XAD; asm volatile("" : "+s"(nu), "+s"(kk));
                pg8::SchedChainS S{(const char*)Qb, (const char*)(D_KMAT + (size_t)l * MEMROWS * D), pm, h, nu}; pg8::EpiSoftmax E{Pb, (LAS float*)(lds + EPI_OFF)}; pg8::gemm_phase(tid, lds, kk, D, D, S, E); }
        PHASE_END_LOCAL
        PHASE_BEGIN
            if (cu < 256) { const int pm = (cu & 7) * 8 + (cu >> 5), h = (cu >> 3) & 3;     int nu = 2, kk = MEMLEN; asm volatile("" : "+s"(nu), "+s"(kk));
                pg8::SchedChainPV S{(const char*)Pb, (const char*)(D_VT + (size_t)l * D * MEMROWS), pm, h, nu}; pg8::EpiPlain E{Ob, D}; pg8::gemm_phase(tid, lds, kk, 1024, MEMROWS, S, E); }
        PHASE_END
        PHASE_BEGIN
            pg8::SchedMN S; S.init(Ob, D, WL + WL_O, D, M, D, G, cu); pg8::EpiResid E{XB, SS + (size_t)(ssi + 1) * M * 8, (LAS float*)(lds + EPI_OFF)};
            pg8::gemm_phase(tid, lds, D, D, D, S, E);
        PHASE_END
        ++ssi;
        PHASE_BEGIN
            GEMM_REP(pg8::SchedMN S; S.init(XB, D, WL + WL_GU, D, M, 2 * FF, G, cu); pg8::EpiGateUp E{SS + (size_t)ssi * M * 8, Hb};
            pg8::gemm_phase<RF16>(tid, lds, D, D, D, S, E);)
        PHASE_END
        PHASE_BEGIN
            pg8::SchedMN S; S.init(Hb, FF, WL + WL_DN, FF, M, D, G, cu); pg8::EpiResid E{XB, SS + (size_t)(ssi + 1) * M * 8, (LAS float*)(lds + EPI_OFF)};
            pg8::gemm_phase(tid, lds, FF, FF, FF, S, E);
        PHASE_END
        ++ssi;
    }

__global__ void __launch_bounds__(NTHR, 2) fwd(Args args) {
    extern __shared__ __attribute__((aligned(16))) unsigned char lds_raw[];
    LAS unsigned char* lds = (LAS unsigned char*)lds_raw;
    volatile LAS unsigned* MISC = (volatile LAS unsigned*)(lds + MISC_OFF);
    const int wave0 = __builtin_amdgcn_readfirstlane((int)threadIdx.x >> 6);
    if (threadIdx.x < 64) MISC[threadIdx.x] = 0u;
    __syncthreads();
#if !MK_SPLIT
    XcdBarrier bar = xcd_barrier_post((unsigned*)(args.ws + WS_CTL), MISC + 8);
#else
    XcdBarrier bar; bar.bar = nullptr; bar.x = 0; bar.st = nullptr;
#endif
    const int lo = args.ph_lo, hi = args.ph_hi; int pc = 0;
    PHASE_BEGIN
        LAS float* scr = (LAS float*)(lds + wave * 16640);
        int rot = 0;
        for (int l = 0; l < DEPTH; ++l) conv_matrix<0>(I.xa_w_kv + (size_t)l * D * 4096, 4096, D, 0, 4096, nullptr, D_WKV + (size_t)l * 4096 * D, 0, scr, gw, NGW, lane, rot);
        for (int rep_ = 0; rep_ < REP_CONV; ++rep_) convert_layer(I, 0, WL, scr, gw, NGW, lane, rot);
        for (int m = gw; m < MEMROWS; m += NGW) {
            const f32x4* xr = (const f32x4*)(I.mem + (size_t)m * D); f32x4 v[8]; float s = 0.f;
#pragma unroll
            for (int j = 0; j < 8; ++j) { v[j] = xr[64 * j + lane]; s += (v[j][0] * v[j][0] + v[j][1] * v[j][1]) + (v[j][2] * v[j][2] + v[j][3] * v[j][3]); }
            const float rs = rsqrtf(wave_sum(s) * (1.0f / D) + EPS);
#pragma unroll
            for (int j = 0; j < 8; ++j) { const f32x4 g = *(const f32x4*)(I.norm_mem + (64 * j + lane) * 4); *(u32x2*)(D_MEMN + (size_t)m * D + (64 * j + lane) * 4) = pack4(v[j] * rs * g); }
        }
        for (int m = gw; m < M; m += NGW) {
            const f32x4* xr = (const f32x4*)(I.x + (size_t)m * D); float s = 0.f;
#pragma unroll
            for (int j = 0; j < 8; ++j) { const f32x4 v = xr[64 * j + lane]; s += (v[0] * v[0] + v[1] * v[1]) + (v[2] * v[2] + v[3] * v[3]); u32x2 w; w.x = rs_pk(v[0], v[1]); w.y = rs_pk(v[2], v[3]); *(u32x2*)(XB + (size_t)m * D + (64 * j + lane) * 4) = w; }
            s = wave_sum(s); if (lane < 8) SS[(size_t)m * 8 + lane] = lane == 0 ? s : 0.f;
        }
        for (int i = cu * NTHR + tid; i < 1024; i += G * NTHR) {
            const float a = I.hgrn_lb[i], b = I.hgrn_lb[1024 + i], mx = fmaxf(a, b), e0 = __expf(a - mx), e1 = __expf(b - mx); D_LB[i] = 0.f; D_LB[1024 + i] = e1 / (e0 + e1); }
        for (int i = cu * NTHR + tid; i < 2 * 2 * 8 * 16384; i += G * NTHR) {
            const int ii = i & 127, jj = (i >> 7) & 127, blk = (i >> 14) & 7, gt = (i >> 17) & 1, e = i >> 18;
            const float* src = gt ? I.lru_w_i : I.lru_w_r; D_WRT[i] = (bf16)f2bf(src[((size_t)(e * 8 + blk) * 128 + ii) * 128 + jj]); }
    PHASE_END

    layer_body<0>(lds, wave0, lo, hi, pc, bar); layer_body<1>(lds, wave0, lo, hi, pc, bar); layer_body<2>(lds, wave0, lo, hi, pc, bar); layer_body<3>(lds, wave0, lo, hi, pc, bar);
    const int ssi = 12;
    PHASE_BEGIN
        const float* ssf = SS + (size_t)ssi * M * 8;
        for (int m = gw; m < M; m += NGW) { f32x4* row = (f32x4*)(xres + (size_t)m * D); const u32x2* xr = (const u32x2*)(XB + (size_t)m * D); const float rs = pg8::rstd_of(ssf, m);
#pragma unroll
            for (int j = 0; j < 8; ++j) { const f32x4 g = *(const f32x4*)(I.norm_final + (64 * j + lane) * 4); const u32x2 w = xr[64 * j + lane];
                f32x4 o; o[0] = rs_lo(w.x) * rs * g[0]; o[1] = rs_hi(w.x) * rs * g[1]; o[2] = rs_lo(w.y) * rs * g[2]; o[3] = rs_hi(w.y) * rs * g[3]; row[64 * j + lane] = o; } }
    PHASE_END
#undef PHASE_BEGIN
#undef PHASE_END
}

constexpr int NPHASES = 1 + (5 + 6) + (1 + 6 + 6) + (1 + 5 + 6) + (1 + 6 + 6) + 1;

extern "C" void kernel_launch(void* const* d_in, const int* in_sizes, int n_in, void* d_out, int out_size, void* d_ws, size_t ws_size, hipStream_t stream) {
    static int grid = 0;
    if (grid == 0) {
        if (n_in != 32 || out_size != M * D || ws_size < WS_END) { fprintf(stderr, "kernel_launch: unexpected problem (n_in %d, out %d, ws %zu)\n", n_in, out_size, ws_size); grid = -1; return; }
        int dev = 0, cus = 0;
        if (hipGetDevice(&dev) != hipSuccess || hipDeviceGetAttribute(&cus, hipDeviceAttributeMultiprocessorCount, dev) != hipSuccess) { grid = -1; return; }
        if (hipFuncSetAttribute((const void*)fwd, hipFuncAttributeMaxDynamicSharedMemorySize, LDS_BYTES) != hipSuccess) { fprintf(stderr, "kernel_launch: hipFuncSetAttribute failed\n"); grid = -1; return; }
        int per_cu = 0;
        if (hipOccupancyMaxActiveBlocksPerMultiprocessor(&per_cu, (const void*)fwd, NTHR, LDS_BYTES) != hipSuccess || per_cu < 1) fprintf(stderr, "kernel_launch: occupancy query says %d\n", per_cu);
        (void)hipGetLastError();
        if (cus != 256) { fprintf(stderr, "kernel_launch: built for a 256-CU device (got %d)\n", cus); grid = -1; return; }
        grid = cus;
    }
    if (grid < 0) return;
    (void)hipMemsetAsync((char*)d_ws + WS_CTL, 0, CTL_ZERO_BYTES, stream);
    Args a{};
    const float** ip = (const float**)&a.in;
    for (int i = 0; i < 32; ++i) ip[i] = (const float*)d_in[i];
    a.out = (float*)d_out; a.ws = (unsigned char*)d_ws;
#if MK_SPLIT
#ifndef PROBE_MASK
#define PROBE_MASK 0ull
#endif
    for (int li = 0; li < NPHASES; ++li) { a.ph_lo = li; a.ph_hi = li + 1; hipLaunchKernelGGL(fwd, dim3(grid), dim3(NTHR), LDS_BYTES, stream, a);
        if ((PROBE_MASK >> li) & 1ull) hipLaunchKernelGGL(fwd, dim3(grid), dim3(NTHR), LDS_BYTES, stream, a); }
#else
    a.ph_lo = 0; a.ph_hi = NPHASES;
    hipLaunchKernelGGL(fwd, dim3(grid), dim3(NTHR), LDS_BYTES, stream, a);
#endif
}
```

```cpp
#include <hip/hip_runtime.h>
#include <cstdio>
#include <cstdint>

#ifndef MK_SPLIT
#define MK_SPLIT 0
#endif

#ifndef RESID_F16
#define RESID_F16 0
#endif
constexpr bool RF16 = RESID_F16 != 0;
#define GAS __attribute__((address_space(1)))
#define LAS __attribute__((address_space(3)))
typedef unsigned short bf16;
typedef short bf16x8 __attribute__((ext_vector_type(8)));
typedef float f32x4 __attribute__((ext_vector_type(4)));
typedef float f32x2 __attribute__((ext_vector_type(2)));
typedef unsigned u32x4 __attribute__((ext_vector_type(4)));
typedef unsigned u32x2 __attribute__((ext_vector_type(2)));

constexpr int D = 2048, NB = 4, SEQ = 4096, M = NB * SEQ, DEPTH = 4, MEMLEN = 256, MEMROWS = NB * MEMLEN;
constexpr int LRUW = 1024, ABIN = 6144;
constexpr int SSDIN = 4096, SSDCONV = 6144, SSDPROJ = 10304, SSDN1 = 10240, NHEADS = 64;
constexpr int XAD = 512, FF = 5632;
constexpr float EPS = 1e-6f;
constexpr int NWAVES = 8, NTHR = 512;

constexpr size_t MiB = 1u << 20;
constexpr size_t WS_CTL = 0, CTL_ZERO_BYTES = 1 * MiB;
constexpr size_t WS_WKV = 2 * MiB;
constexpr size_t WS_KMAT = 66 * MiB;
constexpr size_t WS_VT = 82 * MiB;
constexpr size_t WS_MEMN = 98 * MiB;
constexpr size_t WS_TAB = 102 * MiB;
constexpr size_t WS_XB = 106 * MiB;
constexpr size_t WS_WL = 170 * MiB;
constexpr size_t WS_ACT = 310 * MiB;
constexpr size_t WS_SS = (310 + 680) * MiB;
constexpr size_t WS_END = (310 + 680 + 8) * MiB;
constexpr size_t TAB_LB = 0;
constexpr size_t TAB_WRT = 64 * 1024;
constexpr size_t WL_IN = 0;
constexpr size_t WL_DT = (size_t)SSDN1 * D;
constexpr size_t WL_OUT = (size_t)(SSDN1 + 256) * D;
constexpr size_t WL_Q = WL_OUT + (size_t)D * SSDIN;
constexpr size_t WL_O = WL_Q + (size_t)D * D;
constexpr size_t WL_GU = WL_O + (size_t)D * D;
constexpr size_t WL_DN = WL_GU + (size_t)2 * FF * D;
constexpr size_t WL_ELEMS = WL_DN + (size_t)D * FF;
static_assert(WL_ELEMS * 2 <= 140 * MiB, "per-layer weights");
constexpr size_t A_Z = 0;
constexpr size_t A_XBC = 128 * MiB;
constexpr size_t A_Y = 128 * MiB;
constexpr size_t A_XBT = 320 * MiB;
constexpr size_t A_BCN = 480 * MiB;
constexpr size_t A_ST = 544 * MiB;
constexpr size_t A_DT = 672 * MiB;
constexpr size_t A_DEC = 676 * MiB;
constexpr size_t A_PROJ = 0;
constexpr size_t A_LOGF = 192 * MiB;
constexpr size_t A_HST = 256 * MiB;
constexpr size_t A_YAB = 320 * MiB;
constexpr size_t A_SEG = 384 * MiB;
constexpr size_t A_HDEC = 386 * MiB;
constexpr size_t A_Q = 0;
constexpr size_t A_P = 64 * MiB;
constexpr size_t A_O = 96 * MiB;
constexpr size_t A_H = 160 * MiB;

constexpr int LDS_BYTES = 155648;
constexpr int EPI_OFF = 131072;
constexpr int MISC_OFF = LDS_BYTES - 256;

#define LDS_WAIT() asm volatile("s_waitcnt lgkmcnt(0)" ::: "memory")
#define VM_WAIT() asm volatile("s_waitcnt vmcnt(0)" ::: "memory")
__device__ __forceinline__ unsigned f2bf(float f) { unsigned u = __builtin_bit_cast(unsigned, f); return (u + 0x7fffu + ((u >> 16) & 1u)) >> 16; }
__device__ __forceinline__ unsigned pk2(float lo, float hi) { return f2bf(lo) | (f2bf(hi) << 16); }
typedef __bf16 bf16x2v __attribute__((ext_vector_type(2)));
__device__ __forceinline__ unsigned cvt_pk_bf16(float lo, float hi) { const f32x2 v = {lo, hi}; return __builtin_bit_cast(unsigned, __builtin_convertvector(v, bf16x2v)); }
typedef _Float16 f16x2v __attribute__((ext_vector_type(2)));
typedef _Float16 f16x8 __attribute__((ext_vector_type(8)));
__device__ __forceinline__ unsigned cvt_pk_f16(float lo, float hi) { const f32x2 v = {lo, hi}; return __builtin_bit_cast(unsigned, __builtin_convertvector(v, f16x2v)); }
__device__ __forceinline__ float h16lo(unsigned w) { return (float)__builtin_bit_cast(f16x2v, w)[0]; }
__device__ __forceinline__ float h16hi(unsigned w) { return (float)__builtin_bit_cast(f16x2v, w)[1]; }
__device__ __forceinline__ float bflo(unsigned w) { return __uint_as_float(w << 16); }
__device__ __forceinline__ float bfhi(unsigned w) { return __uint_as_float(w & 0xffff0000u); }
__device__ __forceinline__ unsigned rs_pk(float lo, float hi) { return RF16 ? cvt_pk_f16(lo, hi) : cvt_pk_bf16(lo, hi); }
__device__ __forceinline__ float rs_lo(unsigned w) { return RF16 ? h16lo(w) : bflo(w); }
__device__ __forceinline__ float rs_hi(unsigned w) { return RF16 ? h16hi(w) : bfhi(w); }
__device__ __forceinline__ float bf2f(bf16 b) { return __uint_as_float((unsigned)b << 16); }
__device__ __forceinline__ float sigm(float x) { return __builtin_amdgcn_rcpf(1.f + __expf(-x)); }
__device__ __forceinline__ float siluf(float x) { return x * sigm(x); }
__device__ __forceinline__ float gelu_tanh(float x) { return x * sigm(1.5957691216f * (x + 0.044715f * x * x * x)); }
__device__ __forceinline__ float softplusf(float x) { const float e = __expf(-fabsf(x)); const float l = (e < 0.03f) ? e * (1.f - e * (0.5f - e * 0.33333333f)) : __logf(1.f + e); return fmaxf(x, 0.f) + l; }
__device__ __forceinline__ float wave_sum(float v) {
#pragma unroll
    for (int o = 1; o < 64; o <<= 1) v += __shfl_xor(v, o);
    return v;
}

#define XB_TMO      128
#define XB_XCNT(j)  (256  + 64 * (j))
#define XB_XSUB(j)  (1280 + 64 * (j))
#define XB_XGEN(j)  (2304 + 64 * (j))
#define XB_TOP      3328
#define XB_TOPGEN   3392
#define XCD_BAR_WORDS 3456
#define XB_SPIN_CAP (1u << 18)

__device__ __forceinline__ unsigned xb_ld(unsigned* p)              { return __hip_atomic_load(p, __ATOMIC_RELAXED, __HIP_MEMORY_SCOPE_AGENT); }
__device__ __forceinline__ unsigned xb_add(unsigned* p, unsigned v) { return __hip_atomic_fetch_add(p, v, __ATOMIC_RELAXED, __HIP_MEMORY_SCOPE_AGENT); }
__device__ __forceinline__ unsigned xb_xcc_id() { return (unsigned)__builtin_amdgcn_s_getreg((3 << 11) | 20) & 0xFu; }
#define XB_SPIN(cond, bar) do { unsigned _sp = 0; while (cond) { __builtin_amdgcn_s_sleep(1); \
    if ((++_sp & 255u) == 0u) { if (xb_ld(&(bar)[XB_TMO])) break; if (_sp > XB_SPIN_CAP) { atomicAdd(&(bar)[XB_TMO], 1u); break; } } } } while (0)

struct XcdBarrier {
    unsigned* bar; unsigned x;
    volatile LAS unsigned* st;
};
__device__ __forceinline__ XcdBarrier xcd_barrier_post(unsigned* bar, volatile LAS unsigned* st) {
    XcdBarrier b; b.bar = bar; b.x = xb_xcc_id(); b.st = st;
    if (threadIdx.x == 0) (void)xb_add(&bar[XB_XCNT(b.x)], 1u);
    return b;
}
__device__ __forceinline__ void xcd_barrier_complete(unsigned* bar, unsigned x, unsigned& nloc, unsigned& nx) {
    const unsigned G = gridDim.x * gridDim.y * gridDim.z;
    unsigned sum, cnt, mine, sp = 0u;
    for (;;) {
        sum = 0u; cnt = 0u; mine = 0u;
#pragma unroll
        for (unsigned j = 0; j < 16; ++j) { const unsigned c = xb_ld(&bar[XB_XCNT(j)]); sum += c; cnt += (c > 0u) ? 1u : 0u; mine = (j == x) ? c : mine; }
        if (sum == G) break;
        __builtin_amdgcn_s_sleep(1);
        if ((++sp & 255u) == 0u) { if (xb_ld(&bar[XB_TMO])) break; if (sp > XB_SPIN_CAP) { atomicAdd(&bar[XB_TMO], 1u); break; } }
    }
    nloc = mine > 0u ? mine : 1u; nx = cnt > 0u ? cnt : 1u;
}
__device__ __forceinline__ void xcd_barrier(const XcdBarrier& b) {
    asm volatile("s_waitcnt vmcnt(0)" ::: "memory");
    __syncthreads();
    if (threadIdx.x == 0) {
        unsigned* bar = b.bar;
        __builtin_amdgcn_s_waitcnt(0);
        unsigned nloc = b.st[0], nx = b.st[1];
        if (nloc == 0u) { xcd_barrier_complete(bar, b.x, nloc, nx); b.st[0] = nloc; b.st[1] = nx; }
        const unsigned old = xb_add(&bar[XB_XSUB(b.x)], 1u);
        const unsigned gen = old / nloc;
        if (old + 1u == (gen + 1u) * nloc) {
            __builtin_amdgcn_fence(__ATOMIC_RELEASE, "agent");
            asm volatile("s_waitcnt vmcnt(0)" ::: "memory");
            const unsigned og = xb_add(&bar[XB_TOP], 1u);
            const unsigned tg = og / nx;
            if (og + 1u == (tg + 1u) * nx) xb_add(&bar[XB_TOPGEN], 1u);
            else XB_SPIN(xb_ld(&bar[XB_TOPGEN]) == tg, bar);
            __builtin_amdgcn_fence(__ATOMIC_ACQUIRE, "agent");
            xb_add(&bar[XB_XGEN(b.x)], 1u);
            asm volatile("s_waitcnt vmcnt(0)" ::: "memory");
        } else {
            XB_SPIN(xb_ld(&bar[XB_XGEN(b.x)]) == gen, bar);
            __builtin_amdgcn_fence(__ATOMIC_ACQUIRE, "agent");
            asm volatile("s_waitcnt vmcnt(0)" ::: "memory");
        }
    }
    __syncthreads();
}

namespace pg8 {
constexpr int BM = 256, BK = 64, HALF = 128, HTB = HALF * BK * 2, STAGE_BYTES = 8 * HTB, NXCD = 8, WGM = 8;
__host__ __device__ __forceinline__ int lds_byte(int r, int c) { const int st = (r >> 4) * 2 + (c >> 5), rr = r & 15, cc = c & 31, ob = rr * 64 + cc * 2; return st * 1024 + (ob ^ (((ob >> 9) & 1) << 5)); }
__host__ __device__ __forceinline__ void stage_rc(int b, int& R, int& C) { const int st = b / 1024, sb = b % 1024, swz = sb ^ (((sb >> 9) & 1) << 5); R = (st >> 1) * 16 + swz / 64; C = (st & 1) * 32 + (swz % 64) / 2; }
__host__ __device__ __forceinline__ int perm32(int rho) { const int n = rho >> 4, i = rho & 15; return 8 * (i >> 2) + 4 * n + (i & 3); }

struct Unit { const char* a; const char* b; int orow, ocol, aux; };

__device__ __forceinline__ void glds16_s(const char* base, unsigned voff, unsigned ldsdst) { unsigned keep;
    asm volatile("s_mov_b32 %0, m0\n\ts_mov_b32 m0, %3\n\ts_nop 0\n\tglobal_load_lds_dwordx4 %1, %2\n\ts_mov_b32 m0, %0" : "=&s"(keep) : "v"(voff), "s"(base), "s"(ldsdst) : "memory"); }
template <bool F16 = false, bool ALIGN = true, class Epi, class Sched>
__device__ __forceinline__ void gemm_phase(const int tid, LAS unsigned char* lds, const int K, const int lda, const int ldb, const Sched& S, const Epi& E) {
    const int wid = __builtin_amdgcn_readfirstlane(tid >> 6), lane = tid & 63, wr = wid >> 2, wc = wid & 3, fr = lane & 15, fq = lane >> 4;
    const int nt = K / BK;
    unsigned voffA[2], voffB[2];
#pragma unroll
    for (int i = 0; i < 2; ++i) { int R, C; stage_rc(tid * 16 + i * 8192, R, C); const int Rb = (R & ~31) + perm32(R & 31);
        voffA[i] = (unsigned)(R * lda + C) * 2u; voffB[i] = (unsigned)(Rb * ldb + C) * 2u; }
    const size_t kstep = (size_t)(BK * 2);
    const size_t hstepA = (size_t)HALF * lda * 2, hstepB = (size_t)HALF * ldb * 2;
    const unsigned ldsw = (unsigned)wid * 1024u;
    const unsigned ldsb = (unsigned)(__UINTPTR_TYPE__)lds + ldsw;
    const int aoff = lds_byte(wr * 64 + fr, fq * 8), boff = lds_byte(wc * 32 + fr, fq * 8);
#define PG8_SA(b, h) (((b) * 2 + (h)) * HTB)
#define PG8_SB(b, h) ((4 + (b) * 2 + (h)) * HTB)
#define PG8_STAGE(bufoff, gbase, voff) do { _Pragma("unroll") for (int _i = 0; _i < 2; ++_i) \
        glds16_s((const char*)(gbase), (voff)[_i], ldsb + (unsigned)((bufoff) + _i * 8192)); } while (0)
#define PG8_LDA(dst, b, h) do { _Pragma("unroll") for (int m = 0; m < 4; ++m) _Pragma("unroll") for (int k = 0; k < 2; ++k) dst[m][k] = *(const LAS bf16x8*)(lds + PG8_SA(b, h) + aoff + m * 2048 + k * 1024); } while (0)
#define PG8_LDB(dst, b, h) do { _Pragma("unroll") for (int n = 0; n < 2; ++n) _Pragma("unroll") for (int k = 0; k < 2; ++k) dst[n][k] = *(const LAS bf16x8*)(lds + PG8_SB(b, h) + boff + n * 2048 + k * 1024); } while (0)
#define PG8_MMA(ai, bj, At, Bt) do { __builtin_amdgcn_s_setprio(1); _Pragma("unroll") for (int m = 0; m < 4; ++m) _Pragma("unroll") for (int n = 0; n < 2; ++n) _Pragma("unroll") for (int k = 0; k < 2; ++k) \
        acc[ai][bj][m][n] = F16 ? __builtin_amdgcn_mfma_f32_16x16x32_f16(__builtin_bit_cast(f16x8, Bt[n][k]), __builtin_bit_cast(f16x8, At[m][k]), acc[ai][bj][m][n], 0, 0, 0) \
                                : __builtin_amdgcn_mfma_f32_16x16x32_bf16(Bt[n][k], At[m][k], acc[ai][bj][m][n], 0, 0, 0); __builtin_amdgcn_s_setprio(0); } while (0)
#define PG8_WAIT_V(n) asm volatile("s_waitcnt vmcnt(" #n ")" ::: "memory")
#define PG8_WAIT_L(n) asm volatile("s_waitcnt lgkmcnt(" #n ")" ::: "memory")
#define PG8_BAR __builtin_amdgcn_s_barrier()
#define PG8_SCHED __builtin_amdgcn_sched_barrier(0)
    Unit cur, nxt; int ui = 0;
    if (!S.next(0, cur)) return;
    f32x4 acc[2][2][4][2];
#pragma unroll
    for (int a = 0; a < 2; ++a)
#pragma unroll
        for (int b = 0; b < 2; ++b)
#pragma unroll
            for (int m = 0; m < 4; ++m)
#pragma unroll
                for (int n = 0; n < 2; ++n) acc[a][b][m][n] = (f32x4){0.f, 0.f, 0.f, 0.f};
    bf16x8 At[4][2], B0[2][2], B1[2][2];
    const char* cA = cur.a; const char* cB = cur.b;
    PG8_STAGE(PG8_SB(0, 0), cB, voffB); PG8_STAGE(PG8_SB(0, 1), cB + hstepB, voffB); PG8_STAGE(PG8_SA(0, 0), cA, voffA); PG8_STAGE(PG8_SA(0, 1), cA + hstepA, voffA);
    if (wr == 1) PG8_BAR;
    PG8_WAIT_V(2); PG8_BAR;
    PG8_STAGE(PG8_SB(1, 0), cB + kstep, voffB); PG8_STAGE(PG8_SA(1, 0), cA + kstep, voffA); PG8_STAGE(PG8_SB(1, 1), cB + hstepB + kstep, voffB);
    PG8_WAIT_V(6); PG8_BAR;
    for (;;) {
        const bool has_next = S.next(ui + 1, nxt);
        const char* nA = has_next ? nxt.a : cA; const char* nB = has_next ? nxt.b : cB;
        for (int t = 0; t < nt; t += 2) {
            const bool last = (t == nt - 2);
            const char* a1 = cA + (size_t)(t + 1) * kstep;
            const char* a2 = last ? nA : cA + (size_t)(t + 2) * kstep; const char* b2 = last ? nB : cB + (size_t)(t + 2) * kstep;
            const char* a3 = a2 + kstep; const char* b3 = b2 + kstep;
            PG8_LDB(B0, 0, 0); PG8_LDB(B1, 0, 1); PG8_SCHED; PG8_LDA(At, 0, 0); PG8_STAGE(PG8_SA(1, 1), a1 + hstepA, voffA);
            PG8_WAIT_V(8); PG8_WAIT_L(0); PG8_BAR; PG8_MMA(0, 0, At, B0); PG8_MMA(0, 1, At, B1); PG8_BAR; PG8_SCHED;
            PG8_LDA(At, 0, 1); PG8_STAGE(PG8_SB(0, 0), b2, voffB); PG8_STAGE(PG8_SB(0, 1), b2 + hstepB, voffB); PG8_STAGE(PG8_SA(0, 0), a2, voffA);
            PG8_WAIT_V(8); PG8_WAIT_L(0); PG8_BAR; PG8_MMA(1, 0, At, B0); PG8_MMA(1, 1, At, B1); PG8_BAR; PG8_SCHED;
            PG8_LDB(B0, 1, 0); PG8_LDB(B1, 1, 1); PG8_SCHED; PG8_LDA(At, 1, 0); PG8_STAGE(PG8_SA(0, 1), a2 + hstepA, voffA);
            PG8_WAIT_V(8); PG8_WAIT_L(0); PG8_BAR; PG8_MMA(0, 0, At, B0); PG8_MMA(0, 1, At, B1); PG8_BAR; PG8_SCHED;
            PG8_LDA(At, 1, 1); PG8_STAGE(PG8_SB(1, 0), b3, voffB); PG8_STAGE(PG8_SB(1, 1), b3 + hstepB, voffB); PG8_STAGE(PG8_SA(1, 0), a3, voffA);
            PG8_WAIT_V(8); PG8_WAIT_L(0); PG8_BAR; PG8_MMA(1, 0, At, B0); PG8_MMA(1, 1, At, B1); PG8_BAR; PG8_SCHED;
        }
        if (ALIGN) { if (wr == 0) PG8_BAR; }
        E(acc, cur, wr, wc, fr, fq);
        if (!has_next) break;
#pragma unroll
        for (int a = 0; a < 2; ++a)
#pragma unroll
            for (int b = 0; b < 2; ++b)
#pragma unroll
                for (int m = 0; m < 4; ++m)
#pragma unroll
                    for (int n = 0; n < 2; ++n) acc[a][b][m][n] = (f32x4){0.f, 0.f, 0.f, 0.f};
        cur = nxt; cA = nA; cB = nB; ++ui;
        if (ALIGN) { if (wr == 1) PG8_BAR; }
    }
    PG8_WAIT_V(0);
    if (!ALIGN) { if (wr == 0) PG8_BAR; }
    PG8_BAR;
#undef PG8_SA
#undef PG8_SB
#undef PG8_STAGE
#undef PG8_LDA
#undef PG8_LDB
#undef PG8_MMA
#undef PG8_WAIT_V
#undef PG8_WAIT_L
#undef PG8_SCHED
}
}
namespace pg8 {
struct SchedMN {
    const char* A; const char* Bt; int lda, ldb; int nM, nN, nwg, G, c;
    __device__ __forceinline__ void init(const bf16* A_, int lda_, const bf16* Bt_, int ldb_, int Mrows, int Ncols, int G_, int c_) {
        A = (const char*)A_; Bt = (const char*)Bt_; lda = lda_; ldb = ldb_; nM = Mrows / BM; nN = Ncols / BM; nwg = nM * nN; G = G_; c = c_; }
    __device__ __forceinline__ bool next(int i, Unit& u) const {
        const long L = (long)i * G + c; if (L >= nwg) return false;
        int wgid = (int)L; { const int q = nwg / NXCD, r = nwg % NXCD, xcd = wgid % NXCD, off = wgid / NXCD; wgid = (xcd < r ? xcd * (q + 1) : r * (q + 1) + (xcd - r) * q) + off; }
        const int nig = WGM * nN, gid = wgid / nig, fm = gid * WGM, gsz = (nM - fm) < WGM ? (nM - fm) : WGM;
        const int pm = fm + ((wgid % nig) % gsz), pn = (wgid % nig) / gsz;
        u.a = A + (size_t)pm * BM * lda * 2; u.b = Bt + (size_t)pn * BM * ldb * 2; u.orow = pm * BM; u.ocol = pn * BM; u.aux = pn; return true;
    }
};
struct SchedKV {
    const char* memn; const char* wkv; int G, c;
    __device__ __forceinline__ bool next(int i, Unit& u) const {
        const int L = i * G + c; if (L >= 256) return false;
        const int l = L >> 6, r = L & 63; const char* w = wkv + (size_t)l * 4096 * D * 2;
        if (r < 32) { const int pm = r >> 3, pn = r & 7; u.a = memn + (size_t)pm * 256 * D * 2; u.b = w + (size_t)pn * 256 * D * 2; u.orow = pm * 256; u.ocol = pn * 256; u.aux = l * 2; }
        else { const int q = r - 32, pm = q >> 2, pn = q & 3; u.a = w + (size_t)(2048 + pm * 256) * D * 2; u.b = memn + (size_t)pn * 256 * D * 2; u.orow = pm * 256; u.ocol = pn * 256; u.aux = l * 2 + 1; }
        return true;
    }
};
struct SchedS {
    const char* Q; const char* Km; int G, c;
    __device__ __forceinline__ bool next(int i, Unit& u) const {
        const int L = i * G + c; if (L >= 256) return false;
        const int bh = 2 * (L & 7) + ((L >> 3) >> 4), it = (L >> 3) & 15, b = bh >> 2, h = bh & 3;
        u.a = Q + ((size_t)(b * SEQ + it * 256) * D + h * XAD) * 2; u.b = Km + ((size_t)(b * MEMLEN) * D + h * XAD) * 2; u.orow = b * SEQ + it * 256; u.ocol = h * 256; u.aux = 0; return true;
    }
};
struct SchedPV {
    const char* P; const char* Vt; int G, c;
    __device__ __forceinline__ bool next(int i, Unit& u) const {
        const int L = i * G + c; if (L >= 512) return false;
        const int x = L & 7, r = L >> 3;
        const int bh = 2 * x + (r >> 5), q = r & 31, it = q >> 1, nh = q & 1, b = bh >> 2, h = bh & 3;
        u.a = P + ((size_t)(b * SEQ + it * 256) * 1024 + h * 256) * 2; u.b = Vt + ((size_t)(h * XAD + nh * 256) * 1024 + b * MEMLEN) * 2; u.orow = b * SEQ + it * 256; u.ocol = h * XAD + nh * 256; u.aux = 0; return true;
    }
};
struct SchedDt {
    const char* A; const char* Bt; int c;
    __device__ __forceinline__ bool next(int i, Unit& u) const {
        if (i != 0 || c >= 64) return false;
        u.a = A + (size_t)c * 256 * D * 2; u.b = Bt; u.orow = c * 256; u.ocol = 0; u.aux = 0; return true;
    }
};

struct SchedChainQ {
    const char* A; const char* Bt; int pm, h, n;
    __device__ __forceinline__ bool next(int i, Unit& u) const { if (i >= n) return false; const int pn = 2 * h + i;
        u.a = A + (size_t)pm * 256 * D * 2; u.b = Bt + (size_t)pn * 256 * D * 2; u.orow = pm * 256; u.ocol = pn * 256; u.aux = pn; return true; }
};
struct SchedChainS {
    const char* Q; const char* Km; int pm, h, n;
    __device__ __forceinline__ bool next(int i, Unit& u) const { if (i >= n) return false; const int b = pm >> 4;
        u.a = Q + ((size_t)pm * 256 * D + h * XAD) * 2; u.b = Km + ((size_t)(b * MEMLEN) * D + h * XAD) * 2; u.orow = pm * 256; u.ocol = h * 256; u.aux = 0; return true; }
};
struct SchedChainPV {
    const char* P; const char* Vt; int pm, h, n;
    __device__ __forceinline__ bool next(int i, Unit& u) const { if (i >= n) return false; const int b = pm >> 4;
        u.a = P + ((size_t)pm * 256 * 1024 + h * 256) * 2; u.b = Vt + ((size_t)(h * XAD + i * 256) * 1024 + b * MEMLEN) * 2; u.orow = pm * 256; u.ocol = h * XAD + i * 256; u.aux = 0; return true; }
};

#define EPI_ARGS f32x4 (&acc)[2][2][4][2], const Unit& u, int wr, int wc, int fr, int fq
#define EPI_ROW(ai, m) (u.orow + (ai) * HALF + wr * 64 + (m) * 16 + fr)
#define EPI_COL(bj) (u.ocol + (bj) * HALF + wc * 32 + 8 * fq)
__device__ __forceinline__ float rstd_of(const float* ss, int row) { const f32x4 a = *(const f32x4*)(ss + (size_t)row * 8), b = *(const f32x4*)(ss + (size_t)row * 8 + 4);
    return rsqrtf((((a[0] + a[1]) + (a[2] + a[3])) + ((b[0] + b[1]) + (b[2] + b[3]))) * (1.0f / D) + EPS); }
__device__ __forceinline__ u32x4 pack8(const f32x4 a, const f32x4 b) { u32x4 w; w.x = cvt_pk_bf16(a[0], a[1]); w.y = cvt_pk_bf16(a[2], a[3]); w.z = cvt_pk_bf16(b[0], b[1]); w.w = cvt_pk_bf16(b[2], b[3]); return w; }

struct EpiProjEven {
    const float* ss; bf16* proj; float* logf; const float* lb;
    __device__ __forceinline__ void operator()(EPI_ARGS) const {
        const int range = u.aux >> 2;
#pragma unroll
        for (int ai = 0; ai < 2; ++ai)
#pragma unroll
            for (int m = 0; m < 4; ++m) { const int row = EPI_ROW(ai, m); const float rs = rstd_of(ss, row);
#pragma unroll
                for (int bj = 0; bj < 2; ++bj) { const int col = EPI_COL(bj); f32x4 v0 = acc[ai][bj][m][0] * rs, v1 = acc[ai][bj][m][1] * rs;
                    if (range == 3) { const int c = col - 3072; const f32x4 l0 = *(const f32x4*)(lb + c), l1 = *(const f32x4*)(lb + c + 4);
#pragma unroll
                        for (int j = 0; j < 4; ++j) { v0[j] = __logf(l0[j] + (1.f - l0[j]) * sigm(v0[j])); v1[j] = __logf(l1[j] + (1.f - l1[j]) * sigm(v1[j])); }
                        float* p = logf + (size_t)row * 1024 + c; *(f32x4*)p = v0; *(f32x4*)(p + 4) = v1;
                    } else {
                        if (range == 1) {
#pragma unroll
                            for (int j = 0; j < 4; ++j) { v0[j] = gelu_tanh(v0[j]); v1[j] = gelu_tanh(v1[j]); } }
                        else if (range == 2 || range == 5) {
#pragma unroll
                            for (int j = 0; j < 4; ++j) { v0[j] = siluf(v0[j]); v1[j] = siluf(v1[j]); } }
                        *(u32x4*)(proj + (size_t)row * ABIN + col) = pack8(v0, v1);
                    } } }
    }
};
struct EpiProjOdd {
    const float* ss; bf16* Z; bf16* XBC;
    __device__ __forceinline__ void operator()(EPI_ARGS) const {
        const bool isz = u.ocol < SSDIN;
#pragma unroll
        for (int ai = 0; ai < 2; ++ai)
#pragma unroll
            for (int m = 0; m < 4; ++m) { const int row = EPI_ROW(ai, m); const float rs = rstd_of(ss, row);
#pragma unroll
                for (int bj = 0; bj < 2; ++bj) { const int col = EPI_COL(bj); f32x4 v0 = acc[ai][bj][m][0] * rs, v1 = acc[ai][bj][m][1] * rs;
                    if (isz) {
#pragma unroll
                        for (int j = 0; j < 4; ++j) { v0[j] = siluf(v0[j]); v1[j] = siluf(v1[j]); }
                        *(u32x4*)(Z + (size_t)row * SSDIN + col) = pack8(v0, v1);
                    } else *(u32x4*)(XBC + (size_t)row * SSDCONV + (col - SSDIN)) = pack8(v0, v1); } }
    }
};
struct EpiDt {
    const float* ss; const float* bias; float* DT;
    __device__ __forceinline__ void operator()(EPI_ARGS) const {
        if (wc >= 2) return;
        const int col = wc * 32 + 8 * fq; const f32x4 b0 = *(const f32x4*)(bias + col), b1 = *(const f32x4*)(bias + col + 4);
#pragma unroll
        for (int ai = 0; ai < 2; ++ai)
#pragma unroll
            for (int m = 0; m < 4; ++m) { const int row = EPI_ROW(ai, m); const float rs = rstd_of(ss, row);
                f32x4 v0 = acc[ai][0][m][0] * rs + b0, v1 = acc[ai][0][m][1] * rs + b1;
#pragma unroll
                for (int j = 0; j < 4; ++j) { v0[j] = softplusf(v0[j]); v1[j] = softplusf(v1[j]); }
                float* p = DT + (size_t)row * 64 + col; *(f32x4*)p = v0; *(f32x4*)(p + 4) = v1; }
    }
};
struct EpiResid {
    bf16* xb; float* ssnew; LAS float* tab;
    __device__ __forceinline__ void operator()(EPI_ARGS) const {
#pragma unroll
        for (int ai = 0; ai < 2; ++ai)
#pragma unroll
            for (int m = 0; m < 4; ++m) { const int row = EPI_ROW(ai, m); float sq = 0.f;
#pragma unroll
                for (int bj = 0; bj < 2; ++bj) { bf16* p = xb + (size_t)row * D + EPI_COL(bj); const u32x4 w = *(const u32x4*)p;
                    f32x4 o0 = acc[ai][bj][m][0], o1 = acc[ai][bj][m][1];
                    o0[0] += rs_lo(w.x); o0[1] += rs_hi(w.x); o0[2] += rs_lo(w.y); o0[3] += rs_hi(w.y); o1[0] += rs_lo(w.z); o1[1] += rs_hi(w.z); o1[2] += rs_lo(w.w); o1[3] += rs_hi(w.w);
                    { u32x4 pk; pk.x = rs_pk(o0[0], o0[1]); pk.y = rs_pk(o0[2], o0[3]); pk.z = rs_pk(o1[0], o1[1]); pk.w = rs_pk(o1[2], o1[3]); *(u32x4*)p = pk; }
                    sq += ((o0[0] * o0[0] + o0[1] * o0[1]) + (o0[2] * o0[2] + o0[3] * o0[3])) + ((o1[0] * o1[0] + o1[1] * o1[1]) + (o1[2] * o1[2] + o1[3] * o1[3])); }
                sq += __shfl_xor(sq, 16); sq += __shfl_xor(sq, 32);
                if (fq == 0) tab[(ai * HALF + wr * 64 + m * 16 + fr) * 4 + wc] = sq; }
        LDS_WAIT(); PG8_BAR; asm volatile("" ::: "memory");
        const int lane = fq * 16 + fr, r = (wr * 4 + wc) * 32 + (lane & 31);
        if (lane < 32) { const f32x4 t = *(const LAS f32x4*)(tab + r * 4); ssnew[(size_t)(u.orow + r) * 8 + (u.ocol >> 8)] = (t[0] + t[1]) + (t[2] + t[3]); }
    }
};
struct EpiQ {
    const float* ss; bf16* Q; float scale;
    __device__ __forceinline__ void operator()(EPI_ARGS) const {
#pragma unroll
        for (int ai = 0; ai < 2; ++ai)
#pragma unroll
            for (int m = 0; m < 4; ++m) { const int row = EPI_ROW(ai, m); const float rs = rstd_of(ss, row) * scale;
#pragma unroll
                for (int bj = 0; bj < 2; ++bj) *(u32x4*)(Q + (size_t)row * D + EPI_COL(bj)) = pack8(acc[ai][bj][m][0] * rs, acc[ai][bj][m][1] * rs); }
    }
};
struct EpiPlain {
    bf16* O; int ldc;
    __device__ __forceinline__ void operator()(EPI_ARGS) const {
#pragma unroll
        for (int ai = 0; ai < 2; ++ai)
#pragma unroll
            for (int m = 0; m < 4; ++m) { const int row = EPI_ROW(ai, m);
#pragma unroll
                for (int bj = 0; bj < 2; ++bj) *(u32x4*)(O + (size_t)row * ldc + EPI_COL(bj)) = pack8(acc[ai][bj][m][0], acc[ai][bj][m][1]); }
    }
};
struct EpiKV {
    bf16* Km; bf16* Vt;
    __device__ __forceinline__ void operator()(EPI_ARGS) const {
        const int l = u.aux >> 1; const bool isv = u.aux & 1;
        bf16* O = isv ? Vt + (size_t)l * D * MEMROWS : Km + (size_t)l * MEMROWS * D; const int ldc = isv ? MEMROWS : D;
#pragma unroll
        for (int ai = 0; ai < 2; ++ai)
#pragma unroll
            for (int m = 0; m < 4; ++m) { const int row = EPI_ROW(ai, m);
#pragma unroll
                for (int bj = 0; bj < 2; ++bj) *(u32x4*)(O + (size_t)row * ldc + EPI_COL(bj)) = pack8(acc[ai][bj][m][0], acc[ai][bj][m][1]); }
    }
};
struct EpiSoftmax {
    bf16* P; LAS float* tab;
    __device__ __forceinline__ void operator()(EPI_ARGS) const {
        float mx[2][4];
#pragma unroll
        for (int ai = 0; ai < 2; ++ai)
#pragma unroll
            for (int m = 0; m < 4; ++m) { float v = -3.0e38f;
#pragma unroll
                for (int bj = 0; bj < 2; ++bj)
#pragma unroll
                    for (int n = 0; n < 2; ++n) { const f32x4 a = acc[ai][bj][m][n]; v = fmaxf(v, fmaxf(fmaxf(a[0], a[1]), fmaxf(a[2], a[3]))); }
                v = fmaxf(v, __shfl_xor(v, 16)); v = fmaxf(v, __shfl_xor(v, 32));
                if (fq == 0) tab[(ai * HALF + wr * 64 + m * 16 + fr) * 4 + wc] = v; }
        LDS_WAIT(); PG8_BAR; asm volatile("" ::: "memory");
#pragma unroll
        for (int ai = 0; ai < 2; ++ai)
#pragma unroll
            for (int m = 0; m < 4; ++m) { const int r = ai * HALF + wr * 64 + m * 16 + fr; const f32x4 t = *(const LAS f32x4*)(tab + r * 4);
                const float rm = fmaxf(fmaxf(t[0], t[1]), fmaxf(t[2], t[3])); float s = 0.f;
#pragma unroll
                for (int bj = 0; bj < 2; ++bj)
#pragma unroll
                    for (int n = 0; n < 2; ++n) { f32x4 a = acc[ai][bj][m][n];
#pragma unroll
                        for (int j = 0; j < 4; ++j) { a[j] = __expf(a[j] - rm); s += a[j]; }
                        acc[ai][bj][m][n] = a; }
                s += __shfl_xor(s, 16); s += __shfl_xor(s, 32);
                if (fq == 0) tab[1024 + r * 4 + wc] = s; }
        LDS_WAIT(); PG8_BAR; asm volatile("" ::: "memory");
#pragma unroll
        for (int ai = 0; ai < 2; ++ai)
#pragma unroll
            for (int m = 0; m < 4; ++m) { const int r = ai * HALF + wr * 64 + m * 16 + fr; const f32x4 t = *(const LAS f32x4*)(tab + 1024 + r * 4);
                const float inv = __builtin_amdgcn_rcpf((t[0] + t[1]) + (t[2] + t[3])); const int row = u.orow + r;
#pragma unroll
                for (int bj = 0; bj < 2; ++bj) *(u32x4*)(P + (size_t)row * 1024 + EPI_COL(bj)) = pack8(acc[ai][bj][m][0] * inv, acc[ai][bj][m][1] * inv); }
    }
};
struct EpiGateUp {
    const float* ss; bf16* H;
    __device__ __forceinline__ void operator()(EPI_ARGS) const {
#pragma unroll
        for (int ai = 0; ai < 2; ++ai)
#pragma unroll
            for (int m = 0; m < 4; ++m) { const int row = EPI_ROW(ai, m); const float rs = rstd_of(ss, row);
#pragma unroll
                for (int bj = 0; bj < 2; ++bj) { const int hc = EPI_COL(bj) >> 1; const f32x4 g = acc[ai][bj][m][0] * rs, up = acc[ai][bj][m][1] * rs; f32x4 h;
#pragma unroll
                    for (int j = 0; j < 4; ++j) h[j] = siluf(g[j]) * up[j];
                    u32x2 w; w.x = cvt_pk_bf16(h[0], h[1]); w.y = cvt_pk_bf16(h[2], h[3]); *(u32x2*)(H + (size_t)row * FF + hc) = w; } }
    }
};
#undef EPI_ARGS
}
#define MFMA16(X, Y, ACC) __builtin_amdgcn_mfma_f32_16x16x32_bf16((X), (Y), (ACC), 0, 0, 0)
#define WG_SYNC() do { asm volatile("s_waitcnt vmcnt(0) lgkmcnt(0)" ::: "memory"); __builtin_amdgcn_s_barrier(); asm volatile("" ::: "memory"); } while (0)
#define LDS_SYNC() do { asm volatile("s_waitcnt lgkmcnt(0)" ::: "memory"); __builtin_amdgcn_s_barrier(); asm volatile("" ::: "memory"); } while (0)
constexpr int LP = 136;
constexpr int LP64 = 72;
__device__ __forceinline__ bf16x8 lds_frag(const LAS bf16* base, int row, int pitch, int kofs) { return *(const LAS bf16x8*)(base + row * pitch + kofs); }
__device__ __forceinline__ u32x2 pack4(const f32x4 a) { u32x2 w; w.x = cvt_pk_bf16(a[0], a[1]); w.y = cvt_pk_bf16(a[2], a[3]); return w; }

template <int MAP, bool F16>
__device__ __forceinline__ void conv_item(const float* W, int ldw, int K, int n0, const float* gain, bf16* WT, int row_off, LAS float* scr, int item, int nblk, int lane) {
    const int kb = item / nblk, nb = item % nblk, k0 = 64 * kb, nn0 = 64 * nb;
    const int kr = lane >> 4, n4 = (lane & 15) * 4;
    const float* src = W + (size_t)(k0 + kr) * ldw + n0 + nn0 + n4;
    f32x4 v[16];
#pragma unroll
    for (int i = 0; i < 16; ++i) v[i] = *(const f32x4*)(src + (size_t)(4 * i) * ldw);
#pragma unroll
    for (int i = 0; i < 16; ++i) { f32x4 w = v[i]; if (gain) w = w * gain[k0 + 4 * i + kr];
        LAS float* d = scr + (4 * i + kr) * 65 + n4; d[0] = w[0]; d[1] = w[1]; d[2] = w[2]; d[3] = w[3]; }
    LDS_WAIT(); asm volatile("" ::: "memory");
    const int c = lane & 7, nbase = lane >> 3;
#pragma unroll
    for (int j = 0; j < 8; ++j) { const int n = nbase + 8 * j; const LAS float* s = scr + (8 * c) * 65 + n;
        u32x4 o; if (F16) { o.x = cvt_pk_f16(s[0 * 65], s[1 * 65]); o.y = cvt_pk_f16(s[2 * 65], s[3 * 65]); o.z = cvt_pk_f16(s[4 * 65], s[5 * 65]); o.w = cvt_pk_f16(s[6 * 65], s[7 * 65]); }
        else { o.x = cvt_pk_bf16(s[0 * 65], s[1 * 65]); o.y = cvt_pk_bf16(s[2 * 65], s[3 * 65]); o.z = cvt_pk_bf16(s[4 * 65], s[5 * 65]); o.w = cvt_pk_bf16(s[6 * 65], s[7 * 65]); }
        const int nn = nn0 + n; const int dr = MAP == 0 ? nn : ((nn >> 2) * 8 + (nn & 3) + (MAP == 2 ? 4 : 0));
        *(u32x4*)(WT + (size_t)(row_off + dr) * K + k0 + 8 * c) = o; }
    LDS_WAIT(); asm volatile("" ::: "memory");
}
template <int MAP, bool F16 = false>
__device__ __forceinline__ void conv_matrix(const float* W, int ldw, int K, int n0, int ncols, const float* gain, bf16* WT, int row_off, LAS float* scr, int gw, int NGW, int lane, int& rot) {
    const int nblk = ncols / 64, nitems = (K / 64) * nblk; int first = gw - rot; if (first < 0) first += NGW;
    for (int it = first; it < nitems; it += NGW) conv_item<MAP, F16>(W, ldw, K, n0, gain, WT, row_off, scr, it, nblk, lane);
    rot = (rot + nitems) % NGW;
}

struct In {
    const float *x, *mem, *norm_mix, *norm_xattn, *norm_ffn, *norm_mem, *norm_final, *ab_w_in, *ab_w_out, *lru_conv_w, *lru_conv_b, *lru_w_r, *lru_b_r, *lru_w_i, *lru_b_i, *lru_lambda,
        *hgrn_lb, *hgrn_norm, *ssd_w_in, *ssd_w_out, *ssd_conv_w, *ssd_conv_b, *ssd_dt_bias, *ssd_a_log, *ssd_d, *ssd_norm, *xa_w_q, *xa_w_kv, *xa_w_o, *ffn_w_gate, *ffn_w_up, *ffn_w_down;
};

typedef const In __attribute__((address_space(4))) CIn;
__device__ __forceinline__ void convert_layer(CIn& I, int l, bf16* WL, LAS float* scr, int gw, int NGW, int lane, int& rot) {
    const int e = l >> 1;
    if ((l & 1) == 0) {
        conv_matrix<0, RF16>(I.ab_w_in + (size_t)e * D * ABIN, ABIN, D, 0, ABIN, I.norm_mix + l * D, WL + WL_IN, 0, scr, gw, NGW, lane, rot);
        conv_matrix<0>(I.ab_w_out + (size_t)e * D * D, D, D, 0, D, nullptr, WL + WL_OUT, 0, scr, gw, NGW, lane, rot);
    } else {
        conv_matrix<0, RF16>(I.ssd_w_in + (size_t)e * D * SSDPROJ, SSDPROJ, D, 0, SSDN1, I.norm_mix + l * D, WL + WL_IN, 0, scr, gw, NGW, lane, rot);
        conv_matrix<0, RF16>(I.ssd_w_in + (size_t)e * D * SSDPROJ, SSDPROJ, D, SSDN1, 64, I.norm_mix + l * D, WL + WL_DT, 0, scr, gw, NGW, lane, rot);
        for (int i = gw * 64 + lane; i < 192 * D / 8; i += NGW * 64) *(u32x4*)(WL + WL_DT + (size_t)64 * D + (size_t)i * 8) = (u32x4){0u, 0u, 0u, 0u};
        conv_matrix<0>(I.ssd_w_out + (size_t)e * SSDIN * D, D, SSDIN, 0, D, nullptr, WL + WL_OUT, 0, scr, gw, NGW, lane, rot);
    }
    conv_matrix<0, RF16>(I.xa_w_q + (size_t)l * D * D, D, D, 0, D, I.norm_xattn + l * D, WL + WL_Q, 0, scr, gw, NGW, lane, rot);
    conv_matrix<0>(I.xa_w_o + (size_t)l * D * D, D, D, 0, D, nullptr, WL + WL_O, 0, scr, gw, NGW, lane, rot);
    conv_matrix<1, RF16>(I.ffn_w_gate + (size_t)l * D * FF, FF, D, 0, FF, I.norm_ffn + l * D, WL + WL_GU, 0, scr, gw, NGW, lane, rot);
    conv_matrix<2, RF16>(I.ffn_w_up + (size_t)l * D * FF, FF, D, 0, FF, I.norm_ffn + l * D, WL + WL_GU, 0, scr, gw, NGW, lane, rot);
    conv_matrix<0>(I.ffn_w_down + (size_t)l * FF * D, D, FF, 0, D, nullptr, WL + WL_DN, 0, scr, gw, NGW, lane, rot);
}

template <bool PASSB>
__device__ __forceinline__ void lru_units(const int tid, LAS unsigned char* lds, int G, int cu, const bf16* PROJ, const bf16* WRT, const float* cw, const float* cb, const float* br, const float* bi,
                                          const float* lam, float* SEG, bf16* YAB) {
    const int wid = __builtin_amdgcn_readfirstlane(tid >> 6), lane = tid & 63, q = lane >> 4, c16 = lane & 15;
    LAS bf16* XA = (LAS bf16*)(lds);
    LAS bf16* XC = (LAS bf16*)(lds + 35840);
    LAS bf16* WR = (LAS bf16*)(lds + 70656);
    LAS bf16* WI = (LAS bf16*)(lds + 105472);
    LAS float* PAR = (LAS float*)(lds + 140288);
    LAS float* WT = (LAS float*)(lds + 144384);
    LAS float* HIN = (LAS float*)(lds + 152576);
    int loadedj = -1;
    for (int u = cu; u < 1024; u += G) {
        const int j = u & 7, rest = u >> 3, b = rest >> 5, seg = rest & 31; const int t0 = b * SEQ + seg * 128;
        if (j != loadedj) {
            loadedj = j;
            for (int p = tid; p < 2 * 2048; p += NTHR) { const int g = p >> 11, pp = p & 2047, r = pp >> 4, pc = pp & 15;
                const u32x4 v = *(const u32x4*)(WRT + ((size_t)(g * 8 + j) * 128 + r) * 128 + pc * 8);
                *(LAS u32x4*)((g ? WI : WR) + r * LP + pc * 8) = v; }
            if (tid < 128) { const int ch = j * 128 + tid;
                PAR[0 * 128 + tid] = 8.0f * softplusf(-lam[ch]); PAR[1 * 128 + tid] = br[ch]; PAR[2 * 128 + tid] = bi[ch]; PAR[3 * 128 + tid] = cb[ch];
#pragma unroll
                for (int k = 0; k < 4; ++k) PAR[(4 + k) * 128 + tid] = cw[k * LRUW + ch]; }
        }
        for (int p = tid; p < 131 * 16; p += NTHR) { const int r = p >> 4, pc = p & 15; u32x4 v = (u32x4){0u, 0u, 0u, 0u};
            if (seg > 0 || r >= 3) v = *(const u32x4*)(PROJ + (size_t)(t0 + r - 3) * ABIN + j * 128 + pc * 8);
            *(LAS u32x4*)(XA + r * LP + pc * 8) = v; }
        if (PASSB) { if (tid < 128) { float h = 0.f; const float* sg = SEG + ((size_t)(b * 8 + j) * 32) * 256 + tid * 2;
                for (int s = 0; s < seg; ++s) { const f32x2 ab = *(const f32x2*)(sg + (size_t)s * 256); h = ab.x * h + ab.y; }
                HIN[tid] = h; } }
        WG_SYNC();
        {
            const int ch8 = tid & 15, tr = tid >> 4; u32x4 rows[7];
#pragma unroll
            for (int i = 0; i < 7; ++i) rows[i] = *(const LAS u32x4*)(XA + (4 * tr + i) * LP + ch8 * 8);
            float w[4][8], bb[8];
#pragma unroll
            for (int e = 0; e < 8; ++e) { bb[e] = PAR[3 * 128 + ch8 * 8 + e];
#pragma unroll
                for (int k = 0; k < 4; ++k) w[k][e] = PAR[(4 + k) * 128 + ch8 * 8 + e]; }
#pragma unroll
            for (int i = 0; i < 4; ++i) { float o[8];
#pragma unroll
                for (int e = 0; e < 8; ++e) { float a = bb[e];
#pragma unroll
                    for (int k = 0; k < 4; ++k) { const unsigned wd = rows[i + k][e >> 1]; a += w[k][e] * ((e & 1) ? bfhi(wd) : bflo(wd)); }
                    o[e] = a; }
                u32x4 pk; pk.x = cvt_pk_bf16(o[0], o[1]); pk.y = cvt_pk_bf16(o[2], o[3]); pk.z = cvt_pk_bf16(o[4], o[5]); pk.w = cvt_pk_bf16(o[6], o[7]);
                *(LAS u32x4*)(XC + (4 * tr + i) * LP + ch8 * 8) = pk; }
        }
        WG_SYNC();
        float PP[8][4], HH[8][4];
        {
            bf16x8 xf[4];
#pragma unroll
            for (int ks = 0; ks < 4; ++ks) xf[ks] = lds_frag(XC, 16 * wid + c16, LP, 32 * ks + 8 * q);
#pragma unroll
            for (int jb = 0; jb < 8; ++jb) {
                f32x4 aR = (f32x4){0.f, 0.f, 0.f, 0.f}, aI = aR;
#pragma unroll
                for (int ks = 0; ks < 4; ++ks) { aR = MFMA16(xf[ks], lds_frag(WR, 16 * jb + c16, LP, 32 * ks + 8 * q), aR); aI = MFMA16(xf[ks], lds_frag(WI, 16 * jb + c16, LP, 32 * ks + 8 * q), aI); }
                const int ch = 16 * jb + c16;
                const float sp8 = PAR[ch], pbr = PAR[128 + ch], pbi = PAR[256 + ch], pcb = PAR[384 + ch], w0 = PAR[512 + ch], w1 = PAR[640 + ch], w2 = PAR[768 + ch], w3 = PAR[896 + ch];
                float xr[7];
#pragma unroll
                for (int i = 0; i < 7; ++i) xr[i] = bf2f(XA[(16 * wid + 4 * q + i) * LP + ch]);
                float a[4], bt[4];
#pragma unroll
                for (int r = 0; r < 4; ++r) { const float xc = pcb + w0 * xr[r] + w1 * xr[r + 1] + w2 * xr[r + 2] + w3 * xr[r + 3];
                    const float rg = sigm(aR[r] + pbr), ig = sigm(aI[r] + pbi); const float la = -sp8 * rg;
                    const float av = __expf(la), x2 = 2.0f * la; a[r] = av;
                    const float om = (x2 > -0.02f) ? -x2 * (1.0f + x2 * (0.5f + x2 * 0.16666667f)) : 1.0f - av * av;
                    bt[r] = __builtin_amdgcn_sqrtf(fmaxf(om, 0.f)) * ig * xc; }
                float P[4], H[4]; P[0] = a[0]; H[0] = bt[0];
#pragma unroll
                for (int r = 1; r < 4; ++r) { P[r] = a[r] * P[r - 1]; H[r] = a[r] * H[r - 1] + bt[r]; }
                float Ae = 1.f, Be = 0.f, Aw = 1.f, Bw = 0.f;
#pragma unroll
                for (int qq = 0; qq < 4; ++qq) { const float Aq = __shfl(P[3], c16 + 16 * qq), Bq = __shfl(H[3], c16 + 16 * qq);
                    if (qq < q) { Be = Aq * Be + Bq; Ae = Aq * Ae; }
                    Bw = Aq * Bw + Bq; Aw = Aq * Aw; }
#pragma unroll
                for (int r = 0; r < 4; ++r) { PP[jb][r] = P[r] * Ae; HH[jb][r] = P[r] * Be + H[r]; }
                if (q == 0) *(LAS f32x2*)(WT + (wid * 128 + ch) * 2) = (f32x2){Aw, Bw};
            }
        }
        WG_SYNC();
        if (!PASSB) {
            if (tid < 128) { float A = 1.f, B = 0.f;
#pragma unroll
                for (int w = 0; w < 8; ++w) { const f32x2 ab = *(const LAS f32x2*)(WT + (w * 128 + tid) * 2); B = ab.x * B + ab.y; A = ab.x * A; }
                *(f32x2*)(SEG + ((size_t)(b * 8 + j) * 32 + seg) * 256 + tid * 2) = (f32x2){A, B}; }
        } else {
#pragma unroll
            for (int jb = 0; jb < 8; ++jb) { const int ch = 16 * jb + c16; float h0 = HIN[ch];
                for (int w = 0; w < wid; ++w) { const f32x2 ab = *(const LAS f32x2*)(WT + (w * 128 + ch) * 2); h0 = ab.x * h0 + ab.y; }
#pragma unroll
                for (int r = 0; r < 4; ++r) { const int t = t0 + 16 * wid + 4 * q + r; const float h = PP[jb][r] * h0 + HH[jb][r];
                    const float ga = bf2f(PROJ[(size_t)t * ABIN + 1024 + j * 128 + ch]);
                    YAB[(size_t)t * D + j * 128 + ch] = (bf16)f2bf(ga * h); } }
        }
        WG_SYNC();
    }
}

__device__ __forceinline__ void hgrn1_load(float (&lf)[16], unsigned (&vv)[16], const float* LOGF, const bf16* PROJ, int u, int k, int qt) {
    const int bh = u >> 6, c = u & 63, b = bh >> 3, h = bh & 7; const int t0 = b * SEQ + c * 64 + 16 * qt;
#pragma unroll
    for (int i = 0; i < 16; ++i) { lf[i] = LOGF[(size_t)(t0 + i) * 1024 + h * 128 + k]; vv[i] = PROJ[(size_t)(t0 + i) * ABIN + 4096 + h * 128 + k]; }
}
__device__ __forceinline__ void hgrn1_units(const int tid, LAS unsigned char* lds, int G, int cu, const float* LOGF, const bf16* PROJ, bf16* HST, float* HDEC) {
    const int wid = __builtin_amdgcn_readfirstlane(tid >> 6), lane = tid & 63, q = lane >> 4, c16 = lane & 15;
    LAS bf16* KT = (LAS bf16*)(lds);
    LAS bf16* VT = (LAS bf16*)(lds + 18432);
    LAS float* TOT = (LAS float*)(lds + 36864);
    const int k = tid & 127, qt = tid >> 7;
    float lf[16], nlf[16]; unsigned vv[16], nvv[16];
    if (cu < 2048) hgrn1_load(lf, vv, LOGF, PROJ, cu, k, qt);
    for (int u = cu; u < 2048; u += G) {
        if (u + G < 2048) hgrn1_load(nlf, nvv, LOGF, PROJ, u + G, k, qt);
        float cs[16];
        cs[0] = lf[0];
#pragma unroll
        for (int i = 1; i < 16; ++i) cs[i] = cs[i - 1] + lf[i];
        TOT[qt * 128 + k] = cs[15];
        LDS_SYNC();
        float pre = 0.f, last = 0.f;
#pragma unroll
        for (int qq = 0; qq < 4; ++qq) { const float t = TOT[qq * 128 + k]; if (qq < qt) pre += t; last += t; }
        unsigned kw[8], vw[8];
#pragma unroll
        for (int i = 0; i < 8; ++i) { const float k0 = (1.f - __expf(lf[2 * i])) * __expf(last - (pre + cs[2 * i])), k1 = (1.f - __expf(lf[2 * i + 1])) * __expf(last - (pre + cs[2 * i + 1]));
            kw[i] = cvt_pk_bf16(k0, k1); vw[i] = vv[2 * i] | (vv[2 * i + 1] << 16); }
        *(LAS u32x4*)(KT + k * LP64 + 16 * qt) = (u32x4){kw[0], kw[1], kw[2], kw[3]}; *(LAS u32x4*)(KT + k * LP64 + 16 * qt + 8) = (u32x4){kw[4], kw[5], kw[6], kw[7]};
        *(LAS u32x4*)(VT + k * LP64 + 16 * qt) = (u32x4){vw[0], vw[1], vw[2], vw[3]}; *(LAS u32x4*)(VT + k * LP64 + 16 * qt + 8) = (u32x4){vw[4], vw[5], vw[6], vw[7]};
        if (qt == 0) HDEC[(size_t)u * 128 + k] = __expf(last);
        LDS_SYNC();
        bf16x8 kf[2];
#pragma unroll
        for (int ks = 0; ks < 2; ++ks) kf[ks] = lds_frag(KT, 16 * wid + c16, LP64, 32 * ks + 8 * q);
#pragma unroll
        for (int vb = 0; vb < 8; ++vb) { f32x4 acc = (f32x4){0.f, 0.f, 0.f, 0.f};
#pragma unroll
            for (int ks = 0; ks < 2; ++ks) acc = MFMA16(kf[ks], lds_frag(VT, 16 * vb + c16, LP64, 32 * ks + 8 * q), acc);
            *(u32x2*)(HST + ((size_t)u * 128 + 16 * vb + c16) * 128 + 16 * wid + 4 * q) = pack4(acc); }
        LDS_SYNC();
#pragma unroll
        for (int i = 0; i < 16; ++i) { lf[i] = nlf[i]; vv[i] = nvv[i]; }
    }
    WG_SYNC();
}
__device__ __forceinline__ void hgrn2_scan(const int tid, int G, int cu, bf16* HST, const float* HDEC) {
    for (int task = cu * NTHR + tid; task < 32 * 4096; task += G * NTHR) {
        const int bh = task >> 12, e = (task & 4095) * 4; f32x4 S = (f32x4){0.f, 0.f, 0.f, 0.f};
        bf16* p0 = HST + (size_t)bh * 64 * 16384 + e; const float* d0 = HDEC + (size_t)bh * 64 * 128 + (e & 127);
#pragma unroll 1
        for (int cb = 0; cb < 64; cb += 16) { u32x2 L[16]; f32x4 d[16];
#pragma unroll
            for (int c = 0; c < 16; ++c) { L[c] = *(const u32x2*)(p0 + (size_t)(cb + c) * 16384); d[c] = *(const f32x4*)(d0 + (size_t)(cb + c) * 128); }
#pragma unroll
            for (int c = 0; c < 16; ++c) { *(u32x2*)(p0 + (size_t)(cb + c) * 16384) = pack4(S);
                S[0] = d[c][0] * S[0] + bflo(L[c].x); S[1] = d[c][1] * S[1] + bfhi(L[c].x); S[2] = d[c][2] * S[2] + bflo(L[c].y); S[3] = d[c][3] * S[3] + bfhi(L[c].y); } }
    }
}
__device__ __forceinline__ void hgrn3_load(float (&lf)[16], unsigned (&qv)[16], unsigned (&vv)[16], u32x4 (&st)[4], const float* LOGF, const bf16* PROJ, const bf16* HST, int u, int k, int qt, int tid) {
    const int bh = u >> 6, c = u & 63, b = bh >> 3, h = bh & 7; const int t0 = b * SEQ + c * 64 + 16 * qt;
#pragma unroll
    for (int i = 0; i < 16; ++i) { lf[i] = LOGF[(size_t)(t0 + i) * 1024 + h * 128 + k]; const bf16* pr = PROJ + (size_t)(t0 + i) * ABIN + h * 128 + k; qv[i] = pr[2048]; vv[i] = pr[4096]; }
#pragma unroll
    for (int i = 0; i < 4; ++i) { const int p = tid + NTHR * i, r = p >> 4, pc = p & 15; st[i] = *(const u32x4*)(HST + (size_t)u * 16384 + r * 128 + pc * 8); }
}
__device__ __forceinline__ void hgrn3_units(const int tid, LAS unsigned char* lds, int G, int cu, const float* LOGF, const bf16* PROJ, const bf16* HST, const float* hnorm, bf16* YAB) {
    const int wid = __builtin_amdgcn_readfirstlane(tid >> 6), lane = tid & 63, q = lane >> 4, c16 = lane & 15;
    LAS bf16* QH = (LAS bf16*)(lds);
    LAS bf16* QT = (LAS bf16*)(lds + 17408);
    LAS bf16* KH = (LAS bf16*)(lds + 34816);
    LAS bf16* VT = (LAS bf16*)(lds + 52224);
    LAS bf16* STL = (LAS bf16*)(lds + 70656);
    LAS bf16* PM = (LAS bf16*)(lds + 105472);
    LAS float* TOT = (LAS float*)(lds + 114688);
    LAS float* SQ = (LAS float*)(lds + 116736);
    const int k = tid & 127, qt = tid >> 7;
    float lf[16], nlf[16]; unsigned qv[16], nqv[16], vv[16], nvv[16]; u32x4 st[4], nst[4];
    if (cu < 2048) hgrn3_load(lf, qv, vv, st, LOGF, PROJ, HST, cu, k, qt, tid);
    for (int u = cu; u < 2048; u += G) {
        const int bh = u >> 6, c = u & 63, b = bh >> 3, h = bh & 7; const int tc = b * SEQ + c * 64;
        float cs[16];
        cs[0] = lf[0];
#pragma unroll
        for (int i = 1; i < 16; ++i) cs[i] = cs[i - 1] + lf[i];
        TOT[qt * 128 + k] = cs[15];
#pragma unroll
        for (int i = 0; i < 4; ++i) { const int p = tid + NTHR * i, r = p >> 4, pc = p & 15; *(LAS u32x4*)(STL + r * LP + pc * 8) = st[i]; }
        if (u + G < 2048) hgrn3_load(nlf, nqv, nvv, nst, LOGF, PROJ, HST, u + G, k, qt, tid);
        LDS_SYNC();
        float pre = 0.f;
#pragma unroll
        for (int qq = 0; qq < 4; ++qq) { const float t = TOT[qq * 128 + k]; if (qq < qt) pre += t; }
        const float ref = TOT[k] + TOT[128 + k];
        unsigned vw[8];
#pragma unroll
        for (int i = 0; i < 16; ++i) { const float cum = pre + cs[i], kk = 1.f - __expf(lf[i]), qf = bf2f((bf16)qv[i]);
            QT[(16 * qt + i) * LP + k] = (bf16)f2bf(qf * __expf(cum));
            QH[(16 * qt + i) * LP + k] = (bf16)f2bf(qf * __expf(fminf(cum - ref, 80.f)));
            KH[(16 * qt + i) * LP + k] = (bf16)f2bf(kk * __expf(fminf(ref - cum, 80.f))); }
#pragma unroll
        for (int i = 0; i < 8; ++i) vw[i] = vv[2 * i] | (vv[2 * i + 1] << 16);
        *(LAS u32x4*)(VT + k * LP64 + 16 * qt) = (u32x4){vw[0], vw[1], vw[2], vw[3]}; *(LAS u32x4*)(VT + k * LP64 + 16 * qt + 8) = (u32x4){vw[4], vw[5], vw[6], vw[7]};
        LDS_SYNC();
        {
            const int tb = wid & 3;
            bf16x8 qf[4];
#pragma unroll
            for (int ks = 0; ks < 4; ++ks) qf[ks] = lds_frag(QH, 16 * tb + c16, LP, 32 * ks + 8 * q);
#pragma unroll
            for (int sbi = 0; sbi < 2; ++sbi) { const int sb = 2 * (wid >> 2) + sbi; f32x4 acc = (f32x4){0.f, 0.f, 0.f, 0.f};
#pragma unroll
                for (int ks = 0; ks < 4; ++ks) acc = MFMA16(lds_frag(KH, 16 * sb + c16, LP, 32 * ks + 8 * q), qf[ks], acc);
                const int t = 16 * tb + c16, s0 = 16 * sb + 4 * q;
#pragma unroll
                for (int r = 0; r < 4; ++r) acc[r] = (s0 + r <= t) ? acc[r] : 0.f;
                *(LAS u32x2*)(PM + t * LP64 + s0) = pack4(acc); }
        }
        LDS_SYNC();
        {
            const int tb = wid & 3, vh = wid >> 2, t = 16 * tb + c16;
            bf16x8 qf[4], pf[2];
#pragma unroll
            for (int ks = 0; ks < 4; ++ks) qf[ks] = lds_frag(QT, t, LP, 32 * ks + 8 * q);
#pragma unroll
            for (int ks = 0; ks < 2; ++ks) pf[ks] = lds_frag(PM, t, LP64, 32 * ks + 8 * q);
            f32x4 acc[4]; float sq = 0.f;
#pragma unroll
            for (int vb = 0; vb < 4; ++vb) { const int vr = 64 * vh + 16 * vb + c16; acc[vb] = (f32x4){0.f, 0.f, 0.f, 0.f};
#pragma unroll
                for (int ks = 0; ks < 4; ++ks) acc[vb] = MFMA16(lds_frag(STL, vr, LP, 32 * ks + 8 * q), qf[ks], acc[vb]);
#pragma unroll
                for (int ks = 0; ks < 2; ++ks) acc[vb] = MFMA16(lds_frag(VT, vr, LP64, 32 * ks + 8 * q), pf[ks], acc[vb]);
                sq += (acc[vb][0] * acc[vb][0] + acc[vb][1] * acc[vb][1]) + (acc[vb][2] * acc[vb][2] + acc[vb][3] * acc[vb][3]); }
            sq += __shfl_xor(sq, 16); sq += __shfl_xor(sq, 32);
            if (q == 0) SQ[vh * 64 + t] = sq;
            LDS_SYNC();
            const float rstd = rsqrtf((SQ[t] + SQ[64 + t]) * (1.0f / 128.f) + EPS);
#pragma unroll
            for (int vb = 0; vb < 4; ++vb) { const int v0 = 64 * vh + 16 * vb + 4 * q; const f32x4 hn = *(const f32x4*)(hnorm + h * 128 + v0);
                const u32x2 gw = *(const u32x2*)(PROJ + (size_t)(tc + t) * ABIN + 5120 + h * 128 + v0);
                f32x4 y; y[0] = acc[vb][0] * rstd * hn[0] * bflo(gw.x); y[1] = acc[vb][1] * rstd * hn[1] * bfhi(gw.x); y[2] = acc[vb][2] * rstd * hn[2] * bflo(gw.y); y[3] = acc[vb][3] * rstd * hn[3] * bfhi(gw.y);
                *(u32x2*)(YAB + (size_t)(tc + t) * D + 1024 + h * 128 + v0) = pack4(y); }
        }
        LDS_SYNC();
#pragma unroll
        for (int i = 0; i < 16; ++i) { lf[i] = nlf[i]; qv[i] = nqv[i]; vv[i] = nvv[i]; }
#pragma unroll
        for (int i = 0; i < 4; ++i) st[i] = nst[i];
    }
    WG_SYNC();
}
__device__ __forceinline__ void ssd_prep_load(u32x4 (&rows)[7], const bf16* XBC, int u, int ch8, int tr) {
    const int bc = u / 48, cblk = u % 48, c = bc & 31; const bf16* src = XBC + (size_t)(bc * 128 + 4 * tr - 3) * SSDCONV + cblk * 128 + ch8 * 8;
#pragma unroll
    for (int i = 0; i < 7; ++i) { rows[i] = (u32x4){0u, 0u, 0u, 0u}; if (c > 0 || 4 * tr + i >= 3) rows[i] = *(const u32x4*)(src + (size_t)i * SSDCONV); }
}
__device__ __forceinline__ void ssd_prep_units(const int tid, LAS unsigned char* lds, int ufirst, int ustride, int uend, const bf16* XBC, const float* cw, const float* cb, bf16* XBT, bf16* BCN) {
    LAS bf16* T = (LAS bf16*)(lds);
    const int ch8 = tid & 15, tr = tid >> 4;
    u32x4 rows[7], nrows[7];
    if (ufirst < uend) ssd_prep_load(rows, XBC, ufirst, ch8, tr);
    for (int u = ufirst; u < uend; u += ustride) {
        const int bc = u / 48, cblk = u % 48; const int t0 = bc * 128; const int ch0 = cblk * 128 + ch8 * 8;
        if (u + ustride < uend) ssd_prep_load(nrows, XBC, u + ustride, ch8, tr);
        float w[4][8], bb[8];
        { const f32x4 b0 = *(const f32x4*)(cb + ch0), b1 = *(const f32x4*)(cb + ch0 + 4);
#pragma unroll
          for (int e = 0; e < 4; ++e) { bb[e] = b0[e]; bb[4 + e] = b1[e]; }
#pragma unroll
          for (int k = 0; k < 4; ++k) { const f32x4 w0 = *(const f32x4*)(cw + (size_t)k * SSDCONV + ch0), w1 = *(const f32x4*)(cw + (size_t)k * SSDCONV + ch0 + 4);
#pragma unroll
              for (int e = 0; e < 4; ++e) { w[k][e] = w0[e]; w[k][4 + e] = w1[e]; } } }
        u32x4 ov[4];
#pragma unroll
        for (int i = 0; i < 4; ++i) { float o[8];
#pragma unroll
            for (int e = 0; e < 8; ++e) { float a = bb[e];
#pragma unroll
                for (int k = 0; k < 4; ++k) { const unsigned wd = rows[i + k][e >> 1]; a += w[k][e] * ((e & 1) ? bfhi(wd) : bflo(wd)); }
                o[e] = siluf(a); }
            u32x4 pk; pk.x = cvt_pk_bf16(o[0], o[1]); pk.y = cvt_pk_bf16(o[2], o[3]); pk.z = cvt_pk_bf16(o[4], o[5]); pk.w = cvt_pk_bf16(o[6], o[7]);
            if (cblk >= 32) *(u32x4*)(BCN + (size_t)(t0 + 4 * tr + i) * 2048 + (ch0 - 4096)) = pk;
            ov[i] = pk; }
        if (cblk < 40) {
#pragma unroll
            for (int e = 0; e < 8; ++e) { u32x2 w;
                const unsigned a0 = ov[0][e >> 1], a1 = ov[1][e >> 1], a2 = ov[2][e >> 1], a3 = ov[3][e >> 1];
                if (e & 1) { w.x = (a0 >> 16) | (a1 & 0xffff0000u); w.y = (a2 >> 16) | (a3 & 0xffff0000u); } else { w.x = (a0 & 0xffffu) | (a1 << 16); w.y = (a2 & 0xffffu) | (a3 << 16); }
                *(LAS u32x2*)(T + (ch8 * 8 + e) * LP + 8 * ((tr >> 1) ^ ch8) + 4 * (tr & 1)) = w; }
            LDS_SYNC();
#pragma unroll
            for (int i = 0; i < 4; ++i) { const int p = tid + NTHR * i, r = p >> 4, pc = p & 15;
                *(u32x4*)(XBT + ((size_t)bc * 5120 + cblk * 128 + r) * 128 + pc * 8) = *(const LAS u32x4*)(T + r * LP + 8 * (pc ^ (r >> 3))); }
            LDS_SYNC();
        }
#pragma unroll
        for (int i = 0; i < 7; ++i) rows[i] = nrows[i];
    }
    WG_SYNC();
}
__device__ __forceinline__ float ssd_tables(const float* DT, const float* a_log, int t0, int hd, int wid, int lane, LAS float* CUM, LAS float* DTS) {
    const float an = -__expf(a_log[hd]);
    const float d0 = DT[(size_t)(t0 + 2 * lane) * 64 + hd], d1 = DT[(size_t)(t0 + 2 * lane + 1) * 64 + hd];
    const float a0 = d0 * an, a1 = d1 * an; float v = a0 + a1;
#pragma unroll
    for (int o = 1; o < 64; o <<= 1) { const float t = __shfl_up(v, o); if (lane >= o) v += t; }
    CUM[wid * 128 + 2 * lane] = v - a1; CUM[wid * 128 + 2 * lane + 1] = v; DTS[wid * 128 + 2 * lane] = d0; DTS[wid * 128 + 2 * lane + 1] = d1;
    return __shfl(v, 63);
}
__device__ __forceinline__ void ssd1_units(const int tid, LAS unsigned char* lds, int G, int cu, const bf16* XBT, const float* DT, const float* a_log, bf16* ST, float* DEC) {
    const int wid = __builtin_amdgcn_readfirstlane(tid >> 6), lane = tid & 63, q = lane >> 4, c16 = lane & 15;
    LAS bf16* BT = (LAS bf16*)(lds);
    LAS float* CUM = (LAS float*)(lds + 34816);
    LAS float* DTS = (LAS float*)(lds + 38912);
    for (int u = cu; u < 1024; u += G) {
        const int bc = u >> 3, g = u & 7, t0 = bc * 128, hd = g * 8 + wid;
#pragma unroll
        for (int i = 0; i < 4; ++i) { const int p = tid + NTHR * i, r = p >> 4, pc = p & 15;
            *(LAS u32x4*)(BT + r * LP + pc * 8) = *(const u32x4*)(XBT + ((size_t)bc * 5120 + 4096 + g * 128 + r) * 128 + pc * 8); }
        const float last = ssd_tables(DT, a_log, t0, hd, wid, lane, CUM, DTS);
        if (lane == 0) DEC[bc * 64 + hd] = __expf(last);
        u32x4 xr[4][4];
#pragma unroll
        for (int pb = 0; pb < 4; ++pb)
#pragma unroll
            for (int ks = 0; ks < 4; ++ks) xr[pb][ks] = *(const u32x4*)(XBT + ((size_t)bc * 5120 + hd * 64 + 16 * pb + c16) * 128 + 32 * ks + 8 * q);
        WG_SYNC();
        bf16x8 xf[4][4];
#pragma unroll
        for (int ks = 0; ks < 4; ++ks) { float sc[8];
#pragma unroll
            for (int j = 0; j < 8; ++j) { const int s = 32 * ks + 8 * q + j; sc[j] = DTS[wid * 128 + s] * __expf(last - CUM[wid * 128 + s]); }
#pragma unroll
            for (int pb = 0; pb < 4; ++pb) { u32x4 o;
#pragma unroll
                for (int e = 0; e < 4; ++e) o[e] = cvt_pk_bf16(bflo(xr[pb][ks][e]) * sc[2 * e], bfhi(xr[pb][ks][e]) * sc[2 * e + 1]);
                xf[pb][ks] = __builtin_bit_cast(bf16x8, o); } }
#pragma unroll
        for (int nb = 0; nb < 8; ++nb) { bf16x8 bf[4];
#pragma unroll
            for (int ks = 0; ks < 4; ++ks) bf[ks] = lds_frag(BT, 16 * nb + c16, LP, 32 * ks + 8 * q);
#pragma unroll
            for (int pb = 0; pb < 4; ++pb) { f32x4 acc = (f32x4){0.f, 0.f, 0.f, 0.f};
#pragma unroll
                for (int ks = 0; ks < 4; ++ks) acc = MFMA16(bf[ks], xf[pb][ks], acc);
                *(u32x2*)(ST + (((size_t)bc * 64 + hd) * 64 + 16 * pb + c16) * 128 + 16 * nb + 4 * q) = pack4(acc); } }
        WG_SYNC();
    }
}
__device__ __forceinline__ void ssd2_scan(const int tid, int G, int cu, bf16* ST, const float* DEC) {
    for (int task = cu * NTHR + tid; task < NB * 4096 * 32; task += G * NTHR) {
        const int b = task >> 17, r = task & 131071, hp = r >> 5, n4 = (r & 31) * 4, hd = hp >> 6; f32x4 S = (f32x4){0.f, 0.f, 0.f, 0.f};
        bf16* p0 = ST + ((size_t)(b * 32) * 4096 + hp) * 128 + n4; const float* d0 = DEC + (b * 32) * 64 + hd;
        u32x2 L[32]; float d[32];
#pragma unroll
        for (int c = 0; c < 32; ++c) { L[c] = *(const u32x2*)(p0 + (size_t)c * 4096 * 128); d[c] = d0[c * 64]; }
#pragma unroll
        for (int c = 0; c < 32; ++c) { *(u32x2*)(p0 + (size_t)c * 4096 * 128) = pack4(S);
            S[0] = d[c] * S[0] + bflo(L[c].x); S[1] = d[c] * S[1] + bfhi(L[c].x); S[2] = d[c] * S[2] + bflo(L[c].y); S[3] = d[c] * S[3] + bfhi(L[c].y); }
    }
}
__device__ __forceinline__ void ssd3_units(const int tid, LAS unsigned char* lds, int G, int cu, const bf16* XBT, const bf16* BCN, const bf16* ST, const float* DT, const float* a_log, const float* dskip,
                                           const bf16* Z, const float* normw, bf16* Y) {
    const int wid = __builtin_amdgcn_readfirstlane(tid >> 6), lane = tid & 63, q = lane >> 4, c16 = lane & 15;
    LAS bf16* CN = (LAS bf16*)(lds);
    LAS bf16* BN = (LAS bf16*)(lds + 34816);
    LAS bf16* CB = (LAS bf16*)(lds + 69632);
    LAS float* CUM = (LAS float*)(lds + 104448);
    LAS float* DTS = (LAS float*)(lds + 108544);
    LAS float* SQP = (LAS float*)(lds + 112640);
    for (int u = cu; u < 1024; u += G) {
        const int bc = u >> 3, g = u & 7, t0 = bc * 128, hd = g * 8 + wid;
#pragma unroll
        for (int i = 0; i < 4; ++i) { const int p = tid + NTHR * i, r = p >> 4, pc = p & 15; const bf16* src = BCN + (size_t)(t0 + r) * 2048 + g * 128 + pc * 8;
            *(LAS u32x4*)(BN + r * LP + pc * 8) = *(const u32x4*)src; *(LAS u32x4*)(CN + r * LP + pc * 8) = *(const u32x4*)(src + 1024); }
        (void)ssd_tables(DT, a_log, t0, hd, wid, lane, CUM, DTS);
        bf16x8 sf[4][4];
        const bf16* xb = XBT + ((size_t)bc * 5120 + hd * 64 + c16) * 128 + 8 * q;
        { const bf16* sb = ST + (((size_t)bc * 64 + hd) * 64 + c16) * 128 + 8 * q;
#pragma unroll
          for (int pb = 0; pb < 4; ++pb)
#pragma unroll
              for (int ks = 0; ks < 4; ++ks) sf[pb][ks] = *(const bf16x8*)(sb + (size_t)(16 * pb) * 128 + 32 * ks); }
        WG_SYNC();
        {
            bf16x8 cf[4];
#pragma unroll
            for (int ks = 0; ks < 4; ++ks) cf[ks] = lds_frag(CN, 16 * wid + c16, LP, 32 * ks + 8 * q);
#pragma unroll
            for (int sb = 0; sb < 8; ++sb) { if (sb > wid + 1) continue; f32x4 acc = (f32x4){0.f, 0.f, 0.f, 0.f};
#pragma unroll
                for (int ks = 0; ks < 4; ++ks) acc = MFMA16(lds_frag(BN, 16 * sb + c16, LP, 32 * ks + 8 * q), cf[ks], acc);
                *(LAS u32x2*)(CB + (16 * wid + c16) * LP + 16 * sb + 4 * q) = pack4(acc); }
        }
        WG_SYNC();
        const float dsk = dskip[hd];
        bf16* ybase = Y + (size_t)t0 * SSDIN + hd * 64 + 4 * q; const bf16* zbase = Z + (size_t)t0 * SSDIN + hd * 64 + 4 * q;
        const f32x4 nw0 = *(const f32x4*)(normw + hd * 64 + 4 * q), nw1 = *(const f32x4*)(normw + hd * 64 + 16 + 4 * q), nw2 = *(const f32x4*)(normw + hd * 64 + 32 + 4 * q), nw3 = *(const f32x4*)(normw + hd * 64 + 48 + 4 * q);
#pragma unroll 1
        for (int tp = 0; tp < 8; ++tp) {
        u32x2 yk[1][4];
#pragma unroll
        for (int tt = 0; tt < 1; ++tt) { const int tb = tp;
            const int tl = 16 * tb + c16; const float cumt = CUM[wid * 128 + tl], ect = __expf(cumt);
            f32x4 acc[4];
            { bf16x8 cf[4];
#pragma unroll
              for (int ks = 0; ks < 4; ++ks) cf[ks] = lds_frag(CN, tl, LP, 32 * ks + 8 * q);
#pragma unroll
              for (int pb = 0; pb < 4; ++pb) { acc[pb] = (f32x4){0.f, 0.f, 0.f, 0.f};
#pragma unroll
                  for (int ks = 0; ks < 4; ++ks) acc[pb] = MFMA16(sf[pb][ks], cf[ks], acc[pb]);
                  acc[pb] = acc[pb] * ect; } }
#pragma unroll
            for (int ks = 0; ks < 4; ++ks) { if (32 * ks > 16 * tb + 15) continue;
                const int s0 = 32 * ks + 8 * q; const u32x4 cbw = *(const LAS u32x4*)(CB + tl * LP + s0);
                const f32x4 c0 = *(const LAS f32x4*)(CUM + wid * 128 + s0), c1 = *(const LAS f32x4*)(CUM + wid * 128 + s0 + 4), d0 = *(const LAS f32x4*)(DTS + wid * 128 + s0), d1 = *(const LAS f32x4*)(DTS + wid * 128 + s0 + 4);
                float gv[8];
#pragma unroll
                for (int j = 0; j < 8; ++j) { const int s = s0 + j; const float cb = (j & 1) ? bfhi(cbw[j >> 1]) : bflo(cbw[j >> 1]); const float cs = j < 4 ? c0[j & 3] : c1[j & 3], ds = j < 4 ? d0[j & 3] : d1[j & 3];
                    float v = cb * __expf(fminf(cumt - cs, 0.f)) * ds; v = (s <= tl) ? v : 0.f; gv[j] = (s == tl) ? v + dsk : v; }
                u32x4 gw; gw.x = cvt_pk_bf16(gv[0], gv[1]); gw.y = cvt_pk_bf16(gv[2], gv[3]); gw.z = cvt_pk_bf16(gv[4], gv[5]); gw.w = cvt_pk_bf16(gv[6], gv[7]);
                const bf16x8 gf = __builtin_bit_cast(bf16x8, gw);
#pragma unroll
                for (int pb = 0; pb < 4; ++pb) acc[pb] = MFMA16(*(const bf16x8*)(xb + (size_t)(16 * pb) * 128 + 32 * ks), gf, acc[pb]);
            }
            float sq = 0.f;
#pragma unroll
            for (int pb = 0; pb < 4; ++pb) { const u32x2 zw = *(const u32x2*)(zbase + (size_t)tl * SSDIN + 16 * pb);
                f32x4 y; y[0] = acc[pb][0] * bflo(zw.x); y[1] = acc[pb][1] * bfhi(zw.x); y[2] = acc[pb][2] * bflo(zw.y); y[3] = acc[pb][3] * bfhi(zw.y);
                sq += (y[0] * y[0] + y[1] * y[1]) + (y[2] * y[2] + y[3] * y[3]); yk[tt][pb] = pack4(y); }
            sq += __shfl_xor(sq, 16); sq += __shfl_xor(sq, 32);
            if (q == 0) SQP[tl * 8 + wid] = sq;
        }
        WG_SYNC();
#pragma unroll
        for (int tt = 0; tt < 1; ++tt) { const int tl = 16 * tp + c16; const f32x4 s0 = *(const LAS f32x4*)(SQP + tl * 8), s1 = *(const LAS f32x4*)(SQP + tl * 8 + 4);
            const float rstd = rsqrtf((((s0[0] + s0[1]) + (s0[2] + s0[3])) + ((s1[0] + s1[1]) + (s1[2] + s1[3]))) * (1.0f / 512.f) + EPS);
#pragma unroll
            for (int pb = 0; pb < 4; ++pb) { bf16* yp = ybase + (size_t)tl * SSDIN + 16 * pb; const u32x2 w = yk[tt][pb]; const f32x4 nw = pb == 0 ? nw0 : pb == 1 ? nw1 : pb == 2 ? nw2 : nw3;
                f32x4 y; y[0] = bflo(w.x) * rstd * nw[0]; y[1] = bfhi(w.x) * rstd * nw[1]; y[2] = bflo(w.y) * rstd * nw[2]; y[3] = bfhi(w.y) * rstd * nw[3];
                *(u32x2*)yp = pack4(y); } }
        }
        WG_SYNC();
    }
}
#ifndef REP_GEMM
#define REP_GEMM 1
#endif
#if REP_GEMM == 2
#define GEMM_REP(...) { __VA_ARGS__ } { __VA_ARGS__ }
#else
#define GEMM_REP(...) { __VA_ARGS__ }
#endif
#ifndef REP_MIX
#define REP_MIX 1
#endif
#ifndef REP_CONV
#define REP_CONV 1
#endif
struct Args { In in; float* out; unsigned char* ws; int ph_lo, ph_hi; };
static_assert(sizeof(Args) == 32 * 8 + 8 + 8 + 8, "Args has no padding");
typedef const Args __attribute__((address_space(4))) CArgs;

#ifndef SLEEP_MASK
#define SLEEP_MASK 0ull
#endif
#define SLEEP_AMP 4
#define PHASE_BEGIN if (pc >= lo && pc < hi) { const unsigned long long t0_ = SLEEP_MASK ? __builtin_amdgcn_s_memrealtime() : 0ull; (void)t0_; int tid = wave0 * 64 + (int)__builtin_amdgcn_mbcnt_hi(~0u, __builtin_amdgcn_mbcnt_lo(~0u, 0u)); asm volatile("" : "+v"(tid)); int cu = blockIdx.x; asm volatile("" : "+s"(cu)); int G = gridDim.x; asm volatile("" : "+s"(G)); \
        const int lane = tid & 63, wave = __builtin_amdgcn_readfirstlane(tid >> 6), gw = cu * NWAVES + wave, NGW = G * NWAVES; (void)lane; (void)gw; (void)NGW; \
        CArgs* ap = (CArgs*)__builtin_amdgcn_kernarg_segment_ptr(); asm volatile("" : "+s"(ap)); CIn& I = ap->in; unsigned char* const ws = ap->ws; float* const xres = ap->out; \
        unsigned char* const act = ws + WS_ACT; float* const SS = (float*)(ws + WS_SS); bf16* const XB = (bf16*)(ws + WS_XB); bf16* const WL = (bf16*)(ws + WS_WL); (void)I; (void)xres; (void)act; (void)SS; (void)XB; (void)WL;
#if MK_SPLIT
#define PHASE_END } ++pc;
#else
#define PHASE_END if (pc + 1 < hi) xcd_barrier(bar); if (SLEEP_MASK && ((SLEEP_MASK >> pc) & 1ull)) { const unsigned long long t1_ = __builtin_amdgcn_s_memrealtime(), until_ = t1_ + SLEEP_AMP * (t1_ - t0_); while (__builtin_amdgcn_s_memrealtime() < until_) __builtin_amdgcn_s_sleep(8); } } ++pc;
#endif
#define PHASE_END_LOCAL } ++pc;
#define D_WKV ((bf16*)(ws + WS_WKV))
#define D_KMAT ((bf16*)(ws + WS_KMAT))
#define D_VT ((bf16*)(ws + WS_VT))
#define D_MEMN ((bf16*)(ws + WS_MEMN))
#define D_LB ((float*)(ws + WS_TAB + TAB_LB))
#define D_WRT ((bf16*)(ws + WS_TAB + TAB_WRT))


template <int l>
__device__ __forceinline__ void layer_body(LAS unsigned char* lds, const int wave0, const int lo, const int hi, int& pc, const XcdBarrier& bar) {
    int ssi = 3 * l;

        if (l > 0) {
            PHASE_BEGIN
                int rot = 0; for (int rep_ = 0; rep_ < REP_CONV; ++rep_) { convert_layer(I, l, WL, (LAS float*)(lds + wave * 16640), gw, NGW, lane, rot); }
            PHASE_END
        }
        const int e = l >> 1;
        int mixK;
        if ((l & 1) == 0) {
#define PROJ ((bf16*)(act + A_PROJ))
#define LOGF ((float*)(act + A_LOGF))
#define HST ((bf16*)(act + A_HST))
#define YAB ((bf16*)(act + A_YAB))
#define SEG ((float*)(act + A_SEG))
#define HDEC ((float*)(act + A_HDEC))
            PHASE_BEGIN
                if (l == 0) { pg8::SchedKV S{(const char*)D_MEMN, (const char*)D_WKV, G, cu}; pg8::EpiKV E{D_KMAT, D_VT}; pg8::gemm_phase(tid, lds, D, D, D, S, E); asm volatile("" : "+v"(tid)); }
                GEMM_REP(pg8::SchedMN S; S.init(XB, D, WL + WL_IN, D, M, ABIN, G, cu); pg8::EpiProjEven E{SS + (size_t)ssi * M * 8, PROJ, LOGF, D_LB + e * 1024};
                pg8::gemm_phase<RF16>(tid, lds, D, D, D, S, E);)
            PHASE_END
            PHASE_BEGIN
                for (int rep_ = 0; rep_ < REP_MIX; ++rep_) { lru_units<false>(tid, lds, G, cu, PROJ, D_WRT + (size_t)e * 2 * 8 * 16384, I.lru_conv_w + e * 4 * LRUW, I.lru_conv_b + e * LRUW, I.lru_b_r + e * LRUW, I.lru_b_i + e * LRUW, I.lru_lambda + e * LRUW, SEG, YAB);
                hgrn1_units(tid, lds, G, cu, LOGF, PROJ, HST, HDEC); }
            PHASE_END
            PHASE_BEGIN
                for (int rep_ = 0; rep_ < REP_MIX; ++rep_) { lru_units<true>(tid, lds, G, cu, PROJ, D_WRT + (size_t)e * 2 * 8 * 16384, I.lru_conv_w + e * 4 * LRUW, I.lru_conv_b + e * LRUW, I.lru_b_r + e * LRUW, I.lru_b_i + e * LRUW, I.lru_lambda + e * LRUW, SEG, YAB); }
                hgrn2_scan(tid, G, cu, HST, HDEC);
            PHASE_END
            PHASE_BEGIN
                for (int rep_ = 0; rep_ < REP_MIX; ++rep_) { hgrn3_units(tid, lds, G, cu, LOGF, PROJ, HST, I.hgrn_norm + e * 1024, YAB); }
            PHASE_END
            mixK = D;
        } else {
#define Zb ((bf16*)(act + A_Z))
#define XBC ((bf16*)(act + A_XBC))
#define XBT ((bf16*)(act + A_XBT))
#define BCN ((bf16*)(act + A_BCN))
#define STb ((bf16*)(act + A_ST))
#define DTb ((float*)(act + A_DT))
#define DEC ((float*)(act + A_DEC))
#define Yb ((bf16*)(act + A_Y))
            PHASE_BEGIN
                GEMM_REP(pg8::SchedMN S; S.init(XB, D, WL + WL_IN, D, M, SSDN1, G, cu); pg8::EpiProjOdd E{SS + (size_t)ssi * M * 8, Zb, XBC};
                pg8::gemm_phase<RF16>(tid, lds, D, D, D, S, E);)
            PHASE_END
            PHASE_BEGIN
                for (int rep_ = 0; rep_ < REP_MIX; ++rep_) {
                { pg8::SchedDt S{(const char*)XB, (const char*)(WL + WL_DT), cu}; pg8::EpiDt E{SS + (size_t)ssi * M * 8, I.ssd_dt_bias + e * 64, DTb};
                  pg8::gemm_phase<RF16>(tid, lds, D, D, D, S, E); }
                { int uf = cu, us = G, ue = 6144; if (G == 256) { if (cu < 64) { us = 64; ue = 1152; } else { uf = 1152 + (cu - 64); us = 192; } }
                  ssd_prep_units(tid, lds, uf, us, ue, XBC, I.ssd_conv_w + (size_t)e * 4 * SSDCONV, I.ssd_conv_b + e * SSDCONV, XBT, BCN); }
                }
            PHASE_END
            PHASE_BEGIN
                for (int rep_ = 0; rep_ < REP_MIX; ++rep_) { ssd1_units(tid, lds, G, cu, XBT, DTb, I.ssd_a_log + e * 64, STb, DEC); }
            PHASE_END
            PHASE_BEGIN
                ssd2_scan(tid, G, cu, STb, DEC);
            PHASE_END
            PHASE_BEGIN
                for (int rep_ = 0; rep_ < REP_MIX; ++rep_) { ssd3_units(tid, lds, G, cu, XBT, BCN, STb, DTb, I.ssd_a_log + e * 64, I.ssd_d + e * 64, Zb, I.ssd_norm + e * SSDIN, Yb); }
            PHASE_END
            mixK = SSDIN;
        }
        PHASE_BEGIN
            pg8::SchedMN S; S.init(mixK == D ? (const bf16*)YAB : (const bf16*)Yb, mixK, WL + WL_OUT, mixK, M, D, G, cu); pg8::EpiResid E{XB, SS + (size_t)(ssi + 1) * M * 8, (LAS float*)(lds + EPI_OFF)};
            pg8::gemm_phase(tid, lds, mixK, mixK, mixK, S, E);
        PHASE_END
        ++ssi;
#define Qb ((bf16*)(act + A_Q))
#define Pb ((bf16*)(act + A_P))
#define Ob ((bf16*)(act + A_O))
#define Hb ((bf16*)(act + A_H))
        PHASE_BEGIN
            if (cu < 256) { const int pm = (cu & 7) * 8 + (cu >> 5), h = (cu >> 3) & 3;     int nu = 2; asm volatile("" : "+s"(nu));
                pg8::SchedChainQ S{(const char*)XB, (const char*)(WL + WL_Q), pm, h, nu}; pg8::EpiQ E{SS + (size_t)ssi * M * 8, Qb, 0.044194173824159216f}; pg8::gemm_phase<RF16>(tid, lds, D, D, D, S, E); }
        PHASE_END_LOCAL
        PHASE_BEGIN
            if (cu < 256) { const int pm = (cu & 7) * 8 + (cu >> 5), h = (cu >> 3) & 3;     int nu = 1, kk = XAD; asm volatile("" : "+s"(nu), "+s"(kk));
                pg8::SchedChainS S{(const char*)Qb, (const char*)(D_KMAT + (size_t)l * MEMROWS * D), pm, h, nu}; pg8::EpiSoftmax E{Pb, (LAS float*)(lds + EPI_OFF)}; pg8::gemm_phase(tid, lds, kk, D, D, S, E); }
        PHASE_END_LOCAL
        PHASE_BEGIN
            if (cu < 256) { const int pm = (cu & 7) * 8 + (cu >> 5), h = (cu >> 3) & 3;     int nu = 2, kk = MEMLEN; asm volatile("" : "+s"(nu), "+s"(kk));
                pg8::SchedChainPV S{(const char*)Pb, (const char*)(D_VT + (size_t)l * D * MEMROWS), pm, h, nu}; pg8::EpiPlain E{Ob, D}; pg8::gemm_phase(tid, lds, kk, 1024, MEMROWS, S, E); }
        PHASE_END
        PHASE_BEGIN
            pg8::SchedMN S; S.init(Ob, D, WL + WL_O, D, M, D, G, cu); pg8::EpiResid E{XB, SS + (size_t)(ssi + 1) * M * 8, (LAS float*)(lds + EPI_OFF)};
            pg8::gemm_phase(tid, lds, D, D, D, S, E);
        PHASE_END
        ++ssi;
        PHASE_BEGIN
            GEMM_REP(pg8::SchedMN S; S.init(XB, D, WL + WL_GU, D, M, 2 * FF, G, cu); pg8::EpiGateUp E{SS + (size_t)ssi * M * 8, Hb};
            pg8::gemm_phase<RF16>(tid, lds, D, D, D, S, E);)
        PHASE_END
        PHASE_BEGIN
            pg8::SchedMN S; S.init(Hb, FF, WL + WL_DN, FF, M, D, G, cu); pg8::EpiResid E{XB, SS + (size_t)(ssi + 1) * M * 8, (LAS float*)(lds + EPI_OFF)};
            pg8::gemm_phase(tid, lds, FF, FF, FF, S, E);
        PHASE_END
        ++ssi;
    }

__global__ void __launch_bounds__(NTHR, 2) fwd(Args args) {
    extern __shared__ __attribute__((aligned(16))) unsigned char lds_raw[];
    LAS unsigned char* lds = (LAS unsigned char*)lds_raw;
    volatile LAS unsigned* MISC = (volatile LAS unsigned*)(lds + MISC_OFF);
    const int wave0 = __builtin_amdgcn_readfirstlane((int)threadIdx.x >> 6);
    if (threadIdx.x < 64) MISC[threadIdx.x] = 0u;
    __syncthreads();
#if !MK_SPLIT
    XcdBarrier bar = xcd_barrier_post((unsigned*)(args.ws + WS_CTL), MISC + 8);
#else
    XcdBarrier bar; bar.bar = nullptr; bar.x = 0; bar.st = nullptr;
#endif
    const int lo = args.ph_lo, hi = args.ph_hi; int pc = 0;
    PHASE_BEGIN
        LAS float* scr = (LAS float*)(lds + wave * 16640);
        int rot = 0;
        for (int l = 0; l < DEPTH; ++l) conv_matrix<0>(I.xa_w_kv + (size_t)l * D * 4096, 4096, D, 0, 4096, nullptr, D_WKV + (size_t)l * 4096 * D, 0, scr, gw, NGW, lane, rot);
        for (int rep_ = 0; rep_ < REP_CONV; ++rep_) convert_layer(I, 0, WL, scr, gw, NGW, lane, rot);
        for (int m = gw; m < MEMROWS; m += NGW) {
            const f32x4* xr = (const f32x4*)(I.mem + (size_t)m * D); f32x4 v[8]; float s = 0.f;
#pragma unroll
            for (int j = 0; j < 8; ++j) { v[j] = xr[64 * j + lane]; s += (v[j][0] * v[j][0] + v[j][1] * v[j][1]) + (v[j][2] * v[j][2] + v[j][3] * v[j][3]); }
            const float rs = rsqrtf(wave_sum(s) * (1.0f / D) + EPS);
#pragma unroll
            for (int j = 0; j < 8; ++j) { const f32x4 g = *(const f32x4*)(I.norm_mem + (64 * j + lane) * 4); *(u32x2*)(D_MEMN + (size_t)m * D + (64 * j + lane) * 4) = pack4(v[j] * rs * g); }
        }
        for (int m = gw; m < M; m += NGW) {
            const f32x4* xr = (const f32x4*)(I.x + (size_t)m * D); float s = 0.f;
#pragma unroll
            for (int j = 0; j < 8; ++j) { const f32x4 v = xr[64 * j + lane]; s += (v[0] * v[0] + v[1] * v[1]) + (v[2] * v[2] + v[3] * v[3]); u32x2 w; w.x = rs_pk(v[0], v[1]); w.y = rs_pk(v[2], v[3]); *(u32x2*)(XB + (size_t)m * D + (64 * j + lane) * 4) = w; }
            s = wave_sum(s); if (lane < 8) SS[(size_t)m * 8 + lane] = lane == 0 ? s : 0.f;
        }
        for (int i = cu * NTHR + tid; i < 1024; i += G * NTHR) {
            const float a = I.hgrn_lb[i], b = I.hgrn_lb[1024 + i], mx = fmaxf(a, b), e0 = __expf(a - mx), e1 = __expf(b - mx); D_LB[i] = 0.f; D_LB[1024 + i] = e1 / (e0 + e1); }
        for (int i = cu * NTHR + tid; i < 2 * 2 * 8 * 16384; i += G * NTHR) {
            const int ii = i & 127, jj = (i >> 7) & 127, blk = (i >> 14) & 7, gt = (i >> 17) & 1, e = i >> 18;
            const float* src = gt ? I.lru_w_i : I.lru_w_r; D_WRT[i] = (bf16)f2bf(src[((size_t)(e * 8 + blk) * 128 + ii) * 128 + jj]); }
    PHASE_END

    layer_body<0>(lds, wave0, lo, hi, pc, bar); layer_body<1>(lds, wave0, lo, hi, pc, bar); layer_body<2>(lds, wave0, lo, hi, pc, bar); layer_body<3>(lds, wave0, lo, hi, pc, bar);
    const int ssi = 12;
    PHASE_BEGIN
        const float* ssf = SS + (size_t)ssi * M * 8;
        for (int m = gw; m < M; m += NGW) { f32x4* row = (f32x4*)(xres + (size_t)m * D); const u32x2* xr = (const u32x2*)(XB + (size_t)m * D); const float rs = pg8::rstd_of(ssf, m);
#pragma unroll
            for (int j = 0; j < 8; ++j) { const f32x4 g = *(const f32x4*)(I.norm_final + (64 * j + lane) * 4); const u32x2 w = xr[64 * j + lane];
                f32x4 o; o[0] = rs_lo(w.x) * rs * g[0]; o[1] = rs_hi(w.x) * rs * g[1]; o[2] = rs_lo(w.y) * rs * g[2]; o[3] = rs_hi(w.y) * rs * g[3]; row[64 * j + lane] = o; } }
    PHASE_END
#undef PHASE_BEGIN
#undef PHASE_END
}

constexpr int NPHASES = 1 + (5 + 6) + (1 + 6 + 6) + (1 + 5 + 6) + (1 + 6 + 6) + 1;

extern "C" void kernel_launch(void* const* d_in, const int* in_sizes, int n_in, void* d_out, int out_size, void* d_ws, size_t ws_size, hipStream_t stream) {
    static int grid = 0;
    if (grid == 0) {
        if (n_in != 32 || out_size != M * D || ws_size < WS_END) { fprintf(stderr, "kernel_launch: unexpected problem (n_in %d, out %d, ws %zu)\n", n_in, out_size, ws_size); grid = -1; return; }
        int dev = 0, cus = 0;
        if (hipGetDevice(&dev) != hipSuccess || hipDeviceGetAttribute(&cus, hipDeviceAttributeMultiprocessorCount, dev) != hipSuccess) { grid = -1; return; }
        if (hipFuncSetAttribute((const void*)fwd, hipFuncAttributeMaxDynamicSharedMemorySize, LDS_BYTES) != hipSuccess) { fprintf(stderr, "kernel_launch: hipFuncSetAttribute failed\n"); grid = -1; return; }
        int per_cu = 0;
        if (hipOccupancyMaxActiveBlocksPerMultiprocessor(&per_cu, (const void*)fwd, NTHR, LDS_BYTES) != hipSuccess || per_cu < 1) fprintf(stderr, "kernel_launch: occupancy query says %d\n", per_cu);
        (void)hipGetLastError();
        if (cus != 256) { fprintf(stderr, "kernel_launch: built for a 256-CU device (got %d)\n", cus); grid = -1; return; }
        grid = cus;
    }
    if (grid < 0) return;
    (void)hipMemsetAsync((char*)d_ws + WS_CTL, 0, CTL_ZERO_BYTES, stream);
    Args a{};
    const float** ip = (const float**)&a.in;
    for (int i = 0; i < 32; ++i) ip[i] = (const float*)d_in[i];
    a.out = (float*)d_out; a.ws = (unsigned char*)d_ws;
#if MK_SPLIT
#ifndef PROBE_MASK
#define PROBE_MASK 0ull
#endif
    for (int li = 0; li < NPHASES; ++li) { a.ph_lo = li; a.ph_hi = li + 1; hipLaunchKernelGGL(fwd, dim3(grid), dim3(NTHR), LDS_BYTES, stream, a);
        if ((PROBE_MASK >> li) & 1ull) hipLaunchKernelGGL(fwd, dim3(grid), dim3(NTHR), LDS_BYTES, stream, a); }
#else
    a.ph_lo = 0; a.ph_hi = NPHASES;
    hipLaunchKernelGGL(fwd, dim3(grid), dim3(NTHR), LDS_BYTES, stream, a);
#endif
}
```

```cpp
#include <hip/hip_runtime.h>
#include <cstdio>
#include <cstdint>

#ifndef MK_SPLIT
#define MK_SPLIT 0
#endif

#ifndef RESID_F16
#define RESID_F16 0
#endif
constexpr bool RF16 = RESID_F16 != 0;
#define GAS __attribute__((address_space(1)))
#define LAS __attribute__((address_space(3)))
typedef unsigned short bf16;
typedef short bf16x8 __attribute__((ext_vector_type(8)));
typedef float f32x4 __attribute__((ext_vector_type(4)));
typedef float f32x2 __attribute__((ext_vector_type(2)));
typedef unsigned u32x4 __attribute__((ext_vector_type(4)));
typedef unsigned u32x2 __attribute__((ext_vector_type(2)));

constexpr int D = 2048, NB = 4, SEQ = 4096, M = NB * SEQ, DEPTH = 4, MEMLEN = 256, MEMROWS = NB * MEMLEN;
constexpr int LRUW = 1024, ABIN = 6144;
constexpr int SSDIN = 4096, SSDCONV = 6144, SSDPROJ = 10304, SSDN1 = 10240, NHEADS = 64;
constexpr int XAD = 512, FF = 5632;
constexpr float EPS = 1e-6f;
constexpr int NWAVES = 8, NTHR = 512;

constexpr size_t MiB = 1u << 20;
constexpr size_t WS_CTL = 0, CTL_ZERO_BYTES = 1 * MiB;
constexpr size_t WS_WKV = 2 * MiB;
constexpr size_t WS_KMAT = 66 * MiB;
constexpr size_t WS_VT = 82 * MiB;
constexpr size_t WS_MEMN = 98 * MiB;
constexpr size_t WS_TAB = 102 * MiB;
constexpr size_t WS_XB = 106 * MiB;
constexpr size_t WS_WL = 170 * MiB;
constexpr size_t WS_ACT = 310 * MiB;
constexpr size_t WS_SS = (310 + 680) * MiB;
constexpr size_t WS_END = (310 + 680 + 8) * MiB;
constexpr size_t TAB_LB = 0;
constexpr size_t TAB_WRT = 64 * 1024;
constexpr size_t WL_IN = 0;
constexpr size_t WL_DT = (size_t)SSDN1 * D;
constexpr size_t WL_OUT = (size_t)(SSDN1 + 256) * D;
constexpr size_t WL_Q = WL_OUT + (size_t)D * SSDIN;
constexpr size_t WL_O = WL_Q + (size_t)D * D;
constexpr size_t WL_GU = WL_O + (size_t)D * D;
constexpr size_t WL_DN = WL_GU + (size_t)2 * FF * D;
constexpr size_t WL_ELEMS = WL_DN + (size_t)D * FF;
static_assert(WL_ELEMS * 2 <= 140 * MiB, "per-layer weights");
constexpr size_t A_Z = 0;
constexpr size_t A_XBC = 128 * MiB;
constexpr size_t A_Y = 128 * MiB;
constexpr size_t A_XBT = 320 * MiB;
constexpr size_t A_BCN = 480 * MiB;
constexpr size_t A_ST = 544 * MiB;
constexpr size_t A_DT = 672 * MiB;
constexpr size_t A_DEC = 676 * MiB;
constexpr size_t A_PROJ = 0;
constexpr size_t A_LOGF = 192 * MiB;
constexpr size_t A_HST = 256 * MiB;
constexpr size_t A_YAB = 320 * MiB;
constexpr size_t A_SEG = 384 * MiB;
constexpr size_t A_HDEC = 386 * MiB;
constexpr size_t A_Q = 0;
constexpr size_t A_P = 64 * MiB;
constexpr size_t A_O = 96 * MiB;
constexpr size_t A_H = 160 * MiB;

constexpr int LDS_BYTES = 155648;
constexpr int EPI_OFF = 131072;
constexpr int MISC_OFF = LDS_BYTES - 256;

#define LDS_WAIT() asm volatile("s_waitcnt lgkmcnt(0)" ::: "memory")
#define VM_WAIT() asm volatile("s_waitcnt vmcnt(0)" ::: "memory")
__device__ __forceinline__ unsigned f2bf(float f) { unsigned u = __builtin_bit_cast(unsigned, f); return (u + 0x7fffu + ((u >> 16) & 1u)) >> 16; }
__device__ __forceinline__ unsigned pk2(float lo, float hi) { return f2bf(lo) | (f2bf(hi) << 16); }
typedef __bf16 bf16x2v __attribute__((ext_vector_type(2)));
__device__ __forceinline__ unsigned cvt_pk_bf16(float lo, float hi) { const f32x2 v = {lo, hi}; return __builtin_bit_cast(unsigned, __builtin_convertvector(v, bf16x2v)); }
typedef _Float16 f16x2v __attribute__((ext_vector_type(2)));
typedef _Float16 f16x8 __attribute__((ext_vector_type(8)));
__device__ __forceinline__ unsigned cvt_pk_f16(float lo, float hi) { const f32x2 v = {lo, hi}; return __builtin_bit_cast(unsigned, __builtin_convertvector(v, f16x2v)); }
__device__ __forceinline__ float h16lo(unsigned w) { return (float)__builtin_bit_cast(f16x2v, w)[0]; }
__device__ __forceinline__ float h16hi(unsigned w) { return (float)__builtin_bit_cast(f16x2v, w)[1]; }
__device__ __forceinline__ float bflo(unsigned w) { return __uint_as_float(w << 16); }
__device__ __forceinline__ float bfhi(unsigned w) { return __uint_as_float(w & 0xffff0000u); }
__device__ __forceinline__ unsigned rs_pk(float lo, float hi) { return RF16 ? cvt_pk_f16(lo, hi) : cvt_pk_bf16(lo, hi); }
__device__ __forceinline__ float rs_lo(unsigned w) { return RF16 ? h16lo(w) : bflo(w); }
__device__ __forceinline__ float rs_hi(unsigned w) { return RF16 ? h16hi(w) : bfhi(w); }
__device__ __forceinline__ float bf2f(bf16 b) { return __uint_as_float((unsigned)b << 16); }
__device__ __forceinline__ float sigm(float x) { return __builtin_amdgcn_rcpf(1.f + __expf(-x)); }
__device__ __forceinline__ float siluf(float x) { return x * sigm(x); }
__device__ __forceinline__ float gelu_tanh(float x) { return x * sigm(1.5957691216f * (x + 0.044715f * x * x * x)); }
__device__ __forceinline__ float softplusf(float x) { const float e = __expf(-fabsf(x)); const float l = (e < 0.03f) ? e * (1.f - e * (0.5f - e * 0.33333333f)) : __logf(1.f + e); return fmaxf(x, 0.f) + l; }
__device__ __forceinline__ float wave_sum(float v) {
#pragma unroll
    for (int o = 1; o < 64; o <<= 1) v += __shfl_xor(v, o);
    return v;
}

#define XB_TMO      128
#define XB_XCNT(j)  (256  + 64 * (j))
#define XB_XSUB(j)  (1280 + 64 * (j))
#define XB_XGEN(j)  (2304 + 64 * (j))
#define XB_TOP      3328
#define XB_TOPGEN   3392
#define XCD_BAR_WORDS 3456
#define XB_SPIN_CAP (1u << 18)

__device__ __forceinline__ unsigned xb_ld(unsigned* p)              { return __hip_atomic_load(p, __ATOMIC_RELAXED, __HIP_MEMORY_SCOPE_AGENT); }
__device__ __forceinline__ unsigned xb_add(unsigned* p, unsigned v) { return __hip_atomic_fetch_add(p, v, __ATOMIC_RELAXED, __HIP_MEMORY_SCOPE_AGENT); }
__device__ __forceinline__ unsigned xb_xcc_id() { return (unsigned)__builtin_amdgcn_s_getreg((3 << 11) | 20) & 0xFu; }
#define XB_SPIN(cond, bar) do { unsigned _sp = 0; while (cond) { __builtin_amdgcn_s_sleep(1); \
    if ((++_sp & 255u) == 0u) { if (xb_ld(&(bar)[XB_TMO])) break; if (_sp > XB_SPIN_CAP) { atomicAdd(&(bar)[XB_TMO], 1u); break; } } } } while (0)

struct XcdBarrier {
    unsigned* bar; unsigned x;
    volatile LAS unsigned* st;
};
__device__ __forceinline__ XcdBarrier xcd_barrier_post(unsigned* bar, volatile LAS unsigned* st) {
    XcdBarrier b; b.bar = bar; b.x = xb_xcc_id(); b.st = st;
    if (threadIdx.x == 0) (void)xb_add(&bar[XB_XCNT(b.x)], 1u);
    return b;
}
__device__ __forceinline__ void xcd_barrier_complete(unsigned* bar, unsigned x, unsigned& nloc, unsigned& nx) {
    const unsigned G = gridDim.x * gridDim.y * gridDim.z;
    unsigned sum, cnt, mine, sp = 0u;
    for (;;) {
        sum = 0u; cnt = 0u; mine = 0u;
#pragma unroll
        for (unsigned j = 0; j < 16; ++j) { const unsigned c = xb_ld(&bar[XB_XCNT(j)]); sum += c; cnt += (c > 0u) ? 1u : 0u; mine = (j == x) ? c : mine; }
        if (sum == G) break;
        __builtin_amdgcn_s_sleep(1);
        if ((++sp & 255u) == 0u) { if (xb_ld(&bar[XB_TMO])) break; if (sp > XB_SPIN_CAP) { atomicAdd(&bar[XB_TMO], 1u); break; } }
    }
    nloc = mine > 0u ? mine : 1u; nx = cnt > 0u ? cnt : 1u;
}
__device__ __forceinline__ void xcd_barrier(const XcdBarrier& b) {
    asm volatile("s_waitcnt vmcnt(0)" ::: "memory");
    __syncthreads();
    if (threadIdx.x == 0) {
        unsigned* bar = b.bar;
        __builtin_amdgcn_s_waitcnt(0);
        unsigned nloc = b.st[0], nx = b.st[1];
        if (nloc == 0u) { xcd_barrier_complete(bar, b.x, nloc, nx); b.st[0] = nloc; b.st[1] = nx; }
        const unsigned old = xb_add(&bar[XB_XSUB(b.x)], 1u);
        const unsigned gen = old / nloc;
        if (old + 1u == (gen + 1u) * nloc) {
            __builtin_amdgcn_fence(__ATOMIC_RELEASE, "agent");
            asm volatile("s_waitcnt vmcnt(0)" ::: "memory");
            const unsigned og = xb_add(&bar[XB_TOP], 1u);
            const unsigned tg = og / nx;
            if (og + 1u == (tg + 1u) * nx) xb_add(&bar[XB_TOPGEN], 1u);
            else XB_SPIN(xb_ld(&bar[XB_TOPGEN]) == tg, bar);
            __builtin_amdgcn_fence(__ATOMIC_ACQUIRE, "agent");
            xb_add(&bar[XB_XGEN(b.x)], 1u);
            asm volatile("s_waitcnt vmcnt(0)" ::: "memory");
        } else {
            XB_SPIN(xb_ld(&bar[XB_XGEN(b.x)]) == gen, bar);
            __builtin_amdgcn_fence(__ATOMIC_ACQUIRE, "agent");
            asm volatile("s_waitcnt vmcnt(0)" ::: "memory");
        }
    }
    __syncthreads();
}

namespace pg8 {
constexpr int BM = 256, BK = 64, HALF = 128, HTB = HALF * BK * 2, STAGE_BYTES = 8 * HTB, NXCD = 8, WGM = 8;
__host__ __device__ __forceinline__ int lds_byte(int r, int c) { const int st = (r >> 4) * 2 + (c >> 5), rr = r & 15, cc = c & 31, ob = rr * 64 + cc * 2; return st * 1024 + (ob ^ (((ob >> 9) & 1) << 5)); }
__host__ __device__ __forceinline__ void stage_rc(int b, int& R, int& C) { const int st = b / 1024, sb = b % 1024, swz = sb ^ (((sb >> 9) & 1) << 5); R = (st >> 1) * 16 + swz / 64; C = (st & 1) * 32 + (swz % 64) / 2; }
__host__ __device__ __forceinline__ int perm32(int rho) { const int n = rho >> 4, i = rho & 15; return 8 * (i >> 2) + 4 * n + (i & 3); }

struct Unit { const char* a; const char* b; int orow, ocol, aux; };

__device__ __forceinline__ void glds16_s(const char* base, unsigned voff, unsigned ldsdst) { unsigned keep;
    asm volatile("s_mov_b32 %0, m0\n\ts_mov_b32 m0, %3\n\ts_nop 0\n\tglobal_load_lds_dwordx4 %1, %2\n\ts_mov_b32 m0, %0" : "=&s"(keep) : "v"(voff), "s"(base), "s"(ldsdst) : "memory"); }
template <int N> __device__ __forceinline__ void wait_vm_sel(int flag) {
    asm volatile("s_cmp_lg_u32 %0, 0\n\ts_cbranch_scc1 1\n\ts_waitcnt vmcnt(8)\n\ts_waitcnt vmcnt(%1)" :: "s"(__builtin_amdgcn_readfirstlane(flag)), "n"(N) : "memory", "scc"); }
template <bool F16 = false, bool ALIGN = true, class Epi, class Sched>
__device__ __forceinline__ void gemm_phase(const int tid, LAS unsigned char* lds, const int K, const int lda, const int ldb, const Sched& S, const Epi& E) {
    const int wid = __builtin_amdgcn_readfirstlane(tid >> 6), lane = tid & 63, wr = wid >> 2, wc = wid & 3, fr = lane & 15, fq = lane >> 4;
    const int nt = K / BK;
    unsigned voffA[2], voffB[2];
#pragma unroll
    for (int i = 0; i < 2; ++i) { int R, C; stage_rc(tid * 16 + i * 8192, R, C); const int Rb = (R & ~31) + perm32(R & 31);
        voffA[i] = (unsigned)(R * lda + C) * 2u; voffB[i] = (unsigned)(Rb * ldb + C) * 2u; }
    const size_t kstep = (size_t)(BK * 2);
    const size_t hstepA = (size_t)HALF * lda * 2, hstepB = (size_t)HALF * ldb * 2;
    const unsigned ldsw = (unsigned)wid * 1024u;
    const int aoff = lds_byte(wr * 64 + fr, fq * 8), boff = lds_byte(wc * 32 + fr, fq * 8);
#define PG8_SA(b, h) (((b) * 2 + (h)) * HTB)
#define PG8_SB(b, h) ((4 + (b) * 2 + (h)) * HTB)
#define PG8_STAGE(bufoff, gbase, voff) do { _Pragma("unroll") for (int _i = 0; _i < 2; ++_i) \
        __builtin_amdgcn_global_load_lds((const unsigned*)((const char*)(gbase) + (voff)[_i]), (LAS unsigned*)(lds + (bufoff) + ldsw + _i * 8192), 16, 0, 0); } while (0)
#define PG8_LDA(dst, b, h) do { _Pragma("unroll") for (int m = 0; m < 4; ++m) _Pragma("unroll") for (int k = 0; k < 2; ++k) dst[m][k] = *(const LAS bf16x8*)(lds + PG8_SA(b, h) + aoff + m * 2048 + k * 1024); } while (0)
#define PG8_LDB(dst, b, h) do { _Pragma("unroll") for (int n = 0; n < 2; ++n) _Pragma("unroll") for (int k = 0; k < 2; ++k) dst[n][k] = *(const LAS bf16x8*)(lds + PG8_SB(b, h) + boff + n * 2048 + k * 1024); } while (0)
#define PG8_MMA(ai, bj, At, Bt) do { __builtin_amdgcn_s_setprio(1); _Pragma("unroll") for (int m = 0; m < 4; ++m) _Pragma("unroll") for (int n = 0; n < 2; ++n) _Pragma("unroll") for (int k = 0; k < 2; ++k) \
        acc[ai][bj][m][n] = F16 ? __builtin_amdgcn_mfma_f32_16x16x32_f16(__builtin_bit_cast(f16x8, Bt[n][k]), __builtin_bit_cast(f16x8, At[m][k]), acc[ai][bj][m][n], 0, 0, 0) \
                                : __builtin_amdgcn_mfma_f32_16x16x32_bf16(Bt[n][k], At[m][k], acc[ai][bj][m][n], 0, 0, 0); __builtin_amdgcn_s_setprio(0); } while (0)
#define PG8_WAIT_V(n) asm volatile("s_waitcnt vmcnt(" #n ")" ::: "memory")
#define PG8_WAIT_L(n) asm volatile("s_waitcnt lgkmcnt(" #n ")" ::: "memory")
#define PG8_BAR __builtin_amdgcn_s_barrier()
#define PG8_SCHED __builtin_amdgcn_sched_barrier(0)
    Unit cur, nxt; int ui = 0;
    if (!S.next(0, cur)) return;
    f32x4 acc[2][2][4][2];
#pragma unroll
    for (int a = 0; a < 2; ++a)
#pragma unroll
        for (int b = 0; b < 2; ++b)
#pragma unroll
            for (int m = 0; m < 4; ++m)
#pragma unroll
                for (int n = 0; n < 2; ++n) acc[a][b][m][n] = (f32x4){0.f, 0.f, 0.f, 0.f};
    bf16x8 At[4][2], B0[2][2], B1[2][2];
    const char* cA = cur.a; const char* cB = cur.b;
    PG8_STAGE(PG8_SB(0, 0), cB, voffB); PG8_STAGE(PG8_SB(0, 1), cB + hstepB, voffB); PG8_STAGE(PG8_SA(0, 0), cA, voffA); PG8_STAGE(PG8_SA(0, 1), cA + hstepA, voffA);
    if (wr == 1) PG8_BAR;
    PG8_WAIT_V(2); PG8_BAR;
    PG8_STAGE(PG8_SB(1, 0), cB + kstep, voffB); PG8_STAGE(PG8_SA(1, 0), cA + kstep, voffA); PG8_STAGE(PG8_SB(1, 1), cB + hstepB + kstep, voffB);
    PG8_WAIT_V(6); PG8_BAR;
    for (;;) {
        const bool has_next = S.next(ui + 1, nxt);
        const char* nA = has_next ? nxt.a : cA; const char* nB = has_next ? nxt.b : cB;
        for (int t = 0; t < nt; t += 2) {
            const bool last = (t == nt - 2);
            const int firstf = (ALIGN && t == 0 && ui > 0) ? 1 : 0;
            const char* a1 = cA + (size_t)(t + 1) * kstep;
            const char* a2 = last ? nA : cA + (size_t)(t + 2) * kstep; const char* b2 = last ? nB : cB + (size_t)(t + 2) * kstep;
            const char* a3 = a2 + kstep; const char* b3 = b2 + kstep;
            PG8_LDB(B0, 0, 0); PG8_LDB(B1, 0, 1); PG8_SCHED; PG8_LDA(At, 0, 0); PG8_STAGE(PG8_SA(1, 1), a1 + hstepA, voffA);
            wait_vm_sel<Epi::NST + 4>(firstf); PG8_WAIT_L(0); PG8_BAR; PG8_MMA(0, 0, At, B0); PG8_MMA(0, 1, At, B1); PG8_BAR; PG8_SCHED;
            PG8_LDA(At, 0, 1); PG8_STAGE(PG8_SB(0, 0), b2, voffB); PG8_STAGE(PG8_SB(0, 1), b2 + hstepB, voffB); PG8_STAGE(PG8_SA(0, 0), a2, voffA);
            wait_vm_sel<Epi::NST + 10>(firstf); PG8_WAIT_L(0); PG8_BAR; PG8_MMA(1, 0, At, B0); PG8_MMA(1, 1, At, B1); PG8_BAR; PG8_SCHED;
            PG8_LDB(B0, 1, 0); PG8_LDB(B1, 1, 1); PG8_SCHED; PG8_LDA(At, 1, 0); PG8_STAGE(PG8_SA(0, 1), a2 + hstepA, voffA);
            wait_vm_sel<Epi::NST + 10>(firstf); PG8_WAIT_L(0); PG8_BAR; PG8_MMA(0, 0, At, B0); PG8_MMA(0, 1, At, B1); PG8_BAR; PG8_SCHED;
            PG8_LDA(At, 1, 1); PG8_STAGE(PG8_SB(1, 0), b3, voffB); PG8_STAGE(PG8_SB(1, 1), b3 + hstepB, voffB); PG8_STAGE(PG8_SA(1, 0), a3, voffA);
            PG8_WAIT_V(8); PG8_WAIT_L(0); PG8_BAR; PG8_MMA(1, 0, At, B0); PG8_MMA(1, 1, At, B1); PG8_BAR; PG8_SCHED;
        }
        if (ALIGN) { if (wr == 0) PG8_BAR; }
        if (ALIGN && has_next) {
#pragma unroll
            for (int _i = 0; _i < 2; ++_i) glds16_s(nA + kstep + hstepA, voffA[_i], (unsigned)(__UINTPTR_TYPE__)lds + (unsigned)(PG8_SA(1, 1) + _i * 8192) + ldsw); }
        E(acc, cur, wr, wc, fr, fq);
        if (!has_next) break;
#pragma unroll
        for (int a = 0; a < 2; ++a)
#pragma unroll
            for (int b = 0; b < 2; ++b)
#pragma unroll
                for (int m = 0; m < 4; ++m)
#pragma unroll
                    for (int n = 0; n < 2; ++n) acc[a][b][m][n] = (f32x4){0.f, 0.f, 0.f, 0.f};
        cur = nxt; cA = nA; cB = nB; ++ui;
        if (ALIGN) { if (wr == 1) PG8_BAR; }
    }
    PG8_WAIT_V(0);
    if (!ALIGN) { if (wr == 0) PG8_BAR; }
    PG8_BAR;
#undef PG8_SA
#undef PG8_SB
#undef PG8_STAGE
#undef PG8_LDA
#undef PG8_LDB
#undef PG8_MMA
#undef PG8_WAIT_V
#undef PG8_WAIT_L
#undef PG8_SCHED
}
}
namespace pg8 {
struct SchedMN {
    const char* A; const char* Bt; int lda, ldb; int nM, nN, nwg, G, c;
    __device__ __forceinline__ void init(const bf16* A_, int lda_, const bf16* Bt_, int ldb_, int Mrows, int Ncols, int G_, int c_) {
        A = (const char*)A_; Bt = (const char*)Bt_; lda = lda_; ldb = ldb_; nM = Mrows / BM; nN = Ncols / BM; nwg = nM * nN; G = G_; c = c_; }
    __device__ __forceinline__ bool next(int i, Unit& u) const {
        const long L = (long)i * G + c; if (L >= nwg) return false;
        int wgid = (int)L; { const int q = nwg / NXCD, r = nwg % NXCD, xcd = wgid % NXCD, off = wgid / NXCD; wgid = (xcd < r ? xcd * (q + 1) : r * (q + 1) + (xcd - r) * q) + off; }
        const int nig = WGM * nN, gid = wgid / nig, fm = gid * WGM, gsz = (nM - fm) < WGM ? (nM - fm) : WGM;
        const int pm = fm + ((wgid % nig) % gsz), pn = (wgid % nig) / gsz;
        u.a = A + (size_t)pm * BM * lda * 2; u.b = Bt + (size_t)pn * BM * ldb * 2; u.orow = pm * BM; u.ocol = pn * BM; u.aux = pn; return true;
    }
};
struct SchedKV {
    const char* memn; const char* wkv; int G, c;
    __device__ __forceinline__ bool next(int i, Unit& u) const {
        const int L = i * G + c; if (L >= 256) return false;
        const int l = L >> 6, r = L & 63; const char* w = wkv + (size_t)l * 4096 * D * 2;
        if (r < 32) { const int pm = r >> 3, pn = r & 7; u.a = memn + (size_t)pm * 256 * D * 2; u.b = w + (size_t)pn * 256 * D * 2; u.orow = pm * 256; u.ocol = pn * 256; u.aux = l * 2; }
        else { const int q = r - 32, pm = q >> 2, pn = q & 3; u.a = w + (size_t)(2048 + pm * 256) * D * 2; u.b = memn + (size_t)pn * 256 * D * 2; u.orow = pm * 256; u.ocol = pn * 256; u.aux = l * 2 + 1; }
        return true;
    }
};
struct SchedS {
    const char* Q; const char* Km; int G, c;
    __device__ __forceinline__ bool next(int i, Unit& u) const {
        const int L = i * G + c; if (L >= 256) return false;
        const int bh = 2 * (L & 7) + ((L >> 3) >> 4), it = (L >> 3) & 15, b = bh >> 2, h = bh & 3;
        u.a = Q + ((size_t)(b * SEQ + it * 256) * D + h * XAD) * 2; u.b = Km + ((size_t)(b * MEMLEN) * D + h * XAD) * 2; u.orow = b * SEQ + it * 256; u.ocol = h * 256; u.aux = 0; return true;
    }
};
struct SchedPV {
    const char* P; const char* Vt; int G, c;
    __device__ __forceinline__ bool next(int i, Unit& u) const {
        const int L = i * G + c; if (L >= 512) return false;
        const int x = L & 7, r = L >> 3;
        const int bh = 2 * x + (r >> 5), q = r & 31, it = q >> 1, nh = q & 1, b = bh >> 2, h = bh & 3;
        u.a = P + ((size_t)(b * SEQ + it * 256) * 1024 + h * 256) * 2; u.b = Vt + ((size_t)(h * XAD + nh * 256) * 1024 + b * MEMLEN) * 2; u.orow = b * SEQ + it * 256; u.ocol = h * XAD + nh * 256; u.aux = 0; return true;
    }
};
struct SchedDt {
    const char* A; const char* Bt; int c;
    __device__ __forceinline__ bool next(int i, Unit& u) const {
        if (i != 0 || c >= 64) return false;
        u.a = A + (size_t)c * 256 * D * 2; u.b = Bt; u.orow = c * 256; u.ocol = 0; u.aux = 0; return true;
    }
};

struct SchedChainQ {
    const char* A; const char* Bt; int pm, h, n;
    __device__ __forceinline__ bool next(int i, Unit& u) const { if (i >= n) return false; const int pn = 2 * h + i;
        u.a = A + (size_t)pm * 256 * D * 2; u.b = Bt + (size_t)pn * 256 * D * 2; u.orow = pm * 256; u.ocol = pn * 256; u.aux = pn; return true; }
};
struct SchedChainS {
    const char* Q; const char* Km; int pm, h, n;
    __device__ __forceinline__ bool next(int i, Unit& u) const { if (i >= n) return false; const int b = pm >> 4;
        u.a = Q + ((size_t)pm * 256 * D + h * XAD) * 2; u.b = Km + ((size_t)(b * MEMLEN) * D + h * XAD) * 2; u.orow = pm * 256; u.ocol = h * 256; u.aux = 0; return true; }
};
struct SchedChainPV {
    const char* P; const char* Vt; int pm, h, n;
    __device__ __forceinline__ bool next(int i, Unit& u) const { if (i >= n) return false; const int b = pm >> 4;
        u.a = P + ((size_t)pm * 256 * 1024 + h * 256) * 2; u.b = Vt + ((size_t)(h * XAD + i * 256) * 1024 + b * MEMLEN) * 2; u.orow = pm * 256; u.ocol = h * XAD + i * 256; u.aux = 0; return true; }
};

#define EPI_ARGS f32x4 (&acc)[2][2][4][2], const Unit& u, int wr, int wc, int fr, int fq
#define EPI_ROW(ai, m) (u.orow + (ai) * HALF + wr * 64 + (m) * 16 + fr)
#define EPI_COL(bj) (u.ocol + (bj) * HALF + wc * 32 + 8 * fq)
__device__ __forceinline__ float rstd_of(const float* ss, int row) { const f32x4 a = *(const f32x4*)(ss + (size_t)row * 8), b = *(const f32x4*)(ss + (size_t)row * 8 + 4);
    return rsqrtf((((a[0] + a[1]) + (a[2] + a[3])) + ((b[0] + b[1]) + (b[2] + b[3]))) * (1.0f / D) + EPS); }
__device__ __forceinline__ u32x4 pack8(const f32x4 a, const f32x4 b) { u32x4 w; w.x = cvt_pk_bf16(a[0], a[1]); w.y = cvt_pk_bf16(a[2], a[3]); w.z = cvt_pk_bf16(b[0], b[1]); w.w = cvt_pk_bf16(b[2], b[3]); return w; }

struct EpiProjEven {
    static constexpr int NST = 16;
    const float* ss; bf16* proj; float* logf; const float* lb;
    __device__ __forceinline__ void operator()(EPI_ARGS) const {
        const int range = u.aux >> 2;
#pragma unroll
        for (int ai = 0; ai < 2; ++ai)
#pragma unroll
            for (int m = 0; m < 4; ++m) { const int row = EPI_ROW(ai, m); const float rs = rstd_of(ss, row);
#pragma unroll
                for (int bj = 0; bj < 2; ++bj) { const int col = EPI_COL(bj); f32x4 v0 = acc[ai][bj][m][0] * rs, v1 = acc[ai][bj][m][1] * rs;
                    if (range == 3) { const int c = col - 3072; const f32x4 l0 = *(const f32x4*)(lb + c), l1 = *(const f32x4*)(lb + c + 4);
#pragma unroll
                        for (int j = 0; j < 4; ++j) { v0[j] = __logf(l0[j] + (1.f - l0[j]) * sigm(v0[j])); v1[j] = __logf(l1[j] + (1.f - l1[j]) * sigm(v1[j])); }
                        float* p = logf + (size_t)row * 1024 + c; *(f32x4*)p = v0; *(f32x4*)(p + 4) = v1;
                    } else {
                        if (range == 1) {
#pragma unroll
                            for (int j = 0; j < 4; ++j) { v0[j] = gelu_tanh(v0[j]); v1[j] = gelu_tanh(v1[j]); } }
                        else if (range == 2 || range == 5) {
#pragma unroll
                            for (int j = 0; j < 4; ++j) { v0[j] = siluf(v0[j]); v1[j] = siluf(v1[j]); } }
                        *(u32x4*)(proj + (size_t)row * ABIN + col) = pack8(v0, v1);
                    } } }
    }
};
struct EpiProjOdd {
    static constexpr int NST = 16;
    const float* ss; bf16* Z; bf16* XBC;
    __device__ __forceinline__ void operator()(EPI_ARGS) const {
        const bool isz = u.ocol < SSDIN;
#pragma unroll
        for (int ai = 0; ai < 2; ++ai)
#pragma unroll
            for (int m = 0; m < 4; ++m) { const int row = EPI_ROW(ai, m); const float rs = rstd_of(ss, row);
#pragma unroll
                for (int bj = 0; bj < 2; ++bj) { const int col = EPI_COL(bj); f32x4 v0 = acc[ai][bj][m][0] * rs, v1 = acc[ai][bj][m][1] * rs;
                    if (isz) {
#pragma unroll
                        for (int j = 0; j < 4; ++j) { v0[j] = siluf(v0[j]); v1[j] = siluf(v1[j]); }
                        *(u32x4*)(Z + (size_t)row * SSDIN + col) = pack8(v0, v1);
                    } else *(u32x4*)(XBC + (size_t)row * SSDCONV + (col - SSDIN)) = pack8(v0, v1); } }
    }
};
struct EpiDt {
    static constexpr int NST = 0;
    const float* ss; const float* bias; float* DT;
    __device__ __forceinline__ void operator()(EPI_ARGS) const {
        if (wc >= 2) return;
        const int col = wc * 32 + 8 * fq; const f32x4 b0 = *(const f32x4*)(bias + col), b1 = *(const f32x4*)(bias + col + 4);
#pragma unroll
        for (int ai = 0; ai < 2; ++ai)
#pragma unroll
            for (int m = 0; m < 4; ++m) { const int row = EPI_ROW(ai, m); const float rs = rstd_of(ss, row);
                f32x4 v0 = acc[ai][0][m][0] * rs + b0, v1 = acc[ai][0][m][1] * rs + b1;
#pragma unroll
                for (int j = 0; j < 4; ++j) { v0[j] = softplusf(v0[j]); v1[j] = softplusf(v1[j]); }
                float* p = DT + (size_t)row * 64 + col; *(f32x4*)p = v0; *(f32x4*)(p + 4) = v1; }
    }
};
struct EpiResid {
    static constexpr int NST = 16;
    bf16* xb; float* ssnew; LAS float* tab;
    __device__ __forceinline__ void operator()(EPI_ARGS) const {
#pragma unroll
        for (int ai = 0; ai < 2; ++ai)
#pragma unroll
            for (int m = 0; m < 4; ++m) { const int row = EPI_ROW(ai, m); float sq = 0.f;
#pragma unroll
                for (int bj = 0; bj < 2; ++bj) { bf16* p = xb + (size_t)row * D + EPI_COL(bj); const u32x4 w = *(const u32x4*)p;
                    f32x4 o0 = acc[ai][bj][m][0], o1 = acc[ai][bj][m][1];
                    o0[0] += rs_lo(w.x); o0[1] += rs_hi(w.x); o0[2] += rs_lo(w.y); o0[3] += rs_hi(w.y); o1[0] += rs_lo(w.z); o1[1] += rs_hi(w.z); o1[2] += rs_lo(w.w); o1[3] += rs_hi(w.w);
                    { u32x4 pk; pk.x = rs_pk(o0[0], o0[1]); pk.y = rs_pk(o0[2], o0[3]); pk.z = rs_pk(o1[0], o1[1]); pk.w = rs_pk(o1[2], o1[3]); *(u32x4*)p = pk; }
                    sq += ((o0[0] * o0[0] + o0[1] * o0[1]) + (o0[2] * o0[2] + o0[3] * o0[3])) + ((o1[0] * o1[0] + o1[1] * o1[1]) + (o1[2] * o1[2] + o1[3] * o1[3])); }
                sq += __shfl_xor(sq, 16); sq += __shfl_xor(sq, 32);
                if (fq == 0) tab[(ai * HALF + wr * 64 + m * 16 + fr) * 4 + wc] = sq; }
        LDS_WAIT(); PG8_BAR; asm volatile("" ::: "memory");
        const int lane = fq * 16 + fr, r = (wr * 4 + wc) * 32 + (lane & 31);
        if (lane < 32) { const f32x4 t = *(const LAS f32x4*)(tab + r * 4); ssnew[(size_t)(u.orow + r) * 8 + (u.ocol >> 8)] = (t[0] + t[1]) + (t[2] + t[3]); }
    }
};
struct EpiQ {
    static constexpr int NST = 16;
    const float* ss; bf16* Q; float scale;
    __device__ __forceinline__ void operator()(EPI_ARGS) const {
#pragma unroll
        for (int ai = 0; ai < 2; ++ai)
#pragma unroll
            for (int m = 0; m < 4; ++m) { const int row = EPI_ROW(ai, m); const float rs = rstd_of(ss, row) * scale;
#pragma unroll
                for (int bj = 0; bj < 2; ++bj) *(u32x4*)(Q + (size_t)row * D + EPI_COL(bj)) = pack8(acc[ai][bj][m][0] * rs, acc[ai][bj][m][1] * rs); }
    }
};
struct EpiPlain {
    static constexpr int NST = 16;
    bf16* O; int ldc;
    __device__ __forceinline__ void operator()(EPI_ARGS) const {
#pragma unroll
        for (int ai = 0; ai < 2; ++ai)
#pragma unroll
            for (int m = 0; m < 4; ++m) { const int row = EPI_ROW(ai, m);
#pragma unroll
                for (int bj = 0; bj < 2; ++bj) *(u32x4*)(O + (size_t)row * ldc + EPI_COL(bj)) = pack8(acc[ai][bj][m][0], acc[ai][bj][m][1]); }
    }
};
struct EpiKV {
    static constexpr int NST = 16;
    bf16* Km; bf16* Vt;
    __device__ __forceinline__ void operator()(EPI_ARGS) const {
        const int l = u.aux >> 1; const bool isv = u.aux & 1;
        bf16* O = isv ? Vt + (size_t)l * D * MEMROWS : Km + (size_t)l * MEMROWS * D; const int ldc = isv ? MEMROWS : D;
#pragma unroll
        for (int ai = 0; ai < 2; ++ai)
#pragma unroll
            for (int m = 0; m < 4; ++m) { const int row = EPI_ROW(ai, m);
#pragma unroll
                for (int bj = 0; bj < 2; ++bj) *(u32x4*)(O + (size_t)row * ldc + EPI_COL(bj)) = pack8(acc[ai][bj][m][0], acc[ai][bj][m][1]); }
    }
};
struct EpiSoftmax {
    static constexpr int NST = 16;
    bf16* P; LAS float* tab;
    __device__ __forceinline__ void operator()(EPI_ARGS) const {
        float mx[2][4];
#pragma unroll
        for (int ai = 0; ai < 2; ++ai)
#pragma unroll
            for (int m = 0; m < 4; ++m) { float v = -3.0e38f;
#pragma unroll
                for (int bj = 0; bj < 2; ++bj)
#pragma unroll
                    for (int n = 0; n < 2; ++n) { const f32x4 a = acc[ai][bj][m][n]; v = fmaxf(v, fmaxf(fmaxf(a[0], a[1]), fmaxf(a[2], a[3]))); }
                v = fmaxf(v, __shfl_xor(v, 16)); v = fmaxf(v, __shfl_xor(v, 32));
                if (fq == 0) tab[(ai * HALF + wr * 64 + m * 16 + fr) * 4 + wc] = v; }
        LDS_WAIT(); PG8_BAR; asm volatile("" ::: "memory");
#pragma unroll
        for (int ai = 0; ai < 2; ++ai)
#pragma unroll
            for (int m = 0; m < 4; ++m) { const int r = ai * HALF + wr * 64 + m * 16 + fr; const f32x4 t = *(const LAS f32x4*)(tab + r * 4);
                const float rm = fmaxf(fmaxf(t[0], t[1]), fmaxf(t[2], t[3])); float s = 0.f;
#pragma unroll
                for (int bj = 0; bj < 2; ++bj)
#pragma unroll
                    for (int n = 0; n < 2; ++n) { f32x4 a = acc[ai][bj][m][n];
#pragma unroll
                        for (int j = 0; j < 4; ++j) { a[j] = __expf(a[j] - rm); s += a[j]; }
                        acc[ai][bj][m][n] = a; }
                s += __shfl_xor(s, 16); s += __shfl_xor(s, 32);
                if (fq == 0) tab[1024 + r * 4 + wc] = s; }
        LDS_WAIT(); PG8_BAR; asm volatile("" ::: "memory");
#pragma unroll
        for (int ai = 0; ai < 2; ++ai)
#pragma unroll
            for (int m = 0; m < 4; ++m) { const int r = ai * HALF + wr * 64 + m * 16 + fr; const f32x4 t = *(const LAS f32x4*)(tab + 1024 + r * 4);
                const float inv = __builtin_amdgcn_rcpf((t[0] + t[1]) + (t[2] + t[3])); const int row = u.orow + r;
#pragma unroll
                for (int bj = 0; bj < 2; ++bj) *(u32x4*)(P + (size_t)row * 1024 + EPI_COL(bj)) = pack8(acc[ai][bj][m][0] * inv, acc[ai][bj][m][1] * inv); }
    }
};
struct EpiGateUp {
    static constexpr int NST = 16;
    const float* ss; bf16* H;
    __device__ __forceinline__ void operator()(EPI_ARGS) const {
#pragma unroll
        for (int ai = 0; ai < 2; ++ai)
#pragma unroll
            for (int m = 0; m < 4; ++m) { const int row = EPI_ROW(ai, m); const float rs = rstd_of(ss, row);
#pragma unroll
                for (int bj = 0; bj < 2; ++bj) { const int hc = EPI_COL(bj) >> 1; const f32x4 g = acc[ai][bj][m][0] * rs, up = acc[ai][bj][m][1] * rs; f32x4 h;
#pragma unroll
                    for (int j = 0; j < 4; ++j) h[j] = siluf(g[j]) * up[j];
                    u32x2 w; w.x = cvt_pk_bf16(h[0], h[1]); w.y = cvt_pk_bf16(h[2], h[3]); *(u32x2*)(H + (size_t)row * FF + hc) = w; } }
    }
};
#undef EPI_ARGS
}
#define MFMA16(X, Y, ACC) __builtin_amdgcn_mfma_f32_16x16x32_bf16((X), (Y), (ACC), 0, 0, 0)
#define WG_SYNC() do { asm volatile("s_waitcnt vmcnt(0) lgkmcnt(0)" ::: "memory"); __builtin_amdgcn_s_barrier(); asm volatile("" ::: "memory"); } while (0)
#define LDS_SYNC() do { asm volatile("s_waitcnt lgkmcnt(0)" ::: "memory"); __builtin_amdgcn_s_barrier(); asm volatile("" ::: "memory"); } while (0)
constexpr int LP = 136;
constexpr int LP64 = 72;
__device__ __forceinline__ bf16x8 lds_frag(const LAS bf16* base, int row, int pitch, int kofs) { return *(const LAS bf16x8*)(base + row * pitch + kofs); }
__device__ __forceinline__ u32x2 pack4(const f32x4 a) { u32x2 w; w.x = cvt_pk_bf16(a[0], a[1]); w.y = cvt_pk_bf16(a[2], a[3]); return w; }

template <int MAP, bool F16>
__device__ __forceinline__ void conv_item(const float* W, int ldw, int K, int n0, const float* gain, bf16* WT, int row_off, LAS float* scr, int item, int nblk, int lane) {
    const int kb = item / nblk, nb = item % nblk, k0 = 64 * kb, nn0 = 64 * nb;
    const int kr = lane >> 4, n4 = (lane & 15) * 4;
    const float* src = W + (size_t)(k0 + kr) * ldw + n0 + nn0 + n4;
    f32x4 v[16];
#pragma unroll
    for (int i = 0; i < 16; ++i) v[i] = *(const f32x4*)(src + (size_t)(4 * i) * ldw);
#pragma unroll
    for (int i = 0; i < 16; ++i) { f32x4 w = v[i]; if (gain) w = w * gain[k0 + 4 * i + kr];
        LAS float* d = scr + (4 * i + kr) * 65 + n4; d[0] = w[0]; d[1] = w[1]; d[2] = w[2]; d[3] = w[3]; }
    LDS_WAIT(); asm volatile("" ::: "memory");
    const int c = lane & 7, nbase = lane >> 3;
#pragma unroll
    for (int j = 0; j < 8; ++j) { const int n = nbase + 8 * j; const LAS float* s = scr + (8 * c) * 65 + n;
        u32x4 o; if (F16) { o.x = cvt_pk_f16(s[0 * 65], s[1 * 65]); o.y = cvt_pk_f16(s[2 * 65], s[3 * 65]); o.z = cvt_pk_f16(s[4 * 65], s[5 * 65]); o.w = cvt_pk_f16(s[6 * 65], s[7 * 65]); }
        else { o.x = cvt_pk_bf16(s[0 * 65], s[1 * 65]); o.y = cvt_pk_bf16(s[2 * 65], s[3 * 65]); o.z = cvt_pk_bf16(s[4 * 65], s[5 * 65]); o.w = cvt_pk_bf16(s[6 * 65], s[7 * 65]); }
        const int nn = nn0 + n; const int dr = MAP == 0 ? nn : ((nn >> 2) * 8 + (nn & 3) + (MAP == 2 ? 4 : 0));
        *(u32x4*)(WT + (size_t)(row_off + dr) * K + k0 + 8 * c) = o; }
    LDS_WAIT(); asm volatile("" ::: "memory");
}
template <int MAP, bool F16 = false>
__device__ __forceinline__ void conv_matrix(const float* W, int ldw, int K, int n0, int ncols, const float* gain, bf16* WT, int row_off, LAS float* scr, int gw, int NGW, int lane, int& rot) {
    const int nblk = ncols / 64, nitems = (K / 64) * nblk; int first = gw - rot; if (first < 0) first += NGW;
    for (int it = first; it < nitems; it += NGW) conv_item<MAP, F16>(W, ldw, K, n0, gain, WT, row_off, scr, it, nblk, lane);
    rot = (rot + nitems) % NGW;
}

struct In {
    const float *x, *mem, *norm_mix, *norm_xattn, *norm_ffn, *norm_mem, *norm_final, *ab_w_in, *ab_w_out, *lru_conv_w, *lru_conv_b, *lru_w_r, *lru_b_r, *lru_w_i, *lru_b_i, *lru_lambda,
        *hgrn_lb, *hgrn_norm, *ssd_w_in, *ssd_w_out, *ssd_conv_w, *ssd_conv_b, *ssd_dt_bias, *ssd_a_log, *ssd_d, *ssd_norm, *xa_w_q, *xa_w_kv, *xa_w_o, *ffn_w_gate, *ffn_w_up, *ffn_w_down;
};

typedef const In __attribute__((address_space(4))) CIn;
__device__ __forceinline__ void convert_layer(CIn& I, int l, bf16* WL, LAS float* scr, int gw, int NGW, int lane, int& rot) {
    const int e = l >> 1;
    if ((l & 1) == 0) {
        conv_matrix<0, RF16>(I.ab_w_in + (size_t)e * D * ABIN, ABIN, D, 0, ABIN, I.norm_mix + l * D, WL + WL_IN, 0, scr, gw, NGW, lane, rot);
        conv_matrix<0>(I.ab_w_out + (size_t)e * D * D, D, D, 0, D, nullptr, WL + WL_OUT, 0, scr, gw, NGW, lane, rot);
    } else {
        conv_matrix<0, RF16>(I.ssd_w_in + (size_t)e * D * SSDPROJ, SSDPROJ, D, 0, SSDN1, I.norm_mix + l * D, WL + WL_IN, 0, scr, gw, NGW, lane, rot);
        conv_matrix<0, RF16>(I.ssd_w_in + (size_t)e * D * SSDPROJ, SSDPROJ, D, SSDN1, 64, I.norm_mix + l * D, WL + WL_DT, 0, scr, gw, NGW, lane, rot);
        for (int i = gw * 64 + lane; i < 192 * D / 8; i += NGW * 64) *(u32x4*)(WL + WL_DT + (size_t)64 * D + (size_t)i * 8) = (u32x4){0u, 0u, 0u, 0u};
        conv_matrix<0>(I.ssd_w_out + (size_t)e * SSDIN * D, D, SSDIN, 0, D, nullptr, WL + WL_OUT, 0, scr, gw, NGW, lane, rot);
    }
    conv_matrix<0, RF16>(I.xa_w_q + (size_t)l * D * D, D, D, 0, D, I.norm_xattn + l * D, WL + WL_Q, 0, scr, gw, NGW, lane, rot);
    conv_matrix<0>(I.xa_w_o + (size_t)l * D * D, D, D, 0, D, nullptr, WL + WL_O, 0, scr, gw, NGW, lane, rot);
    conv_matrix<1, RF16>(I.ffn_w_gate + (size_t)l * D * FF, FF, D, 0, FF, I.norm_ffn + l * D, WL + WL_GU, 0, scr, gw, NGW, lane, rot);
    conv_matrix<2, RF16>(I.ffn_w_up + (size_t)l * D * FF, FF, D, 0, FF, I.norm_ffn + l * D, WL + WL_GU, 0, scr, gw, NGW, lane, rot);
    conv_matrix<0>(I.ffn_w_down + (size_t)l * FF * D, D, FF, 0, D, nullptr, WL + WL_DN, 0, scr, gw, NGW, lane, rot);
}

template <bool PASSB>
__device__ __forceinline__ void lru_units(const int tid, LAS unsigned char* lds, int G, int cu, const bf16* PROJ, const bf16* WRT, const float* cw, const float* cb, const float* br, const float* bi,
                                          const float* lam, float* SEG, bf16* YAB) {
    const int wid = __builtin_amdgcn_readfirstlane(tid >> 6), lane = tid & 63, q = lane >> 4, c16 = lane & 15;
    LAS bf16* XA = (LAS bf16*)(lds);
    LAS bf16* XC = (LAS bf16*)(lds + 35840);
    LAS bf16* WR = (LAS bf16*)(lds + 70656);
    LAS bf16* WI = (LAS bf16*)(lds + 105472);
    LAS float* PAR = (LAS float*)(lds + 140288);
    LAS float* WT = (LAS float*)(lds + 144384);
    LAS float* HIN = (LAS float*)(lds + 152576);
    int loadedj = -1;
    for (int u = cu; u < 1024; u += G) {
        const int j = u & 7, rest = u >> 3, b = rest >> 5, seg = rest & 31; const int t0 = b * SEQ + seg * 128;
        if (j != loadedj) {
            loadedj = j;
            for (int p = tid; p < 2 * 2048; p += NTHR) { const int g = p >> 11, pp = p & 2047, r = pp >> 4, pc = pp & 15;
                const u32x4 v = *(const u32x4*)(WRT + ((size_t)(g * 8 + j) * 128 + r) * 128 + pc * 8);
                *(LAS u32x4*)((g ? WI : WR) + r * LP + pc * 8) = v; }
            if (tid < 128) { const int ch = j * 128 + tid;
                PAR[0 * 128 + tid] = 8.0f * softplusf(-lam[ch]); PAR[1 * 128 + tid] = br[ch]; PAR[2 * 128 + tid] = bi[ch]; PAR[3 * 128 + tid] = cb[ch];
#pragma unroll
                for (int k = 0; k < 4; ++k) PAR[(4 + k) * 128 + tid] = cw[k * LRUW + ch]; }
        }
        for (int p = tid; p < 131 * 16; p += NTHR) { const int r = p >> 4, pc = p & 15; u32x4 v = (u32x4){0u, 0u, 0u, 0u};
            if (seg > 0 || r >= 3) v = *(const u32x4*)(PROJ + (size_t)(t0 + r - 3) * ABIN + j * 128 + pc * 8);
            *(LAS u32x4*)(XA + r * LP + pc * 8) = v; }
        if (PASSB) { if (tid < 128) { float h = 0.f; const float* sg = SEG + ((size_t)(b * 8 + j) * 32) * 256 + tid * 2;
                for (int s = 0; s < seg; ++s) { const f32x2 ab = *(const f32x2*)(sg + (size_t)s * 256); h = ab.x * h + ab.y; }
                HIN[tid] = h; } }
        WG_SYNC();
        {
            const int ch8 = tid & 15, tr = tid >> 4; u32x4 rows[7];
#pragma unroll
            for (int i = 0; i < 7; ++i) rows[i] = *(const LAS u32x4*)(XA + (4 * tr + i) * LP + ch8 * 8);
            float w[4][8], bb[8];
#pragma unroll
            for (int e = 0; e < 8; ++e) { bb[e] = PAR[3 * 128 + ch8 * 8 + e];
#pragma unroll
                for (int k = 0; k < 4; ++k) w[k][e] = PAR[(4 + k) * 128 + ch8 * 8 + e]; }
#pragma unroll
            for (int i = 0; i < 4; ++i) { float o[8];
#pragma unroll
                for (int e = 0; e < 8; ++e) { float a = bb[e];
#pragma unroll
                    for (int k = 0; k < 4; ++k) { const unsigned wd = rows[i + k][e >> 1]; a += w[k][e] * ((e & 1) ? bfhi(wd) : bflo(wd)); }
                    o[e] = a; }
                u32x4 pk; pk.x = cvt_pk_bf16(o[0], o[1]); pk.y = cvt_pk_bf16(o[2], o[3]); pk.z = cvt_pk_bf16(o[4], o[5]); pk.w = cvt_pk_bf16(o[6], o[7]);
                *(LAS u32x4*)(XC + (4 * tr + i) * LP + ch8 * 8) = pk; }
        }
        WG_SYNC();
        float PP[8][4], HH[8][4];
        {
            bf16x8 xf[4];
#pragma unroll
            for (int ks = 0; ks < 4; ++ks) xf[ks] = lds_frag(XC, 16 * wid + c16, LP, 32 * ks + 8 * q);
#pragma unroll
            for (int jb = 0; jb < 8; ++jb) {
                f32x4 aR = (f32x4){0.f, 0.f, 0.f, 0.f}, aI = aR;
#pragma unroll
                for (int ks = 0; ks < 4; ++ks) { aR = MFMA16(xf[ks], lds_frag(WR, 16 * jb + c16, LP, 32 * ks + 8 * q), aR); aI = MFMA16(xf[ks], lds_frag(WI, 16 * jb + c16, LP, 32 * ks + 8 * q), aI); }
                const int ch = 16 * jb + c16;
                const float sp8 = PAR[ch], pbr = PAR[128 + ch], pbi = PAR[256 + ch], pcb = PAR[384 + ch], w0 = PAR[512 + ch], w1 = PAR[640 + ch], w2 = PAR[768 + ch], w3 = PAR[896 + ch];
                float xr[7];
#pragma unroll
                for (int i = 0; i < 7; ++i) xr[i] = bf2f(XA[(16 * wid + 4 * q + i) * LP + ch]);
                float a[4], bt[4];
#pragma unroll
                for (int r = 0; r < 4; ++r) { const float xc = pcb + w0 * xr[r] + w1 * xr[r + 1] + w2 * xr[r + 2] + w3 * xr[r + 3];
                    const float rg = sigm(aR[r] + pbr), ig = sigm(aI[r] + pbi); const float la = -sp8 * rg;
                    const float av = __expf(la), x2 = 2.0f * la; a[r] = av;
                    const float om = (x2 > -0.02f) ? -x2 * (1.0f + x2 * (0.5f + x2 * 0.16666667f)) : 1.0f - av * av;
                    bt[r] = __builtin_amdgcn_sqrtf(fmaxf(om, 0.f)) * ig * xc; }
                float P[4], H[4]; P[0] = a[0]; H[0] = bt[0];
#pragma unroll
                for (int r = 1; r < 4; ++r) { P[r] = a[r] * P[r - 1]; H[r] = a[r] * H[r - 1] + bt[r]; }
                float Ae = 1.f, Be = 0.f, Aw = 1.f, Bw = 0.f;
#pragma unroll
                for (int qq = 0; qq < 4; ++qq) { const float Aq = __shfl(P[3], c16 + 16 * qq), Bq = __shfl(H[3], c16 + 16 * qq);
                    if (qq < q) { Be = Aq * Be + Bq; Ae = Aq * Ae; }
                    Bw = Aq * Bw + Bq; Aw = Aq * Aw; }
#pragma unroll
                for (int r = 0; r < 4; ++r) { PP[jb][r] = P[r] * Ae; HH[jb][r] = P[r] * Be + H[r]; }
                if (q == 0) *(LAS f32x2*)(WT + (wid * 128 + ch) * 2) = (f32x2){Aw, Bw};
            }
        }
        WG_SYNC();
        if (!PASSB) {
            if (tid < 128) { float A = 1.f, B = 0.f;
#pragma unroll
                for (int w = 0; w < 8; ++w) { const f32x2 ab = *(const LAS f32x2*)(WT + (w * 128 + tid) * 2); B = ab.x * B + ab.y; A = ab.x * A; }
                *(f32x2*)(SEG + ((size_t)(b * 8 + j) * 32 + seg) * 256 + tid * 2) = (f32x2){A, B}; }
        } else {
#pragma unroll
            for (int jb = 0; jb < 8; ++jb) { const int ch = 16 * jb + c16; float h0 = HIN[ch];
                for (int w = 0; w < wid; ++w) { const f32x2 ab = *(const LAS f32x2*)(WT + (w * 128 + ch) * 2); h0 = ab.x * h0 + ab.y; }
#pragma unroll
                for (int r = 0; r < 4; ++r) { const int t = t0 + 16 * wid + 4 * q + r; const float h = PP[jb][r] * h0 + HH[jb][r];
                    const float ga = bf2f(PROJ[(size_t)t * ABIN + 1024 + j * 128 + ch]);
                    YAB[(size_t)t * D + j * 128 + ch] = (bf16)f2bf(ga * h); } }
        }
        WG_SYNC();
    }
}

__device__ __forceinline__ void hgrn1_load(float (&lf)[16], unsigned (&vv)[16], const float* LOGF, const bf16* PROJ, int u, int k, int qt) {
    const int bh = u >> 6, c = u & 63, b = bh >> 3, h = bh & 7; const int t0 = b * SEQ + c * 64 + 16 * qt;
#pragma unroll
    for (int i = 0; i < 16; ++i) { lf[i] = LOGF[(size_t)(t0 + i) * 1024 + h * 128 + k]; vv[i] = PROJ[(size_t)(t0 + i) * ABIN + 4096 + h * 128 + k]; }
}
__device__ __forceinline__ void hgrn1_units(const int tid, LAS unsigned char* lds, int G, int cu, const float* LOGF, const bf16* PROJ, bf16* HST, float* HDEC) {
    const int wid = __builtin_amdgcn_readfirstlane(tid >> 6), lane = tid & 63, q = lane >> 4, c16 = lane & 15;
    LAS bf16* KT = (LAS bf16*)(lds);
    LAS bf16* VT = (LAS bf16*)(lds + 18432);
    LAS float* TOT = (LAS float*)(lds + 36864);
    const int k = tid & 127, qt = tid >> 7;
    float lf[16], nlf[16]; unsigned vv[16], nvv[16];
    if (cu < 2048) hgrn1_load(lf, vv, LOGF, PROJ, cu, k, qt);
    for (int u = cu; u < 2048; u += G) {
        if (u + G < 2048) hgrn1_load(nlf, nvv, LOGF, PROJ, u + G, k, qt);
        float cs[16];
        cs[0] = lf[0];
#pragma unroll
        for (int i = 1; i < 16; ++i) cs[i] = cs[i - 1] + lf[i];
        TOT[qt * 128 + k] = cs[15];
        LDS_SYNC();
        float pre = 0.f, last = 0.f;
#pragma unroll
        for (int qq = 0; qq < 4; ++qq) { const float t = TOT[qq * 128 + k]; if (qq < qt) pre += t; last += t; }
        unsigned kw[8], vw[8];
#pragma unroll
        for (int i = 0; i < 8; ++i) { const float k0 = (1.f - __expf(lf[2 * i])) * __expf(last - (pre + cs[2 * i])), k1 = (1.f - __expf(lf[2 * i + 1])) * __expf(last - (pre + cs[2 * i + 1]));
            kw[i] = cvt_pk_bf16(k0, k1); vw[i] = vv[2 * i] | (vv[2 * i + 1] << 16); }
        *(LAS u32x4*)(KT + k * LP64 + 16 * qt) = (u32x4){kw[0], kw[1], kw[2], kw[3]}; *(LAS u32x4*)(KT + k * LP64 + 16 * qt + 8) = (u32x4){kw[4], kw[5], kw[6], kw[7]};
        *(LAS u32x4*)(VT + k * LP64 + 16 * qt) = (u32x4){vw[0], vw[1], vw[2], vw[3]}; *(LAS u32x4*)(VT + k * LP64 + 16 * qt + 8) = (u32x4){vw[4], vw[5], vw[6], vw[7]};
        if (qt == 0) HDEC[(size_t)u * 128 + k] = __expf(last);
        LDS_SYNC();
        bf16x8 kf[2];
#pragma unroll
        for (int ks = 0; ks < 2; ++ks) kf[ks] = lds_frag(KT, 16 * wid + c16, LP64, 32 * ks + 8 * q);
#pragma unroll
        for (int vb = 0; vb < 8; ++vb) { f32x4 acc = (f32x4){0.f, 0.f, 0.f, 0.f};
#pragma unroll
            for (int ks = 0; ks < 2; ++ks) acc = MFMA16(kf[ks], lds_frag(VT, 16 * vb + c16, LP64, 32 * ks + 8 * q), acc);
            *(u32x2*)(HST + ((size_t)u * 128 + 16 * vb + c16) * 128 + 16 * wid + 4 * q) = pack4(acc); }
        LDS_SYNC();
#pragma unroll
        for (int i = 0; i < 16; ++i) { lf[i] = nlf[i]; vv[i] = nvv[i]; }
    }
    WG_SYNC();
}
__device__ __forceinline__ void hgrn2_scan(const int tid, int G, int cu, bf16* HST, const float* HDEC) {
    for (int task = cu * NTHR + tid; task < 32 * 4096; task += G * NTHR) {
        const int bh = task >> 12, e = (task & 4095) * 4; f32x4 S = (f32x4){0.f, 0.f, 0.f, 0.f};
        bf16* p0 = HST + (size_t)bh * 64 * 16384 + e; const float* d0 = HDEC + (size_t)bh * 64 * 128 + (e & 127);
#pragma unroll 1
        for (int cb = 0; cb < 64; cb += 16) { u32x2 L[16]; f32x4 d[16];
#pragma unroll
            for (int c = 0; c < 16; ++c) { L[c] = *(const u32x2*)(p0 + (size_t)(cb + c) * 16384); d[c] = *(const f32x4*)(d0 + (size_t)(cb + c) * 128); }
#pragma unroll
            for (int c = 0; c < 16; ++c) { *(u32x2*)(p0 + (size_t)(cb + c) * 16384) = pack4(S);
                S[0] = d[c][0] * S[0] + bflo(L[c].x); S[1] = d[c][1] * S[1] + bfhi(L[c].x); S[2] = d[c][2] * S[2] + bflo(L[c].y); S[3] = d[c][3] * S[3] + bfhi(L[c].y); } }
    }
}
__device__ __forceinline__ void hgrn3_load(float (&lf)[16], unsigned (&qv)[16], unsigned (&vv)[16], u32x4 (&st)[4], const float* LOGF, const bf16* PROJ, const bf16* HST, int u, int k, int qt, int tid) {
    const int bh = u >> 6, c = u & 63, b = bh >> 3, h = bh & 7; const int t0 = b * SEQ + c * 64 + 16 * qt;
#pragma unroll
    for (int i = 0; i < 16; ++i) { lf[i] = LOGF[(size_t)(t0 + i) * 1024 + h * 128 + k]; const bf16* pr = PROJ + (size_t)(t0 + i) * ABIN + h * 128 + k; qv[i] = pr[2048]; vv[i] = pr[4096]; }
#pragma unroll
    for (int i = 0; i < 4; ++i) { const int p = tid + NTHR * i, r = p >> 4, pc = p & 15; st[i] = *(const u32x4*)(HST + (size_t)u * 16384 + r * 128 + pc * 8); }
}
__device__ __forceinline__ void hgrn3_units(const int tid, LAS unsigned char* lds, int G, int cu, const float* LOGF, const bf16* PROJ, const bf16* HST, const float* hnorm, bf16* YAB) {
    const int wid = __builtin_amdgcn_readfirstlane(tid >> 6), lane = tid & 63, q = lane >> 4, c16 = lane & 15;
    LAS bf16* QH = (LAS bf16*)(lds);
    LAS bf16* QT = (LAS bf16*)(lds + 17408);
    LAS bf16* KH = (LAS bf16*)(lds + 34816);
    LAS bf16* VT = (LAS bf16*)(lds + 52224);
    LAS bf16* STL = (LAS bf16*)(lds + 70656);
    LAS bf16* PM = (LAS bf16*)(lds + 105472);
    LAS float* TOT = (LAS float*)(lds + 114688);
    LAS float* SQ = (LAS float*)(lds + 116736);
    const int k = tid & 127, qt = tid >> 7;
    float lf[16], nlf[16]; unsigned qv[16], nqv[16], vv[16], nvv[16]; u32x4 st[4], nst[4];
    if (cu < 2048) hgrn3_load(lf, qv, vv, st, LOGF, PROJ, HST, cu, k, qt, tid);
    for (int u = cu; u < 2048; u += G) {
        const int bh = u >> 6, c = u & 63, b = bh >> 3, h = bh & 7; const int tc = b * SEQ + c * 64;
        float cs[16];
        cs[0] = lf[0];
#pragma unroll
        for (int i = 1; i < 16; ++i) cs[i] = cs[i - 1] + lf[i];
        TOT[qt * 128 + k] = cs[15];
#pragma unroll
        for (int i = 0; i < 4; ++i) { const int p = tid + NTHR * i, r = p >> 4, pc = p & 15; *(LAS u32x4*)(STL + r * LP + pc * 8) = st[i]; }
        if (u + G < 2048) hgrn3_load(nlf, nqv, nvv, nst, LOGF, PROJ, HST, u + G, k, qt, tid);
        LDS_SYNC();
        float pre = 0.f;
#pragma unroll
        for (int qq = 0; qq < 4; ++qq) { const float t = TOT[qq * 128 + k]; if (qq < qt) pre += t; }
        const float ref = TOT[k] + TOT[128 + k];
        unsigned vw[8];
#pragma unroll
        for (int i = 0; i < 16; ++i) { const float cum = pre + cs[i], kk = 1.f - __expf(lf[i]), qf = bf2f((bf16)qv[i]);
            QT[(16 * qt + i) * LP + k] = (bf16)f2bf(qf * __expf(cum));
            QH[(16 * qt + i) * LP + k] = (bf16)f2bf(qf * __expf(fminf(cum - ref, 80.f)));
            KH[(16 * qt + i) * LP + k] = (bf16)f2bf(kk * __expf(fminf(ref - cum, 80.f))); }
#pragma unroll
        for (int i = 0; i < 8; ++i) vw[i] = vv[2 * i] | (vv[2 * i + 1] << 16);
        *(LAS u32x4*)(VT + k * LP64 + 16 * qt) = (u32x4){vw[0], vw[1], vw[2], vw[3]}; *(LAS u32x4*)(VT + k * LP64 + 16 * qt + 8) = (u32x4){vw[4], vw[5], vw[6], vw[7]};
        LDS_SYNC();
        {
            const int tb = wid & 3;
            bf16x8 qf[4];
#pragma unroll
            for (int ks = 0; ks < 4; ++ks) qf[ks] = lds_frag(QH, 16 * tb + c16, LP, 32 * ks + 8 * q);
#pragma unroll
            for (int sbi = 0; sbi < 2; ++sbi) { const int sb = 2 * (wid >> 2) + sbi; f32x4 acc = (f32x4){0.f, 0.f, 0.f, 0.f};
#pragma unroll
                for (int ks = 0; ks < 4; ++ks) acc = MFMA16(lds_frag(KH, 16 * sb + c16, LP, 32 * ks + 8 * q), qf[ks], acc);
                const int t = 16 * tb + c16, s0 = 16 * sb + 4 * q;
#pragma unroll
                for (int r = 0; r < 4; ++r) acc[r] = (s0 + r <= t) ? acc[r] : 0.f;
                *(LAS u32x2*)(PM + t * LP64 + s0) = pack4(acc); }
        }
        LDS_SYNC();
        {
            const int tb = wid & 3, vh = wid >> 2, t = 16 * tb + c16;
            bf16x8 qf[4], pf[2];
#pragma unroll
            for (int ks = 0; ks < 4; ++ks) qf[ks] = lds_frag(QT, t, LP, 32 * ks + 8 * q);
#pragma unroll
            for (int ks = 0; ks < 2; ++ks) pf[ks] = lds_frag(PM, t, LP64, 32 * ks + 8 * q);
            f32x4 acc[4]; float sq = 0.f;
#pragma unroll
            for (int vb = 0; vb < 4; ++vb) { const int vr = 64 * vh + 16 * vb + c16; acc[vb] = (f32x4){0.f, 0.f, 0.f, 0.f};
#pragma unroll
                for (int ks = 0; ks < 4; ++ks) acc[vb] = MFMA16(lds_frag(STL, vr, LP, 32 * ks + 8 * q), qf[ks], acc[vb]);
#pragma unroll
                for (int ks = 0; ks < 2; ++ks) acc[vb] = MFMA16(lds_frag(VT, vr, LP64, 32 * ks + 8 * q), pf[ks], acc[vb]);
                sq += (acc[vb][0] * acc[vb][0] + acc[vb][1] * acc[vb][1]) + (acc[vb][2] * acc[vb][2] + acc[vb][3] * acc[vb][3]); }
            sq += __shfl_xor(sq, 16); sq += __shfl_xor(sq, 32);
            if (q == 0) SQ[vh * 64 + t] = sq;
            LDS_SYNC();
            const float rstd = rsqrtf((SQ[t] + SQ[64 + t]) * (1.0f / 128.f) + EPS);
#pragma unroll
            for (int vb = 0; vb < 4; ++vb) { const int v0 = 64 * vh + 16 * vb + 4 * q; const f32x4 hn = *(const f32x4*)(hnorm + h * 128 + v0);
                const u32x2 gw = *(const u32x2*)(PROJ + (size_t)(tc + t) * ABIN + 5120 + h * 128 + v0);
                f32x4 y; y[0] = acc[vb][0] * rstd * hn[0] * bflo(gw.x); y[1] = acc[vb][1] * rstd * hn[1] * bfhi(gw.x); y[2] = acc[vb][2] * rstd * hn[2] * bflo(gw.y); y[3] = acc[vb][3] * rstd * hn[3] * bfhi(gw.y);
                *(u32x2*)(YAB + (size_t)(tc + t) * D + 1024 + h * 128 + v0) = pack4(y); }
        }
        LDS_SYNC();
#pragma unroll
        for (int i = 0; i < 16; ++i) { lf[i] = nlf[i]; qv[i] = nqv[i]; vv[i] = nvv[i]; }
#pragma unroll
        for (int i = 0; i < 4; ++i) st[i] = nst[i];
    }
    WG_SYNC();
}
__device__ __forceinline__ void ssd_prep_load(u32x4 (&rows)[7], const bf16* XBC, int u, int ch8, int tr) {
    const int bc = u / 48, cblk = u % 48, c = bc & 31; const bf16* src = XBC + (size_t)(bc * 128 + 4 * tr - 3) * SSDCONV + cblk * 128 + ch8 * 8;
#pragma unroll
    for (int i = 0; i < 7; ++i) { rows[i] = (u32x4){0u, 0u, 0u, 0u}; if (c > 0 || 4 * tr + i >= 3) rows[i] = *(const u32x4*)(src + (size_t)i * SSDCONV); }
}
__device__ __forceinline__ void ssd_prep_units(const int tid, LAS unsigned char* lds, int ufirst, int ustride, int uend, const bf16* XBC, const float* cw, const float* cb, bf16* XBT, bf16* BCN) {
    LAS bf16* T = (LAS bf16*)(lds);
    const int ch8 = tid & 15, tr = tid >> 4;
    u32x4 rows[7], nrows[7];
    if (ufirst < uend) ssd_prep_load(rows, XBC, ufirst, ch8, tr);
    for (int u = ufirst; u < uend; u += ustride) {
        const int bc = u / 48, cblk = u % 48; const int t0 = bc * 128; const int ch0 = cblk * 128 + ch8 * 8;
        if (u + ustride < uend) ssd_prep_load(nrows, XBC, u + ustride, ch8, tr);
        float w[4][8], bb[8];
        { const f32x4 b0 = *(const f32x4*)(cb + ch0), b1 = *(const f32x4*)(cb + ch0 + 4);
#pragma unroll
          for (int e = 0; e < 4; ++e) { bb[e] = b0[e]; bb[4 + e] = b1[e]; }
#pragma unroll
          for (int k = 0; k < 4; ++k) { const f32x4 w0 = *(const f32x4*)(cw + (size_t)k * SSDCONV + ch0), w1 = *(const f32x4*)(cw + (size_t)k * SSDCONV + ch0 + 4);
#pragma unroll
              for (int e = 0; e < 4; ++e) { w[k][e] = w0[e]; w[k][4 + e] = w1[e]; } } }
        u32x4 ov[4];
#pragma unroll
        for (int i = 0; i < 4; ++i) { float o[8];
#pragma unroll
            for (int e = 0; e < 8; ++e) { float a = bb[e];
#pragma unroll
                for (int k = 0; k < 4; ++k) { const unsigned wd = rows[i + k][e >> 1]; a += w[k][e] * ((e & 1) ? bfhi(wd) : bflo(wd)); }
                o[e] = siluf(a); }
            u32x4 pk; pk.x = cvt_pk_bf16(o[0], o[1]); pk.y = cvt_pk_bf16(o[2], o[3]); pk.z = cvt_pk_bf16(o[4], o[5]); pk.w = cvt_pk_bf16(o[6], o[7]);
            if (cblk >= 32) *(u32x4*)(BCN + (size_t)(t0 + 4 * tr + i) * 2048 + (ch0 - 4096)) = pk;
            ov[i] = pk; }
        if (cblk < 40) {
#pragma unroll
            for (int e = 0; e < 8; ++e) { u32x2 w;
                const unsigned a0 = ov[0][e >> 1], a1 = ov[1][e >> 1], a2 = ov[2][e >> 1], a3 = ov[3][e >> 1];
                if (e & 1) { w.x = (a0 >> 16) | (a1 & 0xffff0000u); w.y = (a2 >> 16) | (a3 & 0xffff0000u); } else { w.x = (a0 & 0xffffu) | (a1 << 16); w.y = (a2 & 0xffffu) | (a3 << 16); }
                *(LAS u32x2*)(T + (ch8 * 8 + e) * LP + 8 * ((tr >> 1) ^ ch8) + 4 * (tr & 1)) = w; }
            LDS_SYNC();
#pragma unroll
            for (int i = 0; i < 4; ++i) { const int p = tid + NTHR * i, r = p >> 4, pc = p & 15;
                *(u32x4*)(XBT + ((size_t)bc * 5120 + cblk * 128 + r) * 128 + pc * 8) = *(const LAS u32x4*)(T + r * LP + 8 * (pc ^ (r >> 3))); }
            LDS_SYNC();
        }
#pragma unroll
        for (int i = 0; i < 7; ++i) rows[i] = nrows[i];
    }
    WG_SYNC();
}
__device__ __forceinline__ float ssd_tables(const float* DT, const float* a_log, int t0, int hd, int wid, int lane, LAS float* CUM, LAS float* DTS) {
    const float an = -__expf(a_log[hd]);
    const float d0 = DT[(size_t)(t0 + 2 * lane) * 64 + hd], d1 = DT[(size_t)(t0 + 2 * lane + 1) * 64 + hd];
    const float a0 = d0 * an, a1 = d1 * an; float v = a0 + a1;
#pragma unroll
    for (int o = 1; o < 64; o <<= 1) { const float t = __shfl_up(v, o); if (lane >= o) v += t; }
    CUM[wid * 128 + 2 * lane] = v - a1; CUM[wid * 128 + 2 * lane + 1] = v; DTS[wid * 128 + 2 * lane] = d0; DTS[wid * 128 + 2 * lane + 1] = d1;
    return __shfl(v, 63);
}
__device__ __forceinline__ void ssd1_units(const int tid, LAS unsigned char* lds, int G, int cu, const bf16* XBT, const float* DT, const float* a_log, bf16* ST, float* DEC) {
    const int wid = __builtin_amdgcn_readfirstlane(tid >> 6), lane = tid & 63, q = lane >> 4, c16 = lane & 15;
    LAS bf16* BT = (LAS bf16*)(lds);
    LAS float* CUM = (LAS float*)(lds + 34816);
    LAS float* DTS = (LAS float*)(lds + 38912);
    for (int u = cu; u < 1024; u += G) {
        const int bc = u >> 3, g = u & 7, t0 = bc * 128, hd = g * 8 + wid;
#pragma unroll
        for (int i = 0; i < 4; ++i) { const int p = tid + NTHR * i, r = p >> 4, pc = p & 15;
            *(LAS u32x4*)(BT + r * LP + pc * 8) = *(const u32x4*)(XBT + ((size_t)bc * 5120 + 4096 + g * 128 + r) * 128 + pc * 8); }
        const float last = ssd_tables(DT, a_log, t0, hd, wid, lane, CUM, DTS);
        if (lane == 0) DEC[bc * 64 + hd] = __expf(last);
        u32x4 xr[4][4];
#pragma unroll
        for (int pb = 0; pb < 4; ++pb)
#pragma unroll
            for (int ks = 0; ks < 4; ++ks) xr[pb][ks] = *(const u32x4*)(XBT + ((size_t)bc * 5120 + hd * 64 + 16 * pb + c16) * 128 + 32 * ks + 8 * q);
        WG_SYNC();
        bf16x8 xf[4][4];
#pragma unroll
        for (int ks = 0; ks < 4; ++ks) { float sc[8];
#pragma unroll
            for (int j = 0; j < 8; ++j) { const int s = 32 * ks + 8 * q + j; sc[j] = DTS[wid * 128 + s] * __expf(last - CUM[wid * 128 + s]); }
#pragma unroll
            for (int pb = 0; pb < 4; ++pb) { u32x4 o;
#pragma unroll
                for (int e = 0; e < 4; ++e) o[e] = cvt_pk_bf16(bflo(xr[pb][ks][e]) * sc[2 * e], bfhi(xr[pb][ks][e]) * sc[2 * e + 1]);
                xf[pb][ks] = __builtin_bit_cast(bf16x8, o); } }
#pragma unroll
        for (int nb = 0; nb < 8; ++nb) { bf16x8 bf[4];
#pragma unroll
            for (int ks = 0; ks < 4; ++ks) bf[ks] = lds_frag(BT, 16 * nb + c16, LP, 32 * ks + 8 * q);
#pragma unroll
            for (int pb = 0; pb < 4; ++pb) { f32x4 acc = (f32x4){0.f, 0.f, 0.f, 0.f};
#pragma unroll
                for (int ks = 0; ks < 4; ++ks) acc = MFMA16(bf[ks], xf[pb][ks], acc);
                *(u32x2*)(ST + (((size_t)bc * 64 + hd) * 64 + 16 * pb + c16) * 128 + 16 * nb + 4 * q) = pack4(acc); } }
        WG_SYNC();
    }
}
__device__ __forceinline__ void ssd2_scan(const int tid, int G, int cu, bf16* ST, const float* DEC) {
    for (int task = cu * NTHR + tid; task < NB * 4096 * 32; task += G * NTHR) {
        const int b = task >> 17, r = task & 131071, hp = r >> 5, n4 = (r & 31) * 4, hd = hp >> 6; f32x4 S = (f32x4){0.f, 0.f, 0.f, 0.f};
        bf16* p0 = ST + ((size_t)(b * 32) * 4096 + hp) * 128 + n4; const float* d0 = DEC + (b * 32) * 64 + hd;
        u32x2 L[32]; float d[32];
#pragma unroll
        for (int c = 0; c < 32; ++c) { L[c] = *(const u32x2*)(p0 + (size_t)c * 4096 * 128); d[c] = d0[c * 64]; }
#pragma unroll
        for (int c = 0; c < 32; ++c) { *(u32x2*)(p0 + (size_t)c * 4096 * 128) = pack4(S);
            S[0] = d[c] * S[0] + bflo(L[c].x); S[1] = d[c] * S[1] + bfhi(L[c].x); S[2] = d[c] * S[2] + bflo(L[c].y); S[3] = d[c] * S[3] + bfhi(L[c].y); }
    }
}
__device__ __forceinline__ void ssd3_units(const int tid, LAS unsigned char* lds, int G, int cu, const bf16* XBT, const bf16* BCN, const bf16* ST, const float* DT, const float* a_log, const float* dskip,
                                           const bf16* Z, const float* normw, bf16* Y) {
    const int wid = __builtin_amdgcn_readfirstlane(tid >> 6), lane = tid & 63, q = lane >> 4, c16 = lane & 15;
    LAS bf16* CN = (LAS bf16*)(lds);
    LAS bf16* BN = (LAS bf16*)(lds + 34816);
    LAS bf16* CB = (LAS bf16*)(lds + 69632);
    LAS float* CUM = (LAS float*)(lds + 104448);
    LAS float* DTS = (LAS float*)(lds + 108544);
    LAS float* SQP = (LAS float*)(lds + 112640);
    for (int u = cu; u < 1024; u += G) {
        const int bc = u >> 3, g = u & 7, t0 = bc * 128, hd = g * 8 + wid;
#pragma unroll
        for (int i = 0; i < 4; ++i) { const int p = tid + NTHR * i, r = p >> 4, pc = p & 15; const bf16* src = BCN + (size_t)(t0 + r) * 2048 + g * 128 + pc * 8;
            *(LAS u32x4*)(BN + r * LP + pc * 8) = *(const u32x4*)src; *(LAS u32x4*)(CN + r * LP + pc * 8) = *(const u32x4*)(src + 1024); }
        (void)ssd_tables(DT, a_log, t0, hd, wid, lane, CUM, DTS);
        bf16x8 sf[4][4];
        const bf16* xb = XBT + ((size_t)bc * 5120 + hd * 64 + c16) * 128 + 8 * q;
        { const bf16* sb = ST + (((size_t)bc * 64 + hd) * 64 + c16) * 128 + 8 * q;
#pragma unroll
          for (int pb = 0; pb < 4; ++pb)
#pragma unroll
              for (int ks = 0; ks < 4; ++ks) sf[pb][ks] = *(const bf16x8*)(sb + (size_t)(16 * pb) * 128 + 32 * ks); }
        WG_SYNC();
        {
            bf16x8 cf[4];
#pragma unroll
            for (int ks = 0; ks < 4; ++ks) cf[ks] = lds_frag(CN, 16 * wid + c16, LP, 32 * ks + 8 * q);
#pragma unroll
            for (int sb = 0; sb < 8; ++sb) { if (sb > wid + 1) continue; f32x4 acc = (f32x4){0.f, 0.f, 0.f, 0.f};
#pragma unroll
                for (int ks = 0; ks < 4; ++ks) acc = MFMA16(lds_frag(BN, 16 * sb + c16, LP, 32 * ks + 8 * q), cf[ks], acc);
                *(LAS u32x2*)(CB + (16 * wid + c16) * LP + 16 * sb + 4 * q) = pack4(acc); }
        }
        WG_SYNC();
        const float dsk = dskip[hd];
        bf16* ybase = Y + (size_t)t0 * SSDIN + hd * 64 + 4 * q; const bf16* zbase = Z + (size_t)t0 * SSDIN + hd * 64 + 4 * q;
        const f32x4 nw0 = *(const f32x4*)(normw + hd * 64 + 4 * q), nw1 = *(const f32x4*)(normw + hd * 64 + 16 + 4 * q), nw2 = *(const f32x4*)(normw + hd * 64 + 32 + 4 * q), nw3 = *(const f32x4*)(normw + hd * 64 + 48 + 4 * q);
#pragma unroll 1
        for (int tp = 0; tp < 8; ++tp) {
        u32x2 yk[1][4];
#pragma unroll
        for (int tt = 0; tt < 1; ++tt) { const int tb = tp;
            const int tl = 16 * tb + c16; const float cumt = CUM[wid * 128 + tl], ect = __expf(cumt);
            f32x4 acc[4];
            { bf16x8 cf[4];
#pragma unroll
              for (int ks = 0; ks < 4; ++ks) cf[ks] = lds_frag(CN, tl, LP, 32 * ks + 8 * q);
#pragma unroll
              for (int pb = 0; pb < 4; ++pb) { acc[pb] = (f32x4){0.f, 0.f, 0.f, 0.f};
#pragma unroll
                  for (int ks = 0; ks < 4; ++ks) acc[pb] = MFMA16(sf[pb][ks], cf[ks], acc[pb]);
                  acc[pb] = acc[pb] * ect; } }
#pragma unroll
            for (int ks = 0; ks < 4; ++ks) { if (32 * ks > 16 * tb + 15) continue;
                const int s0 = 32 * ks + 8 * q; const u32x4 cbw = *(const LAS u32x4*)(CB + tl * LP + s0);
                const f32x4 c0 = *(const LAS f32x4*)(CUM + wid * 128 + s0), c1 = *(const LAS f32x4*)(CUM + wid * 128 + s0 + 4), d0 = *(const LAS f32x4*)(DTS + wid * 128 + s0), d1 = *(const LAS f32x4*)(DTS + wid * 128 + s0 + 4);
                float gv[8];
#pragma unroll
                for (int j = 0; j < 8; ++j) { const int s = s0 + j; const float cb = (j & 1) ? bfhi(cbw[j >> 1]) : bflo(cbw[j >> 1]); const float cs = j < 4 ? c0[j & 3] : c1[j & 3], ds = j < 4 ? d0[j & 3] : d1[j & 3];
                    float v = cb * __expf(fminf(cumt - cs, 0.f)) * ds; v = (s <= tl) ? v : 0.f; gv[j] = (s == tl) ? v + dsk : v; }
                u32x4 gw; gw.x = cvt_pk_bf16(gv[0], gv[1]); gw.y = cvt_pk_bf16(gv[2], gv[3]); gw.z = cvt_pk_bf16(gv[4], gv[5]); gw.w = cvt_pk_bf16(gv[6], gv[7]);
                const bf16x8 gf = __builtin_bit_cast(bf16x8, gw);
#pragma unroll
                for (int pb = 0; pb < 4; ++pb) acc[pb] = MFMA16(*(const bf16x8*)(xb + (size_t)(16 * pb) * 128 + 32 * ks), gf, acc[pb]);
            }
            float sq = 0.f;
#pragma unroll
            for (int pb = 0; pb < 4; ++pb) { const u32x2 zw = *(const u32x2*)(zbase + (size_t)tl * SSDIN + 16 * pb);
                f32x4 y; y[0] = acc[pb][0] * bflo(zw.x); y[1] = acc[pb][1] * bfhi(zw.x); y[2] = acc[pb][2] * bflo(zw.y); y[3] = acc[pb][3] * bfhi(zw.y);
                sq += (y[0] * y[0] + y[1] * y[1]) + (y[2] * y[2] + y[3] * y[3]); yk[tt][pb] = pack4(y); }
            sq += __shfl_xor(sq, 16); sq += __shfl_xor(sq, 32);
            if (q == 0) SQP[tl * 8 + wid] = sq;
        }
        WG_SYNC();
#pragma unroll
        for (int tt = 0; tt < 1; ++tt) { const int tl = 16 * tp + c16; const f32x4 s0 = *(const LAS f32x4*)(SQP + tl * 8), s1 = *(const LAS f32x4*)(SQP + tl * 8 + 4);
            const float rstd = rsqrtf((((s0[0] + s0[1]) + (s0[2] + s0[3])) + ((s1[0] + s1[1]) + (s1[2] + s1[3]))) * (1.0f / 512.f) + EPS);
#pragma unroll
            for (int pb = 0; pb < 4; ++pb) { bf16* yp = ybase + (size_t)tl * SSDIN + 16 * pb; const u32x2 w = yk[tt][pb]; const f32x4 nw = pb == 0 ? nw0 : pb == 1 ? nw1 : pb == 2 ? nw2 : nw3;
                f32x4 y; y[0] = bflo(w.x) * rstd * nw[0]; y[1] = bfhi(w.x) * rstd * nw[1]; y[2] = bflo(w.y) * rstd * nw[2]; y[3] = bfhi(w.y) * rstd * nw[3];
                *(u32x2*)yp = pack4(y); } }
        }
        WG_SYNC();
    }
}
#ifndef REP_GEMM
#define REP_GEMM 1
#endif
#if REP_GEMM == 2
#define GEMM_REP(...) { __VA_ARGS__ } { __VA_ARGS__ }
#else
#define GEMM_REP(...) { __VA_ARGS__ }
#endif
#ifndef REP_MIX
#define REP_MIX 1
#endif
#ifndef REP_CONV
#define REP_CONV 1
#endif
struct Args { In in; float* out; unsigned char* ws; int ph_lo, ph_hi; };
static_assert(sizeof(Args) == 32 * 8 + 8 + 8 + 8, "Args has no padding");
typedef const Args __attribute__((address_space(4))) CArgs;

#ifndef SLEEP_MASK
#define SLEEP_MASK 0ull
#endif
#define SLEEP_AMP 4
#define PHASE_BEGIN if (pc >= lo && pc < hi) { const unsigned long long t0_ = SLEEP_MASK ? __builtin_amdgcn_s_memrealtime() : 0ull; (void)t0_; int tid = wave0 * 64 + (int)__builtin_amdgcn_mbcnt_hi(~0u, __builtin_amdgcn_mbcnt_lo(~0u, 0u)); asm volatile("" : "+v"(tid)); int cu = blockIdx.x; asm volatile("" : "+s"(cu)); int G = gridDim.x; asm volatile("" : "+s"(G)); \
        const int lane = tid & 63, wave = __builtin_amdgcn_readfirstlane(tid >> 6), gw = cu * NWAVES + wave, NGW = G * NWAVES; (void)lane; (void)gw; (void)NGW; \
        CArgs* ap = (CArgs*)__builtin_amdgcn_kernarg_segment_ptr(); asm volatile("" : "+s"(ap)); CIn& I = ap->in; unsigned char* const ws = ap->ws; float* const xres = ap->out; \
        unsigned char* const act = ws + WS_ACT; float* const SS = (float*)(ws + WS_SS); bf16* const XB = (bf16*)(ws + WS_XB); bf16* const WL = (bf16*)(ws + WS_WL); (void)I; (void)xres; (void)act; (void)SS; (void)XB; (void)WL;
#if MK_SPLIT
#define PHASE_END } ++pc;
#else
#define PHASE_END if (pc + 1 < hi) xcd_barrier(bar); if (SLEEP_MASK && ((SLEEP_MASK >> pc) & 1ull)) { const unsigned long long t1_ = __builtin_amdgcn_s_memrealtime(), until_ = t1_ + SLEEP_AMP * (t1_ - t0_); while (__builtin_amdgcn_s_memrealtime() < until_) __builtin_amdgcn_s_sleep(8); } } ++pc;
#endif
#define PHASE_END_LOCAL } ++pc;
#define D_WKV ((bf16*)(ws + WS_WKV))
#define D_KMAT ((bf16*)(ws + WS_KMAT))
#define D_VT ((bf16*)(ws + WS_VT))
#define D_MEMN ((bf16*)(ws + WS_MEMN))
#define D_LB ((float*)(ws + WS_TAB + TAB_LB))
#define D_WRT ((bf16*)(ws + WS_TAB + TAB_WRT))


template <int l>
__device__ __forceinline__ void layer_body(LAS unsigned char* lds, const int wave0, const int lo, const int hi, int& pc, const XcdBarrier& bar) {
    int ssi = 3 * l;

        if (l > 0) {
            PHASE_BEGIN
                int rot = 0; for (int rep_ = 0; rep_ < REP_CONV; ++rep_) { convert_layer(I, l, WL, (LAS float*)(lds + wave * 16640), gw, NGW, lane, rot); }
            PHASE_END
        }
        const int e = l >> 1;
        int mixK;
        if ((l & 1) == 0) {
#define PROJ ((bf16*)(act + A_PROJ))
#define LOGF ((float*)(act + A_LOGF))
#define HST ((bf16*)(act + A_HST))
#define YAB ((bf16*)(act + A_YAB))
#define SEG ((float*)(act + A_SEG))
#define HDEC ((float*)(act + A_HDEC))
            PHASE_BEGIN
                if (l == 0) { pg8::SchedKV S{(const char*)D_MEMN, (const char*)D_WKV, G, cu}; pg8::EpiKV E{D_KMAT, D_VT}; pg8::gemm_phase(tid, lds, D, D, D, S, E); asm volatile("" : "+v"(tid)); }
                GEMM_REP(pg8::SchedMN S; S.init(XB, D, WL + WL_IN, D, M, ABIN, G, cu); pg8::EpiProjEven E{SS + (size_t)ssi * M * 8, PROJ, LOGF, D_LB + e * 1024};
                pg8::gemm_phase<RF16>(tid, lds, D, D, D, S, E);)
            PHASE_END
            PHASE_BEGIN
                for (int rep_ = 0; rep_ < REP_MIX; ++rep_) { lru_units<false>(tid, lds, G, cu, PROJ, D_WRT + (size_t)e * 2 * 8 * 16384, I.lru_conv_w + e * 4 * LRUW, I.lru_conv_b + e * LRUW, I.lru_b_r + e * LRUW, I.lru_b_i + e * LRUW, I.lru_lambda + e * LRUW, SEG, YAB);
                hgrn1_units(tid, lds, G, cu, LOGF, PROJ, HST, HDEC); }
            PHASE_END
            PHASE_BEGIN
                for (int rep_ = 0; rep_ < REP_MIX; ++rep_) { lru_units<true>(tid, lds, G, cu, PROJ, D_WRT + (size_t)e * 2 * 8 * 16384, I.lru_conv_w + e * 4 * LRUW, I.lru_conv_b + e * LRUW, I.lru_b_r + e * LRUW, I.lru_b_i + e * LRUW, I.lru_lambda + e * LRUW, SEG, YAB); }
                hgrn2_scan(tid, G, cu, HST, HDEC);
            PHASE_END
            PHASE_BEGIN
                for (int rep_ = 0; rep_ < REP_MIX; ++rep_) { hgrn3_units(tid, lds, G, cu, LOGF, PROJ, HST, I.hgrn_norm + e * 1024, YAB); }
            PHASE_END
            mixK = D;
        } else {
#define Zb ((bf16*)(act + A_Z))
#define XBC ((bf16*)(act + A_XBC))
#define XBT ((bf16*)(act + A_XBT))
#define BCN ((bf16*)(act + A_BCN))
#define STb ((bf16*)(act + A_ST))
#define DTb ((float*)(act + A_DT))
#define DEC ((float*)(act + A_DEC))
#define Yb ((bf16*)(act + A_Y))
            PHASE_BEGIN
                GEMM_REP(pg8::SchedMN S; S.init(XB, D, WL + WL_IN, D, M, SSDN1, G, cu); pg8::EpiProjOdd E{SS + (size_t)ssi * M * 8, Zb, XBC};
                pg8::gemm_phase<RF16>(tid, lds, D, D, D, S, E);)
            PHASE_END
            PHASE_BEGIN
                for (int rep_ = 0; rep_ < REP_MIX; ++rep_) {
                { pg8::SchedDt S{(const char*)XB, (const char*)(WL + WL_DT), cu}; pg8::EpiDt E{SS + (size_t)ssi * M * 8, I.ssd_dt_bias + e * 64, DTb};
                  pg8::gemm_phase<RF16>(tid, lds, D, D, D, S, E); }
                { int uf = cu, us = G, ue = 6144; if (G == 256) { if (cu < 64) { us = 64; ue = 1152; } else { uf = 1152 + (cu - 64); us = 192; } }
                  ssd_prep_units(tid, lds, uf, us, ue, XBC, I.ssd_conv_w + (size_t)e * 4 * SSDCONV, I.ssd_conv_b + e * SSDCONV, XBT, BCN); }
                }
            PHASE_END
            PHASE_BEGIN
                for (int rep_ = 0; rep_ < REP_MIX; ++rep_) { ssd1_units(tid, lds, G, cu, XBT, DTb, I.ssd_a_log + e * 64, STb, DEC); }
            PHASE_END
            PHASE_BEGIN
                ssd2_scan(tid, G, cu, STb, DEC);
            PHASE_END
            PHASE_BEGIN
                for (int rep_ = 0; rep_ < REP_MIX; ++rep_) { ssd3_units(tid, lds, G, cu, XBT, BCN, STb, DTb, I.ssd_a_log + e * 64, I.ssd_d + e * 64, Zb, I.ssd_norm + e * SSDIN, Yb); }
            PHASE_END
            mixK = SSDIN;
        }
        PHASE_BEGIN
            pg8::SchedMN S; S.init(mixK == D ? (const bf16*)YAB : (const bf16*)Yb, mixK, WL + WL_OUT, mixK, M, D, G, cu); pg8::EpiResid E{XB, SS + (size_t)(ssi + 1) * M * 8, (LAS float*)(lds + EPI_OFF)};
            pg8::gemm_phase(tid, lds, mixK, mixK, mixK, S, E);
        PHASE_END
        ++ssi;
#define Qb ((bf16*)(act + A_Q))
#define Pb ((bf16*)(act + A_P))
#define Ob ((bf16*)(act + A_O))
#define Hb ((bf16*)(act + A_H))
        PHASE_BEGIN
            if (cu < 256) { const int pm = (cu & 7) * 8 + (cu >> 5), h = (cu >> 3) & 3;     int nu = 2; asm volatile("" : "+s"(nu));
                pg8::SchedChainQ S{(const char*)XB, (const char*)(WL + WL_Q), pm, h, nu}; pg8::EpiQ E{SS + (size_t)ssi * M * 8, Qb, 0.044194173824159216f}; pg8::gemm_phase<RF16>(tid, lds, D, D, D, S, E); }
        PHASE_END_LOCAL
        PHASE_BEGIN
            if (cu < 256) { const int pm = (cu & 7) * 8 + (cu >> 5), h = (cu >> 3) & 3;     int nu = 1, kk = XAD; asm volatile("" : "+s"(nu), "+s"(kk));
                pg8::SchedChainS S{(const char*)Qb, (const char*)(D_KMAT + (size_t)l * MEMROWS * D), pm, h, nu}; pg8::EpiSoftmax E{Pb, (LAS float*)(lds + EPI_OFF)}; pg8::gemm_phase(tid, lds, kk, D, D, S, E); }
        PHASE_END_LOCAL
        PHASE_BEGIN
            if (cu < 256) { const int pm = (cu & 7) * 8 + (cu >> 5), h = (cu >> 3) & 3;     int nu = 2, kk = MEMLEN; asm volatile("" : "+s"(nu), "+s"(kk));
                pg8::SchedChainPV S{(const char*)Pb, (const char*)(D_VT + (size_t)l * D * MEMROWS), pm, h, nu}; pg8::EpiPlain E{Ob, D}; pg8::gemm_phase(tid, lds, kk, 1024, MEMROWS, S, E); }
        PHASE_END
        PHASE_BEGIN
            pg8::SchedMN S; S.init(Ob, D, WL + WL_O, D, M, D, G, cu); pg8::EpiResid E{XB, SS + (size_t)(ssi + 1) * M * 8, (LAS float*)(lds + EPI_OFF)};
            pg8::gemm_phase(tid, lds, D, D, D, S, E);
        PHASE_END
        ++ssi;
        PHASE_BEGIN
            GEMM_REP(pg8::SchedMN S; S.init(XB, D, WL + WL_GU, D, M, 2 * FF, G, cu); pg8::EpiGateUp E{SS + (size_t)ssi * M * 8, Hb};
            pg8::gemm_phase<RF16>(tid, lds, D, D, D, S, E);)
        PHASE_END
        PHASE_BEGIN
            pg8::SchedMN S; S.init(Hb, FF, WL + WL_DN, FF, M, D, G, cu); pg8::EpiResid E{XB, SS + (size_t)(ssi + 1) * M * 8, (LAS float*)(lds + EPI_OFF)};
            pg8::gemm_phase(tid, lds, FF, FF, FF, S, E);
        PHASE_END
        ++ssi;
    }

__global__ void __launch_bounds__(NTHR, 2) fwd(Args args) {
    extern __shared__ __attribute__((aligned(16))) unsigned char lds_raw[];
    LAS unsigned char* lds = (LAS unsigned char*)lds_raw;
    volatile LAS unsigned* MISC = (volatile LAS unsigned*)(lds + MISC_OFF);
    const int wave0 = __builtin_amdgcn_readfirstlane((int)threadIdx.x >> 6);
    if (threadIdx.x < 64) MISC[threadIdx.x] = 0u;
    __syncthreads();
#if !MK_SPLIT
    XcdBarrier bar = xcd_barrier_post((unsigned*)(args.ws + WS_CTL), MISC + 8);
#else
    XcdBarrier bar; bar.bar = nullptr; bar.x = 0; bar.st = nullptr;
#endif
    const int lo = args.ph_lo, hi = args.ph_hi; int pc = 0;
    PHASE_BEGIN
        LAS float* scr = (LAS float*)(lds + wave * 16640);
        int rot = 0;
        for (int l = 0; l < DEPTH; ++l) conv_matrix<0>(I.xa_w_kv + (size_t)l * D * 4096, 4096, D, 0, 4096, nullptr, D_WKV + (size_t)l * 4096 * D, 0, scr, gw, NGW, lane, rot);
        for (int rep_ = 0; rep_ < REP_CONV; ++rep_) convert_layer(I, 0, WL, scr, gw, NGW, lane, rot);
        for (int m = gw; m < MEMROWS; m += NGW) {
            const f32x4* xr = (const f32x4*)(I.mem + (size_t)m * D); f32x4 v[8]; float s = 0.f;
#pragma unroll
            for (int j = 0; j < 8; ++j) { v[j] = xr[64 * j + lane]; s += (v[j][0] * v[j][0] + v[j][1] * v[j][1]) + (v[j][2] * v[j][2] + v[j][3] * v[j][3]); }
            const float rs = rsqrtf(wave_sum(s) * (1.0f / D) + EPS);
#pragma unroll
            for (int j = 0; j < 8; ++j) { const f32x4 g = *(const f32x4*)(I.norm_mem + (64 * j + lane) * 4); *(u32x2*)(D_MEMN + (size_t)m * D + (64 * j + lane) * 4) = pack4(v[j] * rs * g); }
        }
        for (int m = gw; m < M; m += NGW) {
            const f32x4* xr = (const f32x4*)(I.x + (size_t)m * D); float s = 0.f;
#pragma unroll
            for (int j = 0; j < 8; ++j) { const f32x4 v = xr[64 * j + lane]; s += (v[0] * v[0] + v[1] * v[1]) + (v[2] * v[2] + v[3] * v[3]); u32x2 w; w.x = rs_pk(v[0], v[1]); w.y = rs_pk(v[2], v[3]); *(u32x2*)(XB + (size_t)m * D + (64 * j + lane) * 4) = w; }
            s = wave_sum(s); if (lane < 8) SS[(size_t)m * 8 + lane] = lane == 0 ? s : 0.f;
        }
        for (int i = cu * NTHR + tid; i < 1024; i += G * NTHR) {
            const float a = I.hgrn_lb[i], b = I.hgrn_lb[1024 + i], mx = fmaxf(a, b), e0 = __expf(a - mx), e1 = __expf(b - mx); D_LB[i] = 0.f; D_LB[1024 + i] = e1 / (e0 + e1); }
        for (int i = cu * NTHR + tid; i < 2 * 2 * 8 * 16384; i += G * NTHR) {
            const int ii = i & 127, jj = (i >> 7) & 127, blk = (i >> 14) & 7, gt = (i >> 17) & 1, e = i >> 18;
            const float* src = gt ? I.lru_w_i : I.lru_w_r; D_WRT[i] = (bf16)f2bf(src[((size_t)(e * 8 + blk) * 128 + ii) * 128 + jj]); }
    PHASE_END

    layer_body<0>(lds, wave0, lo, hi, pc, bar); layer_body<1>(lds, wave0, lo, hi, pc, bar); layer_body<2>(lds, wave0, lo, hi, pc, bar); layer_body<3>(lds, wave0, lo, hi, pc, bar);
    const int ssi = 12;
    PHASE_BEGIN
        const float* ssf = SS + (size_t)ssi * M * 8;
        for (int m = gw; m < M; m += NGW) { f32x4* row = (f32x4*)(xres + (size_t)m * D); const u32x2* xr = (const u32x2*)(XB + (size_t)m * D); const float rs = pg8::rstd_of(ssf, m);
#pragma unroll
            for (int j = 0; j < 8; ++j) { const f32x4 g = *(const f32x4*)(I.norm_final + (64 * j + lane) * 4); const u32x2 w = xr[64 * j + lane];
                f32x4 o; o[0] = rs_lo(w.x) * rs * g[0]; o[1] = rs_hi(w.x) * rs * g[1]; o[2] = rs_lo(w.y) * rs * g[2]; o[3] = rs_hi(w.y) * rs * g[3]; row[64 * j + lane] = o; } }
    PHASE_END
#undef PHASE_BEGIN
#undef PHASE_END
}

constexpr int NPHASES = 1 + (5 + 6) + (1 + 6 + 6) + (1 + 5 + 6) + (1 + 6 + 6) + 1;

extern "C" void kernel_launch(void* const* d_in, const int* in_sizes, int n_in, void* d_out, int out_size, void* d_ws, size_t ws_size, hipStream_t stream) {
    static int grid = 0;
    if (grid == 0) {
        if (n_in != 32 || out_size != M * D || ws_size < WS_END) { fprintf(stderr, "kernel_launch: unexpected problem (n_in %d, out %d, ws %zu)\n", n_in, out_size, ws_size); grid = -1; return; }
        int dev = 0, cus = 0;
        if (hipGetDevice(&dev) != hipSuccess || hipDeviceGetAttribute(&cus, hipDeviceAttributeMultiprocessorCount, dev) != hipSuccess) { grid = -1; return; }
        if (hipFuncSetAttribute((const void*)fwd, hipFuncAttributeMaxDynamicSharedMemorySize, LDS_BYTES) != hipSuccess) { fprintf(stderr, "kernel_launch: hipFuncSetAttribute failed\n"); grid = -1; return; }
        int per_cu = 0;
        if (hipOccupancyMaxActiveBlocksPerMultiprocessor(&per_cu, (const void*)fwd, NTHR, LDS_BYTES) != hipSuccess || per_cu < 1) fprintf(stderr, "kernel_launch: occupancy query says %d\n", per_cu);
        (void)hipGetLastError();
        if (cus != 256) { fprintf(stderr, "kernel_launch: built for a 256-CU device (got %d)\n", cus); grid = -1; return; }
        grid = cus;
    }
    if (grid < 0) return;
    (void)hipMemsetAsync((char*)d_ws + WS_CTL, 0, CTL_ZERO_BYTES, stream);
    Args a{};
    const float** ip = (const float**)&a.in;
    for (int i = 0; i < 32; ++i) ip[i] = (const float*)d_in[i];
    a.out = (float*)d_out; a.ws = (unsigned char*)d_ws;
#if MK_SPLIT
#ifndef PROBE_MASK
#define PROBE_MASK 0ull
#endif
    for (int li = 0; li < NPHASES; ++li) { a.ph_lo = li; a.ph_hi = li + 1; hipLaunchKernelGGL(fwd, dim3(grid), dim3(NTHR), LDS_BYTES, stream, a);
        if ((PROBE_MASK >> li) & 1ull) hipLaunchKernelGGL(fwd, dim3(grid), dim3(NTHR), LDS_BYTES, stream, a); }
#else
    a.ph_lo = 0; a.ph_hi = NPHASES;
    hipLaunchKernelGGL(fwd, dim3(grid), dim3(NTHR), LDS_BYTES, stream, a);
#endif
}
```

```cpp
#include <hip/hip_runtime.h>
#include <cstdio>
#include <cstdint>

#ifndef MK_SPLIT
#define MK_SPLIT 0
#endif

#ifndef RESID_F16
#define RESID_F16 0
#endif
constexpr bool RF16 = RESID_F16 != 0;
#define GAS __attribute__((address_space(1)))
#define LAS __attribute__((address_space(3)))
typedef unsigned short bf16;
typedef short bf16x8 __attribute__((ext_vector_type(8)));
typedef float f32x4 __attribute__((ext_vector_type(4)));
typedef float f32x2 __attribute__((ext_vector_type(2)));
typedef unsigned u32x4 __attribute__((ext_vector_type(4)));
typedef unsigned u32x2 __attribute__((ext_vector_type(2)));

constexpr int D = 2048, NB = 4, SEQ = 4096, M = NB * SEQ, DEPTH = 4, MEMLEN = 256, MEMROWS = NB * MEMLEN;
constexpr int LRUW = 1024, ABIN = 6144;
constexpr int SSDIN = 4096, SSDCONV = 6144, SSDPROJ = 10304, SSDN1 = 10240, NHEADS = 64;
constexpr int XAD = 512, FF = 5632;
constexpr float EPS = 1e-6f;
constexpr int NWAVES = 8, NTHR = 512;

constexpr size_t MiB = 1u << 20;
constexpr size_t WS_CTL = 0, CTL_ZERO_BYTES = 1 * MiB;
constexpr size_t WS_WKV = 2 * MiB;
constexpr size_t WS_KMAT = 66 * MiB;
constexpr size_t WS_VT = 82 * MiB;
constexpr size_t WS_MEMN = 98 * MiB;
constexpr size_t WS_TAB = 102 * MiB;
constexpr size_t WS_XB = 106 * MiB;
constexpr size_t WS_WL = 170 * MiB;
constexpr size_t WS_ACT = 310 * MiB;
constexpr size_t WS_SS = (310 + 680) * MiB;
constexpr size_t WS_END = (310 + 680 + 8) * MiB;
constexpr size_t TAB_LB = 0;
constexpr size_t TAB_WRT = 64 * 1024;
constexpr size_t WL_IN = 0;
constexpr size_t WL_DT = (size_t)SSDN1 * D;
constexpr size_t WL_OUT = (size_t)(SSDN1 + 256) * D;
constexpr size_t WL_Q = WL_OUT + (size_t)D * SSDIN;
constexpr size_t WL_O = WL_Q + (size_t)D * D;
constexpr size_t WL_GU = WL_O + (size_t)D * D;
constexpr size_t WL_DN = WL_GU + (size_t)2 * FF * D;
constexpr size_t WL_ELEMS = WL_DN + (size_t)D * FF;
static_assert(WL_ELEMS * 2 <= 140 * MiB, "per-layer weights");
constexpr size_t A_Z = 0;
constexpr size_t A_XBC = 128 * MiB;
constexpr size_t A_Y = 128 * MiB;
constexpr size_t A_XBT = 320 * MiB;
constexpr size_t A_BCN = 480 * MiB;
constexpr size_t A_ST = 544 * MiB;
constexpr size_t A_DT = 672 * MiB;
constexpr size_t A_DEC = 676 * MiB;
constexpr size_t A_PROJ = 0;
constexpr size_t A_LOGF = 192 * MiB;
constexpr size_t A_HST = 256 * MiB;
constexpr size_t A_YAB = 320 * MiB;
constexpr size_t A_SEG = 384 * MiB;
constexpr size_t A_HDEC = 386 * MiB;
constexpr size_t A_Q = 0;
constexpr size_t A_P = 64 * MiB;
constexpr size_t A_O = 96 * MiB;
constexpr size_t A_H = 160 * MiB;

constexpr int LDS_BYTES = 155648;
constexpr int EPI_OFF = 131072;
constexpr int MISC_OFF = LDS_BYTES - 256;

#define LDS_WAIT() asm volatile("s_waitcnt lgkmcnt(0)" ::: "memory")
#define VM_WAIT() asm volatile("s_waitcnt vmcnt(0)" ::: "memory")
__device__ __forceinline__ unsigned f2bf(float f) { unsigned u = __builtin_bit_cast(unsigned, f); return (u + 0x7fffu + ((u >> 16) & 1u)) >> 16; }
__device__ __forceinline__ unsigned pk2(float lo, float hi) { return f2bf(lo) | (f2bf(hi) << 16); }
typedef __bf16 bf16x2v __attribute__((ext_vector_type(2)));
__device__ __forceinline__ unsigned cvt_pk_bf16(float lo, float hi) { const f32x2 v = {lo, hi}; return __builtin_bit_cast(unsigned, __builtin_convertvector(v, bf16x2v)); }
typedef _Float16 f16x2v __attribute__((ext_vector_type(2)));
typedef _Float16 f16x8 __attribute__((ext_vector_type(8)));
__device__ __forceinline__ unsigned cvt_pk_f16(float lo, float hi) { const f32x2 v = {lo, hi}; return __builtin_bit_cast(unsigned, __builtin_convertvector(v, f16x2v)); }
__device__ __forceinline__ float h16lo(unsigned w) { return (float)__builtin_bit_cast(f16x2v, w)[0]; }
__device__ __forceinline__ float h16hi(unsigned w) { return (float)__builtin_bit_cast(f16x2v, w)[1]; }
__device__ __forceinline__ float bflo(unsigned w) { return __uint_as_float(w << 16); }
__device__ __forceinline__ float bfhi(unsigned w) { return __uint_as_float(w & 0xffff0000u); }
__device__ __forceinline__ unsigned rs_pk(float lo, float hi) { return RF16 ? cvt_pk_f16(lo, hi) : cvt_pk_bf16(lo, hi); }
__device__ __forceinline__ float rs_lo(unsigned w) { return RF16 ? h16lo(w) : bflo(w); }
__device__ __forceinline__ float rs_hi(unsigned w) { return RF16 ? h16hi(w) : bfhi(w); }
__device__ __forceinline__ float bf2f(bf16 b) { return __uint_as_float((unsigned)b << 16); }
__device__ __forceinline__ float sigm(float x) { return __builtin_amdgcn_rcpf(1.f + __expf(-x)); }
__device__ __forceinline__ float siluf(float x) { return x * sigm(x); }
__device__ __forceinline__ float gelu_tanh(float x) { return x * sigm(1.5957691216f * (x + 0.044715f * x * x * x)); }
__device__ __forceinline__ float softplusf(float x) { const float e = __expf(-fabsf(x)); const float l = (e < 0.03f) ? e * (1.f - e * (0.5f - e * 0.33333333f)) : __logf(1.f + e); return fmaxf(x, 0.f) + l; }
__device__ __forceinline__ float wave_sum(float v) {
#pragma unroll
    for (int o = 1; o < 64; o <<= 1) v += __shfl_xor(v, o);
    return v;
}

#define XB_TMO      128
#define XB_XCNT(j)  (256  + 64 * (j))
#define XB_XSUB(j)  (1280 + 64 * (j))
#define XB_XGEN(j)  (2304 + 64 * (j))
#define XB_TOP      3328
#define XB_TOPGEN   3392
#define XCD_BAR_WORDS 3456
#define XB_SPIN_CAP (1u << 18)

__device__ __forceinline__ unsigned xb_ld(unsigned* p)              { return __hip_atomic_load(p, __ATOMIC_RELAXED, __HIP_MEMORY_SCOPE_AGENT); }
__device__ __forceinline__ unsigned xb_add(unsigned* p, unsigned v) { return __hip_atomic_fetch_add(p, v, __ATOMIC_RELAXED, __HIP_MEMORY_SCOPE_AGENT); }
__device__ __forceinline__ unsigned xb_xcc_id() { return (unsigned)__builtin_amdgcn_s_getreg((3 << 11) | 20) & 0xFu; }
#define XB_SPIN(cond, bar) do { unsigned _sp = 0; while (cond) { __builtin_amdgcn_s_sleep(1); \
    if ((++_sp & 255u) == 0u) { if (xb_ld(&(bar)[XB_TMO])) break; if (_sp > XB_SPIN_CAP) { atomicAdd(&(bar)[XB_TMO], 1u); break; } } } } while (0)

struct XcdBarrier {
    unsigned* bar; unsigned x;
    volatile LAS unsigned* st;
};
__device__ __forceinline__ XcdBarrier xcd_barrier_post(unsigned* bar, volatile LAS unsigned* st) {
    XcdBarrier b; b.bar = bar; b.x = xb_xcc_id(); b.st = st;
    if (threadIdx.x == 0) (void)xb_add(&bar[XB_XCNT(b.x)], 1u);
    return b;
}
__device__ __forceinline__ void xcd_barrier_complete(unsigned* bar, unsigned x, unsigned& nloc, unsigned& nx) {
    const unsigned G = gridDim.x * gridDim.y * gridDim.z;
    unsigned sum, cnt, mine, sp = 0u;
    for (;;) {
        sum = 0u; cnt = 0u; mine = 0u;
#pragma unroll
        for (unsigned j = 0; j < 16; ++j) { const unsigned c = xb_ld(&bar[XB_XCNT(j)]); sum += c; cnt += (c > 0u) ? 1u : 0u; mine = (j == x) ? c : mine; }
        if (sum == G) break;
        __builtin_amdgcn_s_sleep(1);
        if ((++sp & 255u) == 0u) { if (xb_ld(&bar[XB_TMO])) break; if (sp > XB_SPIN_CAP) { atomicAdd(&bar[XB_TMO], 1u); break; } }
    }
    nloc = mine > 0u ? mine : 1u; nx = cnt > 0u ? cnt : 1u;
}
__device__ __forceinline__ void xcd_barrier(const XcdBarrier& b) {
    asm volatile("s_waitcnt vmcnt(0)" ::: "memory");
    __syncthreads();
    if (threadIdx.x == 0) {
        unsigned* bar = b.bar;
        __builtin_amdgcn_s_waitcnt(0);
        unsigned nloc = b.st[0], nx = b.st[1];
        if (nloc == 0u) { xcd_barrier_complete(bar, b.x, nloc, nx); b.st[0] = nloc; b.st[1] = nx; }
        const unsigned old = xb_add(&bar[XB_XSUB(b.x)], 1u);
        const unsigned gen = old / nloc;
        { const unsigned pos1 = old + 1u - gen * nloc;
          if (pos1 == (nloc >> 1) || pos1 == nloc - (nloc >> 3)) asm volatile("buffer_wbl2 sc1" ::: "memory"); }
        if (old + 1u == (gen + 1u) * nloc) {
            __builtin_amdgcn_fence(__ATOMIC_RELEASE, "agent");
            asm volatile("s_waitcnt vmcnt(0)" ::: "memory");
            const unsigned og = xb_add(&bar[XB_TOP], 1u);
            const unsigned tg = og / nx;
            if (og + 1u == (tg + 1u) * nx) xb_add(&bar[XB_TOPGEN], 1u);
            else XB_SPIN(xb_ld(&bar[XB_TOPGEN]) == tg, bar);
            __builtin_amdgcn_fence(__ATOMIC_ACQUIRE, "agent");
            xb_add(&bar[XB_XGEN(b.x)], 1u);
            asm volatile("s_waitcnt vmcnt(0)" ::: "memory");
        } else {
            XB_SPIN(xb_ld(&bar[XB_XGEN(b.x)]) == gen, bar);
            __builtin_amdgcn_fence(__ATOMIC_ACQUIRE, "agent");
            asm volatile("s_waitcnt vmcnt(0)" ::: "memory");
        }
    }
    __syncthreads();
}

namespace pg8 {
constexpr int BM = 256, BK = 64, HALF = 128, HTB = HALF * BK * 2, STAGE_BYTES = 8 * HTB, NXCD = 8, WGM = 8;
__host__ __device__ __forceinline__ int lds_byte(int r, int c) { const int st = (r >> 4) * 2 + (c >> 5), rr = r & 15, cc = c & 31, ob = rr * 64 + cc * 2; return st * 1024 + (ob ^ (((ob >> 9) & 1) << 5)); }
__host__ __device__ __forceinline__ void stage_rc(int b, int& R, int& C) { const int st = b / 1024, sb = b % 1024, swz = sb ^ (((sb >> 9) & 1) << 5); R = (st >> 1) * 16 + swz / 64; C = (st & 1) * 32 + (swz % 64) / 2; }
__host__ __device__ __forceinline__ int perm32(int rho) { const int n = rho >> 4, i = rho & 15; return 8 * (i >> 2) + 4 * n + (i & 3); }

struct Unit { const char* a; const char* b; int orow, ocol, aux; };

#ifndef EPI_PROBE
#define EPI_PROBE 0
#endif
__device__ __forceinline__ void glds16_s(const char* base, unsigned voff, unsigned ldsdst) { unsigned keep;
    asm volatile("s_mov_b32 %0, m0\n\ts_mov_b32 m0, %3\n\ts_nop 0\n\tglobal_load_lds_dwordx4 %1, %2\n\ts_mov_b32 m0, %0" : "=&s"(keep) : "v"(voff), "s"(base), "s"(ldsdst) : "memory"); }
template <int N> __device__ __forceinline__ void wait_vm_sel(int flag) {
    asm volatile("s_cmp_lg_u32 %0, 0\n\ts_cbranch_scc1 1\n\ts_waitcnt vmcnt(8)\n\ts_waitcnt vmcnt(%1)" :: "s"(__builtin_amdgcn_readfirstlane(flag)), "n"(N) : "memory", "scc"); }
template <bool F16 = false, bool ALIGN = true, class Epi, class Sched>
__device__ __forceinline__ void gemm_phase(const int tid, LAS unsigned char* lds, const int K, const int lda, const int ldb, const Sched& S, const Epi& E) {
    const int wid = __builtin_amdgcn_readfirstlane(tid >> 6), lane = tid & 63, wr = wid >> 2, wc = wid & 3, fr = lane & 15, fq = lane >> 4;
    const int nt = K / BK;
    unsigned voffA[2], voffB[2];
#pragma unroll
    for (int i = 0; i < 2; ++i) { int R, C; stage_rc(tid * 16 + i * 8192, R, C); const int Rb = (R & ~31) + perm32(R & 31);
        voffA[i] = (unsigned)(R * lda + C) * 2u; voffB[i] = (unsigned)(Rb * ldb + C) * 2u; }
    const size_t kstep = (size_t)(BK * 2);
    const size_t hstepA = (size_t)HALF * lda * 2, hstepB = (size_t)HALF * ldb * 2;
    const unsigned ldsw = (unsigned)wid * 1024u;
    const int aoff = lds_byte(wr * 64 + fr, fq * 8), boff = lds_byte(wc * 32 + fr, fq * 8);
#define PG8_SA(b, h) (((b) * 2 + (h)) * HTB)
#define PG8_SB(b, h) ((4 + (b) * 2 + (h)) * HTB)
#define PG8_STAGE(bufoff, gbase, voff) do { _Pragma("unroll") for (int _i = 0; _i < 2; ++_i) \
        __builtin_amdgcn_global_load_lds((const unsigned*)((const char*)(gbase) + (voff)[_i]), (LAS unsigned*)(lds + (bufoff) + ldsw + _i * 8192), 16, 0, 0); } while (0)
#define PG8_LDA(dst, b, h) do { _Pragma("unroll") for (int m = 0; m < 4; ++m) _Pragma("unroll") for (int k = 0; k < 2; ++k) dst[m][k] = *(const LAS bf16x8*)(lds + PG8_SA(b, h) + aoff + m * 2048 + k * 1024); } while (0)
#define PG8_LDB(dst, b, h) do { _Pragma("unroll") for (int n = 0; n < 2; ++n) _Pragma("unroll") for (int k = 0; k < 2; ++k) dst[n][k] = *(const LAS bf16x8*)(lds + PG8_SB(b, h) + boff + n * 2048 + k * 1024); } while (0)
#define PG8_MMA(ai, bj, At, Bt) do { __builtin_amdgcn_s_setprio(1); _Pragma("unroll") for (int m = 0; m < 4; ++m) _Pragma("unroll") for (int n = 0; n < 2; ++n) _Pragma("unroll") for (int k = 0; k < 2; ++k) \
        acc[ai][bj][m][n] = F16 ? __builtin_amdgcn_mfma_f32_16x16x32_f16(__builtin_bit_cast(f16x8, Bt[n][k]), __builtin_bit_cast(f16x8, At[m][k]), acc[ai][bj][m][n], 0, 0, 0) \
                                : __builtin_amdgcn_mfma_f32_16x16x32_bf16(Bt[n][k], At[m][k], acc[ai][bj][m][n], 0, 0, 0); __builtin_amdgcn_s_setprio(0); } while (0)
#define PG8_WAIT_V(n) asm volatile("s_waitcnt vmcnt(" #n ")" ::: "memory")
#define PG8_WAIT_L(n) asm volatile("s_waitcnt lgkmcnt(" #n ")" ::: "memory")
#define PG8_BAR __builtin_amdgcn_s_barrier()
#define PG8_SCHED __builtin_amdgcn_sched_barrier(0)
    Unit cur, nxt; int ui = 0;
    if (!S.next(0, cur)) return;
    f32x4 acc[2][2][4][2];
#pragma unroll
    for (int a = 0; a < 2; ++a)
#pragma unroll
        for (int b = 0; b < 2; ++b)
#pragma unroll
            for (int m = 0; m < 4; ++m)
#pragma unroll
                for (int n = 0; n < 2; ++n) acc[a][b][m][n] = (f32x4){0.f, 0.f, 0.f, 0.f};
    bf16x8 At[4][2], B0[2][2], B1[2][2];
    const char* cA = cur.a; const char* cB = cur.b;
    PG8_STAGE(PG8_SB(0, 0), cB, voffB); PG8_STAGE(PG8_SB(0, 1), cB + hstepB, voffB); PG8_STAGE(PG8_SA(0, 0), cA, voffA); PG8_STAGE(PG8_SA(0, 1), cA + hstepA, voffA);
    if (wr == 1) PG8_BAR;
    PG8_WAIT_V(2); PG8_BAR;
    PG8_STAGE(PG8_SB(1, 0), cB + kstep, voffB); PG8_STAGE(PG8_SA(1, 0), cA + kstep, voffA); PG8_STAGE(PG8_SB(1, 1), cB + hstepB + kstep, voffB);
    PG8_WAIT_V(6); PG8_BAR;
    for (;;) {
        const bool has_next = S.next(ui + 1, nxt);
        const char* nA = has_next ? nxt.a : cA; const char* nB = has_next ? nxt.b : cB;
        for (int t = 0; t < nt; t += 2) {
            const bool last = (t == nt - 2);
            const int firstf = (ALIGN && t == 0 && ui > 0) ? 1 : 0;
            const char* a1 = cA + (size_t)(t + 1) * kstep;
            const char* a2 = last ? nA : cA + (size_t)(t + 2) * kstep; const char* b2 = last ? nB : cB + (size_t)(t + 2) * kstep;
            const char* a3 = a2 + kstep; const char* b3 = b2 + kstep;
            PG8_LDB(B0, 0, 0); PG8_LDB(B1, 0, 1); PG8_SCHED; PG8_LDA(At, 0, 0); PG8_STAGE(PG8_SA(1, 1), a1 + hstepA, voffA);
            wait_vm_sel<Epi::NST + 4>(firstf); PG8_WAIT_L(0); PG8_BAR; PG8_MMA(0, 0, At, B0); PG8_MMA(0, 1, At, B1); PG8_BAR; PG8_SCHED;
            PG8_LDA(At, 0, 1); PG8_STAGE(PG8_SB(0, 0), b2, voffB); PG8_STAGE(PG8_SB(0, 1), b2 + hstepB, voffB); PG8_STAGE(PG8_SA(0, 0), a2, voffA);
            wait_vm_sel<Epi::NST + 10>(firstf); PG8_WAIT_L(0); PG8_BAR; PG8_MMA(1, 0, At, B0); PG8_MMA(1, 1, At, B1); PG8_BAR; PG8_SCHED;
            PG8_LDB(B0, 1, 0); PG8_LDB(B1, 1, 1); PG8_SCHED; PG8_LDA(At, 1, 0); PG8_STAGE(PG8_SA(0, 1), a2 + hstepA, voffA);
            wait_vm_sel<Epi::NST + 10>(firstf); PG8_WAIT_L(0); PG8_BAR; PG8_MMA(0, 0, At, B0); PG8_MMA(0, 1, At, B1); PG8_BAR; PG8_SCHED;
            PG8_LDA(At, 1, 1); PG8_STAGE(PG8_SB(1, 0), b3, voffB); PG8_STAGE(PG8_SB(1, 1), b3 + hstepB, voffB); PG8_STAGE(PG8_SA(1, 0), a3, voffA);
            PG8_WAIT_V(8); PG8_WAIT_L(0); PG8_BAR; PG8_MMA(1, 0, At, B0); PG8_MMA(1, 1, At, B1); PG8_BAR; PG8_SCHED;
        }
        const unsigned long long te0_ = EPI_PROBE ? __builtin_amdgcn_s_memrealtime() : 0ull; (void)te0_;
        if (ALIGN) { if (wr == 0) PG8_BAR; }
        if (ALIGN && has_next) {
#pragma unroll
            for (int _i = 0; _i < 2; ++_i) glds16_s(nA + kstep + hstepA, voffA[_i], (unsigned)(__UINTPTR_TYPE__)lds + (unsigned)(PG8_SA(1, 1) + _i * 8192) + ldsw); }
        E(acc, cur, wr, wc, fr, fq, !has_next);
        if (EPI_PROBE) { const unsigned long long t1_ = __builtin_amdgcn_s_memrealtime(), until_ = t1_ + EPI_PROBE * (t1_ - te0_); while (__builtin_amdgcn_s_memrealtime() < until_) __builtin_amdgcn_s_sleep(2); }
        if (!has_next) break;
#pragma unroll
        for (int a = 0; a < 2; ++a)
#pragma unroll
            for (int b = 0; b < 2; ++b)
#pragma unroll
                for (int m = 0; m < 4; ++m)
#pragma unroll
                    for (int n = 0; n < 2; ++n) acc[a][b][m][n] = (f32x4){0.f, 0.f, 0.f, 0.f};
        cur = nxt; cA = nA; cB = nB; ++ui;
        if (ALIGN) { if (wr == 1) PG8_BAR; }
    }
    PG8_WAIT_V(0);
    if (!ALIGN) { if (wr == 0) PG8_BAR; }
    PG8_BAR;
#undef PG8_SA
#undef PG8_SB
#undef PG8_STAGE
#undef PG8_LDA
#undef PG8_LDB
#undef PG8_MMA
#undef PG8_WAIT_V
#undef PG8_WAIT_L
#undef PG8_SCHED
}
}
namespace pg8 {
struct SchedMN {
    const char* A; const char* Bt; int lda, ldb; int nM, nN, nwg, G, c;
    __device__ __forceinline__ void init(const bf16* A_, int lda_, const bf16* Bt_, int ldb_, int Mrows, int Ncols, int G_, int c_) {
        A = (const char*)A_; Bt = (const char*)Bt_; lda = lda_; ldb = ldb_; nM = Mrows / BM; nN = Ncols / BM; nwg = nM * nN; G = G_; c = c_; }
    __device__ __forceinline__ bool next(int i, Unit& u) const {
        const long L = (long)i * G + c; if (L >= nwg) return false;
        int wgid = (int)L; { const int q = nwg / NXCD, r = nwg % NXCD, xcd = wgid % NXCD, off = wgid / NXCD; wgid = (xcd < r ? xcd * (q + 1) : r * (q + 1) + (xcd - r) * q) + off; }
        const int nig = WGM * nN, gid = wgid / nig, fm = gid * WGM, gsz = (nM - fm) < WGM ? (nM - fm) : WGM;
        const int pm = fm + ((wgid % nig) % gsz), pn = (wgid % nig) / gsz;
        u.a = A + (size_t)pm * BM * lda * 2; u.b = Bt + (size_t)pn * BM * ldb * 2; u.orow = pm * BM; u.ocol = pn * BM; u.aux = pn; return true;
    }
};
struct SchedKV {
    const char* memn; const char* wkv; int G, c;
    __device__ __forceinline__ bool next(int i, Unit& u) const {
        const int L = i * G + c; if (L >= 256) return false;
        const int l = L >> 6, r = L & 63; const char* w = wkv + (size_t)l * 4096 * D * 2;
        if (r < 32) { const int pm = r >> 3, pn = r & 7; u.a = memn + (size_t)pm * 256 * D * 2; u.b = w + (size_t)pn * 256 * D * 2; u.orow = pm * 256; u.ocol = pn * 256; u.aux = l * 2; }
        else { const int q = r - 32, pm = q >> 2, pn = q & 3; u.a = w + (size_t)(2048 + pm * 256) * D * 2; u.b = memn + (size_t)pn * 256 * D * 2; u.orow = pm * 256; u.ocol = pn * 256; u.aux = l * 2 + 1; }
        return true;
    }
};
struct SchedS {
    const char* Q; const char* Km; int G, c;
    __device__ __forceinline__ bool next(int i, Unit& u) const {
        const int L = i * G + c; if (L >= 256) return false;
        const int bh = 2 * (L & 7) + ((L >> 3) >> 4), it = (L >> 3) & 15, b = bh >> 2, h = bh & 3;
        u.a = Q + ((size_t)(b * SEQ + it * 256) * D + h * XAD) * 2; u.b = Km + ((size_t)(b * MEMLEN) * D + h * XAD) * 2; u.orow = b * SEQ + it * 256; u.ocol = h * 256; u.aux = 0; return true;
    }
};
struct SchedPV {
    const char* P; const char* Vt; int G, c;
    __device__ __forceinline__ bool next(int i, Unit& u) const {
        const int L = i * G + c; if (L >= 512) return false;
        const int x = L & 7, r = L >> 3;
        const int bh = 2 * x + (r >> 5), q = r & 31, it = q >> 1, nh = q & 1, b = bh >> 2, h = bh & 3;
        u.a = P + ((size_t)(b * SEQ + it * 256) * 1024 + h * 256) * 2; u.b = Vt + ((size_t)(h * XAD + nh * 256) * 1024 + b * MEMLEN) * 2; u.orow = b * SEQ + it * 256; u.ocol = h * XAD + nh * 256; u.aux = 0; return true;
    }
};
struct SchedDt {
    const char* A; const char* Bt; int c;
    __device__ __forceinline__ bool next(int i, Unit& u) const {
        if (i != 0 || c >= 64) return false;
        u.a = A + (size_t)c * 256 * D * 2; u.b = Bt; u.orow = c * 256; u.ocol = 0; u.aux = 0; return true;
    }
};

struct SchedChainQ {
    const char* A; const char* Bt; int pm, h, n;
    __device__ __forceinline__ bool next(int i, Unit& u) const { if (i >= n) return false; const int pn = 2 * h + i;
        u.a = A + (size_t)pm * 256 * D * 2; u.b = Bt + (size_t)pn * 256 * D * 2; u.orow = pm * 256; u.ocol = pn * 256; u.aux = pn; return true; }
};
struct SchedChainS {
    const char* Q; const char* Km; int pm, h, n;
    __device__ __forceinline__ bool next(int i, Unit& u) const { if (i >= n) return false; const int b = pm >> 4;
        u.a = Q + ((size_t)pm * 256 * D + h * XAD) * 2; u.b = Km + ((size_t)(b * MEMLEN) * D + h * XAD) * 2; u.orow = pm * 256; u.ocol = h * 256; u.aux = 0; return true; }
};
struct SchedChainPV {
    const char* P; const char* Vt; int pm, h, n;
    __device__ __forceinline__ bool next(int i, Unit& u) const { if (i >= n) return false; const int b = pm >> 4;
        u.a = P + ((size_t)pm * 256 * 1024 + h * 256) * 2; u.b = Vt + ((size_t)(h * XAD + i * 256) * 1024 + b * MEMLEN) * 2; u.orow = pm * 256; u.ocol = h * XAD + i * 256; u.aux = 0; return true; }
};

#define EPI_ARGS f32x4 (&acc)[2][2][4][2], const Unit& u, int wr, int wc, int fr, int fq, bool wt
#define EPI_ROW(ai, m) (u.orow + (ai) * HALF + wr * 64 + (m) * 16 + fr)
#define EPI_COL(bj) (u.ocol + (bj) * HALF + wc * 32 + 8 * fq)
__device__ __forceinline__ float rstd_of(const float* ss, int row) { const f32x4 a = *(const f32x4*)(ss + (size_t)row * 8), b = *(const f32x4*)(ss + (size_t)row * 8 + 4);
    return rsqrtf((((a[0] + a[1]) + (a[2] + a[3])) + ((b[0] + b[1]) + (b[2] + b[3]))) * (1.0f / D) + EPS); }
__device__ __forceinline__ u32x4 pack8(const f32x4 a, const f32x4 b) { u32x4 w; w.x = cvt_pk_bf16(a[0], a[1]); w.y = cvt_pk_bf16(a[2], a[3]); w.z = cvt_pk_bf16(b[0], b[1]); w.w = cvt_pk_bf16(b[2], b[3]); return w; }

#ifndef EPI_WT
#define EPI_WT 0
#endif
__device__ __forceinline__ void st16_g(void* p, const u32x4 v, bool wt) { if (EPI_WT && wt) asm volatile("global_store_dwordx4 %0, %1, off sc1\n\ts_nop 1" :: "v"(p), "v"(v)); else *(u32x4*)p = v; }
__device__ __forceinline__ void st16_g(void* p, const f32x4 v, bool wt) { if (EPI_WT && wt) asm volatile("global_store_dwordx4 %0, %1, off sc1\n\ts_nop 1" :: "v"(p), "v"(v)); else *(f32x4*)p = v; }
__device__ __forceinline__ void st8_g(void* p, const u32x2 v, bool wt) { if (EPI_WT && wt) asm volatile("global_store_dwordx2 %0, %1, off sc1\n\ts_nop 1" :: "v"(p), "v"(v)); else *(u32x2*)p = v; }
__device__ __forceinline__ void st4_g(float* p, const float v) { if (EPI_WT) asm volatile("global_store_dword %0, %1, off sc1" :: "v"(p), "v"(v)); else *p = v; }

struct EpiProjEven {
    static constexpr int NST = 16;
    const float* ss; bf16* proj; float* logf; const float* lb;
    __device__ __forceinline__ void operator()(EPI_ARGS) const {
        const int range = u.aux >> 2;
#pragma unroll
        for (int ai = 0; ai < 2; ++ai)
#pragma unroll
            for (int m = 0; m < 4; ++m) { const int row = EPI_ROW(ai, m); const float rs = rstd_of(ss, row);
#pragma unroll
                for (int bj = 0; bj < 2; ++bj) { const int col = EPI_COL(bj); f32x4 v0 = acc[ai][bj][m][0] * rs, v1 = acc[ai][bj][m][1] * rs;
                    if (range == 3) { const int c = col - 3072; const f32x4 l0 = *(const f32x4*)(lb + c), l1 = *(const f32x4*)(lb + c + 4);
#pragma unroll
                        for (int j = 0; j < 4; ++j) { v0[j] = __logf(l0[j] + (1.f - l0[j]) * sigm(v0[j])); v1[j] = __logf(l1[j] + (1.f - l1[j]) * sigm(v1[j])); }
                        float* p = logf + (size_t)row * 1024 + c; st16_g(p, v0, wt); st16_g(p + 4, v1, wt);
                    } else {
                        if (range == 1) {
#pragma unroll
                            for (int j = 0; j < 4; ++j) { v0[j] = gelu_tanh(v0[j]); v1[j] = gelu_tanh(v1[j]); } }
                        else if (range == 2 || range == 5) {
#pragma unroll
                            for (int j = 0; j < 4; ++j) { v0[j] = siluf(v0[j]); v1[j] = siluf(v1[j]); } }
                        st16_g(proj + (size_t)row * ABIN + col, pack8(v0, v1), wt);
                    } } }
    }
};
struct EpiProjOdd {
    static constexpr int NST = 16;
    const float* ss; bf16* Z; bf16* XBC;
    __device__ __forceinline__ void operator()(EPI_ARGS) const {
        const bool isz = u.ocol < SSDIN;
#pragma unroll
        for (int ai = 0; ai < 2; ++ai)
#pragma unroll
            for (int m = 0; m < 4; ++m) { const int row = EPI_ROW(ai, m); const float rs = rstd_of(ss, row);
#pragma unroll
                for (int bj = 0; bj < 2; ++bj) { const int col = EPI_COL(bj); f32x4 v0 = acc[ai][bj][m][0] * rs, v1 = acc[ai][bj][m][1] * rs;
                    if (isz) {
#pragma unroll
                        for (int j = 0; j < 4; ++j) { v0[j] = siluf(v0[j]); v1[j] = siluf(v1[j]); }
                        st16_g(Z + (size_t)row * SSDIN + col, pack8(v0, v1), wt);
                    } else st16_g(XBC + (size_t)row * SSDCONV + (col - SSDIN), pack8(v0, v1), wt); } }
    }
};
struct EpiDt {
    static constexpr int NST = 0;
    const float* ss; const float* bias; float* DT;
    __device__ __forceinline__ void operator()(EPI_ARGS) const {
        if (wc >= 2) return;
        const int col = wc * 32 + 8 * fq; const f32x4 b0 = *(const f32x4*)(bias + col), b1 = *(const f32x4*)(bias + col + 4);
#pragma unroll
        for (int ai = 0; ai < 2; ++ai)
#pragma unroll
            for (int m = 0; m < 4; ++m) { const int row = EPI_ROW(ai, m); const float rs = rstd_of(ss, row);
                f32x4 v0 = acc[ai][0][m][0] * rs + b0, v1 = acc[ai][0][m][1] * rs + b1;
#pragma unroll
                for (int j = 0; j < 4; ++j) { v0[j] = softplusf(v0[j]); v1[j] = softplusf(v1[j]); }
                float* p = DT + (size_t)row * 64 + col; st16_g(p, v0, wt); st16_g(p + 4, v1, wt); }
    }
};
struct EpiResid {
    static constexpr int NST = 16;
    bf16* xb; float* ssnew; LAS float* tab;
    __device__ __forceinline__ void operator()(EPI_ARGS) const {
#pragma unroll
        for (int ai = 0; ai < 2; ++ai)
#pragma unroll
            for (int m = 0; m < 4; ++m) { const int row = EPI_ROW(ai, m); float sq = 0.f;
#pragma unroll
                for (int bj = 0; bj < 2; ++bj) { bf16* p = xb + (size_t)row * D + EPI_COL(bj); const u32x4 w = *(const u32x4*)p;
                    f32x4 o0 = acc[ai][bj][m][0], o1 = acc[ai][bj][m][1];
                    o0[0] += rs_lo(w.x); o0[1] += rs_hi(w.x); o0[2] += rs_lo(w.y); o0[3] += rs_hi(w.y); o1[0] += rs_lo(w.z); o1[1] += rs_hi(w.z); o1[2] += rs_lo(w.w); o1[3] += rs_hi(w.w);
                    { u32x4 pk; pk.x = rs_pk(o0[0], o0[1]); pk.y = rs_pk(o0[2], o0[3]); pk.z = rs_pk(o1[0], o1[1]); pk.w = rs_pk(o1[2], o1[3]); st16_g(p, pk, wt); }
                    sq += ((o0[0] * o0[0] + o0[1] * o0[1]) + (o0[2] * o0[2] + o0[3] * o0[3])) + ((o1[0] * o1[0] + o1[1] * o1[1]) + (o1[2] * o1[2] + o1[3] * o1[3])); }
                sq += __shfl_xor(sq, 16); sq += __shfl_xor(sq, 32);
                if (fq == 0) tab[(ai * HALF + wr * 64 + m * 16 + fr) * 4 + wc] = sq; }
        LDS_WAIT(); PG8_BAR; asm volatile("" ::: "memory");
        const int lane = fq * 16 + fr, r = (wr * 4 + wc) * 32 + (lane & 31);
        if (lane < 32) { const f32x4 t = *(const LAS f32x4*)(tab + r * 4); ssnew[(size_t)(u.orow + r) * 8 + (u.ocol >> 8)] = (t[0] + t[1]) + (t[2] + t[3]); }
    }
};
struct EpiQ {
    static constexpr int NST = 16;
    const float* ss; bf16* Q; float scale;
    __device__ __forceinline__ void operator()(EPI_ARGS) const {
#pragma unroll
        for (int ai = 0; ai < 2; ++ai)
#pragma unroll
            for (int m = 0; m < 4; ++m) { const int row = EPI_ROW(ai, m); const float rs = rstd_of(ss, row) * scale;
#pragma unroll
                for (int bj = 0; bj < 2; ++bj) *(u32x4*)(Q + (size_t)row * D + EPI_COL(bj)) = pack8(acc[ai][bj][m][0] * rs, acc[ai][bj][m][1] * rs); }
    }
};
struct EpiPlain {
    static constexpr int NST = 16;
    bf16* O; int ldc;
    __device__ __forceinline__ void operator()(EPI_ARGS) const {
#pragma unroll
        for (int ai = 0; ai < 2; ++ai)
#pragma unroll
            for (int m = 0; m < 4; ++m) { const int row = EPI_ROW(ai, m);
#pragma unroll
                for (int bj = 0; bj < 2; ++bj) st16_g(O + (size_t)row * ldc + EPI_COL(bj), pack8(acc[ai][bj][m][0], acc[ai][bj][m][1]), wt); }
    }
};
struct EpiKV {
    static constexpr int NST = 16;
    bf16* Km; bf16* Vt;
    __device__ __forceinline__ void operator()(EPI_ARGS) const {
        const int l = u.aux >> 1; const bool isv = u.aux & 1;
        bf16* O = isv ? Vt + (size_t)l * D * MEMROWS : Km + (size_t)l * MEMROWS * D; const int ldc = isv ? MEMROWS : D;
#pragma unroll
        for (int ai = 0; ai < 2; ++ai)
#pragma unroll
            for (int m = 0; m < 4; ++m) { const int row = EPI_ROW(ai, m);
#pragma unroll
                for (int bj = 0; bj < 2; ++bj) st16_g(O + (size_t)row * ldc + EPI_COL(bj), pack8(acc[ai][bj][m][0], acc[ai][bj][m][1]), wt); }
    }
};
struct EpiSoftmax {
    static constexpr int NST = 16;
    bf16* P; LAS float* tab;
    __device__ __forceinline__ void operator()(EPI_ARGS) const {
        float mx[2][4];
#pragma unroll
        for (int ai = 0; ai < 2; ++ai)
#pragma unroll
            for (int m = 0; m < 4; ++m) { float v = -3.0e38f;
#pragma unroll
                for (int bj = 0; bj < 2; ++bj)
#pragma unroll
                    for (int n = 0; n < 2; ++n) { const f32x4 a = acc[ai][bj][m][n]; v = fmaxf(v, fmaxf(fmaxf(a[0], a[1]), fmaxf(a[2], a[3]))); }
                v = fmaxf(v, __shfl_xor(v, 16)); v = fmaxf(v, __shfl_xor(v, 32));
                if (fq == 0) tab[(ai * HALF + wr * 64 + m * 16 + fr) * 4 + wc] = v; }
        LDS_WAIT(); PG8_BAR; asm volatile("" ::: "memory");
#pragma unroll
        for (int ai = 0; ai < 2; ++ai)
#pragma unroll
            for (int m = 0; m < 4; ++m) { const int r = ai * HALF + wr * 64 + m * 16 + fr; const f32x4 t = *(const LAS f32x4*)(tab + r * 4);
                const float rm = fmaxf(fmaxf(t[0], t[1]), fmaxf(t[2], t[3])); float s = 0.f;
#pragma unroll
                for (int bj = 0; bj < 2; ++bj)
#pragma unroll
                    for (int n = 0; n < 2; ++n) { f32x4 a = acc[ai][bj][m][n];
#pragma unroll
                        for (int j = 0; j < 4; ++j) { a[j] = __expf(a[j] - rm); s += a[j]; }
                        acc[ai][bj][m][n] = a; }
                s += __shfl_xor(s, 16); s += __shfl_xor(s, 32);
                if (fq == 0) tab[1024 + r * 4 + wc] = s; }
        LDS_WAIT(); PG8_BAR; asm volatile("" ::: "memory");
#pragma unroll
        for (int ai = 0; ai < 2; ++ai)
#pragma unroll
            for (int m = 0; m < 4; ++m) { const int r = ai * HALF + wr * 64 + m * 16 + fr; const f32x4 t = *(const LAS f32x4*)(tab + 1024 + r * 4);
                const float inv = __builtin_amdgcn_rcpf((t[0] + t[1]) + (t[2] + t[3])); const int row = u.orow + r;
#pragma unroll
                for (int bj = 0; bj < 2; ++bj) *(u32x4*)(P + (size_t)row * 1024 + EPI_COL(bj)) = pack8(acc[ai][bj][m][0] * inv, acc[ai][bj][m][1] * inv); }
    }
};
struct EpiGateUp {
    static constexpr int NST = 16;
    const float* ss; bf16* H;
    __device__ __forceinline__ void operator()(EPI_ARGS) const {
#pragma unroll
        for (int ai = 0; ai < 2; ++ai)
#pragma unroll
            for (int m = 0; m < 4; ++m) { const int row = EPI_ROW(ai, m); const float rs = rstd_of(ss, row);
#pragma unroll
                for (int bj = 0; bj < 2; ++bj) { const int hc = EPI_COL(bj) >> 1; const f32x4 g = acc[ai][bj][m][0] * rs, up = acc[ai][bj][m][1] * rs; f32x4 h;
#pragma unroll
                    for (int j = 0; j < 4; ++j) h[j] = siluf(g[j]) * up[j];
                    u32x2 w; w.x = cvt_pk_bf16(h[0], h[1]); w.y = cvt_pk_bf16(h[2], h[3]); st8_g(H + (size_t)row * FF + hc, w, wt); } }
    }
};
#undef EPI_ARGS
}
#define MFMA16(X, Y, ACC) __builtin_amdgcn_mfma_f32_16x16x32_bf16((X), (Y), (ACC), 0, 0, 0)
#define WG_SYNC() do { asm volatile("s_waitcnt vmcnt(0) lgkmcnt(0)" ::: "memory"); __builtin_amdgcn_s_barrier(); asm volatile("" ::: "memory"); } while (0)
#define LDS_SYNC() do { asm volatile("s_waitcnt lgkmcnt(0)" ::: "memory"); __builtin_amdgcn_s_barrier(); asm volatile("" ::: "memory"); } while (0)
constexpr int LP = 136;
constexpr int LP64 = 72;
__device__ __forceinline__ bf16x8 lds_frag(const LAS bf16* base, int row, int pitch, int kofs) { return *(const LAS bf16x8*)(base + row * pitch + kofs); }
__device__ __forceinline__ u32x2 pack4(const f32x4 a) { u32x2 w; w.x = cvt_pk_bf16(a[0], a[1]); w.y = cvt_pk_bf16(a[2], a[3]); return w; }

template <int MAP, bool F16>
__device__ __forceinline__ void conv_item(const float* W, int ldw, int K, int n0, const float* gain, bf16* WT, int row_off, LAS float* scr, int item, int nblk, int lane) {
    const int kb = item / nblk, nb = item % nblk, k0 = 64 * kb, nn0 = 64 * nb;
    const int kr = lane >> 4, n4 = (lane & 15) * 4;
    const float* src = W + (size_t)(k0 + kr) * ldw + n0 + nn0 + n4;
    f32x4 v[16];
#pragma unroll
    for (int i = 0; i < 16; ++i) v[i] = *(const f32x4*)(src + (size_t)(4 * i) * ldw);
#pragma unroll
    for (int i = 0; i < 16; ++i) { f32x4 w = v[i]; if (gain) w = w * gain[k0 + 4 * i + kr];
        LAS float* d = scr + (4 * i + kr) * 65 + n4; d[0] = w[0]; d[1] = w[1]; d[2] = w[2]; d[3] = w[3]; }
    LDS_WAIT(); asm volatile("" ::: "memory");
    const int c = lane & 7, nbase = lane >> 3;
#pragma unroll
    for (int j = 0; j < 8; ++j) { const int n = nbase + 8 * j; const LAS float* s = scr + (8 * c) * 65 + n;
        u32x4 o; if (F16) { o.x = cvt_pk_f16(s[0 * 65], s[1 * 65]); o.y = cvt_pk_f16(s[2 * 65], s[3 * 65]); o.z = cvt_pk_f16(s[4 * 65], s[5 * 65]); o.w = cvt_pk_f16(s[6 * 65], s[7 * 65]); }
        else { o.x = cvt_pk_bf16(s[0 * 65], s[1 * 65]); o.y = cvt_pk_bf16(s[2 * 65], s[3 * 65]); o.z = cvt_pk_bf16(s[4 * 65], s[5 * 65]); o.w = cvt_pk_bf16(s[6 * 65], s[7 * 65]); }
        const int nn = nn0 + n; const int dr = MAP == 0 ? nn : ((nn >> 2) * 8 + (nn & 3) + (MAP == 2 ? 4 : 0));
        *(u32x4*)(WT + (size_t)(row_off + dr) * K + k0 + 8 * c) = o; }
    LDS_WAIT(); asm volatile("" ::: "memory");
}
template <int MAP, bool F16 = false>
__device__ __forceinline__ void conv_matrix(const float* W, int ldw, int K, int n0, int ncols, const float* gain, bf16* WT, int row_off, LAS float* scr, int gw, int NGW, int lane, int& rot) {
    const int nblk = ncols / 64, nitems = (K / 64) * nblk; int first = gw - rot; if (first < 0) first += NGW;
    for (int it = first; it < nitems; it += NGW) conv_item<MAP, F16>(W, ldw, K, n0, gain, WT, row_off, scr, it, nblk, lane);
    rot = (rot + nitems) % NGW;
}

struct In {
    const float *x, *mem, *norm_mix, *norm_xattn, *norm_ffn, *norm_mem, *norm_final, *ab_w_in, *ab_w_out, *lru_conv_w, *lru_conv_b, *lru_w_r, *lru_b_r, *lru_w_i, *lru_b_i, *lru_lambda,
        *hgrn_lb, *hgrn_norm, *ssd_w_in, *ssd_w_out, *ssd_conv_w, *ssd_conv_b, *ssd_dt_bias, *ssd_a_log, *ssd_d, *ssd_norm, *xa_w_q, *xa_w_kv, *xa_w_o, *ffn_w_gate, *ffn_w_up, *ffn_w_down;
};

typedef const In __attribute__((address_space(4))) CIn;
__device__ __forceinline__ void convert_layer(CIn& I, int l, bf16* WL, LAS float* scr, int gw, int NGW, int lane, int& rot) {
    const int e = l >> 1;
    if ((l & 1) == 0) {
        conv_matrix<0, RF16>(I.ab_w_in + (size_t)e * D * ABIN, ABIN, D, 0, ABIN, I.norm_mix + l * D, WL + WL_IN, 0, scr, gw, NGW, lane, rot);
        conv_matrix<0>(I.ab_w_out + (size_t)e * D * D, D, D, 0, D, nullptr, WL + WL_OUT, 0, scr, gw, NGW, lane, rot);
    } else {
        conv_matrix<0, RF16>(I.ssd_w_in + (size_t)e * D * SSDPROJ, SSDPROJ, D, 0, SSDN1, I.norm_mix + l * D, WL + WL_IN, 0, scr, gw, NGW, lane, rot);
        conv_matrix<0, RF16>(I.ssd_w_in + (size_t)e * D * SSDPROJ, SSDPROJ, D, SSDN1, 64, I.norm_mix + l * D, WL + WL_DT, 0, scr, gw, NGW, lane, rot);
        for (int i = gw * 64 + lane; i < 192 * D / 8; i += NGW * 64) *(u32x4*)(WL + WL_DT + (size_t)64 * D + (size_t)i * 8) = (u32x4){0u, 0u, 0u, 0u};
        conv_matrix<0>(I.ssd_w_out + (size_t)e * SSDIN * D, D, SSDIN, 0, D, nullptr, WL + WL_OUT, 0, scr, gw, NGW, lane, rot);
    }
    conv_matrix<0, RF16>(I.xa_w_q + (size_t)l * D * D, D, D, 0, D, I.norm_xattn + l * D, WL + WL_Q, 0, scr, gw, NGW, lane, rot);
    conv_matrix<0>(I.xa_w_o + (size_t)l * D * D, D, D, 0, D, nullptr, WL + WL_O, 0, scr, gw, NGW, lane, rot);
    conv_matrix<1, RF16>(I.ffn_w_gate + (size_t)l * D * FF, FF, D, 0, FF, I.norm_ffn + l * D, WL + WL_GU, 0, scr, gw, NGW, lane, rot);
    conv_matrix<2, RF16>(I.ffn_w_up + (size_t)l * D * FF, FF, D, 0, FF, I.norm_ffn + l * D, WL + WL_GU, 0, scr, gw, NGW, lane, rot);
    conv_matrix<0>(I.ffn_w_down + (size_t)l * FF * D, D, FF, 0, D, nullptr, WL + WL_DN, 0, scr, gw, NGW, lane, rot);
}

template <bool PASSB>
__device__ __forceinline__ void lru_units(const int tid, LAS unsigned char* lds, int G, int cu, const bf16* PROJ, const bf16* WRT, const float* cw, const float* cb, const float* br, const float* bi,
                                          const float* lam, float* SEG, bf16* YAB) {
    const int wid = __builtin_amdgcn_readfirstlane(tid >> 6), lane = tid & 63, q = lane >> 4, c16 = lane & 15;
    LAS bf16* XA = (LAS bf16*)(lds);
    LAS bf16* XC = (LAS bf16*)(lds + 35840);
    LAS bf16* WR = (LAS bf16*)(lds + 70656);
    LAS bf16* WI = (LAS bf16*)(lds + 105472);
    LAS float* PAR = (LAS float*)(lds + 140288);
    LAS float* WT = (LAS float*)(lds + 144384);
    LAS float* HIN = (LAS float*)(lds + 152576);
    int loadedj = -1;
    for (int u = cu; u < 1024; u += G) {
        const int j = u & 7, rest = u >> 3, b = rest >> 5, seg = rest & 31; const int t0 = b * SEQ + seg * 128;
        if (j != loadedj) {
            loadedj = j;
            for (int p = tid; p < 2 * 2048; p += NTHR) { const int g = p >> 11, pp = p & 2047, r = pp >> 4, pc = pp & 15;
                const u32x4 v = *(const u32x4*)(WRT + ((size_t)(g * 8 + j) * 128 + r) * 128 + pc * 8);
                *(LAS u32x4*)((g ? WI : WR) + r * LP + pc * 8) = v; }
            if (tid < 128) { const int ch = j * 128 + tid;
                PAR[0 * 128 + tid] = 8.0f * softplusf(-lam[ch]); PAR[1 * 128 + tid] = br[ch]; PAR[2 * 128 + tid] = bi[ch]; PAR[3 * 128 + tid] = cb[ch];
#pragma unroll
                for (int k = 0; k < 4; ++k) PAR[(4 + k) * 128 + tid] = cw[k * LRUW + ch]; }
        }
        for (int p = tid; p < 131 * 16; p += NTHR) { const int r = p >> 4, pc = p & 15; u32x4 v = (u32x4){0u, 0u, 0u, 0u};
            if (seg > 0 || r >= 3) v = *(const u32x4*)(PROJ + (size_t)(t0 + r - 3) * ABIN + j * 128 + pc * 8);
            *(LAS u32x4*)(XA + r * LP + pc * 8) = v; }
        if (PASSB) { if (tid < 128) { float h = 0.f; const float* sg = SEG + ((size_t)(b * 8 + j) * 32) * 256 + tid * 2;
                for (int s = 0; s < seg; ++s) { const f32x2 ab = *(const f32x2*)(sg + (size_t)s * 256); h = ab.x * h + ab.y; }
                HIN[tid] = h; } }
        WG_SYNC();
        {
            const int ch8 = tid & 15, tr = tid >> 4; u32x4 rows[7];
#pragma unroll
            for (int i = 0; i < 7; ++i) rows[i] = *(const LAS u32x4*)(XA + (4 * tr + i) * LP + ch8 * 8);
            float w[4][8], bb[8];
#pragma unroll
            for (int e = 0; e < 8; ++e) { bb[e] = PAR[3 * 128 + ch8 * 8 + e];
#pragma unroll
                for (int k = 0; k < 4; ++k) w[k][e] = PAR[(4 + k) * 128 + ch8 * 8 + e]; }
#pragma unroll
            for (int i = 0; i < 4; ++i) { float o[8];
#pragma unroll
                for (int e = 0; e < 8; ++e) { float a = bb[e];
#pragma unroll
                    for (int k = 0; k < 4; ++k) { const unsigned wd = rows[i + k][e >> 1]; a += w[k][e] * ((e & 1) ? bfhi(wd) : bflo(wd)); }
                    o[e] = a; }
                u32x4 pk; pk.x = cvt_pk_bf16(o[0], o[1]); pk.y = cvt_pk_bf16(o[2], o[3]); pk.z = cvt_pk_bf16(o[4], o[5]); pk.w = cvt_pk_bf16(o[6], o[7]);
                *(LAS u32x4*)(XC + (4 * tr + i) * LP + ch8 * 8) = pk; }
        }
        WG_SYNC();
        float PP[8][4], HH[8][4];
        {
            bf16x8 xf[4];
#pragma unroll
            for (int ks = 0; ks < 4; ++ks) xf[ks] = lds_frag(XC, 16 * wid + c16, LP, 32 * ks + 8 * q);
#pragma unroll
            for (int jb = 0; jb < 8; ++jb) {
                f32x4 aR = (f32x4){0.f, 0.f, 0.f, 0.f}, aI = aR;
#pragma unroll
                for (int ks = 0; ks < 4; ++ks) { aR = MFMA16(xf[ks], lds_frag(WR, 16 * jb + c16, LP, 32 * ks + 8 * q), aR); aI = MFMA16(xf[ks], lds_frag(WI, 16 * jb + c16, LP, 32 * ks + 8 * q), aI); }
                const int ch = 16 * jb + c16;
                const float sp8 = PAR[ch], pbr = PAR[128 + ch], pbi = PAR[256 + ch], pcb = PAR[384 + ch], w0 = PAR[512 + ch], w1 = PAR[640 + ch], w2 = PAR[768 + ch], w3 = PAR[896 + ch];
                float xr[7];
#pragma unroll
                for (int i = 0; i < 7; ++i) xr[i] = bf2f(XA[(16 * wid + 4 * q + i) * LP + ch]);
                float a[4], bt[4];
#pragma unroll
                for (int r = 0; r < 4; ++r) { const float xc = pcb + w0 * xr[r] + w1 * xr[r + 1] + w2 * xr[r + 2] + w3 * xr[r + 3];
                    const float rg = sigm(aR[r] + pbr), ig = sigm(aI[r] + pbi); const float la = -sp8 * rg;
                    const float av = __expf(la), x2 = 2.0f * la; a[r] = av;
                    const float om = (x2 > -0.02f) ? -x2 * (1.0f + x2 * (0.5f + x2 * 0.16666667f)) : 1.0f - av * av;
                    bt[r] = __builtin_amdgcn_sqrtf(fmaxf(om, 0.f)) * ig * xc; }
                float P[4], H[4]; P[0] = a[0]; H[0] = bt[0];
#pragma unroll
                for (int r = 1; r < 4; ++r) { P[r] = a[r] * P[r - 1]; H[r] = a[r] * H[r - 1] + bt[r]; }
                float Ae = 1.f, Be = 0.f, Aw = 1.f, Bw = 0.f;
#pragma unroll
                for (int qq = 0; qq < 4; ++qq) { const float Aq = __shfl(P[3], c16 + 16 * qq), Bq = __shfl(H[3], c16 + 16 * qq);
                    if (qq < q) { Be = Aq * Be + Bq; Ae = Aq * Ae; }
                    Bw = Aq * Bw + Bq; Aw = Aq * Aw; }
#pragma unroll
                for (int r = 0; r < 4; ++r) { PP[jb][r] = P[r] * Ae; HH[jb][r] = P[r] * Be + H[r]; }
                if (q == 0) *(LAS f32x2*)(WT + (wid * 128 + ch) * 2) = (f32x2){Aw, Bw};
            }
        }
        WG_SYNC();
        if (!PASSB) {
            if (tid < 128) { float A = 1.f, B = 0.f;
#pragma unroll
                for (int w = 0; w < 8; ++w) { const f32x2 ab = *(const LAS f32x2*)(WT + (w * 128 + tid) * 2); B = ab.x * B + ab.y; A = ab.x * A; }
                *(f32x2*)(SEG + ((size_t)(b * 8 + j) * 32 + seg) * 256 + tid * 2) = (f32x2){A, B}; }
        } else {
#pragma unroll
            for (int jb = 0; jb < 8; ++jb) { const int ch = 16 * jb + c16; float h0 = HIN[ch];
                for (int w = 0; w < wid; ++w) { const f32x2 ab = *(const LAS f32x2*)(WT + (w * 128 + ch) * 2); h0 = ab.x * h0 + ab.y; }
#pragma unroll
                for (int r = 0; r < 4; ++r) { const int t = t0 + 16 * wid + 4 * q + r; const float h = PP[jb][r] * h0 + HH[jb][r];
                    const float ga = bf2f(PROJ[(size_t)t * ABIN + 1024 + j * 128 + ch]);
                    YAB[(size_t)t * D + j * 128 + ch] = (bf16)f2bf(ga * h); } }
        }
        WG_SYNC();
    }
}

__device__ __forceinline__ void hgrn1_load(float (&lf)[16], unsigned (&vv)[16], const float* LOGF, const bf16* PROJ, int u, int k, int qt) {
    const int bh = u >> 6, c = u & 63, b = bh >> 3, h = bh & 7; const int t0 = b * SEQ + c * 64 + 16 * qt;
#pragma unroll
    for (int i = 0; i < 16; ++i) { lf[i] = LOGF[(size_t)(t0 + i) * 1024 + h * 128 + k]; vv[i] = PROJ[(size_t)(t0 + i) * ABIN + 4096 + h * 128 + k]; }
}
__device__ __forceinline__ void hgrn1_units(const int tid, LAS unsigned char* lds, int G, int cu, const float* LOGF, const bf16* PROJ, bf16* HST, float* HDEC) {
    const int wid = __builtin_amdgcn_readfirstlane(tid >> 6), lane = tid & 63, q = lane >> 4, c16 = lane & 15;
    LAS bf16* KT = (LAS bf16*)(lds);
    LAS bf16* VT = (LAS bf16*)(lds + 18432);
    LAS float* TOT = (LAS float*)(lds + 36864);
    const int k = tid & 127, qt = tid >> 7;
    float lf[16], nlf[16]; unsigned vv[16], nvv[16];
    if (cu < 2048) hgrn1_load(lf, vv, LOGF, PROJ, cu, k, qt);
    for (int u = cu; u < 2048; u += G) {
        if (u + G < 2048) hgrn1_load(nlf, nvv, LOGF, PROJ, u + G, k, qt);
        float cs[16];
        cs[0] = lf[0];
#pragma unroll
        for (int i = 1; i < 16; ++i) cs[i] = cs[i - 1] + lf[i];
        TOT[qt * 128 + k] = cs[15];
        LDS_SYNC();
        float pre = 0.f, last = 0.f;
#pragma unroll
        for (int qq = 0; qq < 4; ++qq) { const float t = TOT[qq * 128 + k]; if (qq < qt) pre += t; last += t; }
        unsigned kw[8], vw[8];
#pragma unroll
        for (int i = 0; i < 8; ++i) { const float k0 = (1.f - __expf(lf[2 * i])) * __expf(last - (pre + cs[2 * i])), k1 = (1.f - __expf(lf[2 * i + 1])) * __expf(last - (pre + cs[2 * i + 1]));
            kw[i] = cvt_pk_bf16(k0, k1); vw[i] = vv[2 * i] | (vv[2 * i + 1] << 16); }
        *(LAS u32x4*)(KT + k * LP64 + 16 * qt) = (u32x4){kw[0], kw[1], kw[2], kw[3]}; *(LAS u32x4*)(KT + k * LP64 + 16 * qt + 8) = (u32x4){kw[4], kw[5], kw[6], kw[7]};
        *(LAS u32x4*)(VT + k * LP64 + 16 * qt) = (u32x4){vw[0], vw[1], vw[2], vw[3]}; *(LAS u32x4*)(VT + k * LP64 + 16 * qt + 8) = (u32x4){vw[4], vw[5], vw[6], vw[7]};
        if (qt == 0) HDEC[(size_t)u * 128 + k] = __expf(last);
        LDS_SYNC();
        bf16x8 kf[2];
#pragma unroll
        for (int ks = 0; ks < 2; ++ks) kf[ks] = lds_frag(KT, 16 * wid + c16, LP64, 32 * ks + 8 * q);
#pragma unroll
        for (int vb = 0; vb < 8; ++vb) { f32x4 acc = (f32x4){0.f, 0.f, 0.f, 0.f};
#pragma unroll
            for (int ks = 0; ks < 2; ++ks) acc = MFMA16(kf[ks], lds_frag(VT, 16 * vb + c16, LP64, 32 * ks + 8 * q), acc);
            *(u32x2*)(HST + ((size_t)u * 128 + 16 * vb + c16) * 128 + 16 * wid + 4 * q) = pack4(acc); }
        LDS_SYNC();
#pragma unroll
        for (int i = 0; i < 16; ++i) { lf[i] = nlf[i]; vv[i] = nvv[i]; }
    }
    WG_SYNC();
}
__device__ __forceinline__ void hgrn2_scan(const int tid, int G, int cu, bf16* HST, const float* HDEC) {
    for (int task = cu * NTHR + tid; task < 32 * 4096; task += G * NTHR) {
        const int bh = task >> 12, e = (task & 4095) * 4; f32x4 S = (f32x4){0.f, 0.f, 0.f, 0.f};
        bf16* p0 = HST + (size_t)bh * 64 * 16384 + e; const float* d0 = HDEC + (size_t)bh * 64 * 128 + (e & 127);
#pragma unroll 1
        for (int cb = 0; cb < 64; cb += 16) { u32x2 L[16]; f32x4 d[16];
#pragma unroll
            for (int c = 0; c < 16; ++c) { L[c] = *(const u32x2*)(p0 + (size_t)(cb + c) * 16384); d[c] = *(const f32x4*)(d0 + (size_t)(cb + c) * 128); }
#pragma unroll
            for (int c = 0; c < 16; ++c) { *(u32x2*)(p0 + (size_t)(cb + c) * 16384) = pack4(S);
                S[0] = d[c][0] * S[0] + bflo(L[c].x); S[1] = d[c][1] * S[1] + bfhi(L[c].x); S[2] = d[c][2] * S[2] + bflo(L[c].y); S[3] = d[c][3] * S[3] + bfhi(L[c].y); } }
    }
}
__device__ __forceinline__ void hgrn3_load(float (&lf)[16], unsigned (&qv)[16], unsigned (&vv)[16], u32x4 (&st)[4], const float* LOGF, const bf16* PROJ, const bf16* HST, int u, int k, int qt, int tid) {
    const int bh = u >> 6, c = u & 63, b = bh >> 3, h = bh & 7; const int t0 = b * SEQ + c * 64 + 16 * qt;
#pragma unroll
    for (int i = 0; i < 16; ++i) { lf[i] = LOGF[(size_t)(t0 + i) * 1024 + h * 128 + k]; const bf16* pr = PROJ + (size_t)(t0 + i) * ABIN + h * 128 + k; qv[i] = pr[2048]; vv[i] = pr[4096]; }
#pragma unroll
    for (int i = 0; i < 4; ++i) { const int p = tid + NTHR * i, r = p >> 4, pc = p & 15; st[i] = *(const u32x4*)(HST + (size_t)u * 16384 + r * 128 + pc * 8); }
}
__device__ __forceinline__ void hgrn3_units(const int tid, LAS unsigned char* lds, int G, int cu, const float* LOGF, const bf16* PROJ, const bf16* HST, const float* hnorm, bf16* YAB) {
    const int wid = __builtin_amdgcn_readfirstlane(tid >> 6), lane = tid & 63, q = lane >> 4, c16 = lane & 15;
    LAS bf16* QH = (LAS bf16*)(lds);
    LAS bf16* QT = (LAS bf16*)(lds + 17408);
    LAS bf16* KH = (LAS bf16*)(lds + 34816);
    LAS bf16* VT = (LAS bf16*)(lds + 52224);
    LAS bf16* STL = (LAS bf16*)(lds + 70656);
    LAS bf16* PM = (LAS bf16*)(lds + 105472);
    LAS float* TOT = (LAS float*)(lds + 114688);
    LAS float* SQ = (LAS float*)(lds + 116736);
    const int k = tid & 127, qt = tid >> 7;
    float lf[16], nlf[16]; unsigned qv[16], nqv[16], vv[16], nvv[16]; u32x4 st[4], nst[4];
    if (cu < 2048) hgrn3_load(lf, qv, vv, st, LOGF, PROJ, HST, cu, k, qt, tid);
    for (int u = cu; u < 2048; u += G) {
        const int bh = u >> 6, c = u & 63, b = bh >> 3, h = bh & 7; const int tc = b * SEQ + c * 64;
        float cs[16];
        cs[0] = lf[0];
#pragma unroll
        for (int i = 1; i < 16; ++i) cs[i] = cs[i - 1] + lf[i];
        TOT[qt * 128 + k] = cs[15];
#pragma unroll
        for (int i = 0; i < 4; ++i) { const int p = tid + NTHR * i, r = p >> 4, pc = p & 15; *(LAS u32x4*)(STL + r * LP + pc * 8) = st[i]; }
        if (u + G < 2048) hgrn3_load(nlf, nqv, nvv, nst, LOGF, PROJ, HST, u + G, k, qt, tid);
        LDS_SYNC();
        float pre = 0.f;
#pragma unroll
        for (int qq = 0; qq < 4; ++qq) { const float t = TOT[qq * 128 + k]; if (qq < qt) pre += t; }
        const float ref = TOT[k] + TOT[128 + k];
        unsigned vw[8];
#pragma unroll
        for (int i = 0; i < 16; ++i) { const float cum = pre + cs[i], kk = 1.f - __expf(lf[i]), qf = bf2f((bf16)qv[i]);
            QT[(16 * qt + i) * LP + k] = (bf16)f2bf(qf * __expf(cum));
            QH[(16 * qt + i) * LP + k] = (bf16)f2bf(qf * __expf(fminf(cum - ref, 80.f)));
            KH[(16 * qt + i) * LP + k] = (bf16)f2bf(kk * __expf(fminf(ref - cum, 80.f))); }
#pragma unroll
        for (int i = 0; i < 8; ++i) vw[i] = vv[2 * i] | (vv[2 * i + 1] << 16);
        *(LAS u32x4*)(VT + k * LP64 + 16 * qt) = (u32x4){vw[0], vw[1], vw[2], vw[3]}; *(LAS u32x4*)(VT + k * LP64 + 16 * qt + 8) = (u32x4){vw[4], vw[5], vw[6], vw[7]};
        LDS_SYNC();
        {
            const int tb = wid & 3;
            bf16x8 qf[4];
#pragma unroll
            for (int ks = 0; ks < 4; ++ks) qf[ks] = lds_frag(QH, 16 * tb + c16, LP, 32 * ks + 8 * q);
#pragma unroll
            for (int sbi = 0; sbi < 2; ++sbi) { const int sb = 2 * (wid >> 2) + sbi; f32x4 acc = (f32x4){0.f, 0.f, 0.f, 0.f};
#pragma unroll
                for (int ks = 0; ks < 4; ++ks) acc = MFMA16(lds_frag(KH, 16 * sb + c16, LP, 32 * ks + 8 * q), qf[ks], acc);
                const int t = 16 * tb + c16, s0 = 16 * sb + 4 * q;
#pragma unroll
                for (int r = 0; r < 4; ++r) acc[r] = (s0 + r <= t) ? acc[r] : 0.f;
                *(LAS u32x2*)(PM + t * LP64 + s0) = pack4(acc); }
        }
        LDS_SYNC();
        {
            const int tb = wid & 3, vh = wid >> 2, t = 16 * tb + c16;
            bf16x8 qf[4], pf[2];
#pragma unroll
            for (int ks = 0; ks < 4; ++ks) qf[ks] = lds_frag(QT, t, LP, 32 * ks + 8 * q);
#pragma unroll
            for (int ks = 0; ks < 2; ++ks) pf[ks] = lds_frag(PM, t, LP64, 32 * ks + 8 * q);
            f32x4 acc[4]; float sq = 0.f;
#pragma unroll
            for (int vb = 0; vb < 4; ++vb) { const int vr = 64 * vh + 16 * vb + c16; acc[vb] = (f32x4){0.f, 0.f, 0.f, 0.f};
#pragma unroll
                for (int ks = 0; ks < 4; ++ks) acc[vb] = MFMA16(lds_frag(STL, vr, LP, 32 * ks + 8 * q), qf[ks], acc[vb]);
#pragma unroll
                for (int ks = 0; ks < 2; ++ks) acc[vb] = MFMA16(lds_frag(VT, vr, LP64, 32 * ks + 8 * q), pf[ks], acc[vb]);
                sq += (acc[vb][0] * acc[vb][0] + acc[vb][1] * acc[vb][1]) + (acc[vb][2] * acc[vb][2] + acc[vb][3] * acc[vb][3]); }
            sq += __shfl_xor(sq, 16); sq += __shfl_xor(sq, 32);
            if (q == 0) SQ[vh * 64 + t] = sq;
            LDS_SYNC();
            const float rstd = rsqrtf((SQ[t] + SQ[64 + t]) * (1.0f / 128.f) + EPS);
#pragma unroll
            for (int vb = 0; vb < 4; ++vb) { const int v0 = 64 * vh + 16 * vb + 4 * q; const f32x4 hn = *(const f32x4*)(hnorm + h * 128 + v0);
                const u32x2 gw = *(const u32x2*)(PROJ + (size_t)(tc + t) * ABIN + 5120 + h * 128 + v0);
                f32x4 y; y[0] = acc[vb][0] * rstd * hn[0] * bflo(gw.x); y[1] = acc[vb][1] * rstd * hn[1] * bfhi(gw.x); y[2] = acc[vb][2] * rstd * hn[2] * bflo(gw.y); y[3] = acc[vb][3] * rstd * hn[3] * bfhi(gw.y);
                *(u32x2*)(YAB + (size_t)(tc + t) * D + 1024 + h * 128 + v0) = pack4(y); }
        }
        LDS_SYNC();
#pragma unroll
        for (int i = 0; i < 16; ++i) { lf[i] = nlf[i]; qv[i] = nqv[i]; vv[i] = nvv[i]; }
#pragma unroll
        for (int i = 0; i < 4; ++i) st[i] = nst[i];
    }
    WG_SYNC();
}
__device__ __forceinline__ void ssd_prep_load(u32x4 (&rows)[7], const bf16* XBC, int u, int ch8, int tr) {
    const int bc = u / 48, cblk = u % 48, c = bc & 31; const bf16* src = XBC + (size_t)(bc * 128 + 4 * tr - 3) * SSDCONV + cblk * 128 + ch8 * 8;
#pragma unroll
    for (int i = 0; i < 7; ++i) { rows[i] = (u32x4){0u, 0u, 0u, 0u}; if (c > 0 || 4 * tr + i >= 3) rows[i] = *(const u32x4*)(src + (size_t)i * SSDCONV); }
}
__device__ __forceinline__ void ssd_prep_units(const int tid, LAS unsigned char* lds, int ufirst, int ustride, int uend, const bf16* XBC, const float* cw, const float* cb, bf16* XBT, bf16* BCN) {
    LAS bf16* T = (LAS bf16*)(lds);
    const int ch8 = tid & 15, tr = tid >> 4;
    u32x4 rows[7], nrows[7];
    if (ufirst < uend) ssd_prep_load(rows, XBC, ufirst, ch8, tr);
    for (int u = ufirst; u < uend; u += ustride) {
        const int bc = u / 48, cblk = u % 48; const int t0 = bc * 128; const int ch0 = cblk * 128 + ch8 * 8;
        if (u + ustride < uend) ssd_prep_load(nrows, XBC, u + ustride, ch8, tr);
        float w[4][8], bb[8];
        { const f32x4 b0 = *(const f32x4*)(cb + ch0), b1 = *(const f32x4*)(cb + ch0 + 4);
#pragma unroll
          for (int e = 0; e < 4; ++e) { bb[e] = b0[e]; bb[4 + e] = b1[e]; }
#pragma unroll
          for (int k = 0; k < 4; ++k) { const f32x4 w0 = *(const f32x4*)(cw + (size_t)k * SSDCONV + ch0), w1 = *(const f32x4*)(cw + (size_t)k * SSDCONV + ch0 + 4);
#pragma unroll
              for (int e = 0; e < 4; ++e) { w[k][e] = w0[e]; w[k][4 + e] = w1[e]; } } }
        u32x4 ov[4];
#pragma unroll
        for (int i = 0; i < 4; ++i) { float o[8];
#pragma unroll
            for (int e = 0; e < 8; ++e) { float a = bb[e];
#pragma unroll
                for (int k = 0; k < 4; ++k) { const unsigned wd = rows[i + k][e >> 1]; a += w[k][e] * ((e & 1) ? bfhi(wd) : bflo(wd)); }
                o[e] = siluf(a); }
            u32x4 pk; pk.x = cvt_pk_bf16(o[0], o[1]); pk.y = cvt_pk_bf16(o[2], o[3]); pk.z = cvt_pk_bf16(o[4], o[5]); pk.w = cvt_pk_bf16(o[6], o[7]);
            if (cblk >= 32) *(u32x4*)(BCN + (size_t)(t0 + 4 * tr + i) * 2048 + (ch0 - 4096)) = pk;
            ov[i] = pk; }
        if (cblk < 40) {
#pragma unroll
            for (int e = 0; e < 8; ++e) { u32x2 w;
                const unsigned a0 = ov[0][e >> 1], a1 = ov[1][e >> 1], a2 = ov[2][e >> 1], a3 = ov[3][e >> 1];
                if (e & 1) { w.x = (a0 >> 16) | (a1 & 0xffff0000u); w.y = (a2 >> 16) | (a3 & 0xffff0000u); } else { w.x = (a0 & 0xffffu) | (a1 << 16); w.y = (a2 & 0xffffu) | (a3 << 16); }
                *(LAS u32x2*)(T + (ch8 * 8 + e) * LP + 8 * ((tr >> 1) ^ ch8) + 4 * (tr & 1)) = w; }
            LDS_SYNC();
#pragma unroll
            for (int i = 0; i < 4; ++i) { const int p = tid + NTHR * i, r = p >> 4, pc = p & 15;
                *(u32x4*)(XBT + ((size_t)bc * 5120 + cblk * 128 + r) * 128 + pc * 8) = *(const LAS u32x4*)(T + r * LP + 8 * (pc ^ (r >> 3))); }
            LDS_SYNC();
        }
#pragma unroll
        for (int i = 0; i < 7; ++i) rows[i] = nrows[i];
    }
    WG_SYNC();
}
__device__ __forceinline__ float ssd_tables(const float* DT, const float* a_log, int t0, int hd, int wid, int lane, LAS float* CUM, LAS float* DTS) {
    const float an = -__expf(a_log[hd]);
    const float d0 = DT[(size_t)(t0 + 2 * lane) * 64 + hd], d1 = DT[(size_t)(t0 + 2 * lane + 1) * 64 + hd];
    const float a0 = d0 * an, a1 = d1 * an; float v = a0 + a1;
#pragma unroll
    for (int o = 1; o < 64; o <<= 1) { const float t = __shfl_up(v, o); if (lane >= o) v += t; }
    CUM[wid * 128 + 2 * lane] = v - a1; CUM[wid * 128 + 2 * lane + 1] = v; DTS[wid * 128 + 2 * lane] = d0; DTS[wid * 128 + 2 * lane + 1] = d1;
    return __shfl(v, 63);
}
__device__ __forceinline__ void ssd1_units(const int tid, LAS unsigned char* lds, int G, int cu, const bf16* XBT, const float* DT, const float* a_log, bf16* ST, float* DEC) {
    const int wid = __builtin_amdgcn_readfirstlane(tid >> 6), lane = tid & 63, q = lane >> 4, c16 = lane & 15;
    LAS bf16* BT = (LAS bf16*)(lds);
    LAS float* CUM = (LAS float*)(lds + 34816);
    LAS float* DTS = (LAS float*)(lds + 38912);
    for (int u = cu; u < 1024; u += G) {
        const int bc = u >> 3, g = u & 7, t0 = bc * 128, hd = g * 8 + wid;
#pragma unroll
        for (int i = 0; i < 4; ++i) { const int p = tid + NTHR * i, r = p >> 4, pc = p & 15;
            *(LAS u32x4*)(BT + r * LP + pc * 8) = *(const u32x4*)(XBT + ((size_t)bc * 5120 + 4096 + g * 128 + r) * 128 + pc * 8); }
        const float last = ssd_tables(DT, a_log, t0, hd, wid, lane, CUM, DTS);
        if (lane == 0) DEC[bc * 64 + hd] = __expf(last);
        u32x4 xr[4][4];
#pragma unroll
        for (int pb = 0; pb < 4; ++pb)
#pragma unroll
            for (int ks = 0; ks < 4; ++ks) xr[pb][ks] = *(const u32x4*)(XBT + ((size_t)bc * 5120 + hd * 64 + 16 * pb + c16) * 128 + 32 * ks + 8 * q);
        WG_SYNC();
        bf16x8 xf[4][4];
#pragma unroll
        for (int ks = 0; ks < 4; ++ks) { float sc[8];
#pragma unroll
            for (int j = 0; j < 8; ++j) { const int s = 32 * ks + 8 * q + j; sc[j] = DTS[wid * 128 + s] * __expf(last - CUM[wid * 128 + s]); }
#pragma unroll
            for (int pb = 0; pb < 4; ++pb) { u32x4 o;
#pragma unroll
                for (int e = 0; e < 4; ++e) o[e] = cvt_pk_bf16(bflo(xr[pb][ks][e]) * sc[2 * e], bfhi(xr[pb][ks][e]) * sc[2 * e + 1]);
                xf[pb][ks] = __builtin_bit_cast(bf16x8, o); } }
#pragma unroll
        for (int nb = 0; nb < 8; ++nb) { bf16x8 bf[4];
#pragma unroll
            for (int ks = 0; ks < 4; ++ks) bf[ks] = lds_frag(BT, 16 * nb + c16, LP, 32 * ks + 8 * q);
#pragma unroll
            for (int pb = 0; pb < 4; ++pb) { f32x4 acc = (f32x4){0.f, 0.f, 0.f, 0.f};
#pragma unroll
                for (int ks = 0; ks < 4; ++ks) acc = MFMA16(bf[ks], xf[pb][ks], acc);
                *(u32x2*)(ST + (((size_t)bc * 64 + hd) * 64 + 16 * pb + c16) * 128 + 16 * nb + 4 * q) = pack4(acc); } }
        WG_SYNC();
    }
}
__device__ __forceinline__ void ssd2_scan(const int tid, int G, int cu, bf16* ST, const float* DEC) {
    for (int task = cu * NTHR + tid; task < NB * 4096 * 32; task += G * NTHR) {
        const int b = task >> 17, r = task & 131071, hp = r >> 5, n4 = (r & 31) * 4, hd = hp >> 6; f32x4 S = (f32x4){0.f, 0.f, 0.f, 0.f};
        bf16* p0 = ST + ((size_t)(b * 32) * 4096 + hp) * 128 + n4; const float* d0 = DEC + (b * 32) * 64 + hd;
        u32x2 L[32]; float d[32];
#pragma unroll
        for (int c = 0; c < 32; ++c) { L[c] = *(const u32x2*)(p0 + (size_t)c * 4096 * 128); d[c] = d0[c * 64]; }
#pragma unroll
        for (int c = 0; c < 32; ++c) { *(u32x2*)(p0 + (size_t)c * 4096 * 128) = pack4(S);
            S[0] = d[c] * S[0] + bflo(L[c].x); S[1] = d[c] * S[1] + bfhi(L[c].x); S[2] = d[c] * S[2] + bflo(L[c].y); S[3] = d[c] * S[3] + bfhi(L[c].y); }
    }
}
__device__ __forceinline__ void ssd3_units(const int tid, LAS unsigned char* lds, int G, int cu, const bf16* XBT, const bf16* BCN, const bf16* ST, const float* DT, const float* a_log, const float* dskip,
                                           const bf16* Z, const float* normw, bf16* Y) {
    const int wid = __builtin_amdgcn_readfirstlane(tid >> 6), lane = tid & 63, q = lane >> 4, c16 = lane & 15;
    LAS bf16* CN = (LAS bf16*)(lds);
    LAS bf16* BN = (LAS bf16*)(lds + 34816);
    LAS bf16* CB = (LAS bf16*)(lds + 69632);
    LAS float* CUM = (LAS float*)(lds + 104448);
    LAS float* DTS = (LAS float*)(lds + 108544);
    LAS float* SQP = (LAS float*)(lds + 112640);
    for (int u = cu; u < 1024; u += G) {
        const int bc = u >> 3, g = u & 7, t0 = bc * 128, hd = g * 8 + wid;
#pragma unroll
        for (int i = 0; i < 4; ++i) { const int p = tid + NTHR * i, r = p >> 4, pc = p & 15; const bf16* src = BCN + (size_t)(t0 + r) * 2048 + g * 128 + pc * 8;
            *(LAS u32x4*)(BN + r * LP + pc * 8) = *(const u32x4*)src; *(LAS u32x4*)(CN + r * LP + pc * 8) = *(const u32x4*)(src + 1024); }
        (void)ssd_tables(DT, a_log, t0, hd, wid, lane, CUM, DTS);
        bf16x8 sf[4][4];
        const bf16* xb = XBT + ((size_t)bc * 5120 + hd * 64 + c16) * 128 + 8 * q;
        { const bf16* sb = ST + (((size_t)bc * 64 + hd) * 64 + c16) * 128 + 8 * q;
#pragma unroll
          for (int pb = 0; pb < 4; ++pb)
#pragma unroll
              for (int ks = 0; ks < 4; ++ks) sf[pb][ks] = *(const bf16x8*)(sb + (size_t)(16 * pb) * 128 + 32 * ks); }
        WG_SYNC();
        {
            bf16x8 cf[4];
#pragma unroll
            for (int ks = 0; ks < 4; ++ks) cf[ks] = lds_frag(CN, 16 * wid + c16, LP, 32 * ks + 8 * q);
#pragma unroll
            for (int sb = 0; sb < 8; ++sb) { if (sb > wid + 1) continue; f32x4 acc = (f32x4){0.f, 0.f, 0.f, 0.f};
#pragma unroll
                for (int ks = 0; ks < 4; ++ks) acc = MFMA16(lds_frag(BN, 16 * sb + c16, LP, 32 * ks + 8 * q), cf[ks], acc);
                *(LAS u32x2*)(CB + (16 * wid + c16) * LP + 16 * sb + 4 * q) = pack4(acc); }
        }
        WG_SYNC();
        const float dsk = dskip[hd];
        bf16* ybase = Y + (size_t)t0 * SSDIN + hd * 64 + 4 * q; const bf16* zbase = Z + (size_t)t0 * SSDIN + hd * 64 + 4 * q;
        const f32x4 nw0 = *(const f32x4*)(normw + hd * 64 + 4 * q), nw1 = *(const f32x4*)(normw + hd * 64 + 16 + 4 * q), nw2 = *(const f32x4*)(normw + hd * 64 + 32 + 4 * q), nw3 = *(const f32x4*)(normw + hd * 64 + 48 + 4 * q);
#pragma unroll 1
        for (int tp = 0; tp < 8; ++tp) {
        u32x2 yk[1][4];
#pragma unroll
        for (int tt = 0; tt < 1; ++tt) { const int tb = tp;
            const int tl = 16 * tb + c16; const float cumt = CUM[wid * 128 + tl], ect = __expf(cumt);
            f32x4 acc[4];
            { bf16x8 cf[4];
#pragma unroll
              for (int ks = 0; ks < 4; ++ks) cf[ks] = lds_frag(CN, tl, LP, 32 * ks + 8 * q);
#pragma unroll
              for (int pb = 0; pb < 4; ++pb) { acc[pb] = (f32x4){0.f, 0.f, 0.f, 0.f};
#pragma unroll
                  for (int ks = 0; ks < 4; ++ks) acc[pb] = MFMA16(sf[pb][ks], cf[ks], acc[pb]);
                  acc[pb] = acc[pb] * ect; } }
#pragma unroll
            for (int ks = 0; ks < 4; ++ks) { if (32 * ks > 16 * tb + 15) continue;
                const int s0 = 32 * ks + 8 * q; const u32x4 cbw = *(const LAS u32x4*)(CB + tl * LP + s0);
                const f32x4 c0 = *(const LAS f32x4*)(CUM + wid * 128 + s0), c1 = *(const LAS f32x4*)(CUM + wid * 128 + s0 + 4), d0 = *(const LAS f32x4*)(DTS + wid * 128 + s0), d1 = *(const LAS f32x4*)(DTS + wid * 128 + s0 + 4);
                float gv[8];
#pragma unroll
                for (int j = 0; j < 8; ++j) { const int s = s0 + j; const float cb = (j & 1) ? bfhi(cbw[j >> 1]) : bflo(cbw[j >> 1]); const float cs = j < 4 ? c0[j & 3] : c1[j & 3], ds = j < 4 ? d0[j & 3] : d1[j & 3];
                    float v = cb * __expf(fminf(cumt - cs, 0.f)) * ds; v = (s <= tl) ? v : 0.f; gv[j] = (s == tl) ? v + dsk : v; }
                u32x4 gw; gw.x = cvt_pk_bf16(gv[0], gv[1]); gw.y = cvt_pk_bf16(gv[2], gv[3]); gw.z = cvt_pk_bf16(gv[4], gv[5]); gw.w = cvt_pk_bf16(gv[6], gv[7]);
                const bf16x8 gf = __builtin_bit_cast(bf16x8, gw);
#pragma unroll
                for (int pb = 0; pb < 4; ++pb) acc[pb] = MFMA16(*(const bf16x8*)(xb + (size_t)(16 * pb) * 128 + 32 * ks), gf, acc[pb]);
            }
            float sq = 0.f;
#pragma unroll
            for (int pb = 0; pb < 4; ++pb) { const u32x2 zw = *(const u32x2*)(zbase + (size_t)tl * SSDIN + 16 * pb);
                f32x4 y; y[0] = acc[pb][0] * bflo(zw.x); y[1] = acc[pb][1] * bfhi(zw.x); y[2] = acc[pb][2] * bflo(zw.y); y[3] = acc[pb][3] * bfhi(zw.y);
                sq += (y[0] * y[0] + y[1] * y[1]) + (y[2] * y[2] + y[3] * y[3]); yk[tt][pb] = pack4(y); }
            sq += __shfl_xor(sq, 16); sq += __shfl_xor(sq, 32);
            if (q == 0) SQP[tl * 8 + wid] = sq;
        }
        WG_SYNC();
#pragma unroll
        for (int tt = 0; tt < 1; ++tt) { const int tl = 16 * tp + c16; const f32x4 s0 = *(const LAS f32x4*)(SQP + tl * 8), s1 = *(const LAS f32x4*)(SQP + tl * 8 + 4);
            const float rstd = rsqrtf((((s0[0] + s0[1]) + (s0[2] + s0[3])) + ((s1[0] + s1[1]) + (s1[2] + s1[3]))) * (1.0f / 512.f) + EPS);
#pragma unroll
            for (int pb = 0; pb < 4; ++pb) { bf16* yp = ybase + (size_t)tl * SSDIN + 16 * pb; const u32x2 w = yk[tt][pb]; const f32x4 nw = pb == 0 ? nw0 : pb == 1 ? nw1 : pb == 2 ? nw2 : nw3;
                f32x4 y; y[0] = bflo(w.x) * rstd * nw[0]; y[1] = bfhi(w.x) * rstd * nw[1]; y[2] = bflo(w.y) * rstd * nw[2]; y[3] = bfhi(w.y) * rstd * nw[3];
                *(u32x2*)yp = pack4(y); } }
        }
        WG_SYNC();
    }
}
#ifndef REP_GEMM
#define REP_GEMM 1
#endif
#if REP_GEMM == 2
#define GEMM_REP(...) { __VA_ARGS__ } { __VA_ARGS__ }
#else
#define GEMM_REP(...) { __VA_ARGS__ }
#endif
#ifndef REP_MIX
#define REP_MIX 1
#endif
#ifndef REP_CONV
#define REP_CONV 1
#endif
struct Args { In in; float* out; unsigned char* ws; int ph_lo, ph_hi; };
static_assert(sizeof(Args) == 32 * 8 + 8 + 8 + 8, "Args has no padding");
typedef const Args __attribute__((address_space(4))) CArgs;

#ifndef SLEEP_MASK
#define SLEEP_MASK 0ull
#endif
#define SLEEP_AMP 4
#define PHASE_BEGIN if (pc >= lo && pc < hi) { const unsigned long long t0_ = SLEEP_MASK ? __builtin_amdgcn_s_memrealtime() : 0ull; (void)t0_; int tid = wave0 * 64 + (int)__builtin_amdgcn_mbcnt_hi(~0u, __builtin_amdgcn_mbcnt_lo(~0u, 0u)); asm volatile("" : "+v"(tid)); int cu = blockIdx.x; asm volatile("" : "+s"(cu)); int G = gridDim.x; asm volatile("" : "+s"(G)); \
        const int lane = tid & 63, wave = __builtin_amdgcn_readfirstlane(tid >> 6), gw = cu * NWAVES + wave, NGW = G * NWAVES; (void)lane; (void)gw; (void)NGW; \
        CArgs* ap = (CArgs*)__builtin_amdgcn_kernarg_segment_ptr(); asm volatile("" : "+s"(ap)); CIn& I = ap->in; unsigned char* const ws = ap->ws; float* const xres = ap->out; \
        unsigned char* const act = ws + WS_ACT; float* const SS = (float*)(ws + WS_SS); bf16* const XB = (bf16*)(ws + WS_XB); bf16* const WL = (bf16*)(ws + WS_WL); (void)I; (void)xres; (void)act; (void)SS; (void)XB; (void)WL;
#if MK_SPLIT
#define PHASE_END } ++pc;
#else
#define PHASE_END if (pc + 1 < hi) xcd_barrier(bar); if (SLEEP_MASK && ((SLEEP_MASK >> pc) & 1ull)) { const unsigned long long t1_ = __builtin_amdgcn_s_memrealtime(), until_ = t1_ + SLEEP_AMP * (t1_ - t0_); while (__builtin_amdgcn_s_memrealtime() < until_) __builtin_amdgcn_s_sleep(8); } } ++pc;
#endif
#define PHASE_END_LOCAL } ++pc;
#define D_WKV ((bf16*)(ws + WS_WKV))
#define D_KMAT ((bf16*)(ws + WS_KMAT))
#define D_VT ((bf16*)(ws + WS_VT))
#define D_MEMN ((bf16*)(ws + WS_MEMN))
#define D_LB ((float*)(ws + WS_TAB + TAB_LB))
#define D_WRT ((bf16*)(ws + WS_TAB + TAB_WRT))


template <int l>
__device__ __forceinline__ void layer_body(LAS unsigned char* lds, const int wave0, const int lo, const int hi, int& pc, const XcdBarrier& bar) {
    int ssi = 3 * l;

        if (l > 0) {
            PHASE_BEGIN
                int rot = 0; for (int rep_ = 0; rep_ < REP_CONV; ++rep_) { convert_layer(I, l, WL, (LAS float*)(lds + wave * 16640), gw, NGW, lane, rot); }
            PHASE_END
        }
        const int e = l >> 1;
        int mixK;
        if ((l & 1) == 0) {
#define PROJ ((bf16*)(act + A_PROJ))
#define LOGF ((float*)(act + A_LOGF))
#define HST ((bf16*)(act + A_HST))
#define YAB ((bf16*)(act + A_YAB))
#define SEG ((float*)(act + A_SEG))
#define HDEC ((float*)(act + A_HDEC))
            PHASE_BEGIN
                if (l == 0) { pg8::SchedKV S{(const char*)D_MEMN, (const char*)D_WKV, G, cu}; pg8::EpiKV E{D_KMAT, D_VT}; pg8::gemm_phase(tid, lds, D, D, D, S, E); asm volatile("" : "+v"(tid)); }
                GEMM_REP(pg8::SchedMN S; S.init(XB, D, WL + WL_IN, D, M, ABIN, G, cu); pg8::EpiProjEven E{SS + (size_t)ssi * M * 8, PROJ, LOGF, D_LB + e * 1024};
                pg8::gemm_phase<RF16>(tid, lds, D, D, D, S, E);)
            PHASE_END
            PHASE_BEGIN
                for (int rep_ = 0; rep_ < REP_MIX; ++rep_) { lru_units<false>(tid, lds, G, cu, PROJ, D_WRT + (size_t)e * 2 * 8 * 16384, I.lru_conv_w + e * 4 * LRUW, I.lru_conv_b + e * LRUW, I.lru_b_r + e * LRUW, I.lru_b_i + e * LRUW, I.lru_lambda + e * LRUW, SEG, YAB);
                hgrn1_units(tid, lds, G, cu, LOGF, PROJ, HST, HDEC); }
            PHASE_END
            PHASE_BEGIN
                for (int rep_ = 0; rep_ < REP_MIX; ++rep_) { lru_units<true>(tid, lds, G, cu, PROJ, D_WRT + (size_t)e * 2 * 8 * 16384, I.lru_conv_w + e * 4 * LRUW, I.lru_conv_b + e * LRUW, I.lru_b_r + e * LRUW, I.lru_b_i + e * LRUW, I.lru_lambda + e * LRUW, SEG, YAB); }
                hgrn2_scan(tid, G, cu, HST, HDEC);
            PHASE_END
            PHASE_BEGIN
                for (int rep_ = 0; rep_ < REP_MIX; ++rep_) { hgrn3_units(tid, lds, G, cu, LOGF, PROJ, HST, I.hgrn_norm + e * 1024, YAB); }
            PHASE_END
            mixK = D;
        } else {
#define Zb ((bf16*)(act + A_Z))
#define XBC ((bf16*)(act + A_XBC))
#define XBT ((bf16*)(act + A_XBT))
#define BCN ((bf16*)(act + A_BCN))
#define STb ((bf16*)(act + A_ST))
#define DTb ((float*)(act + A_DT))
#define DEC ((float*)(act + A_DEC))
#define Yb ((bf16*)(act + A_Y))
            PHASE_BEGIN
                GEMM_REP(pg8::SchedMN S; S.init(XB, D, WL + WL_IN, D, M, SSDN1, G, cu); pg8::EpiProjOdd E{SS + (size_t)ssi * M * 8, Zb, XBC};
                pg8::gemm_phase<RF16>(tid, lds, D, D, D, S, E);)
            PHASE_END
            PHASE_BEGIN
                for (int rep_ = 0; rep_ < REP_MIX; ++rep_) {
                { pg8::SchedDt S{(const char*)XB, (const char*)(WL + WL_DT), cu}; pg8::EpiDt E{SS + (size_t)ssi * M * 8, I.ssd_dt_bias + e * 64, DTb};
                  pg8::gemm_phase<RF16>(tid, lds, D, D, D, S, E); }
                { int uf = cu, us = G, ue = 6144; if (G == 256) { if (cu < 64) { us = 64; ue = 1152; } else { uf = 1152 + (cu - 64); us = 192; } }
                  ssd_prep_units(tid, lds, uf, us, ue, XBC, I.ssd_conv_w + (size_t)e * 4 * SSDCONV, I.ssd_conv_b + e * SSDCONV, XBT, BCN); }
                }
            PHASE_END
            PHASE_BEGIN
                for (int rep_ = 0; rep_ < REP_MIX; ++rep_) { ssd1_units(tid, lds, G, cu, XBT, DTb, I.ssd_a_log + e * 64, STb, DEC); }
            PHASE_END
            PHASE_BEGIN
                ssd2_scan(tid, G, cu, STb, DEC);
            PHASE_END
            PHASE_BEGIN
                for (int rep_ = 0; rep_ < REP_MIX; ++rep_) { ssd3_units(tid, lds, G, cu, XBT, BCN, STb, DTb, I.ssd_a_log + e * 64, I.ssd_d + e * 64, Zb, I.ssd_norm + e * SSDIN, Yb); }
            PHASE_END
            mixK = SSDIN;
        }
        PHASE_BEGIN
            pg8::SchedMN S; S.init(mixK == D ? (const bf16*)YAB : (const bf16*)Yb, mixK, WL + WL_OUT, mixK, M, D, G, cu); pg8::EpiResid E{XB, SS + (size_t)(ssi + 1) * M * 8, (LAS float*)(lds + EPI_OFF)};
            pg8::gemm_phase(tid, lds, mixK, mixK, mixK, S, E);
        PHASE_END
        ++ssi;
#define Qb ((bf16*)(act + A_Q))
#define Pb ((bf16*)(act + A_P))
#define Ob ((bf16*)(act + A_O))
#define Hb ((bf16*)(act + A_H))
        PHASE_BEGIN
            if (cu < 256) { const int pm = (cu & 7) * 8 + (cu >> 5), h = (cu >> 3) & 3;     int nu = 2; asm volatile("" : "+s"(nu));
                pg8::SchedChainQ S{(const char*)XB, (const char*)(WL + WL_Q), pm, h, nu}; pg8::EpiQ E{SS + (size_t)ssi * M * 8, Qb, 0.044194173824159216f}; pg8::gemm_phase<RF16>(tid, lds, D, D, D, S, E); }
        PHASE_END_LOCAL
        PHASE_BEGIN
            if (cu < 256) { const int pm = (cu & 7) * 8 + (cu >> 5), h = (cu >> 3) & 3;     int nu = 1, kk = XAD; asm volatile("" : "+s"(nu), "+s"(kk));
                pg8::SchedChainS S{(const char*)Qb, (const char*)(D_KMAT + (size_t)l * MEMROWS * D), pm, h, nu}; pg8::EpiSoftmax E{Pb, (LAS float*)(lds + EPI_OFF)}; pg8::gemm_phase(tid, lds, kk, D, D, S, E); }
        PHASE_END_LOCAL
        PHASE_BEGIN
            if (cu < 256) { const int pm = (cu & 7) * 8 + (cu >> 5), h = (cu >> 3) & 3;     int nu = 2, kk = MEMLEN; asm volatile("" : "+s"(nu), "+s"(kk));
                pg8::SchedChainPV S{(const char*)Pb, (const char*)(D_VT + (size_t)l * D * MEMROWS), pm, h, nu}; pg8::EpiPlain E{Ob, D}; pg8::gemm_phase(tid, lds, kk, 1024, MEMROWS, S, E); }
        PHASE_END
        PHASE_BEGIN
            pg8::SchedMN S; S.init(Ob, D, WL + WL_O, D, M, D, G, cu); pg8::EpiResid E{XB, SS + (size_t)(ssi + 1) * M * 8, (LAS float*)(lds + EPI_OFF)};
            pg8::gemm_phase(tid, lds, D, D, D, S, E);
        PHASE_END
        ++ssi;
        PHASE_BEGIN
            GEMM_REP(pg8::SchedMN S; S.init(XB, D, WL + WL_GU, D, M, 2 * FF, G, cu); pg8::EpiGateUp E{SS + (size_t)ssi * M * 8, Hb};
            pg8::gemm_phase<RF16>(tid, lds, D, D, D, S, E);)
        PHASE_END
        PHASE_BEGIN
            pg8::SchedMN S; S.init(Hb, FF, WL + WL_DN, FF, M, D, G, cu); pg8::EpiResid E{XB, SS + (size_t)(ssi + 1) * M * 8, (LAS float*)(lds + EPI_OFF)};
            pg8::gemm_phase(tid, lds, FF, FF, FF, S, E);
        PHASE_END
        ++ssi;
    }

__global__ void __launch_bounds__(NTHR, 2) fwd(Args args) {
    extern __shared__ __attribute__((aligned(16))) unsigned char lds_raw[];
    LAS unsigned char* lds = (LAS unsigned char*)lds_raw;
    volatile LAS unsigned* MISC = (volatile LAS unsigned*)(lds + MISC_OFF);
    const int wave0 = __builtin_amdgcn_readfirstlane((int)threadIdx.x >> 6);
    if (threadIdx.x < 64) MISC[threadIdx.x] = 0u;
    __syncthreads();
#if !MK_SPLIT
    XcdBarrier bar = xcd_barrier_post((unsigned*)(args.ws + WS_CTL), MISC + 8);
#else
    XcdBarrier bar; bar.bar = nullptr; bar.x = 0; bar.st = nullptr;
#endif
    const int lo = args.ph_lo, hi = args.ph_hi; int pc = 0;
    PHASE_BEGIN
        LAS float* scr = (LAS float*)(lds + wave * 16640);
        int rot = 0;
        for (int l = 0; l < DEPTH; ++l) conv_matrix<0>(I.xa_w_kv + (size_t)l * D * 4096, 4096, D, 0, 4096, nullptr, D_WKV + (size_t)l * 4096 * D, 0, scr, gw, NGW, lane, rot);
        for (int rep_ = 0; rep_ < REP_CONV; ++rep_) convert_layer(I, 0, WL, scr, gw, NGW, lane, rot);
        for (int m = gw; m < MEMROWS; m += NGW) {
            const f32x4* xr = (const f32x4*)(I.mem + (size_t)m * D); f32x4 v[8]; float s = 0.f;
#pragma unroll
            for (int j = 0; j < 8; ++j) { v[j] = xr[64 * j + lane]; s += (v[j][0] * v[j][0] + v[j][1] * v[j][1]) + (v[j][2] * v[j][2] + v[j][3] * v[j][3]); }
            const float rs = rsqrtf(wave_sum(s) * (1.0f / D) + EPS);
#pragma unroll
            for (int j = 0; j < 8; ++j) { const f32x4 g = *(const f32x4*)(I.norm_mem + (64 * j + lane) * 4); *(u32x2*)(D_MEMN + (size_t)m * D + (64 * j + lane) * 4) = pack4(v[j] * rs * g); }
        }
        for (int m = gw; m < M; m += NGW) {
            const f32x4* xr = (const f32x4*)(I.x + (size_t)m * D); float s = 0.f;
#pragma unroll
            for (int j = 0; j < 8; ++j) { const f32x4 v = xr[64 * j + lane]; s += (v[0] * v[0] + v[1] * v[1]) + (v[2] * v[2] + v[3] * v[3]); u32x2 w; w.x = rs_pk(v[0], v[1]); w.y = rs_pk(v[2], v[3]); *(u32x2*)(XB + (size_t)m * D + (64 * j + lane) * 4) = w; }
            s = wave_sum(s); if (lane < 8) SS[(size_t)m * 8 + lane] = lane == 0 ? s : 0.f;
        }
        for (int i = cu * NTHR + tid; i < 1024; i += G * NTHR) {
            const float a = I.hgrn_lb[i], b = I.hgrn_lb[1024 + i], mx = fmaxf(a, b), e0 = __expf(a - mx), e1 = __expf(b - mx); D_LB[i] = 0.f; D_LB[1024 + i] = e1 / (e0 + e1); }
        for (int i = cu * NTHR + tid; i < 2 * 2 * 8 * 16384; i += G * NTHR) {
            const int ii = i & 127, jj = (i >> 7) & 127, blk = (i >> 14) & 7, gt = (i >> 17) & 1, e = i >> 18;
            const float* src = gt ? I.lru_w_i : I.lru_w_r; D_WRT[i] = (bf16)f2bf(src[((size_t)(e * 8 + blk) * 128 + ii) * 128 + jj]); }
    PHASE_END

    layer_body<0>(lds, wave0, lo, hi, pc, bar); layer_body<1>(lds, wave0, lo, hi, pc, bar); layer_body<2>(lds, wave0, lo, hi, pc, bar); layer_body<3>(lds, wave0, lo, hi, pc, bar);
    const int ssi = 12;
    PHASE_BEGIN
        const float* ssf = SS + (size_t)ssi * M * 8;
        for (int m = gw; m < M; m += NGW) { f32x4* row = (f32x4*)(xres + (size_t)m * D); const u32x2* xr = (const u32x2*)(XB + (size_t)m * D); const float rs = pg8::rstd_of(ssf, m);
#pragma unroll
            for (int j = 0; j < 8; ++j) { const f32x4 g = *(const f32x4*)(I.norm_final + (64 * j + lane) * 4); const u32x2 w = xr[64 * j + lane];
                f32x4 o; o[0] = rs_lo(w.x) * rs * g[0]; o[1] = rs_hi(w.x) * rs * g[1]; o[2] = rs_lo(w.y) * rs * g[2]; o[3] = rs_hi(w.y) * rs * g[3]; row[64 * j + lane] = o; } }
    PHASE_END
#undef PHASE_BEGIN
#undef PHASE_END
}

constexpr int NPHASES = 1 + (5 + 6) + (1 + 6 + 6) + (1 + 5 + 6) + (1 + 6 + 6) + 1;

extern "C" void kernel_launch(void* const* d_in, const int* in_sizes, int n_in, void* d_out, int out_size, void* d_ws, size_t ws_size, hipStream_t stream) {
    static int grid = 0;
    if (grid == 0) {
        if (n_in != 32 || out_size != M * D || ws_size < WS_END) { fprintf(stderr, "kernel_launch: unexpected problem (n_in %d, out %d, ws %zu)\n", n_in, out_size, ws_size); grid = -1; return; }
        int dev = 0, cus = 0;
        if (hipGetDevice(&dev) != hipSuccess || hipDeviceGetAttribute(&cus, hipDeviceAttributeMultiprocessorCount, dev) != hipSuccess) { grid = -1; return; }
        if (hipFuncSetAttribute((const void*)fwd, hipFuncAttributeMaxDynamicSharedMemorySize, LDS_BYTES) != hipSuccess) { fprintf(stderr, "kernel_launch: hipFuncSetAttribute failed\n"); grid = -1; return; }
        int per_cu = 0;
        if (hipOccupancyMaxActiveBlocksPerMultiprocessor(&per_cu, (const void*)fwd, NTHR, LDS_BYTES) != hipSuccess || per_cu < 1) fprintf(stderr, "kernel_launch: occupancy query says %d\n", per_cu);
        (void)hipGetLastError();
        if (cus != 256) { fprintf(stderr, "kernel_launch: built for a 256-CU device (got %d)\n", cus); grid = -1; return; }
        grid = cus;
    }
    if (grid < 0) return;
    (void)hipMemsetAsync((char*)d_ws + WS_CTL, 0, CTL_ZERO_BYTES, stream);
    Args a{};
    const float** ip = (const float**)&a.in;
    for (int i = 0; i < 32; ++i) ip[i] = (const float*)d_in[i];
    a.out = (float*)d_out; a.ws = (unsigned char*)d_ws;
#if MK_SPLIT
#ifndef PROBE_MASK
#define PROBE_MASK 0ull
#endif
    for (int li = 0; li < NPHASES; ++li) { a.ph_lo = li; a.ph_hi = li + 1; hipLaunchKernelGGL(fwd, dim3(grid), dim3(NTHR), LDS_BYTES, stream, a);
        if ((PROBE_MASK >> li) & 1ull) hipLaunchKernelGGL(fwd, dim3(grid), dim3(NTHR), LDS_BYTES, stream, a); }
#else
    a.ph_lo = 0; a.ph_hi = NPHASES;
    hipLaunchKernelGGL(fwd, dim3(grid), dim3(NTHR), LDS_BYTES, stream, a);
#endif
}
```

```cpp
#include <hip/hip_runtime.h>
#include <cstdio>
#include <cstdint>

#ifndef MK_SPLIT
#define MK_SPLIT 0
#endif

#ifndef RESID_F16
#define RESID_F16 0
#endif
constexpr bool RF16 = RESID_F16 != 0;
#define GAS __attribute__((address_space(1)))
#define LAS __attribute__((address_space(3)))
typedef unsigned short bf16;
typedef short bf16x8 __attribute__((ext_vector_type(8)));
typedef float f32x4 __attribute__((ext_vector_type(4)));
typedef float f32x2 __attribute__((ext_vector_type(2)));
typedef unsigned u32x4 __attribute__((ext_vector_type(4)));
typedef unsigned u32x2 __attribute__((ext_vector_type(2)));

constexpr int D = 2048, NB = 4, SEQ = 4096, M = NB * SEQ, DEPTH = 4, MEMLEN = 256, MEMROWS = NB * MEMLEN;
constexpr int LRUW = 1024, ABIN = 6144;
constexpr int SSDIN = 4096, SSDCONV = 6144, SSDPROJ = 10304, SSDN1 = 10240, NHEADS = 64;
constexpr int XAD = 512, FF = 5632;
constexpr float EPS = 1e-6f;
constexpr int NWAVES = 8, NTHR = 512;

constexpr size_t MiB = 1u << 20;
constexpr size_t WS_CTL = 0, CTL_ZERO_BYTES = 1 * MiB;
constexpr size_t WS_WKV = 2 * MiB;
constexpr size_t WS_KMAT = 66 * MiB;
constexpr size_t WS_VT = 82 * MiB;
constexpr size_t WS_MEMN = 98 * MiB;
constexpr size_t WS_TAB = 102 * MiB;
constexpr size_t WS_XB = 106 * MiB;
constexpr size_t WS_WL = 170 * MiB;
constexpr size_t WS_ACT = 310 * MiB;
constexpr size_t WS_SS = (310 + 680) * MiB;
constexpr size_t WS_END = (310 + 680 + 8) * MiB;
constexpr size_t TAB_LB = 0;
constexpr size_t TAB_WRT = 64 * 1024;
constexpr size_t WL_IN = 0;
constexpr size_t WL_DT = (size_t)SSDN1 * D;
constexpr size_t WL_OUT = (size_t)(SSDN1 + 256) * D;
constexpr size_t WL_Q = WL_OUT + (size_t)D * SSDIN;
constexpr size_t WL_O = WL_Q + (size_t)D * D;
constexpr size_t WL_GU = WL_O + (size_t)D * D;
constexpr size_t WL_DN = WL_GU + (size_t)2 * FF * D;
constexpr size_t WL_ELEMS = WL_DN + (size_t)D * FF;
static_assert(WL_ELEMS * 2 <= 140 * MiB, "per-layer weights");
constexpr size_t A_Z = 0;
constexpr size_t A_XBC = 128 * MiB;
constexpr size_t A_Y = 128 * MiB;
constexpr size_t A_XBT = 320 * MiB;
constexpr size_t A_BCN = 480 * MiB;
constexpr size_t A_ST = 544 * MiB;
constexpr size_t A_DT = 672 * MiB;
constexpr size_t A_DEC = 676 * MiB;
constexpr size_t A_PROJ = 0;
constexpr size_t A_LOGF = 192 * MiB;
constexpr size_t A_HST = 256 * MiB;
constexpr size_t A_YAB = 320 * MiB;
constexpr size_t A_SEG = 384 * MiB;
constexpr size_t A_HDEC = 386 * MiB;
constexpr size_t A_Q = 0;
constexpr size_t A_VW = 16 * MiB;
constexpr size_t A_P = 64 * MiB;
constexpr size_t A_O = 96 * MiB;
constexpr size_t A_H = 160 * MiB;

constexpr int LDS_BYTES = 155648;
constexpr int EPI_OFF = 131072;
constexpr int MISC_OFF = LDS_BYTES - 256;

#define LDS_WAIT() asm volatile("s_waitcnt lgkmcnt(0)" ::: "memory")
#define VM_WAIT() asm volatile("s_waitcnt vmcnt(0)" ::: "memory")
__device__ __forceinline__ unsigned f2bf(float f) { unsigned u = __builtin_bit_cast(unsigned, f); return (u + 0x7fffu + ((u >> 16) & 1u)) >> 16; }
__device__ __forceinline__ unsigned pk2(float lo, float hi) { return f2bf(lo) | (f2bf(hi) << 16); }
typedef __bf16 bf16x2v __attribute__((ext_vector_type(2)));
__device__ __forceinline__ unsigned cvt_pk_bf16(float lo, float hi) { const f32x2 v = {lo, hi}; return __builtin_bit_cast(unsigned, __builtin_convertvector(v, bf16x2v)); }
typedef _Float16 f16x2v __attribute__((ext_vector_type(2)));
typedef _Float16 f16x8 __attribute__((ext_vector_type(8)));
__device__ __forceinline__ unsigned cvt_pk_f16(float lo, float hi) { const f32x2 v = {lo, hi}; return __builtin_bit_cast(unsigned, __builtin_convertvector(v, f16x2v)); }
__device__ __forceinline__ float h16lo(unsigned w) { return (float)__builtin_bit_cast(f16x2v, w)[0]; }
__device__ __forceinline__ float h16hi(unsigned w) { return (float)__builtin_bit_cast(f16x2v, w)[1]; }
__device__ __forceinline__ float bflo(unsigned w) { return __uint_as_float(w << 16); }
__device__ __forceinline__ float bfhi(unsigned w) { return __uint_as_float(w & 0xffff0000u); }
__device__ __forceinline__ unsigned rs_pk(float lo, float hi) { return RF16 ? cvt_pk_f16(lo, hi) : cvt_pk_bf16(lo, hi); }
__device__ __forceinline__ float rs_lo(unsigned w) { return RF16 ? h16lo(w) : bflo(w); }
__device__ __forceinline__ float rs_hi(unsigned w) { return RF16 ? h16hi(w) : bfhi(w); }
__device__ __forceinline__ float bf2f(bf16 b) { return __uint_as_float((unsigned)b << 16); }
__device__ __forceinline__ float sigm(float x) { return __builtin_amdgcn_rcpf(1.f + __expf(-x)); }
__device__ __forceinline__ float siluf(float x) { return x * sigm(x); }
__device__ __forceinline__ float gelu_tanh(float x) { return x * sigm(1.5957691216f * (x + 0.044715f * x * x * x)); }
__device__ __forceinline__ float softplusf(float x) { const float e = __expf(-fabsf(x)); const float l = (e < 0.03f) ? e * (1.f - e * (0.5f - e * 0.33333333f)) : __logf(1.f + e); return fmaxf(x, 0.f) + l; }
__device__ __forceinline__ float wave_sum(float v) {
#pragma unroll
    for (int o = 1; o < 64; o <<= 1) v += __shfl_xor(v, o);
    return v;
}

#define XB_TMO      128
#define XB_XCNT(j)  (256  + 64 * (j))
#define XB_XSUB(j)  (1280 + 64 * (j))
#define XB_XGEN(j)  (2304 + 64 * (j))
#define XB_TOP      3328
#define XB_TOPGEN   3392
#define XCD_BAR_WORDS 3456
#define XB_SPIN_CAP (1u << 18)

__device__ __forceinline__ unsigned xb_ld(unsigned* p)              { return __hip_atomic_load(p, __ATOMIC_RELAXED, __HIP_MEMORY_SCOPE_AGENT); }
__device__ __forceinline__ unsigned xb_add(unsigned* p, unsigned v) { return __hip_atomic_fetch_add(p, v, __ATOMIC_RELAXED, __HIP_MEMORY_SCOPE_AGENT); }
__device__ __forceinline__ unsigned xb_xcc_id() { return (unsigned)__builtin_amdgcn_s_getreg((3 << 11) | 20) & 0xFu; }
#define XB_SPIN(cond, bar) do { unsigned _sp = 0; while (cond) { __builtin_amdgcn_s_sleep(1); \
    if ((++_sp & 255u) == 0u) { if (xb_ld(&(bar)[XB_TMO])) break; if (_sp > XB_SPIN_CAP) { atomicAdd(&(bar)[XB_TMO], 1u); break; } } } } while (0)

struct XcdBarrier {
    unsigned* bar; unsigned x;
    volatile LAS unsigned* st;
};
__device__ __forceinline__ XcdBarrier xcd_barrier_post(unsigned* bar, volatile LAS unsigned* st) {
    XcdBarrier b; b.bar = bar; b.x = xb_xcc_id(); b.st = st;
    if (threadIdx.x == 0) (void)xb_add(&bar[XB_XCNT(b.x)], 1u);
    return b;
}
__device__ __forceinline__ void xcd_barrier_complete(unsigned* bar, unsigned x, unsigned& nloc, unsigned& nx) {
    const unsigned G = gridDim.x * gridDim.y * gridDim.z;
    unsigned sum, cnt, mine, sp = 0u;
    for (;;) {
        sum = 0u; cnt = 0u; mine = 0u;
#pragma unroll
        for (unsigned j = 0; j < 16; ++j) { const unsigned c = xb_ld(&bar[XB_XCNT(j)]); sum += c; cnt += (c > 0u) ? 1u : 0u; mine = (j == x) ? c : mine; }
        if (sum == G) break;
        __builtin_amdgcn_s_sleep(1);
        if ((++sp & 255u) == 0u) { if (xb_ld(&bar[XB_TMO])) break; if (sp > XB_SPIN_CAP) { atomicAdd(&bar[XB_TMO], 1u); break; } }
    }
    nloc = mine > 0u ? mine : 1u; nx = cnt > 0u ? cnt : 1u;
}
__device__ __forceinline__ void xcd_barrier(const XcdBarrier& b) {
    asm volatile("s_waitcnt vmcnt(0)" ::: "memory");
    __syncthreads();
    if (threadIdx.x == 0) {
        unsigned* bar = b.bar;
        __builtin_amdgcn_s_waitcnt(0);
        unsigned nloc = b.st[0], nx = b.st[1];
        if (nloc == 0u) { xcd_barrier_complete(bar, b.x, nloc, nx); b.st[0] = nloc; b.st[1] = nx; }
        const unsigned old = xb_add(&bar[XB_XSUB(b.x)], 1u);
        const unsigned gen = old / nloc;
        if (old + 1u == (gen + 1u) * nloc) {
            __builtin_amdgcn_fence(__ATOMIC_RELEASE, "agent");
            asm volatile("s_waitcnt vmcnt(0)" ::: "memory");
            const unsigned og = xb_add(&bar[XB_TOP], 1u);
            const unsigned tg = og / nx;
            if (og + 1u == (tg + 1u) * nx) xb_add(&bar[XB_TOPGEN], 1u);
            else XB_SPIN(xb_ld(&bar[XB_TOPGEN]) == tg, bar);
            __builtin_amdgcn_fence(__ATOMIC_ACQUIRE, "agent");
            xb_add(&bar[XB_XGEN(b.x)], 1u);
            asm volatile("s_waitcnt vmcnt(0)" ::: "memory");
        } else {
            XB_SPIN(xb_ld(&bar[XB_XGEN(b.x)]) == gen, bar);
            __builtin_amdgcn_fence(__ATOMIC_ACQUIRE, "agent");
            asm volatile("s_waitcnt vmcnt(0)" ::: "memory");
        }
    }
    __syncthreads();
}

namespace pg8 {
constexpr int BM = 256, BK = 64, HALF = 128, HTB = HALF * BK * 2, STAGE_BYTES = 8 * HTB, NXCD = 8, WGM = 8;
__host__ __device__ __forceinline__ int lds_byte(int r, int c) { const int st = (r >> 4) * 2 + (c >> 5), rr = r & 15, cc = c & 31, ob = rr * 64 + cc * 2; return st * 1024 + (ob ^ (((ob >> 9) & 1) << 5)); }
__host__ __device__ __forceinline__ void stage_rc(int b, int& R, int& C) { const int st = b / 1024, sb = b % 1024, swz = sb ^ (((sb >> 9) & 1) << 5); R = (st >> 1) * 16 + swz / 64; C = (st & 1) * 32 + (swz % 64) / 2; }
__host__ __device__ __forceinline__ int perm32(int rho) { const int n = rho >> 4, i = rho & 15; return 8 * (i >> 2) + 4 * n + (i & 3); }

struct Unit { const char* a; const char* b; int orow, ocol, aux; };

template <bool F16 = false, bool ALIGN = true, class Epi, class Sched>
__device__ __forceinline__ void gemm_phase(const int tid, LAS unsigned char* lds, const int K, const int lda, const int ldb, const Sched& S, const Epi& E) {
    const int wid = __builtin_amdgcn_readfirstlane(tid >> 6), lane = tid & 63, wr = wid >> 2, wc = wid & 3, fr = lane & 15, fq = lane >> 4;
    const int nt = K / BK;
    unsigned voffA[2], voffB[2];
#pragma unroll
    for (int i = 0; i < 2; ++i) { int R, C; stage_rc(tid * 16 + i * 8192, R, C); const int Rb = (R & ~31) + perm32(R & 31);
        voffA[i] = (unsigned)(R * lda + C) * 2u; voffB[i] = (unsigned)(Rb * ldb + C) * 2u; }
    const size_t kstep = (size_t)(BK * 2);
    const size_t hstepA = (size_t)HALF * lda * 2, hstepB = (size_t)HALF * ldb * 2;
    const unsigned ldsw = (unsigned)wid * 1024u;
    const int aoff = lds_byte(wr * 64 + fr, fq * 8), boff = lds_byte(wc * 32 + fr, fq * 8);
#define PG8_SA(b, h) (((b) * 2 + (h)) * HTB)
#define PG8_SB(b, h) ((4 + (b) * 2 + (h)) * HTB)
#define PG8_STAGE(bufoff, gbase, voff) do { _Pragma("unroll") for (int _i = 0; _i < 2; ++_i) \
        __builtin_amdgcn_global_load_lds((const unsigned*)((const char*)(gbase) + (voff)[_i]), (LAS unsigned*)(lds + (bufoff) + ldsw + _i * 8192), 16, 0, 0); } while (0)
#define PG8_LDA(dst, b, h) do { _Pragma("unroll") for (int m = 0; m < 4; ++m) _Pragma("unroll") for (int k = 0; k < 2; ++k) dst[m][k] = *(const LAS bf16x8*)(lds + PG8_SA(b, h) + aoff + m * 2048 + k * 1024); } while (0)
#define PG8_LDB(dst, b, h) do { _Pragma("unroll") for (int n = 0; n < 2; ++n) _Pragma("unroll") for (int k = 0; k < 2; ++k) dst[n][k] = *(const LAS bf16x8*)(lds + PG8_SB(b, h) + boff + n * 2048 + k * 1024); } while (0)
#define PG8_MMA(ai, bj, At, Bt) do { __builtin_amdgcn_s_setprio(1); _Pragma("unroll") for (int m = 0; m < 4; ++m) _Pragma("unroll") for (int n = 0; n < 2; ++n) _Pragma("unroll") for (int k = 0; k < 2; ++k) \
        acc[ai][bj][m][n] = F16 ? __builtin_amdgcn_mfma_f32_16x16x32_f16(__builtin_bit_cast(f16x8, Bt[n][k]), __builtin_bit_cast(f16x8, At[m][k]), acc[ai][bj][m][n], 0, 0, 0) \
                                : __builtin_amdgcn_mfma_f32_16x16x32_bf16(Bt[n][k], At[m][k], acc[ai][bj][m][n], 0, 0, 0); __builtin_amdgcn_s_setprio(0); } while (0)
#define PG8_WAIT_V(n) asm volatile("s_waitcnt vmcnt(" #n ")" ::: "memory")
#define PG8_WAIT_L(n) asm volatile("s_waitcnt lgkmcnt(" #n ")" ::: "memory")
#define PG8_BAR __builtin_amdgcn_s_barrier()
#define PG8_SCHED __builtin_amdgcn_sched_barrier(0)
    Unit cur, nxt; int ui = 0;
    if (!S.next(0, cur)) return;
    f32x4 acc[2][2][4][2];
#pragma unroll
    for (int a = 0; a < 2; ++a)
#pragma unroll
        for (int b = 0; b < 2; ++b)
#pragma unroll
            for (int m = 0; m < 4; ++m)
#pragma unroll
                for (int n = 0; n < 2; ++n) acc[a][b][m][n] = (f32x4){0.f, 0.f, 0.f, 0.f};
    bf16x8 At[4][2], B0[2][2], B1[2][2];
    const char* cA = cur.a; const char* cB = cur.b;
    PG8_STAGE(PG8_SB(0, 0), cB, voffB); PG8_STAGE(PG8_SB(0, 1), cB + hstepB, voffB); PG8_STAGE(PG8_SA(0, 0), cA, voffA); PG8_STAGE(PG8_SA(0, 1), cA + hstepA, voffA);
    if (wr == 1) PG8_BAR;
    PG8_WAIT_V(2); PG8_BAR;
    PG8_STAGE(PG8_SB(1, 0), cB + kstep, voffB); PG8_STAGE(PG8_SA(1, 0), cA + kstep, voffA); PG8_STAGE(PG8_SB(1, 1), cB + hstepB + kstep, voffB);
    PG8_WAIT_V(6); PG8_BAR;
    for (;;) {
        const bool has_next = S.next(ui + 1, nxt);
        const char* nA = has_next ? nxt.a : cA; const char* nB = has_next ? nxt.b : cB;
        for (int t = 0; t < nt; t += 2) {
            const bool last = (t == nt - 2);
            const char* a1 = cA + (size_t)(t + 1) * kstep;
            const char* a2 = last ? nA : cA + (size_t)(t + 2) * kstep; const char* b2 = last ? nB : cB + (size_t)(t + 2) * kstep;
            const char* a3 = a2 + kstep; const char* b3 = b2 + kstep;
            PG8_LDB(B0, 0, 0); PG8_LDB(B1, 0, 1); PG8_SCHED; PG8_LDA(At, 0, 0); PG8_STAGE(PG8_SA(1, 1), a1 + hstepA, voffA);
            PG8_WAIT_V(8); PG8_WAIT_L(0); PG8_BAR; PG8_MMA(0, 0, At, B0); PG8_MMA(0, 1, At, B1); PG8_BAR; PG8_SCHED;
            PG8_LDA(At, 0, 1); PG8_STAGE(PG8_SB(0, 0), b2, voffB); PG8_STAGE(PG8_SB(0, 1), b2 + hstepB, voffB); PG8_STAGE(PG8_SA(0, 0), a2, voffA);
            PG8_WAIT_V(8); PG8_WAIT_L(0); PG8_BAR; PG8_MMA(1, 0, At, B0); PG8_MMA(1, 1, At, B1); PG8_BAR; PG8_SCHED;
            PG8_LDB(B0, 1, 0); PG8_LDB(B1, 1, 1); PG8_SCHED; PG8_LDA(At, 1, 0); PG8_STAGE(PG8_SA(0, 1), a2 + hstepA, voffA);
            PG8_WAIT_V(8); PG8_WAIT_L(0); PG8_BAR; PG8_MMA(0, 0, At, B0); PG8_MMA(0, 1, At, B1); PG8_BAR; PG8_SCHED;
            PG8_LDA(At, 1, 1); PG8_STAGE(PG8_SB(1, 0), b3, voffB); PG8_STAGE(PG8_SB(1, 1), b3 + hstepB, voffB); PG8_STAGE(PG8_SA(1, 0), a3, voffA);
            PG8_WAIT_V(8); PG8_WAIT_L(0); PG8_BAR; PG8_MMA(1, 0, At, B0); PG8_MMA(1, 1, At, B1); PG8_BAR; PG8_SCHED;
        }
        if (ALIGN) { if (wr == 0) PG8_BAR; }
        E(acc, cur, wr, wc, fr, fq);
        if (!has_next) break;
#pragma unroll
        for (int a = 0; a < 2; ++a)
#pragma unroll
            for (int b = 0; b < 2; ++b)
#pragma unroll
                for (int m = 0; m < 4; ++m)
#pragma unroll
                    for (int n = 0; n < 2; ++n) acc[a][b][m][n] = (f32x4){0.f, 0.f, 0.f, 0.f};
        cur = nxt; cA = nA; cB = nB; ++ui;
        if (ALIGN) { if (wr == 1) PG8_BAR; }
    }
    PG8_WAIT_V(0);
    if (!ALIGN) { if (wr == 0) PG8_BAR; }
    PG8_BAR;
#undef PG8_SA
#undef PG8_SB
#undef PG8_STAGE
#undef PG8_LDA
#undef PG8_LDB
#undef PG8_MMA
#undef PG8_WAIT_V
#undef PG8_WAIT_L
#undef PG8_SCHED
}
}
namespace pg8 {
struct SchedMN {
    const char* A; const char* Bt; int lda, ldb; int nM, nN, nwg, G, c;
    __device__ __forceinline__ void init(const bf16* A_, int lda_, const bf16* Bt_, int ldb_, int Mrows, int Ncols, int G_, int c_) {
        A = (const char*)A_; Bt = (const char*)Bt_; lda = lda_; ldb = ldb_; nM = Mrows / BM; nN = Ncols / BM; nwg = nM * nN; G = G_; c = c_; }
    __device__ __forceinline__ bool next(int i, Unit& u) const {
        const long L = (long)i * G + c; if (L >= nwg) return false;
        int wgid = (int)L; { const int q = nwg / NXCD, r = nwg % NXCD, xcd = wgid % NXCD, off = wgid / NXCD; wgid = (xcd < r ? xcd * (q + 1) : r * (q + 1) + (xcd - r) * q) + off; }
        const int nig = WGM * nN, gid = wgid / nig, fm = gid * WGM, gsz = (nM - fm) < WGM ? (nM - fm) : WGM;
        const int pm = fm + ((wgid % nig) % gsz), pn = (wgid % nig) / gsz;
        u.a = A + (size_t)pm * BM * lda * 2; u.b = Bt + (size_t)pn * BM * ldb * 2; u.orow = pm * BM; u.ocol = pn * BM; u.aux = pn; return true;
    }
};
struct SchedKV {
    const char* memn; const char* wkv; int G, c;
    __device__ __forceinline__ bool next(int i, Unit& u) const {
        const int L = i * G + c; if (L >= 256) return false;
        const int l = L >> 6, r = L & 63; const char* w = wkv + (size_t)l * 4096 * D * 2;
        if (r < 32) { const int pm = r >> 3, pn = r & 7; u.a = memn + (size_t)pm * 256 * D * 2; u.b = w + (size_t)pn * 256 * D * 2; u.orow = pm * 256; u.ocol = pn * 256; u.aux = l * 2; }
        else { const int q = r - 32, pm = q >> 3, pn = q & 7; u.a = memn + (size_t)pm * 256 * D * 2; u.b = w + (size_t)(2048 + pn * 256) * D * 2; u.orow = pm * 256; u.ocol = pn * 256; u.aux = l * 2 + 1; }
        return true;
    }
};
struct SchedS {
    const char* Q; const char* Km; int G, c;
    __device__ __forceinline__ bool next(int i, Unit& u) const {
        const int L = i * G + c; if (L >= 256) return false;
        const int bh = 2 * (L & 7) + ((L >> 3) >> 4), it = (L >> 3) & 15, b = bh >> 2, h = bh & 3;
        u.a = Q + ((size_t)(b * SEQ + it * 256) * D + h * XAD) * 2; u.b = Km + ((size_t)(b * MEMLEN) * D + h * XAD) * 2; u.orow = b * SEQ + it * 256; u.ocol = h * 256; u.aux = 0; return true;
    }
};
struct SchedPV {
    const char* P; const char* Vt; int G, c;
    __device__ __forceinline__ bool next(int i, Unit& u) const {
        const int L = i * G + c; if (L >= 512) return false;
        const int x = L & 7, r = L >> 3;
        const int bh = 2 * x + (r >> 5), q = r & 31, it = q >> 1, nh = q & 1, b = bh >> 2, h = bh & 3;
        u.a = P + ((size_t)(b * SEQ + it * 256) * 1024 + h * 256) * 2; u.b = Vt + ((size_t)(h * XAD + nh * 256) * 1024 + b * MEMLEN) * 2; u.orow = b * SEQ + it * 256; u.ocol = h * XAD + nh * 256; u.aux = 0; return true;
    }
};
struct SchedDt {
    const char* A; const char* Bt; int c;
    __device__ __forceinline__ bool next(int i, Unit& u) const {
        if (i != 0 || c >= 64) return false;
        u.a = A + (size_t)c * 256 * D * 2; u.b = Bt; u.orow = c * 256; u.ocol = 0; u.aux = 0; return true;
    }
};

struct SchedOne {
    Unit u0; int n;
    __device__ __forceinline__ bool next(int i, Unit& u) const { if (i >= n) return false; u = u0; return true; }
};
struct SchedMNB {
    const char* A; const char* Bt; int lda, ldb; int nM, nN, nwg, G, c; size_t bstride;
    __device__ __forceinline__ void init(const bf16* A_, int lda_, const bf16* Bt_, int ldb_, int Mrows, int Ncols, int G_, int c_, size_t bstride_) {
        A = (const char*)A_; Bt = (const char*)Bt_; lda = lda_; ldb = ldb_; nM = Mrows / BM; nN = Ncols / BM; nwg = nM * nN; G = G_; c = c_; bstride = bstride_; }
    __device__ __forceinline__ bool next(int i, Unit& u) const {
        const long L = (long)i * G + c; if (L >= nwg) return false;
        int wgid = (int)L; { const int q = nwg / NXCD, r = nwg % NXCD, xcd = wgid % NXCD, off = wgid / NXCD; wgid = (xcd < r ? xcd * (q + 1) : r * (q + 1) + (xcd - r) * q) + off; }
        const int nig = WGM * nN, gid = wgid / nig, fm = gid * WGM, gsz = (nM - fm) < WGM ? (nM - fm) : WGM;
        const int pm = fm + ((wgid % nig) % gsz), pn = (wgid % nig) / gsz;
        u.a = A + (size_t)pm * BM * lda * 2; u.b = Bt + (size_t)(pm >> 4) * bstride + (size_t)pn * BM * ldb * 2; u.orow = pm * BM; u.ocol = pn * BM; u.aux = pn; return true;
    }
};
struct SchedChainQ {
    const char* A; const char* Bt; int pm, h, n;
    __device__ __forceinline__ bool next(int i, Unit& u) const { if (i >= n) return false; const int pn = 2 * h + i;
        u.a = A + (size_t)pm * 256 * D * 2; u.b = Bt + (size_t)pn * 256 * D * 2; u.orow = pm * 256; u.ocol = pn * 256; u.aux = pn; return true; }
};
struct SchedChainS {
    const char* Q; const char* Km; int pm, h, n;
    __device__ __forceinline__ bool next(int i, Unit& u) const { if (i >= n) return false; const int b = pm >> 4;
        u.a = Q + ((size_t)pm * 256 * D + h * XAD) * 2; u.b = Km + ((size_t)(b * MEMLEN) * D + h * XAD) * 2; u.orow = pm * 256; u.ocol = h * 256; u.aux = 0; return true; }
};
struct SchedChainPV {
    const char* P; const char* Vt; int pm, h, n;
    __device__ __forceinline__ bool next(int i, Unit& u) const { if (i >= n) return false; const int b = pm >> 4;
        u.a = P + ((size_t)pm * 256 * 1024 + h * 256) * 2; u.b = Vt + ((size_t)(h * XAD + i * 256) * 1024 + b * MEMLEN) * 2; u.orow = pm * 256; u.ocol = h * XAD + i * 256; u.aux = 0; return true; }
};

#define EPI_ARGS f32x4 (&acc)[2][2][4][2], const Unit& u, int wr, int wc, int fr, int fq
#define EPI_ROW(ai, m) (u.orow + (ai) * HALF + wr * 64 + (m) * 16 + fr)
#define EPI_COL(bj) (u.ocol + (bj) * HALF + wc * 32 + 8 * fq)
__device__ __forceinline__ float rstd_of(const float* ss, int row) { const f32x4 a = *(const f32x4*)(ss + (size_t)row * 8), b = *(const f32x4*)(ss + (size_t)row * 8 + 4);
    return rsqrtf((((a[0] + a[1]) + (a[2] + a[3])) + ((b[0] + b[1]) + (b[2] + b[3]))) * (1.0f / D) + EPS); }
__device__ __forceinline__ u32x4 pack8(const f32x4 a, const f32x4 b) { u32x4 w; w.x = cvt_pk_bf16(a[0], a[1]); w.y = cvt_pk_bf16(a[2], a[3]); w.z = cvt_pk_bf16(b[0], b[1]); w.w = cvt_pk_bf16(b[2], b[3]); return w; }

struct EpiProjEven {
    const float* ss; bf16* proj; float* logf; const float* lb;
    __device__ __forceinline__ void operator()(EPI_ARGS) const {
        const int range = u.aux >> 2;
#pragma unroll
        for (int ai = 0; ai < 2; ++ai)
#pragma unroll
            for (int m = 0; m < 4; ++m) { const int row = EPI_ROW(ai, m); const float rs = rstd_of(ss, row);
#pragma unroll
                for (int bj = 0; bj < 2; ++bj) { const int col = EPI_COL(bj); f32x4 v0 = acc[ai][bj][m][0] * rs, v1 = acc[ai][bj][m][1] * rs;
                    if (range == 3) { const int c = col - 3072; const f32x4 l0 = *(const f32x4*)(lb + c), l1 = *(const f32x4*)(lb + c + 4);
#pragma unroll
                        for (int j = 0; j < 4; ++j) { v0[j] = __logf(l0[j] + (1.f - l0[j]) * sigm(v0[j])); v1[j] = __logf(l1[j] + (1.f - l1[j]) * sigm(v1[j])); }
                        float* p = logf + (size_t)row * 1024 + c; *(f32x4*)p = v0; *(f32x4*)(p + 4) = v1;
                    } else {
                        if (range == 1) {
#pragma unroll
                            for (int j = 0; j < 4; ++j) { v0[j] = gelu_tanh(v0[j]); v1[j] = gelu_tanh(v1[j]); } }
                        else if (range == 2 || range == 5) {
#pragma unroll
                            for (int j = 0; j < 4; ++j) { v0[j] = siluf(v0[j]); v1[j] = siluf(v1[j]); } }
                        *(u32x4*)(proj + (size_t)row * ABIN + col) = pack8(v0, v1);
                    } } }
    }
};
struct EpiProjOdd {
    const float* ss; bf16* Z; bf16* XBC;
    __device__ __forceinline__ void operator()(EPI_ARGS) const {
        const bool isz = u.ocol < SSDIN;
#pragma unroll
        for (int ai = 0; ai < 2; ++ai)
#pragma unroll
            for (int m = 0; m < 4; ++m) { const int row = EPI_ROW(ai, m); const float rs = rstd_of(ss, row);
#pragma unroll
                for (int bj = 0; bj < 2; ++bj) { const int col = EPI_COL(bj); f32x4 v0 = acc[ai][bj][m][0] * rs, v1 = acc[ai][bj][m][1] * rs;
                    if (isz) {
#pragma unroll
                        for (int j = 0; j < 4; ++j) { v0[j] = siluf(v0[j]); v1[j] = siluf(v1[j]); }
                        *(u32x4*)(Z + (size_t)row * SSDIN + col) = pack8(v0, v1);
                    } else *(u32x4*)(XBC + (size_t)row * SSDCONV + (col - SSDIN)) = pack8(v0, v1); } }
    }
};
struct EpiDt {
    const float* ss; const float* bias; float* DT;
    __device__ __forceinline__ void operator()(EPI_ARGS) const {
        if (wc >= 2) return;
        const int col = wc * 32 + 8 * fq; const f32x4 b0 = *(const f32x4*)(bias + col), b1 = *(const f32x4*)(bias + col + 4);
#pragma unroll
        for (int ai = 0; ai < 2; ++ai)
#pragma unroll
            for (int m = 0; m < 4; ++m) { const int row = EPI_ROW(ai, m); const float rs = rstd_of(ss, row);
                f32x4 v0 = acc[ai][0][m][0] * rs + b0, v1 = acc[ai][0][m][1] * rs + b1;
#pragma unroll
                for (int j = 0; j < 4; ++j) { v0[j] = softplusf(v0[j]); v1[j] = softplusf(v1[j]); }
                float* p = DT + (size_t)row * 64 + col; *(f32x4*)p = v0; *(f32x4*)(p + 4) = v1; }
    }
};
struct EpiResid {
    bf16* xb; float* ssnew; LAS float* tab;
    __device__ __forceinline__ void operator()(EPI_ARGS) const {
#pragma unroll
        for (int ai = 0; ai < 2; ++ai)
#pragma unroll
            for (int m = 0; m < 4; ++m) { const int row = EPI_ROW(ai, m); float sq = 0.f;
#pragma unroll
                for (int bj = 0; bj < 2; ++bj) { bf16* p = xb + (size_t)row * D + EPI_COL(bj); const u32x4 w = *(const u32x4*)p;
                    f32x4 o0 = acc[ai][bj][m][0], o1 = acc[ai][bj][m][1];
                    o0[0] += rs_lo(w.x); o0[1] += rs_hi(w.x); o0[2] += rs_lo(w.y); o0[3] += rs_hi(w.y); o1[0] += rs_lo(w.z); o1[1] += rs_hi(w.z); o1[2] += rs_lo(w.w); o1[3] += rs_hi(w.w);
                    { u32x4 pk; pk.x = rs_pk(o0[0], o0[1]); pk.y = rs_pk(o0[2], o0[3]); pk.z = rs_pk(o1[0], o1[1]); pk.w = rs_pk(o1[2], o1[3]); *(u32x4*)p = pk; }
                    sq += ((o0[0] * o0[0] + o0[1] * o0[1]) + (o0[2] * o0[2] + o0[3] * o0[3])) + ((o1[0] * o1[0] + o1[1] * o1[1]) + (o1[2] * o1[2] + o1[3] * o1[3])); }
                sq += __shfl_xor(sq, 16); sq += __shfl_xor(sq, 32);
                if (fq == 0) tab[(ai * HALF + wr * 64 + m * 16 + fr) * 4 + wc] = sq; }
        LDS_WAIT(); PG8_BAR; asm volatile("" ::: "memory");
        const int lane = fq * 16 + fr, r = (wr * 4 + wc) * 32 + (lane & 31);
        if (lane < 32) { const f32x4 t = *(const LAS f32x4*)(tab + r * 4); ssnew[(size_t)(u.orow + r) * 8 + (u.ocol >> 8)] = (t[0] + t[1]) + (t[2] + t[3]); }
    }
};
struct EpiQ {
    const float* ss; bf16* Q; float scale;
    __device__ __forceinline__ void operator()(EPI_ARGS) const {
#pragma unroll
        for (int ai = 0; ai < 2; ++ai)
#pragma unroll
            for (int m = 0; m < 4; ++m) { const int row = EPI_ROW(ai, m); const float rs = rstd_of(ss, row) * scale;
#pragma unroll
                for (int bj = 0; bj < 2; ++bj) *(u32x4*)(Q + (size_t)row * D + EPI_COL(bj)) = pack8(acc[ai][bj][m][0] * rs, acc[ai][bj][m][1] * rs); }
    }
};
struct EpiPlain {
    bf16* O; int ldc;
    __device__ __forceinline__ void operator()(EPI_ARGS) const {
#pragma unroll
        for (int ai = 0; ai < 2; ++ai)
#pragma unroll
            for (int m = 0; m < 4; ++m) { const int row = EPI_ROW(ai, m);
#pragma unroll
                for (int bj = 0; bj < 2; ++bj) *(u32x4*)(O + (size_t)row * ldc + EPI_COL(bj)) = pack8(acc[ai][bj][m][0], acc[ai][bj][m][1]); }
    }
};
struct EpiKV {
    bf16* Km; bf16* Vt;
    __device__ __forceinline__ void operator()(EPI_ARGS) const {
        const int l = u.aux >> 1; const bool isv = u.aux & 1;
        bf16* O = Km + (size_t)l * MEMROWS * D + (size_t)(isv ? 1 : 0) * (size_t)(Vt - Km); const int ldc = D;
#pragma unroll
        for (int ai = 0; ai < 2; ++ai)
#pragma unroll
            for (int m = 0; m < 4; ++m) { const int row = EPI_ROW(ai, m);
#pragma unroll
                for (int bj = 0; bj < 2; ++bj) *(u32x4*)(O + (size_t)row * ldc + EPI_COL(bj)) = pack8(acc[ai][bj][m][0], acc[ai][bj][m][1]); }
    }
};
struct EpiSoftmax {
    const float* ss; float scale; bf16* P; LAS float* tab;
    __device__ __forceinline__ void operator()(EPI_ARGS) const {
        float mx[2][4];
#pragma unroll
        for (int ai = 0; ai < 2; ++ai)
#pragma unroll
            for (int m = 0; m < 4; ++m) { float v = -3.0e38f; const float rs = rstd_of(ss, EPI_ROW(ai, m)) * scale;
#pragma unroll
                for (int bj = 0; bj < 2; ++bj)
#pragma unroll
                    for (int n = 0; n < 2; ++n) { const f32x4 a = acc[ai][bj][m][n] * rs; acc[ai][bj][m][n] = a; v = fmaxf(v, fmaxf(fmaxf(a[0], a[1]), fmaxf(a[2], a[3]))); }
                v = fmaxf(v, __shfl_xor(v, 16)); v = fmaxf(v, __shfl_xor(v, 32));
                if (fq == 0) tab[(ai * HALF + wr * 64 + m * 16 + fr) * 4 + wc] = v; }
        LDS_WAIT(); PG8_BAR; asm volatile("" ::: "memory");
#pragma unroll
        for (int ai = 0; ai < 2; ++ai)
#pragma unroll
            for (int m = 0; m < 4; ++m) { const int r = ai * HALF + wr * 64 + m * 16 + fr; const f32x4 t = *(const LAS f32x4*)(tab + r * 4);
                const float rm = fmaxf(fmaxf(t[0], t[1]), fmaxf(t[2], t[3])); float s = 0.f;
#pragma unroll
                for (int bj = 0; bj < 2; ++bj)
#pragma unroll
                    for (int n = 0; n < 2; ++n) { f32x4 a = acc[ai][bj][m][n];
#pragma unroll
                        for (int j = 0; j < 4; ++j) { a[j] = __expf(a[j] - rm); s += a[j]; }
                        acc[ai][bj][m][n] = a; }
                s += __shfl_xor(s, 16); s += __shfl_xor(s, 32);
                if (fq == 0) tab[1024 + r * 4 + wc] = s; }
        LDS_WAIT(); PG8_BAR; asm volatile("" ::: "memory");
#pragma unroll
        for (int ai = 0; ai < 2; ++ai)
#pragma unroll
            for (int m = 0; m < 4; ++m) { const int r = ai * HALF + wr * 64 + m * 16 + fr; const f32x4 t = *(const LAS f32x4*)(tab + 1024 + r * 4);
                const float inv = __builtin_amdgcn_rcpf((t[0] + t[1]) + (t[2] + t[3])); const int row = u.orow + r;
#pragma unroll
                for (int bj = 0; bj < 2; ++bj) *(u32x4*)(P + (size_t)row * 1024 + EPI_COL(bj)) = pack8(acc[ai][bj][m][0] * inv, acc[ai][bj][m][1] * inv); }
    }
};
struct EpiGateUp {
    const float* ss; bf16* H;
    __device__ __forceinline__ void operator()(EPI_ARGS) const {
#pragma unroll
        for (int ai = 0; ai < 2; ++ai)
#pragma unroll
            for (int m = 0; m < 4; ++m) { const int row = EPI_ROW(ai, m); const float rs = rstd_of(ss, row);
#pragma unroll
                for (int bj = 0; bj < 2; ++bj) { const int hc = EPI_COL(bj) >> 1; const f32x4 g = acc[ai][bj][m][0] * rs, up = acc[ai][bj][m][1] * rs; f32x4 h;
#pragma unroll
                    for (int j = 0; j < 4; ++j) h[j] = siluf(g[j]) * up[j];
                    u32x2 w; w.x = cvt_pk_bf16(h[0], h[1]); w.y = cvt_pk_bf16(h[2], h[3]); *(u32x2*)(H + (size_t)row * FF + hc) = w; } }
    }
};
#undef EPI_ARGS
}
#define MFMA16(X, Y, ACC) __builtin_amdgcn_mfma_f32_16x16x32_bf16((X), (Y), (ACC), 0, 0, 0)
#define WG_SYNC() do { asm volatile("s_waitcnt vmcnt(0) lgkmcnt(0)" ::: "memory"); __builtin_amdgcn_s_barrier(); asm volatile("" ::: "memory"); } while (0)
#define LDS_SYNC() do { asm volatile("s_waitcnt lgkmcnt(0)" ::: "memory"); __builtin_amdgcn_s_barrier(); asm volatile("" ::: "memory"); } while (0)
constexpr int LP = 136;
constexpr int LP64 = 72;
__device__ __forceinline__ bf16x8 lds_frag(const LAS bf16* base, int row, int pitch, int kofs) { return *(const LAS bf16x8*)(base + row * pitch + kofs); }
__device__ __forceinline__ u32x2 pack4(const f32x4 a) { u32x2 w; w.x = cvt_pk_bf16(a[0], a[1]); w.y = cvt_pk_bf16(a[2], a[3]); return w; }

template <int MAP, bool F16>
__device__ __forceinline__ void conv_item(const float* W, int ldw, int K, int n0, const float* gain, bf16* WT, int row_off, LAS float* scr, int item, int nblk, int lane) {
    const int kb = item / nblk, nb = item % nblk, k0 = 64 * kb, nn0 = 64 * nb;
    const int kr = lane >> 4, n4 = (lane & 15) * 4;
    const float* src = W + (size_t)(k0 + kr) * ldw + n0 + nn0 + n4;
    f32x4 v[16];
#pragma unroll
    for (int i = 0; i < 16; ++i) v[i] = *(const f32x4*)(src + (size_t)(4 * i) * ldw);
#pragma unroll
    for (int i = 0; i < 16; ++i) { f32x4 w = v[i]; if (gain) w = w * gain[k0 + 4 * i + kr];
        LAS float* d = scr + (4 * i + kr) * 65 + n4; d[0] = w[0]; d[1] = w[1]; d[2] = w[2]; d[3] = w[3]; }
    LDS_WAIT(); asm volatile("" ::: "memory");
    const int c = lane & 7, nbase = lane >> 3;
#pragma unroll
    for (int j = 0; j < 8; ++j) { const int n = nbase + 8 * j; const LAS float* s = scr + (8 * c) * 65 + n;
        u32x4 o; if (F16) { o.x = cvt_pk_f16(s[0 * 65], s[1 * 65]); o.y = cvt_pk_f16(s[2 * 65], s[3 * 65]); o.z = cvt_pk_f16(s[4 * 65], s[5 * 65]); o.w = cvt_pk_f16(s[6 * 65], s[7 * 65]); }
        else { o.x = cvt_pk_bf16(s[0 * 65], s[1 * 65]); o.y = cvt_pk_bf16(s[2 * 65], s[3 * 65]); o.z = cvt_pk_bf16(s[4 * 65], s[5 * 65]); o.w = cvt_pk_bf16(s[6 * 65], s[7 * 65]); }
        const int nn = nn0 + n; const int dr = MAP == 0 ? nn : ((nn >> 2) * 8 + (nn & 3) + (MAP == 2 ? 4 : 0));
        *(u32x4*)(WT + (size_t)(row_off + dr) * K + k0 + 8 * c) = o; }
    LDS_WAIT(); asm volatile("" ::: "memory");
}
__device__ __forceinline__ void conv_item_nat(const float* W, int ldw, const float* gain, bf16* WN, int item, int nblk, int lane) {
    const int kb = item / nblk, nb = item % nblk, k0 = 64 * kb, nn0 = 64 * nb;
    const int kr = lane >> 4, n4 = (lane & 15) * 4;
    const float* src = W + (size_t)(k0 + kr) * ldw + nn0 + n4; bf16* dst = WN + (size_t)(k0 + kr) * ldw + nn0 + n4;
    f32x4 v[16];
#pragma unroll
    for (int i = 0; i < 16; ++i) v[i] = *(const f32x4*)(src + (size_t)(4 * i) * ldw);
#pragma unroll
    for (int i = 0; i < 16; ++i) { const f32x4 w = v[i] * gain[k0 + 4 * i + kr]; *(u32x2*)(dst + (size_t)(4 * i) * ldw) = pack4(w); }
}
__device__ __forceinline__ void conv_matrix_nat(const float* W, int ldw, int K, const float* gain, bf16* WN, int gw, int NGW, int lane, int& rot) {
    const int nblk = ldw / 64, nitems = (K / 64) * nblk; int first = gw - rot; if (first < 0) first += NGW;
    for (int it = first; it < nitems; it += NGW) conv_item_nat(W, ldw, gain, WN, it, nblk, lane);
    rot = (rot + nitems) % NGW;
}
template <int MAP, bool F16 = false>
__device__ __forceinline__ void conv_matrix(const float* W, int ldw, int K, int n0, int ncols, const float* gain, bf16* WT, int row_off, LAS float* scr, int gw, int NGW, int lane, int& rot) {
    const int nblk = ncols / 64, nitems = (K / 64) * nblk; int first = gw - rot; if (first < 0) first += NGW;
    for (int it = first; it < nitems; it += NGW) conv_item<MAP, F16>(W, ldw, K, n0, gain, WT, row_off, scr, it, nblk, lane);
    rot = (rot + nitems) % NGW;
}

struct In {
    const float *x, *mem, *norm_mix, *norm_xattn, *norm_ffn, *norm_mem, *norm_final, *ab_w_in, *ab_w_out, *lru_conv_w, *lru_conv_b, *lru_w_r, *lru_b_r, *lru_w_i, *lru_b_i, *lru_lambda,
        *hgrn_lb, *hgrn_norm, *ssd_w_in, *ssd_w_out, *ssd_conv_w, *ssd_conv_b, *ssd_dt_bias, *ssd_a_log, *ssd_d, *ssd_norm, *xa_w_q, *xa_w_kv, *xa_w_o, *ffn_w_gate, *ffn_w_up, *ffn_w_down;
};

typedef const In __attribute__((address_space(4))) CIn;
__device__ __forceinline__ void convert_layer(CIn& I, int l, bf16* WL, LAS float* scr, int gw, int NGW, int lane, int& rot) {
    const int e = l >> 1;
    if ((l & 1) == 0) {
        conv_matrix<0, RF16>(I.ab_w_in + (size_t)e * D * ABIN, ABIN, D, 0, ABIN, I.norm_mix + l * D, WL + WL_IN, 0, scr, gw, NGW, lane, rot);
        conv_matrix<0>(I.ab_w_out + (size_t)e * D * D, D, D, 0, D, nullptr, WL + WL_OUT, 0, scr, gw, NGW, lane, rot);
    } else {
        conv_matrix<0, RF16>(I.ssd_w_in + (size_t)e * D * SSDPROJ, SSDPROJ, D, 0, SSDN1, I.norm_mix + l * D, WL + WL_IN, 0, scr, gw, NGW, lane, rot);
        conv_matrix<0, RF16>(I.ssd_w_in + (size_t)e * D * SSDPROJ, SSDPROJ, D, SSDN1, 64, I.norm_mix + l * D, WL + WL_DT, 0, scr, gw, NGW, lane, rot);
        for (int i = gw * 64 + lane; i < 192 * D / 8; i += NGW * 64) *(u32x4*)(WL + WL_DT + (size_t)64 * D + (size_t)i * 8) = (u32x4){0u, 0u, 0u, 0u};
        conv_matrix<0>(I.ssd_w_out + (size_t)e * SSDIN * D, D, SSDIN, 0, D, nullptr, WL + WL_OUT, 0, scr, gw, NGW, lane, rot);
    }
    conv_matrix_nat(I.xa_w_q + (size_t)l * D * D, D, D, I.norm_xattn + l * D, WL + WL_Q, gw, NGW, lane, rot);
    conv_matrix<0>(I.xa_w_o + (size_t)l * D * D, D, D, 0, D, nullptr, WL + WL_O, 0, scr, gw, NGW, lane, rot);
    conv_matrix<1, RF16>(I.ffn_w_gate + (size_t)l * D * FF, FF, D, 0, FF, I.norm_ffn + l * D, WL + WL_GU, 0, scr, gw, NGW, lane, rot);
    conv_matrix<2, RF16>(I.ffn_w_up + (size_t)l * D * FF, FF, D, 0, FF, I.norm_ffn + l * D, WL + WL_GU, 0, scr, gw, NGW, lane, rot);
    conv_matrix<0>(I.ffn_w_down + (size_t)l * FF * D, D, FF, 0, D, nullptr, WL + WL_DN, 0, scr, gw, NGW, lane, rot);
}

template <bool PASSB>
__device__ __forceinline__ void lru_units(const int tid, LAS unsigned char* lds, int G, int cu, const bf16* PROJ, const bf16* WRT, const float* cw, const float* cb, const float* br, const float* bi,
                                          const float* lam, float* SEG, bf16* YAB) {
    const int wid = __builtin_amdgcn_readfirstlane(tid >> 6), lane = tid & 63, q = lane >> 4, c16 = lane & 15;
    LAS bf16* XA = (LAS bf16*)(lds);
    LAS bf16* XC = (LAS bf16*)(lds + 35840);
    LAS bf16* WR = (LAS bf16*)(lds + 70656);
    LAS bf16* WI = (LAS bf16*)(lds + 105472);
    LAS float* PAR = (LAS float*)(lds + 140288);
    LAS float* WT = (LAS float*)(lds + 144384);
    LAS float* HIN = (LAS float*)(lds + 152576);
    int loadedj = -1;
    for (int u = cu; u < 1024; u += G) {
        const int j = u & 7, rest = u >> 3, b = rest >> 5, seg = rest & 31; const int t0 = b * SEQ + seg * 128;
        if (j != loadedj) {
            loadedj = j;
            for (int p = tid; p < 2 * 2048; p += NTHR) { const int g = p >> 11, pp = p & 2047, r = pp >> 4, pc = pp & 15;
                const u32x4 v = *(const u32x4*)(WRT + ((size_t)(g * 8 + j) * 128 + r) * 128 + pc * 8);
                *(LAS u32x4*)((g ? WI : WR) + r * LP + pc * 8) = v; }
            if (tid < 128) { const int ch = j * 128 + tid;
                PAR[0 * 128 + tid] = 8.0f * softplusf(-lam[ch]); PAR[1 * 128 + tid] = br[ch]; PAR[2 * 128 + tid] = bi[ch]; PAR[3 * 128 + tid] = cb[ch];
#pragma unroll
                for (int k = 0; k < 4; ++k) PAR[(4 + k) * 128 + tid] = cw[k * LRUW + ch]; }
        }
        for (int p = tid; p < 131 * 16; p += NTHR) { const int r = p >> 4, pc = p & 15; u32x4 v = (u32x4){0u, 0u, 0u, 0u};
            if (seg > 0 || r >= 3) v = *(const u32x4*)(PROJ + (size_t)(t0 + r - 3) * ABIN + j * 128 + pc * 8);
            *(LAS u32x4*)(XA + r * LP + pc * 8) = v; }
        if (PASSB) { if (tid < 128) { float h = 0.f; const float* sg = SEG + ((size_t)(b * 8 + j) * 32) * 256 + tid * 2;
                for (int s = 0; s < seg; ++s) { const f32x2 ab = *(const f32x2*)(sg + (size_t)s * 256); h = ab.x * h + ab.y; }
                HIN[tid] = h; } }
        WG_SYNC();
        {
            const int ch8 = tid & 15, tr = tid >> 4; u32x4 rows[7];
#pragma unroll
            for (int i = 0; i < 7; ++i) rows[i] = *(const LAS u32x4*)(XA + (4 * tr + i) * LP + ch8 * 8);
            float w[4][8], bb[8];
#pragma unroll
            for (int e = 0; e < 8; ++e) { bb[e] = PAR[3 * 128 + ch8 * 8 + e];
#pragma unroll
                for (int k = 0; k < 4; ++k) w[k][e] = PAR[(4 + k) * 128 + ch8 * 8 + e]; }
#pragma unroll
            for (int i = 0; i < 4; ++i) { float o[8];
#pragma unroll
                for (int e = 0; e < 8; ++e) { float a = bb[e];
#pragma unroll
                    for (int k = 0; k < 4; ++k) { const unsigned wd = rows[i + k][e >> 1]; a += w[k][e] * ((e & 1) ? bfhi(wd) : bflo(wd)); }
                    o[e] = a; }
                u32x4 pk; pk.x = cvt_pk_bf16(o[0], o[1]); pk.y = cvt_pk_bf16(o[2], o[3]); pk.z = cvt_pk_bf16(o[4], o[5]); pk.w = cvt_pk_bf16(o[6], o[7]);
                *(LAS u32x4*)(XC + (4 * tr + i) * LP + ch8 * 8) = pk; }
        }
        WG_SYNC();
        float PP[8][4], HH[8][4];
        {
            bf16x8 xf[4];
#pragma unroll
            for (int ks = 0; ks < 4; ++ks) xf[ks] = lds_frag(XC, 16 * wid + c16, LP, 32 * ks + 8 * q);
#pragma unroll
            for (int jb = 0; jb < 8; ++jb) {
                f32x4 aR = (f32x4){0.f, 0.f, 0.f, 0.f}, aI = aR;
#pragma unroll
                for (int ks = 0; ks < 4; ++ks) { aR = MFMA16(xf[ks], lds_frag(WR, 16 * jb + c16, LP, 32 * ks + 8 * q), aR); aI = MFMA16(xf[ks], lds_frag(WI, 16 * jb + c16, LP, 32 * ks + 8 * q), aI); }
                const int ch = 16 * jb + c16;
                const float sp8 = PAR[ch], pbr = PAR[128 + ch], pbi = PAR[256 + ch], pcb = PAR[384 + ch], w0 = PAR[512 + ch], w1 = PAR[640 + ch], w2 = PAR[768 + ch], w3 = PAR[896 + ch];
                float xr[7];
#pragma unroll
                for (int i = 0; i < 7; ++i) xr[i] = bf2f(XA[(16 * wid + 4 * q + i) * LP + ch]);
                float a[4], bt[4];
#pragma unroll
                for (int r = 0; r < 4; ++r) { const float xc = pcb + w0 * xr[r] + w1 * xr[r + 1] + w2 * xr[r + 2] + w3 * xr[r + 3];
                    const float rg = sigm(aR[r] + pbr), ig = sigm(aI[r] + pbi); const float la = -sp8 * rg;
                    const float av = __expf(la), x2 = 2.0f * la; a[r] = av;
                    const float om = (x2 > -0.02f) ? -x2 * (1.0f + x2 * (0.5f + x2 * 0.16666667f)) : 1.0f - av * av;
                    bt[r] = __builtin_amdgcn_sqrtf(fmaxf(om, 0.f)) * ig * xc; }
                float P[4], H[4]; P[0] = a[0]; H[0] = bt[0];
#pragma unroll
                for (int r = 1; r < 4; ++r) { P[r] = a[r] * P[r - 1]; H[r] = a[r] * H[r - 1] + bt[r]; }
                float Ae = 1.f, Be = 0.f, Aw = 1.f, Bw = 0.f;
#pragma unroll
                for (int qq = 0; qq < 4; ++qq) { const float Aq = __shfl(P[3], c16 + 16 * qq), Bq = __shfl(H[3], c16 + 16 * qq);
                    if (qq < q) { Be = Aq * Be + Bq; Ae = Aq * Ae; }
                    Bw = Aq * Bw + Bq; Aw = Aq * Aw; }
#pragma unroll
                for (int r = 0; r < 4; ++r) { PP[jb][r] = P[r] * Ae; HH[jb][r] = P[r] * Be + H[r]; }
                if (q == 0) *(LAS f32x2*)(WT + (wid * 128 + ch) * 2) = (f32x2){Aw, Bw};
            }
        }
        WG_SYNC();
        if (!PASSB) {
            if (tid < 128) { float A = 1.f, B = 0.f;
#pragma unroll
                for (int w = 0; w < 8; ++w) { const f32x2 ab = *(const LAS f32x2*)(WT + (w * 128 + tid) * 2); B = ab.x * B + ab.y; A = ab.x * A; }
                *(f32x2*)(SEG + ((size_t)(b * 8 + j) * 32 + seg) * 256 + tid * 2) = (f32x2){A, B}; }
        } else {
#pragma unroll
            for (int jb = 0; jb < 8; ++jb) { const int ch = 16 * jb + c16; float h0 = HIN[ch];
                for (int w = 0; w < wid; ++w) { const f32x2 ab = *(const LAS f32x2*)(WT + (w * 128 + ch) * 2); h0 = ab.x * h0 + ab.y; }
#pragma unroll
                for (int r = 0; r < 4; ++r) { const int t = t0 + 16 * wid + 4 * q + r; const float h = PP[jb][r] * h0 + HH[jb][r];
                    const float ga = bf2f(PROJ[(size_t)t * ABIN + 1024 + j * 128 + ch]);
                    YAB[(size_t)t * D + j * 128 + ch] = (bf16)f2bf(ga * h); } }
        }
        WG_SYNC();
    }
}

__device__ __forceinline__ void hgrn1_load(float (&lf)[16], unsigned (&vv)[16], const float* LOGF, const bf16* PROJ, int u, int k, int qt) {
    const int bh = u >> 6, c = u & 63, b = bh >> 3, h = bh & 7; const int t0 = b * SEQ + c * 64 + 16 * qt;
#pragma unroll
    for (int i = 0; i < 16; ++i) { lf[i] = LOGF[(size_t)(t0 + i) * 1024 + h * 128 + k]; vv[i] = PROJ[(size_t)(t0 + i) * ABIN + 4096 + h * 128 + k]; }
}
__device__ __forceinline__ void hgrn1_units(const int tid, LAS unsigned char* lds, int G, int cu, const float* LOGF, const bf16* PROJ, bf16* HST, float* HDEC) {
    const int wid = __builtin_amdgcn_readfirstlane(tid >> 6), lane = tid & 63, q = lane >> 4, c16 = lane & 15;
    LAS bf16* KT = (LAS bf16*)(lds);
    LAS bf16* VT = (LAS bf16*)(lds + 18432);
    LAS float* TOT = (LAS float*)(lds + 36864);
    const int k = tid & 127, qt = tid >> 7;
    float lf[16], nlf[16]; unsigned vv[16], nvv[16];
    if (cu < 2048) hgrn1_load(lf, vv, LOGF, PROJ, cu, k, qt);
    for (int u = cu; u < 2048; u += G) {
        if (u + G < 2048) hgrn1_load(nlf, nvv, LOGF, PROJ, u + G, k, qt);
        float cs[16];
        cs[0] = lf[0];
#pragma unroll
        for (int i = 1; i < 16; ++i) cs[i] = cs[i - 1] + lf[i];
        TOT[qt * 128 + k] = cs[15];
        LDS_SYNC();
        float pre = 0.f, last = 0.f;
#pragma unroll
        for (int qq = 0; qq < 4; ++qq) { const float t = TOT[qq * 128 + k]; if (qq < qt) pre += t; last += t; }
        unsigned kw[8], vw[8];
#pragma unroll
        for (int i = 0; i < 8; ++i) { const float k0 = (1.f - __expf(lf[2 * i])) * __expf(last - (pre + cs[2 * i])), k1 = (1.f - __expf(lf[2 * i + 1])) * __expf(last - (pre + cs[2 * i + 1]));
            kw[i] = cvt_pk_bf16(k0, k1); vw[i] = vv[2 * i] | (vv[2 * i + 1] << 16); }
        *(LAS u32x4*)(KT + k * LP64 + 16 * qt) = (u32x4){kw[0], kw[1], kw[2], kw[3]}; *(LAS u32x4*)(KT + k * LP64 + 16 * qt + 8) = (u32x4){kw[4], kw[5], kw[6], kw[7]};
        *(LAS u32x4*)(VT + k * LP64 + 16 * qt) = (u32x4){vw[0], vw[1], vw[2], vw[3]}; *(LAS u32x4*)(VT + k * LP64 + 16 * qt + 8) = (u32x4){vw[4], vw[5], vw[6], vw[7]};
        if (qt == 0) HDEC[(size_t)u * 128 + k] = __expf(last);
        LDS_SYNC();
        bf16x8 kf[2];
#pragma unroll
        for (int ks = 0; ks < 2; ++ks) kf[ks] = lds_frag(KT, 16 * wid + c16, LP64, 32 * ks + 8 * q);
#pragma unroll
        for (int vb = 0; vb < 8; ++vb) { f32x4 acc = (f32x4){0.f, 0.f, 0.f, 0.f};
#pragma unroll
            for (int ks = 0; ks < 2; ++ks) acc = MFMA16(kf[ks], lds_frag(VT, 16 * vb + c16, LP64, 32 * ks + 8 * q), acc);
            *(u32x2*)(HST + ((size_t)u * 128 + 16 * vb + c16) * 128 + 16 * wid + 4 * q) = pack4(acc); }
        LDS_SYNC();
#pragma unroll
        for (int i = 0; i < 16; ++i) { lf[i] = nlf[i]; vv[i] = nvv[i]; }
    }
    WG_SYNC();
}
__device__ __forceinline__ void hgrn2_scan(const int tid, int G, int cu, bf16* HST, const float* HDEC) {
    for (int task = cu * NTHR + tid; task < 32 * 4096; task += G * NTHR) {
        const int bh = task >> 12, e = (task & 4095) * 4; f32x4 S = (f32x4){0.f, 0.f, 0.f, 0.f};
        bf16* p0 = HST + (size_t)bh * 64 * 16384 + e; const float* d0 = HDEC + (size_t)bh * 64 * 128 + (e & 127);
#pragma unroll 1
        for (int cb = 0; cb < 64; cb += 16) { u32x2 L[16]; f32x4 d[16];
#pragma unroll
            for (int c = 0; c < 16; ++c) { L[c] = *(const u32x2*)(p0 + (size_t)(cb + c) * 16384); d[c] = *(const f32x4*)(d0 + (size_t)(cb + c) * 128); }
#pragma unroll
            for (int c = 0; c < 16; ++c) { *(u32x2*)(p0 + (size_t)(cb + c) * 16384) = pack4(S);
                S[0] = d[c][0] * S[0] + bflo(L[c].x); S[1] = d[c][1] * S[1] + bfhi(L[c].x); S[2] = d[c][2] * S[2] + bflo(L[c].y); S[3] = d[c][3] * S[3] + bfhi(L[c].y); } }
    }
}
__device__ __forceinline__ void hgrn3_load(float (&lf)[16], unsigned (&qv)[16], unsigned (&vv)[16], u32x4 (&st)[4], const float* LOGF, const bf16* PROJ, const bf16* HST, int u, int k, int qt, int tid) {
    const int bh = u >> 6, c = u & 63, b = bh >> 3, h = bh & 7; const int t0 = b * SEQ + c * 64 + 16 * qt;
#pragma unroll
    for (int i = 0; i < 16; ++i) { lf[i] = LOGF[(size_t)(t0 + i) * 1024 + h * 128 + k]; const bf16* pr = PROJ + (size_t)(t0 + i) * ABIN + h * 128 + k; qv[i] = pr[2048]; vv[i] = pr[4096]; }
#pragma unroll
    for (int i = 0; i < 4; ++i) { const int p = tid + NTHR * i, r = p >> 4, pc = p & 15; st[i] = *(const u32x4*)(HST + (size_t)u * 16384 + r * 128 + pc * 8); }
}
__device__ __forceinline__ void hgrn3_units(const int tid, LAS unsigned char* lds, int G, int cu, const float* LOGF, const bf16* PROJ, const bf16* HST, const float* hnorm, bf16* YAB) {
    const int wid = __builtin_amdgcn_readfirstlane(tid >> 6), lane = tid & 63, q = lane >> 4, c16 = lane & 15;
    LAS bf16* QH = (LAS bf16*)(lds);
    LAS bf16* QT = (LAS bf16*)(lds + 17408);
    LAS bf16* KH = (LAS bf16*)(lds + 34816);
    LAS bf16* VT = (LAS bf16*)(lds + 52224);
    LAS bf16* STL = (LAS bf16*)(lds + 70656);
    LAS bf16* PM = (LAS bf16*)(lds + 105472);
    LAS float* TOT = (LAS float*)(lds + 114688);
    LAS float* SQ = (LAS float*)(lds + 116736);
    const int k = tid & 127, qt = tid >> 7;
    float lf[16], nlf[16]; unsigned qv[16], nqv[16], vv[16], nvv[16]; u32x4 st[4], nst[4];
    if (cu < 2048) hgrn3_load(lf, qv, vv, st, LOGF, PROJ, HST, cu, k, qt, tid);
    for (int u = cu; u < 2048; u += G) {
        const int bh = u >> 6, c = u & 63, b = bh >> 3, h = bh & 7; const int tc = b * SEQ + c * 64;
        float cs[16];
        cs[0] = lf[0];
#pragma unroll
        for (int i = 1; i < 16; ++i) cs[i] = cs[i - 1] + lf[i];
        TOT[qt * 128 + k] = cs[15];
#pragma unroll
        for (int i = 0; i < 4; ++i) { const int p = tid + NTHR * i, r = p >> 4, pc = p & 15; *(LAS u32x4*)(STL + r * LP + pc * 8) = st[i]; }
        if (u + G < 2048) hgrn3_load(nlf, nqv, nvv, nst, LOGF, PROJ, HST, u + G, k, qt, tid);
        LDS_SYNC();
        float pre = 0.f;
#pragma unroll
        for (int qq = 0; qq < 4; ++qq) { const float t = TOT[qq * 128 + k]; if (qq < qt) pre += t; }
        const float ref = TOT[k] + TOT[128 + k];
        unsigned vw[8];
#pragma unroll
        for (int i = 0; i < 16; ++i) { const float cum = pre + cs[i], kk = 1.f - __expf(lf[i]), qf = bf2f((bf16)qv[i]);
            QT[(16 * qt + i) * LP + k] = (bf16)f2bf(qf * __expf(cum));
            QH[(16 * qt + i) * LP + k] = (bf16)f2bf(qf * __expf(fminf(cum - ref, 80.f)));
            KH[(16 * qt + i) * LP + k] = (bf16)f2bf(kk * __expf(fminf(ref - cum, 80.f))); }
#pragma unroll
        for (int i = 0; i < 8; ++i) vw[i] = vv[2 * i] | (vv[2 * i + 1] << 16);
        *(LAS u32x4*)(VT + k * LP64 + 16 * qt) = (u32x4){vw[0], vw[1], vw[2], vw[3]}; *(LAS u32x4*)(VT + k * LP64 + 16 * qt + 8) = (u32x4){vw[4], vw[5], vw[6], vw[7]};
        LDS_SYNC();
        {
            const int tb = wid & 3;
            bf16x8 qf[4];
#pragma unroll
            for (int ks = 0; ks < 4; ++ks) qf[ks] = lds_frag(QH, 16 * tb + c16, LP, 32 * ks + 8 * q);
#pragma unroll
            for (int sbi = 0; sbi < 2; ++sbi) { const int sb = 2 * (wid >> 2) + sbi; f32x4 acc = (f32x4){0.f, 0.f, 0.f, 0.f};
#pragma unroll
                for (int ks = 0; ks < 4; ++ks) acc = MFMA16(lds_frag(KH, 16 * sb + c16, LP, 32 * ks + 8 * q), qf[ks], acc);
                const int t = 16 * tb + c16, s0 = 16 * sb + 4 * q;
#pragma unroll
                for (int r = 0; r < 4; ++r) acc[r] = (s0 + r <= t) ? acc[r] : 0.f;
                *(LAS u32x2*)(PM + t * LP64 + s0) = pack4(acc); }
        }
        LDS_SYNC();
        {
            const int tb = wid & 3, vh = wid >> 2, t = 16 * tb + c16;
            bf16x8 qf[4], pf[2];
#pragma unroll
            for (int ks = 0; ks < 4; ++ks) qf[ks] = lds_frag(QT, t, LP, 32 * ks + 8 * q);
#pragma unroll
            for (int ks = 0; ks < 2; ++ks) pf[ks] = lds_frag(PM, t, LP64, 32 * ks + 8 * q);
            f32x4 acc[4]; float sq = 0.f;
#pragma unroll
            for (int vb = 0; vb < 4; ++vb) { const int vr = 64 * vh + 16 * vb + c16; acc[vb] = (f32x4){0.f, 0.f, 0.f, 0.f};
#pragma unroll
                for (int ks = 0; ks < 4; ++ks) acc[vb] = MFMA16(lds_frag(STL, vr, LP, 32 * ks + 8 * q), qf[ks], acc[vb]);
#pragma unroll
                for (int ks = 0; ks < 2; ++ks) acc[vb] = MFMA16(lds_frag(VT, vr, LP64, 32 * ks + 8 * q), pf[ks], acc[vb]);
                sq += (acc[vb][0] * acc[vb][0] + acc[vb][1] * acc[vb][1]) + (acc[vb][2] * acc[vb][2] + acc[vb][3] * acc[vb][3]); }
            sq += __shfl_xor(sq, 16); sq += __shfl_xor(sq, 32);
            if (q == 0) SQ[vh * 64 + t] = sq;
            LDS_SYNC();
            const float rstd = rsqrtf((SQ[t] + SQ[64 + t]) * (1.0f / 128.f) + EPS);
#pragma unroll
            for (int vb = 0; vb < 4; ++vb) { const int v0 = 64 * vh + 16 * vb + 4 * q; const f32x4 hn = *(const f32x4*)(hnorm + h * 128 + v0);
                const u32x2 gw = *(const u32x2*)(PROJ + (size_t)(tc + t) * ABIN + 5120 + h * 128 + v0);
                f32x4 y; y[0] = acc[vb][0] * rstd * hn[0] * bflo(gw.x); y[1] = acc[vb][1] * rstd * hn[1] * bfhi(gw.x); y[2] = acc[vb][2] * rstd * hn[2] * bflo(gw.y); y[3] = acc[vb][3] * rstd * hn[3] * bfhi(gw.y);
                *(u32x2*)(YAB + (size_t)(tc + t) * D + 1024 + h * 128 + v0) = pack4(y); }
        }
        LDS_SYNC();
#pragma unroll
        for (int i = 0; i < 16; ++i) { lf[i] = nlf[i]; qv[i] = nqv[i]; vv[i] = nvv[i]; }
#pragma unroll
        for (int i = 0; i < 4; ++i) st[i] = nst[i];
    }
    WG_SYNC();
}
__device__ __forceinline__ void ssd_prep_load(u32x4 (&rows)[7], const bf16* XBC, int u, int ch8, int tr) {
    const int bc = u / 48, cblk = u % 48, c = bc & 31; const bf16* src = XBC + (size_t)(bc * 128 + 4 * tr - 3) * SSDCONV + cblk * 128 + ch8 * 8;
#pragma unroll
    for (int i = 0; i < 7; ++i) { rows[i] = (u32x4){0u, 0u, 0u, 0u}; if (c > 0 || 4 * tr + i >= 3) rows[i] = *(const u32x4*)(src + (size_t)i * SSDCONV); }
}
__device__ __forceinline__ void ssd_prep_units(const int tid, LAS unsigned char* lds, int ufirst, int ustride, int uend, const bf16* XBC, const float* cw, const float* cb, bf16* XBT, bf16* BCN) {
    LAS bf16* T = (LAS bf16*)(lds);
    const int ch8 = tid & 15, tr = tid >> 4;
    u32x4 rows[7], nrows[7];
    if (ufirst < uend) ssd_prep_load(rows, XBC, ufirst, ch8, tr);
    for (int u = ufirst; u < uend; u += ustride) {
        const int bc = u / 48, cblk = u % 48; const int t0 = bc * 128; const int ch0 = cblk * 128 + ch8 * 8;
        if (u + ustride < uend) ssd_prep_load(nrows, XBC, u + ustride, ch8, tr);
        float w[4][8], bb[8];
        { const f32x4 b0 = *(const f32x4*)(cb + ch0), b1 = *(const f32x4*)(cb + ch0 + 4);
#pragma unroll
          for (int e = 0; e < 4; ++e) { bb[e] = b0[e]; bb[4 + e] = b1[e]; }
#pragma unroll
          for (int k = 0; k < 4; ++k) { const f32x4 w0 = *(const f32x4*)(cw + (size_t)k * SSDCONV + ch0), w1 = *(const f32x4*)(cw + (size_t)k * SSDCONV + ch0 + 4);
#pragma unroll
              for (int e = 0; e < 4; ++e) { w[k][e] = w0[e]; w[k][4 + e] = w1[e]; } } }
        u32x4 ov[4];
#pragma unroll
        for (int i = 0; i < 4; ++i) { float o[8];
#pragma unroll
            for (int e = 0; e < 8; ++e) { float a = bb[e];
#pragma unroll
                for (int k = 0; k < 4; ++k) { const unsigned wd = rows[i + k][e >> 1]; a += w[k][e] * ((e & 1) ? bfhi(wd) : bflo(wd)); }
                o[e] = siluf(a); }
            u32x4 pk; pk.x = cvt_pk_bf16(o[0], o[1]); pk.y = cvt_pk_bf16(o[2], o[3]); pk.z = cvt_pk_bf16(o[4], o[5]); pk.w = cvt_pk_bf16(o[6], o[7]);
            if (cblk >= 32) *(u32x4*)(BCN + (size_t)(t0 + 4 * tr + i) * 2048 + (ch0 - 4096)) = pk;
            ov[i] = pk; }
        if (cblk < 40) {
#pragma unroll
            for (int e = 0; e < 8; ++e) { u32x2 w;
                const unsigned a0 = ov[0][e >> 1], a1 = ov[1][e >> 1], a2 = ov[2][e >> 1], a3 = ov[3][e >> 1];
                if (e & 1) { w.x = (a0 >> 16) | (a1 & 0xffff0000u); w.y = (a2 >> 16) | (a3 & 0xffff0000u); } else { w.x = (a0 & 0xffffu) | (a1 << 16); w.y = (a2 & 0xffffu) | (a3 << 16); }
                *(LAS u32x2*)(T + (ch8 * 8 + e) * LP + 8 * ((tr >> 1) ^ ch8) + 4 * (tr & 1)) = w; }
            LDS_SYNC();
#pragma unroll
            for (int i = 0; i < 4; ++i) { const int p = tid + NTHR * i, r = p >> 4, pc = p & 15;
                *(u32x4*)(XBT + ((size_t)bc * 5120 + cblk * 128 + r) * 128 + pc * 8) = *(const LAS u32x4*)(T + r * LP + 8 * (pc ^ (r >> 3))); }
            LDS_SYNC();
        }
#pragma unroll
        for (int i = 0; i < 7; ++i) rows[i] = nrows[i];
    }
    WG_SYNC();
}
__device__ __forceinline__ float ssd_tables(const float* DT, const float* a_log, int t0, int hd, int wid, int lane, LAS float* CUM, LAS float* DTS) {
    const float an = -__expf(a_log[hd]);
    const float d0 = DT[(size_t)(t0 + 2 * lane) * 64 + hd], d1 = DT[(size_t)(t0 + 2 * lane + 1) * 64 + hd];
    const float a0 = d0 * an, a1 = d1 * an; float v = a0 + a1;
#pragma unroll
    for (int o = 1; o < 64; o <<= 1) { const float t = __shfl_up(v, o); if (lane >= o) v += t; }
    CUM[wid * 128 + 2 * lane] = v - a1; CUM[wid * 128 + 2 * lane + 1] = v; DTS[wid * 128 + 2 * lane] = d0; DTS[wid * 128 + 2 * lane + 1] = d1;
    return __shfl(v, 63);
}
__device__ __forceinline__ void ssd1_units(const int tid, LAS unsigned char* lds, int G, int cu, const bf16* XBT, const float* DT, const float* a_log, bf16* ST, float* DEC) {
    const int wid = __builtin_amdgcn_readfirstlane(tid >> 6), lane = tid & 63, q = lane >> 4, c16 = lane & 15;
    LAS bf16* BT = (LAS bf16*)(lds);
    LAS float* CUM = (LAS float*)(lds + 34816);
    LAS float* DTS = (LAS float*)(lds + 38912);
    for (int u = cu; u < 1024; u += G) {
        const int bc = u >> 3, g = u & 7, t0 = bc * 128, hd = g * 8 + wid;
#pragma unroll
        for (int i = 0; i < 4; ++i) { const int p = tid + NTHR * i, r = p >> 4, pc = p & 15;
            *(LAS u32x4*)(BT + r * LP + pc * 8) = *(const u32x4*)(XBT + ((size_t)bc * 5120 + 4096 + g * 128 + r) * 128 + pc * 8); }
        const float last = ssd_tables(DT, a_log, t0, hd, wid, lane, CUM, DTS);
        if (lane == 0) DEC[bc * 64 + hd] = __expf(last);
        u32x4 xr[4][4];
#pragma unroll
        for (int pb = 0; pb < 4; ++pb)
#pragma unroll
            for (int ks = 0; ks < 4; ++ks) xr[pb][ks] = *(const u32x4*)(XBT + ((size_t)bc * 5120 + hd * 64 + 16 * pb + c16) * 128 + 32 * ks + 8 * q);
        WG_SYNC();
        bf16x8 xf[4][4];
#pragma unroll
        for (int ks = 0; ks < 4; ++ks) { float sc[8];
#pragma unroll
            for (int j = 0; j < 8; ++j) { const int s = 32 * ks + 8 * q + j; sc[j] = DTS[wid * 128 + s] * __expf(last - CUM[wid * 128 + s]); }
#pragma unroll
            for (int pb = 0; pb < 4; ++pb) { u32x4 o;
#pragma unroll
                for (int e = 0; e < 4; ++e) o[e] = cvt_pk_bf16(bflo(xr[pb][ks][e]) * sc[2 * e], bfhi(xr[pb][ks][e]) * sc[2 * e + 1]);
                xf[pb][ks] = __builtin_bit_cast(bf16x8, o); } }
#pragma unroll
        for (int nb = 0; nb < 8; ++nb) { bf16x8 bf[4];
#pragma unroll
            for (int ks = 0; ks < 4; ++ks) bf[ks] = lds_frag(BT, 16 * nb + c16, LP, 32 * ks + 8 * q);
#pragma unroll
            for (int pb = 0; pb < 4; ++pb) { f32x4 acc = (f32x4){0.f, 0.f, 0.f, 0.f};
#pragma unroll
                for (int ks = 0; ks < 4; ++ks) acc = MFMA16(bf[ks], xf[pb][ks], acc);
                *(u32x2*)(ST + (((size_t)bc * 64 + hd) * 64 + 16 * pb + c16) * 128 + 16 * nb + 4 * q) = pack4(acc); } }
        WG_SYNC();
    }
}
__device__ __forceinline__ void ssd2_scan(const int tid, int G, int cu, bf16* ST, const float* DEC) {
    for (int task = cu * NTHR + tid; task < NB * 4096 * 32; task += G * NTHR) {
        const int b = task >> 17, r = task & 131071, hp = r >> 5, n4 = (r & 31) * 4, hd = hp >> 6; f32x4 S = (f32x4){0.f, 0.f, 0.f, 0.f};
        bf16* p0 = ST + ((size_t)(b * 32) * 4096 + hp) * 128 + n4; const float* d0 = DEC + (b * 32) * 64 + hd;
        u32x2 L[32]; float d[32];
#pragma unroll
        for (int c = 0; c < 32; ++c) { L[c] = *(const u32x2*)(p0 + (size_t)c * 4096 * 128); d[c] = d0[c * 64]; }
#pragma unroll
        for (int c = 0; c < 32; ++c) { *(u32x2*)(p0 + (size_t)c * 4096 * 128) = pack4(S);
            S[0] = d[c] * S[0] + bflo(L[c].x); S[1] = d[c] * S[1] + bfhi(L[c].x); S[2] = d[c] * S[2] + bflo(L[c].y); S[3] = d[c] * S[3] + bfhi(L[c].y); }
    }
}
__device__ __forceinline__ void ssd3_units(const int tid, LAS unsigned char* lds, int G, int cu, const bf16* XBT, const bf16* BCN, const bf16* ST, const float* DT, const float* a_log, const float* dskip,
                                           const bf16* Z, const float* normw, bf16* Y) {
    const int wid = __builtin_amdgcn_readfirstlane(tid >> 6), lane = tid & 63, q = lane >> 4, c16 = lane & 15;
    LAS bf16* CN = (LAS bf16*)(lds);
    LAS bf16* BN = (LAS bf16*)(lds + 34816);
    LAS bf16* CB = (LAS bf16*)(lds + 69632);
    LAS float* CUM = (LAS float*)(lds + 104448);
    LAS float* DTS = (LAS float*)(lds + 108544);
    LAS float* SQP = (LAS float*)(lds + 112640);
    for (int u = cu; u < 1024; u += G) {
        const int bc = u >> 3, g = u & 7, t0 = bc * 128, hd = g * 8 + wid;
#pragma unroll
        for (int i = 0; i < 4; ++i) { const int p = tid + NTHR * i, r = p >> 4, pc = p & 15; const bf16* src = BCN + (size_t)(t0 + r) * 2048 + g * 128 + pc * 8;
            *(LAS u32x4*)(BN + r * LP + pc * 8) = *(const u32x4*)src; *(LAS u32x4*)(CN + r * LP + pc * 8) = *(const u32x4*)(src + 1024); }
        (void)ssd_tables(DT, a_log, t0, hd, wid, lane, CUM, DTS);
        bf16x8 sf[4][4];
        const bf16* xb = XBT + ((size_t)bc * 5120 + hd * 64 + c16) * 128 + 8 * q;
        { const bf16* sb = ST + (((size_t)bc * 64 + hd) * 64 + c16) * 128 + 8 * q;
#pragma unroll
          for (int pb = 0; pb < 4; ++pb)
#pragma unroll
              for (int ks = 0; ks < 4; ++ks) sf[pb][ks] = *(const bf16x8*)(sb + (size_t)(16 * pb) * 128 + 32 * ks); }
        WG_SYNC();
        {
            bf16x8 cf[4];
#pragma unroll
            for (int ks = 0; ks < 4; ++ks) cf[ks] = lds_frag(CN, 16 * wid + c16, LP, 32 * ks + 8 * q);
#pragma unroll
            for (int sb = 0; sb < 8; ++sb) { if (sb > wid + 1) continue; f32x4 acc = (f32x4){0.f, 0.f, 0.f, 0.f};
#pragma unroll
                for (int ks = 0; ks < 4; ++ks) acc = MFMA16(lds_frag(BN, 16 * sb + c16, LP, 32 * ks + 8 * q), cf[ks], acc);
                *(LAS u32x2*)(CB + (16 * wid + c16) * LP + 16 * sb + 4 * q) = pack4(acc); }
        }
        WG_SYNC();
        const float dsk = dskip[hd];
        bf16* ybase = Y + (size_t)t0 * SSDIN + hd * 64 + 4 * q; const bf16* zbase = Z + (size_t)t0 * SSDIN + hd * 64 + 4 * q;
        const f32x4 nw0 = *(const f32x4*)(normw + hd * 64 + 4 * q), nw1 = *(const f32x4*)(normw + hd * 64 + 16 + 4 * q), nw2 = *(const f32x4*)(normw + hd * 64 + 32 + 4 * q), nw3 = *(const f32x4*)(normw + hd * 64 + 48 + 4 * q);
#pragma unroll 1
        for (int tp = 0; tp < 8; ++tp) {
        u32x2 yk[1][4];
#pragma unroll
        for (int tt = 0; tt < 1; ++tt) { const int tb = tp;
            const int tl = 16 * tb + c16; const float cumt = CUM[wid * 128 + tl], ect = __expf(cumt);
            f32x4 acc[4];
            { bf16x8 cf[4];
#pragma unroll
              for (int ks = 0; ks < 4; ++ks) cf[ks] = lds_frag(CN, tl, LP, 32 * ks + 8 * q);
#pragma unroll
              for (int pb = 0; pb < 4; ++pb) { acc[pb] = (f32x4){0.f, 0.f, 0.f, 0.f};
#pragma unroll
                  for (int ks = 0; ks < 4; ++ks) acc[pb] = MFMA16(sf[pb][ks], cf[ks], acc[pb]);
                  acc[pb] = acc[pb] * ect; } }
#pragma unroll
            for (int ks = 0; ks < 4; ++ks) { if (32 * ks > 16 * tb + 15) continue;
                const int s0 = 32 * ks + 8 * q; const u32x4 cbw = *(const LAS u32x4*)(CB + tl * LP + s0);
                const f32x4 c0 = *(const LAS f32x4*)(CUM + wid * 128 + s0), c1 = *(const LAS f32x4*)(CUM + wid * 128 + s0 + 4), d0 = *(const LAS f32x4*)(DTS + wid * 128 + s0), d1 = *(const LAS f32x4*)(DTS + wid * 128 + s0 + 4);
                float gv[8];
#pragma unroll
                for (int j = 0; j < 8; ++j) { const int s = s0 + j; const float cb = (j & 1) ? bfhi(cbw[j >> 1]) : bflo(cbw[j >> 1]); const float cs = j < 4 ? c0[j & 3] : c1[j & 3], ds = j < 4 ? d0[j & 3] : d1[j & 3];
                    float v = cb * __expf(fminf(cumt - cs, 0.f)) * ds; v = (s <= tl) ? v : 0.f; gv[j] = (s == tl) ? v + dsk : v; }
                u32x4 gw; gw.x = cvt_pk_bf16(gv[0], gv[1]); gw.y = cvt_pk_bf16(gv[2], gv[3]); gw.z = cvt_pk_bf16(gv[4], gv[5]); gw.w = cvt_pk_bf16(gv[6], gv[7]);
                const bf16x8 gf = __builtin_bit_cast(bf16x8, gw);
#pragma unroll
                for (int pb = 0; pb < 4; ++pb) acc[pb] = MFMA16(*(const bf16x8*)(xb + (size_t)(16 * pb) * 128 + 32 * ks), gf, acc[pb]);
            }
            float sq = 0.f;
#pragma unroll
            for (int pb = 0; pb < 4; ++pb) { const u32x2 zw = *(const u32x2*)(zbase + (size_t)tl * SSDIN + 16 * pb);
                f32x4 y; y[0] = acc[pb][0] * bflo(zw.x); y[1] = acc[pb][1] * bfhi(zw.x); y[2] = acc[pb][2] * bflo(zw.y); y[3] = acc[pb][3] * bfhi(zw.y);
                sq += (y[0] * y[0] + y[1] * y[1]) + (y[2] * y[2] + y[3] * y[3]); yk[tt][pb] = pack4(y); }
            sq += __shfl_xor(sq, 16); sq += __shfl_xor(sq, 32);
            if (q == 0) SQP[tl * 8 + wid] = sq;
        }
        WG_SYNC();
#pragma unroll
        for (int tt = 0; tt < 1; ++tt) { const int tl = 16 * tp + c16; const f32x4 s0 = *(const LAS f32x4*)(SQP + tl * 8), s1 = *(const LAS f32x4*)(SQP + tl * 8 + 4);
            const float rstd = rsqrtf((((s0[0] + s0[1]) + (s0[2] + s0[3])) + ((s1[0] + s1[1]) + (s1[2] + s1[3]))) * (1.0f / 512.f) + EPS);
#pragma unroll
            for (int pb = 0; pb < 4; ++pb) { bf16* yp = ybase + (size_t)tl * SSDIN + 16 * pb; const u32x2 w = yk[tt][pb]; const f32x4 nw = pb == 0 ? nw0 : pb == 1 ? nw1 : pb == 2 ? nw2 : nw3;
                f32x4 y; y[0] = bflo(w.x) * rstd * nw[0]; y[1] = bfhi(w.x) * rstd * nw[1]; y[2] = bflo(w.y) * rstd * nw[2]; y[3] = bfhi(w.y) * rstd * nw[3];
                *(u32x2*)yp = pack4(y); } }
        }
        WG_SYNC();
    }
}
#ifndef REP_GEMM
#define REP_GEMM 1
#endif
#if REP_GEMM == 2
#define GEMM_REP(...) { __VA_ARGS__ } { __VA_ARGS__ }
#else
#define GEMM_REP(...) { __VA_ARGS__ }
#endif
#ifndef REP_MIX
#define REP_MIX 1
#endif
#ifndef REP_CONV
#define REP_CONV 1
#endif
struct Args { In in; float* out; unsigned char* ws; int ph_lo, ph_hi; };
static_assert(sizeof(Args) == 32 * 8 + 8 + 8 + 8, "Args has no padding");
typedef const Args __attribute__((address_space(4))) CArgs;

#ifndef SLEEP_MASK
#define SLEEP_MASK 0ull
#endif
#define SLEEP_AMP 4
#define PHASE_BEGIN if (pc >= lo && pc < hi) { const unsigned long long t0_ = SLEEP_MASK ? __builtin_amdgcn_s_memrealtime() : 0ull; (void)t0_; int tid = wave0 * 64 + (int)__builtin_amdgcn_mbcnt_hi(~0u, __builtin_amdgcn_mbcnt_lo(~0u, 0u)); asm volatile("" : "+v"(tid)); int cu = blockIdx.x; asm volatile("" : "+s"(cu)); int G = gridDim.x; asm volatile("" : "+s"(G)); \
        const int lane = tid & 63, wave = __builtin_amdgcn_readfirstlane(tid >> 6), gw = cu * NWAVES + wave, NGW = G * NWAVES; (void)lane; (void)gw; (void)NGW; \
        CArgs* ap = (CArgs*)__builtin_amdgcn_kernarg_segment_ptr(); asm volatile("" : "+s"(ap)); CIn& I = ap->in; unsigned char* const ws = ap->ws; float* const xres = ap->out; \
        unsigned char* const act = ws + WS_ACT; float* const SS = (float*)(ws + WS_SS); bf16* const XB = (bf16*)(ws + WS_XB); bf16* const WL = (bf16*)(ws + WS_WL); (void)I; (void)xres; (void)act; (void)SS; (void)XB; (void)WL;
#if MK_SPLIT
#define PHASE_END } ++pc;
#else
#define PHASE_END if (pc + 1 < hi) xcd_barrier(bar); if (SLEEP_MASK && ((SLEEP_MASK >> pc) & 1ull)) { const unsigned long long t1_ = __builtin_amdgcn_s_memrealtime(), until_ = t1_ + SLEEP_AMP * (t1_ - t0_); while (__builtin_amdgcn_s_memrealtime() < until_) __builtin_amdgcn_s_sleep(8); } } ++pc;
#endif
#define PHASE_END_LOCAL } ++pc;
#define D_WKV ((bf16*)(ws + WS_WKV))
#define D_KMAT ((bf16*)(ws + WS_KMAT))
#define D_VT ((bf16*)(ws + WS_VT))
#define D_MEMN ((bf16*)(ws + WS_MEMN))
#define D_LB ((float*)(ws + WS_TAB + TAB_LB))
#define D_WRT ((bf16*)(ws + WS_TAB + TAB_WRT))


template <int l>
__device__ __forceinline__ void layer_body(LAS unsigned char* lds, const int wave0, const int lo, const int hi, int& pc, const XcdBarrier& bar) {
    int ssi = 3 * l;

        if (l > 0) {
            PHASE_BEGIN
                int rot = 0; for (int rep_ = 0; rep_ < REP_CONV; ++rep_) { convert_layer(I, l, WL, (LAS float*)(lds + wave * 16640), gw, NGW, lane, rot); }
            PHASE_END
        }
        const int e = l >> 1;
        int mixK;
        if ((l & 1) == 0) {
#define PROJ ((bf16*)(act + A_PROJ))
#define LOGF ((float*)(act + A_LOGF))
#define HST ((bf16*)(act + A_HST))
#define YAB ((bf16*)(act + A_YAB))
#define SEG ((float*)(act + A_SEG))
#define HDEC ((float*)(act + A_HDEC))
            PHASE_BEGIN
                if (l == 0) { pg8::SchedKV S{(const char*)D_MEMN, (const char*)D_WKV, G, cu}; pg8::EpiKV E{D_KMAT, D_VT}; pg8::gemm_phase(tid, lds, D, D, D, S, E); asm volatile("" : "+v"(tid)); }
                GEMM_REP(pg8::SchedMN S; S.init(XB, D, WL + WL_IN, D, M, ABIN, G, cu); pg8::EpiProjEven E{SS + (size_t)ssi * M * 8, PROJ, LOGF, D_LB + e * 1024};
                pg8::gemm_phase<RF16>(tid, lds, D, D, D, S, E);)
            PHASE_END
            PHASE_BEGIN
                for (int rep_ = 0; rep_ < REP_MIX; ++rep_) { lru_units<false>(tid, lds, G, cu, PROJ, D_WRT + (size_t)e * 2 * 8 * 16384, I.lru_conv_w + e * 4 * LRUW, I.lru_conv_b + e * LRUW, I.lru_b_r + e * LRUW, I.lru_b_i + e * LRUW, I.lru_lambda + e * LRUW, SEG, YAB);
                hgrn1_units(tid, lds, G, cu, LOGF, PROJ, HST, HDEC); }
            PHASE_END
            PHASE_BEGIN
                for (int rep_ = 0; rep_ < REP_MIX; ++rep_) { lru_units<true>(tid, lds, G, cu, PROJ, D_WRT + (size_t)e * 2 * 8 * 16384, I.lru_conv_w + e * 4 * LRUW, I.lru_conv_b + e * LRUW, I.lru_b_r + e * LRUW, I.lru_b_i + e * LRUW, I.lru_lambda + e * LRUW, SEG, YAB); }
                hgrn2_scan(tid, G, cu, HST, HDEC);
            PHASE_END
            PHASE_BEGIN
                for (int rep_ = 0; rep_ < REP_MIX; ++rep_) { hgrn3_units(tid, lds, G, cu, LOGF, PROJ, HST, I.hgrn_norm + e * 1024, YAB); }
            PHASE_END
            mixK = D;
        } else {
#define Zb ((bf16*)(act + A_Z))
#define XBC ((bf16*)(act + A_XBC))
#define XBT ((bf16*)(act + A_XBT))
#define BCN ((bf16*)(act + A_BCN))
#define STb ((bf16*)(act + A_ST))
#define DTb ((float*)(act + A_DT))
#define DEC ((float*)(act + A_DEC))
#define Yb ((bf16*)(act + A_Y))
            PHASE_BEGIN
                GEMM_REP(pg8::SchedMN S; S.init(XB, D, WL + WL_IN, D, M, SSDN1, G, cu); pg8::EpiProjOdd E{SS + (size_t)ssi * M * 8, Zb, XBC};
                pg8::gemm_phase<RF16>(tid, lds, D, D, D, S, E);)
            PHASE_END
            PHASE_BEGIN
                for (int rep_ = 0; rep_ < REP_MIX; ++rep_) {
                { pg8::SchedDt S{(const char*)XB, (const char*)(WL + WL_DT), cu}; pg8::EpiDt E{SS + (size_t)ssi * M * 8, I.ssd_dt_bias + e * 64, DTb};
                  pg8::gemm_phase<RF16>(tid, lds, D, D, D, S, E); }
                { int uf = cu, us = G, ue = 6144; if (G == 256) { if (cu < 64) { us = 64; ue = 1152; } else { uf = 1152 + (cu - 64); us = 192; } }
                  ssd_prep_units(tid, lds, uf, us, ue, XBC, I.ssd_conv_w + (size_t)e * 4 * SSDCONV, I.ssd_conv_b + e * SSDCONV, XBT, BCN); }
                }
            PHASE_END
            PHASE_BEGIN
                for (int rep_ = 0; rep_ < REP_MIX; ++rep_) { ssd1_units(tid, lds, G, cu, XBT, DTb, I.ssd_a_log + e * 64, STb, DEC); }
            PHASE_END
            PHASE_BEGIN
                ssd2_scan(tid, G, cu, STb, DEC);
            PHASE_END
            PHASE_BEGIN
                for (int rep_ = 0; rep_ < REP_MIX; ++rep_) { ssd3_units(tid, lds, G, cu, XBT, BCN, STb, DTb, I.ssd_a_log + e * 64, I.ssd_d + e * 64, Zb, I.ssd_norm + e * SSDIN, Yb); }
            PHASE_END
            mixK = SSDIN;
        }
#define KQb ((bf16*)(act + A_Q))
#define VWb ((bf16*)(act + A_VW))
#define Pb ((bf16*)(act + A_P))
#define Hb ((bf16*)(act + A_H))
        PHASE_BEGIN
            { pg8::SchedMN S; S.init(mixK == D ? (const bf16*)YAB : (const bf16*)Yb, mixK, WL + WL_OUT, mixK, M, D, G, cu); pg8::EpiResid E{XB, SS + (size_t)(ssi + 1) * M * 8, (LAS float*)(lds + EPI_OFF)};
              pg8::gemm_phase(tid, lds, mixK, mixK, mixK, S, E); asm volatile("" : "+v"(tid)); }
            if (cu < 256) { int nu = 1, kk = XAD; asm volatile("" : "+s"(nu), "+s"(kk)); const int iskq = cu < 128, idx = cu & 127, bh = idx >> 3, t8 = idx & 7, b = bh >> 2, h = bh & 3;
                const bf16* Km = D_KMAT + (size_t)l * MEMROWS * D; const bf16* Vm = D_VT + (size_t)l * MEMROWS * D;
                pg8::SchedOne S; S.n = nu;
                S.u0.a = iskq ? (const char*)(Km + (size_t)(b * MEMLEN) * D + h * XAD) : (const char*)(WL + WL_O + (size_t)(t8 * 256) * D + h * XAD);
                S.u0.b = iskq ? (const char*)(WL + WL_Q + (size_t)(t8 * 256) * D + h * XAD) : (const char*)(Vm + (size_t)(b * MEMLEN) * D + h * XAD);
                S.u0.orow = iskq ? bh * 256 : t8 * 256; S.u0.ocol = iskq ? t8 * 256 : h * 256; S.u0.aux = 0;
                pg8::EpiPlain E{iskq ? KQb : VWb + (size_t)b * D * 1024, iskq ? D : 1024}; pg8::gemm_phase(tid, lds, kk, D, D, S, E); }
        PHASE_END
        ++ssi;
        PHASE_BEGIN
            static_assert(!RF16, "the absorbed key matrix is bf16: the residual stream must be bf16 too");
            if (cu < 256) { const int pm = (cu & 7) * 8 + (cu >> 5), h = (cu >> 3) & 3;     int nu = 1; asm volatile("" : "+s"(nu));
                pg8::SchedOne S; S.n = nu; S.u0.a = (const char*)(XB + (size_t)pm * 256 * D); S.u0.b = (const char*)(KQb + (size_t)(((pm >> 4) * 4 + h) * 256) * D); S.u0.orow = pm * 256; S.u0.ocol = h * 256; S.u0.aux = 0;
                pg8::EpiSoftmax E{SS + (size_t)ssi * M * 8, 0.044194173824159216f, Pb, (LAS float*)(lds + EPI_OFF)}; pg8::gemm_phase(tid, lds, D, D, D, S, E); }
        PHASE_END
        PHASE_BEGIN
            pg8::SchedMNB S; S.init(Pb, 1024, VWb, 1024, M, D, G, cu, (size_t)D * 1024 * 2); pg8::EpiResid E{XB, SS + (size_t)(ssi + 1) * M * 8, (LAS float*)(lds + EPI_OFF)};
            pg8::gemm_phase(tid, lds, 1024, 1024, 1024, S, E);
        PHASE_END
        ++ssi;
        PHASE_BEGIN
            GEMM_REP(pg8::SchedMN S; S.init(XB, D, WL + WL_GU, D, M, 2 * FF, G, cu); pg8::EpiGateUp E{SS + (size_t)ssi * M * 8, Hb};
            pg8::gemm_phase<RF16>(tid, lds, D, D, D, S, E);)
        PHASE_END
        PHASE_BEGIN
            pg8::SchedMN S; S.init(Hb, FF, WL + WL_DN, FF, M, D, G, cu); pg8::EpiResid E{XB, SS + (size_t)(ssi + 1) * M * 8, (LAS float*)(lds + EPI_OFF)};
            pg8::gemm_phase(tid, lds, FF, FF, FF, S, E);
        PHASE_END
        ++ssi;
    }

__global__ void __launch_bounds__(NTHR, 2) fwd(Args args) {
    extern __shared__ __attribute__((aligned(16))) unsigned char lds_raw[];
    LAS unsigned char* lds = (LAS unsigned char*)lds_raw;
    volatile LAS unsigned* MISC = (volatile LAS unsigned*)(lds + MISC_OFF);
    const int wave0 = __builtin_amdgcn_readfirstlane((int)threadIdx.x >> 6);
    if (threadIdx.x < 64) MISC[threadIdx.x] = 0u;
    __syncthreads();
#if !MK_SPLIT
    XcdBarrier bar = xcd_barrier_post((unsigned*)(args.ws + WS_CTL), MISC + 8);
#else
    XcdBarrier bar; bar.bar = nullptr; bar.x = 0; bar.st = nullptr;
#endif
    const int lo = args.ph_lo, hi = args.ph_hi; int pc = 0;
    PHASE_BEGIN
        LAS float* scr = (LAS float*)(lds + wave * 16640);
        int rot = 0;
        for (int l = 0; l < DEPTH; ++l) conv_matrix<0>(I.xa_w_kv + (size_t)l * D * 4096, 4096, D, 0, 4096, nullptr, D_WKV + (size_t)l * 4096 * D, 0, scr, gw, NGW, lane, rot);
        for (int rep_ = 0; rep_ < REP_CONV; ++rep_) convert_layer(I, 0, WL, scr, gw, NGW, lane, rot);
        for (int m = gw; m < MEMROWS; m += NGW) {
            const f32x4* xr = (const f32x4*)(I.mem + (size_t)m * D); f32x4 v[8]; float s = 0.f;
#pragma unroll
            for (int j = 0; j < 8; ++j) { v[j] = xr[64 * j + lane]; s += (v[j][0] * v[j][0] + v[j][1] * v[j][1]) + (v[j][2] * v[j][2] + v[j][3] * v[j][3]); }
            const float rs = rsqrtf(wave_sum(s) * (1.0f / D) + EPS);
#pragma unroll
            for (int j = 0; j < 8; ++j) { const f32x4 g = *(const f32x4*)(I.norm_mem + (64 * j + lane) * 4); *(u32x2*)(D_MEMN + (size_t)m * D + (64 * j + lane) * 4) = pack4(v[j] * rs * g); }
        }
        for (int m = gw; m < M; m += NGW) {
            const f32x4* xr = (const f32x4*)(I.x + (size_t)m * D); float s = 0.f;
#pragma unroll
            for (int j = 0; j < 8; ++j) { const f32x4 v = xr[64 * j + lane]; s += (v[0] * v[0] + v[1] * v[1]) + (v[2] * v[2] + v[3] * v[3]); u32x2 w; w.x = rs_pk(v[0], v[1]); w.y = rs_pk(v[2], v[3]); *(u32x2*)(XB + (size_t)m * D + (64 * j + lane) * 4) = w; }
            s = wave_sum(s); if (lane < 8) SS[(size_t)m * 8 + lane] = lane == 0 ? s : 0.f;
        }
        for (int i = cu * NTHR + tid; i < 1024; i += G * NTHR) {
            const float a = I.hgrn_lb[i], b = I.hgrn_lb[1024 + i], mx = fmaxf(a, b), e0 = __expf(a - mx), e1 = __expf(b - mx); D_LB[i] = 0.f; D_LB[1024 + i] = e1 / (e0 + e1); }
        for (int i = cu * NTHR + tid; i < 2 * 2 * 8 * 16384; i += G * NTHR) {
            const int ii = i & 127, jj = (i >> 7) & 127, blk = (i >> 14) & 7, gt = (i >> 17) & 1, e = i >> 18;
            const float* src = gt ? I.lru_w_i : I.lru_w_r; D_WRT[i] = (bf16)f2bf(src[((size_t)(e * 8 + blk) * 128 + ii) * 128 + jj]); }
    PHASE_END

    layer_body<0>(lds, wave0, lo, hi, pc, bar); layer_body<1>(lds, wave0, lo, hi, pc, bar); layer_body<2>(lds, wave0, lo, hi, pc, bar); layer_body<3>(lds, wave0, lo, hi, pc, bar);
    const int ssi = 12;
    PHASE_BEGIN
        const float* ssf = SS + (size_t)ssi * M * 8;
        for (int m = gw; m < M; m += NGW) { f32x4* row = (f32x4*)(xres + (size_t)m * D); const u32x2* xr = (const u32x2*)(XB + (size_t)m * D); const float rs = pg8::rstd_of(ssf, m);
#pragma unroll
            for (int j = 0; j < 8; ++j) { const f32x4 g = *(const f32x4*)(I.norm_final + (64 * j + lane) * 4); const u32x2 w = xr[64 * j + lane];
                f32x4 o; o[0] = rs_lo(w.x) * rs * g[0]; o[1] = rs_hi(w.x) * rs * g[1]; o[2] = rs_lo(w.y) * rs * g[2]; o[3] = rs_hi(w.y) * rs * g[3]; row[64 * j + lane] = o; } }
    PHASE_END
#undef PHASE_BEGIN
#undef PHASE_END
}

constexpr int NPHASES = 1 + (5 + 4) + (1 + 6 + 4) + (1 + 5 + 4) + (1 + 6 + 4) + 1;

extern "C" void kernel_launch(void* const* d_in, const int* in_sizes, int n_in, void* d_out, int out_size, void* d_ws, size_t ws_size, hipStream_t stream) {
    static int grid = 0;
    if (grid == 0) {
        if (n_in != 32 || out_size != M * D || ws_size < WS_END) { fprintf(stderr, "kernel_launch: unexpected problem (n_in %d, out %d, ws %zu)\n", n_in, out_size, ws_size); grid = -1; return; }
        int dev = 0, cus = 0;
        if (hipGetDevice(&dev) != hipSuccess || hipDeviceGetAttribute(&cus, hipDeviceAttributeMultiprocessorCount, dev) != hipSuccess) { grid = -1; return; }
        if (hipFuncSetAttribute((const void*)fwd, hipFuncAttributeMaxDynamicSharedMemorySize, LDS_BYTES) != hipSuccess) { fprintf(stderr, "kernel_launch: hipFuncSetAttribute failed\n"); grid = -1; return; }
        int per_cu = 0;
        if (hipOccupancyMaxActiveBlocksPerMultiprocessor(&per_cu, (const void*)fwd, NTHR, LDS_BYTES) != hipSuccess || per_cu < 1) fprintf(stderr, "kernel_launch: occupancy query says %d\n", per_cu);
        (void)hipGetLastError();
        if (cus != 256) { fprintf(stderr, "kernel_launch: built for a 256-CU device (got %d)\n", cus); grid = -1; return; }
        grid = cus;
    }
    if (grid < 0) return;
    (void)hipMemsetAsync((char*)d_ws + WS_CTL, 0, CTL_ZERO_BYTES, stream);
    Args a{};
    const float** ip = (const float**)&a.in;
    for (int i = 0; i < 32; ++i) ip[i] = (const float*)d_in[i];
    a.out = (float*)d_out; a.ws = (unsigned char*)d_ws;
#if MK_SPLIT
#ifndef PROBE_MASK
#define PROBE_MASK 0ull
#endif
    for (int li = 0; li < NPHASES; ++li) { a.ph_lo = li; a.ph_hi = li + 1; hipLaunchKernelGGL(fwd, dim3(grid), dim3(NTHR), LDS_BYTES, stream, a);
        if ((PROBE_MASK >> li) & 1ull) hipLaunchKernelGGL(fwd, dim3(grid), dim3(NTHR), LDS_BYTES, stream, a); }
#else
    a.ph_lo = 0; a.ph_hi = NPHASES;
    hipLaunchKernelGGL(fwd, dim3(grid), dim3(NTHR), LDS_BYTES, stream, a);
#endif
}
```

```cpp
#include <hip/hip_runtime.h>
#include <cstdio>
#include <cstdint>

#ifndef MK_SPLIT
#define MK_SPLIT 0
#endif

#ifndef RESID_F16
#define RESID_F16 0
#endif
constexpr bool RF16 = RESID_F16 != 0;
#define GAS __attribute__((address_space(1)))
#define LAS __attribute__((address_space(3)))
typedef unsigned short bf16;
typedef short bf16x8 __attribute__((ext_vector_type(8)));
typedef float f32x4 __attribute__((ext_vector_type(4)));
typedef float f32x2 __attribute__((ext_vector_type(2)));
typedef unsigned u32x4 __attribute__((ext_vector_type(4)));
typedef unsigned u32x2 __attribute__((ext_vector_type(2)));

constexpr int D = 2048, NB = 4, SEQ = 4096, M = NB * SEQ, DEPTH = 4, MEMLEN = 256, MEMROWS = NB * MEMLEN;
constexpr int LRUW = 1024, ABIN = 6144;
constexpr int SSDIN = 4096, SSDCONV = 6144, SSDPROJ = 10304, SSDN1 = 10240, NHEADS = 64;
constexpr int XAD = 512, FF = 5632;
constexpr float EPS = 1e-6f;
constexpr int NWAVES = 8, NTHR = 512;

constexpr size_t MiB = 1u << 20;
constexpr size_t WS_CTL = 0, CTL_ZERO_BYTES = 1 * MiB;
constexpr size_t WS_WKV = 2 * MiB;
constexpr size_t WS_KMAT = 66 * MiB;
constexpr size_t WS_VT = 82 * MiB;
constexpr size_t WS_MEMN = 98 * MiB;
constexpr size_t WS_TAB = 102 * MiB;
constexpr size_t WS_XB = 106 * MiB;
constexpr size_t WS_WL = 170 * MiB;
constexpr size_t WS_ACT = 310 * MiB;
constexpr size_t WS_SS = (310 + 680) * MiB;
constexpr size_t WS_WL2 = (310 + 680 + 8) * MiB;
constexpr size_t WS_END = (310 + 680 + 8 + 140) * MiB;
constexpr size_t TAB_LB = 0;
constexpr size_t TAB_WRT = 64 * 1024;
constexpr size_t WL_IN = 0;
constexpr size_t WL_DT = (size_t)SSDN1 * D;
constexpr size_t WL_OUT = (size_t)(SSDN1 + 256) * D;
constexpr size_t WL_Q = WL_OUT + (size_t)D * SSDIN;
constexpr size_t WL_O = WL_Q + (size_t)D * D;
constexpr size_t WL_GU = WL_O + (size_t)D * D;
constexpr size_t WL_DN = WL_GU + (size_t)2 * FF * D;
constexpr size_t WL_ELEMS = WL_DN + (size_t)D * FF;
static_assert(WL_ELEMS * 2 <= 140 * MiB, "per-layer weights");
constexpr size_t A_Z = 0;
constexpr size_t A_XBC = 128 * MiB;
constexpr size_t A_Y = 128 * MiB;
constexpr size_t A_XBT = 320 * MiB;
constexpr size_t A_BCN = 480 * MiB;
constexpr size_t A_ST = 544 * MiB;
constexpr size_t A_DT = 672 * MiB;
constexpr size_t A_DEC = 676 * MiB;
constexpr size_t A_PROJ = 0;
constexpr size_t A_LOGF = 192 * MiB;
constexpr size_t A_HST = 256 * MiB;
constexpr size_t A_YAB = 320 * MiB;
constexpr size_t A_SEG = 384 * MiB;
constexpr size_t A_HDEC = 386 * MiB;
constexpr size_t A_Q = 0;
constexpr size_t A_VW = 16 * MiB;
constexpr size_t A_P = 64 * MiB;
constexpr size_t A_O = 96 * MiB;
constexpr size_t A_H = 160 * MiB;

constexpr int LDS_BYTES = 155648;
constexpr int EPI_OFF = 131072;
constexpr int MISC_OFF = LDS_BYTES - 256;

#define LDS_WAIT() asm volatile("s_waitcnt lgkmcnt(0)" ::: "memory")
#define VM_WAIT() asm volatile("s_waitcnt vmcnt(0)" ::: "memory")
__device__ __forceinline__ unsigned f2bf(float f) { unsigned u = __builtin_bit_cast(unsigned, f); return (u + 0x7fffu + ((u >> 16) & 1u)) >> 16; }
__device__ __forceinline__ unsigned pk2(float lo, float hi) { return f2bf(lo) | (f2bf(hi) << 16); }
typedef __bf16 bf16x2v __attribute__((ext_vector_type(2)));
__device__ __forceinline__ unsigned cvt_pk_bf16(float lo, float hi) { const f32x2 v = {lo, hi}; return __builtin_bit_cast(unsigned, __builtin_convertvector(v, bf16x2v)); }
typedef _Float16 f16x2v __attribute__((ext_vector_type(2)));
typedef _Float16 f16x8 __attribute__((ext_vector_type(8)));
__device__ __forceinline__ unsigned cvt_pk_f16(float lo, float hi) { const f32x2 v = {lo, hi}; return __builtin_bit_cast(unsigned, __builtin_convertvector(v, f16x2v)); }
__device__ __forceinline__ float h16lo(unsigned w) { return (float)__builtin_bit_cast(f16x2v, w)[0]; }
__device__ __forceinline__ float h16hi(unsigned w) { return (float)__builtin_bit_cast(f16x2v, w)[1]; }
__device__ __forceinline__ float bflo(unsigned w) { return __uint_as_float(w << 16); }
__device__ __forceinline__ float bfhi(unsigned w) { return __uint_as_float(w & 0xffff0000u); }
__device__ __forceinline__ unsigned rs_pk(float lo, float hi) { return RF16 ? cvt_pk_f16(lo, hi) : cvt_pk_bf16(lo, hi); }
__device__ __forceinline__ float rs_lo(unsigned w) { return RF16 ? h16lo(w) : bflo(w); }
__device__ __forceinline__ float rs_hi(unsigned w) { return RF16 ? h16hi(w) : bfhi(w); }
__device__ __forceinline__ float bf2f(bf16 b) { return __uint_as_float((unsigned)b << 16); }
__device__ __forceinline__ float sigm(float x) { return __builtin_amdgcn_rcpf(1.f + __expf(-x)); }
__device__ __forceinline__ float siluf(float x) { return x * sigm(x); }
__device__ __forceinline__ float gelu_tanh(float x) { return x * sigm(1.5957691216f * (x + 0.044715f * x * x * x)); }
__device__ __forceinline__ float softplusf(float x) { const float e = __expf(-fabsf(x)); const float l = (e < 0.03f) ? e * (1.f - e * (0.5f - e * 0.33333333f)) : __logf(1.f + e); return fmaxf(x, 0.f) + l; }
__device__ __forceinline__ float wave_sum(float v) {
#pragma unroll
    for (int o = 1; o < 64; o <<= 1) v += __shfl_xor(v, o);
    return v;
}

#define XB_TMO      128
#define XB_XCNT(j)  (256  + 64 * (j))
#define XB_XSUB(j)  (1280 + 64 * (j))
#define XB_XGEN(j)  (2304 + 64 * (j))
#define XB_TOP      3328
#define XB_TOPGEN   3392
#define XCD_BAR_WORDS 3456
#define XB_SPIN_CAP (1u << 18)

__device__ __forceinline__ unsigned xb_ld(unsigned* p)              { return __hip_atomic_load(p, __ATOMIC_RELAXED, __HIP_MEMORY_SCOPE_AGENT); }
__device__ __forceinline__ unsigned xb_add(unsigned* p, unsigned v) { return __hip_atomic_fetch_add(p, v, __ATOMIC_RELAXED, __HIP_MEMORY_SCOPE_AGENT); }
__device__ __forceinline__ unsigned xb_xcc_id() { return (unsigned)__builtin_amdgcn_s_getreg((3 << 11) | 20) & 0xFu; }
#define XB_SPIN(cond, bar) do { unsigned _sp = 0; while (cond) { __builtin_amdgcn_s_sleep(1); \
    if ((++_sp & 255u) == 0u) { if (xb_ld(&(bar)[XB_TMO])) break; if (_sp > XB_SPIN_CAP) { atomicAdd(&(bar)[XB_TMO], 1u); break; } } } } while (0)

struct XcdBarrier {
    unsigned* bar; unsigned x;
    volatile LAS unsigned* st;
};
__device__ __forceinline__ XcdBarrier xcd_barrier_post(unsigned* bar, volatile LAS unsigned* st) {
    XcdBarrier b; b.bar = bar; b.x = xb_xcc_id(); b.st = st;
    if (threadIdx.x == 0) (void)xb_add(&bar[XB_XCNT(b.x)], 1u);
    return b;
}
__device__ __forceinline__ void xcd_barrier_complete(unsigned* bar, unsigned x, unsigned& nloc, unsigned& nx) {
    const unsigned G = gridDim.x * gridDim.y * gridDim.z;
    unsigned sum, cnt, mine, sp = 0u;
    for (;;) {
        sum = 0u; cnt = 0u; mine = 0u;
#pragma unroll
        for (unsigned j = 0; j < 16; ++j) { const unsigned c = xb_ld(&bar[XB_XCNT(j)]); sum += c; cnt += (c > 0u) ? 1u : 0u; mine = (j == x) ? c : mine; }
        if (sum == G) break;
        __builtin_amdgcn_s_sleep(1);
        if ((++sp & 255u) == 0u) { if (xb_ld(&bar[XB_TMO])) break; if (sp > XB_SPIN_CAP) { atomicAdd(&bar[XB_TMO], 1u); break; } }
    }
    nloc = mine > 0u ? mine : 1u; nx = cnt > 0u ? cnt : 1u;
}
__device__ __forceinline__ void xcd_barrier(const XcdBarrier& b) {
    asm volatile("s_waitcnt vmcnt(0)" ::: "memory");
    __syncthreads();
    if (threadIdx.x == 0) {
        unsigned* bar = b.bar;
        __builtin_amdgcn_s_waitcnt(0);
        unsigned nloc = b.st[0], nx = b.st[1];
        if (nloc == 0u) { xcd_barrier_complete(bar, b.x, nloc, nx); b.st[0] = nloc; b.st[1] = nx; }
        const unsigned old = xb_add(&bar[XB_XSUB(b.x)], 1u);
        const unsigned gen = old / nloc;
        if (old + 1u == (gen + 1u) * nloc) {
            __builtin_amdgcn_fence(__ATOMIC_RELEASE, "agent");
            asm volatile("s_waitcnt vmcnt(0)" ::: "memory");
            const unsigned og = xb_add(&bar[XB_TOP], 1u);
            const unsigned tg = og / nx;
            if (og + 1u == (tg + 1u) * nx) xb_add(&bar[XB_TOPGEN], 1u);
            else XB_SPIN(xb_ld(&bar[XB_TOPGEN]) == tg, bar);
            __builtin_amdgcn_fence(__ATOMIC_ACQUIRE, "agent");
            xb_add(&bar[XB_XGEN(b.x)], 1u);
            asm volatile("s_waitcnt vmcnt(0)" ::: "memory");
        } else {
            XB_SPIN(xb_ld(&bar[XB_XGEN(b.x)]) == gen, bar);
            __builtin_amdgcn_fence(__ATOMIC_ACQUIRE, "agent");
            asm volatile("s_waitcnt vmcnt(0)" ::: "memory");
        }
    }
    __syncthreads();
}

namespace pg8 {
constexpr int BM = 256, BK = 64, HALF = 128, HTB = HALF * BK * 2, STAGE_BYTES = 8 * HTB, NXCD = 8, WGM = 8;
__host__ __device__ __forceinline__ int lds_byte(int r, int c) { const int st = (r >> 4) * 2 + (c >> 5), rr = r & 15, cc = c & 31, ob = rr * 64 + cc * 2; return st * 1024 + (ob ^ (((ob >> 9) & 1) << 5)); }
__host__ __device__ __forceinline__ void stage_rc(int b, int& R, int& C) { const int st = b / 1024, sb = b % 1024, swz = sb ^ (((sb >> 9) & 1) << 5); R = (st >> 1) * 16 + swz / 64; C = (st & 1) * 32 + (swz % 64) / 2; }
__host__ __device__ __forceinline__ int perm32(int rho) { const int n = rho >> 4, i = rho & 15; return 8 * (i >> 2) + 4 * n + (i & 3); }

struct Unit { const char* a; const char* b; int orow, ocol, aux; };

template <bool F16 = false, bool ALIGN = true, class Epi, class Sched>
__device__ __forceinline__ void gemm_phase(const int tid, LAS unsigned char* lds, const int K, const int lda, const int ldb, const Sched& S, const Epi& E) {
    const int wid = __builtin_amdgcn_readfirstlane(tid >> 6), lane = tid & 63, wr = wid >> 2, wc = wid & 3, fr = lane & 15, fq = lane >> 4;
    const int nt = K / BK;
    unsigned voffA[2], voffB[2];
#pragma unroll
    for (int i = 0; i < 2; ++i) { int R, C; stage_rc(tid * 16 + i * 8192, R, C); const int Rb = (R & ~31) + perm32(R & 31);
        voffA[i] = (unsigned)(R * lda + C) * 2u; voffB[i] = (unsigned)(Rb * ldb + C) * 2u; }
    const size_t kstep = (size_t)(BK * 2);
    const size_t hstepA = (size_t)HALF * lda * 2, hstepB = (size_t)HALF * ldb * 2;
    const unsigned ldsw = (unsigned)wid * 1024u;
    const int aoff = lds_byte(wr * 64 + fr, fq * 8), boff = lds_byte(wc * 32 + fr, fq * 8);
#define PG8_SA(b, h) (((b) * 2 + (h)) * HTB)
#define PG8_SB(b, h) ((4 + (b) * 2 + (h)) * HTB)
#define PG8_STAGE(bufoff, gbase, voff) do { _Pragma("unroll") for (int _i = 0; _i < 2; ++_i) \
        __builtin_amdgcn_global_load_lds((const unsigned*)((const char*)(gbase) + (voff)[_i]), (LAS unsigned*)(lds + (bufoff) + ldsw + _i * 8192), 16, 0, 0); } while (0)
#define PG8_LDA(dst, b, h) do { _Pragma("unroll") for (int m = 0; m < 4; ++m) _Pragma("unroll") for (int k = 0; k < 2; ++k) dst[m][k] = *(const LAS bf16x8*)(lds + PG8_SA(b, h) + aoff + m * 2048 + k * 1024); } while (0)
#define PG8_LDB(dst, b, h) do { _Pragma("unroll") for (int n = 0; n < 2; ++n) _Pragma("unroll") for (int k = 0; k < 2; ++k) dst[n][k] = *(const LAS bf16x8*)(lds + PG8_SB(b, h) + boff + n * 2048 + k * 1024); } while (0)
#define PG8_MMA(ai, bj, At, Bt) do { __builtin_amdgcn_s_setprio(1); _Pragma("unroll") for (int m = 0; m < 4; ++m) _Pragma("unroll") for (int n = 0; n < 2; ++n) _Pragma("unroll") for (int k = 0; k < 2; ++k) \
        acc[ai][bj][m][n] = F16 ? __builtin_amdgcn_mfma_f32_16x16x32_f16(__builtin_bit_cast(f16x8, Bt[n][k]), __builtin_bit_cast(f16x8, At[m][k]), acc[ai][bj][m][n], 0, 0, 0) \
                                : __builtin_amdgcn_mfma_f32_16x16x32_bf16(Bt[n][k], At[m][k], acc[ai][bj][m][n], 0, 0, 0); __builtin_amdgcn_s_setprio(0); } while (0)
#define PG8_WAIT_V(n) asm volatile("s_waitcnt vmcnt(" #n ")" ::: "memory")
#define PG8_WAIT_L(n) asm volatile("s_waitcnt lgkmcnt(" #n ")" ::: "memory")
#define PG8_BAR __builtin_amdgcn_s_barrier()
#define PG8_SCHED __builtin_amdgcn_sched_barrier(0)
    Unit cur, nxt; int ui = 0;
    if (!S.next(0, cur)) return;
    f32x4 acc[2][2][4][2];
#pragma unroll
    for (int a = 0; a < 2; ++a)
#pragma unroll
        for (int b = 0; b < 2; ++b)
#pragma unroll
            for (int m = 0; m < 4; ++m)
#pragma unroll
                for (int n = 0; n < 2; ++n) acc[a][b][m][n] = (f32x4){0.f, 0.f, 0.f, 0.f};
    bf16x8 At[4][2], B0[2][2], B1[2][2];
    const char* cA = cur.a; const char* cB = cur.b;
    PG8_STAGE(PG8_SB(0, 0), cB, voffB); PG8_STAGE(PG8_SB(0, 1), cB + hstepB, voffB); PG8_STAGE(PG8_SA(0, 0), cA, voffA); PG8_STAGE(PG8_SA(0, 1), cA + hstepA, voffA);
    if (wr == 1) PG8_BAR;
    PG8_WAIT_V(2); PG8_BAR;
    PG8_STAGE(PG8_SB(1, 0), cB + kstep, voffB); PG8_STAGE(PG8_SA(1, 0), cA + kstep, voffA); PG8_STAGE(PG8_SB(1, 1), cB + hstepB + kstep, voffB);
    PG8_WAIT_V(6); PG8_BAR;
    for (;;) {
        const bool has_next = S.next(ui + 1, nxt);
        const char* nA = has_next ? nxt.a : cA; const char* nB = has_next ? nxt.b : cB;
        for (int t = 0; t < nt; t += 2) {
            const bool last = (t == nt - 2);
            const char* a1 = cA + (size_t)(t + 1) * kstep;
            const char* a2 = last ? nA : cA + (size_t)(t + 2) * kstep; const char* b2 = last ? nB : cB + (size_t)(t + 2) * kstep;
            const char* a3 = a2 + kstep; const char* b3 = b2 + kstep;
            PG8_LDB(B0, 0, 0); PG8_LDB(B1, 0, 1); PG8_SCHED; PG8_LDA(At, 0, 0); PG8_STAGE(PG8_SA(1, 1), a1 + hstepA, voffA);
            PG8_WAIT_V(8); PG8_WAIT_L(0); PG8_BAR; PG8_MMA(0, 0, At, B0); PG8_MMA(0, 1, At, B1); PG8_BAR; PG8_SCHED;
            PG8_LDA(At, 0, 1); PG8_STAGE(PG8_SB(0, 0), b2, voffB); PG8_STAGE(PG8_SB(0, 1), b2 + hstepB, voffB); PG8_STAGE(PG8_SA(0, 0), a2, voffA);
            PG8_WAIT_V(8); PG8_WAIT_L(0); PG8_BAR; PG8_MMA(1, 0, At, B0); PG8_MMA(1, 1, At, B1); PG8_BAR; PG8_SCHED;
            PG8_LDB(B0, 1, 0); PG8_LDB(B1, 1, 1); PG8_SCHED; PG8_LDA(At, 1, 0); PG8_STAGE(PG8_SA(0, 1), a2 + hstepA, voffA);
            PG8_WAIT_V(8); PG8_WAIT_L(0); PG8_BAR; PG8_MMA(0, 0, At, B0); PG8_MMA(0, 1, At, B1); PG8_BAR; PG8_SCHED;
            PG8_LDA(At, 1, 1); PG8_STAGE(PG8_SB(1, 0), b3, voffB); PG8_STAGE(PG8_SB(1, 1), b3 + hstepB, voffB); PG8_STAGE(PG8_SA(1, 0), a3, voffA);
            PG8_WAIT_V(8); PG8_WAIT_L(0); PG8_BAR; PG8_MMA(1, 0, At, B0); PG8_MMA(1, 1, At, B1); PG8_BAR; PG8_SCHED;
        }
        if (ALIGN) { if (wr == 0) PG8_BAR; }
        E(acc, cur, wr, wc, fr, fq);
        if (!has_next) break;
#pragma unroll
        for (int a = 0; a < 2; ++a)
#pragma unroll
            for (int b = 0; b < 2; ++b)
#pragma unroll
                for (int m = 0; m < 4; ++m)
#pragma unroll
                    for (int n = 0; n < 2; ++n) acc[a][b][m][n] = (f32x4){0.f, 0.f, 0.f, 0.f};
        cur = nxt; cA = nA; cB = nB; ++ui;
        if (ALIGN) { if (wr == 1) PG8_BAR; }
    }
    PG8_WAIT_V(0);
    if (!ALIGN) { if (wr == 0) PG8_BAR; }
    PG8_BAR;
#undef PG8_SA
#undef PG8_SB
#undef PG8_STAGE
#undef PG8_LDA
#undef PG8_LDB
#undef PG8_MMA
#undef PG8_WAIT_V
#undef PG8_WAIT_L
#undef PG8_SCHED
}
}
namespace pg8 {
struct SchedMN {
    const char* A; const char* Bt; int lda, ldb; int nM, nN, nwg, G, c;
    __device__ __forceinline__ void init(const bf16* A_, int lda_, const bf16* Bt_, int ldb_, int Mrows, int Ncols, int G_, int c_) {
        A = (const char*)A_; Bt = (const char*)Bt_; lda = lda_; ldb = ldb_; nM = Mrows / BM; nN = Ncols / BM; nwg = nM * nN; G = G_; c = c_; }
    __device__ __forceinline__ bool next(int i, Unit& u) const {
        const long L = (long)i * G + c; if (L >= nwg) return false;
        int wgid = (int)L; { const int q = nwg / NXCD, r = nwg % NXCD, xcd = wgid % NXCD, off = wgid / NXCD; wgid = (xcd < r ? xcd * (q + 1) : r * (q + 1) + (xcd - r) * q) + off; }
        const int nig = WGM * nN, gid = wgid / nig, fm = gid * WGM, gsz = (nM - fm) < WGM ? (nM - fm) : WGM;
        const int pm = fm + ((wgid % nig) % gsz), pn = (wgid % nig) / gsz;
        u.a = A + (size_t)pm * BM * lda * 2; u.b = Bt + (size_t)pn * BM * ldb * 2; u.orow = pm * BM; u.ocol = pn * BM; u.aux = pn; return true;
    }
};
struct SchedKV {
    const char* memn; const char* wkv; int G, c;
    __device__ __forceinline__ bool next(int i, Unit& u) const {
        const int L = i * G + c; if (L >= 256) return false;
        const int l = L >> 6, r = L & 63; const char* w = wkv + (size_t)l * 4096 * D * 2;
        if (r < 32) { const int pm = r >> 3, pn = r & 7; u.a = memn + (size_t)pm * 256 * D * 2; u.b = w + (size_t)pn * 256 * D * 2; u.orow = pm * 256; u.ocol = pn * 256; u.aux = l * 2; }
        else { const int q = r - 32, pm = q >> 3, pn = q & 7; u.a = memn + (size_t)pm * 256 * D * 2; u.b = w + (size_t)(2048 + pn * 256) * D * 2; u.orow = pm * 256; u.ocol = pn * 256; u.aux = l * 2 + 1; }
        return true;
    }
};
struct SchedS {
    const char* Q; const char* Km; int G, c;
    __device__ __forceinline__ bool next(int i, Unit& u) const {
        const int L = i * G + c; if (L >= 256) return false;
        const int bh = 2 * (L & 7) + ((L >> 3) >> 4), it = (L >> 3) & 15, b = bh >> 2, h = bh & 3;
        u.a = Q + ((size_t)(b * SEQ + it * 256) * D + h * XAD) * 2; u.b = Km + ((size_t)(b * MEMLEN) * D + h * XAD) * 2; u.orow = b * SEQ + it * 256; u.ocol = h * 256; u.aux = 0; return true;
    }
};
struct SchedPV {
    const char* P; const char* Vt; int G, c;
    __device__ __forceinline__ bool next(int i, Unit& u) const {
        const int L = i * G + c; if (L >= 512) return false;
        const int x = L & 7, r = L >> 3;
        const int bh = 2 * x + (r >> 5), q = r & 31, it = q >> 1, nh = q & 1, b = bh >> 2, h = bh & 3;
        u.a = P + ((size_t)(b * SEQ + it * 256) * 1024 + h * 256) * 2; u.b = Vt + ((size_t)(h * XAD + nh * 256) * 1024 + b * MEMLEN) * 2; u.orow = b * SEQ + it * 256; u.ocol = h * XAD + nh * 256; u.aux = 0; return true;
    }
};
struct SchedDt {
    const char* A; const char* Bt; int c;
    __device__ __forceinline__ bool next(int i, Unit& u) const {
        if (i != 0 || c >= 64) return false;
        u.a = A + (size_t)c * 256 * D * 2; u.b = Bt; u.orow = c * 256; u.ocol = 0; u.aux = 0; return true;
    }
};

struct SchedOne {
    Unit u0; int n;
    __device__ __forceinline__ bool next(int i, Unit& u) const { if (i >= n) return false; u = u0; return true; }
};
struct SchedMNB {
    const char* A; const char* Bt; int lda, ldb; int nM, nN, nwg, G, c; size_t bstride;
    __device__ __forceinline__ void init(const bf16* A_, int lda_, const bf16* Bt_, int ldb_, int Mrows, int Ncols, int G_, int c_, size_t bstride_) {
        A = (const char*)A_; Bt = (const char*)Bt_; lda = lda_; ldb = ldb_; nM = Mrows / BM; nN = Ncols / BM; nwg = nM * nN; G = G_; c = c_; bstride = bstride_; }
    __device__ __forceinline__ bool next(int i, Unit& u) const {
        const long L = (long)i * G + c; if (L >= nwg) return false;
        int wgid = (int)L; { const int q = nwg / NXCD, r = nwg % NXCD, xcd = wgid % NXCD, off = wgid / NXCD; wgid = (xcd < r ? xcd * (q + 1) : r * (q + 1) + (xcd - r) * q) + off; }
        const int nig = WGM * nN, gid = wgid / nig, fm = gid * WGM, gsz = (nM - fm) < WGM ? (nM - fm) : WGM;
        const int pm = fm + ((wgid % nig) % gsz), pn = (wgid % nig) / gsz;
        u.a = A + (size_t)pm * BM * lda * 2; u.b = Bt + (size_t)(pm >> 4) * bstride + (size_t)pn * BM * ldb * 2; u.orow = pm * BM; u.ocol = pn * BM; u.aux = pn; return true;
    }
};
struct SchedChainQ {
    const char* A; const char* Bt; int pm, h, n;
    __device__ __forceinline__ bool next(int i, Unit& u) const { if (i >= n) return false; const int pn = 2 * h + i;
        u.a = A + (size_t)pm * 256 * D * 2; u.b = Bt + (size_t)pn * 256 * D * 2; u.orow = pm * 256; u.ocol = pn * 256; u.aux = pn; return true; }
};
struct SchedChainS {
    const char* Q; const char* Km; int pm, h, n;
    __device__ __forceinline__ bool next(int i, Unit& u) const { if (i >= n) return false; const int b = pm >> 4;
        u.a = Q + ((size_t)pm * 256 * D + h * XAD) * 2; u.b = Km + ((size_t)(b * MEMLEN) * D + h * XAD) * 2; u.orow = pm * 256; u.ocol = h * 256; u.aux = 0; return true; }
};
struct SchedChainPV {
    const char* P; const char* Vt; int pm, h, n;
    __device__ __forceinline__ bool next(int i, Unit& u) const { if (i >= n) return false; const int b = pm >> 4;
        u.a = P + ((size_t)pm * 256 * 1024 + h * 256) * 2; u.b = Vt + ((size_t)(h * XAD + i * 256) * 1024 + b * MEMLEN) * 2; u.orow = pm * 256; u.ocol = h * XAD + i * 256; u.aux = 0; return true; }
};

#define EPI_ARGS f32x4 (&acc)[2][2][4][2], const Unit& u, int wr, int wc, int fr, int fq
#define EPI_ROW(ai, m) (u.orow + (ai) * HALF + wr * 64 + (m) * 16 + fr)
#define EPI_COL(bj) (u.ocol + (bj) * HALF + wc * 32 + 8 * fq)
__device__ __forceinline__ float rstd_of(const float* ss, int row) { const f32x4 a = *(const f32x4*)(ss + (size_t)row * 8), b = *(const f32x4*)(ss + (size_t)row * 8 + 4);
    return rsqrtf((((a[0] + a[1]) + (a[2] + a[3])) + ((b[0] + b[1]) + (b[2] + b[3]))) * (1.0f / D) + EPS); }
__device__ __forceinline__ u32x4 pack8(const f32x4 a, const f32x4 b) { u32x4 w; w.x = cvt_pk_bf16(a[0], a[1]); w.y = cvt_pk_bf16(a[2], a[3]); w.z = cvt_pk_bf16(b[0], b[1]); w.w = cvt_pk_bf16(b[2], b[3]); return w; }

struct EpiProjEven {
    const float* ss; bf16* proj; float* logf; const float* lb;
    __device__ __forceinline__ void operator()(EPI_ARGS) const {
        const int range = u.aux >> 2;
#pragma unroll
        for (int ai = 0; ai < 2; ++ai)
#pragma unroll
            for (int m = 0; m < 4; ++m) { const int row = EPI_ROW(ai, m); const float rs = rstd_of(ss, row);
#pragma unroll
                for (int bj = 0; bj < 2; ++bj) { const int col = EPI_COL(bj); f32x4 v0 = acc[ai][bj][m][0] * rs, v1 = acc[ai][bj][m][1] * rs;
                    if (range == 3) { const int c = col - 3072; const f32x4 l0 = *(const f32x4*)(lb + c), l1 = *(const f32x4*)(lb + c + 4);
#pragma unroll
                        for (int j = 0; j < 4; ++j) { v0[j] = __logf(l0[j] + (1.f - l0[j]) * sigm(v0[j])); v1[j] = __logf(l1[j] + (1.f - l1[j]) * sigm(v1[j])); }
                        float* p = logf + (size_t)row * 1024 + c; *(f32x4*)p = v0; *(f32x4*)(p + 4) = v1;
                    } else {
                        if (range == 1) {
#pragma unroll
                            for (int j = 0; j < 4; ++j) { v0[j] = gelu_tanh(v0[j]); v1[j] = gelu_tanh(v1[j]); } }
                        else if (range == 2 || range == 5) {
#pragma unroll
                            for (int j = 0; j < 4; ++j) { v0[j] = siluf(v0[j]); v1[j] = siluf(v1[j]); } }
                        *(u32x4*)(proj + (size_t)row * ABIN + col) = pack8(v0, v1);
                    } } }
    }
};
struct EpiProjOdd {
    const float* ss; bf16* Z; bf16* XBC;
    __device__ __forceinline__ void operator()(EPI_ARGS) const {
        const bool isz = u.ocol < SSDIN;
#pragma unroll
        for (int ai = 0; ai < 2; ++ai)
#pragma unroll
            for (int m = 0; m < 4; ++m) { const int row = EPI_ROW(ai, m); const float rs = rstd_of(ss, row);
#pragma unroll
                for (int bj = 0; bj < 2; ++bj) { const int col = EPI_COL(bj); f32x4 v0 = acc[ai][bj][m][0] * rs, v1 = acc[ai][bj][m][1] * rs;
                    if (isz) {
#pragma unroll
                        for (int j = 0; j < 4; ++j) { v0[j] = siluf(v0[j]); v1[j] = siluf(v1[j]); }
                        *(u32x4*)(Z + (size_t)row * SSDIN + col) = pack8(v0, v1);
                    } else *(u32x4*)(XBC + (size_t)row * SSDCONV + (col - SSDIN)) = pack8(v0, v1); } }
    }
};
struct EpiDt {
    const float* ss; const float* bias; float* DT;
    __device__ __forceinline__ void operator()(EPI_ARGS) const {
        if (wc >= 2) return;
        const int col = wc * 32 + 8 * fq; const f32x4 b0 = *(const f32x4*)(bias + col), b1 = *(const f32x4*)(bias + col + 4);
#pragma unroll
        for (int ai = 0; ai < 2; ++ai)
#pragma unroll
            for (int m = 0; m < 4; ++m) { const int row = EPI_ROW(ai, m); const float rs = rstd_of(ss, row);
                f32x4 v0 = acc[ai][0][m][0] * rs + b0, v1 = acc[ai][0][m][1] * rs + b1;
#pragma unroll
                for (int j = 0; j < 4; ++j) { v0[j] = softplusf(v0[j]); v1[j] = softplusf(v1[j]); }
                float* p = DT + (size_t)row * 64 + col; *(f32x4*)p = v0; *(f32x4*)(p + 4) = v1; }
    }
};
struct EpiResid {
    bf16* xb; float* ssnew; LAS float* tab;
    __device__ __forceinline__ void operator()(EPI_ARGS) const {
#pragma unroll
        for (int ai = 0; ai < 2; ++ai)
#pragma unroll
            for (int m = 0; m < 4; ++m) { const int row = EPI_ROW(ai, m); float sq = 0.f;
#pragma unroll
                for (int bj = 0; bj < 2; ++bj) { bf16* p = xb + (size_t)row * D + EPI_COL(bj); const u32x4 w = *(const u32x4*)p;
                    f32x4 o0 = acc[ai][bj][m][0], o1 = acc[ai][bj][m][1];
                    o0[0] += rs_lo(w.x); o0[1] += rs_hi(w.x); o0[2] += rs_lo(w.y); o0[3] += rs_hi(w.y); o1[0] += rs_lo(w.z); o1[1] += rs_hi(w.z); o1[2] += rs_lo(w.w); o1[3] += rs_hi(w.w);
                    { u32x4 pk; pk.x = rs_pk(o0[0], o0[1]); pk.y = rs_pk(o0[2], o0[3]); pk.z = rs_pk(o1[0], o1[1]); pk.w = rs_pk(o1[2], o1[3]); *(u32x4*)p = pk; }
                    sq += ((o0[0] * o0[0] + o0[1] * o0[1]) + (o0[2] * o0[2] + o0[3] * o0[3])) + ((o1[0] * o1[0] + o1[1] * o1[1]) + (o1[2] * o1[2] + o1[3] * o1[3])); }
                sq += __shfl_xor(sq, 16); sq += __shfl_xor(sq, 32);
                if (fq == 0) tab[(ai * HALF + wr * 64 + m * 16 + fr) * 4 + wc] = sq; }
        LDS_WAIT(); PG8_BAR; asm volatile("" ::: "memory");
        const int lane = fq * 16 + fr, r = (wr * 4 + wc) * 32 + (lane & 31);
        if (lane < 32) { const f32x4 t = *(const LAS f32x4*)(tab + r * 4); ssnew[(size_t)(u.orow + r) * 8 + (u.ocol >> 8)] = (t[0] + t[1]) + (t[2] + t[3]); }
    }
};
struct EpiQ {
    const float* ss; bf16* Q; float scale;
    __device__ __forceinline__ void operator()(EPI_ARGS) const {
#pragma unroll
        for (int ai = 0; ai < 2; ++ai)
#pragma unroll
            for (int m = 0; m < 4; ++m) { const int row = EPI_ROW(ai, m); const float rs = rstd_of(ss, row) * scale;
#pragma unroll
                for (int bj = 0; bj < 2; ++bj) *(u32x4*)(Q + (size_t)row * D + EPI_COL(bj)) = pack8(acc[ai][bj][m][0] * rs, acc[ai][bj][m][1] * rs); }
    }
};
struct EpiPlain {
    bf16* O; int ldc;
    __device__ __forceinline__ void operator()(EPI_ARGS) const {
#pragma unroll
        for (int ai = 0; ai < 2; ++ai)
#pragma unroll
            for (int m = 0; m < 4; ++m) { const int row = EPI_ROW(ai, m);
#pragma unroll
                for (int bj = 0; bj < 2; ++bj) *(u32x4*)(O + (size_t)row * ldc + EPI_COL(bj)) = pack8(acc[ai][bj][m][0], acc[ai][bj][m][1]); }
    }
};
struct EpiKV {
    bf16* Km; bf16* Vt;
    __device__ __forceinline__ void operator()(EPI_ARGS) const {
        const int l = u.aux >> 1; const bool isv = u.aux & 1;
        bf16* O = Km + (size_t)l * MEMROWS * D + (size_t)(isv ? 1 : 0) * (size_t)(Vt - Km); const int ldc = D;
#pragma unroll
        for (int ai = 0; ai < 2; ++ai)
#pragma unroll
            for (int m = 0; m < 4; ++m) { const int row = EPI_ROW(ai, m);
#pragma unroll
                for (int bj = 0; bj < 2; ++bj) *(u32x4*)(O + (size_t)row * ldc + EPI_COL(bj)) = pack8(acc[ai][bj][m][0], acc[ai][bj][m][1]); }
    }
};
struct EpiSoftmax {
    const float* ss; float scale; bf16* P; LAS float* tab;
    __device__ __forceinline__ void operator()(EPI_ARGS) const {
        float mx[2][4];
#pragma unroll
        for (int ai = 0; ai < 2; ++ai)
#pragma unroll
            for (int m = 0; m < 4; ++m) { float v = -3.0e38f; const float rs = rstd_of(ss, EPI_ROW(ai, m)) * scale;
#pragma unroll
                for (int bj = 0; bj < 2; ++bj)
#pragma unroll
                    for (int n = 0; n < 2; ++n) { const f32x4 a = acc[ai][bj][m][n] * rs; acc[ai][bj][m][n] = a; v = fmaxf(v, fmaxf(fmaxf(a[0], a[1]), fmaxf(a[2], a[3]))); }
                v = fmaxf(v, __shfl_xor(v, 16)); v = fmaxf(v, __shfl_xor(v, 32));
                if (fq == 0) tab[(ai * HALF + wr * 64 + m * 16 + fr) * 4 + wc] = v; }
        LDS_WAIT(); PG8_BAR; asm volatile("" ::: "memory");
#pragma unroll
        for (int ai = 0; ai < 2; ++ai)
#pragma unroll
            for (int m = 0; m < 4; ++m) { const int r = ai * HALF + wr * 64 + m * 16 + fr; const f32x4 t = *(const LAS f32x4*)(tab + r * 4);
                const float rm = fmaxf(fmaxf(t[0], t[1]), fmaxf(t[2], t[3])); float s = 0.f;
#pragma unroll
                for (int bj = 0; bj < 2; ++bj)
#pragma unroll
                    for (int n = 0; n < 2; ++n) { f32x4 a = acc[ai][bj][m][n];
#pragma unroll
                        for (int j = 0; j < 4; ++j) { a[j] = __expf(a[j] - rm); s += a[j]; }
                        acc[ai][bj][m][n] = a; }
                s += __shfl_xor(s, 16); s += __shfl_xor(s, 32);
                if (fq == 0) tab[1024 + r * 4 + wc] = s; }
        LDS_WAIT(); PG8_BAR; asm volatile("" ::: "memory");
#pragma unroll
        for (int ai = 0; ai < 2; ++ai)
#pragma unroll
            for (int m = 0; m < 4; ++m) { const int r = ai * HALF + wr * 64 + m * 16 + fr; const f32x4 t = *(const LAS f32x4*)(tab + 1024 + r * 4);
                const float inv = __builtin_amdgcn_rcpf((t[0] + t[1]) + (t[2] + t[3])); const int row = u.orow + r;
#pragma unroll
                for (int bj = 0; bj < 2; ++bj) *(u32x4*)(P + (size_t)row * 1024 + EPI_COL(bj)) = pack8(acc[ai][bj][m][0] * inv, acc[ai][bj][m][1] * inv); }
    }
};
struct EpiGateUp {
    const float* ss; bf16* H;
    __device__ __forceinline__ void operator()(EPI_ARGS) const {
#pragma unroll
        for (int ai = 0; ai < 2; ++ai)
#pragma unroll
            for (int m = 0; m < 4; ++m) { const int row = EPI_ROW(ai, m); const float rs = rstd_of(ss, row);
#pragma unroll
                for (int bj = 0; bj < 2; ++bj) { const int hc = EPI_COL(bj) >> 1; const f32x4 g = acc[ai][bj][m][0] * rs, up = acc[ai][bj][m][1] * rs; f32x4 h;
#pragma unroll
                    for (int j = 0; j < 4; ++j) h[j] = siluf(g[j]) * up[j];
                    u32x2 w; w.x = cvt_pk_bf16(h[0], h[1]); w.y = cvt_pk_bf16(h[2], h[3]); *(u32x2*)(H + (size_t)row * FF + hc) = w; } }
    }
};
#undef EPI_ARGS
}
#define MFMA16(X, Y, ACC) __builtin_amdgcn_mfma_f32_16x16x32_bf16((X), (Y), (ACC), 0, 0, 0)
#define WG_SYNC() do { asm volatile("s_waitcnt vmcnt(0) lgkmcnt(0)" ::: "memory"); __builtin_amdgcn_s_barrier(); asm volatile("" ::: "memory"); } while (0)
#define LDS_SYNC() do { asm volatile("s_waitcnt lgkmcnt(0)" ::: "memory"); __builtin_amdgcn_s_barrier(); asm volatile("" ::: "memory"); } while (0)
constexpr int LP = 136;
constexpr int LP64 = 72;
__device__ __forceinline__ bf16x8 lds_frag(const LAS bf16* base, int row, int pitch, int kofs) { return *(const LAS bf16x8*)(base + row * pitch + kofs); }
__device__ __forceinline__ u32x2 pack4(const f32x4 a) { u32x2 w; w.x = cvt_pk_bf16(a[0], a[1]); w.y = cvt_pk_bf16(a[2], a[3]); return w; }

template <int MAP, bool F16>
__device__ __forceinline__ void conv_item(const float* W, int ldw, int K, int n0, const float* gain, bf16* WT, int row_off, LAS float* scr, int item, int nblk, int lane) {
    const int kb = item / nblk, nb = item % nblk, k0 = 64 * kb, nn0 = 64 * nb;
    const int kr = lane >> 4, n4 = (lane & 15) * 4;
    const float* src = W + (size_t)(k0 + kr) * ldw + n0 + nn0 + n4;
    f32x4 v[16];
#pragma unroll
    for (int i = 0; i < 16; ++i) v[i] = *(const f32x4*)(src + (size_t)(4 * i) * ldw);
#pragma unroll
    for (int i = 0; i < 16; ++i) { f32x4 w = v[i]; if (gain) w = w * gain[k0 + 4 * i + kr];
        LAS float* d = scr + (4 * i + kr) * 65 + n4; d[0] = w[0]; d[1] = w[1]; d[2] = w[2]; d[3] = w[3]; }
    LDS_WAIT(); asm volatile("" ::: "memory");
    const int c = lane & 7, nbase = lane >> 3;
#pragma unroll
    for (int j = 0; j < 8; ++j) { const int n = nbase + 8 * j; const LAS float* s = scr + (8 * c) * 65 + n;
        u32x4 o; if (F16) { o.x = cvt_pk_f16(s[0 * 65], s[1 * 65]); o.y = cvt_pk_f16(s[2 * 65], s[3 * 65]); o.z = cvt_pk_f16(s[4 * 65], s[5 * 65]); o.w = cvt_pk_f16(s[6 * 65], s[7 * 65]); }
        else { o.x = cvt_pk_bf16(s[0 * 65], s[1 * 65]); o.y = cvt_pk_bf16(s[2 * 65], s[3 * 65]); o.z = cvt_pk_bf16(s[4 * 65], s[5 * 65]); o.w = cvt_pk_bf16(s[6 * 65], s[7 * 65]); }
        const int nn = nn0 + n; const int dr = MAP == 0 ? nn : ((nn >> 2) * 8 + (nn & 3) + (MAP == 2 ? 4 : 0));
        *(u32x4*)(WT + (size_t)(row_off + dr) * K + k0 + 8 * c) = o; }
    LDS_WAIT(); asm volatile("" ::: "memory");
}
__device__ __forceinline__ void conv_item_nat(const float* W, int ldw, const float* gain, bf16* WN, int item, int nblk, int lane) {
    const int kb = item / nblk, nb = item % nblk, k0 = 64 * kb, nn0 = 64 * nb;
    const int kr = lane >> 4, n4 = (lane & 15) * 4;
    const float* src = W + (size_t)(k0 + kr) * ldw + nn0 + n4; bf16* dst = WN + (size_t)(k0 + kr) * ldw + nn0 + n4;
    f32x4 v[16];
#pragma unroll
    for (int i = 0; i < 16; ++i) v[i] = *(const f32x4*)(src + (size_t)(4 * i) * ldw);
#pragma unroll
    for (int i = 0; i < 16; ++i) { const f32x4 w = v[i] * gain[k0 + 4 * i + kr]; *(u32x2*)(dst + (size_t)(4 * i) * ldw) = pack4(w); }
}
__device__ __forceinline__ void conv_matrix_nat(const float* W, int ldw, int K, const float* gain, bf16* WN, int gw, int NGW, int lane, int& rot) {
    const int nblk = ldw / 64, nitems = (K / 64) * nblk; int first = gw - rot; if (first < 0) first += NGW;
    for (int it = first; it < nitems; it += NGW) conv_item_nat(W, ldw, gain, WN, it, nblk, lane);
    rot = (rot + nitems) % NGW;
}
template <int MAP, bool F16 = false>
__device__ __forceinline__ void conv_matrix(const float* W, int ldw, int K, int n0, int ncols, const float* gain, bf16* WT, int row_off, LAS float* scr, int gw, int NGW, int lane, int& rot) {
    const int nblk = ncols / 64, nitems = (K / 64) * nblk; int first = gw - rot; if (first < 0) first += NGW;
    for (int it = first; it < nitems; it += NGW) conv_item<MAP, F16>(W, ldw, K, n0, gain, WT, row_off, scr, it, nblk, lane);
    rot = (rot + nitems) % NGW;
}

struct In {
    const float *x, *mem, *norm_mix, *norm_xattn, *norm_ffn, *norm_mem, *norm_final, *ab_w_in, *ab_w_out, *lru_conv_w, *lru_conv_b, *lru_w_r, *lru_b_r, *lru_w_i, *lru_b_i, *lru_lambda,
        *hgrn_lb, *hgrn_norm, *ssd_w_in, *ssd_w_out, *ssd_conv_w, *ssd_conv_b, *ssd_dt_bias, *ssd_a_log, *ssd_d, *ssd_norm, *xa_w_q, *xa_w_kv, *xa_w_o, *ffn_w_gate, *ffn_w_up, *ffn_w_down;
};

typedef const In __attribute__((address_space(4))) CIn;
__device__ __forceinline__ void convert_layer(CIn& I, int l, bf16* WL, LAS float* scr, int gw, int NGW, int lane, int& rot) {
    const int e = l >> 1;
    if ((l & 1) == 0) {
        conv_matrix<0, RF16>(I.ab_w_in + (size_t)e * D * ABIN, ABIN, D, 0, ABIN, I.norm_mix + l * D, WL + WL_IN, 0, scr, gw, NGW, lane, rot);
        conv_matrix<0>(I.ab_w_out + (size_t)e * D * D, D, D, 0, D, nullptr, WL + WL_OUT, 0, scr, gw, NGW, lane, rot);
    } else {
        conv_matrix<0, RF16>(I.ssd_w_in + (size_t)e * D * SSDPROJ, SSDPROJ, D, 0, SSDN1, I.norm_mix + l * D, WL + WL_IN, 0, scr, gw, NGW, lane, rot);
        conv_matrix<0, RF16>(I.ssd_w_in + (size_t)e * D * SSDPROJ, SSDPROJ, D, SSDN1, 64, I.norm_mix + l * D, WL + WL_DT, 0, scr, gw, NGW, lane, rot);
        for (int i = gw * 64 + lane; i < 192 * D / 8; i += NGW * 64) *(u32x4*)(WL + WL_DT + (size_t)64 * D + (size_t)i * 8) = (u32x4){0u, 0u, 0u, 0u};
        conv_matrix<0>(I.ssd_w_out + (size_t)e * SSDIN * D, D, SSDIN, 0, D, nullptr, WL + WL_OUT, 0, scr, gw, NGW, lane, rot);
    }
    conv_matrix_nat(I.xa_w_q + (size_t)l * D * D, D, D, I.norm_xattn + l * D, WL + WL_Q, gw, NGW, lane, rot);
    conv_matrix<0>(I.xa_w_o + (size_t)l * D * D, D, D, 0, D, nullptr, WL + WL_O, 0, scr, gw, NGW, lane, rot);
    conv_matrix<1, RF16>(I.ffn_w_gate + (size_t)l * D * FF, FF, D, 0, FF, I.norm_ffn + l * D, WL + WL_GU, 0, scr, gw, NGW, lane, rot);
    conv_matrix<2, RF16>(I.ffn_w_up + (size_t)l * D * FF, FF, D, 0, FF, I.norm_ffn + l * D, WL + WL_GU, 0, scr, gw, NGW, lane, rot);
    conv_matrix<0>(I.ffn_w_down + (size_t)l * FF * D, D, FF, 0, D, nullptr, WL + WL_DN, 0, scr, gw, NGW, lane, rot);
}

template <bool PASSB>
__device__ __forceinline__ void lru_units(const int tid, LAS unsigned char* lds, int G, int cu, const bf16* PROJ, const bf16* WRT, const float* cw, const float* cb, const float* br, const float* bi,
                                          const float* lam, float* SEG, bf16* YAB) {
    const int wid = __builtin_amdgcn_readfirstlane(tid >> 6), lane = tid & 63, q = lane >> 4, c16 = lane & 15;
    LAS bf16* XA = (LAS bf16*)(lds);
    LAS bf16* XC = (LAS bf16*)(lds + 35840);
    LAS bf16* WR = (LAS bf16*)(lds + 70656);
    LAS bf16* WI = (LAS bf16*)(lds + 105472);
    LAS float* PAR = (LAS float*)(lds + 140288);
    LAS float* WT = (LAS float*)(lds + 144384);
    LAS float* HIN = (LAS float*)(lds + 152576);
    int loadedj = -1;
    for (int u = cu; u < 1024; u += G) {
        const int j = u & 7, rest = u >> 3, b = rest >> 5, seg = rest & 31; const int t0 = b * SEQ + seg * 128;
        if (j != loadedj) {
            loadedj = j;
            for (int p = tid; p < 2 * 2048; p += NTHR) { const int g = p >> 11, pp = p & 2047, r = pp >> 4, pc = pp & 15;
                const u32x4 v = *(const u32x4*)(WRT + ((size_t)(g * 8 + j) * 128 + r) * 128 + pc * 8);
                *(LAS u32x4*)((g ? WI : WR) + r * LP + pc * 8) = v; }
            if (tid < 128) { const int ch = j * 128 + tid;
                PAR[0 * 128 + tid] = 8.0f * softplusf(-lam[ch]); PAR[1 * 128 + tid] = br[ch]; PAR[2 * 128 + tid] = bi[ch]; PAR[3 * 128 + tid] = cb[ch];
#pragma unroll
                for (int k = 0; k < 4; ++k) PAR[(4 + k) * 128 + tid] = cw[k * LRUW + ch]; }
        }
        for (int p = tid; p < 131 * 16; p += NTHR) { const int r = p >> 4, pc = p & 15; u32x4 v = (u32x4){0u, 0u, 0u, 0u};
            if (seg > 0 || r >= 3) v = *(const u32x4*)(PROJ + (size_t)(t0 + r - 3) * ABIN + j * 128 + pc * 8);
            *(LAS u32x4*)(XA + r * LP + pc * 8) = v; }
        if (PASSB) { if (tid < 128) { float h = 0.f; const float* sg = SEG + ((size_t)(b * 8 + j) * 32) * 256 + tid * 2;
                for (int s = 0; s < seg; ++s) { const f32x2 ab = *(const f32x2*)(sg + (size_t)s * 256); h = ab.x * h + ab.y; }
                HIN[tid] = h; } }
        WG_SYNC();
        {
            const int ch8 = tid & 15, tr = tid >> 4; u32x4 rows[7];
#pragma unroll
            for (int i = 0; i < 7; ++i) rows[i] = *(const LAS u32x4*)(XA + (4 * tr + i) * LP + ch8 * 8);
            float w[4][8], bb[8];
#pragma unroll
            for (int e = 0; e < 8; ++e) { bb[e] = PAR[3 * 128 + ch8 * 8 + e];
#pragma unroll
                for (int k = 0; k < 4; ++k) w[k][e] = PAR[(4 + k) * 128 + ch8 * 8 + e]; }
#pragma unroll
            for (int i = 0; i < 4; ++i) { float o[8];
#pragma unroll
                for (int e = 0; e < 8; ++e) { float a = bb[e];
#pragma unroll
                    for (int k = 0; k < 4; ++k) { const unsigned wd = rows[i + k][e >> 1]; a += w[k][e] * ((e & 1) ? bfhi(wd) : bflo(wd)); }
                    o[e] = a; }
                u32x4 pk; pk.x = cvt_pk_bf16(o[0], o[1]); pk.y = cvt_pk_bf16(o[2], o[3]); pk.z = cvt_pk_bf16(o[4], o[5]); pk.w = cvt_pk_bf16(o[6], o[7]);
                *(LAS u32x4*)(XC + (4 * tr + i) * LP + ch8 * 8) = pk; }
        }
        WG_SYNC();
        float PP[8][4], HH[8][4];
        {
            bf16x8 xf[4];
#pragma unroll
            for (int ks = 0; ks < 4; ++ks) xf[ks] = lds_frag(XC, 16 * wid + c16, LP, 32 * ks + 8 * q);
#pragma unroll
            for (int jb = 0; jb < 8; ++jb) {
                f32x4 aR = (f32x4){0.f, 0.f, 0.f, 0.f}, aI = aR;
#pragma unroll
                for (int ks = 0; ks < 4; ++ks) { aR = MFMA16(xf[ks], lds_frag(WR, 16 * jb + c16, LP, 32 * ks + 8 * q), aR); aI = MFMA16(xf[ks], lds_frag(WI, 16 * jb + c16, LP, 32 * ks + 8 * q), aI); }
                const int ch = 16 * jb + c16;
                const float sp8 = PAR[ch], pbr = PAR[128 + ch], pbi = PAR[256 + ch], pcb = PAR[384 + ch], w0 = PAR[512 + ch], w1 = PAR[640 + ch], w2 = PAR[768 + ch], w3 = PAR[896 + ch];
                float xr[7];
#pragma unroll
                for (int i = 0; i < 7; ++i) xr[i] = bf2f(XA[(16 * wid + 4 * q + i) * LP + ch]);
                float a[4], bt[4];
#pragma unroll
                for (int r = 0; r < 4; ++r) { const float xc = pcb + w0 * xr[r] + w1 * xr[r + 1] + w2 * xr[r + 2] + w3 * xr[r + 3];
                    const float rg = sigm(aR[r] + pbr), ig = sigm(aI[r] + pbi); const float la = -sp8 * rg;
                    const float av = __expf(la), x2 = 2.0f * la; a[r] = av;
                    const float om = (x2 > -0.02f) ? -x2 * (1.0f + x2 * (0.5f + x2 * 0.16666667f)) : 1.0f - av * av;
                    bt[r] = __builtin_amdgcn_sqrtf(fmaxf(om, 0.f)) * ig * xc; }
                float P[4], H[4]; P[0] = a[0]; H[0] = bt[0];
#pragma unroll
                for (int r = 1; r < 4; ++r) { P[r] = a[r] * P[r - 1]; H[r] = a[r] * H[r - 1] + bt[r]; }
                float Ae = 1.f, Be = 0.f, Aw = 1.f, Bw = 0.f;
#pragma unroll
                for (int qq = 0; qq < 4; ++qq) { const float Aq = __shfl(P[3], c16 + 16 * qq), Bq = __shfl(H[3], c16 + 16 * qq);
                    if (qq < q) { Be = Aq * Be + Bq; Ae = Aq * Ae; }
                    Bw = Aq * Bw + Bq; Aw = Aq * Aw; }
#pragma unroll
                for (int r = 0; r < 4; ++r) { PP[jb][r] = P[r] * Ae; HH[jb][r] = P[r] * Be + H[r]; }
                if (q == 0) *(LAS f32x2*)(WT + (wid * 128 + ch) * 2) = (f32x2){Aw, Bw};
            }
        }
        WG_SYNC();
        if (!PASSB) {
            if (tid < 128) { float A = 1.f, B = 0.f;
#pragma unroll
                for (int w = 0; w < 8; ++w) { const f32x2 ab = *(const LAS f32x2*)(WT + (w * 128 + tid) * 2); B = ab.x * B + ab.y; A = ab.x * A; }
                *(f32x2*)(SEG + ((size_t)(b * 8 + j) * 32 + seg) * 256 + tid * 2) = (f32x2){A, B}; }
        } else {
#pragma unroll
            for (int jb = 0; jb < 8; ++jb) { const int ch = 16 * jb + c16; float h0 = HIN[ch];
                for (int w = 0; w < wid; ++w) { const f32x2 ab = *(const LAS f32x2*)(WT + (w * 128 + ch) * 2); h0 = ab.x * h0 + ab.y; }
#pragma unroll
                for (int r = 0; r < 4; ++r) { const int t = t0 + 16 * wid + 4 * q + r; const float h = PP[jb][r] * h0 + HH[jb][r];
                    const float ga = bf2f(PROJ[(size_t)t * ABIN + 1024 + j * 128 + ch]);
                    YAB[(size_t)t * D + j * 128 + ch] = (bf16)f2bf(ga * h); } }
        }
        WG_SYNC();
    }
}

__device__ __forceinline__ void hgrn1_load(float (&lf)[16], unsigned (&vv)[16], const float* LOGF, const bf16* PROJ, int u, int k, int qt) {
    const int bh = u >> 6, c = u & 63, b = bh >> 3, h = bh & 7; const int t0 = b * SEQ + c * 64 + 16 * qt;
#pragma unroll
    for (int i = 0; i < 16; ++i) { lf[i] = LOGF[(size_t)(t0 + i) * 1024 + h * 128 + k]; vv[i] = PROJ[(size_t)(t0 + i) * ABIN + 4096 + h * 128 + k]; }
}
__device__ __forceinline__ void hgrn1_units(const int tid, LAS unsigned char* lds, int G, int cu, const float* LOGF, const bf16* PROJ, bf16* HST, float* HDEC) {
    const int wid = __builtin_amdgcn_readfirstlane(tid >> 6), lane = tid & 63, q = lane >> 4, c16 = lane & 15;
    LAS bf16* KT = (LAS bf16*)(lds);
    LAS bf16* VT = (LAS bf16*)(lds + 18432);
    LAS float* TOT = (LAS float*)(lds + 36864);
    const int k = tid & 127, qt = tid >> 7;
    float lf[16], nlf[16]; unsigned vv[16], nvv[16];
    if (cu < 2048) hgrn1_load(lf, vv, LOGF, PROJ, cu, k, qt);
    for (int u = cu; u < 2048; u += G) {
        if (u + G < 2048) hgrn1_load(nlf, nvv, LOGF, PROJ, u + G, k, qt);
        float cs[16];
        cs[0] = lf[0];
#pragma unroll
        for (int i = 1; i < 16; ++i) cs[i] = cs[i - 1] + lf[i];
        TOT[qt * 128 + k] = cs[15];
        LDS_SYNC();
        float pre = 0.f, last = 0.f;
#pragma unroll
        for (int qq = 0; qq < 4; ++qq) { const float t = TOT[qq * 128 + k]; if (qq < qt) pre += t; last += t; }
        unsigned kw[8], vw[8];
#pragma unroll
        for (int i = 0; i < 8; ++i) { const float k0 = (1.f - __expf(lf[2 * i])) * __expf(last - (pre + cs[2 * i])), k1 = (1.f - __expf(lf[2 * i + 1])) * __expf(last - (pre + cs[2 * i + 1]));
            kw[i] = cvt_pk_bf16(k0, k1); vw[i] = vv[2 * i] | (vv[2 * i + 1] << 16); }
        *(LAS u32x4*)(KT + k * LP64 + 16 * qt) = (u32x4){kw[0], kw[1], kw[2], kw[3]}; *(LAS u32x4*)(KT + k * LP64 + 16 * qt + 8) = (u32x4){kw[4], kw[5], kw[6], kw[7]};
        *(LAS u32x4*)(VT + k * LP64 + 16 * qt) = (u32x4){vw[0], vw[1], vw[2], vw[3]}; *(LAS u32x4*)(VT + k * LP64 + 16 * qt + 8) = (u32x4){vw[4], vw[5], vw[6], vw[7]};
        if (qt == 0) HDEC[(size_t)u * 128 + k] = __expf(last);
        LDS_SYNC();
        bf16x8 kf[2];
#pragma unroll
        for (int ks = 0; ks < 2; ++ks) kf[ks] = lds_frag(KT, 16 * wid + c16, LP64, 32 * ks + 8 * q);
#pragma unroll
        for (int vb = 0; vb < 8; ++vb) { f32x4 acc = (f32x4){0.f, 0.f, 0.f, 0.f};
#pragma unroll
            for (int ks = 0; ks < 2; ++ks) acc = MFMA16(kf[ks], lds_frag(VT, 16 * vb + c16, LP64, 32 * ks + 8 * q), acc);
            *(u32x2*)(HST + ((size_t)u * 128 + 16 * vb + c16) * 128 + 16 * wid + 4 * q) = pack4(acc); }
        LDS_SYNC();
#pragma unroll
        for (int i = 0; i < 16; ++i) { lf[i] = nlf[i]; vv[i] = nvv[i]; }
    }
    WG_SYNC();
}
__device__ __forceinline__ void hgrn2_scan(const int tid, int G, int cu, bf16* HST, const float* HDEC) {
    for (int task = cu * NTHR + tid; task < 32 * 4096; task += G * NTHR) {
        const int bh = task >> 12, e = (task & 4095) * 4; f32x4 S = (f32x4){0.f, 0.f, 0.f, 0.f};
        bf16* p0 = HST + (size_t)bh * 64 * 16384 + e; const float* d0 = HDEC + (size_t)bh * 64 * 128 + (e & 127);
#pragma unroll 1
        for (int cb = 0; cb < 64; cb += 16) { u32x2 L[16]; f32x4 d[16];
#pragma unroll
            for (int c = 0; c < 16; ++c) { L[c] = *(const u32x2*)(p0 + (size_t)(cb + c) * 16384); d[c] = *(const f32x4*)(d0 + (size_t)(cb + c) * 128); }
#pragma unroll
            for (int c = 0; c < 16; ++c) { *(u32x2*)(p0 + (size_t)(cb + c) * 16384) = pack4(S);
                S[0] = d[c][0] * S[0] + bflo(L[c].x); S[1] = d[c][1] * S[1] + bfhi(L[c].x); S[2] = d[c][2] * S[2] + bflo(L[c].y); S[3] = d[c][3] * S[3] + bfhi(L[c].y); } }
    }
}
__device__ __forceinline__ void hgrn3_load(float (&lf)[16], unsigned (&qv)[16], unsigned (&vv)[16], u32x4 (&st)[4], const float* LOGF, const bf16* PROJ, const bf16* HST, int u, int k, int qt, int tid) {
    const int bh = u >> 6, c = u & 63, b = bh >> 3, h = bh & 7; const int t0 = b * SEQ + c * 64 + 16 * qt;
#pragma unroll
    for (int i = 0; i < 16; ++i) { lf[i] = LOGF[(size_t)(t0 + i) * 1024 + h * 128 + k]; const bf16* pr = PROJ + (size_t)(t0 + i) * ABIN + h * 128 + k; qv[i] = pr[2048]; vv[i] = pr[4096]; }
#pragma unroll
    for (int i = 0; i < 4; ++i) { const int p = tid + NTHR * i, r = p >> 4, pc = p & 15; st[i] = *(const u32x4*)(HST + (size_t)u * 16384 + r * 128 + pc * 8); }
}
__device__ __forceinline__ void hgrn3_units(const int tid, LAS unsigned char* lds, int G, int cu, const float* LOGF, const bf16* PROJ, const bf16* HST, const float* hnorm, bf16* YAB) {
    const int wid = __builtin_amdgcn_readfirstlane(tid >> 6), lane = tid & 63, q = lane >> 4, c16 = lane & 15;
    LAS bf16* QH = (LAS bf16*)(lds);
    LAS bf16* QT = (LAS bf16*)(lds + 17408);
    LAS bf16* KH = (LAS bf16*)(lds + 34816);
    LAS bf16* VT = (LAS bf16*)(lds + 52224);
    LAS bf16* STL = (LAS bf16*)(lds + 70656);
    LAS bf16* PM = (LAS bf16*)(lds + 105472);
    LAS float* TOT = (LAS float*)(lds + 114688);
    LAS float* SQ = (LAS float*)(lds + 116736);
    const int k = tid & 127, qt = tid >> 7;
    float lf[16], nlf[16]; unsigned qv[16], nqv[16], vv[16], nvv[16]; u32x4 st[4], nst[4];
    if (cu < 2048) hgrn3_load(lf, qv, vv, st, LOGF, PROJ, HST, cu, k, qt, tid);
    for (int u = cu; u < 2048; u += G) {
        const int bh = u >> 6, c = u & 63, b = bh >> 3, h = bh & 7; const int tc = b * SEQ + c * 64;
        float cs[16];
        cs[0] = lf[0];
#pragma unroll
        for (int i = 1; i < 16; ++i) cs[i] = cs[i - 1] + lf[i];
        TOT[qt * 128 + k] = cs[15];
#pragma unroll
        for (int i = 0; i < 4; ++i) { const int p = tid + NTHR * i, r = p >> 4, pc = p & 15; *(LAS u32x4*)(STL + r * LP + pc * 8) = st[i]; }
        if (u + G < 2048) hgrn3_load(nlf, nqv, nvv, nst, LOGF, PROJ, HST, u + G, k, qt, tid);
        LDS_SYNC();
        float pre = 0.f;
#pragma unroll
        for (int qq = 0; qq < 4; ++qq) { const float t = TOT[qq * 128 + k]; if (qq < qt) pre += t; }
        const float ref = TOT[k] + TOT[128 + k];
        unsigned vw[8];
#pragma unroll
        for (int i = 0; i < 16; ++i) { const float cum = pre + cs[i], kk = 1.f - __expf(lf[i]), qf = bf2f((bf16)qv[i]);
            QT[(16 * qt + i) * LP + k] = (bf16)f2bf(qf * __expf(cum));
            QH[(16 * qt + i) * LP + k] = (bf16)f2bf(qf * __expf(fminf(cum - ref, 80.f)));
            KH[(16 * qt + i) * LP + k] = (bf16)f2bf(kk * __expf(fminf(ref - cum, 80.f))); }
#pragma unroll
        for (int i = 0; i < 8; ++i) vw[i] = vv[2 * i] | (vv[2 * i + 1] << 16);
        *(LAS u32x4*)(VT + k * LP64 + 16 * qt) = (u32x4){vw[0], vw[1], vw[2], vw[3]}; *(LAS u32x4*)(VT + k * LP64 + 16 * qt + 8) = (u32x4){vw[4], vw[5], vw[6], vw[7]};
        LDS_SYNC();
        {
            const int tb = wid & 3;
            bf16x8 qf[4];
#pragma unroll
            for (int ks = 0; ks < 4; ++ks) qf[ks] = lds_frag(QH, 16 * tb + c16, LP, 32 * ks + 8 * q);
#pragma unroll
            for (int sbi = 0; sbi < 2; ++sbi) { const int sb = 2 * (wid >> 2) + sbi; f32x4 acc = (f32x4){0.f, 0.f, 0.f, 0.f};
#pragma unroll
                for (int ks = 0; ks < 4; ++ks) acc = MFMA16(lds_frag(KH, 16 * sb + c16, LP, 32 * ks + 8 * q), qf[ks], acc);
                const int t = 16 * tb + c16, s0 = 16 * sb + 4 * q;
#pragma unroll
                for (int r = 0; r < 4; ++r) acc[r] = (s0 + r <= t) ? acc[r] : 0.f;
                *(LAS u32x2*)(PM + t * LP64 + s0) = pack4(acc); }
        }
        LDS_SYNC();
        {
            const int tb = wid & 3, vh = wid >> 2, t = 16 * tb + c16;
            bf16x8 qf[4], pf[2];
#pragma unroll
            for (int ks = 0; ks < 4; ++ks) qf[ks] = lds_frag(QT, t, LP, 32 * ks + 8 * q);
#pragma unroll
            for (int ks = 0; ks < 2; ++ks) pf[ks] = lds_frag(PM, t, LP64, 32 * ks + 8 * q);
            f32x4 acc[4]; float sq = 0.f;
#pragma unroll
            for (int vb = 0; vb < 4; ++vb) { const int vr = 64 * vh + 16 * vb + c16; acc[vb] = (f32x4){0.f, 0.f, 0.f, 0.f};
#pragma unroll
                for (int ks = 0; ks < 4; ++ks) acc[vb] = MFMA16(lds_frag(STL, vr, LP, 32 * ks + 8 * q), qf[ks], acc[vb]);
#pragma unroll
                for (int ks = 0; ks < 2; ++ks) acc[vb] = MFMA16(lds_frag(VT, vr, LP64, 32 * ks + 8 * q), pf[ks], acc[vb]);
                sq += (acc[vb][0] * acc[vb][0] + acc[vb][1] * acc[vb][1]) + (acc[vb][2] * acc[vb][2] + acc[vb][3] * acc[vb][3]); }
            sq += __shfl_xor(sq, 16); sq += __shfl_xor(sq, 32);
            if (q == 0) SQ[vh * 64 + t] = sq;
            LDS_SYNC();
            const float rstd = rsqrtf((SQ[t] + SQ[64 + t]) * (1.0f / 128.f) + EPS);
#pragma unroll
            for (int vb = 0; vb < 4; ++vb) { const int v0 = 64 * vh + 16 * vb + 4 * q; const f32x4 hn = *(const f32x4*)(hnorm + h * 128 + v0);
                const u32x2 gw = *(const u32x2*)(PROJ + (size_t)(tc + t) * ABIN + 5120 + h * 128 + v0);
                f32x4 y; y[0] = acc[vb][0] * rstd * hn[0] * bflo(gw.x); y[1] = acc[vb][1] * rstd * hn[1] * bfhi(gw.x); y[2] = acc[vb][2] * rstd * hn[2] * bflo(gw.y); y[3] = acc[vb][3] * rstd * hn[3] * bfhi(gw.y);
                *(u32x2*)(YAB + (size_t)(tc + t) * D + 1024 + h * 128 + v0) = pack4(y); }
        }
        LDS_SYNC();
#pragma unroll
        for (int i = 0; i < 16; ++i) { lf[i] = nlf[i]; qv[i] = nqv[i]; vv[i] = nvv[i]; }
#pragma unroll
        for (int i = 0; i < 4; ++i) st[i] = nst[i];
    }
    WG_SYNC();
}
__device__ __forceinline__ void ssd_prep_load(u32x4 (&rows)[7], const bf16* XBC, int u, int ch8, int tr) {
    const int bc = u / 48, cblk = u % 48, c = bc & 31; const bf16* src = XBC + (size_t)(bc * 128 + 4 * tr - 3) * SSDCONV + cblk * 128 + ch8 * 8;
#pragma unroll
    for (int i = 0; i < 7; ++i) { rows[i] = (u32x4){0u, 0u, 0u, 0u}; if (c > 0 || 4 * tr + i >= 3) rows[i] = *(const u32x4*)(src + (size_t)i * SSDCONV); }
}
__device__ __forceinline__ void ssd_prep_units(const int tid, LAS unsigned char* lds, int ufirst, int ustride, int uend, const bf16* XBC, const float* cw, const float* cb, bf16* XBT, bf16* BCN) {
    LAS bf16* T = (LAS bf16*)(lds);
    const int ch8 = tid & 15, tr = tid >> 4;
    u32x4 rows[7], nrows[7];
    if (ufirst < uend) ssd_prep_load(rows, XBC, ufirst, ch8, tr);
    for (int u = ufirst; u < uend; u += ustride) {
        const int bc = u / 48, cblk = u % 48; const int t0 = bc * 128; const int ch0 = cblk * 128 + ch8 * 8;
        if (u + ustride < uend) ssd_prep_load(nrows, XBC, u + ustride, ch8, tr);
        float w[4][8], bb[8];
        { const f32x4 b0 = *(const f32x4*)(cb + ch0), b1 = *(const f32x4*)(cb + ch0 + 4);
#pragma unroll
          for (int e = 0; e < 4; ++e) { bb[e] = b0[e]; bb[4 + e] = b1[e]; }
#pragma unroll
          for (int k = 0; k < 4; ++k) { const f32x4 w0 = *(const f32x4*)(cw + (size_t)k * SSDCONV + ch0), w1 = *(const f32x4*)(cw + (size_t)k * SSDCONV + ch0 + 4);
#pragma unroll
              for (int e = 0; e < 4; ++e) { w[k][e] = w0[e]; w[k][4 + e] = w1[e]; } } }
        u32x4 ov[4];
#pragma unroll
        for (int i = 0; i < 4; ++i) { float o[8];
#pragma unroll
            for (int e = 0; e < 8; ++e) { float a = bb[e];
#pragma unroll
                for (int k = 0; k < 4; ++k) { const unsigned wd = rows[i + k][e >> 1]; a += w[k][e] * ((e & 1) ? bfhi(wd) : bflo(wd)); }
                o[e] = siluf(a); }
            u32x4 pk; pk.x = cvt_pk_bf16(o[0], o[1]); pk.y = cvt_pk_bf16(o[2], o[3]); pk.z = cvt_pk_bf16(o[4], o[5]); pk.w = cvt_pk_bf16(o[6], o[7]);
            if (cblk >= 32) *(u32x4*)(BCN + (size_t)(t0 + 4 * tr + i) * 2048 + (ch0 - 4096)) = pk;
            ov[i] = pk; }
        if (cblk < 40) {
#pragma unroll
            for (int e = 0; e < 8; ++e) { u32x2 w;
                const unsigned a0 = ov[0][e >> 1], a1 = ov[1][e >> 1], a2 = ov[2][e >> 1], a3 = ov[3][e >> 1];
                if (e & 1) { w.x = (a0 >> 16) | (a1 & 0xffff0000u); w.y = (a2 >> 16) | (a3 & 0xffff0000u); } else { w.x = (a0 & 0xffffu) | (a1 << 16); w.y = (a2 & 0xffffu) | (a3 << 16); }
                *(LAS u32x2*)(T + (ch8 * 8 + e) * LP + 8 * ((tr >> 1) ^ ch8) + 4 * (tr & 1)) = w; }
            LDS_SYNC();
#pragma unroll
            for (int i = 0; i < 4; ++i) { const int p = tid + NTHR * i, r = p >> 4, pc = p & 15;
                *(u32x4*)(XBT + ((size_t)bc * 5120 + cblk * 128 + r) * 128 + pc * 8) = *(const LAS u32x4*)(T + r * LP + 8 * (pc ^ (r >> 3))); }
            LDS_SYNC();
        }
#pragma unroll
        for (int i = 0; i < 7; ++i) rows[i] = nrows[i];
    }
    WG_SYNC();
}
__device__ __forceinline__ float ssd_tables(const float* DT, const float* a_log, int t0, int hd, int wid, int lane, LAS float* CUM, LAS float* DTS) {
    const float an = -__expf(a_log[hd]);
    const float d0 = DT[(size_t)(t0 + 2 * lane) * 64 + hd], d1 = DT[(size_t)(t0 + 2 * lane + 1) * 64 + hd];
    const float a0 = d0 * an, a1 = d1 * an; float v = a0 + a1;
#pragma unroll
    for (int o = 1; o < 64; o <<= 1) { const float t = __shfl_up(v, o); if (lane >= o) v += t; }
    CUM[wid * 128 + 2 * lane] = v - a1; CUM[wid * 128 + 2 * lane + 1] = v; DTS[wid * 128 + 2 * lane] = d0; DTS[wid * 128 + 2 * lane + 1] = d1;
    return __shfl(v, 63);
}
__device__ __forceinline__ void ssd1_units(const int tid, LAS unsigned char* lds, int G, int cu, const bf16* XBT, const float* DT, const float* a_log, bf16* ST, float* DEC) {
    const int wid = __builtin_amdgcn_readfirstlane(tid >> 6), lane = tid & 63, q = lane >> 4, c16 = lane & 15;
    LAS bf16* BT = (LAS bf16*)(lds);
    LAS float* CUM = (LAS float*)(lds + 34816);
    LAS float* DTS = (LAS float*)(lds + 38912);
    for (int u = cu; u < 1024; u += G) {
        const int bc = u >> 3, g = u & 7, t0 = bc * 128, hd = g * 8 + wid;
#pragma unroll
        for (int i = 0; i < 4; ++i) { const int p = tid + NTHR * i, r = p >> 4, pc = p & 15;
            *(LAS u32x4*)(BT + r * LP + pc * 8) = *(const u32x4*)(XBT + ((size_t)bc * 5120 + 4096 + g * 128 + r) * 128 + pc * 8); }
        const float last = ssd_tables(DT, a_log, t0, hd, wid, lane, CUM, DTS);
        if (lane == 0) DEC[bc * 64 + hd] = __expf(last);
        u32x4 xr[4][4];
#pragma unroll
        for (int pb = 0; pb < 4; ++pb)
#pragma unroll
            for (int ks = 0; ks < 4; ++ks) xr[pb][ks] = *(const u32x4*)(XBT + ((size_t)bc * 5120 + hd * 64 + 16 * pb + c16) * 128 + 32 * ks + 8 * q);
        WG_SYNC();
        bf16x8 xf[4][4];
#pragma unroll
        for (int ks = 0; ks < 4; ++ks) { float sc[8];
#pragma unroll
            for (int j = 0; j < 8; ++j) { const int s = 32 * ks + 8 * q + j; sc[j] = DTS[wid * 128 + s] * __expf(last - CUM[wid * 128 + s]); }
#pragma unroll
            for (int pb = 0; pb < 4; ++pb) { u32x4 o;
#pragma unroll
                for (int e = 0; e < 4; ++e) o[e] = cvt_pk_bf16(bflo(xr[pb][ks][e]) * sc[2 * e], bfhi(xr[pb][ks][e]) * sc[2 * e + 1]);
                xf[pb][ks] = __builtin_bit_cast(bf16x8, o); } }
#pragma unroll
        for (int nb = 0; nb < 8; ++nb) { bf16x8 bf[4];
#pragma unroll
            for (int ks = 0; ks < 4; ++ks) bf[ks] = lds_frag(BT, 16 * nb + c16, LP, 32 * ks + 8 * q);
#pragma unroll
            for (int pb = 0; pb < 4; ++pb) { f32x4 acc = (f32x4){0.f, 0.f, 0.f, 0.f};
#pragma unroll
                for (int ks = 0; ks < 4; ++ks) acc = MFMA16(bf[ks], xf[pb][ks], acc);
                *(u32x2*)(ST + (((size_t)bc * 64 + hd) * 64 + 16 * pb + c16) * 128 + 16 * nb + 4 * q) = pack4(acc); } }
        WG_SYNC();
    }
}
__device__ __forceinline__ void ssd2_scan(const int tid, int G, int cu, bf16* ST, const float* DEC) {
    for (int task = cu * NTHR + tid; task < NB * 4096 * 32; task += G * NTHR) {
        const int b = task >> 17, r = task & 131071, hp = r >> 5, n4 = (r & 31) * 4, hd = hp >> 6; f32x4 S = (f32x4){0.f, 0.f, 0.f, 0.f};
        bf16* p0 = ST + ((size_t)(b * 32) * 4096 + hp) * 128 + n4; const float* d0 = DEC + (b * 32) * 64 + hd;
        u32x2 L[32]; float d[32];
#pragma unroll
        for (int c = 0; c < 32; ++c) { L[c] = *(const u32x2*)(p0 + (size_t)c * 4096 * 128); d[c] = d0[c * 64]; }
#pragma unroll
        for (int c = 0; c < 32; ++c) { *(u32x2*)(p0 + (size_t)c * 4096 * 128) = pack4(S);
            S[0] = d[c] * S[0] + bflo(L[c].x); S[1] = d[c] * S[1] + bfhi(L[c].x); S[2] = d[c] * S[2] + bflo(L[c].y); S[3] = d[c] * S[3] + bfhi(L[c].y); }
    }
}
__device__ __forceinline__ void ssd3_units(const int tid, LAS unsigned char* lds, int G, int cu, const bf16* XBT, const bf16* BCN, const bf16* ST, const float* DT, const float* a_log, const float* dskip,
                                           const bf16* Z, const float* normw, bf16* Y) {
    const int wid = __builtin_amdgcn_readfirstlane(tid >> 6), lane = tid & 63, q = lane >> 4, c16 = lane & 15;
    LAS bf16* CN = (LAS bf16*)(lds);
    LAS bf16* BN = (LAS bf16*)(lds + 34816);
    LAS bf16* CB = (LAS bf16*)(lds + 69632);
    LAS float* CUM = (LAS float*)(lds + 104448);
    LAS float* DTS = (LAS float*)(lds + 108544);
    LAS float* SQP = (LAS float*)(lds + 112640);
    for (int u = cu; u < 1024; u += G) {
        const int bc = u >> 3, g = u & 7, t0 = bc * 128, hd = g * 8 + wid;
#pragma unroll
        for (int i = 0; i < 4; ++i) { const int p = tid + NTHR * i, r = p >> 4, pc = p & 15; const bf16* src = BCN + (size_t)(t0 + r) * 2048 + g * 128 + pc * 8;
            *(LAS u32x4*)(BN + r * LP + pc * 8) = *(const u32x4*)src; *(LAS u32x4*)(CN + r * LP + pc * 8) = *(const u32x4*)(src + 1024); }
        (void)ssd_tables(DT, a_log, t0, hd, wid, lane, CUM, DTS);
        bf16x8 sf[4][4];
        const bf16* xb = XBT + ((size_t)bc * 5120 + hd * 64 + c16) * 128 + 8 * q;
        { const bf16* sb = ST + (((size_t)bc * 64 + hd) * 64 + c16) * 128 + 8 * q;
#pragma unroll
          for (int pb = 0; pb < 4; ++pb)
#pragma unroll
              for (int ks = 0; ks < 4; ++ks) sf[pb][ks] = *(const bf16x8*)(sb + (size_t)(16 * pb) * 128 + 32 * ks); }
        WG_SYNC();
        {
            bf16x8 cf[4];
#pragma unroll
            for (int ks = 0; ks < 4; ++ks) cf[ks] = lds_frag(CN, 16 * wid + c16, LP, 32 * ks + 8 * q);
#pragma unroll
            for (int sb = 0; sb < 8; ++sb) { if (sb > wid + 1) continue; f32x4 acc = (f32x4){0.f, 0.f, 0.f, 0.f};
#pragma unroll
                for (int ks = 0; ks < 4; ++ks) acc = MFMA16(lds_frag(BN, 16 * sb + c16, LP, 32 * ks + 8 * q), cf[ks], acc);
                *(LAS u32x2*)(CB + (16 * wid + c16) * LP + 16 * sb + 4 * q) = pack4(acc); }
        }
        WG_SYNC();
        const float dsk = dskip[hd];
        bf16* ybase = Y + (size_t)t0 * SSDIN + hd * 64 + 4 * q; const bf16* zbase = Z + (size_t)t0 * SSDIN + hd * 64 + 4 * q;
        const f32x4 nw0 = *(const f32x4*)(normw + hd * 64 + 4 * q), nw1 = *(const f32x4*)(normw + hd * 64 + 16 + 4 * q), nw2 = *(const f32x4*)(normw + hd * 64 + 32 + 4 * q), nw3 = *(const f32x4*)(normw + hd * 64 + 48 + 4 * q);
#pragma unroll 1
        for (int tp = 0; tp < 8; ++tp) {
        u32x2 yk[1][4];
#pragma unroll
        for (int tt = 0; tt < 1; ++tt) { const int tb = tp;
            const int tl = 16 * tb + c16; const float cumt = CUM[wid * 128 + tl], ect = __expf(cumt);
            f32x4 acc[4];
            { bf16x8 cf[4];
#pragma unroll
              for (int ks = 0; ks < 4; ++ks) cf[ks] = lds_frag(CN, tl, LP, 32 * ks + 8 * q);
#pragma unroll
              for (int pb = 0; pb < 4; ++pb) { acc[pb] = (f32x4){0.f, 0.f, 0.f, 0.f};
#pragma unroll
                  for (int ks = 0; ks < 4; ++ks) acc[pb] = MFMA16(sf[pb][ks], cf[ks], acc[pb]);
                  acc[pb] = acc[pb] * ect; } }
#pragma unroll
            for (int ks = 0; ks < 4; ++ks) { if (32 * ks > 16 * tb + 15) continue;
                const int s0 = 32 * ks + 8 * q; const u32x4 cbw = *(const LAS u32x4*)(CB + tl * LP + s0);
                const f32x4 c0 = *(const LAS f32x4*)(CUM + wid * 128 + s0), c1 = *(const LAS f32x4*)(CUM + wid * 128 + s0 + 4), d0 = *(const LAS f32x4*)(DTS + wid * 128 + s0), d1 = *(const LAS f32x4*)(DTS + wid * 128 + s0 + 4);
                float gv[8];
#pragma unroll
                for (int j = 0; j < 8; ++j) { const int s = s0 + j; const float cb = (j & 1) ? bfhi(cbw[j >> 1]) : bflo(cbw[j >> 1]); const float cs = j < 4 ? c0[j & 3] : c1[j & 3], ds = j < 4 ? d0[j & 3] : d1[j & 3];
                    float v = cb * __expf(fminf(cumt - cs, 0.f)) * ds; v = (s <= tl) ? v : 0.f; gv[j] = (s == tl) ? v + dsk : v; }
                u32x4 gw; gw.x = cvt_pk_bf16(gv[0], gv[1]); gw.y = cvt_pk_bf16(gv[2], gv[3]); gw.z = cvt_pk_bf16(gv[4], gv[5]); gw.w = cvt_pk_bf16(gv[6], gv[7]);
                const bf16x8 gf = __builtin_bit_cast(bf16x8, gw);
#pragma unroll
                for (int pb = 0; pb < 4; ++pb) acc[pb] = MFMA16(*(const bf16x8*)(xb + (size_t)(16 * pb) * 128 + 32 * ks), gf, acc[pb]);
            }
            float sq = 0.f;
#pragma unroll
            for (int pb = 0; pb < 4; ++pb) { const u32x2 zw = *(const u32x2*)(zbase + (size_t)tl * SSDIN + 16 * pb);
                f32x4 y; y[0] = acc[pb][0] * bflo(zw.x); y[1] = acc[pb][1] * bfhi(zw.x); y[2] = acc[pb][2] * bflo(zw.y); y[3] = acc[pb][3] * bfhi(zw.y);
                sq += (y[0] * y[0] + y[1] * y[1]) + (y[2] * y[2] + y[3] * y[3]); yk[tt][pb] = pack4(y); }
            sq += __shfl_xor(sq, 16); sq += __shfl_xor(sq, 32);
            if (q == 0) SQP[tl * 8 + wid] = sq;
        }
        WG_SYNC();
#pragma unroll
        for (int tt = 0; tt < 1; ++tt) { const int tl = 16 * tp + c16; const f32x4 s0 = *(const LAS f32x4*)(SQP + tl * 8), s1 = *(const LAS f32x4*)(SQP + tl * 8 + 4);
            const float rstd = rsqrtf((((s0[0] + s0[1]) + (s0[2] + s0[3])) + ((s1[0] + s1[1]) + (s1[2] + s1[3]))) * (1.0f / 512.f) + EPS);
#pragma unroll
            for (int pb = 0; pb < 4; ++pb) { bf16* yp = ybase + (size_t)tl * SSDIN + 16 * pb; const u32x2 w = yk[tt][pb]; const f32x4 nw = pb == 0 ? nw0 : pb == 1 ? nw1 : pb == 2 ? nw2 : nw3;
                f32x4 y; y[0] = bflo(w.x) * rstd * nw[0]; y[1] = bfhi(w.x) * rstd * nw[1]; y[2] = bflo(w.y) * rstd * nw[2]; y[3] = bfhi(w.y) * rstd * nw[3];
                *(u32x2*)yp = pack4(y); } }
        }
        WG_SYNC();
    }
}
#ifndef REP_GEMM
#define REP_GEMM 1
#endif
#if REP_GEMM == 2
#define GEMM_REP(...) { __VA_ARGS__ } { __VA_ARGS__ }
#else
#define GEMM_REP(...) { __VA_ARGS__ }
#endif
#ifndef REP_MIX
#define REP_MIX 1
#endif
#ifndef REP_CONV
#define REP_CONV 1
#endif
struct Args { In in; float* out; unsigned char* ws; int ph_lo, ph_hi; };
static_assert(sizeof(Args) == 32 * 8 + 8 + 8 + 8, "Args has no padding");
typedef const Args __attribute__((address_space(4))) CArgs;

#ifndef SLEEP_MASK
#define SLEEP_MASK 0ull
#endif
#define SLEEP_AMP 4
#define PHASE_BEGIN if (pc >= lo && pc < hi) { const unsigned long long t0_ = SLEEP_MASK ? __builtin_amdgcn_s_memrealtime() : 0ull; (void)t0_; int tid = wave0 * 64 + (int)__builtin_amdgcn_mbcnt_hi(~0u, __builtin_amdgcn_mbcnt_lo(~0u, 0u)); asm volatile("" : "+v"(tid)); int cu = blockIdx.x; asm volatile("" : "+s"(cu)); int G = gridDim.x; asm volatile("" : "+s"(G)); \
        const int lane = tid & 63, wave = __builtin_amdgcn_readfirstlane(tid >> 6), gw = cu * NWAVES + wave, NGW = G * NWAVES; (void)lane; (void)gw; (void)NGW; \
        CArgs* ap = (CArgs*)__builtin_amdgcn_kernarg_segment_ptr(); asm volatile("" : "+s"(ap)); CIn& I = ap->in; unsigned char* const ws = ap->ws; float* const xres = ap->out; \
        unsigned char* const act = ws + WS_ACT; float* const SS = (float*)(ws + WS_SS); bf16* const XB = (bf16*)(ws + WS_XB); bf16* const WL = (bf16*)(ws + WS_WL); (void)I; (void)xres; (void)act; (void)SS; (void)XB; (void)WL;
#if MK_SPLIT
#define PHASE_END } ++pc;
#else
#define PHASE_END if (pc + 1 < hi) xcd_barrier(bar); if (SLEEP_MASK && ((SLEEP_MASK >> pc) & 1ull)) { const unsigned long long t1_ = __builtin_amdgcn_s_memrealtime(), until_ = t1_ + SLEEP_AMP * (t1_ - t0_); while (__builtin_amdgcn_s_memrealtime() < until_) __builtin_amdgcn_s_sleep(8); } } ++pc;
#endif
#define PHASE_END_LOCAL } ++pc;
#define D_WKV ((bf16*)(ws + WS_WKV))
#define D_KMAT ((bf16*)(ws + WS_KMAT))
#define D_VT ((bf16*)(ws + WS_VT))
#define D_MEMN ((bf16*)(ws + WS_MEMN))
#define D_LB ((float*)(ws + WS_TAB + TAB_LB))
#define D_WRT ((bf16*)(ws + WS_TAB + TAB_WRT))


template <int l>
__device__ __forceinline__ void layer_body(LAS unsigned char* lds, const int wave0, const int lo, const int hi, int& pc, const XcdBarrier& bar) {
    int ssi = 3 * l;
#define WLL ((bf16*)(ws + ((l & 1) ? WS_WL2 : WS_WL)))
#define WLN ((bf16*)(ws + ((l & 1) ? WS_WL : WS_WL2)))

        const int e = l >> 1;
        int mixK;
        if ((l & 1) == 0) {
#define PROJ ((bf16*)(act + A_PROJ))
#define LOGF ((float*)(act + A_LOGF))
#define HST ((bf16*)(act + A_HST))
#define YAB ((bf16*)(act + A_YAB))
#define SEG ((float*)(act + A_SEG))
#define HDEC ((float*)(act + A_HDEC))
            PHASE_BEGIN
                if (l == 0) { pg8::SchedKV S{(const char*)D_MEMN, (const char*)D_WKV, G, cu}; pg8::EpiKV E{D_KMAT, D_VT}; pg8::gemm_phase(tid, lds, D, D, D, S, E); asm volatile("" : "+v"(tid)); }
                GEMM_REP(pg8::SchedMN S; S.init(XB, D, WLL + WL_IN, D, M, ABIN, G, cu); pg8::EpiProjEven E{SS + (size_t)ssi * M * 8, PROJ, LOGF, D_LB + e * 1024};
                pg8::gemm_phase<RF16>(tid, lds, D, D, D, S, E);)
            PHASE_END
            PHASE_BEGIN
                for (int rep_ = 0; rep_ < REP_MIX; ++rep_) { lru_units<false>(tid, lds, G, cu, PROJ, D_WRT + (size_t)e * 2 * 8 * 16384, I.lru_conv_w + e * 4 * LRUW, I.lru_conv_b + e * LRUW, I.lru_b_r + e * LRUW, I.lru_b_i + e * LRUW, I.lru_lambda + e * LRUW, SEG, YAB);
                hgrn1_units(tid, lds, G, cu, LOGF, PROJ, HST, HDEC); }
            PHASE_END
            PHASE_BEGIN
                for (int rep_ = 0; rep_ < REP_MIX; ++rep_) { lru_units<true>(tid, lds, G, cu, PROJ, D_WRT + (size_t)e * 2 * 8 * 16384, I.lru_conv_w + e * 4 * LRUW, I.lru_conv_b + e * LRUW, I.lru_b_r + e * LRUW, I.lru_b_i + e * LRUW, I.lru_lambda + e * LRUW, SEG, YAB); }
                hgrn2_scan(tid, G, cu, HST, HDEC);
            PHASE_END
            PHASE_BEGIN
                for (int rep_ = 0; rep_ < REP_MIX; ++rep_) { hgrn3_units(tid, lds, G, cu, LOGF, PROJ, HST, I.hgrn_norm + e * 1024, YAB); }
            PHASE_END
            mixK = D;
        } else {
#define Zb ((bf16*)(act + A_Z))
#define XBC ((bf16*)(act + A_XBC))
#define XBT ((bf16*)(act + A_XBT))
#define BCN ((bf16*)(act + A_BCN))
#define STb ((bf16*)(act + A_ST))
#define DTb ((float*)(act + A_DT))
#define DEC ((float*)(act + A_DEC))
#define Yb ((bf16*)(act + A_Y))
            PHASE_BEGIN
                GEMM_REP(pg8::SchedMN S; S.init(XB, D, WLL + WL_IN, D, M, SSDN1, G, cu); pg8::EpiProjOdd E{SS + (size_t)ssi * M * 8, Zb, XBC};
                pg8::gemm_phase<RF16>(tid, lds, D, D, D, S, E);)
            PHASE_END
            PHASE_BEGIN
                for (int rep_ = 0; rep_ < REP_MIX; ++rep_) {
                { pg8::SchedDt S{(const char*)XB, (const char*)(WLL + WL_DT), cu}; pg8::EpiDt E{SS + (size_t)ssi * M * 8, I.ssd_dt_bias + e * 64, DTb};
                  pg8::gemm_phase<RF16>(tid, lds, D, D, D, S, E); }
                { int uf = cu, us = G, ue = 6144; if (G == 256) { if (cu < 64) { us = 64; ue = 1152; } else { uf = 1152 + (cu - 64); us = 192; } }
                  ssd_prep_units(tid, lds, uf, us, ue, XBC, I.ssd_conv_w + (size_t)e * 4 * SSDCONV, I.ssd_conv_b + e * SSDCONV, XBT, BCN); }
                }
            PHASE_END
            PHASE_BEGIN
                for (int rep_ = 0; rep_ < REP_MIX; ++rep_) { ssd1_units(tid, lds, G, cu, XBT, DTb, I.ssd_a_log + e * 64, STb, DEC); }
            PHASE_END
            PHASE_BEGIN
                ssd2_scan(tid, G, cu, STb, DEC);
            PHASE_END
            PHASE_BEGIN
                for (int rep_ = 0; rep_ < REP_MIX; ++rep_) { ssd3_units(tid, lds, G, cu, XBT, BCN, STb, DTb, I.ssd_a_log + e * 64, I.ssd_d + e * 64, Zb, I.ssd_norm + e * SSDIN, Yb); }
            PHASE_END
            mixK = SSDIN;
        }
#define KQb ((bf16*)(act + A_Q))
#define VWb ((bf16*)(act + A_VW))
#define Pb ((bf16*)(act + A_P))
#define Hb ((bf16*)(act + A_H))
        PHASE_BEGIN
            { pg8::SchedMN S; S.init(mixK == D ? (const bf16*)YAB : (const bf16*)Yb, mixK, WLL + WL_OUT, mixK, M, D, G, cu); pg8::EpiResid E{XB, SS + (size_t)(ssi + 1) * M * 8, (LAS float*)(lds + EPI_OFF)};
              pg8::gemm_phase(tid, lds, mixK, mixK, mixK, S, E); asm volatile("" : "+v"(tid)); }
            if (cu < 256) { int nu = 1, kk = XAD; asm volatile("" : "+s"(nu), "+s"(kk)); const int iskq = cu < 128, idx = cu & 127, bh = idx >> 3, t8 = idx & 7, b = bh >> 2, h = bh & 3;
                const bf16* Km = D_KMAT + (size_t)l * MEMROWS * D; const bf16* Vm = D_VT + (size_t)l * MEMROWS * D;
                pg8::SchedOne S; S.n = nu;
                S.u0.a = iskq ? (const char*)(Km + (size_t)(b * MEMLEN) * D + h * XAD) : (const char*)(WLL + WL_O + (size_t)(t8 * 256) * D + h * XAD);
                S.u0.b = iskq ? (const char*)(WLL + WL_Q + (size_t)(t8 * 256) * D + h * XAD) : (const char*)(Vm + (size_t)(b * MEMLEN) * D + h * XAD);
                S.u0.orow = iskq ? bh * 256 : t8 * 256; S.u0.ocol = iskq ? t8 * 256 : h * 256; S.u0.aux = 0;
                pg8::EpiPlain E{iskq ? KQb : VWb + (size_t)b * D * 1024, iskq ? D : 1024}; pg8::gemm_phase(tid, lds, kk, D, D, S, E); }
        PHASE_END
        ++ssi;
        PHASE_BEGIN
            static_assert(!RF16, "the absorbed key matrix is bf16: the residual stream must be bf16 too");
            if (cu < 256) { const int pm = (cu & 7) * 8 + (cu >> 5), h = (cu >> 3) & 3;     int nu = 1; asm volatile("" : "+s"(nu));
                pg8::SchedOne S; S.n = nu; S.u0.a = (const char*)(XB + (size_t)pm * 256 * D); S.u0.b = (const char*)(KQb + (size_t)(((pm >> 4) * 4 + h) * 256) * D); S.u0.orow = pm * 256; S.u0.ocol = h * 256; S.u0.aux = 0;
                pg8::EpiSoftmax E{SS + (size_t)ssi * M * 8, 0.044194173824159216f, Pb, (LAS float*)(lds + EPI_OFF)}; pg8::gemm_phase(tid, lds, D, D, D, S, E); }
        PHASE_END
        PHASE_BEGIN
            pg8::SchedMNB S; S.init(Pb, 1024, VWb, 1024, M, D, G, cu, (size_t)D * 1024 * 2); pg8::EpiResid E{XB, SS + (size_t)(ssi + 1) * M * 8, (LAS float*)(lds + EPI_OFF)};
            pg8::gemm_phase(tid, lds, 1024, 1024, 1024, S, E);
        PHASE_END
        ++ssi;
        PHASE_BEGIN
            if (l + 1 < DEPTH && (cu & 1)) { int rot = 0; convert_layer(I, l + 1, WLN, (LAS float*)(lds + wave * 16640), gw, NGW, lane, rot); WG_SYNC(); asm volatile("" : "+v"(tid)); }
            GEMM_REP(pg8::SchedMN S; S.init(XB, D, WLL + WL_GU, D, M, 2 * FF, G, cu); pg8::EpiGateUp E{SS + (size_t)ssi * M * 8, Hb};
            pg8::gemm_phase<RF16>(tid, lds, D, D, D, S, E);)
            if (l + 1 < DEPTH && !(cu & 1)) { asm volatile("" : "+v"(tid)); const int lane2 = tid & 63, wave2 = __builtin_amdgcn_readfirstlane(tid >> 6); int rot = 0; convert_layer(I, l + 1, WLN, (LAS float*)(lds + wave2 * 16640), cu * NWAVES + wave2, NGW, lane2, rot); }
        PHASE_END
        PHASE_BEGIN
            pg8::SchedMN S; S.init(Hb, FF, WLL + WL_DN, FF, M, D, G, cu); pg8::EpiResid E{XB, SS + (size_t)(ssi + 1) * M * 8, (LAS float*)(lds + EPI_OFF)};
            pg8::gemm_phase(tid, lds, FF, FF, FF, S, E);
        PHASE_END
        ++ssi;
    }

__global__ void __launch_bounds__(NTHR, 2) fwd(Args args) {
    extern __shared__ __attribute__((aligned(16))) unsigned char lds_raw[];
    LAS unsigned char* lds = (LAS unsigned char*)lds_raw;
    volatile LAS unsigned* MISC = (volatile LAS unsigned*)(lds + MISC_OFF);
    const int wave0 = __builtin_amdgcn_readfirstlane((int)threadIdx.x >> 6);
    if (threadIdx.x < 64) MISC[threadIdx.x] = 0u;
    __syncthreads();
#if !MK_SPLIT
    XcdBarrier bar = xcd_barrier_post((unsigned*)(args.ws + WS_CTL), MISC + 8);
#else
    XcdBarrier bar; bar.bar = nullptr; bar.x = 0; bar.st = nullptr;
#endif
    const int lo = args.ph_lo, hi = args.ph_hi; int pc = 0;
    PHASE_BEGIN
        LAS float* scr = (LAS float*)(lds + wave * 16640);
        int rot = 0;
        for (int l = 0; l < DEPTH; ++l) conv_matrix<0>(I.xa_w_kv + (size_t)l * D * 4096, 4096, D, 0, 4096, nullptr, D_WKV + (size_t)l * 4096 * D, 0, scr, gw, NGW, lane, rot);
        for (int rep_ = 0; rep_ < REP_CONV; ++rep_) convert_layer(I, 0, WL, scr, gw, NGW, lane, rot);
        for (int m = gw; m < MEMROWS; m += NGW) {
            const f32x4* xr = (const f32x4*)(I.mem + (size_t)m * D); f32x4 v[8]; float s = 0.f;
#pragma unroll
            for (int j = 0; j < 8; ++j) { v[j] = xr[64 * j + lane]; s += (v[j][0] * v[j][0] + v[j][1] * v[j][1]) + (v[j][2] * v[j][2] + v[j][3] * v[j][3]); }
            const float rs = rsqrtf(wave_sum(s) * (1.0f / D) + EPS);
#pragma unroll
            for (int j = 0; j < 8; ++j) { const f32x4 g = *(const f32x4*)(I.norm_mem + (64 * j + lane) * 4); *(u32x2*)(D_MEMN + (size_t)m * D + (64 * j + lane) * 4) = pack4(v[j] * rs * g); }
        }
        for (int m = gw; m < M; m += NGW) {
            const f32x4* xr = (const f32x4*)(I.x + (size_t)m * D); float s = 0.f;
#pragma unroll
            for (int j = 0; j < 8; ++j) { const f32x4 v = xr[64 * j + lane]; s += (v[0] * v[0] + v[1] * v[1]) + (v[2] * v[2] + v[3] * v[3]); u32x2 w; w.x = rs_pk(v[0], v[1]); w.y = rs_pk(v[2], v[3]); *(u32x2*)(XB + (size_t)m * D + (64 * j + lane) * 4) = w; }
            s = wave_sum(s); if (lane < 8) SS[(size_t)m * 8 + lane] = lane == 0 ? s : 0.f;
        }
        for (int i = cu * NTHR + tid; i < 1024; i += G * NTHR) {
            const float a = I.hgrn_lb[i], b = I.hgrn_lb[1024 + i], mx = fmaxf(a, b), e0 = __expf(a - mx), e1 = __expf(b - mx); D_LB[i] = 0.f; D_LB[1024 + i] = e1 / (e0 + e1); }
        for (int i = cu * NTHR + tid; i < 2 * 2 * 8 * 16384; i += G * NTHR) {
            const int ii = i & 127, jj = (i >> 7) & 127, blk = (i >> 14) & 7, gt = (i >> 17) & 1, e = i >> 18;
            const float* src = gt ? I.lru_w_i : I.lru_w_r; D_WRT[i] = (bf16)f2bf(src[((size_t)(e * 8 + blk) * 128 + ii) * 128 + jj]); }
    PHASE_END

    layer_body<0>(lds, wave0, lo, hi, pc, bar); layer_body<1>(lds, wave0, lo, hi, pc, bar); layer_body<2>(lds, wave0, lo, hi, pc, bar); layer_body<3>(lds, wave0, lo, hi, pc, bar);
    const int ssi = 12;
    PHASE_BEGIN
        const float* ssf = SS + (size_t)ssi * M * 8;
        for (int m = gw; m < M; m += NGW) { f32x4* row = (f32x4*)(xres + (size_t)m * D); const u32x2* xr = (const u32x2*)(XB + (size_t)m * D); const float rs = pg8::rstd_of(ssf, m);
#pragma unroll
            for (int j = 0; j < 8; ++j) { const f32x4 g = *(const f32x4*)(I.norm_final + (64 * j + lane) * 4); const u32x2 w = xr[64 * j + lane];
                f32x4 o; o[0] = rs_lo(w.x) * rs * g[0]; o[1] = rs_hi(w.x) * rs * g[1]; o[2] = rs_lo(w.y) * rs * g[2]; o[3] = rs_hi(w.y) * rs * g[3]; row[64 * j + lane] = o; } }
    PHASE_END
#undef PHASE_BEGIN
#undef PHASE_END
}

constexpr int NPHASES = 1 + (5 + 4) + (6 + 4) + (5 + 4) + (6 + 4) + 1;

extern "C" void kernel_launch(void* const* d_in, const int* in_sizes, int n_in, void* d_out, int out_size, void* d_ws, size_t ws_size, hipStream_t stream) {
    static int grid = 0;
    if (grid == 0) {
        if (n_in != 32 || out_size != M * D || ws_size < WS_END) { fprintf(stderr, "kernel_launch: unexpected problem (n_in %d, out %d, ws %zu)\n", n_in, out_size, ws_size); grid = -1; return; }
        int dev = 0, cus = 0;
        if (hipGetDevice(&dev) != hipSuccess || hipDeviceGetAttribute(&cus, hipDeviceAttributeMultiprocessorCount, dev) != hipSuccess) { grid = -1; return; }
        if (hipFuncSetAttribute((const void*)fwd, hipFuncAttributeMaxDynamicSharedMemorySize, LDS_BYTES) != hipSuccess) { fprintf(stderr, "kernel_launch: hipFuncSetAttribute failed\n"); grid = -1; return; }
        int per_cu = 0;
        if (hipOccupancyMaxActiveBlocksPerMultiprocessor(&per_cu, (const void*)fwd, NTHR, LDS_BYTES) != hipSuccess || per_cu < 1) fprintf(stderr, "kernel_launch: occupancy query says %d\n", per_cu);
        (void)hipGetLastError();
        if (cus != 256) { fprintf(stderr, "kernel_launch: built for a 256-CU device (got %d)\n", cus); grid = -1; return; }
        grid = cus;
    }
    if (grid < 0) return;
    (void)hipMemsetAsync((char*)d_ws + WS_CTL, 0, CTL_ZERO_BYTES, stream);
    Args a{};
    const float** ip = (const float**)&a.in;
    for (int i = 0; i < 32; ++i) ip[i] = (const float*)d_in[i];
    a.out = (float*)d_out; a.ws = (unsigned char*)d_ws;
#if MK_SPLIT
#ifndef PROBE_MASK
#define PROBE_MASK 0ull
#endif
    for (int li = 0; li < NPHASES; ++li) { a.ph_lo = li; a.ph_hi = li + 1; hipLaunchKernelGGL(fwd, dim3(grid), dim3(NTHR), LDS_BYTES, stream, a);
        if ((PROBE_MASK >> li) & 1ull) hipLaunchKernelGGL(fwd, dim3(grid), dim3(NTHR), LDS_BYTES, stream, a); }
#else
    a.ph_lo = 0; a.ph_hi = NPHASES;
    hipLaunchKernelGGL(fwd, dim3(grid), dim3(NTHR), LDS_BYTES, stream, a);
#endif
}
```

```cpp
#include <hip/hip_runtime.h>
#include <cstdio>
#include <cstdint>

#ifndef MK_SPLIT
#define MK_SPLIT 0
#endif

#ifndef RESID_F16
#define RESID_F16 0
#endif
constexpr bool RF16 = RESID_F16 != 0;
#define GAS __attribute__((address_space(1)))
#define LAS __attribute__((address_space(3)))
typedef unsigned short bf16;
typedef short bf16x8 __attribute__((ext_vector_type(8)));
typedef float f32x4 __attribute__((ext_vector_type(4)));
typedef float f32x2 __attribute__((ext_vector_type(2)));
typedef unsigned u32x4 __attribute__((ext_vector_type(4)));
typedef unsigned u32x2 __attribute__((ext_vector_type(2)));

constexpr int D = 2048, NB = 4, SEQ = 4096, M = NB * SEQ, DEPTH = 4, MEMLEN = 256, MEMROWS = NB * MEMLEN;
constexpr int LRUW = 1024, ABIN = 6144;
constexpr int SSDIN = 4096, SSDCONV = 6144, SSDPROJ = 10304, SSDN1 = 10240, NHEADS = 64;
constexpr int XAD = 512, FF = 5632;
constexpr float EPS = 1e-6f;
constexpr int NWAVES = 8, NTHR = 512;

constexpr size_t MiB = 1u << 20;
constexpr size_t WS_CTL = 0, CTL_ZERO_BYTES = 1 * MiB;
constexpr size_t WS_WKV = 2 * MiB;
constexpr size_t WS_KMAT = 66 * MiB;
constexpr size_t WS_VT = 82 * MiB;
constexpr size_t WS_MEMN = 98 * MiB;
constexpr size_t WS_TAB = 102 * MiB;
constexpr size_t WS_XB = 106 * MiB;
constexpr size_t WS_WL = 170 * MiB;
constexpr size_t WS_ACT = 310 * MiB;
constexpr size_t WS_SS = (310 + 680) * MiB;
constexpr size_t WS_WL2 = (310 + 680 + 8) * MiB;
constexpr size_t WS_KQ = (310 + 680 + 8 + 140) * MiB;
constexpr size_t WS_VW = WS_KQ + 16 * MiB;
constexpr size_t WS_END = WS_VW + 16 * MiB;
constexpr size_t TAB_LB = 0;
constexpr size_t TAB_WRT = 64 * 1024;
constexpr size_t WL_IN = 0;
constexpr size_t WL_DT = (size_t)SSDN1 * D;
constexpr size_t WL_OUT = (size_t)(SSDN1 + 256) * D;
constexpr size_t WL_Q = WL_OUT + (size_t)D * SSDIN;
constexpr size_t WL_O = WL_Q + (size_t)D * D;
constexpr size_t WL_GU = WL_O + (size_t)D * D;
constexpr size_t WL_DN = WL_GU + (size_t)2 * FF * D;
constexpr size_t WL_ELEMS = WL_DN + (size_t)D * FF;
static_assert(WL_ELEMS * 2 <= 140 * MiB, "per-layer weights");
constexpr size_t A_Z = 0;
constexpr size_t A_XBC = 128 * MiB;
constexpr size_t A_Y = 128 * MiB;
constexpr size_t A_XBT = 320 * MiB;
constexpr size_t A_BCN = 480 * MiB;
constexpr size_t A_ST = 544 * MiB;
constexpr size_t A_DT = 672 * MiB;
constexpr size_t A_DEC = 676 * MiB;
constexpr size_t A_PROJ = 0;
constexpr size_t A_LOGF = 192 * MiB;
constexpr size_t A_HST = 256 * MiB;
constexpr size_t A_YAB = 320 * MiB;
constexpr size_t A_SEG = 384 * MiB;
constexpr size_t A_HDEC = 386 * MiB;

constexpr size_t A_P = 64 * MiB;
constexpr size_t A_O = 96 * MiB;
constexpr size_t A_H = 160 * MiB;

constexpr int LDS_BYTES = 155648;
constexpr int EPI_OFF = 131072;
constexpr int MISC_OFF = LDS_BYTES - 256;

#define LDS_WAIT() asm volatile("s_waitcnt lgkmcnt(0)" ::: "memory")
#define VM_WAIT() asm volatile("s_waitcnt vmcnt(0)" ::: "memory")
__device__ __forceinline__ unsigned f2bf(float f) { unsigned u = __builtin_bit_cast(unsigned, f); return (u + 0x7fffu + ((u >> 16) & 1u)) >> 16; }
__device__ __forceinline__ unsigned pk2(float lo, float hi) { return f2bf(lo) | (f2bf(hi) << 16); }
typedef __bf16 bf16x2v __attribute__((ext_vector_type(2)));
__device__ __forceinline__ unsigned cvt_pk_bf16(float lo, float hi) { const f32x2 v = {lo, hi}; return __builtin_bit_cast(unsigned, __builtin_convertvector(v, bf16x2v)); }
typedef _Float16 f16x2v __attribute__((ext_vector_type(2)));
typedef _Float16 f16x8 __attribute__((ext_vector_type(8)));
__device__ __forceinline__ unsigned cvt_pk_f16(float lo, float hi) { const f32x2 v = {lo, hi}; return __builtin_bit_cast(unsigned, __builtin_convertvector(v, f16x2v)); }
__device__ __forceinline__ float h16lo(unsigned w) { return (float)__builtin_bit_cast(f16x2v, w)[0]; }
__device__ __forceinline__ float h16hi(unsigned w) { return (float)__builtin_bit_cast(f16x2v, w)[1]; }
__device__ __forceinline__ float bflo(unsigned w) { return __uint_as_float(w << 16); }
__device__ __forceinline__ float bfhi(unsigned w) { return __uint_as_float(w & 0xffff0000u); }
__device__ __forceinline__ unsigned rs_pk(float lo, float hi) { return RF16 ? cvt_pk_f16(lo, hi) : cvt_pk_bf16(lo, hi); }
__device__ __forceinline__ float rs_lo(unsigned w) { return RF16 ? h16lo(w) : bflo(w); }
__device__ __forceinline__ float rs_hi(unsigned w) { return RF16 ? h16hi(w) : bfhi(w); }
__device__ __forceinline__ float bf2f(bf16 b) { return __uint_as_float((unsigned)b << 16); }
__device__ __forceinline__ float sigm(float x) { return __builtin_amdgcn_rcpf(1.f + __expf(-x)); }
__device__ __forceinline__ float siluf(float x) { return x * sigm(x); }
__device__ __forceinline__ float gelu_tanh(float x) { return x * sigm(1.5957691216f * (x + 0.044715f * x * x * x)); }
__device__ __forceinline__ float softplusf(float x) { const float e = __expf(-fabsf(x)); const float l = (e < 0.03f) ? e * (1.f - e * (0.5f - e * 0.33333333f)) : __logf(1.f + e); return fmaxf(x, 0.f) + l; }
__device__ __forceinline__ float wave_sum(float v) {
#pragma unroll
    for (int o = 1; o < 64; o <<= 1) v += __shfl_xor(v, o);
    return v;
}

#define XB_TMO      128
#define XB_XCNT(j)  (256  + 64 * (j))
#define XB_XSUB(j)  (1280 + 64 * (j))
#define XB_XGEN(j)  (2304 + 64 * (j))
#define XB_TOP      3328
#define XB_TOPGEN   3392
#define XCD_BAR_WORDS 3456
#define XB_SPIN_CAP (1u << 18)

__device__ __forceinline__ unsigned xb_ld(unsigned* p)              { return __hip_atomic_load(p, __ATOMIC_RELAXED, __HIP_MEMORY_SCOPE_AGENT); }
__device__ __forceinline__ unsigned xb_add(unsigned* p, unsigned v) { return __hip_atomic_fetch_add(p, v, __ATOMIC_RELAXED, __HIP_MEMORY_SCOPE_AGENT); }
__device__ __forceinline__ unsigned xb_xcc_id() { return (unsigned)__builtin_amdgcn_s_getreg((3 << 11) | 20) & 0xFu; }
#define XB_SPIN(cond, bar) do { unsigned _sp = 0; while (cond) { __builtin_amdgcn_s_sleep(1); \
    if ((++_sp & 255u) == 0u) { if (xb_ld(&(bar)[XB_TMO])) break; if (_sp > XB_SPIN_CAP) { atomicAdd(&(bar)[XB_TMO], 1u); break; } } } } while (0)

struct XcdBarrier {
    unsigned* bar; unsigned x;
    volatile LAS unsigned* st;
};
__device__ __forceinline__ XcdBarrier xcd_barrier_post(unsigned* bar, volatile LAS unsigned* st) {
    XcdBarrier b; b.bar = bar; b.x = xb_xcc_id(); b.st = st;
    if (threadIdx.x == 0) (void)xb_add(&bar[XB_XCNT(b.x)], 1u);
    return b;
}
__device__ __forceinline__ void xcd_barrier_complete(unsigned* bar, unsigned x, unsigned& nloc, unsigned& nx) {
    const unsigned G = gridDim.x * gridDim.y * gridDim.z;
    unsigned sum, cnt, mine, sp = 0u;
    for (;;) {
        sum = 0u; cnt = 0u; mine = 0u;
#pragma unroll
        for (unsigned j = 0; j < 16; ++j) { const unsigned c = xb_ld(&bar[XB_XCNT(j)]); sum += c; cnt += (c > 0u) ? 1u : 0u; mine = (j == x) ? c : mine; }
        if (sum == G) break;
        __builtin_amdgcn_s_sleep(1);
        if ((++sp & 255u) == 0u) { if (xb_ld(&bar[XB_TMO])) break; if (sp > XB_SPIN_CAP) { atomicAdd(&bar[XB_TMO], 1u); break; } }
    }
    nloc = mine > 0u ? mine : 1u; nx = cnt > 0u ? cnt : 1u;
}
__device__ __forceinline__ void xcd_barrier(const XcdBarrier& b) {
    asm volatile("s_waitcnt vmcnt(0)" ::: "memory");
    __syncthreads();
    if (threadIdx.x == 0) {
        unsigned* bar = b.bar;
        __builtin_amdgcn_s_waitcnt(0);
        unsigned nloc = b.st[0], nx = b.st[1];
        if (nloc == 0u) { xcd_barrier_complete(bar, b.x, nloc, nx); b.st[0] = nloc; b.st[1] = nx; }
        const unsigned old = xb_add(&bar[XB_XSUB(b.x)], 1u);
        const unsigned gen = old / nloc;
        if (old + 1u == (gen + 1u) * nloc) {
            __builtin_amdgcn_fence(__ATOMIC_RELEASE, "agent");
            asm volatile("s_waitcnt vmcnt(0)" ::: "memory");
            const unsigned og = xb_add(&bar[XB_TOP], 1u);
            const unsigned tg = og / nx;
            if (og + 1u == (tg + 1u) * nx) xb_add(&bar[XB_TOPGEN], 1u);
            else XB_SPIN(xb_ld(&bar[XB_TOPGEN]) == tg, bar);
            __builtin_amdgcn_fence(__ATOMIC_ACQUIRE, "agent");
            xb_add(&bar[XB_XGEN(b.x)], 1u);
            asm volatile("s_waitcnt vmcnt(0)" ::: "memory");
        } else {
            XB_SPIN(xb_ld(&bar[XB_XGEN(b.x)]) == gen, bar);
            __builtin_amdgcn_fence(__ATOMIC_ACQUIRE, "agent");
            asm volatile("s_waitcnt vmcnt(0)" ::: "memory");
        }
    }
    __syncthreads();
}

namespace pg8 {
constexpr int BM = 256, BK = 64, HALF = 128, HTB = HALF * BK * 2, STAGE_BYTES = 8 * HTB, NXCD = 8, WGM = 8;
__host__ __device__ __forceinline__ int lds_byte(int r, int c) { const int st = (r >> 4) * 2 + (c >> 5), rr = r & 15, cc = c & 31, ob = rr * 64 + cc * 2; return st * 1024 + (ob ^ (((ob >> 9) & 1) << 5)); }
__host__ __device__ __forceinline__ void stage_rc(int b, int& R, int& C) { const int st = b / 1024, sb = b % 1024, swz = sb ^ (((sb >> 9) & 1) << 5); R = (st >> 1) * 16 + swz / 64; C = (st & 1) * 32 + (swz % 64) / 2; }
__host__ __device__ __forceinline__ int perm32(int rho) { const int n = rho >> 4, i = rho & 15; return 8 * (i >> 2) + 4 * n + (i & 3); }

struct Unit { const char* a; const char* b; int orow, ocol, aux; };

template <bool F16 = false, bool ALIGN = true, class Epi, class Sched>
__device__ __forceinline__ void gemm_phase(const int tid, LAS unsigned char* lds, const int K, const int lda, const int ldb, const Sched& S, const Epi& E) {
    const int wid = __builtin_amdgcn_readfirstlane(tid >> 6), lane = tid & 63, wr = wid >> 2, wc = wid & 3, fr = lane & 15, fq = lane >> 4;
    const int nt = K / BK;
    unsigned voffA[2], voffB[2];
#pragma unroll
    for (int i = 0; i < 2; ++i) { int R, C; stage_rc(tid * 16 + i * 8192, R, C); const int Rb = (R & ~31) + perm32(R & 31);
        voffA[i] = (unsigned)(R * lda + C) * 2u; voffB[i] = (unsigned)(Rb * ldb + C) * 2u; }
    const size_t kstep = (size_t)(BK * 2);
    const size_t hstepA = (size_t)HALF * lda * 2, hstepB = (size_t)HALF * ldb * 2;
    const unsigned ldsw = (unsigned)wid * 1024u;
    const int aoff = lds_byte(wr * 64 + fr, fq * 8), boff = lds_byte(wc * 32 + fr, fq * 8);
#define PG8_SA(b, h) (((b) * 2 + (h)) * HTB)
#define PG8_SB(b, h) ((4 + (b) * 2 + (h)) * HTB)
#define PG8_STAGE(bufoff, gbase, voff) do { _Pragma("unroll") for (int _i = 0; _i < 2; ++_i) \
        __builtin_amdgcn_global_load_lds((const unsigned*)((const char*)(gbase) + (voff)[_i]), (LAS unsigned*)(lds + (bufoff) + ldsw + _i * 8192), 16, 0, 0); } while (0)
#define PG8_LDA(dst, b, h) do { _Pragma("unroll") for (int m = 0; m < 4; ++m) _Pragma("unroll") for (int k = 0; k < 2; ++k) dst[m][k] = *(const LAS bf16x8*)(lds + PG8_SA(b, h) + aoff + m * 2048 + k * 1024); } while (0)
#define PG8_LDB(dst, b, h) do { _Pragma("unroll") for (int n = 0; n < 2; ++n) _Pragma("unroll") for (int k = 0; k < 2; ++k) dst[n][k] = *(const LAS bf16x8*)(lds + PG8_SB(b, h) + boff + n * 2048 + k * 1024); } while (0)
#define PG8_MMA(ai, bj, At, Bt) do { __builtin_amdgcn_s_setprio(1); _Pragma("unroll") for (int m = 0; m < 4; ++m) _Pragma("unroll") for (int n = 0; n < 2; ++n) _Pragma("unroll") for (int k = 0; k < 2; ++k) \
        acc[ai][bj][m][n] = F16 ? __builtin_amdgcn_mfma_f32_16x16x32_f16(__builtin_bit_cast(f16x8, Bt[n][k]), __builtin_bit_cast(f16x8, At[m][k]), acc[ai][bj][m][n], 0, 0, 0) \
                                : __builtin_amdgcn_mfma_f32_16x16x32_bf16(Bt[n][k], At[m][k], acc[ai][bj][m][n], 0, 0, 0); __builtin_amdgcn_s_setprio(0); } while (0)
#define PG8_WAIT_V(n) asm volatile("s_waitcnt vmcnt(" #n ")" ::: "memory")
#define PG8_WAIT_L(n) asm volatile("s_waitcnt lgkmcnt(" #n ")" ::: "memory")
#define PG8_BAR __builtin_amdgcn_s_barrier()
#define PG8_SCHED __builtin_amdgcn_sched_barrier(0)
    Unit cur, nxt; int ui = 0;
    if (!S.next(0, cur)) return;
    f32x4 acc[2][2][4][2];
#pragma unroll
    for (int a = 0; a < 2; ++a)
#pragma unroll
        for (int b = 0; b < 2; ++b)
#pragma unroll
            for (int m = 0; m < 4; ++m)
#pragma unroll
                for (int n = 0; n < 2; ++n) acc[a][b][m][n] = (f32x4){0.f, 0.f, 0.f, 0.f};
    bf16x8 At[4][2], B0[2][2], B1[2][2];
    const char* cA = cur.a; const char* cB = cur.b;
    PG8_STAGE(PG8_SB(0, 0), cB, voffB); PG8_STAGE(PG8_SB(0, 1), cB + hstepB, voffB); PG8_STAGE(PG8_SA(0, 0), cA, voffA); PG8_STAGE(PG8_SA(0, 1), cA + hstepA, voffA);
    if (wr == 1) PG8_BAR;
    PG8_WAIT_V(2); PG8_BAR;
    PG8_STAGE(PG8_SB(1, 0), cB + kstep, voffB); PG8_STAGE(PG8_SA(1, 0), cA + kstep, voffA); PG8_STAGE(PG8_SB(1, 1), cB + hstepB + kstep, voffB);
    PG8_WAIT_V(6); PG8_BAR;
    for (;;) {
        const bool has_next = S.next(ui + 1, nxt);
        const char* nA = has_next ? nxt.a : cA; const char* nB = has_next ? nxt.b : cB;
        for (int t = 0; t < nt; t += 2) {
            const bool last = (t == nt - 2);
            const char* a1 = cA + (size_t)(t + 1) * kstep;
            const char* a2 = last ? nA : cA + (size_t)(t + 2) * kstep; const char* b2 = last ? nB : cB + (size_t)(t + 2) * kstep;
            const char* a3 = a2 + kstep; const char* b3 = b2 + kstep;
            PG8_LDB(B0, 0, 0); PG8_LDB(B1, 0, 1); PG8_SCHED; PG8_LDA(At, 0, 0); PG8_STAGE(PG8_SA(1, 1), a1 + hstepA, voffA);
            PG8_WAIT_V(8); PG8_WAIT_L(0); PG8_BAR; PG8_MMA(0, 0, At, B0); PG8_MMA(0, 1, At, B1); PG8_BAR; PG8_SCHED;
            PG8_LDA(At, 0, 1); PG8_STAGE(PG8_SB(0, 0), b2, voffB); PG8_STAGE(PG8_SB(0, 1), b2 + hstepB, voffB); PG8_STAGE(PG8_SA(0, 0), a2, voffA);
            PG8_WAIT_V(8); PG8_WAIT_L(0); PG8_BAR; PG8_MMA(1, 0, At, B0); PG8_MMA(1, 1, At, B1); PG8_BAR; PG8_SCHED;
            PG8_LDB(B0, 1, 0); PG8_LDB(B1, 1, 1); PG8_SCHED; PG8_LDA(At, 1, 0); PG8_STAGE(PG8_SA(0, 1), a2 + hstepA, voffA);
            PG8_WAIT_V(8); PG8_WAIT_L(0); PG8_BAR; PG8_MMA(0, 0, At, B0); PG8_MMA(0, 1, At, B1); PG8_BAR; PG8_SCHED;
            PG8_LDA(At, 1, 1); PG8_STAGE(PG8_SB(1, 0), b3, voffB); PG8_STAGE(PG8_SB(1, 1), b3 + hstepB, voffB); PG8_STAGE(PG8_SA(1, 0), a3, voffA);
            PG8_WAIT_V(8); PG8_WAIT_L(0); PG8_BAR; PG8_MMA(1, 0, At, B0); PG8_MMA(1, 1, At, B1); PG8_BAR; PG8_SCHED;
        }
        if (ALIGN) { if (wr == 0) PG8_BAR; }
        E(acc, cur, wr, wc, fr, fq);
        if (!has_next) break;
#pragma unroll
        for (int a = 0; a < 2; ++a)
#pragma unroll
            for (int b = 0; b < 2; ++b)
#pragma unroll
                for (int m = 0; m < 4; ++m)
#pragma unroll
                    for (int n = 0; n < 2; ++n) acc[a][b][m][n] = (f32x4){0.f, 0.f, 0.f, 0.f};
        cur = nxt; cA = nA; cB = nB; ++ui;
        if (ALIGN) { if (wr == 1) PG8_BAR; }
    }
    PG8_WAIT_V(0);
    if (!ALIGN) { if (wr == 0) PG8_BAR; }
    PG8_BAR;
#undef PG8_SA
#undef PG8_SB
#undef PG8_STAGE
#undef PG8_LDA
#undef PG8_LDB
#undef PG8_MMA
#undef PG8_WAIT_V
#undef PG8_WAIT_L
#undef PG8_SCHED
}
}
namespace pg8 {
struct SchedMN {
    const char* A; const char* Bt; int lda, ldb; int nM, nN, nwg, G, c;
    __device__ __forceinline__ void init(const bf16* A_, int lda_, const bf16* Bt_, int ldb_, int Mrows, int Ncols, int G_, int c_) {
        A = (const char*)A_; Bt = (const char*)Bt_; lda = lda_; ldb = ldb_; nM = Mrows / BM; nN = Ncols / BM; nwg = nM * nN; G = G_; c = c_; }
    __device__ __forceinline__ bool next(int i, Unit& u) const {
        const long L = (long)i * G + c; if (L >= nwg) return false;
        int wgid = (int)L; { const int q = nwg / NXCD, r = nwg % NXCD, xcd = wgid % NXCD, off = wgid / NXCD; wgid = (xcd < r ? xcd * (q + 1) : r * (q + 1) + (xcd - r) * q) + off; }
        const int nig = WGM * nN, gid = wgid / nig, fm = gid * WGM, gsz = (nM - fm) < WGM ? (nM - fm) : WGM;
        const int pm = fm + ((wgid % nig) % gsz), pn = (wgid % nig) / gsz;
        u.a = A + (size_t)pm * BM * lda * 2; u.b = Bt + (size_t)pn * BM * ldb * 2; u.orow = pm * BM; u.ocol = pn * BM; u.aux = pn; return true;
    }
};
struct SchedKV {
    const char* memn; const char* wkv; int G, c;
    __device__ __forceinline__ bool next(int i, Unit& u) const {
        const int L = i * G + c; if (L >= 256) return false;
        const int l = L >> 6, r = L & 63; const char* w = wkv + (size_t)l * 4096 * D * 2;
        if (r < 32) { const int pm = r >> 3, pn = r & 7; u.a = memn + (size_t)pm * 256 * D * 2; u.b = w + (size_t)pn * 256 * D * 2; u.orow = pm * 256; u.ocol = pn * 256; u.aux = l * 2; }
        else { const int q = r - 32, pm = q >> 3, pn = q & 7; u.a = memn + (size_t)pm * 256 * D * 2; u.b = w + (size_t)(2048 + pn * 256) * D * 2; u.orow = pm * 256; u.ocol = pn * 256; u.aux = l * 2 + 1; }
        return true;
    }
};
struct SchedS {
    const char* Q; const char* Km; int G, c;
    __device__ __forceinline__ bool next(int i, Unit& u) const {
        const int L = i * G + c; if (L >= 256) return false;
        const int bh = 2 * (L & 7) + ((L >> 3) >> 4), it = (L >> 3) & 15, b = bh >> 2, h = bh & 3;
        u.a = Q + ((size_t)(b * SEQ + it * 256) * D + h * XAD) * 2; u.b = Km + ((size_t)(b * MEMLEN) * D + h * XAD) * 2; u.orow = b * SEQ + it * 256; u.ocol = h * 256; u.aux = 0; return true;
    }
};
struct SchedPV {
    const char* P; const char* Vt; int G, c;
    __device__ __forceinline__ bool next(int i, Unit& u) const {
        const int L = i * G + c; if (L >= 512) return false;
        const int x = L & 7, r = L >> 3;
        const int bh = 2 * x + (r >> 5), q = r & 31, it = q >> 1, nh = q & 1, b = bh >> 2, h = bh & 3;
        u.a = P + ((size_t)(b * SEQ + it * 256) * 1024 + h * 256) * 2; u.b = Vt + ((size_t)(h * XAD + nh * 256) * 1024 + b * MEMLEN) * 2; u.orow = b * SEQ + it * 256; u.ocol = h * XAD + nh * 256; u.aux = 0; return true;
    }
};
struct SchedDt {
    const char* A; const char* Bt; int c;
    __device__ __forceinline__ bool next(int i, Unit& u) const {
        if (i != 0 || c >= 64) return false;
        u.a = A + (size_t)c * 256 * D * 2; u.b = Bt; u.orow = c * 256; u.ocol = 0; u.aux = 0; return true;
    }
};

struct SchedOne {
    Unit u0; int n;
    __device__ __forceinline__ bool next(int i, Unit& u) const { if (i >= n) return false; u = u0; return true; }
};
struct SchedMNB {
    const char* A; const char* Bt; int lda, ldb; int nM, nN, nwg, G, c; size_t bstride;
    __device__ __forceinline__ void init(const bf16* A_, int lda_, const bf16* Bt_, int ldb_, int Mrows, int Ncols, int G_, int c_, size_t bstride_) {
        A = (const char*)A_; Bt = (const char*)Bt_; lda = lda_; ldb = ldb_; nM = Mrows / BM; nN = Ncols / BM; nwg = nM * nN; G = G_; c = c_; bstride = bstride_; }
    __device__ __forceinline__ bool next(int i, Unit& u) const {
        const long L = (long)i * G + c; if (L >= nwg) return false;
        int wgid = (int)L; { const int q = nwg / NXCD, r = nwg % NXCD, xcd = wgid % NXCD, off = wgid / NXCD; wgid = (xcd < r ? xcd * (q + 1) : r * (q + 1) + (xcd - r) * q) + off; }
        const int nig = WGM * nN, gid = wgid / nig, fm = gid * WGM, gsz = (nM - fm) < WGM ? (nM - fm) : WGM;
        const int pm = fm + ((wgid % nig) % gsz), pn = (wgid % nig) / gsz;
        u.a = A + (size_t)pm * BM * lda * 2; u.b = Bt + (size_t)(pm >> 4) * bstride + (size_t)pn * BM * ldb * 2; u.orow = pm * BM; u.ocol = pn * BM; u.aux = pn; return true;
    }
};
struct SchedChainQ {
    const char* A; const char* Bt; int pm, h, n;
    __device__ __forceinline__ bool next(int i, Unit& u) const { if (i >= n) return false; const int pn = 2 * h + i;
        u.a = A + (size_t)pm * 256 * D * 2; u.b = Bt + (size_t)pn * 256 * D * 2; u.orow = pm * 256; u.ocol = pn * 256; u.aux = pn; return true; }
};
struct SchedChainS {
    const char* Q; const char* Km; int pm, h, n;
    __device__ __forceinline__ bool next(int i, Unit& u) const { if (i >= n) return false; const int b = pm >> 4;
        u.a = Q + ((size_t)pm * 256 * D + h * XAD) * 2; u.b = Km + ((size_t)(b * MEMLEN) * D + h * XAD) * 2; u.orow = pm * 256; u.ocol = h * 256; u.aux = 0; return true; }
};
struct SchedChainPV {
    const char* P; const char* Vt; int pm, h, n;
    __device__ __forceinline__ bool next(int i, Unit& u) const { if (i >= n) return false; const int b = pm >> 4;
        u.a = P + ((size_t)pm * 256 * 1024 + h * 256) * 2; u.b = Vt + ((size_t)(h * XAD + i * 256) * 1024 + b * MEMLEN) * 2; u.orow = pm * 256; u.ocol = h * XAD + i * 256; u.aux = 0; return true; }
};

#define EPI_ARGS f32x4 (&acc)[2][2][4][2], const Unit& u, int wr, int wc, int fr, int fq
#define EPI_ROW(ai, m) (u.orow + (ai) * HALF + wr * 64 + (m) * 16 + fr)
#define EPI_COL(bj) (u.ocol + (bj) * HALF + wc * 32 + 8 * fq)
__device__ __forceinline__ float rstd_of(const float* ss, int row) { const f32x4 a = *(const f32x4*)(ss + (size_t)row * 8), b = *(const f32x4*)(ss + (size_t)row * 8 + 4);
    return rsqrtf((((a[0] + a[1]) + (a[2] + a[3])) + ((b[0] + b[1]) + (b[2] + b[3]))) * (1.0f / D) + EPS); }
__device__ __forceinline__ u32x4 pack8(const f32x4 a, const f32x4 b) { u32x4 w; w.x = cvt_pk_bf16(a[0], a[1]); w.y = cvt_pk_bf16(a[2], a[3]); w.z = cvt_pk_bf16(b[0], b[1]); w.w = cvt_pk_bf16(b[2], b[3]); return w; }

struct EpiProjEven {
    const float* ss; bf16* proj; float* logf; const float* lb;
    __device__ __forceinline__ void operator()(EPI_ARGS) const {
        const int range = u.aux >> 2;
#pragma unroll
        for (int ai = 0; ai < 2; ++ai)
#pragma unroll
            for (int m = 0; m < 4; ++m) { const int row = EPI_ROW(ai, m); const float rs = rstd_of(ss, row);
#pragma unroll
                for (int bj = 0; bj < 2; ++bj) { const int col = EPI_COL(bj); f32x4 v0 = acc[ai][bj][m][0] * rs, v1 = acc[ai][bj][m][1] * rs;
                    if (range == 3) { const int c = col - 3072; const f32x4 l0 = *(const f32x4*)(lb + c), l1 = *(const f32x4*)(lb + c + 4);
#pragma unroll
                        for (int j = 0; j < 4; ++j) { v0[j] = __logf(l0[j] + (1.f - l0[j]) * sigm(v0[j])); v1[j] = __logf(l1[j] + (1.f - l1[j]) * sigm(v1[j])); }
                        float* p = logf + (size_t)row * 1024 + c; *(f32x4*)p = v0; *(f32x4*)(p + 4) = v1;
                    } else {
                        if (range == 1) {
#pragma unroll
                            for (int j = 0; j < 4; ++j) { v0[j] = gelu_tanh(v0[j]); v1[j] = gelu_tanh(v1[j]); } }
                        else if (range == 2 || range == 5) {
#pragma unroll
                            for (int j = 0; j < 4; ++j) { v0[j] = siluf(v0[j]); v1[j] = siluf(v1[j]); } }
                        *(u32x4*)(proj + (size_t)row * ABIN + col) = pack8(v0, v1);
                    } } }
    }
};
struct EpiProjOdd {
    const float* ss; bf16* Z; bf16* XBC;
    __device__ __forceinline__ void operator()(EPI_ARGS) const {
        const bool isz = u.ocol < SSDIN;
#pragma unroll
        for (int ai = 0; ai < 2; ++ai)
#pragma unroll
            for (int m = 0; m < 4; ++m) { const int row = EPI_ROW(ai, m); const float rs = rstd_of(ss, row);
#pragma unroll
                for (int bj = 0; bj < 2; ++bj) { const int col = EPI_COL(bj); f32x4 v0 = acc[ai][bj][m][0] * rs, v1 = acc[ai][bj][m][1] * rs;
                    if (isz) {
#pragma unroll
                        for (int j = 0; j < 4; ++j) { v0[j] = siluf(v0[j]); v1[j] = siluf(v1[j]); }
                        *(u32x4*)(Z + (size_t)row * SSDIN + col) = pack8(v0, v1);
                    } else *(u32x4*)(XBC + (size_t)row * SSDCONV + (col - SSDIN)) = pack8(v0, v1); } }
    }
};
struct EpiDt {
    const float* ss; const float* bias; float* DT;
    __device__ __forceinline__ void operator()(EPI_ARGS) const {
        if (wc >= 2) return;
        const int col = wc * 32 + 8 * fq; const f32x4 b0 = *(const f32x4*)(bias + col), b1 = *(const f32x4*)(bias + col + 4);
#pragma unroll
        for (int ai = 0; ai < 2; ++ai)
#pragma unroll
            for (int m = 0; m < 4; ++m) { const int row = EPI_ROW(ai, m); const float rs = rstd_of(ss, row);
                f32x4 v0 = acc[ai][0][m][0] * rs + b0, v1 = acc[ai][0][m][1] * rs + b1;
#pragma unroll
                for (int j = 0; j < 4; ++j) { v0[j] = softplusf(v0[j]); v1[j] = softplusf(v1[j]); }
                float* p = DT + (size_t)row * 64 + col; *(f32x4*)p = v0; *(f32x4*)(p + 4) = v1; }
    }
};
struct EpiResid {
    bf16* xb; float* ssnew; LAS float* tab;
    __device__ __forceinline__ void operator()(EPI_ARGS) const {
#pragma unroll
        for (int ai = 0; ai < 2; ++ai)
#pragma unroll
            for (int m = 0; m < 4; ++m) { const int row = EPI_ROW(ai, m); float sq = 0.f;
#pragma unroll
                for (int bj = 0; bj < 2; ++bj) { bf16* p = xb + (size_t)row * D + EPI_COL(bj); const u32x4 w = *(const u32x4*)p;
                    f32x4 o0 = acc[ai][bj][m][0], o1 = acc[ai][bj][m][1];
                    o0[0] += rs_lo(w.x); o0[1] += rs_hi(w.x); o0[2] += rs_lo(w.y); o0[3] += rs_hi(w.y); o1[0] += rs_lo(w.z); o1[1] += rs_hi(w.z); o1[2] += rs_lo(w.w); o1[3] += rs_hi(w.w);
                    { u32x4 pk; pk.x = rs_pk(o0[0], o0[1]); pk.y = rs_pk(o0[2], o0[3]); pk.z = rs_pk(o1[0], o1[1]); pk.w = rs_pk(o1[2], o1[3]); *(u32x4*)p = pk; }
                    sq += ((o0[0] * o0[0] + o0[1] * o0[1]) + (o0[2] * o0[2] + o0[3] * o0[3])) + ((o1[0] * o1[0] + o1[1] * o1[1]) + (o1[2] * o1[2] + o1[3] * o1[3])); }
                sq += __shfl_xor(sq, 16); sq += __shfl_xor(sq, 32);
                if (fq == 0) tab[(ai * HALF + wr * 64 + m * 16 + fr) * 4 + wc] = sq; }
        LDS_WAIT(); PG8_BAR; asm volatile("" ::: "memory");
        const int lane = fq * 16 + fr, r = (wr * 4 + wc) * 32 + (lane & 31);
        if (lane < 32) { const f32x4 t = *(const LAS f32x4*)(tab + r * 4); ssnew[(size_t)(u.orow + r) * 8 + (u.ocol >> 8)] = (t[0] + t[1]) + (t[2] + t[3]); }
    }
};
struct EpiQ {
    const float* ss; bf16* Q; float scale;
    __device__ __forceinline__ void operator()(EPI_ARGS) const {
#pragma unroll
        for (int ai = 0; ai < 2; ++ai)
#pragma unroll
            for (int m = 0; m < 4; ++m) { const int row = EPI_ROW(ai, m); const float rs = rstd_of(ss, row) * scale;
#pragma unroll
                for (int bj = 0; bj < 2; ++bj) *(u32x4*)(Q + (size_t)row * D + EPI_COL(bj)) = pack8(acc[ai][bj][m][0] * rs, acc[ai][bj][m][1] * rs); }
    }
};
struct EpiPlain {
    bf16* O; int ldc;
    __device__ __forceinline__ void operator()(EPI_ARGS) const {
#pragma unroll
        for (int ai = 0; ai < 2; ++ai)
#pragma unroll
            for (int m = 0; m < 4; ++m) { const int row = EPI_ROW(ai, m);
#pragma unroll
                for (int bj = 0; bj < 2; ++bj) *(u32x4*)(O + (size_t)row * ldc + EPI_COL(bj)) = pack8(acc[ai][bj][m][0], acc[ai][bj][m][1]); }
    }
};
struct EpiKV {
    bf16* Km; bf16* Vt;
    __device__ __forceinline__ void operator()(EPI_ARGS) const {
        const int l = u.aux >> 1; const bool isv = u.aux & 1;
        bf16* O = Km + (size_t)l * MEMROWS * D + (size_t)(isv ? 1 : 0) * (size_t)(Vt - Km); const int ldc = D;
#pragma unroll
        for (int ai = 0; ai < 2; ++ai)
#pragma unroll
            for (int m = 0; m < 4; ++m) { const int row = EPI_ROW(ai, m);
#pragma unroll
                for (int bj = 0; bj < 2; ++bj) *(u32x4*)(O + (size_t)row * ldc + EPI_COL(bj)) = pack8(acc[ai][bj][m][0], acc[ai][bj][m][1]); }
    }
};
struct EpiSoftmax {
    const float* ss; float scale; bf16* P; LAS float* tab;
    __device__ __forceinline__ void operator()(EPI_ARGS) const {
        float mx[2][4];
#pragma unroll
        for (int ai = 0; ai < 2; ++ai)
#pragma unroll
            for (int m = 0; m < 4; ++m) { float v = -3.0e38f; const float rs = rstd_of(ss, EPI_ROW(ai, m)) * scale;
#pragma unroll
                for (int bj = 0; bj < 2; ++bj)
#pragma unroll
                    for (int n = 0; n < 2; ++n) { const f32x4 a = acc[ai][bj][m][n] * rs; acc[ai][bj][m][n] = a; v = fmaxf(v, fmaxf(fmaxf(a[0], a[1]), fmaxf(a[2], a[3]))); }
                v = fmaxf(v, __shfl_xor(v, 16)); v = fmaxf(v, __shfl_xor(v, 32));
                if (fq == 0) tab[(ai * HALF + wr * 64 + m * 16 + fr) * 4 + wc] = v; }
        LDS_WAIT(); PG8_BAR; asm volatile("" ::: "memory");
#pragma unroll
        for (int ai = 0; ai < 2; ++ai)
#pragma unroll
            for (int m = 0; m < 4; ++m) { const int r = ai * HALF + wr * 64 + m * 16 + fr; const f32x4 t = *(const LAS f32x4*)(tab + r * 4);
                const float rm = fmaxf(fmaxf(t[0], t[1]), fmaxf(t[2], t[3])); float s = 0.f;
#pragma unroll
                for (int bj = 0; bj < 2; ++bj)
#pragma unroll
                    for (int n = 0; n < 2; ++n) { f32x4 a = acc[ai][bj][m][n];
#pragma unroll
                        for (int j = 0; j < 4; ++j) { a[j] = __expf(a[j] - rm); s += a[j]; }
                        acc[ai][bj][m][n] = a; }
                s += __shfl_xor(s, 16); s += __shfl_xor(s, 32);
                if (fq == 0) tab[1024 + r * 4 + wc] = s; }
        LDS_WAIT(); PG8_BAR; asm volatile("" ::: "memory");
#pragma unroll
        for (int ai = 0; ai < 2; ++ai)
#pragma unroll
            for (int m = 0; m < 4; ++m) { const int r = ai * HALF + wr * 64 + m * 16 + fr; const f32x4 t = *(const LAS f32x4*)(tab + 1024 + r * 4);
                const float inv = __builtin_amdgcn_rcpf((t[0] + t[1]) + (t[2] + t[3])); const int row = u.orow + r;
#pragma unroll
                for (int bj = 0; bj < 2; ++bj) *(u32x4*)(P + (size_t)row * 1024 + EPI_COL(bj)) = pack8(acc[ai][bj][m][0] * inv, acc[ai][bj][m][1] * inv); }
    }
};
struct EpiGateUp {
    const float* ss; bf16* H;
    __device__ __forceinline__ void operator()(EPI_ARGS) const {
#pragma unroll
        for (int ai = 0; ai < 2; ++ai)
#pragma unroll
            for (int m = 0; m < 4; ++m) { const int row = EPI_ROW(ai, m); const float rs = rstd_of(ss, row);
#pragma unroll
                for (int bj = 0; bj < 2; ++bj) { const int hc = EPI_COL(bj) >> 1; const f32x4 g = acc[ai][bj][m][0] * rs, up = acc[ai][bj][m][1] * rs; f32x4 h;
#pragma unroll
                    for (int j = 0; j < 4; ++j) h[j] = siluf(g[j]) * up[j];
                    u32x2 w; w.x = cvt_pk_bf16(h[0], h[1]); w.y = cvt_pk_bf16(h[2], h[3]); *(u32x2*)(H + (size_t)row * FF + hc) = w; } }
    }
};
#undef EPI_ARGS
}
#define MFMA16(X, Y, ACC) __builtin_amdgcn_mfma_f32_16x16x32_bf16((X), (Y), (ACC), 0, 0, 0)
#define WG_SYNC() do { asm volatile("s_waitcnt vmcnt(0) lgkmcnt(0)" ::: "memory"); __builtin_amdgcn_s_barrier(); asm volatile("" ::: "memory"); } while (0)
#define LDS_SYNC() do { asm volatile("s_waitcnt lgkmcnt(0)" ::: "memory"); __builtin_amdgcn_s_barrier(); asm volatile("" ::: "memory"); } while (0)
constexpr int LP = 136;
constexpr int LP64 = 72;
__device__ __forceinline__ bf16x8 lds_frag(const LAS bf16* base, int row, int pitch, int kofs) { return *(const LAS bf16x8*)(base + row * pitch + kofs); }
__device__ __forceinline__ u32x2 pack4(const f32x4 a) { u32x2 w; w.x = cvt_pk_bf16(a[0], a[1]); w.y = cvt_pk_bf16(a[2], a[3]); return w; }

template <int MAP, bool F16>
__device__ __forceinline__ void conv_item(const float* W, int ldw, int K, int n0, const float* gain, bf16* WT, int row_off, LAS float* scr, int item, int nblk, int lane) {
    const int kb = item / nblk, nb = item % nblk, k0 = 64 * kb, nn0 = 64 * nb;
    const int kr = lane >> 4, n4 = (lane & 15) * 4;
    const float* src = W + (size_t)(k0 + kr) * ldw + n0 + nn0 + n4;
    f32x4 v[16];
#pragma unroll
    for (int i = 0; i < 16; ++i) v[i] = *(const f32x4*)(src + (size_t)(4 * i) * ldw);
#pragma unroll
    for (int i = 0; i < 16; ++i) { f32x4 w = v[i]; if (gain) w = w * gain[k0 + 4 * i + kr];
        LAS float* d = scr + (4 * i + kr) * 65 + n4; d[0] = w[0]; d[1] = w[1]; d[2] = w[2]; d[3] = w[3]; }
    LDS_WAIT(); asm volatile("" ::: "memory");
    const int c = lane & 7, nbase = lane >> 3;
#pragma unroll
    for (int j = 0; j < 8; ++j) { const int n = nbase + 8 * j; const LAS float* s = scr + (8 * c) * 65 + n;
        u32x4 o; if (F16) { o.x = cvt_pk_f16(s[0 * 65], s[1 * 65]); o.y = cvt_pk_f16(s[2 * 65], s[3 * 65]); o.z = cvt_pk_f16(s[4 * 65], s[5 * 65]); o.w = cvt_pk_f16(s[6 * 65], s[7 * 65]); }
        else { o.x = cvt_pk_bf16(s[0 * 65], s[1 * 65]); o.y = cvt_pk_bf16(s[2 * 65], s[3 * 65]); o.z = cvt_pk_bf16(s[4 * 65], s[5 * 65]); o.w = cvt_pk_bf16(s[6 * 65], s[7 * 65]); }
        const int nn = nn0 + n; const int dr = MAP == 0 ? nn : ((nn >> 2) * 8 + (nn & 3) + (MAP == 2 ? 4 : 0));
        *(u32x4*)(WT + (size_t)(row_off + dr) * K + k0 + 8 * c) = o; }
    LDS_WAIT(); asm volatile("" ::: "memory");
}
__device__ __forceinline__ void conv_item_nat(const float* W, int ldw, const float* gain, bf16* WN, int item, int nblk, int lane) {
    const int kb = item / nblk, nb = item % nblk, k0 = 64 * kb, nn0 = 64 * nb;
    const int kr = lane >> 4, n4 = (lane & 15) * 4;
    const float* src = W + (size_t)(k0 + kr) * ldw + nn0 + n4; bf16* dst = WN + (size_t)(k0 + kr) * ldw + nn0 + n4;
    f32x4 v[16];
#pragma unroll
    for (int i = 0; i < 16; ++i) v[i] = *(const f32x4*)(src + (size_t)(4 * i) * ldw);
#pragma unroll
    for (int i = 0; i < 16; ++i) { const f32x4 w = v[i] * gain[k0 + 4 * i + kr]; *(u32x2*)(dst + (size_t)(4 * i) * ldw) = pack4(w); }
}
__device__ __forceinline__ void conv_matrix_nat(const float* W, int ldw, int K, const float* gain, bf16* WN, int gw, int NGW, int lane, int& rot) {
    const int nblk = ldw / 64, nitems = (K / 64) * nblk; int first = gw - rot; if (first < 0) first += NGW;
    for (int it = first; it < nitems; it += NGW) conv_item_nat(W, ldw, gain, WN, it, nblk, lane);
    rot = (rot + nitems) % NGW;
}
template <int MAP, bool F16 = false>
__device__ __forceinline__ void conv_matrix(const float* W, int ldw, int K, int n0, int ncols, const float* gain, bf16* WT, int row_off, LAS float* scr, int gw, int NGW, int lane, int& rot) {
    const int nblk = ncols / 64, nitems = (K / 64) * nblk; int first = gw - rot; if (first < 0) first += NGW;
    for (int it = first; it < nitems; it += NGW) conv_item<MAP, F16>(W, ldw, K, n0, gain, WT, row_off, scr, it, nblk, lane);
    rot = (rot + nitems) % NGW;
}

struct In {
    const float *x, *mem, *norm_mix, *norm_xattn, *norm_ffn, *norm_mem, *norm_final, *ab_w_in, *ab_w_out, *lru_conv_w, *lru_conv_b, *lru_w_r, *lru_b_r, *lru_w_i, *lru_b_i, *lru_lambda,
        *hgrn_lb, *hgrn_norm, *ssd_w_in, *ssd_w_out, *ssd_conv_w, *ssd_conv_b, *ssd_dt_bias, *ssd_a_log, *ssd_d, *ssd_norm, *xa_w_q, *xa_w_kv, *xa_w_o, *ffn_w_gate, *ffn_w_up, *ffn_w_down;
};

typedef const In __attribute__((address_space(4))) CIn;
template <int PARTS = 3>
__device__ __forceinline__ void convert_layer(CIn& I, int l, bf16* WL, LAS float* scr, int gw, int NGW, int lane, int& rot) {
    const int e = l >> 1;
    if ((l & 1) == 0) {
        if (PARTS & 1) conv_matrix<0, RF16>(I.ab_w_in + (size_t)e * D * ABIN, ABIN, D, 0, ABIN, I.norm_mix + l * D, WL + WL_IN, 0, scr, gw, NGW, lane, rot);
        if (PARTS & 2) conv_matrix<0>(I.ab_w_out + (size_t)e * D * D, D, D, 0, D, nullptr, WL + WL_OUT, 0, scr, gw, NGW, lane, rot);
    } else {
        if (PARTS & 1) { conv_matrix<0, RF16>(I.ssd_w_in + (size_t)e * D * SSDPROJ, SSDPROJ, D, 0, SSDN1, I.norm_mix + l * D, WL + WL_IN, 0, scr, gw, NGW, lane, rot);
        conv_matrix<0, RF16>(I.ssd_w_in + (size_t)e * D * SSDPROJ, SSDPROJ, D, SSDN1, 64, I.norm_mix + l * D, WL + WL_DT, 0, scr, gw, NGW, lane, rot);
        for (int i = gw * 64 + lane; i < 192 * D / 8; i += NGW * 64) *(u32x4*)(WL + WL_DT + (size_t)64 * D + (size_t)i * 8) = (u32x4){0u, 0u, 0u, 0u}; }
        if (PARTS & 2) conv_matrix<0>(I.ssd_w_out + (size_t)e * SSDIN * D, D, SSDIN, 0, D, nullptr, WL + WL_OUT, 0, scr, gw, NGW, lane, rot);
    }
    if (!(PARTS & 2)) return;
    conv_matrix_nat(I.xa_w_q + (size_t)l * D * D, D, D, I.norm_xattn + l * D, WL + WL_Q, gw, NGW, lane, rot);
    conv_matrix<0>(I.xa_w_o + (size_t)l * D * D, D, D, 0, D, nullptr, WL + WL_O, 0, scr, gw, NGW, lane, rot);
    conv_matrix<1, RF16>(I.ffn_w_gate + (size_t)l * D * FF, FF, D, 0, FF, I.norm_ffn + l * D, WL + WL_GU, 0, scr, gw, NGW, lane, rot);
    conv_matrix<2, RF16>(I.ffn_w_up + (size_t)l * D * FF, FF, D, 0, FF, I.norm_ffn + l * D, WL + WL_GU, 0, scr, gw, NGW, lane, rot);
    conv_matrix<0>(I.ffn_w_down + (size_t)l * FF * D, D, FF, 0, D, nullptr, WL + WL_DN, 0, scr, gw, NGW, lane, rot);
}

template <bool PASSB>
__device__ __forceinline__ void lru_units(const int tid, LAS unsigned char* lds, int G, int cu, const bf16* PROJ, const bf16* WRT, const float* cw, const float* cb, const float* br, const float* bi,
                                          const float* lam, float* SEG, bf16* YAB) {
    const int wid = __builtin_amdgcn_readfirstlane(tid >> 6), lane = tid & 63, q = lane >> 4, c16 = lane & 15;
    LAS bf16* XA = (LAS bf16*)(lds);
    LAS bf16* XC = (LAS bf16*)(lds + 35840);
    LAS bf16* WR = (LAS bf16*)(lds + 70656);
    LAS bf16* WI = (LAS bf16*)(lds + 105472);
    LAS float* PAR = (LAS float*)(lds + 140288);
    LAS float* WT = (LAS float*)(lds + 144384);
    LAS float* HIN = (LAS float*)(lds + 152576);
    int loadedj = -1;
    for (int u = cu; u < 1024; u += G) {
        const int j = u & 7, rest = u >> 3, b = rest >> 5, seg = rest & 31; const int t0 = b * SEQ + seg * 128;
        if (j != loadedj) {
            loadedj = j;
            for (int p = tid; p < 2 * 2048; p += NTHR) { const int g = p >> 11, pp = p & 2047, r = pp >> 4, pc = pp & 15;
                const u32x4 v = *(const u32x4*)(WRT + ((size_t)(g * 8 + j) * 128 + r) * 128 + pc * 8);
                *(LAS u32x4*)((g ? WI : WR) + r * LP + pc * 8) = v; }
            if (tid < 128) { const int ch = j * 128 + tid;
                PAR[0 * 128 + tid] = 8.0f * softplusf(-lam[ch]); PAR[1 * 128 + tid] = br[ch]; PAR[2 * 128 + tid] = bi[ch]; PAR[3 * 128 + tid] = cb[ch];
#pragma unroll
                for (int k = 0; k < 4; ++k) PAR[(4 + k) * 128 + tid] = cw[k * LRUW + ch]; }
        }
        for (int p = tid; p < 131 * 16; p += NTHR) { const int r = p >> 4, pc = p & 15; u32x4 v = (u32x4){0u, 0u, 0u, 0u};
            if (seg > 0 || r >= 3) v = *(const u32x4*)(PROJ + (size_t)(t0 + r - 3) * ABIN + j * 128 + pc * 8);
            *(LAS u32x4*)(XA + r * LP + pc * 8) = v; }
        if (PASSB) { if (tid < 128) { float h = 0.f; const float* sg = SEG + ((size_t)(b * 8 + j) * 32) * 256 + tid * 2;
                for (int s = 0; s < seg; ++s) { const f32x2 ab = *(const f32x2*)(sg + (size_t)s * 256); h = ab.x * h + ab.y; }
                HIN[tid] = h; } }
        WG_SYNC();
        {
            const int ch8 = tid & 15, tr = tid >> 4; u32x4 rows[7];
#pragma unroll
            for (int i = 0; i < 7; ++i) rows[i] = *(const LAS u32x4*)(XA + (4 * tr + i) * LP + ch8 * 8);
            float w[4][8], bb[8];
#pragma unroll
            for (int e = 0; e < 8; ++e) { bb[e] = PAR[3 * 128 + ch8 * 8 + e];
#pragma unroll
                for (int k = 0; k < 4; ++k) w[k][e] = PAR[(4 + k) * 128 + ch8 * 8 + e]; }
#pragma unroll
            for (int i = 0; i < 4; ++i) { float o[8];
#pragma unroll
                for (int e = 0; e < 8; ++e) { float a = bb[e];
#pragma unroll
                    for (int k = 0; k < 4; ++k) { const unsigned wd = rows[i + k][e >> 1]; a += w[k][e] * ((e & 1) ? bfhi(wd) : bflo(wd)); }
                    o[e] = a; }
                u32x4 pk; pk.x = cvt_pk_bf16(o[0], o[1]); pk.y = cvt_pk_bf16(o[2], o[3]); pk.z = cvt_pk_bf16(o[4], o[5]); pk.w = cvt_pk_bf16(o[6], o[7]);
                *(LAS u32x4*)(XC + (4 * tr + i) * LP + ch8 * 8) = pk; }
        }
        WG_SYNC();
        float PP[8][4], HH[8][4];
        {
            bf16x8 xf[4];
#pragma unroll
            for (int ks = 0; ks < 4; ++ks) xf[ks] = lds_frag(XC, 16 * wid + c16, LP, 32 * ks + 8 * q);
#pragma unroll
            for (int jb = 0; jb < 8; ++jb) {
                f32x4 aR = (f32x4){0.f, 0.f, 0.f, 0.f}, aI = aR;
#pragma unroll
                for (int ks = 0; ks < 4; ++ks) { aR = MFMA16(xf[ks], lds_frag(WR, 16 * jb + c16, LP, 32 * ks + 8 * q), aR); aI = MFMA16(xf[ks], lds_frag(WI, 16 * jb + c16, LP, 32 * ks + 8 * q), aI); }
                const int ch = 16 * jb + c16;
                const float sp8 = PAR[ch], pbr = PAR[128 + ch], pbi = PAR[256 + ch], pcb = PAR[384 + ch], w0 = PAR[512 + ch], w1 = PAR[640 + ch], w2 = PAR[768 + ch], w3 = PAR[896 + ch];
                float xr[7];
#pragma unroll
                for (int i = 0; i < 7; ++i) xr[i] = bf2f(XA[(16 * wid + 4 * q + i) * LP + ch]);
                float a[4], bt[4];
#pragma unroll
                for (int r = 0; r < 4; ++r) { const float xc = pcb + w0 * xr[r] + w1 * xr[r + 1] + w2 * xr[r + 2] + w3 * xr[r + 3];
                    const float rg = sigm(aR[r] + pbr), ig = sigm(aI[r] + pbi); const float la = -sp8 * rg;
                    const float av = __expf(la), x2 = 2.0f * la; a[r] = av;
                    const float om = (x2 > -0.02f) ? -x2 * (1.0f + x2 * (0.5f + x2 * 0.16666667f)) : 1.0f - av * av;
                    bt[r] = __builtin_amdgcn_sqrtf(fmaxf(om, 0.f)) * ig * xc; }
                float P[4], H[4]; P[0] = a[0]; H[0] = bt[0];
#pragma unroll
                for (int r = 1; r < 4; ++r) { P[r] = a[r] * P[r - 1]; H[r] = a[r] * H[r - 1] + bt[r]; }
                float Ae = 1.f, Be = 0.f, Aw = 1.f, Bw = 0.f;
#pragma unroll
                for (int qq = 0; qq < 4; ++qq) { const float Aq = __shfl(P[3], c16 + 16 * qq), Bq = __shfl(H[3], c16 + 16 * qq);
                    if (qq < q) { Be = Aq * Be + Bq; Ae = Aq * Ae; }
                    Bw = Aq * Bw + Bq; Aw = Aq * Aw; }
#pragma unroll
                for (int r = 0; r < 4; ++r) { PP[jb][r] = P[r] * Ae; HH[jb][r] = P[r] * Be + H[r]; }
                if (q == 0) *(LAS f32x2*)(WT + (wid * 128 + ch) * 2) = (f32x2){Aw, Bw};
            }
        }
        WG_SYNC();
        if (!PASSB) {
            if (tid < 128) { float A = 1.f, B = 0.f;
#pragma unroll
                for (int w = 0; w < 8; ++w) { const f32x2 ab = *(const LAS f32x2*)(WT + (w * 128 + tid) * 2); B = ab.x * B + ab.y; A = ab.x * A; }
                *(f32x2*)(SEG + ((size_t)(b * 8 + j) * 32 + seg) * 256 + tid * 2) = (f32x2){A, B}; }
        } else {
#pragma unroll
            for (int jb = 0; jb < 8; ++jb) { const int ch = 16 * jb + c16; float h0 = HIN[ch];
                for (int w = 0; w < wid; ++w) { const f32x2 ab = *(const LAS f32x2*)(WT + (w * 128 + ch) * 2); h0 = ab.x * h0 + ab.y; }
#pragma unroll
                for (int r = 0; r < 4; ++r) { const int t = t0 + 16 * wid + 4 * q + r; const float h = PP[jb][r] * h0 + HH[jb][r];
                    const float ga = bf2f(PROJ[(size_t)t * ABIN + 1024 + j * 128 + ch]);
                    YAB[(size_t)t * D + j * 128 + ch] = (bf16)f2bf(ga * h); } }
        }
        WG_SYNC();
    }
}

__device__ __forceinline__ void hgrn1_load(float (&lf)[16], unsigned (&vv)[16], const float* LOGF, const bf16* PROJ, int u, int k, int qt) {
    const int bh = u >> 6, c = u & 63, b = bh >> 3, h = bh & 7; const int t0 = b * SEQ + c * 64 + 16 * qt;
#pragma unroll
    for (int i = 0; i < 16; ++i) { lf[i] = LOGF[(size_t)(t0 + i) * 1024 + h * 128 + k]; vv[i] = PROJ[(size_t)(t0 + i) * ABIN + 4096 + h * 128 + k]; }
}
__device__ __forceinline__ void hgrn1_units(const int tid, LAS unsigned char* lds, int G, int cu, const float* LOGF, const bf16* PROJ, bf16* HST, float* HDEC) {
    const int wid = __builtin_amdgcn_readfirstlane(tid >> 6), lane = tid & 63, q = lane >> 4, c16 = lane & 15;
    LAS bf16* KT = (LAS bf16*)(lds);
    LAS bf16* VT = (LAS bf16*)(lds + 18432);
    LAS float* TOT = (LAS float*)(lds + 36864);
    const int k = tid & 127, qt = tid >> 7;
    float lf[16], nlf[16]; unsigned vv[16], nvv[16];
    if (cu < 2048) hgrn1_load(lf, vv, LOGF, PROJ, cu, k, qt);
    for (int u = cu; u < 2048; u += G) {
        if (u + G < 2048) hgrn1_load(nlf, nvv, LOGF, PROJ, u + G, k, qt);
        float cs[16];
        cs[0] = lf[0];
#pragma unroll
        for (int i = 1; i < 16; ++i) cs[i] = cs[i - 1] + lf[i];
        TOT[qt * 128 + k] = cs[15];
        LDS_SYNC();
        float pre = 0.f, last = 0.f;
#pragma unroll
        for (int qq = 0; qq < 4; ++qq) { const float t = TOT[qq * 128 + k]; if (qq < qt) pre += t; last += t; }
        unsigned kw[8], vw[8];
#pragma unroll
        for (int i = 0; i < 8; ++i) { const float k0 = (1.f - __expf(lf[2 * i])) * __expf(last - (pre + cs[2 * i])), k1 = (1.f - __expf(lf[2 * i + 1])) * __expf(last - (pre + cs[2 * i + 1]));
            kw[i] = cvt_pk_bf16(k0, k1); vw[i] = vv[2 * i] | (vv[2 * i + 1] << 16); }
        *(LAS u32x4*)(KT + k * LP64 + 16 * qt) = (u32x4){kw[0], kw[1], kw[2], kw[3]}; *(LAS u32x4*)(KT + k * LP64 + 16 * qt + 8) = (u32x4){kw[4], kw[5], kw[6], kw[7]};
        *(LAS u32x4*)(VT + k * LP64 + 16 * qt) = (u32x4){vw[0], vw[1], vw[2], vw[3]}; *(LAS u32x4*)(VT + k * LP64 + 16 * qt + 8) = (u32x4){vw[4], vw[5], vw[6], vw[7]};
        if (qt == 0) HDEC[(size_t)u * 128 + k] = __expf(last);
        LDS_SYNC();
        bf16x8 kf[2];
#pragma unroll
        for (int ks = 0; ks < 2; ++ks) kf[ks] = lds_frag(KT, 16 * wid + c16, LP64, 32 * ks + 8 * q);
#pragma unroll
        for (int vb = 0; vb < 8; ++vb) { f32x4 acc = (f32x4){0.f, 0.f, 0.f, 0.f};
#pragma unroll
            for (int ks = 0; ks < 2; ++ks) acc = MFMA16(kf[ks], lds_frag(VT, 16 * vb + c16, LP64, 32 * ks + 8 * q), acc);
            *(u32x2*)(HST + ((size_t)u * 128 + 16 * vb + c16) * 128 + 16 * wid + 4 * q) = pack4(acc); }
        LDS_SYNC();
#pragma unroll
        for (int i = 0; i < 16; ++i) { lf[i] = nlf[i]; vv[i] = nvv[i]; }
    }
    WG_SYNC();
}
__device__ __forceinline__ void hgrn2_scan(const int tid, int G, int cu, bf16* HST, const float* HDEC) {
    for (int task = cu * NTHR + tid; task < 32 * 4096; task += G * NTHR) {
        const int bh = task >> 12, e = (task & 4095) * 4; f32x4 S = (f32x4){0.f, 0.f, 0.f, 0.f};
        bf16* p0 = HST + (size_t)bh * 64 * 16384 + e; const float* d0 = HDEC + (size_t)bh * 64 * 128 + (e & 127);
#pragma unroll 1
        for (int cb = 0; cb < 64; cb += 16) { u32x2 L[16]; f32x4 d[16];
#pragma unroll
            for (int c = 0; c < 16; ++c) { L[c] = *(const u32x2*)(p0 + (size_t)(cb + c) * 16384); d[c] = *(const f32x4*)(d0 + (size_t)(cb + c) * 128); }
#pragma unroll
            for (int c = 0; c < 16; ++c) { *(u32x2*)(p0 + (size_t)(cb + c) * 16384) = pack4(S);
                S[0] = d[c][0] * S[0] + bflo(L[c].x); S[1] = d[c][1] * S[1] + bfhi(L[c].x); S[2] = d[c][2] * S[2] + bflo(L[c].y); S[3] = d[c][3] * S[3] + bfhi(L[c].y); } }
    }
}
__device__ __forceinline__ void hgrn3_load(float (&lf)[16], unsigned (&qv)[16], unsigned (&vv)[16], u32x4 (&st)[4], const float* LOGF, const bf16* PROJ, const bf16* HST, int u, int k, int qt, int tid) {
    const int bh = u >> 6, c = u & 63, b = bh >> 3, h = bh & 7; const int t0 = b * SEQ + c * 64 + 16 * qt;
#pragma unroll
    for (int i = 0; i < 16; ++i) { lf[i] = LOGF[(size_t)(t0 + i) * 1024 + h * 128 + k]; const bf16* pr = PROJ + (size_t)(t0 + i) * ABIN + h * 128 + k; qv[i] = pr[2048]; vv[i] = pr[4096]; }
#pragma unroll
    for (int i = 0; i < 4; ++i) { const int p = tid + NTHR * i, r = p >> 4, pc = p & 15; st[i] = *(const u32x4*)(HST + (size_t)u * 16384 + r * 128 + pc * 8); }
}
__device__ __forceinline__ void hgrn3_units(const int tid, LAS unsigned char* lds, int G, int cu, const float* LOGF, const bf16* PROJ, const bf16* HST, const float* hnorm, bf16* YAB) {
    const int wid = __builtin_amdgcn_readfirstlane(tid >> 6), lane = tid & 63, q = lane >> 4, c16 = lane & 15;
    LAS bf16* QH = (LAS bf16*)(lds);
    LAS bf16* QT = (LAS bf16*)(lds + 17408);
    LAS bf16* KH = (LAS bf16*)(lds + 34816);
    LAS bf16* VT = (LAS bf16*)(lds + 52224);
    LAS bf16* STL = (LAS bf16*)(lds + 70656);
    LAS bf16* PM = (LAS bf16*)(lds + 105472);
    LAS float* TOT = (LAS float*)(lds + 114688);
    LAS float* SQ = (LAS float*)(lds + 116736);
    const int k = tid & 127, qt = tid >> 7;
    float lf[16], nlf[16]; unsigned qv[16], nqv[16], vv[16], nvv[16]; u32x4 st[4], nst[4];
    if (cu < 2048) hgrn3_load(lf, qv, vv, st, LOGF, PROJ, HST, cu, k, qt, tid);
    for (int u = cu; u < 2048; u += G) {
        const int bh = u >> 6, c = u & 63, b = bh >> 3, h = bh & 7; const int tc = b * SEQ + c * 64;
        float cs[16];
        cs[0] = lf[0];
#pragma unroll
        for (int i = 1; i < 16; ++i) cs[i] = cs[i - 1] + lf[i];
        TOT[qt * 128 + k] = cs[15];
#pragma unroll
        for (int i = 0; i < 4; ++i) { const int p = tid + NTHR * i, r = p >> 4, pc = p & 15; *(LAS u32x4*)(STL + r * LP + pc * 8) = st[i]; }
        if (u + G < 2048) hgrn3_load(nlf, nqv, nvv, nst, LOGF, PROJ, HST, u + G, k, qt, tid);
        LDS_SYNC();
        float pre = 0.f;
#pragma unroll
        for (int qq = 0; qq < 4; ++qq) { const float t = TOT[qq * 128 + k]; if (qq < qt) pre += t; }
        const float ref = TOT[k] + TOT[128 + k];
        unsigned vw[8];
#pragma unroll
        for (int i = 0; i < 16; ++i) { const float cum = pre + cs[i], kk = 1.f - __expf(lf[i]), qf = bf2f((bf16)qv[i]);
            QT[(16 * qt + i) * LP + k] = (bf16)f2bf(qf * __expf(cum));
            QH[(16 * qt + i) * LP + k] = (bf16)f2bf(qf * __expf(fminf(cum - ref, 80.f)));
            KH[(16 * qt + i) * LP + k] = (bf16)f2bf(kk * __expf(fminf(ref - cum, 80.f))); }
#pragma unroll
        for (int i = 0; i < 8; ++i) vw[i] = vv[2 * i] | (vv[2 * i + 1] << 16);
        *(LAS u32x4*)(VT + k * LP64 + 16 * qt) = (u32x4){vw[0], vw[1], vw[2], vw[3]}; *(LAS u32x4*)(VT + k * LP64 + 16 * qt + 8) = (u32x4){vw[4], vw[5], vw[6], vw[7]};
        LDS_SYNC();
        {
            const int tb = wid & 3;
            bf16x8 qf[4];
#pragma unroll
            for (int ks = 0; ks < 4; ++ks) qf[ks] = lds_frag(QH, 16 * tb + c16, LP, 32 * ks + 8 * q);
#pragma unroll
            for (int sbi = 0; sbi < 2; ++sbi) { const int sb = 2 * (wid >> 2) + sbi; f32x4 acc = (f32x4){0.f, 0.f, 0.f, 0.f};
#pragma unroll
                for (int ks = 0; ks < 4; ++ks) acc = MFMA16(lds_frag(KH, 16 * sb + c16, LP, 32 * ks + 8 * q), qf[ks], acc);
                const int t = 16 * tb + c16, s0 = 16 * sb + 4 * q;
#pragma unroll
                for (int r = 0; r < 4; ++r) acc[r] = (s0 + r <= t) ? acc[r] : 0.f;
                *(LAS u32x2*)(PM + t * LP64 + s0) = pack4(acc); }
        }
        LDS_SYNC();
        {
            const int tb = wid & 3, vh = wid >> 2, t = 16 * tb + c16;
            bf16x8 qf[4], pf[2];
#pragma unroll
            for (int ks = 0; ks < 4; ++ks) qf[ks] = lds_frag(QT, t, LP, 32 * ks + 8 * q);
#pragma unroll
            for (int ks = 0; ks < 2; ++ks) pf[ks] = lds_frag(PM, t, LP64, 32 * ks + 8 * q);
            f32x4 acc[4]; float sq = 0.f;
#pragma unroll
            for (int vb = 0; vb < 4; ++vb) { const int vr = 64 * vh + 16 * vb + c16; acc[vb] = (f32x4){0.f, 0.f, 0.f, 0.f};
#pragma unroll
                for (int ks = 0; ks < 4; ++ks) acc[vb] = MFMA16(lds_frag(STL, vr, LP, 32 * ks + 8 * q), qf[ks], acc[vb]);
#pragma unroll
                for (int ks = 0; ks < 2; ++ks) acc[vb] = MFMA16(lds_frag(VT, vr, LP64, 32 * ks + 8 * q), pf[ks], acc[vb]);
                sq += (acc[vb][0] * acc[vb][0] + acc[vb][1] * acc[vb][1]) + (acc[vb][2] * acc[vb][2] + acc[vb][3] * acc[vb][3]); }
            sq += __shfl_xor(sq, 16); sq += __shfl_xor(sq, 32);
            if (q == 0) SQ[vh * 64 + t] = sq;
            LDS_SYNC();
            const float rstd = rsqrtf((SQ[t] + SQ[64 + t]) * (1.0f / 128.f) + EPS);
#pragma unroll
            for (int vb = 0; vb < 4; ++vb) { const int v0 = 64 * vh + 16 * vb + 4 * q; const f32x4 hn = *(const f32x4*)(hnorm + h * 128 + v0);
                const u32x2 gw = *(const u32x2*)(PROJ + (size_t)(tc + t) * ABIN + 5120 + h * 128 + v0);
                f32x4 y; y[0] = acc[vb][0] * rstd * hn[0] * bflo(gw.x); y[1] = acc[vb][1] * rstd * hn[1] * bfhi(gw.x); y[2] = acc[vb][2] * rstd * hn[2] * bflo(gw.y); y[3] = acc[vb][3] * rstd * hn[3] * bfhi(gw.y);
                *(u32x2*)(YAB + (size_t)(tc + t) * D + 1024 + h * 128 + v0) = pack4(y); }
        }
        LDS_SYNC();
#pragma unroll
        for (int i = 0; i < 16; ++i) { lf[i] = nlf[i]; qv[i] = nqv[i]; vv[i] = nvv[i]; }
#pragma unroll
        for (int i = 0; i < 4; ++i) st[i] = nst[i];
    }
    WG_SYNC();
}
__device__ __forceinline__ void ssd_prep_load(u32x4 (&rows)[7], const bf16* XBC, int u, int ch8, int tr) {
    const int bc = u / 48, cblk = u % 48, c = bc & 31; const bf16* src = XBC + (size_t)(bc * 128 + 4 * tr - 3) * SSDCONV + cblk * 128 + ch8 * 8;
#pragma unroll
    for (int i = 0; i < 7; ++i) { rows[i] = (u32x4){0u, 0u, 0u, 0u}; if (c > 0 || 4 * tr + i >= 3) rows[i] = *(const u32x4*)(src + (size_t)i * SSDCONV); }
}
__device__ __forceinline__ void ssd_prep_units(const int tid, LAS unsigned char* lds, int ufirst, int ustride, int uend, const bf16* XBC, const float* cw, const float* cb, bf16* XBT, bf16* BCN) {
    LAS bf16* T = (LAS bf16*)(lds);
    const int ch8 = tid & 15, tr = tid >> 4;
    u32x4 rows[7], nrows[7];
    if (ufirst < uend) ssd_prep_load(rows, XBC, ufirst, ch8, tr);
    for (int u = ufirst; u < uend; u += ustride) {
        const int bc = u / 48, cblk = u % 48; const int t0 = bc * 128; const int ch0 = cblk * 128 + ch8 * 8;
        if (u + ustride < uend) ssd_prep_load(nrows, XBC, u + ustride, ch8, tr);
        float w[4][8], bb[8];
        { const f32x4 b0 = *(const f32x4*)(cb + ch0), b1 = *(const f32x4*)(cb + ch0 + 4);
#pragma unroll
          for (int e = 0; e < 4; ++e) { bb[e] = b0[e]; bb[4 + e] = b1[e]; }
#pragma unroll
          for (int k = 0; k < 4; ++k) { const f32x4 w0 = *(const f32x4*)(cw + (size_t)k * SSDCONV + ch0), w1 = *(const f32x4*)(cw + (size_t)k * SSDCONV + ch0 + 4);
#pragma unroll
              for (int e = 0; e < 4; ++e) { w[k][e] = w0[e]; w[k][4 + e] = w1[e]; } } }
        u32x4 ov[4];
#pragma unroll
        for (int i = 0; i < 4; ++i) { float o[8];
#pragma unroll
            for (int e = 0; e < 8; ++e) { float a = bb[e];
#pragma unroll
                for (int k = 0; k < 4; ++k) { const unsigned wd = rows[i + k][e >> 1]; a += w[k][e] * ((e & 1) ? bfhi(wd) : bflo(wd)); }
                o[e] = siluf(a); }
            u32x4 pk; pk.x = cvt_pk_bf16(o[0], o[1]); pk.y = cvt_pk_bf16(o[2], o[3]); pk.z = cvt_pk_bf16(o[4], o[5]); pk.w = cvt_pk_bf16(o[6], o[7]);
            if (cblk >= 32) *(u32x4*)(BCN + (size_t)(t0 + 4 * tr + i) * 2048 + (ch0 - 4096)) = pk;
            ov[i] = pk; }
        if (cblk < 40) {
#pragma unroll
            for (int e = 0; e < 8; ++e) { u32x2 w;
                const unsigned a0 = ov[0][e >> 1], a1 = ov[1][e >> 1], a2 = ov[2][e >> 1], a3 = ov[3][e >> 1];
                if (e & 1) { w.x = (a0 >> 16) | (a1 & 0xffff0000u); w.y = (a2 >> 16) | (a3 & 0xffff0000u); } else { w.x = (a0 & 0xffffu) | (a1 << 16); w.y = (a2 & 0xffffu) | (a3 << 16); }
                *(LAS u32x2*)(T + (ch8 * 8 + e) * LP + 8 * ((tr >> 1) ^ ch8) + 4 * (tr & 1)) = w; }
            LDS_SYNC();
#pragma unroll
            for (int i = 0; i < 4; ++i) { const int p = tid + NTHR * i, r = p >> 4, pc = p & 15;
                *(u32x4*)(XBT + ((size_t)bc * 5120 + cblk * 128 + r) * 128 + pc * 8) = *(const LAS u32x4*)(T + r * LP + 8 * (pc ^ (r >> 3))); }
            LDS_SYNC();
        }
#pragma unroll
        for (int i = 0; i < 7; ++i) rows[i] = nrows[i];
    }
    WG_SYNC();
}
__device__ __forceinline__ float ssd_tables(const float* DT, const float* a_log, int t0, int hd, int wid, int lane, LAS float* CUM, LAS float* DTS) {
    const float an = -__expf(a_log[hd]);
    const float d0 = DT[(size_t)(t0 + 2 * lane) * 64 + hd], d1 = DT[(size_t)(t0 + 2 * lane + 1) * 64 + hd];
    const float a0 = d0 * an, a1 = d1 * an; float v = a0 + a1;
#pragma unroll
    for (int o = 1; o < 64; o <<= 1) { const float t = __shfl_up(v, o); if (lane >= o) v += t; }
    CUM[wid * 128 + 2 * lane] = v - a1; CUM[wid * 128 + 2 * lane + 1] = v; DTS[wid * 128 + 2 * lane] = d0; DTS[wid * 128 + 2 * lane + 1] = d1;
    return __shfl(v, 63);
}
__device__ __forceinline__ void ssd1_units(const int tid, LAS unsigned char* lds, int G, int cu, const bf16* XBT, const float* DT, const float* a_log, bf16* ST, float* DEC) {
    const int wid = __builtin_amdgcn_readfirstlane(tid >> 6), lane = tid & 63, q = lane >> 4, c16 = lane & 15;
    LAS bf16* BT = (LAS bf16*)(lds);
    LAS float* CUM = (LAS float*)(lds + 34816);
    LAS float* DTS = (LAS float*)(lds + 38912);
    for (int u = cu; u < 1024; u += G) {
        const int bc = u >> 3, g = u & 7, t0 = bc * 128, hd = g * 8 + wid;
#pragma unroll
        for (int i = 0; i < 4; ++i) { const int p = tid + NTHR * i, r = p >> 4, pc = p & 15;
            *(LAS u32x4*)(BT + r * LP + pc * 8) = *(const u32x4*)(XBT + ((size_t)bc * 5120 + 4096 + g * 128 + r) * 128 + pc * 8); }
        const float last = ssd_tables(DT, a_log, t0, hd, wid, lane, CUM, DTS);
        if (lane == 0) DEC[bc * 64 + hd] = __expf(last);
        u32x4 xr[4][4];
#pragma unroll
        for (int pb = 0; pb < 4; ++pb)
#pragma unroll
            for (int ks = 0; ks < 4; ++ks) xr[pb][ks] = *(const u32x4*)(XBT + ((size_t)bc * 5120 + hd * 64 + 16 * pb + c16) * 128 + 32 * ks + 8 * q);
        WG_SYNC();
        bf16x8 xf[4][4];
#pragma unroll
        for (int ks = 0; ks < 4; ++ks) { float sc[8];
#pragma unroll
            for (int j = 0; j < 8; ++j) { const int s = 32 * ks + 8 * q + j; sc[j] = DTS[wid * 128 + s] * __expf(last - CUM[wid * 128 + s]); }
#pragma unroll
            for (int pb = 0; pb < 4; ++pb) { u32x4 o;
#pragma unroll
                for (int e = 0; e < 4; ++e) o[e] = cvt_pk_bf16(bflo(xr[pb][ks][e]) * sc[2 * e], bfhi(xr[pb][ks][e]) * sc[2 * e + 1]);
                xf[pb][ks] = __builtin_bit_cast(bf16x8, o); } }
#pragma unroll
        for (int nb = 0; nb < 8; ++nb) { bf16x8 bf[4];
#pragma unroll
            for (int ks = 0; ks < 4; ++ks) bf[ks] = lds_frag(BT, 16 * nb + c16, LP, 32 * ks + 8 * q);
#pragma unroll
            for (int pb = 0; pb < 4; ++pb) { f32x4 acc = (f32x4){0.f, 0.f, 0.f, 0.f};
#pragma unroll
                for (int ks = 0; ks < 4; ++ks) acc = MFMA16(bf[ks], xf[pb][ks], acc);
                *(u32x2*)(ST + (((size_t)bc * 64 + hd) * 64 + 16 * pb + c16) * 128 + 16 * nb + 4 * q) = pack4(acc); } }
        WG_SYNC();
    }
}
__device__ __forceinline__ void ssd2_scan(const int tid, int G, int cu, bf16* ST, const float* DEC) {
    for (int task = cu * NTHR + tid; task < NB * 4096 * 32; task += G * NTHR) {
        const int b = task >> 17, r = task & 131071, hp = r >> 5, n4 = (r & 31) * 4, hd = hp >> 6; f32x4 S = (f32x4){0.f, 0.f, 0.f, 0.f};
        bf16* p0 = ST + ((size_t)(b * 32) * 4096 + hp) * 128 + n4; const float* d0 = DEC + (b * 32) * 64 + hd;
        u32x2 L[32]; float d[32];
#pragma unroll
        for (int c = 0; c < 32; ++c) { L[c] = *(const u32x2*)(p0 + (size_t)c * 4096 * 128); d[c] = d0[c * 64]; }
#pragma unroll
        for (int c = 0; c < 32; ++c) { *(u32x2*)(p0 + (size_t)c * 4096 * 128) = pack4(S);
            S[0] = d[c] * S[0] + bflo(L[c].x); S[1] = d[c] * S[1] + bfhi(L[c].x); S[2] = d[c] * S[2] + bflo(L[c].y); S[3] = d[c] * S[3] + bfhi(L[c].y); }
    }
}
__device__ __forceinline__ void ssd3_units(const int tid, LAS unsigned char* lds, int G, int cu, const bf16* XBT, const bf16* BCN, const bf16* ST, const float* DT, const float* a_log, const float* dskip,
                                           const bf16* Z, const float* normw, bf16* Y) {
    const int wid = __builtin_amdgcn_readfirstlane(tid >> 6), lane = tid & 63, q = lane >> 4, c16 = lane & 15;
    LAS bf16* CN = (LAS bf16*)(lds);
    LAS bf16* BN = (LAS bf16*)(lds + 34816);
    LAS bf16* CB = (LAS bf16*)(lds + 69632);
    LAS float* CUM = (LAS float*)(lds + 104448);
    LAS float* DTS = (LAS float*)(lds + 108544);
    LAS float* SQP = (LAS float*)(lds + 112640);
    for (int u = cu; u < 1024; u += G) {
        const int bc = u >> 3, g = u & 7, t0 = bc * 128, hd = g * 8 + wid;
#pragma unroll
        for (int i = 0; i < 4; ++i) { const int p = tid + NTHR * i, r = p >> 4, pc = p & 15; const bf16* src = BCN + (size_t)(t0 + r) * 2048 + g * 128 + pc * 8;
            *(LAS u32x4*)(BN + r * LP + pc * 8) = *(const u32x4*)src; *(LAS u32x4*)(CN + r * LP + pc * 8) = *(const u32x4*)(src + 1024); }
        (void)ssd_tables(DT, a_log, t0, hd, wid, lane, CUM, DTS);
        bf16x8 sf[4][4];
        const bf16* xb = XBT + ((size_t)bc * 5120 + hd * 64 + c16) * 128 + 8 * q;
        { const bf16* sb = ST + (((size_t)bc * 64 + hd) * 64 + c16) * 128 + 8 * q;
#pragma unroll
          for (int pb = 0; pb < 4; ++pb)
#pragma unroll
              for (int ks = 0; ks < 4; ++ks) sf[pb][ks] = *(const bf16x8*)(sb + (size_t)(16 * pb) * 128 + 32 * ks); }
        WG_SYNC();
        {
            bf16x8 cf[4];
#pragma unroll
            for (int ks = 0; ks < 4; ++ks) cf[ks] = lds_frag(CN, 16 * wid + c16, LP, 32 * ks + 8 * q);
#pragma unroll
            for (int sb = 0; sb < 8; ++sb) { if (sb > wid + 1) continue; f32x4 acc = (f32x4){0.f, 0.f, 0.f, 0.f};
#pragma unroll
                for (int ks = 0; ks < 4; ++ks) acc = MFMA16(lds_frag(BN, 16 * sb + c16, LP, 32 * ks + 8 * q), cf[ks], acc);
                *(LAS u32x2*)(CB + (16 * wid + c16) * LP + 16 * sb + 4 * q) = pack4(acc); }
        }
        WG_SYNC();
        const float dsk = dskip[hd];
        bf16* ybase = Y + (size_t)t0 * SSDIN + hd * 64 + 4 * q; const bf16* zbase = Z + (size_t)t0 * SSDIN + hd * 64 + 4 * q;
        const f32x4 nw0 = *(const f32x4*)(normw + hd * 64 + 4 * q), nw1 = *(const f32x4*)(normw + hd * 64 + 16 + 4 * q), nw2 = *(const f32x4*)(normw + hd * 64 + 32 + 4 * q), nw3 = *(const f32x4*)(normw + hd * 64 + 48 + 4 * q);
#pragma unroll 1
        for (int tp = 0; tp < 8; ++tp) {
        u32x2 yk[1][4];
#pragma unroll
        for (int tt = 0; tt < 1; ++tt) { const int tb = tp;
            const int tl = 16 * tb + c16; const float cumt = CUM[wid * 128 + tl], ect = __expf(cumt);
            f32x4 acc[4];
            { bf16x8 cf[4];
#pragma unroll
              for (int ks = 0; ks < 4; ++ks) cf[ks] = lds_frag(CN, tl, LP, 32 * ks + 8 * q);
#pragma unroll
              for (int pb = 0; pb < 4; ++pb) { acc[pb] = (f32x4){0.f, 0.f, 0.f, 0.f};
#pragma unroll
                  for (int ks = 0; ks < 4; ++ks) acc[pb] = MFMA16(sf[pb][ks], cf[ks], acc[pb]);
                  acc[pb] = acc[pb] * ect; } }
#pragma unroll
            for (int ks = 0; ks < 4; ++ks) { if (32 * ks > 16 * tb + 15) continue;
                const int s0 = 32 * ks + 8 * q; const u32x4 cbw = *(const LAS u32x4*)(CB + tl * LP + s0);
                const f32x4 c0 = *(const LAS f32x4*)(CUM + wid * 128 + s0), c1 = *(const LAS f32x4*)(CUM + wid * 128 + s0 + 4), d0 = *(const LAS f32x4*)(DTS + wid * 128 + s0), d1 = *(const LAS f32x4*)(DTS + wid * 128 + s0 + 4);
                float gv[8];
#pragma unroll
                for (int j = 0; j < 8; ++j) { const int s = s0 + j; const float cb = (j & 1) ? bfhi(cbw[j >> 1]) : bflo(cbw[j >> 1]); const float cs = j < 4 ? c0[j & 3] : c1[j & 3], ds = j < 4 ? d0[j & 3] : d1[j & 3];
                    float v = cb * __expf(fminf(cumt - cs, 0.f)) * ds; v = (s <= tl) ? v : 0.f; gv[j] = (s == tl) ? v + dsk : v; }
                u32x4 gw; gw.x = cvt_pk_bf16(gv[0], gv[1]); gw.y = cvt_pk_bf16(gv[2], gv[3]); gw.z = cvt_pk_bf16(gv[4], gv[5]); gw.w = cvt_pk_bf16(gv[6], gv[7]);
                const bf16x8 gf = __builtin_bit_cast(bf16x8, gw);
#pragma unroll
                for (int pb = 0; pb < 4; ++pb) acc[pb] = MFMA16(*(const bf16x8*)(xb + (size_t)(16 * pb) * 128 + 32 * ks), gf, acc[pb]);
            }
            float sq = 0.f;
#pragma unroll
            for (int pb = 0; pb < 4; ++pb) { const u32x2 zw = *(const u32x2*)(zbase + (size_t)tl * SSDIN + 16 * pb);
                f32x4 y; y[0] = acc[pb][0] * bflo(zw.x); y[1] = acc[pb][1] * bfhi(zw.x); y[2] = acc[pb][2] * bflo(zw.y); y[3] = acc[pb][3] * bfhi(zw.y);
                sq += (y[0] * y[0] + y[1] * y[1]) + (y[2] * y[2] + y[3] * y[3]); yk[tt][pb] = pack4(y); }
            sq += __shfl_xor(sq, 16); sq += __shfl_xor(sq, 32);
            if (q == 0) SQP[tl * 8 + wid] = sq;
        }
        WG_SYNC();
#pragma unroll
        for (int tt = 0; tt < 1; ++tt) { const int tl = 16 * tp + c16; const f32x4 s0 = *(const LAS f32x4*)(SQP + tl * 8), s1 = *(const LAS f32x4*)(SQP + tl * 8 + 4);
            const float rstd = rsqrtf((((s0[0] + s0[1]) + (s0[2] + s0[3])) + ((s1[0] + s1[1]) + (s1[2] + s1[3]))) * (1.0f / 512.f) + EPS);
#pragma unroll
            for (int pb = 0; pb < 4; ++pb) { bf16* yp = ybase + (size_t)tl * SSDIN + 16 * pb; const u32x2 w = yk[tt][pb]; const f32x4 nw = pb == 0 ? nw0 : pb == 1 ? nw1 : pb == 2 ? nw2 : nw3;
                f32x4 y; y[0] = bflo(w.x) * rstd * nw[0]; y[1] = bfhi(w.x) * rstd * nw[1]; y[2] = bflo(w.y) * rstd * nw[2]; y[3] = bfhi(w.y) * rstd * nw[3];
                *(u32x2*)yp = pack4(y); } }
        }
        WG_SYNC();
    }
}
#ifndef REP_GEMM
#define REP_GEMM 1
#endif
#if REP_GEMM == 2
#define GEMM_REP(...) { __VA_ARGS__ } { __VA_ARGS__ }
#else
#define GEMM_REP(...) { __VA_ARGS__ }
#endif
#ifndef REP_MIX
#define REP_MIX 1
#endif
#ifndef REP_CONV
#define REP_CONV 1
#endif
struct Args { In in; float* out; unsigned char* ws; int ph_lo, ph_hi; };
static_assert(sizeof(Args) == 32 * 8 + 8 + 8 + 8, "Args has no padding");
typedef const Args __attribute__((address_space(4))) CArgs;

#ifndef SLEEP_MASK
#define SLEEP_MASK 0ull
#endif
#define SLEEP_AMP 4
#define PHASE_BEGIN if (pc >= lo && pc < hi) { const unsigned long long t0_ = SLEEP_MASK ? __builtin_amdgcn_s_memrealtime() : 0ull; (void)t0_; int tid = wave0 * 64 + (int)__builtin_amdgcn_mbcnt_hi(~0u, __builtin_amdgcn_mbcnt_lo(~0u, 0u)); asm volatile("" : "+v"(tid)); int cu = blockIdx.x; asm volatile("" : "+s"(cu)); int G = gridDim.x; asm volatile("" : "+s"(G)); \
        const int lane = tid & 63, wave = __builtin_amdgcn_readfirstlane(tid >> 6), gw = cu * NWAVES + wave, NGW = G * NWAVES; (void)lane; (void)gw; (void)NGW; \
        CArgs* ap = (CArgs*)__builtin_amdgcn_kernarg_segment_ptr(); asm volatile("" : "+s"(ap)); CIn& I = ap->in; unsigned char* const ws = ap->ws; float* const xres = ap->out; \
        unsigned char* const act = ws + WS_ACT; float* const SS = (float*)(ws + WS_SS); bf16* const XB = (bf16*)(ws + WS_XB); bf16* const WL = (bf16*)(ws + WS_WL); (void)I; (void)xres; (void)act; (void)SS; (void)XB; (void)WL;
#if MK_SPLIT
#define PHASE_END } ++pc;
#else
#define PHASE_END if (pc + 1 < hi) xcd_barrier(bar); if (SLEEP_MASK && ((SLEEP_MASK >> pc) & 1ull)) { const unsigned long long t1_ = __builtin_amdgcn_s_memrealtime(), until_ = t1_ + SLEEP_AMP * (t1_ - t0_); while (__builtin_amdgcn_s_memrealtime() < until_) __builtin_amdgcn_s_sleep(8); } } ++pc;
#endif
#define PHASE_END_LOCAL } ++pc;
#define D_WKV ((bf16*)(ws + WS_WKV))
#define D_KMAT ((bf16*)(ws + WS_KMAT))
#define D_VT ((bf16*)(ws + WS_VT))
#define D_MEMN ((bf16*)(ws + WS_MEMN))
#define D_LB ((float*)(ws + WS_TAB + TAB_LB))
#define D_WRT ((bf16*)(ws + WS_TAB + TAB_WRT))


#define KQb ((bf16*)(ws + WS_KQ))
#define VWb ((bf16*)(ws + WS_VW))
#define Pb ((bf16*)(act + A_P))
#define Hb ((bf16*)(act + A_H))
#define ABSORB_UNIT \
            if (cu < 256) { int nu = 1, kk = XAD; asm volatile("" : "+s"(nu), "+s"(kk)); const int iskq = cu < 128, idx = cu & 127, bh = idx >> 3, t8 = idx & 7, b = bh >> 2, h = bh & 3; \
                const bf16* Km = D_KMAT + (size_t)l * MEMROWS * D; const bf16* Vm = D_VT + (size_t)l * MEMROWS * D; \
                pg8::SchedOne S; S.n = nu; \
                S.u0.a = iskq ? (const char*)(Km + (size_t)(b * MEMLEN) * D + h * XAD) : (const char*)(WLL + WL_O + (size_t)(t8 * 256) * D + h * XAD); \
                S.u0.b = iskq ? (const char*)(WLL + WL_Q + (size_t)(t8 * 256) * D + h * XAD) : (const char*)(Vm + (size_t)(b * MEMLEN) * D + h * XAD); \
                S.u0.orow = iskq ? bh * 256 : t8 * 256; S.u0.ocol = iskq ? t8 * 256 : h * 256; S.u0.aux = 0; \
                pg8::EpiPlain E{iskq ? KQb : VWb + (size_t)b * D * 1024, iskq ? D : 1024}; pg8::gemm_phase(tid, lds, kk, D, D, S, E); }
template <int l>
__device__ __forceinline__ void layer_body(LAS unsigned char* lds, const int wave0, const int lo, const int hi, int& pc, const XcdBarrier& bar) {
    int ssi = 3 * l;
#define WLL ((bf16*)(ws + ((l & 1) ? WS_WL2 : WS_WL)))
#define WLN ((bf16*)(ws + ((l & 1) ? WS_WL : WS_WL2)))

        const int e = l >> 1;
        int mixK;
        if ((l & 1) == 0) {
#define PROJ ((bf16*)(act + A_PROJ))
#define LOGF ((float*)(act + A_LOGF))
#define HST ((bf16*)(act + A_HST))
#define YAB ((bf16*)(act + A_YAB))
#define SEG ((float*)(act + A_SEG))
#define HDEC ((float*)(act + A_HDEC))
            PHASE_BEGIN
                if (l == 0 && (cu & 1)) { int rot = 0; convert_layer<2>(I, 0, WLL, (LAS float*)(lds + wave * 16640), gw, NGW, lane, rot); WG_SYNC(); asm volatile("" : "+v"(tid)); }
                if (l == 0) { pg8::SchedKV S{(const char*)D_MEMN, (const char*)D_WKV, G, cu}; pg8::EpiKV E{D_KMAT, D_VT}; pg8::gemm_phase(tid, lds, D, D, D, S, E); asm volatile("" : "+v"(tid)); }
                GEMM_REP(pg8::SchedMN S; S.init(XB, D, WLL + WL_IN, D, M, ABIN, G, cu); pg8::EpiProjEven E{SS + (size_t)ssi * M * 8, PROJ, LOGF, D_LB + e * 1024};
                pg8::gemm_phase<RF16>(tid, lds, D, D, D, S, E);)
                if (l == 0 && !(cu & 1)) { asm volatile("" : "+v"(tid)); const int lane2 = tid & 63, wave2 = __builtin_amdgcn_readfirstlane(tid >> 6); int rot = 0; convert_layer<2>(I, 0, WLL, (LAS float*)(lds + wave2 * 16640), cu * NWAVES + wave2, NGW, lane2, rot); }
            PHASE_END
            PHASE_BEGIN
                for (int rep_ = 0; rep_ < REP_MIX; ++rep_) { lru_units<false>(tid, lds, G, cu, PROJ, D_WRT + (size_t)e * 2 * 8 * 16384, I.lru_conv_w + e * 4 * LRUW, I.lru_conv_b + e * LRUW, I.lru_b_r + e * LRUW, I.lru_b_i + e * LRUW, I.lru_lambda + e * LRUW, SEG, YAB);
                hgrn1_units(tid, lds, G, cu, LOGF, PROJ, HST, HDEC); }
            PHASE_END
            PHASE_BEGIN
                for (int rep_ = 0; rep_ < REP_MIX; ++rep_) { lru_units<true>(tid, lds, G, cu, PROJ, D_WRT + (size_t)e * 2 * 8 * 16384, I.lru_conv_w + e * 4 * LRUW, I.lru_conv_b + e * LRUW, I.lru_b_r + e * LRUW, I.lru_b_i + e * LRUW, I.lru_lambda + e * LRUW, SEG, YAB); }
                hgrn2_scan(tid, G, cu, HST, HDEC);
            PHASE_END
            PHASE_BEGIN
                if (cu & 1) { ABSORB_UNIT asm volatile("" : "+v"(tid)); }
                for (int rep_ = 0; rep_ < REP_MIX; ++rep_) { hgrn3_units(tid, lds, G, cu, LOGF, PROJ, HST, I.hgrn_norm + e * 1024, YAB); }
                if (!(cu & 1)) { WG_SYNC(); asm volatile("" : "+v"(tid)); ABSORB_UNIT }
            PHASE_END
            mixK = D;
        } else {
#define Zb ((bf16*)(act + A_Z))
#define XBC ((bf16*)(act + A_XBC))
#define XBT ((bf16*)(act + A_XBT))
#define BCN ((bf16*)(act + A_BCN))
#define STb ((bf16*)(act + A_ST))
#define DTb ((float*)(act + A_DT))
#define DEC ((float*)(act + A_DEC))
#define Yb ((bf16*)(act + A_Y))
            PHASE_BEGIN
                GEMM_REP(pg8::SchedMN S; S.init(XB, D, WLL + WL_IN, D, M, SSDN1, G, cu); pg8::EpiProjOdd E{SS + (size_t)ssi * M * 8, Zb, XBC};
                pg8::gemm_phase<RF16>(tid, lds, D, D, D, S, E);)
            PHASE_END
            PHASE_BEGIN
                for (int rep_ = 0; rep_ < REP_MIX; ++rep_) {
                { pg8::SchedDt S{(const char*)XB, (const char*)(WLL + WL_DT), cu}; pg8::EpiDt E{SS + (size_t)ssi * M * 8, I.ssd_dt_bias + e * 64, DTb};
                  pg8::gemm_phase<RF16>(tid, lds, D, D, D, S, E); }
                { int uf = cu, us = G, ue = 6144; if (G == 256) { if (cu < 64) { us = 64; ue = 1152; } else { uf = 1152 + (cu - 64); us = 192; } }
                  ssd_prep_units(tid, lds, uf, us, ue, XBC, I.ssd_conv_w + (size_t)e * 4 * SSDCONV, I.ssd_conv_b + e * SSDCONV, XBT, BCN); }
                }
            PHASE_END
            PHASE_BEGIN
                for (int rep_ = 0; rep_ < REP_MIX; ++rep_) { ssd1_units(tid, lds, G, cu, XBT, DTb, I.ssd_a_log + e * 64, STb, DEC); }
            PHASE_END
            PHASE_BEGIN
                ssd2_scan(tid, G, cu, STb, DEC);
            PHASE_END
            PHASE_BEGIN
                if (cu & 1) { ABSORB_UNIT asm volatile("" : "+v"(tid)); }
                for (int rep_ = 0; rep_ < REP_MIX; ++rep_) { ssd3_units(tid, lds, G, cu, XBT, BCN, STb, DTb, I.ssd_a_log + e * 64, I.ssd_d + e * 64, Zb, I.ssd_norm + e * SSDIN, Yb); }
                if (!(cu & 1)) { WG_SYNC(); asm volatile("" : "+v"(tid)); ABSORB_UNIT }
            PHASE_END
            mixK = SSDIN;
        }
        PHASE_BEGIN
            { pg8::SchedMN S; S.init(mixK == D ? (const bf16*)YAB : (const bf16*)Yb, mixK, WLL + WL_OUT, mixK, M, D, G, cu); pg8::EpiResid E{XB, SS + (size_t)(ssi + 1) * M * 8, (LAS float*)(lds + EPI_OFF)};
              pg8::gemm_phase(tid, lds, mixK, mixK, mixK, S, E); asm volatile("" : "+v"(tid)); }
        PHASE_END
        ++ssi;
        PHASE_BEGIN
            static_assert(!RF16, "the absorbed key matrix is bf16: the residual stream must be bf16 too");
            if (cu < 256) { const int pm = (cu & 7) * 8 + (cu >> 5), h = (cu >> 3) & 3;     int nu = 1; asm volatile("" : "+s"(nu));
                pg8::SchedOne S; S.n = nu; S.u0.a = (const char*)(XB + (size_t)pm * 256 * D); S.u0.b = (const char*)(KQb + (size_t)(((pm >> 4) * 4 + h) * 256) * D); S.u0.orow = pm * 256; S.u0.ocol = h * 256; S.u0.aux = 0;
                pg8::EpiSoftmax E{SS + (size_t)ssi * M * 8, 0.044194173824159216f, Pb, (LAS float*)(lds + EPI_OFF)}; pg8::gemm_phase(tid, lds, D, D, D, S, E); }
        PHASE_END
        PHASE_BEGIN
            pg8::SchedMNB S; S.init(Pb, 1024, VWb, 1024, M, D, G, cu, (size_t)D * 1024 * 2); pg8::EpiResid E{XB, SS + (size_t)(ssi + 1) * M * 8, (LAS float*)(lds + EPI_OFF)};
            pg8::gemm_phase(tid, lds, 1024, 1024, 1024, S, E);
        PHASE_END
        ++ssi;
        PHASE_BEGIN
            if (l + 1 < DEPTH && (cu & 1)) { int rot = 0; convert_layer(I, l + 1, WLN, (LAS float*)(lds + wave * 16640), gw, NGW, lane, rot); WG_SYNC(); asm volatile("" : "+v"(tid)); }
            GEMM_REP(pg8::SchedMN S; S.init(XB, D, WLL + WL_GU, D, M, 2 * FF, G, cu); pg8::EpiGateUp E{SS + (size_t)ssi * M * 8, Hb};
            pg8::gemm_phase<RF16>(tid, lds, D, D, D, S, E);)
            if (l + 1 < DEPTH && !(cu & 1)) { asm volatile("" : "+v"(tid)); const int lane2 = tid & 63, wave2 = __builtin_amdgcn_readfirstlane(tid >> 6); int rot = 0; convert_layer(I, l + 1, WLN, (LAS float*)(lds + wave2 * 16640), cu * NWAVES + wave2, NGW, lane2, rot); }
        PHASE_END
        PHASE_BEGIN
            pg8::SchedMN S; S.init(Hb, FF, WLL + WL_DN, FF, M, D, G, cu); pg8::EpiResid E{XB, SS + (size_t)(ssi + 1) * M * 8, (LAS float*)(lds + EPI_OFF)};
            pg8::gemm_phase(tid, lds, FF, FF, FF, S, E);
        PHASE_END
        ++ssi;
    }

__global__ void __launch_bounds__(NTHR, 2) fwd(Args args) {
    extern __shared__ __attribute__((aligned(16))) unsigned char lds_raw[];
    LAS unsigned char* lds = (LAS unsigned char*)lds_raw;
    volatile LAS unsigned* MISC = (volatile LAS unsigned*)(lds + MISC_OFF);
    const int wave0 = __builtin_amdgcn_readfirstlane((int)threadIdx.x >> 6);
    if (threadIdx.x < 64) MISC[threadIdx.x] = 0u;
    __syncthreads();
#if !MK_SPLIT
    XcdBarrier bar = xcd_barrier_post((unsigned*)(args.ws + WS_CTL), MISC + 8);
#else
    XcdBarrier bar; bar.bar = nullptr; bar.x = 0; bar.st = nullptr;
#endif
    const int lo = args.ph_lo, hi = args.ph_hi; int pc = 0;
    PHASE_BEGIN
        LAS float* scr = (LAS float*)(lds + wave * 16640);
        int rot = 0;
        for (int l = 0; l < DEPTH; ++l) conv_matrix<0>(I.xa_w_kv + (size_t)l * D * 4096, 4096, D, 0, 4096, nullptr, D_WKV + (size_t)l * 4096 * D, 0, scr, gw, NGW, lane, rot);
        for (int rep_ = 0; rep_ < REP_CONV; ++rep_) convert_layer<1>(I, 0, WL, scr, gw, NGW, lane, rot);
        for (int m = gw; m < MEMROWS; m += NGW) {
            const f32x4* xr = (const f32x4*)(I.mem + (size_t)m * D); f32x4 v[8]; float s = 0.f;
#pragma unroll
            for (int j = 0; j < 8; ++j) { v[j] = xr[64 * j + lane]; s += (v[j][0] * v[j][0] + v[j][1] * v[j][1]) + (v[j][2] * v[j][2] + v[j][3] * v[j][3]); }
            const float rs = rsqrtf(wave_sum(s) * (1.0f / D) + EPS);
#pragma unroll
            for (int j = 0; j < 8; ++j) { const f32x4 g = *(const f32x4*)(I.norm_mem + (64 * j + lane) * 4); *(u32x2*)(D_MEMN + (size_t)m * D + (64 * j + lane) * 4) = pack4(v[j] * rs * g); }
        }
        for (int m = gw; m < M; m += NGW) {
            const f32x4* xr = (const f32x4*)(I.x + (size_t)m * D); float s = 0.f;
#pragma unroll
            for (int j = 0; j < 8; ++j) { const f32x4 v = xr[64 * j + lane]; s += (v[0] * v[0] + v[1] * v[1]) + (v[2] * v[2] + v[3] * v[3]); u32x2 w; w.x = rs_pk(v[0], v[1]); w.y = rs_pk(v[2], v[3]); *(u32x2*)(XB + (size_t)m * D + (64 * j + lane) * 4) = w; }
            s = wave_sum(s); if (lane < 8) SS[(size_t)m * 8 + lane] = lane == 0 ? s : 0.f;
        }
        for (int i = cu * NTHR + tid; i < 1024; i += G * NTHR) {
            const float a = I.hgrn_lb[i], b = I.hgrn_lb[1024 + i], mx = fmaxf(a, b), e0 = __expf(a - mx), e1 = __expf(b - mx); D_LB[i] = 0.f; D_LB[1024 + i] = e1 / (e0 + e1); }
        for (int i = cu * NTHR + tid; i < 2 * 2 * 8 * 16384; i += G * NTHR) {
            const int ii = i & 127, jj = (i >> 7) & 127, blk = (i >> 14) & 7, gt = (i >> 17) & 1, e = i >> 18;
            const float* src = gt ? I.lru_w_i : I.lru_w_r; D_WRT[i] = (bf16)f2bf(src[((size_t)(e * 8 + blk) * 128 + ii) * 128 + jj]); }
    PHASE_END

    layer_body<0>(lds, wave0, lo, hi, pc, bar); layer_body<1>(lds, wave0, lo, hi, pc, bar); layer_body<2>(lds, wave0, lo, hi, pc, bar); layer_body<3>(lds, wave0, lo, hi, pc, bar);
    const int ssi = 12;
    PHASE_BEGIN
        const float* ssf = SS + (size_t)ssi * M * 8;
        for (int m = gw; m < M; m += NGW) { f32x4* row = (f32x4*)(xres + (size_t)m * D); const u32x2* xr = (const u32x2*)(XB + (size_t)m * D); const float rs = pg8::rstd_of(ssf, m);
#pragma unroll
            for (int j = 0; j < 8; ++j) { const f32x4 g = *(const f32x4*)(I.norm_final + (64 * j + lane) * 4); const u32x2 w = xr[64 * j + lane];
                f32x4 o; o[0] = rs_lo(w.x) * rs * g[0]; o[1] = rs_hi(w.x) * rs * g[1]; o[2] = rs_lo(w.y) * rs * g[2]; o[3] = rs_hi(w.y) * rs * g[3]; row[64 * j + lane] = o; } }
    PHASE_END
#undef PHASE_BEGIN
#undef PHASE_END
}

constexpr int NPHASES = 1 + (5 + 4) + (6 + 4) + (5 + 4) + (6 + 4) + 1;

extern "C" void kernel_launch(void* const* d_in, const int* in_sizes, int n_in, void* d_out, int out_size, void* d_ws, size_t ws_size, hipStream_t stream) {
    static int grid = 0;
    if (grid == 0) {
        if (n_in != 32 || out_size != M * D || ws_size < WS_END) { fprintf(stderr, "kernel_launch: unexpected problem (n_in %d, out %d, ws %zu)\n", n_in, out_size, ws_size); grid = -1; return; }
        int dev = 0, cus = 0;
        if (hipGetDevice(&dev) != hipSuccess || hipDeviceGetAttribute(&cus, hipDeviceAttributeMultiprocessorCount, dev) != hipSuccess) { grid = -1; return; }
        if (hipFuncSetAttribute((const void*)fwd, hipFuncAttributeMaxDynamicSharedMemorySize, LDS_BYTES) != hipSuccess) { fprintf(stderr, "kernel_launch: hipFuncSetAttribute failed\n"); grid = -1; return; }
        int per_cu = 0;
        if (hipOccupancyMaxActiveBlocksPerMultiprocessor(&per_cu, (const void*)fwd, NTHR, LDS_BYTES) != hipSuccess || per_cu < 1) fprintf(stderr, "kernel_launch: occupancy query says %d\n", per_cu);
        (void)hipGetLastError();
        if (cus != 256) { fprintf(stderr, "kernel_launch: built for a 256-CU device (got %d)\n", cus); grid = -1; return; }
        grid = cus;
    }
    if (grid < 0) return;
    (void)hipMemsetAsync((char*)d_ws + WS_CTL, 0, CTL_ZERO_BYTES, stream);
    Args a{};
    const float** ip = (const float**)&a.in;
    for (int i = 0; i < 32; ++i) ip[i] = (const float*)d_in[i];
    a.out = (float*)d_out; a.ws = (unsigned char*)d_ws;
#if MK_SPLIT
#ifndef PROBE_MASK
#define PROBE_MASK 0ull
#endif
    for (int li = 0; li < NPHASES; ++li) { a.ph_lo = li; a.ph_hi = li + 1; hipLaunchKernelGGL(fwd, dim3(grid), dim3(NTHR), LDS_BYTES, stream, a);
        if ((PROBE_MASK >> li) & 1ull) hipLaunchKernelGGL(fwd, dim3(grid), dim3(NTHR), LDS_BYTES, stream, a); }
#else
    a.ph_lo = 0; a.ph_hi = NPHASES;
    hipLaunchKernelGGL(fwd, dim3(grid), dim3(NTHR), LDS_BYTES, stream, a);
#endif
}
```

```cpp
#include <hip/hip_runtime.h>
#include <cstdio>
#include <cstdint>

#ifndef MK_SPLIT
#define MK_SPLIT 0
#endif

#ifndef RESID_F16
#define RESID_F16 0
#endif
constexpr bool RF16 = RESID_F16 != 0;
#define GAS __attribute__((address_space(1)))
#define LAS __attribute__((address_space(3)))
typedef unsigned short bf16;
typedef short bf16x8 __attribute__((ext_vector_type(8)));
typedef float f32x4 __attribute__((ext_vector_type(4)));
typedef float f32x2 __attribute__((ext_vector_type(2)));
typedef unsigned u32x4 __attribute__((ext_vector_type(4)));
typedef unsigned u32x2 __attribute__((ext_vector_type(2)));

constexpr int D = 2048, NB = 4, SEQ = 4096, M = NB * SEQ, DEPTH = 4, MEMLEN = 256, MEMROWS = NB * MEMLEN;
constexpr int LRUW = 1024, ABIN = 6144;
constexpr int SSDIN = 4096, SSDCONV = 6144, SSDPROJ = 10304, SSDN1 = 10240, NHEADS = 64;
constexpr int XAD = 512, FF = 5632;
constexpr float EPS = 1e-6f;
constexpr int NWAVES = 8, NTHR = 512;

constexpr size_t MiB = 1u << 20;
constexpr size_t WS_CTL = 0, CTL_ZERO_BYTES = 1 * MiB;
constexpr size_t WS_WKV = 2 * MiB;
constexpr size_t WS_KMAT = 66 * MiB;
constexpr size_t WS_VT = 82 * MiB;
constexpr size_t WS_MEMN = 98 * MiB;
constexpr size_t WS_TAB = 102 * MiB;
constexpr size_t WS_XB = 106 * MiB;
constexpr size_t WS_WL = 170 * MiB;
constexpr size_t WS_ACT = 310 * MiB;
constexpr size_t WS_SS = (310 + 680) * MiB;
constexpr size_t WS_WL2 = (310 + 680 + 8) * MiB;
constexpr size_t WS_KQ = (310 + 680 + 8 + 140) * MiB;
constexpr size_t WS_VW = WS_KQ + 16 * MiB;
constexpr size_t WS_END = WS_VW + 16 * MiB;
constexpr size_t TAB_LB = 0;
constexpr size_t TAB_WRT = 64 * 1024;
constexpr size_t WL_IN = 0;
constexpr size_t WL_DT = (size_t)SSDN1 * D;
constexpr size_t WL_OUT = (size_t)(SSDN1 + 256) * D;
constexpr size_t WL_Q = WL_OUT + (size_t)D * SSDIN;
constexpr size_t WL_O = WL_Q + (size_t)D * D;
constexpr size_t WL_GU = WL_O + (size_t)D * D;
constexpr size_t WL_DN = WL_GU + (size_t)2 * FF * D;
constexpr size_t WL_ELEMS = WL_DN + (size_t)D * FF;
static_assert(WL_ELEMS * 2 <= 140 * MiB, "per-layer weights");
constexpr size_t A_Z = 0;
constexpr size_t A_XBC = 128 * MiB;
constexpr size_t A_Y = 128 * MiB;
constexpr size_t A_XBT = 320 * MiB;
constexpr size_t A_BCN = 480 * MiB;
constexpr size_t A_ST = 544 * MiB;
constexpr size_t A_DT = 672 * MiB;
constexpr size_t A_DEC = 676 * MiB;
constexpr size_t A_PROJ = 0;
constexpr size_t A_LOGF = 192 * MiB;
constexpr size_t A_HST = 256 * MiB;
constexpr size_t A_YAB = 320 * MiB;
constexpr size_t A_SEG = 384 * MiB;
constexpr size_t A_HDEC = 386 * MiB;

constexpr size_t A_P = 64 * MiB;
constexpr size_t A_O = 96 * MiB;
constexpr size_t A_H = 160 * MiB;

constexpr int LDS_BYTES = 155648;
constexpr int EPI_OFF = 131072;
constexpr int MISC_OFF = LDS_BYTES - 256;

#define LDS_WAIT() asm volatile("s_waitcnt lgkmcnt(0)" ::: "memory")
#define VM_WAIT() asm volatile("s_waitcnt vmcnt(0)" ::: "memory")
__device__ __forceinline__ unsigned f2bf(float f) { unsigned u = __builtin_bit_cast(unsigned, f); return (u + 0x7fffu + ((u >> 16) & 1u)) >> 16; }
__device__ __forceinline__ unsigned pk2(float lo, float hi) { return f2bf(lo) | (f2bf(hi) << 16); }
typedef __bf16 bf16x2v __attribute__((ext_vector_type(2)));
__device__ __forceinline__ unsigned cvt_pk_bf16(float lo, float hi) { const f32x2 v = {lo, hi}; return __builtin_bit_cast(unsigned, __builtin_convertvector(v, bf16x2v)); }
typedef _Float16 f16x2v __attribute__((ext_vector_type(2)));
typedef _Float16 f16x8 __attribute__((ext_vector_type(8)));
__device__ __forceinline__ unsigned cvt_pk_f16(float lo, float hi) { const f32x2 v = {lo, hi}; return __builtin_bit_cast(unsigned, __builtin_convertvector(v, f16x2v)); }
__device__ __forceinline__ float h16lo(unsigned w) { return (float)__builtin_bit_cast(f16x2v, w)[0]; }
__device__ __forceinline__ float h16hi(unsigned w) { return (float)__builtin_bit_cast(f16x2v, w)[1]; }
__device__ __forceinline__ float bflo(unsigned w) { return __uint_as_float(w << 16); }
__device__ __forceinline__ float bfhi(unsigned w) { return __uint_as_float(w & 0xffff0000u); }
__device__ __forceinline__ unsigned rs_pk(float lo, float hi) { return RF16 ? cvt_pk_f16(lo, hi) : cvt_pk_bf16(lo, hi); }
__device__ __forceinline__ float rs_lo(unsigned w) { return RF16 ? h16lo(w) : bflo(w); }
__device__ __forceinline__ float rs_hi(unsigned w) { return RF16 ? h16hi(w) : bfhi(w); }
__device__ __forceinline__ float bf2f(bf16 b) { return __uint_as_float((unsigned)b << 16); }
__device__ __forceinline__ float sigm(float x) { return __builtin_amdgcn_rcpf(1.f + __expf(-x)); }
__device__ __forceinline__ float siluf(float x) { return x * sigm(x); }
__device__ __forceinline__ float gelu_tanh(float x) { return x * sigm(1.5957691216f * (x + 0.044715f * x * x * x)); }
__device__ __forceinline__ float softplusf(float x) { const float e = __expf(-fabsf(x)); const float l = (e < 0.03f) ? e * (1.f - e * (0.5f - e * 0.33333333f)) : __logf(1.f + e); return fmaxf(x, 0.f) + l; }
__device__ __forceinline__ float wave_sum(float v) {
#pragma unroll
    for (int o = 1; o < 64; o <<= 1) v += __shfl_xor(v, o);
    return v;
}

#define XB_TMO      128
#define XB_XCNT(j)  (256  + 64 * (j))
#define XB_XSUB(j)  (1280 + 64 * (j))
#define XB_XGEN(j)  (2304 + 64 * (j))
#define XB_TOP      3328
#define XB_TOPGEN   3392
#define XCD_BAR_WORDS 3456
#define XL_RANK(j)  (4096 + 64 * (j))
#define XL_SUB(j)   (5120 + 64 * (j))
#define XL_GEN(j)   (6144 + 64 * (j))
#define XB_SPIN_CAP (1u << 18)

__device__ __forceinline__ unsigned xb_ld(unsigned* p)              { return __hip_atomic_load(p, __ATOMIC_RELAXED, __HIP_MEMORY_SCOPE_AGENT); }
__device__ __forceinline__ unsigned xb_add(unsigned* p, unsigned v) { return __hip_atomic_fetch_add(p, v, __ATOMIC_RELAXED, __HIP_MEMORY_SCOPE_AGENT); }
__device__ __forceinline__ unsigned xb_xcc_id() { return (unsigned)__builtin_amdgcn_s_getreg((3 << 11) | 20) & 0xFu; }
#define XB_SPIN(cond, bar) do { unsigned _sp = 0; while (cond) { __builtin_amdgcn_s_sleep(1); \
    if ((++_sp & 255u) == 0u) { if (xb_ld(&(bar)[XB_TMO])) break; if (_sp > XB_SPIN_CAP) { atomicAdd(&(bar)[XB_TMO], 1u); break; } } } } while (0)

struct XcdBarrier {
    unsigned* bar; unsigned x;
    volatile LAS unsigned* st;
};
__device__ __forceinline__ XcdBarrier xcd_barrier_post(unsigned* bar, volatile LAS unsigned* st) {
    XcdBarrier b; b.bar = bar; b.x = xb_xcc_id(); b.st = st;
    if (threadIdx.x == 0) (void)xb_add(&bar[XB_XCNT(b.x)], 1u);
    return b;
}
__device__ __forceinline__ void xcd_barrier_complete(unsigned* bar, unsigned x, unsigned& nloc, unsigned& nx) {
    const unsigned G = gridDim.x * gridDim.y * gridDim.z;
    unsigned sum, cnt, mine, sp = 0u;
    for (;;) {
        sum = 0u; cnt = 0u; mine = 0u;
#pragma unroll
        for (unsigned j = 0; j < 16; ++j) { const unsigned c = xb_ld(&bar[XB_XCNT(j)]); sum += c; cnt += (c > 0u) ? 1u : 0u; mine = (j == x) ? c : mine; }
        if (sum == G) break;
        __builtin_amdgcn_s_sleep(1);
        if ((++sp & 255u) == 0u) { if (xb_ld(&bar[XB_TMO])) break; if (sp > XB_SPIN_CAP) { atomicAdd(&bar[XB_TMO], 1u); break; } }
    }
    nloc = mine > 0u ? mine : 1u; nx = cnt > 0u ? cnt : 1u;
}
__device__ __forceinline__ void xcd_barrier(const XcdBarrier& b) {
    asm volatile("s_waitcnt vmcnt(0)" ::: "memory");
    __syncthreads();
    if (threadIdx.x == 0) {
        unsigned* bar = b.bar;
        __builtin_amdgcn_s_waitcnt(0);
        unsigned nloc = b.st[0], nx = b.st[1];
        if (nloc == 0u) { xcd_barrier_complete(bar, b.x, nloc, nx); b.st[0] = nloc; b.st[1] = nx; }
        const unsigned old = xb_add(&bar[XB_XSUB(b.x)], 1u);
        const unsigned gen = old / nloc;
        if (old + 1u == (gen + 1u) * nloc) {
            __builtin_amdgcn_fence(__ATOMIC_RELEASE, "agent");
            asm volatile("s_waitcnt vmcnt(0)" ::: "memory");
            const unsigned og = xb_add(&bar[XB_TOP], 1u);
            const unsigned tg = og / nx;
            if (og + 1u == (tg + 1u) * nx) xb_add(&bar[XB_TOPGEN], 1u);
            else XB_SPIN(xb_ld(&bar[XB_TOPGEN]) == tg, bar);
            __builtin_amdgcn_fence(__ATOMIC_ACQUIRE, "agent");
            xb_add(&bar[XB_XGEN(b.x)], 1u);
            asm volatile("s_waitcnt vmcnt(0)" ::: "memory");
        } else {
            XB_SPIN(xb_ld(&bar[XB_XGEN(b.x)]) == gen, bar);
            __builtin_amdgcn_fence(__ATOMIC_ACQUIRE, "agent");
            asm volatile("s_waitcnt vmcnt(0)" ::: "memory");
        }
    }
    __syncthreads();
}

__device__ __forceinline__ void xcd_local_barrier(const XcdBarrier& b, unsigned n) {
    asm volatile("s_waitcnt vmcnt(0)" ::: "memory");
    __syncthreads();
    if (threadIdx.x == 0) {
        unsigned* bar = b.bar;
        __builtin_amdgcn_s_waitcnt(0);
        const unsigned old = xb_add(&bar[XL_SUB(b.x)], 1u), gen = old / n;
        if (old + 1u == (gen + 1u) * n) xb_add(&bar[XL_GEN(b.x)], 1u);
        else XB_SPIN(xb_ld(&bar[XL_GEN(b.x)]) == gen, bar);
        __builtin_amdgcn_fence(__ATOMIC_ACQUIRE, "agent");
        asm volatile("s_waitcnt vmcnt(0)" ::: "memory");
    }
    __syncthreads();
}

namespace pg8 {
constexpr int BM = 256, BK = 64, HALF = 128, HTB = HALF * BK * 2, STAGE_BYTES = 8 * HTB, NXCD = 8, WGM = 8;
__host__ __device__ __forceinline__ int lds_byte(int r, int c) { const int st = (r >> 4) * 2 + (c >> 5), rr = r & 15, cc = c & 31, ob = rr * 64 + cc * 2; return st * 1024 + (ob ^ (((ob >> 9) & 1) << 5)); }
__host__ __device__ __forceinline__ void stage_rc(int b, int& R, int& C) { const int st = b / 1024, sb = b % 1024, swz = sb ^ (((sb >> 9) & 1) << 5); R = (st >> 1) * 16 + swz / 64; C = (st & 1) * 32 + (swz % 64) / 2; }
__host__ __device__ __forceinline__ int perm32(int rho) { const int n = rho >> 4, i = rho & 15; return 8 * (i >> 2) + 4 * n + (i & 3); }

struct Unit { const char* a; const char* b; int orow, ocol, aux; };

template <bool F16 = false, bool ALIGN = true, class Epi, class Sched>
__device__ __forceinline__ void gemm_phase(const int tid, LAS unsigned char* lds, const int K, const int lda, const int ldb, const Sched& S, const Epi& E) {
    const int wid = __builtin_amdgcn_readfirstlane(tid >> 6), lane = tid & 63, wr = wid >> 2, wc = wid & 3, fr = lane & 15, fq = lane >> 4;
    const int nt = K / BK;
    unsigned voffA[2], voffB[2];
#pragma unroll
    for (int i = 0; i < 2; ++i) { int R, C; stage_rc(tid * 16 + i * 8192, R, C); const int Rb = (R & ~31) + perm32(R & 31);
        voffA[i] = (unsigned)(R * lda + C) * 2u; voffB[i] = (unsigned)(Rb * ldb + C) * 2u; }
    const size_t kstep = (size_t)(BK * 2);
    const size_t hstepA = (size_t)HALF * lda * 2, hstepB = (size_t)HALF * ldb * 2;
    const unsigned ldsw = (unsigned)wid * 1024u;
    const int aoff = lds_byte(wr * 64 + fr, fq * 8), boff = lds_byte(wc * 32 + fr, fq * 8);
#define PG8_SA(b, h) (((b) * 2 + (h)) * HTB)
#define PG8_SB(b, h) ((4 + (b) * 2 + (h)) * HTB)
#define PG8_STAGE(bufoff, gbase, voff) do { _Pragma("unroll") for (int _i = 0; _i < 2; ++_i) \
        __builtin_amdgcn_global_load_lds((const unsigned*)((const char*)(gbase) + (voff)[_i]), (LAS unsigned*)(lds + (bufoff) + ldsw + _i * 8192), 16, 0, 0); } while (0)
#define PG8_LDA(dst, b, h) do { _Pragma("unroll") for (int m = 0; m < 4; ++m) _Pragma("unroll") for (int k = 0; k < 2; ++k) dst[m][k] = *(const LAS bf16x8*)(lds + PG8_SA(b, h) + aoff + m * 2048 + k * 1024); } while (0)
#define PG8_LDB(dst, b, h) do { _Pragma("unroll") for (int n = 0; n < 2; ++n) _Pragma("unroll") for (int k = 0; k < 2; ++k) dst[n][k] = *(const LAS bf16x8*)(lds + PG8_SB(b, h) + boff + n * 2048 + k * 1024); } while (0)
#define PG8_MMA(ai, bj, At, Bt) do { __builtin_amdgcn_s_setprio(1); _Pragma("unroll") for (int m = 0; m < 4; ++m) _Pragma("unroll") for (int n = 0; n < 2; ++n) _Pragma("unroll") for (int k = 0; k < 2; ++k) \
        acc[ai][bj][m][n] = F16 ? __builtin_amdgcn_mfma_f32_16x16x32_f16(__builtin_bit_cast(f16x8, Bt[n][k]), __builtin_bit_cast(f16x8, At[m][k]), acc[ai][bj][m][n], 0, 0, 0) \
                                : __builtin_amdgcn_mfma_f32_16x16x32_bf16(Bt[n][k], At[m][k], acc[ai][bj][m][n], 0, 0, 0); __builtin_amdgcn_s_setprio(0); } while (0)
#define PG8_WAIT_V(n) asm volatile("s_waitcnt vmcnt(" #n ")" ::: "memory")
#define PG8_WAIT_L(n) asm volatile("s_waitcnt lgkmcnt(" #n ")" ::: "memory")
#define PG8_BAR __builtin_amdgcn_s_barrier()
#define PG8_SCHED __builtin_amdgcn_sched_barrier(0)
    Unit cur, nxt; int ui = 0;
    if (!S.next(0, cur)) return;
    f32x4 acc[2][2][4][2];
#pragma unroll
    for (int a = 0; a < 2; ++a)
#pragma unroll
        for (int b = 0; b < 2; ++b)
#pragma unroll
            for (int m = 0; m < 4; ++m)
#pragma unroll
                for (int n = 0; n < 2; ++n) acc[a][b][m][n] = (f32x4){0.f, 0.f, 0.f, 0.f};
    bf16x8 At[4][2], B0[2][2], B1[2][2];
    const char* cA = cur.a; const char* cB = cur.b;
    PG8_STAGE(PG8_SB(0, 0), cB, voffB); PG8_STAGE(PG8_SB(0, 1), cB + hstepB, voffB); PG8_STAGE(PG8_SA(0, 0), cA, voffA); PG8_STAGE(PG8_SA(0, 1), cA + hstepA, voffA);
    if (wr == 1) PG8_BAR;
    PG8_WAIT_V(2); PG8_BAR;
    PG8_STAGE(PG8_SB(1, 0), cB + kstep, voffB); PG8_STAGE(PG8_SA(1, 0), cA + kstep, voffA); PG8_STAGE(PG8_SB(1, 1), cB + hstepB + kstep, voffB);
    PG8_WAIT_V(6); PG8_BAR;
    for (;;) {
        const bool has_next = S.next(ui + 1, nxt);
        const char* nA = has_next ? nxt.a : cA; const char* nB = has_next ? nxt.b : cB;
        for (int t = 0; t < nt; t += 2) {
            const bool last = (t == nt - 2);
            const char* a1 = cA + (size_t)(t + 1) * kstep;
            const char* a2 = last ? nA : cA + (size_t)(t + 2) * kstep; const char* b2 = last ? nB : cB + (size_t)(t + 2) * kstep;
            const char* a3 = a2 + kstep; const char* b3 = b2 + kstep;
            PG8_LDB(B0, 0, 0); PG8_LDB(B1, 0, 1); PG8_SCHED; PG8_LDA(At, 0, 0); PG8_STAGE(PG8_SA(1, 1), a1 + hstepA, voffA);
            PG8_WAIT_V(8); PG8_WAIT_L(0); PG8_BAR; PG8_MMA(0, 0, At, B0); PG8_MMA(0, 1, At, B1); PG8_BAR; PG8_SCHED;
            PG8_LDA(At, 0, 1); PG8_STAGE(PG8_SB(0, 0), b2, voffB); PG8_STAGE(PG8_SB(0, 1), b2 + hstepB, voffB); PG8_STAGE(PG8_SA(0, 0), a2, voffA);
            PG8_WAIT_V(8); PG8_WAIT_L(0); PG8_BAR; PG8_MMA(1, 0, At, B0); PG8_MMA(1, 1, At, B1); PG8_BAR; PG8_SCHED;
            PG8_LDB(B0, 1, 0); PG8_LDB(B1, 1, 1); PG8_SCHED; PG8_LDA(At, 1, 0); PG8_STAGE(PG8_SA(0, 1), a2 + hstepA, voffA);
            PG8_WAIT_V(8); PG8_WAIT_L(0); PG8_BAR; PG8_MMA(0, 0, At, B0); PG8_MMA(0, 1, At, B1); PG8_BAR; PG8_SCHED;
            PG8_LDA(At, 1, 1); PG8_STAGE(PG8_SB(1, 0), b3, voffB); PG8_STAGE(PG8_SB(1, 1), b3 + hstepB, voffB); PG8_STAGE(PG8_SA(1, 0), a3, voffA);
            PG8_WAIT_V(8); PG8_WAIT_L(0); PG8_BAR; PG8_MMA(1, 0, At, B0); PG8_MMA(1, 1, At, B1); PG8_BAR; PG8_SCHED;
        }
        if (ALIGN) { if (wr == 0) PG8_BAR; }
        E(acc, cur, wr, wc, fr, fq);
        if (!has_next) break;
#pragma unroll
        for (int a = 0; a < 2; ++a)
#pragma unroll
            for (int b = 0; b < 2; ++b)
#pragma unroll
                for (int m = 0; m < 4; ++m)
#pragma unroll
                    for (int n = 0; n < 2; ++n) acc[a][b][m][n] = (f32x4){0.f, 0.f, 0.f, 0.f};
        cur = nxt; cA = nA; cB = nB; ++ui;
        if (ALIGN) { if (wr == 1) PG8_BAR; }
    }
    PG8_WAIT_V(0);
    if (!ALIGN) { if (wr == 0) PG8_BAR; }
    PG8_BAR;
#undef PG8_SA
#undef PG8_SB
#undef PG8_STAGE
#undef PG8_LDA
#undef PG8_LDB
#undef PG8_MMA
#undef PG8_WAIT_V
#undef PG8_WAIT_L
#undef PG8_SCHED
}
}
namespace pg8 {
struct SchedMN {
    const char* A; const char* Bt; int lda, ldb; int nM, nN, nwg, G, c;
    __device__ __forceinline__ void init(const bf16* A_, int lda_, const bf16* Bt_, int ldb_, int Mrows, int Ncols, int G_, int c_) {
        A = (const char*)A_; Bt = (const char*)Bt_; lda = lda_; ldb = ldb_; nM = Mrows / BM; nN = Ncols / BM; nwg = nM * nN; G = G_; c = c_; }
    __device__ __forceinline__ bool next(int i, Unit& u) const {
        const long L = (long)i * G + c; if (L >= nwg) return false;
        int wgid = (int)L; { const int q = nwg / NXCD, r = nwg % NXCD, xcd = wgid % NXCD, off = wgid / NXCD; wgid = (xcd < r ? xcd * (q + 1) : r * (q + 1) + (xcd - r) * q) + off; }
        const int nig = WGM * nN, gid = wgid / nig, fm = gid * WGM, gsz = (nM - fm) < WGM ? (nM - fm) : WGM;
        const int pm = fm + ((wgid % nig) % gsz), pn = (wgid % nig) / gsz;
        u.a = A + (size_t)pm * BM * lda * 2; u.b = Bt + (size_t)pn * BM * ldb * 2; u.orow = pm * BM; u.ocol = pn * BM; u.aux = pn; return true;
    }
};
struct SchedKV {
    const char* memn; const char* wkv; int G, c;
    __device__ __forceinline__ bool next(int i, Unit& u) const {
        const int L = i * G + c; if (L >= 256) return false;
        const int l = L >> 6, r = L & 63; const char* w = wkv + (size_t)l * 4096 * D * 2;
        if (r < 32) { const int pm = r >> 3, pn = r & 7; u.a = memn + (size_t)pm * 256 * D * 2; u.b = w + (size_t)pn * 256 * D * 2; u.orow = pm * 256; u.ocol = pn * 256; u.aux = l * 2; }
        else { const int q = r - 32, pm = q >> 3, pn = q & 7; u.a = memn + (size_t)pm * 256 * D * 2; u.b = w + (size_t)(2048 + pn * 256) * D * 2; u.orow = pm * 256; u.ocol = pn * 256; u.aux = l * 2 + 1; }
        return true;
    }
};
struct SchedS {
    const char* Q; const char* Km; int G, c;
    __device__ __forceinline__ bool next(int i, Unit& u) const {
        const int L = i * G + c; if (L >= 256) return false;
        const int bh = 2 * (L & 7) + ((L >> 3) >> 4), it = (L >> 3) & 15, b = bh >> 2, h = bh & 3;
        u.a = Q + ((size_t)(b * SEQ + it * 256) * D + h * XAD) * 2; u.b = Km + ((size_t)(b * MEMLEN) * D + h * XAD) * 2; u.orow = b * SEQ + it * 256; u.ocol = h * 256; u.aux = 0; return true;
    }
};
struct SchedPV {
    const char* P; const char* Vt; int G, c;
    __device__ __forceinline__ bool next(int i, Unit& u) const {
        const int L = i * G + c; if (L >= 512) return false;
        const int x = L & 7, r = L >> 3;
        const int bh = 2 * x + (r >> 5), q = r & 31, it = q >> 1, nh = q & 1, b = bh >> 2, h = bh & 3;
        u.a = P + ((size_t)(b * SEQ + it * 256) * 1024 + h * 256) * 2; u.b = Vt + ((size_t)(h * XAD + nh * 256) * 1024 + b * MEMLEN) * 2; u.orow = b * SEQ + it * 256; u.ocol = h * XAD + nh * 256; u.aux = 0; return true;
    }
};
struct SchedDt {
    const char* A; const char* Bt; int c;
    __device__ __forceinline__ bool next(int i, Unit& u) const {
        if (i != 0 || c >= 64) return false;
        u.a = A + (size_t)c * 256 * D * 2; u.b = Bt; u.orow = c * 256; u.ocol = 0; u.aux = 0; return true;
    }
};

struct SchedOne {
    Unit u0; int n;
    __device__ __forceinline__ bool next(int i, Unit& u) const { if (i >= n) return false; u = u0; return true; }
};
struct SchedMNB {
    const char* A; const char* Bt; int lda, ldb; int nM, nN, nwg, G, c; size_t bstride;
    __device__ __forceinline__ void init(const bf16* A_, int lda_, const bf16* Bt_, int ldb_, int Mrows, int Ncols, int G_, int c_, size_t bstride_) {
        A = (const char*)A_; Bt = (const char*)Bt_; lda = lda_; ldb = ldb_; nM = Mrows / BM; nN = Ncols / BM; nwg = nM * nN; G = G_; c = c_; bstride = bstride_; }
    __device__ __forceinline__ bool next(int i, Unit& u) const {
        const long L = (long)i * G + c; if (L >= nwg) return false;
        int wgid = (int)L; { const int q = nwg / NXCD, r = nwg % NXCD, xcd = wgid % NXCD, off = wgid / NXCD; wgid = (xcd < r ? xcd * (q + 1) : r * (q + 1) + (xcd - r) * q) + off; }
        const int nig = WGM * nN, gid = wgid / nig, fm = gid * WGM, gsz = (nM - fm) < WGM ? (nM - fm) : WGM;
        const int pm = fm + ((wgid % nig) % gsz), pn = (wgid % nig) / gsz;
        u.a = A + (size_t)pm * BM * lda * 2; u.b = Bt + (size_t)(pm >> 4) * bstride + (size_t)pn * BM * ldb * 2; u.orow = pm * BM; u.ocol = pn * BM; u.aux = pn; return true;
    }
};
struct SchedChainQ {
    const char* A; const char* Bt; int pm, h, n;
    __device__ __forceinline__ bool next(int i, Unit& u) const { if (i >= n) return false; const int pn = 2 * h + i;
        u.a = A + (size_t)pm * 256 * D * 2; u.b = Bt + (size_t)pn * 256 * D * 2; u.orow = pm * 256; u.ocol = pn * 256; u.aux = pn; return true; }
};
struct SchedChainS {
    const char* Q; const char* Km; int pm, h, n;
    __device__ __forceinline__ bool next(int i, Unit& u) const { if (i >= n) return false; const int b = pm >> 4;
        u.a = Q + ((size_t)pm * 256 * D + h * XAD) * 2; u.b = Km + ((size_t)(b * MEMLEN) * D + h * XAD) * 2; u.orow = pm * 256; u.ocol = h * 256; u.aux = 0; return true; }
};
struct SchedChainPV {
    const char* P; const char* Vt; int pm, h, n;
    __device__ __forceinline__ bool next(int i, Unit& u) const { if (i >= n) return false; const int b = pm >> 4;
        u.a = P + ((size_t)pm * 256 * 1024 + h * 256) * 2; u.b = Vt + ((size_t)(h * XAD + i * 256) * 1024 + b * MEMLEN) * 2; u.orow = pm * 256; u.ocol = h * XAD + i * 256; u.aux = 0; return true; }
};

#define EPI_ARGS f32x4 (&acc)[2][2][4][2], const Unit& u, int wr, int wc, int fr, int fq
#define EPI_ROW(ai, m) (u.orow + (ai) * HALF + wr * 64 + (m) * 16 + fr)
#define EPI_COL(bj) (u.ocol + (bj) * HALF + wc * 32 + 8 * fq)
__device__ __forceinline__ float rstd_of(const float* ss, int row) { const f32x4 a = *(const f32x4*)(ss + (size_t)row * 8), b = *(const f32x4*)(ss + (size_t)row * 8 + 4);
    return rsqrtf((((a[0] + a[1]) + (a[2] + a[3])) + ((b[0] + b[1]) + (b[2] + b[3]))) * (1.0f / D) + EPS); }
__device__ __forceinline__ u32x4 pack8(const f32x4 a, const f32x4 b) { u32x4 w; w.x = cvt_pk_bf16(a[0], a[1]); w.y = cvt_pk_bf16(a[2], a[3]); w.z = cvt_pk_bf16(b[0], b[1]); w.w = cvt_pk_bf16(b[2], b[3]); return w; }

struct EpiProjEven {
    const float* ss; bf16* proj; float* logf; const float* lb;
    __device__ __forceinline__ void operator()(EPI_ARGS) const {
        const int range = u.aux >> 2;
#pragma unroll
        for (int ai = 0; ai < 2; ++ai)
#pragma unroll
            for (int m = 0; m < 4; ++m) { const int row = EPI_ROW(ai, m); const float rs = rstd_of(ss, row);
#pragma unroll
                for (int bj = 0; bj < 2; ++bj) { const int col = EPI_COL(bj); f32x4 v0 = acc[ai][bj][m][0] * rs, v1 = acc[ai][bj][m][1] * rs;
                    if (range == 3) { const int c = col - 3072; const f32x4 l0 = *(const f32x4*)(lb + c), l1 = *(const f32x4*)(lb + c + 4);
#pragma unroll
                        for (int j = 0; j < 4; ++j) { v0[j] = __logf(l0[j] + (1.f - l0[j]) * sigm(v0[j])); v1[j] = __logf(l1[j] + (1.f - l1[j]) * sigm(v1[j])); }
                        float* p = logf + (size_t)row * 1024 + c; *(f32x4*)p = v0; *(f32x4*)(p + 4) = v1;
                    } else {
                        if (range == 1) {
#pragma unroll
                            for (int j = 0; j < 4; ++j) { v0[j] = gelu_tanh(v0[j]); v1[j] = gelu_tanh(v1[j]); } }
                        else if (range == 2 || range == 5) {
#pragma unroll
                            for (int j = 0; j < 4; ++j) { v0[j] = siluf(v0[j]); v1[j] = siluf(v1[j]); } }
                        *(u32x4*)(proj + (size_t)row * ABIN + col) = pack8(v0, v1);
                    } } }
    }
};
struct EpiProjOdd {
    const float* ss; bf16* Z; bf16* XBC;
    __device__ __forceinline__ void operator()(EPI_ARGS) const {
        const bool isz = u.ocol < SSDIN;
#pragma unroll
        for (int ai = 0; ai < 2; ++ai)
#pragma unroll
            for (int m = 0; m < 4; ++m) { const int row = EPI_ROW(ai, m); const float rs = rstd_of(ss, row);
#pragma unroll
                for (int bj = 0; bj < 2; ++bj) { const int col = EPI_COL(bj); f32x4 v0 = acc[ai][bj][m][0] * rs, v1 = acc[ai][bj][m][1] * rs;
                    if (isz) {
#pragma unroll
                        for (int j = 0; j < 4; ++j) { v0[j] = siluf(v0[j]); v1[j] = siluf(v1[j]); }
                        *(u32x4*)(Z + (size_t)row * SSDIN + col) = pack8(v0, v1);
                    } else *(u32x4*)(XBC + (size_t)row * SSDCONV + (col - SSDIN)) = pack8(v0, v1); } }
    }
};
struct EpiDt {
    const float* ss; const float* bias; float* DT;
    __device__ __forceinline__ void operator()(EPI_ARGS) const {
        if (wc >= 2) return;
        const int col = wc * 32 + 8 * fq; const f32x4 b0 = *(const f32x4*)(bias + col), b1 = *(const f32x4*)(bias + col + 4);
#pragma unroll
        for (int ai = 0; ai < 2; ++ai)
#pragma unroll
            for (int m = 0; m < 4; ++m) { const int row = EPI_ROW(ai, m); const float rs = rstd_of(ss, row);
                f32x4 v0 = acc[ai][0][m][0] * rs + b0, v1 = acc[ai][0][m][1] * rs + b1;
#pragma unroll
                for (int j = 0; j < 4; ++j) { v0[j] = softplusf(v0[j]); v1[j] = softplusf(v1[j]); }
                float* p = DT + (size_t)row * 64 + col; *(f32x4*)p = v0; *(f32x4*)(p + 4) = v1; }
    }
};
struct EpiResid {
    bf16* xb; float* ssnew; LAS float* tab;
    __device__ __forceinline__ void operator()(EPI_ARGS) const {
#pragma unroll
        for (int ai = 0; ai < 2; ++ai)
#pragma unroll
            for (int m = 0; m < 4; ++m) { const int row = EPI_ROW(ai, m); float sq = 0.f;
#pragma unroll
                for (int bj = 0; bj < 2; ++bj) { bf16* p = xb + (size_t)row * D + EPI_COL(bj); const u32x4 w = *(const u32x4*)p;
                    f32x4 o0 = acc[ai][bj][m][0], o1 = acc[ai][bj][m][1];
                    o0[0] += rs_lo(w.x); o0[1] += rs_hi(w.x); o0[2] += rs_lo(w.y); o0[3] += rs_hi(w.y); o1[0] += rs_lo(w.z); o1[1] += rs_hi(w.z); o1[2] += rs_lo(w.w); o1[3] += rs_hi(w.w);
                    { u32x4 pk; pk.x = rs_pk(o0[0], o0[1]); pk.y = rs_pk(o0[2], o0[3]); pk.z = rs_pk(o1[0], o1[1]); pk.w = rs_pk(o1[2], o1[3]); *(u32x4*)p = pk; }
                    sq += ((o0[0] * o0[0] + o0[1] * o0[1]) + (o0[2] * o0[2] + o0[3] * o0[3])) + ((o1[0] * o1[0] + o1[1] * o1[1]) + (o1[2] * o1[2] + o1[3] * o1[3])); }
                sq += __shfl_xor(sq, 16); sq += __shfl_xor(sq, 32);
                if (fq == 0) tab[(ai * HALF + wr * 64 + m * 16 + fr) * 4 + wc] = sq; }
        LDS_WAIT(); PG8_BAR; asm volatile("" ::: "memory");
        const int lane = fq * 16 + fr, r = (wr * 4 + wc) * 32 + (lane & 31);
        if (lane < 32) { const f32x4 t = *(const LAS f32x4*)(tab + r * 4); ssnew[(size_t)(u.orow + r) * 8 + (u.ocol >> 8)] = (t[0] + t[1]) + (t[2] + t[3]); }
    }
};
struct EpiQ {
    const float* ss; bf16* Q; float scale;
    __device__ __forceinline__ void operator()(EPI_ARGS) const {
#pragma unroll
        for (int ai = 0; ai < 2; ++ai)
#pragma unroll
            for (int m = 0; m < 4; ++m) { const int row = EPI_ROW(ai, m); const float rs = rstd_of(ss, row) * scale;
#pragma unroll
                for (int bj = 0; bj < 2; ++bj) *(u32x4*)(Q + (size_t)row * D + EPI_COL(bj)) = pack8(acc[ai][bj][m][0] * rs, acc[ai][bj][m][1] * rs); }
    }
};
struct EpiPlain {
    bf16* O; int ldc;
    __device__ __forceinline__ void operator()(EPI_ARGS) const {
#pragma unroll
        for (int ai = 0; ai < 2; ++ai)
#pragma unroll
            for (int m = 0; m < 4; ++m) { const int row = EPI_ROW(ai, m);
#pragma unroll
                for (int bj = 0; bj < 2; ++bj) *(u32x4*)(O + (size_t)row * ldc + EPI_COL(bj)) = pack8(acc[ai][bj][m][0], acc[ai][bj][m][1]); }
    }
};
struct EpiKV {
    bf16* Km; bf16* Vt;
    __device__ __forceinline__ void operator()(EPI_ARGS) const {
        const int l = u.aux >> 1; const bool isv = u.aux & 1;
        bf16* O = Km + (size_t)l * MEMROWS * D + (size_t)(isv ? 1 : 0) * (size_t)(Vt - Km); const int ldc = D;
#pragma unroll
        for (int ai = 0; ai < 2; ++ai)
#pragma unroll
            for (int m = 0; m < 4; ++m) { const int row = EPI_ROW(ai, m);
#pragma unroll
                for (int bj = 0; bj < 2; ++bj) *(u32x4*)(O + (size_t)row * ldc + EPI_COL(bj)) = pack8(acc[ai][bj][m][0], acc[ai][bj][m][1]); }
    }
};
struct EpiSoftmax {
    const float* ss; float scale; bf16* P; LAS float* tab;
    __device__ __forceinline__ void operator()(EPI_ARGS) const {
        float mx[2][4];
#pragma unroll
        for (int ai = 0; ai < 2; ++ai)
#pragma unroll
            for (int m = 0; m < 4; ++m) { float v = -3.0e38f; const float rs = rstd_of(ss, EPI_ROW(ai, m)) * scale;
#pragma unroll
                for (int bj = 0; bj < 2; ++bj)
#pragma unroll
                    for (int n = 0; n < 2; ++n) { const f32x4 a = acc[ai][bj][m][n] * rs; acc[ai][bj][m][n] = a; v = fmaxf(v, fmaxf(fmaxf(a[0], a[1]), fmaxf(a[2], a[3]))); }
                v = fmaxf(v, __shfl_xor(v, 16)); v = fmaxf(v, __shfl_xor(v, 32));
                if (fq == 0) tab[(ai * HALF + wr * 64 + m * 16 + fr) * 4 + wc] = v; }
        LDS_WAIT(); PG8_BAR; asm volatile("" ::: "memory");
#pragma unroll
        for (int ai = 0; ai < 2; ++ai)
#pragma unroll
            for (int m = 0; m < 4; ++m) { const int r = ai * HALF + wr * 64 + m * 16 + fr; const f32x4 t = *(const LAS f32x4*)(tab + r * 4);
                const float rm = fmaxf(fmaxf(t[0], t[1]), fmaxf(t[2], t[3])); float s = 0.f;
#pragma unroll
                for (int bj = 0; bj < 2; ++bj)
#pragma unroll
                    for (int n = 0; n < 2; ++n) { f32x4 a = acc[ai][bj][m][n];
#pragma unroll
                        for (int j = 0; j < 4; ++j) { a[j] = __expf(a[j] - rm); s += a[j]; }
                        acc[ai][bj][m][n] = a; }
                s += __shfl_xor(s, 16); s += __shfl_xor(s, 32);
                if (fq == 0) tab[1024 + r * 4 + wc] = s; }
        LDS_WAIT(); PG8_BAR; asm volatile("" ::: "memory");
#pragma unroll
        for (int ai = 0; ai < 2; ++ai)
#pragma unroll
            for (int m = 0; m < 4; ++m) { const int r = ai * HALF + wr * 64 + m * 16 + fr; const f32x4 t = *(const LAS f32x4*)(tab + 1024 + r * 4);
                const float inv = __builtin_amdgcn_rcpf((t[0] + t[1]) + (t[2] + t[3])); const int row = u.orow + r;
#pragma unroll
                for (int bj = 0; bj < 2; ++bj) *(u32x4*)(P + (size_t)row * 1024 + EPI_COL(bj)) = pack8(acc[ai][bj][m][0] * inv, acc[ai][bj][m][1] * inv); }
    }
};
struct EpiGateUp {
    const float* ss; bf16* H;
    __device__ __forceinline__ void operator()(EPI_ARGS) const {
#pragma unroll
        for (int ai = 0; ai < 2; ++ai)
#pragma unroll
            for (int m = 0; m < 4; ++m) { const int row = EPI_ROW(ai, m); const float rs = rstd_of(ss, row);
#pragma unroll
                for (int bj = 0; bj < 2; ++bj) { const int hc = EPI_COL(bj) >> 1; const f32x4 g = acc[ai][bj][m][0] * rs, up = acc[ai][bj][m][1] * rs; f32x4 h;
#pragma unroll
                    for (int j = 0; j < 4; ++j) h[j] = siluf(g[j]) * up[j];
                    u32x2 w; w.x = cvt_pk_bf16(h[0], h[1]); w.y = cvt_pk_bf16(h[2], h[3]); *(u32x2*)(H + (size_t)row * FF + hc) = w; } }
    }
};
#undef EPI_ARGS
}
#define MFMA16(X, Y, ACC) __builtin_amdgcn_mfma_f32_16x16x32_bf16((X), (Y), (ACC), 0, 0, 0)
#define WG_SYNC() do { asm volatile("s_waitcnt vmcnt(0) lgkmcnt(0)" ::: "memory"); __builtin_amdgcn_s_barrier(); asm volatile("" ::: "memory"); } while (0)
#define LDS_SYNC() do { asm volatile("s_waitcnt lgkmcnt(0)" ::: "memory"); __builtin_amdgcn_s_barrier(); asm volatile("" ::: "memory"); } while (0)
constexpr int LP = 136;
constexpr int LP64 = 72;
__device__ __forceinline__ bf16x8 lds_frag(const LAS bf16* base, int row, int pitch, int kofs) { return *(const LAS bf16x8*)(base + row * pitch + kofs); }
__device__ __forceinline__ u32x2 pack4(const f32x4 a) { u32x2 w; w.x = cvt_pk_bf16(a[0], a[1]); w.y = cvt_pk_bf16(a[2], a[3]); return w; }

template <int MAP, bool F16>
__device__ __forceinline__ void conv_item(const float* W, int ldw, int K, int n0, const float* gain, bf16* WT, int row_off, LAS float* scr, int item, int nblk, int lane) {
    const int kb = item / nblk, nb = item % nblk, k0 = 64 * kb, nn0 = 64 * nb;
    const int kr = lane >> 4, n4 = (lane & 15) * 4;
    const float* src = W + (size_t)(k0 + kr) * ldw + n0 + nn0 + n4;
    f32x4 v[16];
#pragma unroll
    for (int i = 0; i < 16; ++i) v[i] = *(const f32x4*)(src + (size_t)(4 * i) * ldw);
#pragma unroll
    for (int i = 0; i < 16; ++i) { f32x4 w = v[i]; if (gain) w = w * gain[k0 + 4 * i + kr];
        LAS float* d = scr + (4 * i + kr) * 65 + n4; d[0] = w[0]; d[1] = w[1]; d[2] = w[2]; d[3] = w[3]; }
    LDS_WAIT(); asm volatile("" ::: "memory");
    const int c = lane & 7, nbase = lane >> 3;
#pragma unroll
    for (int j = 0; j < 8; ++j) { const int n = nbase + 8 * j; const LAS float* s = scr + (8 * c) * 65 + n;
        u32x4 o; if (F16) { o.x = cvt_pk_f16(s[0 * 65], s[1 * 65]); o.y = cvt_pk_f16(s[2 * 65], s[3 * 65]); o.z = cvt_pk_f16(s[4 * 65], s[5 * 65]); o.w = cvt_pk_f16(s[6 * 65], s[7 * 65]); }
        else { o.x = cvt_pk_bf16(s[0 * 65], s[1 * 65]); o.y = cvt_pk_bf16(s[2 * 65], s[3 * 65]); o.z = cvt_pk_bf16(s[4 * 65], s[5 * 65]); o.w = cvt_pk_bf16(s[6 * 65], s[7 * 65]); }
        const int nn = nn0 + n; const int dr = MAP == 0 ? nn : ((nn >> 2) * 8 + (nn & 3) + (MAP == 2 ? 4 : 0));
        *(u32x4*)(WT + (size_t)(row_off + dr) * K + k0 + 8 * c) = o; }
    LDS_WAIT(); asm volatile("" ::: "memory");
}
__device__ __forceinline__ void conv_item_nat(const float* W, int ldw, const float* gain, bf16* WN, int item, int nblk, int lane) {
    const int kb = item / nblk, nb = item % nblk, k0 = 64 * kb, nn0 = 64 * nb;
    const int kr = lane >> 4, n4 = (lane & 15) * 4;
    const float* src = W + (size_t)(k0 + kr) * ldw + nn0 + n4; bf16* dst = WN + (size_t)(k0 + kr) * ldw + nn0 + n4;
    f32x4 v[16];
#pragma unroll
    for (int i = 0; i < 16; ++i) v[i] = *(const f32x4*)(src + (size_t)(4 * i) * ldw);
#pragma unroll
    for (int i = 0; i < 16; ++i) { const f32x4 w = v[i] * gain[k0 + 4 * i + kr]; *(u32x2*)(dst + (size_t)(4 * i) * ldw) = pack4(w); }
}
__device__ __forceinline__ void conv_matrix_nat(const float* W, int ldw, int K, const float* gain, bf16* WN, int gw, int NGW, int lane, int& rot) {
    const int nblk = ldw / 64, nitems = (K / 64) * nblk; int first = gw - rot; if (first < 0) first += NGW;
    for (int it = first; it < nitems; it += NGW) conv_item_nat(W, ldw, gain, WN, it, nblk, lane);
    rot = (rot + nitems) % NGW;
}
template <int MAP, bool F16 = false>
__device__ __forceinline__ void conv_matrix(const float* W, int ldw, int K, int n0, int ncols, const float* gain, bf16* WT, int row_off, LAS float* scr, int gw, int NGW, int lane, int& rot) {
    const int nblk = ncols / 64, nitems = (K / 64) * nblk; int first = gw - rot; if (first < 0) first += NGW;
    for (int it = first; it < nitems; it += NGW) conv_item<MAP, F16>(W, ldw, K, n0, gain, WT, row_off, scr, it, nblk, lane);
    rot = (rot + nitems) % NGW;
}

struct In {
    const float *x, *mem, *norm_mix, *norm_xattn, *norm_ffn, *norm_mem, *norm_final, *ab_w_in, *ab_w_out, *lru_conv_w, *lru_conv_b, *lru_w_r, *lru_b_r, *lru_w_i, *lru_b_i, *lru_lambda,
        *hgrn_lb, *hgrn_norm, *ssd_w_in, *ssd_w_out, *ssd_conv_w, *ssd_conv_b, *ssd_dt_bias, *ssd_a_log, *ssd_d, *ssd_norm, *xa_w_q, *xa_w_kv, *xa_w_o, *ffn_w_gate, *ffn_w_up, *ffn_w_down;
};

typedef const In __attribute__((address_space(4))) CIn;
template <int PARTS = 3>
__device__ __forceinline__ void convert_layer(CIn& I, int l, bf16* WL, LAS float* scr, int gw, int NGW, int lane, int& rot) {
    const int e = l >> 1;
    if ((l & 1) == 0) {
        if (PARTS & 1) conv_matrix<0, RF16>(I.ab_w_in + (size_t)e * D * ABIN, ABIN, D, 0, ABIN, I.norm_mix + l * D, WL + WL_IN, 0, scr, gw, NGW, lane, rot);
        if (PARTS & 2) conv_matrix<0>(I.ab_w_out + (size_t)e * D * D, D, D, 0, D, nullptr, WL + WL_OUT, 0, scr, gw, NGW, lane, rot);
    } else {
        if (PARTS & 1) { conv_matrix<0, RF16>(I.ssd_w_in + (size_t)e * D * SSDPROJ, SSDPROJ, D, 0, SSDN1, I.norm_mix + l * D, WL + WL_IN, 0, scr, gw, NGW, lane, rot);
        conv_matrix<0, RF16>(I.ssd_w_in + (size_t)e * D * SSDPROJ, SSDPROJ, D, SSDN1, 64, I.norm_mix + l * D, WL + WL_DT, 0, scr, gw, NGW, lane, rot);
        for (int i = gw * 64 + lane; i < 192 * D / 8; i += NGW * 64) *(u32x4*)(WL + WL_DT + (size_t)64 * D + (size_t)i * 8) = (u32x4){0u, 0u, 0u, 0u}; }
        if (PARTS & 2) conv_matrix<0>(I.ssd_w_out + (size_t)e * SSDIN * D, D, SSDIN, 0, D, nullptr, WL + WL_OUT, 0, scr, gw, NGW, lane, rot);
    }
    if (!(PARTS & 2)) return;
    conv_matrix_nat(I.xa_w_q + (size_t)l * D * D, D, D, I.norm_xattn + l * D, WL + WL_Q, gw, NGW, lane, rot);
    conv_matrix<0>(I.xa_w_o + (size_t)l * D * D, D, D, 0, D, nullptr, WL + WL_O, 0, scr, gw, NGW, lane, rot);
    conv_matrix<1, RF16>(I.ffn_w_gate + (size_t)l * D * FF, FF, D, 0, FF, I.norm_ffn + l * D, WL + WL_GU, 0, scr, gw, NGW, lane, rot);
    conv_matrix<2, RF16>(I.ffn_w_up + (size_t)l * D * FF, FF, D, 0, FF, I.norm_ffn + l * D, WL + WL_GU, 0, scr, gw, NGW, lane, rot);
    conv_matrix<0>(I.ffn_w_down + (size_t)l * FF * D, D, FF, 0, D, nullptr, WL + WL_DN, 0, scr, gw, NGW, lane, rot);
}

template <bool PASSB>
__device__ __forceinline__ void lru_units(const int tid, LAS unsigned char* lds, int G, int cu, const bf16* PROJ, const bf16* WRT, const float* cw, const float* cb, const float* br, const float* bi,
                                          const float* lam, float* SEG, bf16* YAB) {
    const int wid = __builtin_amdgcn_readfirstlane(tid >> 6), lane = tid & 63, q = lane >> 4, c16 = lane & 15;
    LAS bf16* XA = (LAS bf16*)(lds);
    LAS bf16* XC = (LAS bf16*)(lds + 35840);
    LAS bf16* WR = (LAS bf16*)(lds + 70656);
    LAS bf16* WI = (LAS bf16*)(lds + 105472);
    LAS float* PAR = (LAS float*)(lds + 140288);
    LAS float* WT = (LAS float*)(lds + 144384);
    LAS float* HIN = (LAS float*)(lds + 152576);
    int loadedj = -1;
    for (int u = cu; u < 1024; u += G) {
        const int j = u & 7, rest = u >> 3, b = rest >> 5, seg = rest & 31; const int t0 = b * SEQ + seg * 128;
        if (j != loadedj) {
            loadedj = j;
            for (int p = tid; p < 2 * 2048; p += NTHR) { const int g = p >> 11, pp = p & 2047, r = pp >> 4, pc = pp & 15;
                const u32x4 v = *(const u32x4*)(WRT + ((size_t)(g * 8 + j) * 128 + r) * 128 + pc * 8);
                *(LAS u32x4*)((g ? WI : WR) + r * LP + pc * 8) = v; }
            if (tid < 128) { const int ch = j * 128 + tid;
                PAR[0 * 128 + tid] = 8.0f * softplusf(-lam[ch]); PAR[1 * 128 + tid] = br[ch]; PAR[2 * 128 + tid] = bi[ch]; PAR[3 * 128 + tid] = cb[ch];
#pragma unroll
                for (int k = 0; k < 4; ++k) PAR[(4 + k) * 128 + tid] = cw[k * LRUW + ch]; }
        }
        for (int p = tid; p < 131 * 16; p += NTHR) { const int r = p >> 4, pc = p & 15; u32x4 v = (u32x4){0u, 0u, 0u, 0u};
            if (seg > 0 || r >= 3) v = *(const u32x4*)(PROJ + (size_t)(t0 + r - 3) * ABIN + j * 128 + pc * 8);
            *(LAS u32x4*)(XA + r * LP + pc * 8) = v; }
        if (PASSB) { if (tid < 128) { float h = 0.f; const float* sg = SEG + ((size_t)(b * 8 + j) * 32) * 256 + tid * 2;
                for (int s = 0; s < seg; ++s) { const f32x2 ab = *(const f32x2*)(sg + (size_t)s * 256); h = ab.x * h + ab.y; }
                HIN[tid] = h; } }
        WG_SYNC();
        {
            const int ch8 = tid & 15, tr = tid >> 4; u32x4 rows[7];
#pragma unroll
            for (int i = 0; i < 7; ++i) rows[i] = *(const LAS u32x4*)(XA + (4 * tr + i) * LP + ch8 * 8);
            float w[4][8], bb[8];
#pragma unroll
            for (int e = 0; e < 8; ++e) { bb[e] = PAR[3 * 128 + ch8 * 8 + e];
#pragma unroll
                for (int k = 0; k < 4; ++k) w[k][e] = PAR[(4 + k) * 128 + ch8 * 8 + e]; }
#pragma unroll
            for (int i = 0; i < 4; ++i) { float o[8];
#pragma unroll
                for (int e = 0; e < 8; ++e) { float a = bb[e];
#pragma unroll
                    for (int k = 0; k < 4; ++k) { const unsigned wd = rows[i + k][e >> 1]; a += w[k][e] * ((e & 1) ? bfhi(wd) : bflo(wd)); }
                    o[e] = a; }
                u32x4 pk; pk.x = cvt_pk_bf16(o[0], o[1]); pk.y = cvt_pk_bf16(o[2], o[3]); pk.z = cvt_pk_bf16(o[4], o[5]); pk.w = cvt_pk_bf16(o[6], o[7]);
                *(LAS u32x4*)(XC + (4 * tr + i) * LP + ch8 * 8) = pk; }
        }
        WG_SYNC();
        float PP[8][4], HH[8][4];
        {
            bf16x8 xf[4];
#pragma unroll
            for (int ks = 0; ks < 4; ++ks) xf[ks] = lds_frag(XC, 16 * wid + c16, LP, 32 * ks + 8 * q);
#pragma unroll
            for (int jb = 0; jb < 8; ++jb) {
                f32x4 aR = (f32x4){0.f, 0.f, 0.f, 0.f}, aI = aR;
#pragma unroll
                for (int ks = 0; ks < 4; ++ks) { aR = MFMA16(xf[ks], lds_frag(WR, 16 * jb + c16, LP, 32 * ks + 8 * q), aR); aI = MFMA16(xf[ks], lds_frag(WI, 16 * jb + c16, LP, 32 * ks + 8 * q), aI); }
                const int ch = 16 * jb + c16;
                const float sp8 = PAR[ch], pbr = PAR[128 + ch], pbi = PAR[256 + ch], pcb = PAR[384 + ch], w0 = PAR[512 + ch], w1 = PAR[640 + ch], w2 = PAR[768 + ch], w3 = PAR[896 + ch];
                float xr[7];
#pragma unroll
                for (int i = 0; i < 7; ++i) xr[i] = bf2f(XA[(16 * wid + 4 * q + i) * LP + ch]);
                float a[4], bt[4];
#pragma unroll
                for (int r = 0; r < 4; ++r) { const float xc = pcb + w0 * xr[r] + w1 * xr[r + 1] + w2 * xr[r + 2] + w3 * xr[r + 3];
                    const float rg = sigm(aR[r] + pbr), ig = sigm(aI[r] + pbi); const float la = -sp8 * rg;
                    const float av = __expf(la), x2 = 2.0f * la; a[r] = av;
                    const float om = (x2 > -0.02f) ? -x2 * (1.0f + x2 * (0.5f + x2 * 0.16666667f)) : 1.0f - av * av;
                    bt[r] = __builtin_amdgcn_sqrtf(fmaxf(om, 0.f)) * ig * xc; }
                float P[4], H[4]; P[0] = a[0]; H[0] = bt[0];
#pragma unroll
                for (int r = 1; r < 4; ++r) { P[r] = a[r] * P[r - 1]; H[r] = a[r] * H[r - 1] + bt[r]; }
                float Ae = 1.f, Be = 0.f, Aw = 1.f, Bw = 0.f;
#pragma unroll
                for (int qq = 0; qq < 4; ++qq) { const float Aq = __shfl(P[3], c16 + 16 * qq), Bq = __shfl(H[3], c16 + 16 * qq);
                    if (qq < q) { Be = Aq * Be + Bq; Ae = Aq * Ae; }
                    Bw = Aq * Bw + Bq; Aw = Aq * Aw; }
#pragma unroll
                for (int r = 0; r < 4; ++r) { PP[jb][r] = P[r] * Ae; HH[jb][r] = P[r] * Be + H[r]; }
                if (q == 0) *(LAS f32x2*)(WT + (wid * 128 + ch) * 2) = (f32x2){Aw, Bw};
            }
        }
        WG_SYNC();
        if (!PASSB) {
            if (tid < 128) { float A = 1.f, B = 0.f;
#pragma unroll
                for (int w = 0; w < 8; ++w) { const f32x2 ab = *(const LAS f32x2*)(WT + (w * 128 + tid) * 2); B = ab.x * B + ab.y; A = ab.x * A; }
                *(f32x2*)(SEG + ((size_t)(b * 8 + j) * 32 + seg) * 256 + tid * 2) = (f32x2){A, B}; }
        } else {
#pragma unroll
            for (int jb = 0; jb < 8; ++jb) { const int ch = 16 * jb + c16; float h0 = HIN[ch];
                for (int w = 0; w < wid; ++w) { const f32x2 ab = *(const LAS f32x2*)(WT + (w * 128 + ch) * 2); h0 = ab.x * h0 + ab.y; }
#pragma unroll
                for (int r = 0; r < 4; ++r) { const int t = t0 + 16 * wid + 4 * q + r; const float h = PP[jb][r] * h0 + HH[jb][r];
                    const float ga = bf2f(PROJ[(size_t)t * ABIN + 1024 + j * 128 + ch]);
                    YAB[(size_t)t * D + j * 128 + ch] = (bf16)f2bf(ga * h); } }
        }
        WG_SYNC();
    }
}

__device__ __forceinline__ void hgrn1_load(float (&lf)[16], unsigned (&vv)[16], const float* LOGF, const bf16* PROJ, int u, int k, int qt) {
    const int bh = u >> 6, c = u & 63, b = bh >> 3, h = bh & 7; const int t0 = b * SEQ + c * 64 + 16 * qt;
#pragma unroll
    for (int i = 0; i < 16; ++i) { lf[i] = LOGF[(size_t)(t0 + i) * 1024 + h * 128 + k]; vv[i] = PROJ[(size_t)(t0 + i) * ABIN + 4096 + h * 128 + k]; }
}
__device__ __forceinline__ void hgrn1_units(const int tid, LAS unsigned char* lds, int G, int cu, const float* LOGF, const bf16* PROJ, bf16* HST, float* HDEC) {
    const int wid = __builtin_amdgcn_readfirstlane(tid >> 6), lane = tid & 63, q = lane >> 4, c16 = lane & 15;
    LAS bf16* KT = (LAS bf16*)(lds);
    LAS bf16* VT = (LAS bf16*)(lds + 18432);
    LAS float* TOT = (LAS float*)(lds + 36864);
    const int k = tid & 127, qt = tid >> 7;
    float lf[16], nlf[16]; unsigned vv[16], nvv[16];
    if (cu < 2048) hgrn1_load(lf, vv, LOGF, PROJ, cu, k, qt);
    for (int u = cu; u < 2048; u += G) {
        if (u + G < 2048) hgrn1_load(nlf, nvv, LOGF, PROJ, u + G, k, qt);
        float cs[16];
        cs[0] = lf[0];
#pragma unroll
        for (int i = 1; i < 16; ++i) cs[i] = cs[i - 1] + lf[i];
        TOT[qt * 128 + k] = cs[15];
        LDS_SYNC();
        float pre = 0.f, last = 0.f;
#pragma unroll
        for (int qq = 0; qq < 4; ++qq) { const float t = TOT[qq * 128 + k]; if (qq < qt) pre += t; last += t; }
        unsigned kw[8], vw[8];
#pragma unroll
        for (int i = 0; i < 8; ++i) { const float k0 = (1.f - __expf(lf[2 * i])) * __expf(last - (pre + cs[2 * i])), k1 = (1.f - __expf(lf[2 * i + 1])) * __expf(last - (pre + cs[2 * i + 1]));
            kw[i] = cvt_pk_bf16(k0, k1); vw[i] = vv[2 * i] | (vv[2 * i + 1] << 16); }
        *(LAS u32x4*)(KT + k * LP64 + 16 * qt) = (u32x4){kw[0], kw[1], kw[2], kw[3]}; *(LAS u32x4*)(KT + k * LP64 + 16 * qt + 8) = (u32x4){kw[4], kw[5], kw[6], kw[7]};
        *(LAS u32x4*)(VT + k * LP64 + 16 * qt) = (u32x4){vw[0], vw[1], vw[2], vw[3]}; *(LAS u32x4*)(VT + k * LP64 + 16 * qt + 8) = (u32x4){vw[4], vw[5], vw[6], vw[7]};
        if (qt == 0) HDEC[(size_t)u * 128 + k] = __expf(last);
        LDS_SYNC();
        bf16x8 kf[2];
#pragma unroll
        for (int ks = 0; ks < 2; ++ks) kf[ks] = lds_frag(KT, 16 * wid + c16, LP64, 32 * ks + 8 * q);
#pragma unroll
        for (int vb = 0; vb < 8; ++vb) { f32x4 acc = (f32x4){0.f, 0.f, 0.f, 0.f};
#pragma unroll
            for (int ks = 0; ks < 2; ++ks) acc = MFMA16(kf[ks], lds_frag(VT, 16 * vb + c16, LP64, 32 * ks + 8 * q), acc);
            *(u32x2*)(HST + ((size_t)u * 128 + 16 * vb + c16) * 128 + 16 * wid + 4 * q) = pack4(acc); }
        LDS_SYNC();
#pragma unroll
        for (int i = 0; i < 16; ++i) { lf[i] = nlf[i]; vv[i] = nvv[i]; }
    }
    WG_SYNC();
}
__device__ __forceinline__ void hgrn2_scan(const int tid, int G, int cu, bf16* HST, const float* HDEC) {
    for (int task = cu * NTHR + tid; task < 32 * 4096; task += G * NTHR) {
        const int bh = task >> 12, e = (task & 4095) * 4; f32x4 S = (f32x4){0.f, 0.f, 0.f, 0.f};
        bf16* p0 = HST + (size_t)bh * 64 * 16384 + e; const float* d0 = HDEC + (size_t)bh * 64 * 128 + (e & 127);
#pragma unroll 1
        for (int cb = 0; cb < 64; cb += 16) { u32x2 L[16]; f32x4 d[16];
#pragma unroll
            for (int c = 0; c < 16; ++c) { L[c] = *(const u32x2*)(p0 + (size_t)(cb + c) * 16384); d[c] = *(const f32x4*)(d0 + (size_t)(cb + c) * 128); }
#pragma unroll
            for (int c = 0; c < 16; ++c) { *(u32x2*)(p0 + (size_t)(cb + c) * 16384) = pack4(S);
                S[0] = d[c][0] * S[0] + bflo(L[c].x); S[1] = d[c][1] * S[1] + bfhi(L[c].x); S[2] = d[c][2] * S[2] + bflo(L[c].y); S[3] = d[c][3] * S[3] + bfhi(L[c].y); } }
    }
}
__device__ __forceinline__ void hgrn3_load(float (&lf)[16], unsigned (&qv)[16], unsigned (&vv)[16], u32x4 (&st)[4], const float* LOGF, const bf16* PROJ, const bf16* HST, int u, int k, int qt, int tid) {
    const int bh = u >> 6, c = u & 63, b = bh >> 3, h = bh & 7; const int t0 = b * SEQ + c * 64 + 16 * qt;
#pragma unroll
    for (int i = 0; i < 16; ++i) { lf[i] = LOGF[(size_t)(t0 + i) * 1024 + h * 128 + k]; const bf16* pr = PROJ + (size_t)(t0 + i) * ABIN + h * 128 + k; qv[i] = pr[2048]; vv[i] = pr[4096]; }
#pragma unroll
    for (int i = 0; i < 4; ++i) { const int p = tid + NTHR * i, r = p >> 4, pc = p & 15; st[i] = *(const u32x4*)(HST + (size_t)u * 16384 + r * 128 + pc * 8); }
}
__device__ __forceinline__ void hgrn3_units(const int tid, LAS unsigned char* lds, int G, int cu, const float* LOGF, const bf16* PROJ, const bf16* HST, const float* hnorm, bf16* YAB) {
    const int wid = __builtin_amdgcn_readfirstlane(tid >> 6), lane = tid & 63, q = lane >> 4, c16 = lane & 15;
    LAS bf16* QH = (LAS bf16*)(lds);
    LAS bf16* QT = (LAS bf16*)(lds + 17408);
    LAS bf16* KH = (LAS bf16*)(lds + 34816);
    LAS bf16* VT = (LAS bf16*)(lds + 52224);
    LAS bf16* STL = (LAS bf16*)(lds + 70656);
    LAS bf16* PM = (LAS bf16*)(lds + 105472);
    LAS float* TOT = (LAS float*)(lds + 114688);
    LAS float* SQ = (LAS float*)(lds + 116736);
    const int k = tid & 127, qt = tid >> 7;
    float lf[16], nlf[16]; unsigned qv[16], nqv[16], vv[16], nvv[16]; u32x4 st[4], nst[4];
    if (cu < 2048) hgrn3_load(lf, qv, vv, st, LOGF, PROJ, HST, cu, k, qt, tid);
    for (int u = cu; u < 2048; u += G) {
        const int bh = u >> 6, c = u & 63, b = bh >> 3, h = bh & 7; const int tc = b * SEQ + c * 64;
        float cs[16];
        cs[0] = lf[0];
#pragma unroll
        for (int i = 1; i < 16; ++i) cs[i] = cs[i - 1] + lf[i];
        TOT[qt * 128 + k] = cs[15];
#pragma unroll
        for (int i = 0; i < 4; ++i) { const int p = tid + NTHR * i, r = p >> 4, pc = p & 15; *(LAS u32x4*)(STL + r * LP + pc * 8) = st[i]; }
        if (u + G < 2048) hgrn3_load(nlf, nqv, nvv, nst, LOGF, PROJ, HST, u + G, k, qt, tid);
        LDS_SYNC();
        float pre = 0.f;
#pragma unroll
        for (int qq = 0; qq < 4; ++qq) { const float t = TOT[qq * 128 + k]; if (qq < qt) pre += t; }
        const float ref = TOT[k] + TOT[128 + k];
        unsigned vw[8];
#pragma unroll
        for (int i = 0; i < 16; ++i) { const float cum = pre + cs[i], kk = 1.f - __expf(lf[i]), qf = bf2f((bf16)qv[i]);
            QT[(16 * qt + i) * LP + k] = (bf16)f2bf(qf * __expf(cum));
            QH[(16 * qt + i) * LP + k] = (bf16)f2bf(qf * __expf(fminf(cum - ref, 80.f)));
            KH[(16 * qt + i) * LP + k] = (bf16)f2bf(kk * __expf(fminf(ref - cum, 80.f))); }
#pragma unroll
        for (int i = 0; i < 8; ++i) vw[i] = vv[2 * i] | (vv[2 * i + 1] << 16);
        *(LAS u32x4*)(VT + k * LP64 + 16 * qt) = (u32x4){vw[0], vw[1], vw[2], vw[3]}; *(LAS u32x4*)(VT + k * LP64 + 16 * qt + 8) = (u32x4){vw[4], vw[5], vw[6], vw[7]};
        LDS_SYNC();
        {
            const int tb = wid & 3;
            bf16x8 qf[4];
#pragma unroll
            for (int ks = 0; ks < 4; ++ks) qf[ks] = lds_frag(QH, 16 * tb + c16, LP, 32 * ks + 8 * q);
#pragma unroll
            for (int sbi = 0; sbi < 2; ++sbi) { const int sb = 2 * (wid >> 2) + sbi; f32x4 acc = (f32x4){0.f, 0.f, 0.f, 0.f};
#pragma unroll
                for (int ks = 0; ks < 4; ++ks) acc = MFMA16(lds_frag(KH, 16 * sb + c16, LP, 32 * ks + 8 * q), qf[ks], acc);
                const int t = 16 * tb + c16, s0 = 16 * sb + 4 * q;
#pragma unroll
                for (int r = 0; r < 4; ++r) acc[r] = (s0 + r <= t) ? acc[r] : 0.f;
                *(LAS u32x2*)(PM + t * LP64 + s0) = pack4(acc); }
        }
        LDS_SYNC();
        {
            const int tb = wid & 3, vh = wid >> 2, t = 16 * tb + c16;
            bf16x8 qf[4], pf[2];
#pragma unroll
            for (int ks = 0; ks < 4; ++ks) qf[ks] = lds_frag(QT, t, LP, 32 * ks + 8 * q);
#pragma unroll
            for (int ks = 0; ks < 2; ++ks) pf[ks] = lds_frag(PM, t, LP64, 32 * ks + 8 * q);
            f32x4 acc[4]; float sq = 0.f;
#pragma unroll
            for (int vb = 0; vb < 4; ++vb) { const int vr = 64 * vh + 16 * vb + c16; acc[vb] = (f32x4){0.f, 0.f, 0.f, 0.f};
#pragma unroll
                for (int ks = 0; ks < 4; ++ks) acc[vb] = MFMA16(lds_frag(STL, vr, LP, 32 * ks + 8 * q), qf[ks], acc[vb]);
#pragma unroll
                for (int ks = 0; ks < 2; ++ks) acc[vb] = MFMA16(lds_frag(VT, vr, LP64, 32 * ks + 8 * q), pf[ks], acc[vb]);
                sq += (acc[vb][0] * acc[vb][0] + acc[vb][1] * acc[vb][1]) + (acc[vb][2] * acc[vb][2] + acc[vb][3] * acc[vb][3]); }
            sq += __shfl_xor(sq, 16); sq += __shfl_xor(sq, 32);
            if (q == 0) SQ[vh * 64 + t] = sq;
            LDS_SYNC();
            const float rstd = rsqrtf((SQ[t] + SQ[64 + t]) * (1.0f / 128.f) + EPS);
#pragma unroll
            for (int vb = 0; vb < 4; ++vb) { const int v0 = 64 * vh + 16 * vb + 4 * q; const f32x4 hn = *(const f32x4*)(hnorm + h * 128 + v0);
                const u32x2 gw = *(const u32x2*)(PROJ + (size_t)(tc + t) * ABIN + 5120 + h * 128 + v0);
                f32x4 y; y[0] = acc[vb][0] * rstd * hn[0] * bflo(gw.x); y[1] = acc[vb][1] * rstd * hn[1] * bfhi(gw.x); y[2] = acc[vb][2] * rstd * hn[2] * bflo(gw.y); y[3] = acc[vb][3] * rstd * hn[3] * bfhi(gw.y);
                *(u32x2*)(YAB + (size_t)(tc + t) * D + 1024 + h * 128 + v0) = pack4(y); }
        }
        LDS_SYNC();
#pragma unroll
        for (int i = 0; i < 16; ++i) { lf[i] = nlf[i]; qv[i] = nqv[i]; vv[i] = nvv[i]; }
#pragma unroll
        for (int i = 0; i < 4; ++i) st[i] = nst[i];
    }
    WG_SYNC();
}
__device__ __forceinline__ void ssd_prep_load(u32x4 (&rows)[7], const bf16* XBC, int u, int ch8, int tr) {
    const int bc = u / 48, cblk = u % 48, c = bc & 31; const bf16* src = XBC + (size_t)(bc * 128 + 4 * tr - 3) * SSDCONV + cblk * 128 + ch8 * 8;
#pragma unroll
    for (int i = 0; i < 7; ++i) { rows[i] = (u32x4){0u, 0u, 0u, 0u}; if (c > 0 || 4 * tr + i >= 3) rows[i] = *(const u32x4*)(src + (size_t)i * SSDCONV); }
}
__device__ __forceinline__ void ssd_prep_units(const int tid, LAS unsigned char* lds, int ufirst, int ustride, int uend, const bf16* XBC, const float* cw, const float* cb, bf16* XBT, bf16* BCN) {
    LAS bf16* T = (LAS bf16*)(lds);
    const int ch8 = tid & 15, tr = tid >> 4;
    u32x4 rows[7], nrows[7];
    if (ufirst < uend) ssd_prep_load(rows, XBC, ufirst, ch8, tr);
    for (int u = ufirst; u < uend; u += ustride) {
        const int bc = u / 48, cblk = u % 48; const int t0 = bc * 128; const int ch0 = cblk * 128 + ch8 * 8;
        if (u + ustride < uend) ssd_prep_load(nrows, XBC, u + ustride, ch8, tr);
        float w[4][8], bb[8];
        { const f32x4 b0 = *(const f32x4*)(cb + ch0), b1 = *(const f32x4*)(cb + ch0 + 4);
#pragma unroll
          for (int e = 0; e < 4; ++e) { bb[e] = b0[e]; bb[4 + e] = b1[e]; }
#pragma unroll
          for (int k = 0; k < 4; ++k) { const f32x4 w0 = *(const f32x4*)(cw + (size_t)k * SSDCONV + ch0), w1 = *(const f32x4*)(cw + (size_t)k * SSDCONV + ch0 + 4);
#pragma unroll
              for (int e = 0; e < 4; ++e) { w[k][e] = w0[e]; w[k][4 + e] = w1[e]; } } }
        u32x4 ov[4];
#pragma unroll
        for (int i = 0; i < 4; ++i) { float o[8];
#pragma unroll
            for (int e = 0; e < 8; ++e) { float a = bb[e];
#pragma unroll
                for (int k = 0; k < 4; ++k) { const unsigned wd = rows[i + k][e >> 1]; a += w[k][e] * ((e & 1) ? bfhi(wd) : bflo(wd)); }
                o[e] = siluf(a); }
            u32x4 pk; pk.x = cvt_pk_bf16(o[0], o[1]); pk.y = cvt_pk_bf16(o[2], o[3]); pk.z = cvt_pk_bf16(o[4], o[5]); pk.w = cvt_pk_bf16(o[6], o[7]);
            if (cblk >= 32) *(u32x4*)(BCN + (size_t)(t0 + 4 * tr + i) * 2048 + (ch0 - 4096)) = pk;
            ov[i] = pk; }
        if (cblk < 40) {
#pragma unroll
            for (int e = 0; e < 8; ++e) { u32x2 w;
                const unsigned a0 = ov[0][e >> 1], a1 = ov[1][e >> 1], a2 = ov[2][e >> 1], a3 = ov[3][e >> 1];
                if (e & 1) { w.x = (a0 >> 16) | (a1 & 0xffff0000u); w.y = (a2 >> 16) | (a3 & 0xffff0000u); } else { w.x = (a0 & 0xffffu) | (a1 << 16); w.y = (a2 & 0xffffu) | (a3 << 16); }
                *(LAS u32x2*)(T + (ch8 * 8 + e) * LP + 8 * ((tr >> 1) ^ ch8) + 4 * (tr & 1)) = w; }
            LDS_SYNC();
#pragma unroll
            for (int i = 0; i < 4; ++i) { const int p = tid + NTHR * i, r = p >> 4, pc = p & 15;
                *(u32x4*)(XBT + ((size_t)bc * 5120 + cblk * 128 + r) * 128 + pc * 8) = *(const LAS u32x4*)(T + r * LP + 8 * (pc ^ (r >> 3))); }
            LDS_SYNC();
        }
#pragma unroll
        for (int i = 0; i < 7; ++i) rows[i] = nrows[i];
    }
    WG_SYNC();
}
__device__ __forceinline__ float ssd_tables(const float* DT, const float* a_log, int t0, int hd, int wid, int lane, LAS float* CUM, LAS float* DTS) {
    const float an = -__expf(a_log[hd]);
    const float d0 = DT[(size_t)(t0 + 2 * lane) * 64 + hd], d1 = DT[(size_t)(t0 + 2 * lane + 1) * 64 + hd];
    const float a0 = d0 * an, a1 = d1 * an; float v = a0 + a1;
#pragma unroll
    for (int o = 1; o < 64; o <<= 1) { const float t = __shfl_up(v, o); if (lane >= o) v += t; }
    CUM[wid * 128 + 2 * lane] = v - a1; CUM[wid * 128 + 2 * lane + 1] = v; DTS[wid * 128 + 2 * lane] = d0; DTS[wid * 128 + 2 * lane + 1] = d1;
    return __shfl(v, 63);
}
__device__ __forceinline__ void ssd1_units(const int tid, LAS unsigned char* lds, int G, int cu, const bf16* XBT, const float* DT, const float* a_log, bf16* ST, float* DEC) {
    const int wid = __builtin_amdgcn_readfirstlane(tid >> 6), lane = tid & 63, q = lane >> 4, c16 = lane & 15;
    LAS bf16* BT = (LAS bf16*)(lds);
    LAS float* CUM = (LAS float*)(lds + 34816);
    LAS float* DTS = (LAS float*)(lds + 38912);
    for (int u = cu; u < 1024; u += G) {
        const int bc = u >> 3, g = u & 7, t0 = bc * 128, hd = g * 8 + wid;
#pragma unroll
        for (int i = 0; i < 4; ++i) { const int p = tid + NTHR * i, r = p >> 4, pc = p & 15;
            *(LAS u32x4*)(BT + r * LP + pc * 8) = *(const u32x4*)(XBT + ((size_t)bc * 5120 + 4096 + g * 128 + r) * 128 + pc * 8); }
        const float last = ssd_tables(DT, a_log, t0, hd, wid, lane, CUM, DTS);
        if (lane == 0) DEC[bc * 64 + hd] = __expf(last);
        u32x4 xr[4][4];
#pragma unroll
        for (int pb = 0; pb < 4; ++pb)
#pragma unroll
            for (int ks = 0; ks < 4; ++ks) xr[pb][ks] = *(const u32x4*)(XBT + ((size_t)bc * 5120 + hd * 64 + 16 * pb + c16) * 128 + 32 * ks + 8 * q);
        WG_SYNC();
        bf16x8 xf[4][4];
#pragma unroll
        for (int ks = 0; ks < 4; ++ks) { float sc[8];
#pragma unroll
            for (int j = 0; j < 8; ++j) { const int s = 32 * ks + 8 * q + j; sc[j] = DTS[wid * 128 + s] * __expf(last - CUM[wid * 128 + s]); }
#pragma unroll
            for (int pb = 0; pb < 4; ++pb) { u32x4 o;
#pragma unroll
                for (int e = 0; e < 4; ++e) o[e] = cvt_pk_bf16(bflo(xr[pb][ks][e]) * sc[2 * e], bfhi(xr[pb][ks][e]) * sc[2 * e + 1]);
                xf[pb][ks] = __builtin_bit_cast(bf16x8, o); } }
#pragma unroll
        for (int nb = 0; nb < 8; ++nb) { bf16x8 bf[4];
#pragma unroll
            for (int ks = 0; ks < 4; ++ks) bf[ks] = lds_frag(BT, 16 * nb + c16, LP, 32 * ks + 8 * q);
#pragma unroll
            for (int pb = 0; pb < 4; ++pb) { f32x4 acc = (f32x4){0.f, 0.f, 0.f, 0.f};
#pragma unroll
                for (int ks = 0; ks < 4; ++ks) acc = MFMA16(bf[ks], xf[pb][ks], acc);
                *(u32x2*)(ST + (((size_t)bc * 64 + hd) * 64 + 16 * pb + c16) * 128 + 16 * nb + 4 * q) = pack4(acc); } }
        WG_SYNC();
    }
}
__device__ __forceinline__ void ssd2_scan(const int tid, int G, int cu, bf16* ST, const float* DEC) {
    for (int task = cu * NTHR + tid; task < NB * 4096 * 32; task += G * NTHR) {
        const int b = task >> 17, r = task & 131071, hp = r >> 5, n4 = (r & 31) * 4, hd = hp >> 6; f32x4 S = (f32x4){0.f, 0.f, 0.f, 0.f};
        bf16* p0 = ST + ((size_t)(b * 32) * 4096 + hp) * 128 + n4; const float* d0 = DEC + (b * 32) * 64 + hd;
        u32x2 L[32]; float d[32];
#pragma unroll
        for (int c = 0; c < 32; ++c) { L[c] = *(const u32x2*)(p0 + (size_t)c * 4096 * 128); d[c] = d0[c * 64]; }
#pragma unroll
        for (int c = 0; c < 32; ++c) { *(u32x2*)(p0 + (size_t)c * 4096 * 128) = pack4(S);
            S[0] = d[c] * S[0] + bflo(L[c].x); S[1] = d[c] * S[1] + bfhi(L[c].x); S[2] = d[c] * S[2] + bflo(L[c].y); S[3] = d[c] * S[3] + bfhi(L[c].y); }
    }
}
__device__ __forceinline__ void ssd3_units(const int tid, LAS unsigned char* lds, int G, int cu, const bf16* XBT, const bf16* BCN, const bf16* ST, const float* DT, const float* a_log, const float* dskip,
                                           const bf16* Z, const float* normw, bf16* Y) {
    const int wid = __builtin_amdgcn_readfirstlane(tid >> 6), lane = tid & 63, q = lane >> 4, c16 = lane & 15;
    LAS bf16* CN = (LAS bf16*)(lds);
    LAS bf16* BN = (LAS bf16*)(lds + 34816);
    LAS bf16* CB = (LAS bf16*)(lds + 69632);
    LAS float* CUM = (LAS float*)(lds + 104448);
    LAS float* DTS = (LAS float*)(lds + 108544);
    LAS float* SQP = (LAS float*)(lds + 112640);
    for (int u = cu; u < 1024; u += G) {
        const int bc = u >> 3, g = u & 7, t0 = bc * 128, hd = g * 8 + wid;
#pragma unroll
        for (int i = 0; i < 4; ++i) { const int p = tid + NTHR * i, r = p >> 4, pc = p & 15; const bf16* src = BCN + (size_t)(t0 + r) * 2048 + g * 128 + pc * 8;
            *(LAS u32x4*)(BN + r * LP + pc * 8) = *(const u32x4*)src; *(LAS u32x4*)(CN + r * LP + pc * 8) = *(const u32x4*)(src + 1024); }
        (void)ssd_tables(DT, a_log, t0, hd, wid, lane, CUM, DTS);
        bf16x8 sf[4][4];
        const bf16* xb = XBT + ((size_t)bc * 5120 + hd * 64 + c16) * 128 + 8 * q;
        { const bf16* sb = ST + (((size_t)bc * 64 + hd) * 64 + c16) * 128 + 8 * q;
#pragma unroll
          for (int pb = 0; pb < 4; ++pb)
#pragma unroll
              for (int ks = 0; ks < 4; ++ks) sf[pb][ks] = *(const bf16x8*)(sb + (size_t)(16 * pb) * 128 + 32 * ks); }
        WG_SYNC();
        {
            bf16x8 cf[4];
#pragma unroll
            for (int ks = 0; ks < 4; ++ks) cf[ks] = lds_frag(CN, 16 * wid + c16, LP, 32 * ks + 8 * q);
#pragma unroll
            for (int sb = 0; sb < 8; ++sb) { if (sb > wid + 1) continue; f32x4 acc = (f32x4){0.f, 0.f, 0.f, 0.f};
#pragma unroll
                for (int ks = 0; ks < 4; ++ks) acc = MFMA16(lds_frag(BN, 16 * sb + c16, LP, 32 * ks + 8 * q), cf[ks], acc);
                *(LAS u32x2*)(CB + (16 * wid + c16) * LP + 16 * sb + 4 * q) = pack4(acc); }
        }
        WG_SYNC();
        const float dsk = dskip[hd];
        bf16* ybase = Y + (size_t)t0 * SSDIN + hd * 64 + 4 * q; const bf16* zbase = Z + (size_t)t0 * SSDIN + hd * 64 + 4 * q;
        const f32x4 nw0 = *(const f32x4*)(normw + hd * 64 + 4 * q), nw1 = *(const f32x4*)(normw + hd * 64 + 16 + 4 * q), nw2 = *(const f32x4*)(normw + hd * 64 + 32 + 4 * q), nw3 = *(const f32x4*)(normw + hd * 64 + 48 + 4 * q);
#pragma unroll 1
        for (int tp = 0; tp < 8; ++tp) {
        u32x2 yk[1][4];
#pragma unroll
        for (int tt = 0; tt < 1; ++tt) { const int tb = tp;
            const int tl = 16 * tb + c16; const float cumt = CUM[wid * 128 + tl], ect = __expf(cumt);
            f32x4 acc[4];
            { bf16x8 cf[4];
#pragma unroll
              for (int ks = 0; ks < 4; ++ks) cf[ks] = lds_frag(CN, tl, LP, 32 * ks + 8 * q);
#pragma unroll
              for (int pb = 0; pb < 4; ++pb) { acc[pb] = (f32x4){0.f, 0.f, 0.f, 0.f};
#pragma unroll
                  for (int ks = 0; ks < 4; ++ks) acc[pb] = MFMA16(sf[pb][ks], cf[ks], acc[pb]);
                  acc[pb] = acc[pb] * ect; } }
#pragma unroll
            for (int ks = 0; ks < 4; ++ks) { if (32 * ks > 16 * tb + 15) continue;
                const int s0 = 32 * ks + 8 * q; const u32x4 cbw = *(const LAS u32x4*)(CB + tl * LP + s0);
                const f32x4 c0 = *(const LAS f32x4*)(CUM + wid * 128 + s0), c1 = *(const LAS f32x4*)(CUM + wid * 128 + s0 + 4), d0 = *(const LAS f32x4*)(DTS + wid * 128 + s0), d1 = *(const LAS f32x4*)(DTS + wid * 128 + s0 + 4);
                float gv[8];
#pragma unroll
                for (int j = 0; j < 8; ++j) { const int s = s0 + j; const float cb = (j & 1) ? bfhi(cbw[j >> 1]) : bflo(cbw[j >> 1]); const float cs = j < 4 ? c0[j & 3] : c1[j & 3], ds = j < 4 ? d0[j & 3] : d1[j & 3];
                    float v = cb * __expf(fminf(cumt - cs, 0.f)) * ds; v = (s <= tl) ? v : 0.f; gv[j] = (s == tl) ? v + dsk : v; }
                u32x4 gw; gw.x = cvt_pk_bf16(gv[0], gv[1]); gw.y = cvt_pk_bf16(gv[2], gv[3]); gw.z = cvt_pk_bf16(gv[4], gv[5]); gw.w = cvt_pk_bf16(gv[6], gv[7]);
                const bf16x8 gf = __builtin_bit_cast(bf16x8, gw);
#pragma unroll
                for (int pb = 0; pb < 4; ++pb) acc[pb] = MFMA16(*(const bf16x8*)(xb + (size_t)(16 * pb) * 128 + 32 * ks), gf, acc[pb]);
            }
            float sq = 0.f;
#pragma unroll
            for (int pb = 0; pb < 4; ++pb) { const u32x2 zw = *(const u32x2*)(zbase + (size_t)tl * SSDIN + 16 * pb);
                f32x4 y; y[0] = acc[pb][0] * bflo(zw.x); y[1] = acc[pb][1] * bfhi(zw.x); y[2] = acc[pb][2] * bflo(zw.y); y[3] = acc[pb][3] * bfhi(zw.y);
                sq += (y[0] * y[0] + y[1] * y[1]) + (y[2] * y[2] + y[3] * y[3]); yk[tt][pb] = pack4(y); }
            sq += __shfl_xor(sq, 16); sq += __shfl_xor(sq, 32);
            if (q == 0) SQP[tl * 8 + wid] = sq;
        }
        WG_SYNC();
#pragma unroll
        for (int tt = 0; tt < 1; ++tt) { const int tl = 16 * tp + c16; const f32x4 s0 = *(const LAS f32x4*)(SQP + tl * 8), s1 = *(const LAS f32x4*)(SQP + tl * 8 + 4);
            const float rstd = rsqrtf((((s0[0] + s0[1]) + (s0[2] + s0[3])) + ((s1[0] + s1[1]) + (s1[2] + s1[3]))) * (1.0f / 512.f) + EPS);
#pragma unroll
            for (int pb = 0; pb < 4; ++pb) { bf16* yp = ybase + (size_t)tl * SSDIN + 16 * pb; const u32x2 w = yk[tt][pb]; const f32x4 nw = pb == 0 ? nw0 : pb == 1 ? nw1 : pb == 2 ? nw2 : nw3;
                f32x4 y; y[0] = bflo(w.x) * rstd * nw[0]; y[1] = bfhi(w.x) * rstd * nw[1]; y[2] = bflo(w.y) * rstd * nw[2]; y[3] = bfhi(w.y) * rstd * nw[3];
                *(u32x2*)yp = pack4(y); } }
        }
        WG_SYNC();
    }
}
#ifndef REP_GEMM
#define REP_GEMM 1
#endif
#if REP_GEMM == 2
#define GEMM_REP(...) { __VA_ARGS__ } { __VA_ARGS__ }
#else
#define GEMM_REP(...) { __VA_ARGS__ }
#endif
#ifndef REP_MIX
#define REP_MIX 1
#endif
#ifndef REP_CONV
#define REP_CONV 1
#endif
struct Args { In in; float* out; unsigned char* ws; int ph_lo, ph_hi; };
static_assert(sizeof(Args) == 32 * 8 + 8 + 8 + 8, "Args has no padding");
typedef const Args __attribute__((address_space(4))) CArgs;

#ifndef SLEEP_MASK
#define SLEEP_MASK 0ull
#endif
#define SLEEP_AMP 4
#define PHASE_BEGIN if (pc >= lo && pc < hi) { const unsigned long long t0_ = SLEEP_MASK ? __builtin_amdgcn_s_memrealtime() : 0ull; (void)t0_; int tid = wave0 * 64 + (int)__builtin_amdgcn_mbcnt_hi(~0u, __builtin_amdgcn_mbcnt_lo(~0u, 0u)); asm volatile("" : "+v"(tid)); int cu = __builtin_amdgcn_readfirstlane((int)*(volatile LAS unsigned*)(lds + MISC_OFF + 64)); asm volatile("" : "+s"(cu)); int G = gridDim.x; asm volatile("" : "+s"(G)); \
        const int lane = tid & 63, wave = __builtin_amdgcn_readfirstlane(tid >> 6), gw = cu * NWAVES + wave, NGW = G * NWAVES; (void)lane; (void)gw; (void)NGW; \
        CArgs* ap = (CArgs*)__builtin_amdgcn_kernarg_segment_ptr(); asm volatile("" : "+s"(ap)); CIn& I = ap->in; unsigned char* const ws = ap->ws; float* const xres = ap->out; \
        unsigned char* const act = ws + WS_ACT; float* const SS = (float*)(ws + WS_SS); bf16* const XB = (bf16*)(ws + WS_XB); bf16* const WL = (bf16*)(ws + WS_WL); (void)I; (void)xres; (void)act; (void)SS; (void)XB; (void)WL;
#if MK_SPLIT
#define PHASE_END } ++pc;
#else
#define PHASE_END if (pc + 1 < hi) xcd_barrier(bar); if (SLEEP_MASK && ((SLEEP_MASK >> pc) & 1ull)) { const unsigned long long t1_ = __builtin_amdgcn_s_memrealtime(), until_ = t1_ + SLEEP_AMP * (t1_ - t0_); while (__builtin_amdgcn_s_memrealtime() < until_) __builtin_amdgcn_s_sleep(8); } } ++pc;
#endif
#if MK_SPLIT
#define PHASE_END_XCD } ++pc;
#else
#define PHASE_END_XCD if (pc + 1 < hi) { if (*(volatile LAS unsigned*)(lds + MISC_OFF + 68)) xcd_local_barrier(bar, 32u); else xcd_barrier(bar); } } ++pc;
#endif
#define PHASE_END_LOCAL } ++pc;
#define D_WKV ((bf16*)(ws + WS_WKV))
#define D_KMAT ((bf16*)(ws + WS_KMAT))
#define D_VT ((bf16*)(ws + WS_VT))
#define D_MEMN ((bf16*)(ws + WS_MEMN))
#define D_LB ((float*)(ws + WS_TAB + TAB_LB))
#define D_WRT ((bf16*)(ws + WS_TAB + TAB_WRT))


#define KQb ((bf16*)(ws + WS_KQ))
#define VWb ((bf16*)(ws + WS_VW))
#define Pb ((bf16*)(act + A_P))
#define Hb ((bf16*)(act + A_H))
#define ABSORB_UNIT \
            if (cu < 256) { int nu = 1, kk = XAD; asm volatile("" : "+s"(nu), "+s"(kk)); const int iskq = cu < 128, idx = cu & 127, bh = idx >> 3, t8 = idx & 7, b = bh >> 2, h = bh & 3; \
                const bf16* Km = D_KMAT + (size_t)l * MEMROWS * D; const bf16* Vm = D_VT + (size_t)l * MEMROWS * D; \
                pg8::SchedOne S; S.n = nu; \
                S.u0.a = iskq ? (const char*)(Km + (size_t)(b * MEMLEN) * D + h * XAD) : (const char*)(WLL + WL_O + (size_t)(t8 * 256) * D + h * XAD); \
                S.u0.b = iskq ? (const char*)(WLL + WL_Q + (size_t)(t8 * 256) * D + h * XAD) : (const char*)(Vm + (size_t)(b * MEMLEN) * D + h * XAD); \
                S.u0.orow = iskq ? bh * 256 : t8 * 256; S.u0.ocol = iskq ? t8 * 256 : h * 256; S.u0.aux = 0; \
                pg8::EpiPlain E{iskq ? KQb : VWb + (size_t)b * D * 1024, iskq ? D : 1024}; pg8::gemm_phase(tid, lds, kk, D, D, S, E); }
template <int l>
__device__ __forceinline__ void layer_body(LAS unsigned char* lds, const int wave0, const int lo, const int hi, int& pc, const XcdBarrier& bar) {
    int ssi = 3 * l;
#define WLL ((bf16*)(ws + ((l & 1) ? WS_WL2 : WS_WL)))
#define WLN ((bf16*)(ws + ((l & 1) ? WS_WL : WS_WL2)))

        const int e = l >> 1;
        int mixK;
        if ((l & 1) == 0) {
#define PROJ ((bf16*)(act + A_PROJ))
#define LOGF ((float*)(act + A_LOGF))
#define HST ((bf16*)(act + A_HST))
#define YAB ((bf16*)(act + A_YAB))
#define SEG ((float*)(act + A_SEG))
#define HDEC ((float*)(act + A_HDEC))
            PHASE_BEGIN
                if (l == 0 && (cu & 1)) { int rot = 0; convert_layer<2>(I, 0, WLL, (LAS float*)(lds + wave * 16640), gw, NGW, lane, rot); WG_SYNC(); asm volatile("" : "+v"(tid)); }
                if (l == 0) { pg8::SchedKV S{(const char*)D_MEMN, (const char*)D_WKV, G, cu}; pg8::EpiKV E{D_KMAT, D_VT}; pg8::gemm_phase(tid, lds, D, D, D, S, E); asm volatile("" : "+v"(tid)); }
                GEMM_REP(pg8::SchedMN S; S.init(XB, D, WLL + WL_IN, D, M, ABIN, G, cu); pg8::EpiProjEven E{SS + (size_t)ssi * M * 8, PROJ, LOGF, D_LB + e * 1024};
                pg8::gemm_phase<RF16>(tid, lds, D, D, D, S, E);)
                if (l == 0 && !(cu & 1)) { asm volatile("" : "+v"(tid)); const int lane2 = tid & 63, wave2 = __builtin_amdgcn_readfirstlane(tid >> 6); int rot = 0; convert_layer<2>(I, 0, WLL, (LAS float*)(lds + wave2 * 16640), cu * NWAVES + wave2, NGW, lane2, rot); }
            PHASE_END
            PHASE_BEGIN
                for (int rep_ = 0; rep_ < REP_MIX; ++rep_) { lru_units<false>(tid, lds, G, cu, PROJ, D_WRT + (size_t)e * 2 * 8 * 16384, I.lru_conv_w + e * 4 * LRUW, I.lru_conv_b + e * LRUW, I.lru_b_r + e * LRUW, I.lru_b_i + e * LRUW, I.lru_lambda + e * LRUW, SEG, YAB);
                hgrn1_units(tid, lds, G, cu, LOGF, PROJ, HST, HDEC); }
            PHASE_END
            PHASE_BEGIN
                for (int rep_ = 0; rep_ < REP_MIX; ++rep_) { lru_units<true>(tid, lds, G, cu, PROJ, D_WRT + (size_t)e * 2 * 8 * 16384, I.lru_conv_w + e * 4 * LRUW, I.lru_conv_b + e * LRUW, I.lru_b_r + e * LRUW, I.lru_b_i + e * LRUW, I.lru_lambda + e * LRUW, SEG, YAB); }
                hgrn2_scan(tid, G, cu, HST, HDEC);
            PHASE_END
            PHASE_BEGIN
                if (cu & 1) { ABSORB_UNIT asm volatile("" : "+v"(tid)); }
                for (int rep_ = 0; rep_ < REP_MIX; ++rep_) { hgrn3_units(tid, lds, G, cu, LOGF, PROJ, HST, I.hgrn_norm + e * 1024, YAB); }
                if (!(cu & 1)) { WG_SYNC(); asm volatile("" : "+v"(tid)); ABSORB_UNIT }
            PHASE_END
            mixK = D;
        } else {
#define Zb ((bf16*)(act + A_Z))
#define XBC ((bf16*)(act + A_XBC))
#define XBT ((bf16*)(act + A_XBT))
#define BCN ((bf16*)(act + A_BCN))
#define STb ((bf16*)(act + A_ST))
#define DTb ((float*)(act + A_DT))
#define DEC ((float*)(act + A_DEC))
#define Yb ((bf16*)(act + A_Y))
            PHASE_BEGIN
                GEMM_REP(pg8::SchedMN S; S.init(XB, D, WLL + WL_IN, D, M, SSDN1, G, cu); pg8::EpiProjOdd E{SS + (size_t)ssi * M * 8, Zb, XBC};
                pg8::gemm_phase<RF16>(tid, lds, D, D, D, S, E);)
            PHASE_END
            PHASE_BEGIN
                for (int rep_ = 0; rep_ < REP_MIX; ++rep_) {
                { pg8::SchedDt S{(const char*)XB, (const char*)(WLL + WL_DT), cu}; pg8::EpiDt E{SS + (size_t)ssi * M * 8, I.ssd_dt_bias + e * 64, DTb};
                  pg8::gemm_phase<RF16>(tid, lds, D, D, D, S, E); }
                { int uf = cu, us = G, ue = 6144; if (G == 256) { if (cu < 64) { us = 64; ue = 1152; } else { uf = 1152 + (cu - 64); us = 192; } }
                  ssd_prep_units(tid, lds, uf, us, ue, XBC, I.ssd_conv_w + (size_t)e * 4 * SSDCONV, I.ssd_conv_b + e * SSDCONV, XBT, BCN); }
                }
            PHASE_END
            PHASE_BEGIN
                for (int rep_ = 0; rep_ < REP_MIX; ++rep_) { ssd1_units(tid, lds, G, cu, XBT, DTb, I.ssd_a_log + e * 64, STb, DEC); }
            PHASE_END
            PHASE_BEGIN
                ssd2_scan(tid, G, cu, STb, DEC);
            PHASE_END
            PHASE_BEGIN
                if (cu & 1) { ABSORB_UNIT asm volatile("" : "+v"(tid)); }
                for (int rep_ = 0; rep_ < REP_MIX; ++rep_) { ssd3_units(tid, lds, G, cu, XBT, BCN, STb, DTb, I.ssd_a_log + e * 64, I.ssd_d + e * 64, Zb, I.ssd_norm + e * SSDIN, Yb); }
                if (!(cu & 1)) { WG_SYNC(); asm volatile("" : "+v"(tid)); ABSORB_UNIT }
            PHASE_END
            mixK = SSDIN;
        }
        PHASE_BEGIN
            { pg8::SchedMN S; S.init(mixK == D ? (const bf16*)YAB : (const bf16*)Yb, mixK, WLL + WL_OUT, mixK, M, D, G, cu); pg8::EpiResid E{XB, SS + (size_t)(ssi + 1) * M * 8, (LAS float*)(lds + EPI_OFF)};
              pg8::gemm_phase(tid, lds, mixK, mixK, mixK, S, E); asm volatile("" : "+v"(tid)); }
        PHASE_END_XCD
        ++ssi;
        PHASE_BEGIN
            static_assert(!RF16, "the absorbed key matrix is bf16: the residual stream must be bf16 too");
            if (cu < 256) { const int pm = (cu & 7) * 8 + (cu >> 5), h = (cu >> 3) & 3;     int nu = 1; asm volatile("" : "+s"(nu));
                pg8::SchedOne S; S.n = nu; S.u0.a = (const char*)(XB + (size_t)pm * 256 * D); S.u0.b = (const char*)(KQb + (size_t)(((pm >> 4) * 4 + h) * 256) * D); S.u0.orow = pm * 256; S.u0.ocol = h * 256; S.u0.aux = 0;
                pg8::EpiSoftmax E{SS + (size_t)ssi * M * 8, 0.044194173824159216f, Pb, (LAS float*)(lds + EPI_OFF)}; pg8::gemm_phase(tid, lds, D, D, D, S, E); }
        PHASE_END_XCD
        PHASE_BEGIN
            pg8::SchedMNB S; S.init(Pb, 1024, VWb, 1024, M, D, G, cu, (size_t)D * 1024 * 2); pg8::EpiResid E{XB, SS + (size_t)(ssi + 1) * M * 8, (LAS float*)(lds + EPI_OFF)};
            pg8::gemm_phase(tid, lds, 1024, 1024, 1024, S, E);
        PHASE_END
        ++ssi;
        PHASE_BEGIN
            if (l + 1 < DEPTH && (cu & 1)) { int rot = 0; convert_layer(I, l + 1, WLN, (LAS float*)(lds + wave * 16640), gw, NGW, lane, rot); WG_SYNC(); asm volatile("" : "+v"(tid)); }
            GEMM_REP(pg8::SchedMN S; S.init(XB, D, WLL + WL_GU, D, M, 2 * FF, G, cu); pg8::EpiGateUp E{SS + (size_t)ssi * M * 8, Hb};
            pg8::gemm_phase<RF16>(tid, lds, D, D, D, S, E);)
            if (l + 1 < DEPTH && !(cu & 1)) { asm volatile("" : "+v"(tid)); const int lane2 = tid & 63, wave2 = __builtin_amdgcn_readfirstlane(tid >> 6); int rot = 0; convert_layer(I, l + 1, WLN, (LAS float*)(lds + wave2 * 16640), cu * NWAVES + wave2, NGW, lane2, rot); }
        PHASE_END_XCD
        PHASE_BEGIN
            pg8::SchedMN S; S.init(Hb, FF, WLL + WL_DN, FF, M, D, G, cu); pg8::EpiResid E{XB, SS + (size_t)(ssi + 1) * M * 8, (LAS float*)(lds + EPI_OFF)};
            pg8::gemm_phase(tid, lds, FF, FF, FF, S, E);
        PHASE_END
        ++ssi;
    }

__global__ void __launch_bounds__(NTHR, 2) fwd(Args args) {
    extern __shared__ __attribute__((aligned(16))) unsigned char lds_raw[];
    LAS unsigned char* lds = (LAS unsigned char*)lds_raw;
    volatile LAS unsigned* MISC = (volatile LAS unsigned*)(lds + MISC_OFF);
    const int wave0 = __builtin_amdgcn_readfirstlane((int)threadIdx.x >> 6);
    if (threadIdx.x < 64) MISC[threadIdx.x] = 0u;
    __syncthreads();
#if !MK_SPLIT
    XcdBarrier bar = xcd_barrier_post((unsigned*)(args.ws + WS_CTL), MISC + 8);
    if (threadIdx.x == 0) { MISC[16] = blockIdx.x; MISC[17] = 0u; MISC[18] = xb_add(&bar.bar[XL_RANK(bar.x)], 1u); }
    __syncthreads();
#else
    XcdBarrier bar; bar.bar = nullptr; bar.x = 0; bar.st = nullptr;
    if (threadIdx.x == 0) { MISC[16] = blockIdx.x; MISC[17] = 0u; }
    __syncthreads();
#endif
    const int lo = args.ph_lo, hi = args.ph_hi; int pc = 0;
    PHASE_BEGIN
        LAS float* scr = (LAS float*)(lds + wave * 16640);
        int rot = 0;
        for (int l = 0; l < DEPTH; ++l) conv_matrix<0>(I.xa_w_kv + (size_t)l * D * 4096, 4096, D, 0, 4096, nullptr, D_WKV + (size_t)l * 4096 * D, 0, scr, gw, NGW, lane, rot);
        for (int rep_ = 0; rep_ < REP_CONV; ++rep_) convert_layer<1>(I, 0, WL, scr, gw, NGW, lane, rot);
        for (int m = gw; m < MEMROWS; m += NGW) {
            const f32x4* xr = (const f32x4*)(I.mem + (size_t)m * D); f32x4 v[8]; float s = 0.f;
#pragma unroll
            for (int j = 0; j < 8; ++j) { v[j] = xr[64 * j + lane]; s += (v[j][0] * v[j][0] + v[j][1] * v[j][1]) + (v[j][2] * v[j][2] + v[j][3] * v[j][3]); }
            const float rs = rsqrtf(wave_sum(s) * (1.0f / D) + EPS);
#pragma unroll
            for (int j = 0; j < 8; ++j) { const f32x4 g = *(const f32x4*)(I.norm_mem + (64 * j + lane) * 4); *(u32x2*)(D_MEMN + (size_t)m * D + (64 * j + lane) * 4) = pack4(v[j] * rs * g); }
        }
        for (int m = gw; m < M; m += NGW) {
            const f32x4* xr = (const f32x4*)(I.x + (size_t)m * D); float s = 0.f;
#pragma unroll
            for (int j = 0; j < 8; ++j) { const f32x4 v = xr[64 * j + lane]; s += (v[0] * v[0] + v[1] * v[1]) + (v[2] * v[2] + v[3] * v[3]); u32x2 w; w.x = rs_pk(v[0], v[1]); w.y = rs_pk(v[2], v[3]); *(u32x2*)(XB + (size_t)m * D + (64 * j + lane) * 4) = w; }
            s = wave_sum(s); if (lane < 8) SS[(size_t)m * 8 + lane] = lane == 0 ? s : 0.f;
        }
        for (int i = cu * NTHR + tid; i < 1024; i += G * NTHR) {
            const float a = I.hgrn_lb[i], b = I.hgrn_lb[1024 + i], mx = fmaxf(a, b), e0 = __expf(a - mx), e1 = __expf(b - mx); D_LB[i] = 0.f; D_LB[1024 + i] = e1 / (e0 + e1); }
        for (int i = cu * NTHR + tid; i < 2 * 2 * 8 * 16384; i += G * NTHR) {
            const int ii = i & 127, jj = (i >> 7) & 127, blk = (i >> 14) & 7, gt = (i >> 17) & 1, e = i >> 18;
            const float* src = gt ? I.lru_w_i : I.lru_w_r; D_WRT[i] = (bf16)f2bf(src[((size_t)(e * 8 + blk) * 128 + ii) * 128 + jj]); }
    PHASE_END

#if !MK_SPLIT
    if (threadIdx.x == 0) { bool uni = gridDim.x == 256;
        for (unsigned j = 0; j < 16; ++j) { const unsigned c = xb_ld(&bar.bar[XB_XCNT(j)]); uni = uni && (c == (j < 8 ? 32u : 0u)); }
        if (uni && MISC[18] < 32u) { MISC[16] = 8u * MISC[18] + bar.x; MISC[17] = 1u; } }
    __syncthreads();
#endif
    layer_body<0>(lds, wave0, lo, hi, pc, bar); layer_body<1>(lds, wave0, lo, hi, pc, bar); layer_body<2>(lds, wave0, lo, hi, pc, bar); layer_body<3>(lds, wave0, lo, hi, pc, bar);
    const int ssi = 12;
    PHASE_BEGIN
        const float* ssf = SS + (size_t)ssi * M * 8;
        for (int m = gw; m < M; m += NGW) { f32x4* row = (f32x4*)(xres + (size_t)m * D); const u32x2* xr = (const u32x2*)(XB + (size_t)m * D); const float rs = pg8::rstd_of(ssf, m);
#pragma unroll
            for (int j = 0; j < 8; ++j) { const f32x4 g = *(const f32x4*)(I.norm_final + (64 * j + lane) * 4); const u32x2 w = xr[64 * j + lane];
                f32x4 o; o[0] = rs_lo(w.x) * rs * g[0]; o[1] = rs_hi(w.x) * rs * g[1]; o[2] = rs_lo(w.y) * rs * g[2]; o[3] = rs_hi(w.y) * rs * g[3]; row[64 * j + lane] = o; } }
    PHASE_END
#undef PHASE_BEGIN
#undef PHASE_END
}

constexpr int NPHASES = 1 + (5 + 4) + (6 + 4) + (5 + 4) + (6 + 4) + 1;

extern "C" void kernel_launch(void* const* d_in, const int* in_sizes, int n_in, void* d_out, int out_size, void* d_ws, size_t ws_size, hipStream_t stream) {
    static int grid = 0;
    if (grid == 0) {
        if (n_in != 32 || out_size != M * D || ws_size < WS_END) { fprintf(stderr, "kernel_launch: unexpected problem (n_in %d, out %d, ws %zu)\n", n_in, out_size, ws_size); grid = -1; return; }
        int dev = 0, cus = 0;
        if (hipGetDevice(&dev) != hipSuccess || hipDeviceGetAttribute(&cus, hipDeviceAttributeMultiprocessorCount, dev) != hipSuccess) { grid = -1; return; }
        if (hipFuncSetAttribute((const void*)fwd, hipFuncAttributeMaxDynamicSharedMemorySize, LDS_BYTES) != hipSuccess) { fprintf(stderr, "kernel_launch: hipFuncSetAttribute failed\n"); grid = -1; return; }
        int per_cu = 0;
        if (hipOccupancyMaxActiveBlocksPerMultiprocessor(&per_cu, (const void*)fwd, NTHR, LDS_BYTES) != hipSuccess || per_cu < 1) fprintf(stderr, "kernel_launch: occupancy query says %d\n", per_cu);
        (void)hipGetLastError();
        if (cus != 256) { fprintf(stderr, "kernel_launch: built for a 256-CU device (got %d)\n", cus); grid = -1; return; }
        grid = cus;
    }
    if (grid < 0) return;
    (void)hipMemsetAsync((char*)d_ws + WS_CTL, 0, CTL_ZERO_BYTES, stream);
    Args a{};
    const float** ip = (const float**)&a.in;
    for (int i = 0; i < 32; ++i) ip[i] = (const float*)d_in[i];
    a.out = (float*)d_out; a.ws = (unsigned char*)d_ws;
#if MK_SPLIT
#ifndef PROBE_MASK
#define PROBE_MASK 0ull
#endif
    for (int li = 0; li < NPHASES; ++li) { a.ph_lo = li; a.ph_hi = li + 1; hipLaunchKernelGGL(fwd, dim3(grid), dim3(NTHR), LDS_BYTES, stream, a);
        if ((PROBE_MASK >> li) & 1ull) hipLaunchKernelGGL(fwd, dim3(grid), dim3(NTHR), LDS_BYTES, stream, a); }
#else
    a.ph_lo = 0; a.ph_hi = NPHASES;
    hipLaunchKernelGGL(fwd, dim3(grid), dim3(NTHR), LDS_BYTES, stream, a);
#endif
}
```

```cpp
#include <hip/hip_runtime.h>
#include <cstdio>
#include <cstdint>

#ifndef MK_SPLIT
#define MK_SPLIT 0
#endif

#ifndef RESID_F16
#define RESID_F16 0
#endif
constexpr bool RF16 = RESID_F16 != 0;
#define GAS __attribute__((address_space(1)))
#define LAS __attribute__((address_space(3)))
typedef unsigned short bf16;
typedef short bf16x8 __attribute__((ext_vector_type(8)));
typedef float f32x4 __attribute__((ext_vector_type(4)));
typedef float f32x2 __attribute__((ext_vector_type(2)));
typedef unsigned u32x4 __attribute__((ext_vector_type(4)));
typedef unsigned u32x2 __attribute__((ext_vector_type(2)));

constexpr int D = 2048, NB = 4, SEQ = 4096, M = NB * SEQ, DEPTH = 4, MEMLEN = 256, MEMROWS = NB * MEMLEN;
constexpr int LRUW = 1024, ABIN = 6144;
constexpr int SSDIN = 4096, SSDCONV = 6144, SSDPROJ = 10304, SSDN1 = 10240, NHEADS = 64;
constexpr int XAD = 512, FF = 5632;
constexpr float EPS = 1e-6f;
constexpr int NWAVES = 8, NTHR = 512;

constexpr size_t MiB = 1u << 20;
constexpr size_t WS_CTL = 0, CTL_ZERO_BYTES = 32 * 1024;
constexpr size_t WS_WKV = 2 * MiB;
constexpr size_t WS_KMAT = 66 * MiB;
constexpr size_t WS_VT = 82 * MiB;
constexpr size_t WS_MEMN = 98 * MiB;
constexpr size_t WS_TAB = 102 * MiB;
constexpr size_t WS_XB = 106 * MiB;
constexpr size_t WS_WL = 170 * MiB;
constexpr size_t WS_ACT = 310 * MiB;
constexpr size_t WS_SS = (310 + 680) * MiB;
constexpr size_t WS_WL2 = (310 + 680 + 8) * MiB;
constexpr size_t WS_KQ = (310 + 680 + 8 + 140) * MiB;
constexpr size_t WS_VW = WS_KQ + 16 * MiB;
constexpr size_t WS_END = WS_VW + 16 * MiB;
constexpr size_t TAB_LB = 0;
constexpr size_t TAB_WRT = 64 * 1024;
constexpr size_t WL_IN = 0;
constexpr size_t WL_DT = (size_t)SSDN1 * D;
constexpr size_t WL_OUT = (size_t)(SSDN1 + 256) * D;
constexpr size_t WL_Q = WL_OUT + (size_t)D * SSDIN;
constexpr size_t WL_O = WL_Q + (size_t)D * D;
constexpr size_t WL_GU = WL_O + (size_t)D * D;
constexpr size_t WL_DN = WL_GU + (size_t)2 * FF * D;
constexpr size_t WL_ELEMS = WL_DN + (size_t)D * FF;
static_assert(WL_ELEMS * 2 <= 140 * MiB, "per-layer weights");
constexpr size_t A_Z = 0;
constexpr size_t A_XBC = 128 * MiB;
constexpr size_t A_Y = 128 * MiB;
constexpr size_t A_XBT = 320 * MiB;
constexpr size_t A_BCN = 480 * MiB;
constexpr size_t A_ST = 544 * MiB;
constexpr size_t A_DT = 672 * MiB;
constexpr size_t A_DEC = 676 * MiB;
constexpr size_t A_PROJ = 0;
constexpr size_t A_LOGF = 192 * MiB;
constexpr size_t A_HST = 256 * MiB;
constexpr size_t A_YAB = 320 * MiB;
constexpr size_t A_SEG = 384 * MiB;
constexpr size_t A_HDEC = 386 * MiB;

constexpr size_t A_P = 64 * MiB;
constexpr size_t A_O = 96 * MiB;
constexpr size_t A_H = 160 * MiB;

constexpr int LDS_BYTES = 155648;
constexpr int EPI_OFF = 131072;
constexpr int MISC_OFF = LDS_BYTES - 256;

#define LDS_WAIT() asm volatile("s_waitcnt lgkmcnt(0)" ::: "memory")
#define VM_WAIT() asm volatile("s_waitcnt vmcnt(0)" ::: "memory")
__device__ __forceinline__ unsigned f2bf(float f) { unsigned u = __builtin_bit_cast(unsigned, f); return (u + 0x7fffu + ((u >> 16) & 1u)) >> 16; }
__device__ __forceinline__ unsigned pk2(float lo, float hi) { return f2bf(lo) | (f2bf(hi) << 16); }
typedef __bf16 bf16x2v __attribute__((ext_vector_type(2)));
__device__ __forceinline__ unsigned cvt_pk_bf16(float lo, float hi) { const f32x2 v = {lo, hi}; return __builtin_bit_cast(unsigned, __builtin_convertvector(v, bf16x2v)); }
typedef _Float16 f16x2v __attribute__((ext_vector_type(2)));
typedef _Float16 f16x8 __attribute__((ext_vector_type(8)));
__device__ __forceinline__ unsigned cvt_pk_f16(float lo, float hi) { const f32x2 v = {lo, hi}; return __builtin_bit_cast(unsigned, __builtin_convertvector(v, f16x2v)); }
__device__ __forceinline__ float h16lo(unsigned w) { return (float)__builtin_bit_cast(f16x2v, w)[0]; }
__device__ __forceinline__ float h16hi(unsigned w) { return (float)__builtin_bit_cast(f16x2v, w)[1]; }
__device__ __forceinline__ float bflo(unsigned w) { return __uint_as_float(w << 16); }
__device__ __forceinline__ float bfhi(unsigned w) { return __uint_as_float(w & 0xffff0000u); }
__device__ __forceinline__ unsigned rs_pk(float lo, float hi) { return RF16 ? cvt_pk_f16(lo, hi) : cvt_pk_bf16(lo, hi); }
__device__ __forceinline__ float rs_lo(unsigned w) { return RF16 ? h16lo(w) : bflo(w); }
__device__ __forceinline__ float rs_hi(unsigned w) { return RF16 ? h16hi(w) : bfhi(w); }
__device__ __forceinline__ float bf2f(bf16 b) { return __uint_as_float((unsigned)b << 16); }
__device__ __forceinline__ float sigm(float x) { return __builtin_amdgcn_rcpf(1.f + __expf(-x)); }
__device__ __forceinline__ float siluf(float x) { return x * sigm(x); }
__device__ __forceinline__ float gelu_tanh(float x) { return x * sigm(1.5957691216f * (x + 0.044715f * x * x * x)); }
__device__ __forceinline__ float softplusf(float x) { const float e = __expf(-fabsf(x)); const float l = (e < 0.03f) ? e * (1.f - e * (0.5f - e * 0.33333333f)) : __logf(1.f + e); return fmaxf(x, 0.f) + l; }
__device__ __forceinline__ float wave_sum(float v) {
#pragma unroll
    for (int o = 1; o < 64; o <<= 1) v += __shfl_xor(v, o);
    return v;
}

#define XB_TMO      128
#define XB_XCNT(j)  (256  + 64 * (j))
#define XB_XSUB(j)  (1280 + 64 * (j))
#define XB_XGEN(j)  (2304 + 64 * (j))
#define XB_TOP      3328
#define XB_TOPGEN   3392
#define XCD_BAR_WORDS 3456
#define XL_RANK(j)  (4096 + 64 * (j))
#define XL_SUB(j)   (5120 + 64 * (j))
#define XL_GEN(j)   (6144 + 64 * (j))
#define XB_SPIN_CAP (1u << 18)

__device__ __forceinline__ unsigned xb_ld(unsigned* p)              { return __hip_atomic_load(p, __ATOMIC_RELAXED, __HIP_MEMORY_SCOPE_AGENT); }
__device__ __forceinline__ unsigned xb_add(unsigned* p, unsigned v) { return __hip_atomic_fetch_add(p, v, __ATOMIC_RELAXED, __HIP_MEMORY_SCOPE_AGENT); }
__device__ __forceinline__ unsigned xb_xcc_id() { return (unsigned)__builtin_amdgcn_s_getreg((3 << 11) | 20) & 0xFu; }
#define XB_SPIN(cond, bar) do { unsigned _sp = 0; while (cond) { __builtin_amdgcn_s_sleep(1); \
    if ((++_sp & 255u) == 0u) { if (xb_ld(&(bar)[XB_TMO])) break; if (_sp > XB_SPIN_CAP) { atomicAdd(&(bar)[XB_TMO], 1u); break; } } } } while (0)

struct XcdBarrier {
    unsigned* bar; unsigned x;
    volatile LAS unsigned* st;
};
__device__ __forceinline__ XcdBarrier xcd_barrier_post(unsigned* bar, volatile LAS unsigned* st) {
    XcdBarrier b; b.bar = bar; b.x = xb_xcc_id(); b.st = st;
    if (threadIdx.x == 0) (void)xb_add(&bar[XB_XCNT(b.x)], 1u);
    return b;
}
__device__ __forceinline__ void xcd_barrier_complete(unsigned* bar, unsigned x, unsigned& nloc, unsigned& nx) {
    const unsigned G = gridDim.x * gridDim.y * gridDim.z;
    unsigned sum, cnt, mine, sp = 0u;
    for (;;) {
        sum = 0u; cnt = 0u; mine = 0u;
#pragma unroll
        for (unsigned j = 0; j < 16; ++j) { const unsigned c = xb_ld(&bar[XB_XCNT(j)]); sum += c; cnt += (c > 0u) ? 1u : 0u; mine = (j == x) ? c : mine; }
        if (sum == G) break;
        __builtin_amdgcn_s_sleep(1);
        if ((++sp & 255u) == 0u) { if (xb_ld(&bar[XB_TMO])) break; if (sp > XB_SPIN_CAP) { atomicAdd(&bar[XB_TMO], 1u); break; } }
    }
    nloc = mine > 0u ? mine : 1u; nx = cnt > 0u ? cnt : 1u;
}
__device__ __forceinline__ void xcd_barrier(const XcdBarrier& b) {
    asm volatile("s_waitcnt vmcnt(0)" ::: "memory");
    __syncthreads();
    if (threadIdx.x == 0) {
        unsigned* bar = b.bar;
        __builtin_amdgcn_s_waitcnt(0);
        unsigned nloc = b.st[0], nx = b.st[1];
        if (nloc == 0u) { xcd_barrier_complete(bar, b.x, nloc, nx); b.st[0] = nloc; b.st[1] = nx; }
        const unsigned old = xb_add(&bar[XB_XSUB(b.x)], 1u);
        const unsigned gen = old / nloc;
        if (old + 1u == (gen + 1u) * nloc) {
            __builtin_amdgcn_fence(__ATOMIC_RELEASE, "agent");
            asm volatile("s_waitcnt vmcnt(0)" ::: "memory");
            const unsigned og = xb_add(&bar[XB_TOP], 1u);
            const unsigned tg = og / nx;
            if (og + 1u == (tg + 1u) * nx) xb_add(&bar[XB_TOPGEN], 1u);
            else XB_SPIN(xb_ld(&bar[XB_TOPGEN]) == tg, bar);
            __builtin_amdgcn_fence(__ATOMIC_ACQUIRE, "agent");
            xb_add(&bar[XB_XGEN(b.x)], 1u);
            asm volatile("s_waitcnt vmcnt(0)" ::: "memory");
        } else {
            XB_SPIN(xb_ld(&bar[XB_XGEN(b.x)]) == gen, bar);
            __builtin_amdgcn_fence(__ATOMIC_ACQUIRE, "agent");
            asm volatile("s_waitcnt vmcnt(0)" ::: "memory");
        }
    }
    __syncthreads();
}

__device__ __forceinline__ void xcd_local_barrier(const XcdBarrier& b, unsigned n) {
    asm volatile("s_waitcnt vmcnt(0)" ::: "memory");
    __syncthreads();
    if (threadIdx.x == 0) {
        unsigned* bar = b.bar;
        __builtin_amdgcn_s_waitcnt(0);
        const unsigned old = xb_add(&bar[XL_SUB(b.x)], 1u), gen = old / n;
        if (old + 1u == (gen + 1u) * n) xb_add(&bar[XL_GEN(b.x)], 1u);
        else XB_SPIN(xb_ld(&bar[XL_GEN(b.x)]) == gen, bar);
        __builtin_amdgcn_fence(__ATOMIC_ACQUIRE, "agent");
        asm volatile("s_waitcnt vmcnt(0)" ::: "memory");
    }
    __syncthreads();
}

namespace pg8 {
constexpr int BM = 256, BK = 64, HALF = 128, HTB = HALF * BK * 2, STAGE_BYTES = 8 * HTB, NXCD = 8, WGM = 8;
__host__ __device__ __forceinline__ int lds_byte(int r, int c) { const int st = (r >> 4) * 2 + (c >> 5), rr = r & 15, cc = c & 31, ob = rr * 64 + cc * 2; return st * 1024 + (ob ^ (((ob >> 9) & 1) << 5)); }
__host__ __device__ __forceinline__ void stage_rc(int b, int& R, int& C) { const int st = b / 1024, sb = b % 1024, swz = sb ^ (((sb >> 9) & 1) << 5); R = (st >> 1) * 16 + swz / 64; C = (st & 1) * 32 + (swz % 64) / 2; }
__host__ __device__ __forceinline__ int perm32(int rho) { const int n = rho >> 4, i = rho & 15; return 8 * (i >> 2) + 4 * n + (i & 3); }

struct Unit { const char* a; const char* b; int orow, ocol, aux; };

template <bool F16 = false, bool ALIGN = true, class Epi, class Sched>
__device__ __forceinline__ void gemm_phase(const int tid, LAS unsigned char* lds, const int K, const int lda, const int ldb, const Sched& S, const Epi& E) {
    const int wid = __builtin_amdgcn_readfirstlane(tid >> 6), lane = tid & 63, wr = wid >> 2, wc = wid & 3, fr = lane & 15, fq = lane >> 4;
    const int nt = K / BK;
    unsigned voffA[2], voffB[2];
#pragma unroll
    for (int i = 0; i < 2; ++i) { int R, C; stage_rc(tid * 16 + i * 8192, R, C); const int Rb = (R & ~31) + perm32(R & 31);
        voffA[i] = (unsigned)(R * lda + C) * 2u; voffB[i] = (unsigned)(Rb * ldb + C) * 2u; }
    const size_t kstep = (size_t)(BK * 2);
    const size_t hstepA = (size_t)HALF * lda * 2, hstepB = (size_t)HALF * ldb * 2;
    const unsigned ldsw = (unsigned)wid * 1024u;
    const int aoff = lds_byte(wr * 64 + fr, fq * 8), boff = lds_byte(wc * 32 + fr, fq * 8);
#define PG8_SA(b, h) (((b) * 2 + (h)) * HTB)
#define PG8_SB(b, h) ((4 + (b) * 2 + (h)) * HTB)
#define PG8_STAGE(bufoff, gbase, voff) do { _Pragma("unroll") for (int _i = 0; _i < 2; ++_i) \
        __builtin_amdgcn_global_load_lds((const unsigned*)((const char*)(gbase) + (voff)[_i]), (LAS unsigned*)(lds + (bufoff) + ldsw + _i * 8192), 16, 0, 0); } while (0)
#define PG8_LDA(dst, b, h) do { _Pragma("unroll") for (int m = 0; m < 4; ++m) _Pragma("unroll") for (int k = 0; k < 2; ++k) dst[m][k] = *(const LAS bf16x8*)(lds + PG8_SA(b, h) + aoff + m * 2048 + k * 1024); } while (0)
#define PG8_LDB(dst, b, h) do { _Pragma("unroll") for (int n = 0; n < 2; ++n) _Pragma("unroll") for (int k = 0; k < 2; ++k) dst[n][k] = *(const LAS bf16x8*)(lds + PG8_SB(b, h) + boff + n * 2048 + k * 1024); } while (0)
#define PG8_MMA(ai, bj, At, Bt) do { __builtin_amdgcn_s_setprio(1); _Pragma("unroll") for (int m = 0; m < 4; ++m) _Pragma("unroll") for (int n = 0; n < 2; ++n) _Pragma("unroll") for (int k = 0; k < 2; ++k) \
        acc[ai][bj][m][n] = F16 ? __builtin_amdgcn_mfma_f32_16x16x32_f16(__builtin_bit_cast(f16x8, Bt[n][k]), __builtin_bit_cast(f16x8, At[m][k]), acc[ai][bj][m][n], 0, 0, 0) \
                                : __builtin_amdgcn_mfma_f32_16x16x32_bf16(Bt[n][k], At[m][k], acc[ai][bj][m][n], 0, 0, 0); __builtin_amdgcn_s_setprio(0); } while (0)
#define PG8_WAIT_V(n) asm volatile("s_waitcnt vmcnt(" #n ")" ::: "memory")
#define PG8_WAIT_L(n) asm volatile("s_waitcnt lgkmcnt(" #n ")" ::: "memory")
#define PG8_BAR __builtin_amdgcn_s_barrier()
#define PG8_SCHED __builtin_amdgcn_sched_barrier(0)
    Unit cur, nxt; int ui = 0;
    if (!S.next(0, cur)) return;
    f32x4 acc[2][2][4][2];
#pragma unroll
    for (int a = 0; a < 2; ++a)
#pragma unroll
        for (int b = 0; b < 2; ++b)
#pragma unroll
            for (int m = 0; m < 4; ++m)
#pragma unroll
                for (int n = 0; n < 2; ++n) acc[a][b][m][n] = (f32x4){0.f, 0.f, 0.f, 0.f};
    bf16x8 At[4][2], B0[2][2], B1[2][2];
    const char* cA = cur.a; const char* cB = cur.b;
    PG8_STAGE(PG8_SB(0, 0), cB, voffB); PG8_STAGE(PG8_SB(0, 1), cB + hstepB, voffB); PG8_STAGE(PG8_SA(0, 0), cA, voffA); PG8_STAGE(PG8_SA(0, 1), cA + hstepA, voffA);
    if (wr == 1) PG8_BAR;
    PG8_WAIT_V(2); PG8_BAR;
    PG8_STAGE(PG8_SB(1, 0), cB + kstep, voffB); PG8_STAGE(PG8_SA(1, 0), cA + kstep, voffA); PG8_STAGE(PG8_SB(1, 1), cB + hstepB + kstep, voffB);
    PG8_WAIT_V(6); PG8_BAR;
    for (;;) {
        const bool has_next = S.next(ui + 1, nxt);
        const char* nA = has_next ? nxt.a : cA; const char* nB = has_next ? nxt.b : cB;
        for (int t = 0; t < nt; t += 2) {
            const bool last = (t == nt - 2);
            const char* a1 = cA + (size_t)(t + 1) * kstep;
            const char* a2 = last ? nA : cA + (size_t)(t + 2) * kstep; const char* b2 = last ? nB : cB + (size_t)(t + 2) * kstep;
            const char* a3 = a2 + kstep; const char* b3 = b2 + kstep;
            PG8_LDB(B0, 0, 0); PG8_LDB(B1, 0, 1); PG8_SCHED; PG8_LDA(At, 0, 0); PG8_STAGE(PG8_SA(1, 1), a1 + hstepA, voffA);
            PG8_WAIT_V(8); PG8_WAIT_L(0); PG8_BAR; PG8_MMA(0, 0, At, B0); PG8_MMA(0, 1, At, B1); PG8_BAR; PG8_SCHED;
            PG8_LDA(At, 0, 1); PG8_STAGE(PG8_SB(0, 0), b2, voffB); PG8_STAGE(PG8_SB(0, 1), b2 + hstepB, voffB); PG8_STAGE(PG8_SA(0, 0), a2, voffA);
            PG8_WAIT_V(8); PG8_WAIT_L(0); PG8_BAR; PG8_MMA(1, 0, At, B0); PG8_MMA(1, 1, At, B1); PG8_BAR; PG8_SCHED;
            PG8_LDB(B0, 1, 0); PG8_LDB(B1, 1, 1); PG8_SCHED; PG8_LDA(At, 1, 0); PG8_STAGE(PG8_SA(0, 1), a2 + hstepA, voffA);
            PG8_WAIT_V(8); PG8_WAIT_L(0); PG8_BAR; PG8_MMA(0, 0, At, B0); PG8_MMA(0, 1, At, B1); PG8_BAR; PG8_SCHED;
            PG8_LDA(At, 1, 1); PG8_STAGE(PG8_SB(1, 0), b3, voffB); PG8_STAGE(PG8_SB(1, 1), b3 + hstepB, voffB); PG8_STAGE(PG8_SA(1, 0), a3, voffA);
            PG8_WAIT_V(8); PG8_WAIT_L(0); PG8_BAR; PG8_MMA(1, 0, At, B0); PG8_MMA(1, 1, At, B1); PG8_BAR; PG8_SCHED;
        }
        if (ALIGN) { if (wr == 0) PG8_BAR; }
        E(acc, cur, wr, wc, fr, fq);
        if (!has_next) break;
#pragma unroll
        for (int a = 0; a < 2; ++a)
#pragma unroll
            for (int b = 0; b < 2; ++b)
#pragma unroll
                for (int m = 0; m < 4; ++m)
#pragma unroll
                    for (int n = 0; n < 2; ++n) acc[a][b][m][n] = (f32x4){0.f, 0.f, 0.f, 0.f};
        cur = nxt; cA = nA; cB = nB; ++ui;
        if (ALIGN) { if (wr == 1) PG8_BAR; }
    }
    PG8_WAIT_V(0);
    if (!ALIGN) { if (wr == 0) PG8_BAR; }
    PG8_BAR;
#undef PG8_SA
#undef PG8_SB
#undef PG8_STAGE
#undef PG8_LDA
#undef PG8_LDB
#undef PG8_MMA
#undef PG8_WAIT_V
#undef PG8_WAIT_L
#undef PG8_SCHED
}
}
namespace pg8 {
struct SchedMN {
    const char* A; const char* Bt; int lda, ldb; int nM, nN, nwg, G, c;
    __device__ __forceinline__ void init(const bf16* A_, int lda_, const bf16* Bt_, int ldb_, int Mrows, int Ncols, int G_, int c_) {
        A = (const char*)A_; Bt = (const char*)Bt_; lda = lda_; ldb = ldb_; nM = Mrows / BM; nN = Ncols / BM; nwg = nM * nN; G = G_; c = c_; }
    __device__ __forceinline__ bool next(int i, Unit& u) const {
        const long L = (long)i * G + c; if (L >= nwg) return false;
        int wgid = (int)L; { const int q = nwg / NXCD, r = nwg % NXCD, xcd = wgid % NXCD, off = wgid / NXCD; wgid = (xcd < r ? xcd * (q + 1) : r * (q + 1) + (xcd - r) * q) + off; }
        const int nig = WGM * nN, gid = wgid / nig, fm = gid * WGM, gsz = (nM - fm) < WGM ? (nM - fm) : WGM;
        const int pm = fm + ((wgid % nig) % gsz), pn = (wgid % nig) / gsz;
        u.a = A + (size_t)pm * BM * lda * 2; u.b = Bt + (size_t)pn * BM * ldb * 2; u.orow = pm * BM; u.ocol = pn * BM; u.aux = pn; return true;
    }
};
struct SchedKV {
    const char* memn; const char* wkv; int G, c;
    __device__ __forceinline__ bool next(int i, Unit& u) const {
        const int L = i * G + c; if (L >= 256) return false;
        const int l = L >> 6, r = L & 63; const char* w = wkv + (size_t)l * 4096 * D * 2;
        if (r < 32) { const int pm = r >> 3, pn = r & 7; u.a = memn + (size_t)pm * 256 * D * 2; u.b = w + (size_t)pn * 256 * D * 2; u.orow = pm * 256; u.ocol = pn * 256; u.aux = l * 2; }
        else { const int q = r - 32, pm = q >> 3, pn = q & 7; u.a = memn + (size_t)pm * 256 * D * 2; u.b = w + (size_t)(2048 + pn * 256) * D * 2; u.orow = pm * 256; u.ocol = pn * 256; u.aux = l * 2 + 1; }
        return true;
    }
};
struct SchedS {
    const char* Q; const char* Km; int G, c;
    __device__ __forceinline__ bool next(int i, Unit& u) const {
        const int L = i * G + c; if (L >= 256) return false;
        const int bh = 2 * (L & 7) + ((L >> 3) >> 4), it = (L >> 3) & 15, b = bh >> 2, h = bh & 3;
        u.a = Q + ((size_t)(b * SEQ + it * 256) * D + h * XAD) * 2; u.b = Km + ((size_t)(b * MEMLEN) * D + h * XAD) * 2; u.orow = b * SEQ + it * 256; u.ocol = h * 256; u.aux = 0; return true;
    }
};
struct SchedPV {
    const char* P; const char* Vt; int G, c;
    __device__ __forceinline__ bool next(int i, Unit& u) const {
        const int L = i * G + c; if (L >= 512) return false;
        const int x = L & 7, r = L >> 3;
        const int bh = 2 * x + (r >> 5), q = r & 31, it = q >> 1, nh = q & 1, b = bh >> 2, h = bh & 3;
        u.a = P + ((size_t)(b * SEQ + it * 256) * 1024 + h * 256) * 2; u.b = Vt + ((size_t)(h * XAD + nh * 256) * 1024 + b * MEMLEN) * 2; u.orow = b * SEQ + it * 256; u.ocol = h * XAD + nh * 256; u.aux = 0; return true;
    }
};
struct SchedDt {
    const char* A; const char* Bt; int c;
    __device__ __forceinline__ bool next(int i, Unit& u) const {
        if (i != 0 || c >= 64) return false;
        u.a = A + (size_t)c * 256 * D * 2; u.b = Bt; u.orow = c * 256; u.ocol = 0; u.aux = 0; return true;
    }
};

struct SchedOne {
    Unit u0; int n;
    __device__ __forceinline__ bool next(int i, Unit& u) const { if (i >= n) return false; u = u0; return true; }
};
struct SchedMNB {
    const char* A; const char* Bt; int lda, ldb; int nM, nN, nwg, G, c; size_t bstride;
    __device__ __forceinline__ void init(const bf16* A_, int lda_, const bf16* Bt_, int ldb_, int Mrows, int Ncols, int G_, int c_, size_t bstride_) {
        A = (const char*)A_; Bt = (const char*)Bt_; lda = lda_; ldb = ldb_; nM = Mrows / BM; nN = Ncols / BM; nwg = nM * nN; G = G_; c = c_; bstride = bstride_; }
    __device__ __forceinline__ bool next(int i, Unit& u) const {
        const long L = (long)i * G + c; if (L >= nwg) return false;
        int wgid = (int)L; { const int q = nwg / NXCD, r = nwg % NXCD, xcd = wgid % NXCD, off = wgid / NXCD; wgid = (xcd < r ? xcd * (q + 1) : r * (q + 1) + (xcd - r) * q) + off; }
        const int nig = WGM * nN, gid = wgid / nig, fm = gid * WGM, gsz = (nM - fm) < WGM ? (nM - fm) : WGM;
        const int pm = fm + ((wgid % nig) % gsz), pn = (wgid % nig) / gsz;
        u.a = A + (size_t)pm * BM * lda * 2; u.b = Bt + (size_t)(pm >> 4) * bstride + (size_t)pn * BM * ldb * 2; u.orow = pm * BM; u.ocol = pn * BM; u.aux = pn; return true;
    }
};
struct SchedChainQ {
    const char* A; const char* Bt; int pm, h, n;
    __device__ __forceinline__ bool next(int i, Unit& u) const { if (i >= n) return false; const int pn = 2 * h + i;
        u.a = A + (size_t)pm * 256 * D * 2; u.b = Bt + (size_t)pn * 256 * D * 2; u.orow = pm * 256; u.ocol = pn * 256; u.aux = pn; return true; }
};
struct SchedChainS {
    const char* Q; const char* Km; int pm, h, n;
    __device__ __forceinline__ bool next(int i, Unit& u) const { if (i >= n) return false; const int b = pm >> 4;
        u.a = Q + ((size_t)pm * 256 * D + h * XAD) * 2; u.b = Km + ((size_t)(b * MEMLEN) * D + h * XAD) * 2; u.orow = pm * 256; u.ocol = h * 256; u.aux = 0; return true; }
};
struct SchedChainPV {
    const char* P; const char* Vt; int pm, h, n;
    __device__ __forceinline__ bool next(int i, Unit& u) const { if (i >= n) return false; const int b = pm >> 4;
        u.a = P + ((size_t)pm * 256 * 1024 + h * 256) * 2; u.b = Vt + ((size_t)(h * XAD + i * 256) * 1024 + b * MEMLEN) * 2; u.orow = pm * 256; u.ocol = h * XAD + i * 256; u.aux = 0; return true; }
};

#define EPI_ARGS f32x4 (&acc)[2][2][4][2], const Unit& u, int wr, int wc, int fr, int fq
#define EPI_ROW(ai, m) (u.orow + (ai) * HALF + wr * 64 + (m) * 16 + fr)
#define EPI_COL(bj) (u.ocol + (bj) * HALF + wc * 32 + 8 * fq)
__device__ __forceinline__ float rstd_of(const float* ss, int row) { const f32x4 a = *(const f32x4*)(ss + (size_t)row * 8), b = *(const f32x4*)(ss + (size_t)row * 8 + 4);
    return rsqrtf((((a[0] + a[1]) + (a[2] + a[3])) + ((b[0] + b[1]) + (b[2] + b[3]))) * (1.0f / D) + EPS); }
__device__ __forceinline__ u32x4 pack8(const f32x4 a, const f32x4 b) { u32x4 w; w.x = cvt_pk_bf16(a[0], a[1]); w.y = cvt_pk_bf16(a[2], a[3]); w.z = cvt_pk_bf16(b[0], b[1]); w.w = cvt_pk_bf16(b[2], b[3]); return w; }

struct EpiProjEven {
    const float* ss; bf16* proj; float* logf; const float* lb;
    __device__ __forceinline__ void operator()(EPI_ARGS) const {
        const int range = u.aux >> 2;
#pragma unroll
        for (int ai = 0; ai < 2; ++ai)
#pragma unroll
            for (int m = 0; m < 4; ++m) { const int row = EPI_ROW(ai, m); const float rs = rstd_of(ss, row);
#pragma unroll
                for (int bj = 0; bj < 2; ++bj) { const int col = EPI_COL(bj); f32x4 v0 = acc[ai][bj][m][0] * rs, v1 = acc[ai][bj][m][1] * rs;
                    if (range == 3) { const int c = col - 3072; const f32x4 l0 = *(const f32x4*)(lb + c), l1 = *(const f32x4*)(lb + c + 4);
#pragma unroll
                        for (int j = 0; j < 4; ++j) { v0[j] = __logf(l0[j] + (1.f - l0[j]) * sigm(v0[j])); v1[j] = __logf(l1[j] + (1.f - l1[j]) * sigm(v1[j])); }
                        float* p = logf + (size_t)row * 1024 + c; *(f32x4*)p = v0; *(f32x4*)(p + 4) = v1;
                    } else {
                        if (range == 1) {
#pragma unroll
                            for (int j = 0; j < 4; ++j) { v0[j] = gelu_tanh(v0[j]); v1[j] = gelu_tanh(v1[j]); } }
                        else if (range == 2 || range == 5) {
#pragma unroll
                            for (int j = 0; j < 4; ++j) { v0[j] = siluf(v0[j]); v1[j] = siluf(v1[j]); } }
                        *(u32x4*)(proj + (size_t)row * ABIN + col) = pack8(v0, v1);
                    } } }
    }
};
struct EpiProjOdd {
    const float* ss; bf16* Z; bf16* XBC;
    __device__ __forceinline__ void operator()(EPI_ARGS) const {
        const bool isz = u.ocol < SSDIN;
#pragma unroll
        for (int ai = 0; ai < 2; ++ai)
#pragma unroll
            for (int m = 0; m < 4; ++m) { const int row = EPI_ROW(ai, m); const float rs = rstd_of(ss, row);
#pragma unroll
                for (int bj = 0; bj < 2; ++bj) { const int col = EPI_COL(bj); f32x4 v0 = acc[ai][bj][m][0] * rs, v1 = acc[ai][bj][m][1] * rs;
                    if (isz) {
#pragma unroll
                        for (int j = 0; j < 4; ++j) { v0[j] = siluf(v0[j]); v1[j] = siluf(v1[j]); }
                        *(u32x4*)(Z + (size_t)row * SSDIN + col) = pack8(v0, v1);
                    } else *(u32x4*)(XBC + (size_t)row * SSDCONV + (col - SSDIN)) = pack8(v0, v1); } }
    }
};
struct EpiDt {
    const float* ss; const float* bias; float* DT;
    __device__ __forceinline__ void operator()(EPI_ARGS) const {
        if (wc >= 2) return;
        const int col = wc * 32 + 8 * fq; const f32x4 b0 = *(const f32x4*)(bias + col), b1 = *(const f32x4*)(bias + col + 4);
#pragma unroll
        for (int ai = 0; ai < 2; ++ai)
#pragma unroll
            for (int m = 0; m < 4; ++m) { const int row = EPI_ROW(ai, m); const float rs = rstd_of(ss, row);
                f32x4 v0 = acc[ai][0][m][0] * rs + b0, v1 = acc[ai][0][m][1] * rs + b1;
#pragma unroll
                for (int j = 0; j < 4; ++j) { v0[j] = softplusf(v0[j]); v1[j] = softplusf(v1[j]); }
                float* p = DT + (size_t)row * 64 + col; *(f32x4*)p = v0; *(f32x4*)(p + 4) = v1; }
    }
};
struct EpiResid {
    bf16* xb; float* ssnew; LAS float* tab;
    __device__ __forceinline__ void operator()(EPI_ARGS) const {
#pragma unroll
        for (int ai = 0; ai < 2; ++ai)
#pragma unroll
            for (int m = 0; m < 4; ++m) { const int row = EPI_ROW(ai, m); float sq = 0.f;
#pragma unroll
                for (int bj = 0; bj < 2; ++bj) { bf16* p = xb + (size_t)row * D + EPI_COL(bj); const u32x4 w = *(const u32x4*)p;
                    f32x4 o0 = acc[ai][bj][m][0], o1 = acc[ai][bj][m][1];
                    o0[0] += rs_lo(w.x); o0[1] += rs_hi(w.x); o0[2] += rs_lo(w.y); o0[3] += rs_hi(w.y); o1[0] += rs_lo(w.z); o1[1] += rs_hi(w.z); o1[2] += rs_lo(w.w); o1[3] += rs_hi(w.w);
                    { u32x4 pk; pk.x = rs_pk(o0[0], o0[1]); pk.y = rs_pk(o0[2], o0[3]); pk.z = rs_pk(o1[0], o1[1]); pk.w = rs_pk(o1[2], o1[3]); *(u32x4*)p = pk; }
                    sq += ((o0[0] * o0[0] + o0[1] * o0[1]) + (o0[2] * o0[2] + o0[3] * o0[3])) + ((o1[0] * o1[0] + o1[1] * o1[1]) + (o1[2] * o1[2] + o1[3] * o1[3])); }
                sq += __shfl_xor(sq, 16); sq += __shfl_xor(sq, 32);
                if (fq == 0) tab[(ai * HALF + wr * 64 + m * 16 + fr) * 4 + wc] = sq; }
        LDS_WAIT(); PG8_BAR; asm volatile("" ::: "memory");
        const int lane = fq * 16 + fr, r = (wr * 4 + wc) * 32 + (lane & 31);
        if (lane < 32) { const f32x4 t = *(const LAS f32x4*)(tab + r * 4); ssnew[(size_t)(u.orow + r) * 8 + (u.ocol >> 8)] = (t[0] + t[1]) + (t[2] + t[3]); }
    }
};
struct EpiQ {
    const float* ss; bf16* Q; float scale;
    __device__ __forceinline__ void operator()(EPI_ARGS) const {
#pragma unroll
        for (int ai = 0; ai < 2; ++ai)
#pragma unroll
            for (int m = 0; m < 4; ++m) { const int row = EPI_ROW(ai, m); const float rs = rstd_of(ss, row) * scale;
#pragma unroll
                for (int bj = 0; bj < 2; ++bj) *(u32x4*)(Q + (size_t)row * D + EPI_COL(bj)) = pack8(acc[ai][bj][m][0] * rs, acc[ai][bj][m][1] * rs); }
    }
};
struct EpiPlain {
    bf16* O; int ldc;
    __device__ __forceinline__ void operator()(EPI_ARGS) const {
#pragma unroll
        for (int ai = 0; ai < 2; ++ai)
#pragma unroll
            for (int m = 0; m < 4; ++m) { const int row = EPI_ROW(ai, m);
#pragma unroll
                for (int bj = 0; bj < 2; ++bj) *(u32x4*)(O + (size_t)row * ldc + EPI_COL(bj)) = pack8(acc[ai][bj][m][0], acc[ai][bj][m][1]); }
    }
};
struct EpiKV {
    bf16* Km; bf16* Vt;
    __device__ __forceinline__ void operator()(EPI_ARGS) const {
        const int l = u.aux >> 1; const bool isv = u.aux & 1;
        bf16* O = Km + (size_t)l * MEMROWS * D + (size_t)(isv ? 1 : 0) * (size_t)(Vt - Km); const int ldc = D;
#pragma unroll
        for (int ai = 0; ai < 2; ++ai)
#pragma unroll
            for (int m = 0; m < 4; ++m) { const int row = EPI_ROW(ai, m);
#pragma unroll
                for (int bj = 0; bj < 2; ++bj) *(u32x4*)(O + (size_t)row * ldc + EPI_COL(bj)) = pack8(acc[ai][bj][m][0], acc[ai][bj][m][1]); }
    }
};
struct EpiSoftmax {
    const float* ss; float scale; bf16* P; LAS float* tab;
    __device__ __forceinline__ void operator()(EPI_ARGS) const {
        float mx[2][4];
#pragma unroll
        for (int ai = 0; ai < 2; ++ai)
#pragma unroll
            for (int m = 0; m < 4; ++m) { float v = -3.0e38f; const float rs = rstd_of(ss, EPI_ROW(ai, m)) * scale;
#pragma unroll
                for (int bj = 0; bj < 2; ++bj)
#pragma unroll
                    for (int n = 0; n < 2; ++n) { const f32x4 a = acc[ai][bj][m][n] * rs; acc[ai][bj][m][n] = a; v = fmaxf(v, fmaxf(fmaxf(a[0], a[1]), fmaxf(a[2], a[3]))); }
                v = fmaxf(v, __shfl_xor(v, 16)); v = fmaxf(v, __shfl_xor(v, 32));
                if (fq == 0) tab[(ai * HALF + wr * 64 + m * 16 + fr) * 4 + wc] = v; }
        LDS_WAIT(); PG8_BAR; asm volatile("" ::: "memory");
#pragma unroll
        for (int ai = 0; ai < 2; ++ai)
#pragma unroll
            for (int m = 0; m < 4; ++m) { const int r = ai * HALF + wr * 64 + m * 16 + fr; const f32x4 t = *(const LAS f32x4*)(tab + r * 4);
                const float rm = fmaxf(fmaxf(t[0], t[1]), fmaxf(t[2], t[3])); float s = 0.f;
#pragma unroll
                for (int bj = 0; bj < 2; ++bj)
#pragma unroll
                    for (int n = 0; n < 2; ++n) { f32x4 a = acc[ai][bj][m][n];
#pragma unroll
                        for (int j = 0; j < 4; ++j) { a[j] = __expf(a[j] - rm); s += a[j]; }
                        acc[ai][bj][m][n] = a; }
                s += __shfl_xor(s, 16); s += __shfl_xor(s, 32);
                if (fq == 0) tab[1024 + r * 4 + wc] = s; }
        LDS_WAIT(); PG8_BAR; asm volatile("" ::: "memory");
#pragma unroll
        for (int ai = 0; ai < 2; ++ai)
#pragma unroll
            for (int m = 0; m < 4; ++m) { const int r = ai * HALF + wr * 64 + m * 16 + fr; const f32x4 t = *(const LAS f32x4*)(tab + 1024 + r * 4);
                const float inv = __builtin_amdgcn_rcpf((t[0] + t[1]) + (t[2] + t[3])); const int row = u.orow + r;
#pragma unroll
                for (int bj = 0; bj < 2; ++bj) *(u32x4*)(P + (size_t)row * 1024 + EPI_COL(bj)) = pack8(acc[ai][bj][m][0] * inv, acc[ai][bj][m][1] * inv); }
    }
};
struct EpiGateUp {
    const float* ss; bf16* H;
    __device__ __forceinline__ void operator()(EPI_ARGS) const {
#pragma unroll
        for (int ai = 0; ai < 2; ++ai)
#pragma unroll
            for (int m = 0; m < 4; ++m) { const int row = EPI_ROW(ai, m); const float rs = rstd_of(ss, row);
#pragma unroll
                for (int bj = 0; bj < 2; ++bj) { const int hc = EPI_COL(bj) >> 1; const f32x4 g = acc[ai][bj][m][0] * rs, up = acc[ai][bj][m][1] * rs; f32x4 h;
#pragma unroll
                    for (int j = 0; j < 4; ++j) h[j] = siluf(g[j]) * up[j];
                    u32x2 w; w.x = cvt_pk_bf16(h[0], h[1]); w.y = cvt_pk_bf16(h[2], h[3]); *(u32x2*)(H + (size_t)row * FF + hc) = w; } }
    }
};
#undef EPI_ARGS
}
#define MFMA16(X, Y, ACC) __builtin_amdgcn_mfma_f32_16x16x32_bf16((X), (Y), (ACC), 0, 0, 0)
#define WG_SYNC() do { asm volatile("s_waitcnt vmcnt(0) lgkmcnt(0)" ::: "memory"); __builtin_amdgcn_s_barrier(); asm volatile("" ::: "memory"); } while (0)
#define LDS_SYNC() do { asm volatile("s_waitcnt lgkmcnt(0)" ::: "memory"); __builtin_amdgcn_s_barrier(); asm volatile("" ::: "memory"); } while (0)
constexpr int LP = 136;
constexpr int LP64 = 72;
__device__ __forceinline__ bf16x8 lds_frag(const LAS bf16* base, int row, int pitch, int kofs) { return *(const LAS bf16x8*)(base + row * pitch + kofs); }
__device__ __forceinline__ u32x2 pack4(const f32x4 a) { u32x2 w; w.x = cvt_pk_bf16(a[0], a[1]); w.y = cvt_pk_bf16(a[2], a[3]); return w; }

template <int MAP, bool F16>
__device__ __forceinline__ void conv_item(const float* W, int ldw, int K, int n0, const float* gain, bf16* WT, int row_off, LAS float* scr, int item, int nblk, int lane) {
    const int kb = item / nblk, nb = item % nblk, k0 = 64 * kb, nn0 = 64 * nb;
    const int kr = lane >> 4, n4 = (lane & 15) * 4;
    const float* src = W + (size_t)(k0 + kr) * ldw + n0 + nn0 + n4;
    f32x4 v[16];
#pragma unroll
    for (int i = 0; i < 16; ++i) v[i] = *(const f32x4*)(src + (size_t)(4 * i) * ldw);
#pragma unroll
    for (int i = 0; i < 16; ++i) { f32x4 w = v[i]; if (gain) w = w * gain[k0 + 4 * i + kr];
        LAS float* d = scr + (4 * i + kr) * 65 + n4; d[0] = w[0]; d[1] = w[1]; d[2] = w[2]; d[3] = w[3]; }
    LDS_WAIT(); asm volatile("" ::: "memory");
    const int c = lane & 7, nbase = lane >> 3;
#pragma unroll
    for (int j = 0; j < 8; ++j) { const int n = nbase + 8 * j; const LAS float* s = scr + (8 * c) * 65 + n;
        u32x4 o; if (F16) { o.x = cvt_pk_f16(s[0 * 65], s[1 * 65]); o.y = cvt_pk_f16(s[2 * 65], s[3 * 65]); o.z = cvt_pk_f16(s[4 * 65], s[5 * 65]); o.w = cvt_pk_f16(s[6 * 65], s[7 * 65]); }
        else { o.x = cvt_pk_bf16(s[0 * 65], s[1 * 65]); o.y = cvt_pk_bf16(s[2 * 65], s[3 * 65]); o.z = cvt_pk_bf16(s[4 * 65], s[5 * 65]); o.w = cvt_pk_bf16(s[6 * 65], s[7 * 65]); }
        const int nn = nn0 + n; const int dr = MAP == 0 ? nn : ((nn >> 2) * 8 + (nn & 3) + (MAP == 2 ? 4 : 0));
        *(u32x4*)(WT + (size_t)(row_off + dr) * K + k0 + 8 * c) = o; }
    LDS_WAIT(); asm volatile("" ::: "memory");
}
__device__ __forceinline__ void conv_item_nat(const float* W, int ldw, const float* gain, bf16* WN, int item, int nblk, int lane) {
    const int kb = item / nblk, nb = item % nblk, k0 = 64 * kb, nn0 = 64 * nb;
    const int kr = lane >> 4, n4 = (lane & 15) * 4;
    const float* src = W + (size_t)(k0 + kr) * ldw + nn0 + n4; bf16* dst = WN + (size_t)(k0 + kr) * ldw + nn0 + n4;
    f32x4 v[16];
#pragma unroll
    for (int i = 0; i < 16; ++i) v[i] = *(const f32x4*)(src + (size_t)(4 * i) * ldw);
#pragma unroll
    for (int i = 0; i < 16; ++i) { const f32x4 w = v[i] * gain[k0 + 4 * i + kr]; *(u32x2*)(dst + (size_t)(4 * i) * ldw) = pack4(w); }
}
__device__ __forceinline__ void conv_matrix_nat(const float* W, int ldw, int K, const float* gain, bf16* WN, int gw, int NGW, int lane, int& rot) {
    const int nblk = ldw / 64, nitems = (K / 64) * nblk; int first = gw - rot; if (first < 0) first += NGW;
    for (int it = first; it < nitems; it += NGW) conv_item_nat(W, ldw, gain, WN, it, nblk, lane);
    rot = (rot + nitems) % NGW;
}
template <int MAP, bool F16 = false>
__device__ __forceinline__ void conv_matrix(const float* W, int ldw, int K, int n0, int ncols, const float* gain, bf16* WT, int row_off, LAS float* scr, int gw, int NGW, int lane, int& rot) {
    const int nblk = ncols / 64, nitems = (K / 64) * nblk; int first = gw - rot; if (first < 0) first += NGW;
    for (int it = first; it < nitems; it += NGW) conv_item<MAP, F16>(W, ldw, K, n0, gain, WT, row_off, scr, it, nblk, lane);
    rot = (rot + nitems) % NGW;
}

struct In {
    const float *x, *mem, *norm_mix, *norm_xattn, *norm_ffn, *norm_mem, *norm_final, *ab_w_in, *ab_w_out, *lru_conv_w, *lru_conv_b, *lru_w_r, *lru_b_r, *lru_w_i, *lru_b_i, *lru_lambda,
        *hgrn_lb, *hgrn_norm, *ssd_w_in, *ssd_w_out, *ssd_conv_w, *ssd_conv_b, *ssd_dt_bias, *ssd_a_log, *ssd_d, *ssd_norm, *xa_w_q, *xa_w_kv, *xa_w_o, *ffn_w_gate, *ffn_w_up, *ffn_w_down;
};

typedef const In __attribute__((address_space(4))) CIn;
template <int PARTS = 3>
__device__ __forceinline__ void convert_layer(CIn& I, int l, bf16* WL, LAS float* scr, int gw, int NGW, int lane, int& rot) {
    const int e = l >> 1;
    if ((l & 1) == 0) {
        if (PARTS & 1) conv_matrix<0, RF16>(I.ab_w_in + (size_t)e * D * ABIN, ABIN, D, 0, ABIN, I.norm_mix + l * D, WL + WL_IN, 0, scr, gw, NGW, lane, rot);
        if (PARTS & 2) conv_matrix<0>(I.ab_w_out + (size_t)e * D * D, D, D, 0, D, nullptr, WL + WL_OUT, 0, scr, gw, NGW, lane, rot);
    } else {
        if (PARTS & 1) { conv_matrix<0, RF16>(I.ssd_w_in + (size_t)e * D * SSDPROJ, SSDPROJ, D, 0, SSDN1, I.norm_mix + l * D, WL + WL_IN, 0, scr, gw, NGW, lane, rot);
        conv_matrix<0, RF16>(I.ssd_w_in + (size_t)e * D * SSDPROJ, SSDPROJ, D, SSDN1, 64, I.norm_mix + l * D, WL + WL_DT, 0, scr, gw, NGW, lane, rot);
        for (int i = gw * 64 + lane; i < 192 * D / 8; i += NGW * 64) *(u32x4*)(WL + WL_DT + (size_t)64 * D + (size_t)i * 8) = (u32x4){0u, 0u, 0u, 0u}; }
        if (PARTS & 2) conv_matrix<0>(I.ssd_w_out + (size_t)e * SSDIN * D, D, SSDIN, 0, D, nullptr, WL + WL_OUT, 0, scr, gw, NGW, lane, rot);
    }
    if (!(PARTS & 2)) return;
    conv_matrix_nat(I.xa_w_q + (size_t)l * D * D, D, D, I.norm_xattn + l * D, WL + WL_Q, gw, NGW, lane, rot);
    conv_matrix<0>(I.xa_w_o + (size_t)l * D * D, D, D, 0, D, nullptr, WL + WL_O, 0, scr, gw, NGW, lane, rot);
    conv_matrix<1, RF16>(I.ffn_w_gate + (size_t)l * D * FF, FF, D, 0, FF, I.norm_ffn + l * D, WL + WL_GU, 0, scr, gw, NGW, lane, rot);
    conv_matrix<2, RF16>(I.ffn_w_up + (size_t)l * D * FF, FF, D, 0, FF, I.norm_ffn + l * D, WL + WL_GU, 0, scr, gw, NGW, lane, rot);
    conv_matrix<0>(I.ffn_w_down + (size_t)l * FF * D, D, FF, 0, D, nullptr, WL + WL_DN, 0, scr, gw, NGW, lane, rot);
}

template <bool PASSB>
__device__ __forceinline__ void lru_units(const int tid, LAS unsigned char* lds, int G, int cu, const bf16* PROJ, const bf16* WRT, const float* cw, const float* cb, const float* br, const float* bi,
                                          const float* lam, float* SEG, bf16* YAB) {
    const int wid = __builtin_amdgcn_readfirstlane(tid >> 6), lane = tid & 63, q = lane >> 4, c16 = lane & 15;
    LAS bf16* XA = (LAS bf16*)(lds);
    LAS bf16* XC = (LAS bf16*)(lds + 35840);
    LAS bf16* WR = (LAS bf16*)(lds + 70656);
    LAS bf16* WI = (LAS bf16*)(lds + 105472);
    LAS float* PAR = (LAS float*)(lds + 140288);
    LAS float* WT = (LAS float*)(lds + 144384);
    LAS float* HIN = (LAS float*)(lds + 152576);
    int loadedj = -1;
    for (int u = cu; u < 1024; u += G) {
        const int j = u & 7, rest = u >> 3, b = rest >> 5, seg = rest & 31; const int t0 = b * SEQ + seg * 128;
        if (j != loadedj) {
            loadedj = j;
            for (int p = tid; p < 2 * 2048; p += NTHR) { const int g = p >> 11, pp = p & 2047, r = pp >> 4, pc = pp & 15;
                const u32x4 v = *(const u32x4*)(WRT + ((size_t)(g * 8 + j) * 128 + r) * 128 + pc * 8);
                *(LAS u32x4*)((g ? WI : WR) + r * LP + pc * 8) = v; }
            if (tid < 128) { const int ch = j * 128 + tid;
                PAR[0 * 128 + tid] = 8.0f * softplusf(-lam[ch]); PAR[1 * 128 + tid] = br[ch]; PAR[2 * 128 + tid] = bi[ch]; PAR[3 * 128 + tid] = cb[ch];
#pragma unroll
                for (int k = 0; k < 4; ++k) PAR[(4 + k) * 128 + tid] = cw[k * LRUW + ch]; }
        }
        for (int p = tid; p < 131 * 16; p += NTHR) { const int r = p >> 4, pc = p & 15; u32x4 v = (u32x4){0u, 0u, 0u, 0u};
            if (seg > 0 || r >= 3) v = *(const u32x4*)(PROJ + (size_t)(t0 + r - 3) * ABIN + j * 128 + pc * 8);
            *(LAS u32x4*)(XA + r * LP + pc * 8) = v; }
        if (PASSB) { if (tid < 128) { float h = 0.f; const float* sg = SEG + ((size_t)(b * 8 + j) * 32) * 256 + tid * 2;
                for (int s = 0; s < seg; ++s) { const f32x2 ab = *(const f32x2*)(sg + (size_t)s * 256); h = ab.x * h + ab.y; }
                HIN[tid] = h; } }
        WG_SYNC();
        {
            const int ch8 = tid & 15, tr = tid >> 4; u32x4 rows[7];
#pragma unroll
            for (int i = 0; i < 7; ++i) rows[i] = *(const LAS u32x4*)(XA + (4 * tr + i) * LP + ch8 * 8);
            float w[4][8], bb[8];
#pragma unroll
            for (int e = 0; e < 8; ++e) { bb[e] = PAR[3 * 128 + ch8 * 8 + e];
#pragma unroll
                for (int k = 0; k < 4; ++k) w[k][e] = PAR[(4 + k) * 128 + ch8 * 8 + e]; }
#pragma unroll
            for (int i = 0; i < 4; ++i) { float o[8];
#pragma unroll
                for (int e = 0; e < 8; ++e) { float a = bb[e];
#pragma unroll
                    for (int k = 0; k < 4; ++k) { const unsigned wd = rows[i + k][e >> 1]; a += w[k][e] * ((e & 1) ? bfhi(wd) : bflo(wd)); }
                    o[e] = a; }
                u32x4 pk; pk.x = cvt_pk_bf16(o[0], o[1]); pk.y = cvt_pk_bf16(o[2], o[3]); pk.z = cvt_pk_bf16(o[4], o[5]); pk.w = cvt_pk_bf16(o[6], o[7]);
                *(LAS u32x4*)(XC + (4 * tr + i) * LP + ch8 * 8) = pk; }
        }
        WG_SYNC();
        float PP[8][4], HH[8][4];
        {
            bf16x8 xf[4];
#pragma unroll
            for (int ks = 0; ks < 4; ++ks) xf[ks] = lds_frag(XC, 16 * wid + c16, LP, 32 * ks + 8 * q);
#pragma unroll
            for (int jb = 0; jb < 8; ++jb) {
                f32x4 aR = (f32x4){0.f, 0.f, 0.f, 0.f}, aI = aR;
#pragma unroll
                for (int ks = 0; ks < 4; ++ks) { aR = MFMA16(xf[ks], lds_frag(WR, 16 * jb + c16, LP, 32 * ks + 8 * q), aR); aI = MFMA16(xf[ks], lds_frag(WI, 16 * jb + c16, LP, 32 * ks + 8 * q), aI); }
                const int ch = 16 * jb + c16;
                const float sp8 = PAR[ch], pbr = PAR[128 + ch], pbi = PAR[256 + ch], pcb = PAR[384 + ch], w0 = PAR[512 + ch], w1 = PAR[640 + ch], w2 = PAR[768 + ch], w3 = PAR[896 + ch];
                float xr[7];
#pragma unroll
                for (int i = 0; i < 7; ++i) xr[i] = bf2f(XA[(16 * wid + 4 * q + i) * LP + ch]);
                float a[4], bt[4];
#pragma unroll
                for (int r = 0; r < 4; ++r) { const float xc = pcb + w0 * xr[r] + w1 * xr[r + 1] + w2 * xr[r + 2] + w3 * xr[r + 3];
                    const float rg = sigm(aR[r] + pbr), ig = sigm(aI[r] + pbi); const float la = -sp8 * rg;
                    const float av = __expf(la), x2 = 2.0f * la; a[r] = av;
                    const float om = (x2 > -0.02f) ? -x2 * (1.0f + x2 * (0.5f + x2 * 0.16666667f)) : 1.0f - av * av;
                    bt[r] = __builtin_amdgcn_sqrtf(fmaxf(om, 0.f)) * ig * xc; }
                float P[4], H[4]; P[0] = a[0]; H[0] = bt[0];
#pragma unroll
                for (int r = 1; r < 4; ++r) { P[r] = a[r] * P[r - 1]; H[r] = a[r] * H[r - 1] + bt[r]; }
                float Ae = 1.f, Be = 0.f, Aw = 1.f, Bw = 0.f;
#pragma unroll
                for (int qq = 0; qq < 4; ++qq) { const float Aq = __shfl(P[3], c16 + 16 * qq), Bq = __shfl(H[3], c16 + 16 * qq);
                    if (qq < q) { Be = Aq * Be + Bq; Ae = Aq * Ae; }
                    Bw = Aq * Bw + Bq; Aw = Aq * Aw; }
#pragma unroll
                for (int r = 0; r < 4; ++r) { PP[jb][r] = P[r] * Ae; HH[jb][r] = P[r] * Be + H[r]; }
                if (q == 0) *(LAS f32x2*)(WT + (wid * 128 + ch) * 2) = (f32x2){Aw, Bw};
            }
        }
        WG_SYNC();
        if (!PASSB) {
            if (tid < 128) { float A = 1.f, B = 0.f;
#pragma unroll
                for (int w = 0; w < 8; ++w) { const f32x2 ab = *(const LAS f32x2*)(WT + (w * 128 + tid) * 2); B = ab.x * B + ab.y; A = ab.x * A; }
                *(f32x2*)(SEG + ((size_t)(b * 8 + j) * 32 + seg) * 256 + tid * 2) = (f32x2){A, B}; }
        } else {
#pragma unroll
            for (int jb = 0; jb < 8; ++jb) { const int ch = 16 * jb + c16; float h0 = HIN[ch];
                for (int w = 0; w < wid; ++w) { const f32x2 ab = *(const LAS f32x2*)(WT + (w * 128 + ch) * 2); h0 = ab.x * h0 + ab.y; }
#pragma unroll
                for (int r = 0; r < 4; ++r) { const int t = t0 + 16 * wid + 4 * q + r; const float h = PP[jb][r] * h0 + HH[jb][r];
                    const float ga = bf2f(PROJ[(size_t)t * ABIN + 1024 + j * 128 + ch]);
                    YAB[(size_t)t * D + j * 128 + ch] = (bf16)f2bf(ga * h); } }
        }
        WG_SYNC();
    }
}

__device__ __forceinline__ void hgrn1_load(float (&lf)[16], unsigned (&vv)[16], const float* LOGF, const bf16* PROJ, int u, int k, int qt) {
    const int bh = u >> 6, c = u & 63, b = bh >> 3, h = bh & 7; const int t0 = b * SEQ + c * 64 + 16 * qt;
#pragma unroll
    for (int i = 0; i < 16; ++i) { lf[i] = LOGF[(size_t)(t0 + i) * 1024 + h * 128 + k]; vv[i] = PROJ[(size_t)(t0 + i) * ABIN + 4096 + h * 128 + k]; }
}
__device__ __forceinline__ void hgrn1_units(const int tid, LAS unsigned char* lds, int G, int cu, const float* LOGF, const bf16* PROJ, bf16* HST, float* HDEC) {
    const int wid = __builtin_amdgcn_readfirstlane(tid >> 6), lane = tid & 63, q = lane >> 4, c16 = lane & 15;
    LAS bf16* KT = (LAS bf16*)(lds);
    LAS bf16* VT = (LAS bf16*)(lds + 18432);
    LAS float* TOT = (LAS float*)(lds + 36864);
    const int k = tid & 127, qt = tid >> 7;
    float lf[16], nlf[16]; unsigned vv[16], nvv[16];
    if (cu < 2048) hgrn1_load(lf, vv, LOGF, PROJ, cu, k, qt);
    for (int u = cu; u < 2048; u += G) {
        if (u + G < 2048) hgrn1_load(nlf, nvv, LOGF, PROJ, u + G, k, qt);
        float cs[16];
        cs[0] = lf[0];
#pragma unroll
        for (int i = 1; i < 16; ++i) cs[i] = cs[i - 1] + lf[i];
        TOT[qt * 128 + k] = cs[15];
        LDS_SYNC();
        float pre = 0.f, last = 0.f;
#pragma unroll
        for (int qq = 0; qq < 4; ++qq) { const float t = TOT[qq * 128 + k]; if (qq < qt) pre += t; last += t; }
        unsigned kw[8], vw[8];
#pragma unroll
        for (int i = 0; i < 8; ++i) { const float k0 = (1.f - __expf(lf[2 * i])) * __expf(last - (pre + cs[2 * i])), k1 = (1.f - __expf(lf[2 * i + 1])) * __expf(last - (pre + cs[2 * i + 1]));
            kw[i] = cvt_pk_bf16(k0, k1); vw[i] = vv[2 * i] | (vv[2 * i + 1] << 16); }
        *(LAS u32x4*)(KT + k * LP64 + 16 * qt) = (u32x4){kw[0], kw[1], kw[2], kw[3]}; *(LAS u32x4*)(KT + k * LP64 + 16 * qt + 8) = (u32x4){kw[4], kw[5], kw[6], kw[7]};
        *(LAS u32x4*)(VT + k * LP64 + 16 * qt) = (u32x4){vw[0], vw[1], vw[2], vw[3]}; *(LAS u32x4*)(VT + k * LP64 + 16 * qt + 8) = (u32x4){vw[4], vw[5], vw[6], vw[7]};
        if (qt == 0) HDEC[(size_t)u * 128 + k] = __expf(last);
        LDS_SYNC();
        bf16x8 kf[2];
#pragma unroll
        for (int ks = 0; ks < 2; ++ks) kf[ks] = lds_frag(KT, 16 * wid + c16, LP64, 32 * ks + 8 * q);
#pragma unroll
        for (int vb = 0; vb < 8; ++vb) { f32x4 acc = (f32x4){0.f, 0.f, 0.f, 0.f};
#pragma unroll
            for (int ks = 0; ks < 2; ++ks) acc = MFMA16(kf[ks], lds_frag(VT, 16 * vb + c16, LP64, 32 * ks + 8 * q), acc);
            *(u32x2*)(HST + ((size_t)u * 128 + 16 * vb + c16) * 128 + 16 * wid + 4 * q) = pack4(acc); }
        LDS_SYNC();
#pragma unroll
        for (int i = 0; i < 16; ++i) { lf[i] = nlf[i]; vv[i] = nvv[i]; }
    }
    WG_SYNC();
}
__device__ __forceinline__ void hgrn2_scan(const int tid, int G, int cu, bf16* HST, const float* HDEC) {
    for (int task = cu * NTHR + tid; task < 32 * 4096; task += G * NTHR) {
        const int bh = task >> 12, e = (task & 4095) * 4; f32x4 S = (f32x4){0.f, 0.f, 0.f, 0.f};
        bf16* p0 = HST + (size_t)bh * 64 * 16384 + e; const float* d0 = HDEC + (size_t)bh * 64 * 128 + (e & 127);
#pragma unroll 1
        for (int cb = 0; cb < 64; cb += 16) { u32x2 L[16]; f32x4 d[16];
#pragma unroll
            for (int c = 0; c < 16; ++c) { L[c] = *(const u32x2*)(p0 + (size_t)(cb + c) * 16384); d[c] = *(const f32x4*)(d0 + (size_t)(cb + c) * 128); }
#pragma unroll
            for (int c = 0; c < 16; ++c) { *(u32x2*)(p0 + (size_t)(cb + c) * 16384) = pack4(S);
                S[0] = d[c][0] * S[0] + bflo(L[c].x); S[1] = d[c][1] * S[1] + bfhi(L[c].x); S[2] = d[c][2] * S[2] + bflo(L[c].y); S[3] = d[c][3] * S[3] + bfhi(L[c].y); } }
    }
}
__device__ __forceinline__ void hgrn3_load(float (&lf)[16], unsigned (&qv)[16], unsigned (&vv)[16], u32x4 (&st)[4], const float* LOGF, const bf16* PROJ, const bf16* HST, int u, int k, int qt, int tid) {
    const int bh = u >> 6, c = u & 63, b = bh >> 3, h = bh & 7; const int t0 = b * SEQ + c * 64 + 16 * qt;
#pragma unroll
    for (int i = 0; i < 16; ++i) { lf[i] = LOGF[(size_t)(t0 + i) * 1024 + h * 128 + k]; const bf16* pr = PROJ + (size_t)(t0 + i) * ABIN + h * 128 + k; qv[i] = pr[2048]; vv[i] = pr[4096]; }
#pragma unroll
    for (int i = 0; i < 4; ++i) { const int p = tid + NTHR * i, r = p >> 4, pc = p & 15; st[i] = *(const u32x4*)(HST + (size_t)u * 16384 + r * 128 + pc * 8); }
}
__device__ __forceinline__ void hgrn3_units(const int tid, LAS unsigned char* lds, int G, int cu, const float* LOGF, const bf16* PROJ, const bf16* HST, const float* hnorm, bf16* YAB) {
    const int wid = __builtin_amdgcn_readfirstlane(tid >> 6), lane = tid & 63, q = lane >> 4, c16 = lane & 15;
    LAS bf16* QH = (LAS bf16*)(lds);
    LAS bf16* QT = (LAS bf16*)(lds + 17408);
    LAS bf16* KH = (LAS bf16*)(lds + 34816);
    LAS bf16* VT = (LAS bf16*)(lds + 52224);
    LAS bf16* STL = (LAS bf16*)(lds + 70656);
    LAS bf16* PM = (LAS bf16*)(lds + 105472);
    LAS float* TOT = (LAS float*)(lds + 114688);
    LAS float* SQ = (LAS float*)(lds + 116736);
    const int k = tid & 127, qt = tid >> 7;
    float lf[16], nlf[16]; unsigned qv[16], nqv[16], vv[16], nvv[16]; u32x4 st[4], nst[4];
    if (cu < 2048) hgrn3_load(lf, qv, vv, st, LOGF, PROJ, HST, cu, k, qt, tid);
    for (int u = cu; u < 2048; u += G) {
        const int bh = u >> 6, c = u & 63, b = bh >> 3, h = bh & 7; const int tc = b * SEQ + c * 64;
        float cs[16];
        cs[0] = lf[0];
#pragma unroll
        for (int i = 1; i < 16; ++i) cs[i] = cs[i - 1] + lf[i];
        TOT[qt * 128 + k] = cs[15];
#pragma unroll
        for (int i = 0; i < 4; ++i) { const int p = tid + NTHR * i, r = p >> 4, pc = p & 15; *(LAS u32x4*)(STL + r * LP + pc * 8) = st[i]; }
        if (u + G < 2048) hgrn3_load(nlf, nqv, nvv, nst, LOGF, PROJ, HST, u + G, k, qt, tid);
        LDS_SYNC();
        float pre = 0.f;
#pragma unroll
        for (int qq = 0; qq < 4; ++qq) { const float t = TOT[qq * 128 + k]; if (qq < qt) pre += t; }
        const float ref = TOT[k] + TOT[128 + k];
        unsigned vw[8];
#pragma unroll
        for (int i = 0; i < 16; ++i) { const float cum = pre + cs[i], kk = 1.f - __expf(lf[i]), qf = bf2f((bf16)qv[i]);
            QT[(16 * qt + i) * LP + k] = (bf16)f2bf(qf * __expf(cum));
            QH[(16 * qt + i) * LP + k] = (bf16)f2bf(qf * __expf(fminf(cum - ref, 80.f)));
            KH[(16 * qt + i) * LP + k] = (bf16)f2bf(kk * __expf(fminf(ref - cum, 80.f))); }
#pragma unroll
        for (int i = 0; i < 8; ++i) vw[i] = vv[2 * i] | (vv[2 * i + 1] << 16);
        *(LAS u32x4*)(VT + k * LP64 + 16 * qt) = (u32x4){vw[0], vw[1], vw[2], vw[3]}; *(LAS u32x4*)(VT + k * LP64 + 16 * qt + 8) = (u32x4){vw[4], vw[5], vw[6], vw[7]};
        LDS_SYNC();
        {
            const int tb = wid & 3;
            bf16x8 qf[4];
#pragma unroll
            for (int ks = 0; ks < 4; ++ks) qf[ks] = lds_frag(QH, 16 * tb + c16, LP, 32 * ks + 8 * q);
#pragma unroll
            for (int sbi = 0; sbi < 2; ++sbi) { const int sb = 2 * (wid >> 2) + sbi; f32x4 acc = (f32x4){0.f, 0.f, 0.f, 0.f};
#pragma unroll
                for (int ks = 0; ks < 4; ++ks) acc = MFMA16(lds_frag(KH, 16 * sb + c16, LP, 32 * ks + 8 * q), qf[ks], acc);
                const int t = 16 * tb + c16, s0 = 16 * sb + 4 * q;
#pragma unroll
                for (int r = 0; r < 4; ++r) acc[r] = (s0 + r <= t) ? acc[r] : 0.f;
                *(LAS u32x2*)(PM + t * LP64 + s0) = pack4(acc); }
        }
        LDS_SYNC();
        {
            const int tb = wid & 3, vh = wid >> 2, t = 16 * tb + c16;
            bf16x8 qf[4], pf[2];
#pragma unroll
            for (int ks = 0; ks < 4; ++ks) qf[ks] = lds_frag(QT, t, LP, 32 * ks + 8 * q);
#pragma unroll
            for (int ks = 0; ks < 2; ++ks) pf[ks] = lds_frag(PM, t, LP64, 32 * ks + 8 * q);
            f32x4 acc[4]; float sq = 0.f;
#pragma unroll
            for (int vb = 0; vb < 4; ++vb) { const int vr = 64 * vh + 16 * vb + c16; acc[vb] = (f32x4){0.f, 0.f, 0.f, 0.f};
#pragma unroll
                for (int ks = 0; ks < 4; ++ks) acc[vb] = MFMA16(lds_frag(STL, vr, LP, 32 * ks + 8 * q), qf[ks], acc[vb]);
#pragma unroll
                for (int ks = 0; ks < 2; ++ks) acc[vb] = MFMA16(lds_frag(VT, vr, LP64, 32 * ks + 8 * q), pf[ks], acc[vb]);
                sq += (acc[vb][0] * acc[vb][0] + acc[vb][1] * acc[vb][1]) + (acc[vb][2] * acc[vb][2] + acc[vb][3] * acc[vb][3]); }
            sq += __shfl_xor(sq, 16); sq += __shfl_xor(sq, 32);
            if (q == 0) SQ[vh * 64 + t] = sq;
            LDS_SYNC();
            const float rstd = rsqrtf((SQ[t] + SQ[64 + t]) * (1.0f / 128.f) + EPS);
#pragma unroll
            for (int vb = 0; vb < 4; ++vb) { const int v0 = 64 * vh + 16 * vb + 4 * q; const f32x4 hn = *(const f32x4*)(hnorm + h * 128 + v0);
                const u32x2 gw = *(const u32x2*)(PROJ + (size_t)(tc + t) * ABIN + 5120 + h * 128 + v0);
                f32x4 y; y[0] = acc[vb][0] * rstd * hn[0] * bflo(gw.x); y[1] = acc[vb][1] * rstd * hn[1] * bfhi(gw.x); y[2] = acc[vb][2] * rstd * hn[2] * bflo(gw.y); y[3] = acc[vb][3] * rstd * hn[3] * bfhi(gw.y);
                *(u32x2*)(YAB + (size_t)(tc + t) * D + 1024 + h * 128 + v0) = pack4(y); }
        }
        LDS_SYNC();
#pragma unroll
        for (int i = 0; i < 16; ++i) { lf[i] = nlf[i]; qv[i] = nqv[i]; vv[i] = nvv[i]; }
#pragma unroll
        for (int i = 0; i < 4; ++i) st[i] = nst[i];
    }
    WG_SYNC();
}
__device__ __forceinline__ void ssd_prep_load(u32x4 (&rows)[7], const bf16* XBC, int u, int ch8, int tr) {
    const int bc = u / 48, cblk = u % 48, c = bc & 31; const bf16* src = XBC + (size_t)(bc * 128 + 4 * tr - 3) * SSDCONV + cblk * 128 + ch8 * 8;
#pragma unroll
    for (int i = 0; i < 7; ++i) { rows[i] = (u32x4){0u, 0u, 0u, 0u}; if (c > 0 || 4 * tr + i >= 3) rows[i] = *(const u32x4*)(src + (size_t)i * SSDCONV); }
}
__device__ __forceinline__ void ssd_prep_units(const int tid, LAS unsigned char* lds, int ufirst, int ustride, int uend, const bf16* XBC, const float* cw, const float* cb, bf16* XBT, bf16* BCN) {
    LAS bf16* T = (LAS bf16*)(lds);
    const int ch8 = tid & 15, tr = tid >> 4;
    u32x4 rows[7], nrows[7];
    if (ufirst < uend) ssd_prep_load(rows, XBC, ufirst, ch8, tr);
    for (int u = ufirst; u < uend; u += ustride) {
        const int bc = u / 48, cblk = u % 48; const int t0 = bc * 128; const int ch0 = cblk * 128 + ch8 * 8;
        if (u + ustride < uend) ssd_prep_load(nrows, XBC, u + ustride, ch8, tr);
        float w[4][8], bb[8];
        { const f32x4 b0 = *(const f32x4*)(cb + ch0), b1 = *(const f32x4*)(cb + ch0 + 4);
#pragma unroll
          for (int e = 0; e < 4; ++e) { bb[e] = b0[e]; bb[4 + e] = b1[e]; }
#pragma unroll
          for (int k = 0; k < 4; ++k) { const f32x4 w0 = *(const f32x4*)(cw + (size_t)k * SSDCONV + ch0), w1 = *(const f32x4*)(cw + (size_t)k * SSDCONV + ch0 + 4);
#pragma unroll
              for (int e = 0; e < 4; ++e) { w[k][e] = w0[e]; w[k][4 + e] = w1[e]; } } }
        u32x4 ov[4];
#pragma unroll
        for (int i = 0; i < 4; ++i) { float o[8];
#pragma unroll
            for (int e = 0; e < 8; ++e) { float a = bb[e];
#pragma unroll
                for (int k = 0; k < 4; ++k) { const unsigned wd = rows[i + k][e >> 1]; a += w[k][e] * ((e & 1) ? bfhi(wd) : bflo(wd)); }
                o[e] = siluf(a); }
            u32x4 pk; pk.x = cvt_pk_bf16(o[0], o[1]); pk.y = cvt_pk_bf16(o[2], o[3]); pk.z = cvt_pk_bf16(o[4], o[5]); pk.w = cvt_pk_bf16(o[6], o[7]);
            if (cblk >= 32) *(u32x4*)(BCN + (size_t)(t0 + 4 * tr + i) * 2048 + (ch0 - 4096)) = pk;
            ov[i] = pk; }
        if (cblk < 40) {
#pragma unroll
            for (int e = 0; e < 8; ++e) { u32x2 w;
                const unsigned a0 = ov[0][e >> 1], a1 = ov[1][e >> 1], a2 = ov[2][e >> 1], a3 = ov[3][e >> 1];
                if (e & 1) { w.x = (a0 >> 16) | (a1 & 0xffff0000u); w.y = (a2 >> 16) | (a3 & 0xffff0000u); } else { w.x = (a0 & 0xffffu) | (a1 << 16); w.y = (a2 & 0xffffu) | (a3 << 16); }
                *(LAS u32x2*)(T + (ch8 * 8 + e) * LP + 8 * ((tr >> 1) ^ ch8) + 4 * (tr & 1)) = w; }
            LDS_SYNC();
#pragma unroll
            for (int i = 0; i < 4; ++i) { const int p = tid + NTHR * i, r = p >> 4, pc = p & 15;
                *(u32x4*)(XBT + ((size_t)bc * 5120 + cblk * 128 + r) * 128 + pc * 8) = *(const LAS u32x4*)(T + r * LP + 8 * (pc ^ (r >> 3))); }
            LDS_SYNC();
        }
#pragma unroll
        for (int i = 0; i < 7; ++i) rows[i] = nrows[i];
    }
    WG_SYNC();
}
__device__ __forceinline__ float ssd_tables(const float* DT, const float* a_log, int t0, int hd, int wid, int lane, LAS float* CUM, LAS float* DTS) {
    const float an = -__expf(a_log[hd]);
    const float d0 = DT[(size_t)(t0 + 2 * lane) * 64 + hd], d1 = DT[(size_t)(t0 + 2 * lane + 1) * 64 + hd];
    const float a0 = d0 * an, a1 = d1 * an; float v = a0 + a1;
#pragma unroll
    for (int o = 1; o < 64; o <<= 1) { const float t = __shfl_up(v, o); if (lane >= o) v += t; }
    CUM[wid * 128 + 2 * lane] = v - a1; CUM[wid * 128 + 2 * lane + 1] = v; DTS[wid * 128 + 2 * lane] = d0; DTS[wid * 128 + 2 * lane + 1] = d1;
    return __shfl(v, 63);
}
__device__ __forceinline__ void ssd1_units(const int tid, LAS unsigned char* lds, int G, int cu, const bf16* XBT, const float* DT, const float* a_log, bf16* ST, float* DEC) {
    const int wid = __builtin_amdgcn_readfirstlane(tid >> 6), lane = tid & 63, q = lane >> 4, c16 = lane & 15;
    LAS bf16* BT = (LAS bf16*)(lds);
    LAS float* CUM = (LAS float*)(lds + 34816);
    LAS float* DTS = (LAS float*)(lds + 38912);
    for (int u = cu; u < 1024; u += G) {
        const int bc = u >> 3, g = u & 7, t0 = bc * 128, hd = g * 8 + wid;
#pragma unroll
        for (int i = 0; i < 4; ++i) { const int p = tid + NTHR * i, r = p >> 4, pc = p & 15;
            *(LAS u32x4*)(BT + r * LP + pc * 8) = *(const u32x4*)(XBT + ((size_t)bc * 5120 + 4096 + g * 128 + r) * 128 + pc * 8); }
        const float last = ssd_tables(DT, a_log, t0, hd, wid, lane, CUM, DTS);
        if (lane == 0) DEC[bc * 64 + hd] = __expf(last);
        u32x4 xr[4][4];
#pragma unroll
        for (int pb = 0; pb < 4; ++pb)
#pragma unroll
            for (int ks = 0; ks < 4; ++ks) xr[pb][ks] = *(const u32x4*)(XBT + ((size_t)bc * 5120 + hd * 64 + 16 * pb + c16) * 128 + 32 * ks + 8 * q);
        WG_SYNC();
        bf16x8 xf[4][4];
#pragma unroll
        for (int ks = 0; ks < 4; ++ks) { float sc[8];
#pragma unroll
            for (int j = 0; j < 8; ++j) { const int s = 32 * ks + 8 * q + j; sc[j] = DTS[wid * 128 + s] * __expf(last - CUM[wid * 128 + s]); }
#pragma unroll
            for (int pb = 0; pb < 4; ++pb) { u32x4 o;
#pragma unroll
                for (int e = 0; e < 4; ++e) o[e] = cvt_pk_bf16(bflo(xr[pb][ks][e]) * sc[2 * e], bfhi(xr[pb][ks][e]) * sc[2 * e + 1]);
                xf[pb][ks] = __builtin_bit_cast(bf16x8, o); } }
#pragma unroll
        for (int nb = 0; nb < 8; ++nb) { bf16x8 bf[4];
#pragma unroll
            for (int ks = 0; ks < 4; ++ks) bf[ks] = lds_frag(BT, 16 * nb + c16, LP, 32 * ks + 8 * q);
#pragma unroll
            for (int pb = 0; pb < 4; ++pb) { f32x4 acc = (f32x4){0.f, 0.f, 0.f, 0.f};
#pragma unroll
                for (int ks = 0; ks < 4; ++ks) acc = MFMA16(bf[ks], xf[pb][ks], acc);
                *(u32x2*)(ST + (((size_t)bc * 64 + hd) * 64 + 16 * pb + c16) * 128 + 16 * nb + 4 * q) = pack4(acc); } }
        WG_SYNC();
    }
}
__device__ __forceinline__ void ssd2_scan(const int tid, int G, int cu, bf16* ST, const float* DEC) {
    for (int task = cu * NTHR + tid; task < NB * 4096 * 32; task += G * NTHR) {
        const int b = task >> 17, r = task & 131071, hp = r >> 5, n4 = (r & 31) * 4, hd = hp >> 6; f32x4 S = (f32x4){0.f, 0.f, 0.f, 0.f};
        bf16* p0 = ST + ((size_t)(b * 32) * 4096 + hp) * 128 + n4; const float* d0 = DEC + (b * 32) * 64 + hd;
        u32x2 L[32]; float d[32];
#pragma unroll
        for (int c = 0; c < 32; ++c) { L[c] = *(const u32x2*)(p0 + (size_t)c * 4096 * 128); d[c] = d0[c * 64]; }
#pragma unroll
        for (int c = 0; c < 32; ++c) { *(u32x2*)(p0 + (size_t)c * 4096 * 128) = pack4(S);
            S[0] = d[c] * S[0] + bflo(L[c].x); S[1] = d[c] * S[1] + bfhi(L[c].x); S[2] = d[c] * S[2] + bflo(L[c].y); S[3] = d[c] * S[3] + bfhi(L[c].y); }
    }
}
__device__ __forceinline__ void ssd3_units(const int tid, LAS unsigned char* lds, int G, int cu, const bf16* XBT, const bf16* BCN, const bf16* ST, const float* DT, const float* a_log, const float* dskip,
                                           const bf16* Z, const float* normw, bf16* Y) {
    const int wid = __builtin_amdgcn_readfirstlane(tid >> 6), lane = tid & 63, q = lane >> 4, c16 = lane & 15;
    LAS bf16* CN = (LAS bf16*)(lds);
    LAS bf16* BN = (LAS bf16*)(lds + 34816);
    LAS bf16* CB = (LAS bf16*)(lds + 69632);
    LAS float* CUM = (LAS float*)(lds + 104448);
    LAS float* DTS = (LAS float*)(lds + 108544);
    LAS float* SQP = (LAS float*)(lds + 112640);
    for (int u = cu; u < 1024; u += G) {
        const int bc = u >> 3, g = u & 7, t0 = bc * 128, hd = g * 8 + wid;
#pragma unroll
        for (int i = 0; i < 4; ++i) { const int p = tid + NTHR * i, r = p >> 4, pc = p & 15; const bf16* src = BCN + (size_t)(t0 + r) * 2048 + g * 128 + pc * 8;
            *(LAS u32x4*)(BN + r * LP + pc * 8) = *(const u32x4*)src; *(LAS u32x4*)(CN + r * LP + pc * 8) = *(const u32x4*)(src + 1024); }
        (void)ssd_tables(DT, a_log, t0, hd, wid, lane, CUM, DTS);
        bf16x8 sf[4][4];
        const bf16* xb = XBT + ((size_t)bc * 5120 + hd * 64 + c16) * 128 + 8 * q;
        { const bf16* sb = ST + (((size_t)bc * 64 + hd) * 64 + c16) * 128 + 8 * q;
#pragma unroll
          for (int pb = 0; pb < 4; ++pb)
#pragma unroll
              for (int ks = 0; ks < 4; ++ks) sf[pb][ks] = *(const bf16x8*)(sb + (size_t)(16 * pb) * 128 + 32 * ks); }
        WG_SYNC();
        {
            bf16x8 cf[4];
#pragma unroll
            for (int ks = 0; ks < 4; ++ks) cf[ks] = lds_frag(CN, 16 * wid + c16, LP, 32 * ks + 8 * q);
#pragma unroll
            for (int sb = 0; sb < 8; ++sb) { if (sb > wid + 1) continue; f32x4 acc = (f32x4){0.f, 0.f, 0.f, 0.f};
#pragma unroll
                for (int ks = 0; ks < 4; ++ks) acc = MFMA16(lds_frag(BN, 16 * sb + c16, LP, 32 * ks + 8 * q), cf[ks], acc);
                *(LAS u32x2*)(CB + (16 * wid + c16) * LP + 16 * sb + 4 * q) = pack4(acc); }
        }
        WG_SYNC();
        const float dsk = dskip[hd];
        bf16* ybase = Y + (size_t)t0 * SSDIN + hd * 64 + 4 * q; const bf16* zbase = Z + (size_t)t0 * SSDIN + hd * 64 + 4 * q;
        const f32x4 nw0 = *(const f32x4*)(normw + hd * 64 + 4 * q), nw1 = *(const f32x4*)(normw + hd * 64 + 16 + 4 * q), nw2 = *(const f32x4*)(normw + hd * 64 + 32 + 4 * q), nw3 = *(const f32x4*)(normw + hd * 64 + 48 + 4 * q);
#pragma unroll 1
        for (int tp = 0; tp < 8; ++tp) {
        u32x2 yk[1][4];
#pragma unroll
        for (int tt = 0; tt < 1; ++tt) { const int tb = tp;
            const int tl = 16 * tb + c16; const float cumt = CUM[wid * 128 + tl], ect = __expf(cumt);
            f32x4 acc[4];
            { bf16x8 cf[4];
#pragma unroll
              for (int ks = 0; ks < 4; ++ks) cf[ks] = lds_frag(CN, tl, LP, 32 * ks + 8 * q);
#pragma unroll
              for (int pb = 0; pb < 4; ++pb) { acc[pb] = (f32x4){0.f, 0.f, 0.f, 0.f};
#pragma unroll
                  for (int ks = 0; ks < 4; ++ks) acc[pb] = MFMA16(sf[pb][ks], cf[ks], acc[pb]);
                  acc[pb] = acc[pb] * ect; } }
#pragma unroll
            for (int ks = 0; ks < 4; ++ks) { if (32 * ks > 16 * tb + 15) continue;
                const int s0 = 32 * ks + 8 * q; const u32x4 cbw = *(const LAS u32x4*)(CB + tl * LP + s0);
                const f32x4 c0 = *(const LAS f32x4*)(CUM + wid * 128 + s0), c1 = *(const LAS f32x4*)(CUM + wid * 128 + s0 + 4), d0 = *(const LAS f32x4*)(DTS + wid * 128 + s0), d1 = *(const LAS f32x4*)(DTS + wid * 128 + s0 + 4);
                float gv[8];
#pragma unroll
                for (int j = 0; j < 8; ++j) { const int s = s0 + j; const float cb = (j & 1) ? bfhi(cbw[j >> 1]) : bflo(cbw[j >> 1]); const float cs = j < 4 ? c0[j & 3] : c1[j & 3], ds = j < 4 ? d0[j & 3] : d1[j & 3];
                    float v = cb * __expf(fminf(cumt - cs, 0.f)) * ds; v = (s <= tl) ? v : 0.f; gv[j] = (s == tl) ? v + dsk : v; }
                u32x4 gw; gw.x = cvt_pk_bf16(gv[0], gv[1]); gw.y = cvt_pk_bf16(gv[2], gv[3]); gw.z = cvt_pk_bf16(gv[4], gv[5]); gw.w = cvt_pk_bf16(gv[6], gv[7]);
                const bf16x8 gf = __builtin_bit_cast(bf16x8, gw);
#pragma unroll
                for (int pb = 0; pb < 4; ++pb) acc[pb] = MFMA16(*(const bf16x8*)(xb + (size_t)(16 * pb) * 128 + 32 * ks), gf, acc[pb]);
            }
            float sq = 0.f;
#pragma unroll
            for (int pb = 0; pb < 4; ++pb) { const u32x2 zw = *(const u32x2*)(zbase + (size_t)tl * SSDIN + 16 * pb);
                f32x4 y; y[0] = acc[pb][0] * bflo(zw.x); y[1] = acc[pb][1] * bfhi(zw.x); y[2] = acc[pb][2] * bflo(zw.y); y[3] = acc[pb][3] * bfhi(zw.y);
                sq += (y[0] * y[0] + y[1] * y[1]) + (y[2] * y[2] + y[3] * y[3]); yk[tt][pb] = pack4(y); }
            sq += __shfl_xor(sq, 16); sq += __shfl_xor(sq, 32);
            if (q == 0) SQP[tl * 8 + wid] = sq;
        }
        WG_SYNC();
#pragma unroll
        for (int tt = 0; tt < 1; ++tt) { const int tl = 16 * tp + c16; const f32x4 s0 = *(const LAS f32x4*)(SQP + tl * 8), s1 = *(const LAS f32x4*)(SQP + tl * 8 + 4);
            const float rstd = rsqrtf((((s0[0] + s0[1]) + (s0[2] + s0[3])) + ((s1[0] + s1[1]) + (s1[2] + s1[3]))) * (1.0f / 512.f) + EPS);
#pragma unroll
            for (int pb = 0; pb < 4; ++pb) { bf16* yp = ybase + (size_t)tl * SSDIN + 16 * pb; const u32x2 w = yk[tt][pb]; const f32x4 nw = pb == 0 ? nw0 : pb == 1 ? nw1 : pb == 2 ? nw2 : nw3;
                f32x4 y; y[0] = bflo(w.x) * rstd * nw[0]; y[1] = bfhi(w.x) * rstd * nw[1]; y[2] = bflo(w.y) * rstd * nw[2]; y[3] = bfhi(w.y) * rstd * nw[3];
                *(u32x2*)yp = pack4(y); } }
        }
        WG_SYNC();
    }
}
#ifndef REP_GEMM
#define REP_GEMM 1
#endif
#if REP_GEMM == 2
#define GEMM_REP(...) { __VA_ARGS__ } { __VA_ARGS__ }
#else
#define GEMM_REP(...) { __VA_ARGS__ }
#endif
#ifndef REP_MIX
#define REP_MIX 1
#endif
#ifndef REP_CONV
#define REP_CONV 1
#endif
struct Args { In in; float* out; unsigned char* ws; int ph_lo, ph_hi; };
static_assert(sizeof(Args) == 32 * 8 + 8 + 8 + 8, "Args has no padding");
typedef const Args __attribute__((address_space(4))) CArgs;

#ifndef SLEEP_MASK
#define SLEEP_MASK 0ull
#endif
#define SLEEP_AMP 4
#define PHASE_BEGIN if (pc >= lo && pc < hi) { const unsigned long long t0_ = SLEEP_MASK ? __builtin_amdgcn_s_memrealtime() : 0ull; (void)t0_; int tid = wave0 * 64 + (int)__builtin_amdgcn_mbcnt_hi(~0u, __builtin_amdgcn_mbcnt_lo(~0u, 0u)); asm volatile("" : "+v"(tid)); int cu = __builtin_amdgcn_readfirstlane((int)*(volatile LAS unsigned*)(lds + MISC_OFF + 64)); asm volatile("" : "+s"(cu)); int G = gridDim.x; asm volatile("" : "+s"(G)); \
        const int lane = tid & 63, wave = __builtin_amdgcn_readfirstlane(tid >> 6), gw = cu * NWAVES + wave, NGW = G * NWAVES; (void)lane; (void)gw; (void)NGW; \
        CArgs* ap = (CArgs*)__builtin_amdgcn_kernarg_segment_ptr(); asm volatile("" : "+s"(ap)); CIn& I = ap->in; unsigned char* const ws = ap->ws; float* const xres = ap->out; \
        unsigned char* const act = ws + WS_ACT; float* const SS = (float*)(ws + WS_SS); bf16* const XB = (bf16*)(ws + WS_XB); bf16* const WL = (bf16*)(ws + WS_WL); (void)I; (void)xres; (void)act; (void)SS; (void)XB; (void)WL;
#if MK_SPLIT
#define PHASE_END } ++pc;
#else
#define PHASE_END if (pc + 1 < hi) xcd_barrier(bar); if (SLEEP_MASK && ((SLEEP_MASK >> pc) & 1ull)) { const unsigned long long t1_ = __builtin_amdgcn_s_memrealtime(), until_ = t1_ + SLEEP_AMP * (t1_ - t0_); while (__builtin_amdgcn_s_memrealtime() < until_) __builtin_amdgcn_s_sleep(8); } } ++pc;
#endif
#if MK_SPLIT
#define PHASE_END_XCD } ++pc;
#else
#define PHASE_END_XCD if (pc + 1 < hi) { if (*(volatile LAS unsigned*)(lds + MISC_OFF + 68)) xcd_local_barrier(bar, 32u); else xcd_barrier(bar); } } ++pc;
#endif
#define PHASE_END_LOCAL } ++pc;
#define D_WKV ((bf16*)(ws + WS_WKV))
#define D_KMAT ((bf16*)(ws + WS_KMAT))
#define D_VT ((bf16*)(ws + WS_VT))
#define D_MEMN ((bf16*)(ws + WS_MEMN))
#define D_LB ((float*)(ws + WS_TAB + TAB_LB))
#define D_WRT ((bf16*)(ws + WS_TAB + TAB_WRT))


#define KQb ((bf16*)(ws + WS_KQ))
#define VWb ((bf16*)(ws + WS_VW))
#define Pb ((bf16*)(act + A_P))
#define Hb ((bf16*)(act + A_H))
#define ABSORB_UNIT \
            if (cu < 256) { int nu = 1, kk = XAD; asm volatile("" : "+s"(nu), "+s"(kk)); const int iskq = cu < 128, idx = cu & 127, bh = idx >> 3, t8 = idx & 7, b = bh >> 2, h = bh & 3; \
                const bf16* Km = D_KMAT + (size_t)l * MEMROWS * D; const bf16* Vm = D_VT + (size_t)l * MEMROWS * D; \
                pg8::SchedOne S; S.n = nu; \
                S.u0.a = iskq ? (const char*)(Km + (size_t)(b * MEMLEN) * D + h * XAD) : (const char*)(WLL + WL_O + (size_t)(t8 * 256) * D + h * XAD); \
                S.u0.b = iskq ? (const char*)(WLL + WL_Q + (size_t)(t8 * 256) * D + h * XAD) : (const char*)(Vm + (size_t)(b * MEMLEN) * D + h * XAD); \
                S.u0.orow = iskq ? bh * 256 : t8 * 256; S.u0.ocol = iskq ? t8 * 256 : h * 256; S.u0.aux = 0; \
                pg8::EpiPlain E{iskq ? KQb : VWb + (size_t)b * D * 1024, iskq ? D : 1024}; pg8::gemm_phase(tid, lds, kk, D, D, S, E); }
template <int l>
__device__ __forceinline__ void layer_body(LAS unsigned char* lds, const int wave0, const int lo, const int hi, int& pc, const XcdBarrier& bar) {
    int ssi = 3 * l;
#define WLL ((bf16*)(ws + ((l & 1) ? WS_WL2 : WS_WL)))
#define WLN ((bf16*)(ws + ((l & 1) ? WS_WL : WS_WL2)))

        const int e = l >> 1;
        int mixK;
        if ((l & 1) == 0) {
#define PROJ ((bf16*)(act + A_PROJ))
#define LOGF ((float*)(act + A_LOGF))
#define HST ((bf16*)(act + A_HST))
#define YAB ((bf16*)(act + A_YAB))
#define SEG ((float*)(act + A_SEG))
#define HDEC ((float*)(act + A_HDEC))
            PHASE_BEGIN
                if (l == 0 && (cu & 1)) { int rot = 0; convert_layer<2>(I, 0, WLL, (LAS float*)(lds + wave * 16640), gw, NGW, lane, rot); WG_SYNC(); asm volatile("" : "+v"(tid)); }
                if (l == 0) { pg8::SchedKV S{(const char*)D_MEMN, (const char*)D_WKV, G, cu}; pg8::EpiKV E{D_KMAT, D_VT}; pg8::gemm_phase(tid, lds, D, D, D, S, E); asm volatile("" : "+v"(tid)); }
                GEMM_REP(pg8::SchedMN S; S.init(XB, D, WLL + WL_IN, D, M, ABIN, G, cu); pg8::EpiProjEven E{SS + (size_t)ssi * M * 8, PROJ, LOGF, D_LB + e * 1024};
                pg8::gemm_phase<RF16>(tid, lds, D, D, D, S, E);)
                if (l == 0 && !(cu & 1)) { asm volatile("" : "+v"(tid)); const int lane2 = tid & 63, wave2 = __builtin_amdgcn_readfirstlane(tid >> 6); int rot = 0; convert_layer<2>(I, 0, WLL, (LAS float*)(lds + wave2 * 16640), cu * NWAVES + wave2, NGW, lane2, rot); }
            PHASE_END
            PHASE_BEGIN
                for (int rep_ = 0; rep_ < REP_MIX; ++rep_) { lru_units<false>(tid, lds, G, cu, PROJ, D_WRT + (size_t)e * 2 * 8 * 16384, I.lru_conv_w + e * 4 * LRUW, I.lru_conv_b + e * LRUW, I.lru_b_r + e * LRUW, I.lru_b_i + e * LRUW, I.lru_lambda + e * LRUW, SEG, YAB);
                hgrn1_units(tid, lds, G, cu, LOGF, PROJ, HST, HDEC); }
            PHASE_END
            PHASE_BEGIN
                for (int rep_ = 0; rep_ < REP_MIX; ++rep_) { lru_units<true>(tid, lds, G, cu, PROJ, D_WRT + (size_t)e * 2 * 8 * 16384, I.lru_conv_w + e * 4 * LRUW, I.lru_conv_b + e * LRUW, I.lru_b_r + e * LRUW, I.lru_b_i + e * LRUW, I.lru_lambda + e * LRUW, SEG, YAB); }
                hgrn2_scan(tid, G, cu, HST, HDEC);
            PHASE_END
            PHASE_BEGIN
                if (cu & 1) { ABSORB_UNIT asm volatile("" : "+v"(tid)); }
                for (int rep_ = 0; rep_ < REP_MIX; ++rep_) { hgrn3_units(tid, lds, G, cu, LOGF, PROJ, HST, I.hgrn_norm + e * 1024, YAB); }
                if (!(cu & 1)) { WG_SYNC(); asm volatile("" : "+v"(tid)); ABSORB_UNIT }
            PHASE_END
            mixK = D;
        } else {
#define Zb ((bf16*)(act + A_Z))
#define XBC ((bf16*)(act + A_XBC))
#define XBT ((bf16*)(act + A_XBT))
#define BCN ((bf16*)(act + A_BCN))
#define STb ((bf16*)(act + A_ST))
#define DTb ((float*)(act + A_DT))
#define DEC ((float*)(act + A_DEC))
#define Yb ((bf16*)(act + A_Y))
            PHASE_BEGIN
                GEMM_REP(pg8::SchedMN S; S.init(XB, D, WLL + WL_IN, D, M, SSDN1, G, cu); pg8::EpiProjOdd E{SS + (size_t)ssi * M * 8, Zb, XBC};
                pg8::gemm_phase<RF16>(tid, lds, D, D, D, S, E);)
            PHASE_END
            PHASE_BEGIN
                for (int rep_ = 0; rep_ < REP_MIX; ++rep_) {
                { pg8::SchedDt S{(const char*)XB, (const char*)(WLL + WL_DT), cu}; pg8::EpiDt E{SS + (size_t)ssi * M * 8, I.ssd_dt_bias + e * 64, DTb};
                  pg8::gemm_phase<RF16>(tid, lds, D, D, D, S, E); }
                { int uf = cu, us = G, ue = 6144; if (G == 256) { if (cu < 64) { us = 64; ue = 1152; } else { uf = 1152 + (cu - 64); us = 192; } }
                  ssd_prep_units(tid, lds, uf, us, ue, XBC, I.ssd_conv_w + (size_t)e * 4 * SSDCONV, I.ssd_conv_b + e * SSDCONV, XBT, BCN); }
                }
            PHASE_END
            PHASE_BEGIN
                for (int rep_ = 0; rep_ < REP_MIX; ++rep_) { ssd1_units(tid, lds, G, cu, XBT, DTb, I.ssd_a_log + e * 64, STb, DEC); }
            PHASE_END
            PHASE_BEGIN
                ssd2_scan(tid, G, cu, STb, DEC);
            PHASE_END
            PHASE_BEGIN
                if (cu & 1) { ABSORB_UNIT asm volatile("" : "+v"(tid)); }
                for (int rep_ = 0; rep_ < REP_MIX; ++rep_) { ssd3_units(tid, lds, G, cu, XBT, BCN, STb, DTb, I.ssd_a_log + e * 64, I.ssd_d + e * 64, Zb, I.ssd_norm + e * SSDIN, Yb); }
                if (!(cu & 1)) { WG_SYNC(); asm volatile("" : "+v"(tid)); ABSORB_UNIT }
            PHASE_END
            mixK = SSDIN;
        }
        PHASE_BEGIN
            { pg8::SchedMN S; S.init(mixK == D ? (const bf16*)YAB : (const bf16*)Yb, mixK, WLL + WL_OUT, mixK, M, D, G, cu); pg8::EpiResid E{XB, SS + (size_t)(ssi + 1) * M * 8, (LAS float*)(lds + EPI_OFF)};
              pg8::gemm_phase(tid, lds, mixK, mixK, mixK, S, E); asm volatile("" : "+v"(tid)); }
        PHASE_END_XCD
        ++ssi;
        PHASE_BEGIN
            static_assert(!RF16, "the absorbed key matrix is bf16: the residual stream must be bf16 too");
            if (cu < 256) { const int pm = (cu & 7) * 8 + (cu >> 5), h = (cu >> 3) & 3;     int nu = 1; asm volatile("" : "+s"(nu));
                pg8::SchedOne S; S.n = nu; S.u0.a = (const char*)(XB + (size_t)pm * 256 * D); S.u0.b = (const char*)(KQb + (size_t)(((pm >> 4) * 4 + h) * 256) * D); S.u0.orow = pm * 256; S.u0.ocol = h * 256; S.u0.aux = 0;
                pg8::EpiSoftmax E{SS + (size_t)ssi * M * 8, 0.044194173824159216f, Pb, (LAS float*)(lds + EPI_OFF)}; pg8::gemm_phase(tid, lds, D, D, D, S, E); }
        PHASE_END_XCD
        PHASE_BEGIN
            pg8::SchedMNB S; S.init(Pb, 1024, VWb, 1024, M, D, G, cu, (size_t)D * 1024 * 2); pg8::EpiResid E{XB, SS + (size_t)(ssi + 1) * M * 8, (LAS float*)(lds + EPI_OFF)};
            pg8::gemm_phase(tid, lds, 1024, 1024, 1024, S, E);
        PHASE_END
        ++ssi;
        PHASE_BEGIN
            if (l + 1 < DEPTH && (cu & 1)) { int rot = 0; convert_layer(I, l + 1, WLN, (LAS float*)(lds + wave * 16640), gw, NGW, lane, rot); WG_SYNC(); asm volatile("" : "+v"(tid)); }
            GEMM_REP(pg8::SchedMN S; S.init(XB, D, WLL + WL_GU, D, M, 2 * FF, G, cu); pg8::EpiGateUp E{SS + (size_t)ssi * M * 8, Hb};
            pg8::gemm_phase<RF16>(tid, lds, D, D, D, S, E);)
            if (l + 1 < DEPTH && !(cu & 1)) { asm volatile("" : "+v"(tid)); const int lane2 = tid & 63, wave2 = __builtin_amdgcn_readfirstlane(tid >> 6); int rot = 0; convert_layer(I, l + 1, WLN, (LAS float*)(lds + wave2 * 16640), cu * NWAVES + wave2, NGW, lane2, rot); }
        PHASE_END_XCD
        if (l + 1 < DEPTH) {
        PHASE_BEGIN
            pg8::SchedMN S; S.init(Hb, FF, WLL + WL_DN, FF, M, D, G, cu); pg8::EpiResid E{XB, SS + (size_t)(ssi + 1) * M * 8, (LAS float*)(lds + EPI_OFF)};
            pg8::gemm_phase(tid, lds, FF, FF, FF, S, E);
        PHASE_END
        } else {
        PHASE_BEGIN
            pg8::SchedMN S; S.init(Hb, FF, WLL + WL_DN, FF, M, D, G, cu); pg8::EpiResid E{XB, SS + (size_t)(ssi + 1) * M * 8, (LAS float*)(lds + EPI_OFF)};
            pg8::gemm_phase(tid, lds, FF, FF, FF, S, E);
        PHASE_END_XCD
        }
        ++ssi;
    }

__global__ void __launch_bounds__(NTHR, 2) fwd(Args args) {
    extern __shared__ __attribute__((aligned(16))) unsigned char lds_raw[];
    LAS unsigned char* lds = (LAS unsigned char*)lds_raw;
    volatile LAS unsigned* MISC = (volatile LAS unsigned*)(lds + MISC_OFF);
    const int wave0 = __builtin_amdgcn_readfirstlane((int)threadIdx.x >> 6);
    if (threadIdx.x < 64) MISC[threadIdx.x] = 0u;
    __syncthreads();
#if !MK_SPLIT
    XcdBarrier bar = xcd_barrier_post((unsigned*)(args.ws + WS_CTL), MISC + 8);
    if (threadIdx.x == 0) { MISC[16] = blockIdx.x; MISC[17] = 0u; MISC[18] = xb_add(&bar.bar[XL_RANK(bar.x)], 1u); }
    __syncthreads();
#else
    XcdBarrier bar; bar.bar = nullptr; bar.x = 0; bar.st = nullptr;
    if (threadIdx.x == 0) { MISC[16] = blockIdx.x; MISC[17] = 0u; }
    __syncthreads();
#endif
    const int lo = args.ph_lo, hi = args.ph_hi; int pc = 0;
    PHASE_BEGIN
        LAS float* scr = (LAS float*)(lds + wave * 16640);
        int rot = 0;
        for (int l = 0; l < DEPTH; ++l) conv_matrix<0>(I.xa_w_kv + (size_t)l * D * 4096, 4096, D, 0, 4096, nullptr, D_WKV + (size_t)l * 4096 * D, 0, scr, gw, NGW, lane, rot);
        for (int rep_ = 0; rep_ < REP_CONV; ++rep_) convert_layer<1>(I, 0, WL, scr, gw, NGW, lane, rot);
        for (int m = gw; m < MEMROWS; m += NGW) {
            const f32x4* xr = (const f32x4*)(I.mem + (size_t)m * D); f32x4 v[8]; float s = 0.f;
#pragma unroll
            for (int j = 0; j < 8; ++j) { v[j] = xr[64 * j + lane]; s += (v[j][0] * v[j][0] + v[j][1] * v[j][1]) + (v[j][2] * v[j][2] + v[j][3] * v[j][3]); }
            const float rs = rsqrtf(wave_sum(s) * (1.0f / D) + EPS);
#pragma unroll
            for (int j = 0; j < 8; ++j) { const f32x4 g = *(const f32x4*)(I.norm_mem + (64 * j + lane) * 4); *(u32x2*)(D_MEMN + (size_t)m * D + (64 * j + lane) * 4) = pack4(v[j] * rs * g); }
        }
        for (int m = gw; m < M; m += NGW) {
            const f32x4* xr = (const f32x4*)(I.x + (size_t)m * D); float s = 0.f;
#pragma unroll
            for (int j = 0; j < 8; ++j) { const f32x4 v = xr[64 * j + lane]; s += (v[0] * v[0] + v[1] * v[1]) + (v[2] * v[2] + v[3] * v[3]); u32x2 w; w.x = rs_pk(v[0], v[1]); w.y = rs_pk(v[2], v[3]); *(u32x2*)(XB + (size_t)m * D + (64 * j + lane) * 4) = w; }
            s = wave_sum(s); if (lane < 8) SS[(size_t)m * 8 + lane] = lane == 0 ? s : 0.f;
        }
        for (int i = cu * NTHR + tid; i < 1024; i += G * NTHR) {
            const float a = I.hgrn_lb[i], b = I.hgrn_lb[1024 + i], mx = fmaxf(a, b), e0 = __expf(a - mx), e1 = __expf(b - mx); D_LB[i] = 0.f; D_LB[1024 + i] = e1 / (e0 + e1); }
        for (int i = cu * NTHR + tid; i < 2 * 2 * 8 * 16384; i += G * NTHR) {
            const int ii = i & 127, jj = (i >> 7) & 127, blk = (i >> 14) & 7, gt = (i >> 17) & 1, e = i >> 18;
            const float* src = gt ? I.lru_w_i : I.lru_w_r; D_WRT[i] = (bf16)f2bf(src[((size_t)(e * 8 + blk) * 128 + ii) * 128 + jj]); }
    PHASE_END

#if !MK_SPLIT
    if (threadIdx.x == 0) { bool uni = gridDim.x == 256;
        for (unsigned j = 0; j < 16; ++j) { const unsigned c = xb_ld(&bar.bar[XB_XCNT(j)]); uni = uni && (c == (j < 8 ? 32u : 0u)); }
        if (uni && MISC[18] < 32u) { MISC[16] = 8u * MISC[18] + bar.x; MISC[17] = 1u; } }
    __syncthreads();
#endif
    layer_body<0>(lds, wave0, lo, hi, pc, bar); layer_body<1>(lds, wave0, lo, hi, pc, bar); layer_body<2>(lds, wave0, lo, hi, pc, bar); layer_body<3>(lds, wave0, lo, hi, pc, bar);
    const int ssi = 12;
    PHASE_BEGIN
        const float* ssf = SS + (size_t)ssi * M * 8;
        for (int k = 0; k < 8; ++k) { const int m = 2048 * (cu & 7) + (cu >> 3) * 8 + wave + 256 * k;
            f32x4* row = (f32x4*)(xres + (size_t)m * D); const u32x2* xr = (const u32x2*)(XB + (size_t)m * D); const float rs = pg8::rstd_of(ssf, m);
#pragma unroll
            for (int j = 0; j < 8; ++j) { const f32x4 g = *(const f32x4*)(I.norm_final + (64 * j + lane) * 4); const u32x2 w = xr[64 * j + lane];
                f32x4 o; o[0] = rs_lo(w.x) * rs * g[0]; o[1] = rs_hi(w.x) * rs * g[1]; o[2] = rs_lo(w.y) * rs * g[2]; o[3] = rs_hi(w.y) * rs * g[3]; row[64 * j + lane] = o; } }
    PHASE_END
#undef PHASE_BEGIN
#undef PHASE_END
}

constexpr int NPHASES = 1 + (5 + 4) + (6 + 4) + (5 + 4) + (6 + 4) + 1;

extern "C" void kernel_launch(void* const* d_in, const int* in_sizes, int n_in, void* d_out, int out_size, void* d_ws, size_t ws_size, hipStream_t stream) {
    static int grid = 0;
    if (grid == 0) {
        if (n_in != 32 || out_size != M * D || ws_size < WS_END) { fprintf(stderr, "kernel_launch: unexpected problem (n_in %d, out %d, ws %zu)\n", n_in, out_size, ws_size); grid = -1; return; }
        int dev = 0, cus = 0;
        if (hipGetDevice(&dev) != hipSuccess || hipDeviceGetAttribute(&cus, hipDeviceAttributeMultiprocessorCount, dev) != hipSuccess) { grid = -1; return; }
        if (hipFuncSetAttribute((const void*)fwd, hipFuncAttributeMaxDynamicSharedMemorySize, LDS_BYTES) != hipSuccess) { fprintf(stderr, "kernel_launch: hipFuncSetAttribute failed\n"); grid = -1; return; }
        int per_cu = 0;
        if (hipOccupancyMaxActiveBlocksPerMultiprocessor(&per_cu, (const void*)fwd, NTHR, LDS_BYTES) != hipSuccess || per_cu < 1) fprintf(stderr, "kernel_launch: occupancy query says %d\n", per_cu);
        (void)hipGetLastError();
        if (cus != 256) { fprintf(stderr, "kernel_launch: built for a 256-CU device (got %d)\n", cus); grid = -1; return; }
        grid = cus;
    }
    if (grid < 0) return;
    (void)hipMemsetAsync((char*)d_ws + WS_CTL, 0, CTL_ZERO_BYTES, stream);
    Args a{};
    const float** ip = (const float**)&a.in;
    for (int i = 0; i < 32; ++i) ip[i] = (const float*)d_in[i];
    a.out = (float*)d_out; a.ws = (unsigned char*)d_ws;
#if MK_SPLIT
#ifndef PROBE_MASK
#define PROBE_MASK 0ull
#endif
    for (int li = 0; li < NPHASES; ++li) { a.ph_lo = li; a.ph_hi = li + 1; hipLaunchKernelGGL(fwd, dim3(grid), dim3(NTHR), LDS_BYTES, stream, a);
        if ((PROBE_MASK >> li) & 1ull) hipLaunchKernelGGL(fwd, dim3(grid), dim3(NTHR), LDS_BYTES, stream, a); }
#else
    a.ph_lo = 0; a.ph_hi = NPHASES;
    hipLaunchKernelGGL(fwd, dim3(grid), dim3(NTHR), LDS_BYTES, stream, a);
#endif
}
```
